# Optimizing an MI355X kernel written in HIP

```python
import jax
import jax.numpy as jnp
from jax import lax
import numpy as np

D_MODEL = 1024
BATCH = 4
SEQ = 8192
DEPTH = 2

HEAD_DIM = 64
D_MIX = D_MODEL
D_CONV = D_MIX // 4
D_RWKV = D_MIX // 4
D_NSA = D_MIX - D_CONV - D_RWKV
CONV_WIDTH = 31
CONV_GROUPS = D_CONV // HEAD_DIM
CONV_EPS = 1e-5
RWKV_HEADS = D_RWKV // HEAD_DIM
LORA_W = 64
LORA_A = 64
LORA_G = 128
RWKV_GN_EPS = 64e-5
NSA_HEADS = D_NSA // HEAD_DIM
NSA_KV_HEADS = 2
NSA_GROUP = NSA_HEADS // NSA_KV_HEADS
CMP_BLOCK = 32
CMP_STRIDE = 16
CMP_HIDDEN = 2 * HEAD_DIM
SEL_BLOCK = 64
N_SEL = 16
WINDOW = 512
Q_BLOCK = 128
FORCE_SCORE = 1e4
NEG_INF = -1e30
PEER_HEADS = 8
PEER_KEYS = 128
PEER_TOPK = 16
PEER_QDIM = 256
N_EXPERTS = PEER_KEYS * PEER_KEYS
PEER_CHUNK = 128
RMS_EPS = 1e-6
N_CONV_IN = 2 * D_CONV
N_RWKV_IN = 3 * D_RWKV + LORA_W + LORA_A + LORA_G
N_Q_IN = D_NSA
N_KV_IN = 6 * NSA_KV_HEADS * HEAD_DIM
N_GATE_IN = 3 * NSA_HEADS
N_IN = N_CONV_IN + N_RWKV_IN + N_Q_IN + N_KV_IN + N_GATE_IN

kernel_name = 'hymba_conv_rwkv7_nsa_peer_adaln'


def _rmsnorm(x, g):
    x32 = x.astype(jnp.float32)
    y = x32 * lax.rsqrt(jnp.mean(x32 * x32, axis=-1, keepdims=True) + RMS_EPS)
    return (y * g.astype(jnp.float32)).astype(x.dtype)


def _group_norm(y, n_groups, g, b, eps):
    shp = y.shape
    y32 = y.astype(jnp.float32).reshape(shp[:-1] + (n_groups, shp[-1] // n_groups))
    mu = jnp.mean(y32, axis=-1, keepdims=True)
    var = jnp.mean(jnp.square(y32 - mu), axis=-1, keepdims=True)
    yn = ((y32 - mu) * lax.rsqrt(var + eps)).reshape(shp)
    return (yn * g.astype(jnp.float32) + b.astype(jnp.float32)).astype(y.dtype)


def _conv_mixer(p, dw_w, dw_b, gn_g, gn_b):
    val, gate = jnp.split(p, 2, axis=-1)
    u = val * jax.nn.sigmoid(gate)
    y = lax.conv_general_dilated(u, dw_w.astype(u.dtype), window_strides=(1,),
                                 padding=((CONV_WIDTH - 1, 0),),
                                 dimension_numbers=('NWC', 'WIO', 'NWC'),
                                 feature_group_count=D_CONV) + dw_b
    y = _group_norm(y, CONV_GROUPS, gn_g, gn_b, CONV_EPS)
    return jax.nn.silu(y)


def _rwkv_mixer(p, mu, w0, w_up, a0, a_up, g_up, k_k, k_a, r_k, ln_g, ln_b):
    B, T, _ = p.shape
    f32 = jnp.float32
    prev = jnp.pad(p, ((0, 0), (1, 0), (0, 0)))[:, :-1]
    p = p + (prev - p) * mu
    r, k, v, xw, xa, xg = jnp.split(
        p, [D_RWKV, 2 * D_RWKV, 3 * D_RWKV, 3 * D_RWKV + LORA_W, 3 * D_RWKV + LORA_W + LORA_A], axis=-1)
    w_log = -jax.nn.softplus(-(w0 + jnp.tanh(xw) @ w_up).astype(f32)) - 0.5
    decay = jnp.exp(-jnp.exp(w_log))
    a = jax.nn.sigmoid((a0 + xa @ a_up).astype(f32))
    g = (jax.nn.sigmoid(xg) @ g_up).astype(f32)

    def heads(z):
        return z.astype(f32).reshape(B, T, RWKV_HEADS, HEAD_DIM)

    kk = heads(k * k_k)
    kk = kk / jnp.maximum(jnp.linalg.norm(kk, axis=-1, keepdims=True), 1e-12)
    k_eff = k.astype(f32) * (1.0 + (a - 1.0) * k_a.astype(f32))
    r_h, k_h, v_h, w_h, a_h = heads(r), heads(k_eff), heads(v), heads(decay), heads(a)

    def step(S, inp):
        r_t, w_t, k_t, v_t, kk_t, a_t = inp
        sa = jnp.einsum('bhvk,bhk->bhv', S, -kk_t)
        S = (S * w_t[:, :, None, :] + sa[..., None] * (kk_t * a_t)[:, :, None, :]
             + v_t[..., None] * k_t[:, :, None, :])
        return S, jnp.einsum('bhvk,bhk->bhv', S, r_t)

    def tm(z):
        return z.transpose(1, 0, 2, 3)

    S0 = jnp.zeros((B, RWKV_HEADS, HEAD_DIM, HEAD_DIM), f32)
    _, ys = lax.scan(step, S0, (tm(r_h), tm(w_h), tm(k_h), tm(v_h), tm(kk), tm(a_h)))
    y = ys.transpose(1, 0, 2, 3).reshape(B, T, D_RWKV)
    y = _group_norm(y, RWKV_HEADS, ln_g, ln_b, RWKV_GN_EPS)
    bonus = jnp.sum(r_h * k_h * r_k.astype(f32), axis=-1, keepdims=True) * v_h
    y = (y + bonus.reshape(B, T, D_RWKV)) * g
    return y.astype(p.dtype)


def _nsa_mixer(p_q, p_kv, p_gate, ck_pos, ck_w1, ck_w2, cv_pos, cv_w1, cv_w2):
    B, T, _ = p_q.shape
    G, R, dk = NSA_KV_HEADS, NSA_GROUP, HEAD_DIM
    f32 = jnp.float32
    scale = HEAD_DIM ** -0.5

    def kv_heads(z):
        return z.reshape(B, T, G, dk).transpose(0, 2, 1, 3)

    k_cmp, v_cmp, k_sel, v_sel, k_win, v_win = [kv_heads(z) for z in jnp.split(p_kv, 6, axis=-1)]

    n_c = (T - CMP_BLOCK) // CMP_STRIDE + 1
    cmp_idx = jnp.arange(n_c)[:, None] * CMP_STRIDE + jnp.arange(CMP_BLOCK)[None, :]

    def compress(z, pos, w1, w2):
        blk = (z[:, :, cmp_idx] + pos).reshape(B, G, n_c, CMP_BLOCK * dk)
        return jax.nn.silu(blk @ w1) @ w2

    kc = compress(k_cmp, ck_pos, ck_w1, ck_w2)
    vc = compress(v_cmp, cv_pos, cv_w1, cv_w2)
    cmp_end = cmp_idx[:, -1]

    n_s = T // SEL_BLOCK
    n_sel = min(N_SEL, n_s)
    ks = k_sel.reshape(B, G, n_s, SEL_BLOCK, dk)
    vs = v_sel.reshape(B, G, n_s, SEL_BLOCK, dk)
    cmp_start = jnp.arange(n_c) * CMP_STRIDE
    sel_start = jnp.arange(n_s) * SEL_BLOCK
    overlap = ((cmp_start[:, None] < sel_start[None, :] + SEL_BLOCK)
               & (cmp_start[:, None] + CMP_BLOCK > sel_start[None, :])).astype(f32)

    kw = jnp.pad(k_win, ((0, 0), (0, 0), (WINDOW, 0), (0, 0)))
    vw = jnp.pad(v_win, ((0, 0), (0, 0), (WINDOW, 0), (0, 0)))

    n_qb = T // Q_BLOCK
    q_all = p_q.reshape(B, n_qb, Q_BLOCK, G, R, dk).transpose(1, 0, 3, 4, 2, 5)
    g_all = jax.nn.sigmoid(p_gate.astype(f32)).reshape(B, n_qb, Q_BLOCK, 3, G, R).transpose(1, 0, 4, 5, 2, 3)
    b_ix = jnp.arange(B)[:, None, None, None]
    g_ix = jnp.arange(G)[None, :, None, None]

    def block(args):
        qi, q, gate = args
        t = qi * Q_BLOCK + jnp.arange(Q_BLOCK)
        valid_c = cmp_end[None, :] <= t[:, None]
        s_c = jnp.einsum('bgrqd,bgnd->bgrqn', q, kc).astype(f32) * scale
        p_c = jax.nn.softmax(jnp.where(valid_c, s_c, NEG_INF), axis=-1) * jnp.any(valid_c, axis=-1)[:, None]
        o_c = jnp.einsum('bgrqn,bgnd->bgrqd', p_c.astype(vc.dtype), vc)
        imp = jnp.einsum('bgrqn,ns->bgqs', p_c, overlap)
        blk_j = jnp.arange(n_s)[None, :]
        cur = (t // SEL_BLOCK)[:, None]
        forced = (blk_j == 0) | (blk_j == cur) | (blk_j == cur - 1)
        imp = jnp.where(forced, FORCE_SCORE, jnp.where(blk_j <= cur, imp, -1.0))
        _, sel = lax.top_k(imp, n_sel)
        k_g = ks[b_ix, g_ix, sel]
        v_g = vs[b_ix, g_ix, sel]
        key_pos = sel[..., None] * SEL_BLOCK + jnp.arange(SEL_BLOCK)
        valid_s = (key_pos <= t[None, None, :, None, None]).reshape(B, G, Q_BLOCK, n_sel * SEL_BLOCK)[:, :, None]
        s_s = jnp.einsum('bgrqd,bgqnld->bgrqnl', q, k_g).astype(f32).reshape(
            B, G, R, Q_BLOCK, n_sel * SEL_BLOCK) * scale
        p_s = jax.nn.softmax(jnp.where(valid_s, s_s, NEG_INF), axis=-1).reshape(
            B, G, R, Q_BLOCK, n_sel, SEL_BLOCK)
        o_s = jnp.einsum('bgrqnl,bgqnld->bgrqd', p_s.astype(v_g.dtype), v_g)
        start = qi * Q_BLOCK
        k_w = lax.dynamic_slice_in_dim(kw, start, WINDOW + Q_BLOCK, axis=2)
        v_w = lax.dynamic_slice_in_dim(vw, start, WINDOW + Q_BLOCK, axis=2)
        key_w = start - WINDOW + jnp.arange(WINDOW + Q_BLOCK)
        dist = t[:, None] - key_w[None, :]
        valid_w = (dist >= 0) & (dist < WINDOW) & (key_w[None, :] >= 0)
        s_w = jnp.einsum('bgrqd,bgkd->bgrqk', q, k_w).astype(f32) * scale
        p_w = jax.nn.softmax(jnp.where(valid_w, s_w, NEG_INF), axis=-1)
        o_w = jnp.einsum('bgrqk,bgkd->bgrqd', p_w.astype(v_w.dtype), v_w)
        o = gate[..., 0, None] * o_c + gate[..., 1, None] * o_s + gate[..., 2, None] * o_w
        return o.astype(q.dtype)

    out = lax.map(block, (jnp.arange(n_qb), q_all, g_all))
    return out.transpose(1, 0, 4, 2, 3, 5).reshape(B, T, D_NSA)


def _peer(h, wq, k1, k2, u, v):
    B, T, D = h.shape
    half = PEER_QDIM // 2
    tok = h.reshape(-1, PEER_CHUNK, D)

    def chunk(hc):
        q = (hc @ wq).reshape(PEER_CHUNK, PEER_HEADS, PEER_QDIM)
        s1 = jnp.einsum('chd,nd->chn', q[..., :half], k1).astype(jnp.float32)
        s2 = jnp.einsum('chd,nd->chn', q[..., half:], k2).astype(jnp.float32)
        v1, i1 = lax.top_k(s1, PEER_TOPK)
        v2, i2 = lax.top_k(s2, PEER_TOPK)
        cand = (v1[..., :, None] + v2[..., None, :]).reshape(PEER_CHUNK, PEER_HEADS, PEER_TOPK * PEER_TOPK)
        sc, ci = lax.top_k(cand, PEER_TOPK)
        e = (jnp.take_along_axis(i1, ci // PEER_TOPK, axis=-1) * PEER_KEYS
             + jnp.take_along_axis(i2, ci % PEER_TOPK, axis=-1))
        gw = jax.nn.softmax(sc, axis=-1)
        hid = jnp.einsum('chkd,cd->chk', u[e], hc).astype(jnp.float32)
        act = (jax.nn.gelu(hid, approximate=False) * gw).astype(hc.dtype)
        return jnp.einsum('chk,chkd->cd', act, v[e])

    return lax.map(chunk, tok).reshape(B, T, D)


def setup_inputs(seed: int = 0) -> dict:
    key = jax.random.key(seed)
    keys = iter(jax.random.split(key, 64))
    L, D = DEPTH, D_MODEL

    def nrm(shape, s):
        return jax.random.normal(next(keys), shape, jnp.float32) * s

    return {
        'x': nrm((BATCH, SEQ, D), 1.0),
        'c': nrm((BATCH, D), 1.0),
        'ada_w': nrm((L, D, 6 * D), 0.5 * D ** -0.5),
        'ada_b': nrm((L, 6 * D), 0.01),
        'norm1_g': 1.0 + nrm((L, D), 0.02),
        'norm2_g': 1.0 + nrm((L, D), 0.02),
        'w_in': nrm((L, D, N_IN), D ** -0.5),
        'conv_dw_w': nrm((L, CONV_WIDTH, 1, D_CONV), CONV_WIDTH ** -0.5),
        'conv_dw_b': nrm((L, D_CONV), 0.01),
        'conv_gn_g': 1.0 + nrm((L, D_CONV), 0.02),
        'conv_gn_b': nrm((L, D_CONV), 0.01),
        'rwkv_mu': jax.random.uniform(next(keys), (L, N_RWKV_IN), jnp.float32),
        'rwkv_w0': nrm((L, D_RWKV), 1.0) - 1.0,
        'rwkv_w_up': nrm((L, LORA_W, D_RWKV), LORA_W ** -0.5),
        'rwkv_a0': nrm((L, D_RWKV), 0.5),
        'rwkv_a_up': nrm((L, LORA_A, D_RWKV), LORA_A ** -0.5),
        'rwkv_g_up': nrm((L, LORA_G, D_RWKV), LORA_G ** -0.5),
        'rwkv_k_k': 0.85 + nrm((L, D_RWKV), 0.1),
        'rwkv_k_a': 1.0 + nrm((L, D_RWKV), 0.1),
        'rwkv_r_k': nrm((L, RWKV_HEADS, HEAD_DIM), 0.1),
        'rwkv_ln_g': 1.0 + nrm((L, D_RWKV), 0.02),
        'rwkv_ln_b': nrm((L, D_RWKV), 0.01),
        'nsa_ck_pos': nrm((L, CMP_BLOCK, HEAD_DIM), 0.1),
        'nsa_ck_w1': nrm((L, CMP_BLOCK * HEAD_DIM, CMP_HIDDEN), (CMP_BLOCK * HEAD_DIM) ** -0.5),
        'nsa_ck_w2': nrm((L, CMP_HIDDEN, HEAD_DIM), CMP_HIDDEN ** -0.5),
        'nsa_cv_pos': nrm((L, CMP_BLOCK, HEAD_DIM), 0.1),
        'nsa_cv_w1': nrm((L, CMP_BLOCK * HEAD_DIM, CMP_HIDDEN), (CMP_BLOCK * HEAD_DIM) ** -0.5),
        'nsa_cv_w2': nrm((L, CMP_HIDDEN, HEAD_DIM), CMP_HIDDEN ** -0.5),
        'w_out': nrm((L, D_MIX, D), D_MIX ** -0.5),
        'peer_wq': nrm((L, D, PEER_HEADS * PEER_QDIM), D ** -0.5),
        'peer_k1': nrm((L, PEER_KEYS, PEER_QDIM // 2), (PEER_QDIM // 2) ** -0.5),
        'peer_k2': nrm((L, PEER_KEYS, PEER_QDIM // 2), (PEER_QDIM // 2) ** -0.5),
        'peer_u': nrm((L, N_EXPERTS, D), D ** -0.5),
        'peer_v': nrm((L, N_EXPERTS, D), 1.0),
        'final_g': 1.0 + nrm((D,), 0.02),
    }


def reference(x, c, ada_w, ada_b, norm1_g, norm2_g, w_in, conv_dw_w, conv_dw_b, conv_gn_g, conv_gn_b,
              rwkv_mu, rwkv_w0, rwkv_w_up, rwkv_a0, rwkv_a_up, rwkv_g_up, rwkv_k_k, rwkv_k_a, rwkv_r_k,
              rwkv_ln_g, rwkv_ln_b, nsa_ck_pos, nsa_ck_w1, nsa_ck_w2, nsa_cv_pos, nsa_cv_w1, nsa_cv_w2,
              w_out, peer_wq, peer_k1, peer_k2, peer_u, peer_v, final_g):
    cs = jax.nn.silu(c)
    splits = [N_CONV_IN, N_CONV_IN + N_RWKV_IN, N_CONV_IN + N_RWKV_IN + N_Q_IN,
              N_CONV_IN + N_RWKV_IN + N_Q_IN + N_KV_IN]
    for l in range(DEPTH):
        mod = cs @ ada_w[l] + ada_b[l]
        sh1, sc1, g1, sh2, sc2, g2 = [m[:, None, :] for m in jnp.split(mod, 6, axis=-1)]
        h = _rmsnorm(x, norm1_g[l]) * (1.0 + sc1) + sh1
        p_conv, p_rwkv, p_q, p_kv, p_gate = jnp.split(h @ w_in[l], splits, axis=-1)
        o_conv = _conv_mixer(p_conv, conv_dw_w[l], conv_dw_b[l], conv_gn_g[l], conv_gn_b[l])
        o_rwkv = _rwkv_mixer(p_rwkv, rwkv_mu[l], rwkv_w0[l], rwkv_w_up[l], rwkv_a0[l], rwkv_a_up[l],
                             rwkv_g_up[l], rwkv_k_k[l], rwkv_k_a[l], rwkv_r_k[l], rwkv_ln_g[l], rwkv_ln_b[l])
        o_nsa = _nsa_mixer(p_q, p_kv, p_gate, nsa_ck_pos[l], nsa_ck_w1[l], nsa_ck_w2[l],
                           nsa_cv_pos[l], nsa_cv_w1[l], nsa_cv_w2[l])
        mix = jnp.concatenate([o_conv.astype(x.dtype), o_rwkv.astype(x.dtype), o_nsa.astype(x.dtype)], axis=-1)
        x = x + g1 * (mix @ w_out[l])
        h2 = _rmsnorm(x, norm2_g[l]) * (1.0 + sc2) + sh2
        x = x + g2 * _peer(h2, peer_wq[l], peer_k1[l], peer_k2[l], peer_u[l], peer_v[l])
    return _rmsnorm(x, final_g)
```

```cpp
#include <hip/hip_runtime.h>
#include <hip/hip_cooperative_groups.h>
#include <stdint.h>
#include <stdio.h>
namespace cg = cooperative_groups;

#ifndef EN_CONV
#define EN_CONV 1
#endif
#ifndef EN_RWKV
#define EN_RWKV 1
#endif
#ifndef EN_NSA_CMP
#define EN_NSA_CMP 1
#endif
#ifndef EN_NSA_WIN
#define EN_NSA_WIN 1
#endif
#ifndef EN_NSA_SEL
#define EN_NSA_SEL 1
#endif
#ifndef EN_PEER
#define EN_PEER 1
#endif
#ifndef MULTI_LAUNCH
#define MULTI_LAUNCH 0
#endif

#define DEV __device__ __forceinline__
typedef unsigned short u16;
typedef __attribute__((ext_vector_type(8))) short bf16x8;
typedef __attribute__((ext_vector_type(4))) float f32x4;
typedef __attribute__((ext_vector_type(4))) unsigned int u32x4;
typedef __attribute__((ext_vector_type(2))) unsigned int u32x2;

constexpr int NB = 4, NT = 8192, ND = 1024, NTOK = NB * NT, NL = 2;
constexpr int NIN = 2840, NINP = 2944;
constexpr size_t MiB = 1ull << 20;

constexpr size_t OFF_CTL = 0;
constexpr size_t CTL_ZERO_BYTES = 16384;
constexpr size_t OFF_MOD = 64 * 1024;
constexpr size_t OFF_CBP = 256 * 1024;
constexpr size_t OFF_WIN = 1 * MiB;
constexpr size_t OFF_WOUT = 13 * MiB;
constexpr size_t OFF_WQ = 17 * MiB;
constexpr size_t OFF_CW1 = 25 * MiB;
constexpr size_t OFF_K12 = 27 * MiB;
constexpr size_t OFF_U = 28 * MiB;
constexpr size_t OFF_V = 60 * MiB;
constexpr size_t OFF_H = 92 * MiB;
constexpr size_t OFF_MIX = 156 * MiB;
constexpr size_t OFF_E = 220 * MiB;
constexpr size_t OFF_PCONV = OFF_E + 0;
constexpr size_t OFF_PRWKV = OFF_E + 32 * MiB;
constexpr size_t OFF_YRAW = OFF_E + 32 * MiB;
constexpr size_t OFF_Q = OFF_E + 96 * MiB;
constexpr size_t OFF_KV = OFF_E + 128 * MiB;
constexpr size_t OFF_GATE = OFF_E + 176 * MiB;
constexpr size_t OFF_KC = OFF_E + 180 * MiB;
constexpr size_t OFF_VCT = OFF_KC + 512 * 1024;
constexpr size_t OFF_RV = OFF_E + 184 * MiB;
constexpr size_t OFF_RKK = OFF_E + 200 * MiB;
constexpr size_t OFF_RKKA = OFF_E + 216 * MiB;
constexpr size_t OFF_RG = OFF_E + 232 * MiB;
constexpr size_t OFF_BONUS = OFF_E + 248 * MiB;
constexpr size_t OFF_RW = OFF_H;
constexpr size_t OFF_RR = OFF_H + 32 * MiB;
constexpr size_t OFF_RK = OFF_H + 48 * MiB;
constexpr size_t OFF_QP = OFF_E + 0;
constexpr size_t OFF_PIDX = OFF_E + 128 * MiB;
constexpr size_t OFF_PGW = OFF_E + 144 * MiB;
constexpr size_t WS_NEED = OFF_E + 249 * MiB;

#define QW(l, q) (64 * ((l) * 8 + (q)))
enum { Q_CMP = 0, Q_CONV = 1, Q_RWP = 2, Q_NSA = 3, Q_PTK = 4 };

enum { I_X = 0, I_C, I_ADAW, I_ADAB, I_N1G, I_N2G, I_WIN, I_CDW, I_CDB, I_CGG, I_CGB, I_MU, I_W0, I_WUP, I_A0, I_AUP, I_GUP,
       I_KK, I_KA, I_RK, I_LNG, I_LNB, I_CKPOS, I_CKW1, I_CKW2, I_CVPOS, I_CVW1, I_CVW2, I_WOUT, I_PWQ, I_PK1, I_PK2, I_PU, I_PV, I_FG };

struct Params {
    const float* in[35];
    float* out;
    unsigned char* ws;
    int ph_lo, ph_hi;
};

DEV int TID() { int t = threadIdx.x; asm volatile("" : "+v"(t)); return t; }
DEV int BID() { int t = blockIdx.x; asm volatile("" : "+s"(t)); return t; }
DEV u16 f2bf(float f) { unsigned u = __float_as_uint(f); u += 0x7fffu + ((u >> 16) & 1u); return (u16)(u >> 16); }
DEV float bf2f(u16 h) { return __uint_as_float(((unsigned)h) << 16); }
DEV unsigned pack2(float a, float b) { return (unsigned)f2bf(a) | ((unsigned)f2bf(b) << 16); }
DEV float bflo(unsigned u) { return __uint_as_float(u << 16); }
DEV float bfhi(unsigned u) { return __uint_as_float(u & 0xffff0000u); }
DEV float sigmoidf_(float x) { return 1.f / (1.f + __expf(-x)); }
DEV float wave_sum(float v) { for (int o = 32; o > 0; o >>= 1) v += __shfl_xor(v, o); return v; }
DEV f32x4 mfma16(bf16x8 a, bf16x8 b, f32x4 c) { return __builtin_amdgcn_mfma_f32_16x16x32_bf16(a, b, c, 0, 0, 0); }
template <int CTRL> DEV float dppf(float x) { return __int_as_float(__builtin_amdgcn_update_dpp(0, __float_as_int(x), CTRL, 0xF, 0xF, false)); }
template <int CTRL> DEV unsigned dppu(unsigned x) { return (unsigned)__builtin_amdgcn_update_dpp(0, (int)x, CTRL, 0xF, 0xF, false); }
DEV float reduce16(float x) { x += dppf<0xB1>(x); x += dppf<0x4E>(x); x += dppf<0x124>(x); x += dppf<0x128>(x); return x; }
DEV float quadsum(float x) { x += dppf<0xB1>(x); x += dppf<0x4E>(x); return x; }
DEV void lds_fence() { asm volatile("s_waitcnt lgkmcnt(0)" ::: "memory"); }
DEV bf16x8 ld8(const u16* p) { return *(const bf16x8*)p; }

DEV int block_next(unsigned* ctr, int* slot) {
    __syncthreads();
    if (TID() == 0) *slot = (int)atomicAdd(ctr, 1u);
    __syncthreads();
    return *slot;
}
DEV int wave_next(unsigned* ctr) {
    int v = 0;
    if ((TID() & 63) == 0) v = (int)atomicAdd(ctr, 1u);
    return __builtin_amdgcn_readfirstlane(v);
}

template <class Epi>
DEV void gemm_phase(const u16* __restrict__ A, int lda, const u16* __restrict__ Bt, int ldb, int mtiles, int ntiles, int K, Epi& epi,
                    unsigned char* lds, int bid, int nb) {
    const int tid = TID(), lane = tid & 63, wave = tid >> 6;
    const int wm = wave >> 1, wn = wave & 1, q4 = lane >> 4, cidx = lane & 15;
    u16* As = (u16*)lds;
    u16* Bs = (u16*)(lds + 32768);
    const int KT = K >> 6;
    const int total = mtiles * ntiles;
    const int srow = tid >> 3, sch = tid & 7;
    for (int tile = bid; tile < total; tile += nb) {
        const int mt = tile / ntiles, nt = tile - mt * ntiles;
        const int m0 = mt * 128, n0 = nt * 128;
        f32x4 acc[4][4];
#pragma unroll
        for (int i = 0; i < 4; ++i)
#pragma unroll
            for (int j = 0; j < 4; ++j) acc[i][j] = (f32x4){0.f, 0.f, 0.f, 0.f};
        const u16* Ag = A + (size_t)(m0 + srow) * lda + sch * 8;
        const u16* Bg = Bt + (size_t)(n0 + srow) * ldb + sch * 8;
        bf16x8 ra[4], rb[4];
#pragma unroll
        for (int i = 0; i < 4; ++i) { ra[i] = ld8(Ag + (size_t)(32 * i) * lda); rb[i] = ld8(Bg + (size_t)(32 * i) * ldb); }
#pragma unroll
        for (int i = 0; i < 4; ++i) {
            const int row = srow + 32 * i; const int off = row * 64 + ((sch ^ (row & 7)) << 3);
            *(bf16x8*)(As + off) = ra[i]; *(bf16x8*)(Bs + off) = rb[i];
        }
        __syncthreads();
        for (int kt = 0; kt < KT; ++kt) {
            const int buf = kt & 1;
            if (kt + 1 < KT) {
                const int k0 = (kt + 1) * 64;
#pragma unroll
                for (int i = 0; i < 4; ++i) { ra[i] = ld8(Ag + (size_t)(32 * i) * lda + k0); rb[i] = ld8(Bg + (size_t)(32 * i) * ldb + k0); }
            }
            const u16* Ab = As + buf * 8192;
            const u16* Bb = Bs + buf * 8192;
#pragma unroll
            for (int s = 0; s < 2; ++s) {
                bf16x8 a[4], b[4];
                const int ch = s * 4 + q4;
#pragma unroll
                for (int i = 0; i < 4; ++i) {
                    const int row = wm * 64 + i * 16 + cidx;
                    a[i] = *(const bf16x8*)(Ab + row * 64 + ((ch ^ (row & 7)) << 3));
                    const int rowb = wn * 64 + i * 16 + cidx;
                    b[i] = *(const bf16x8*)(Bb + rowb * 64 + ((ch ^ (rowb & 7)) << 3));
                }
#pragma unroll
                for (int i = 0; i < 4; ++i)
#pragma unroll
                    for (int j = 0; j < 4; ++j) acc[i][j] = mfma16(a[i], b[j], acc[i][j]);
            }
            if (kt + 1 < KT) {
                u16* Aw = As + (buf ^ 1) * 8192;
                u16* Bw = Bs + (buf ^ 1) * 8192;
#pragma unroll
                for (int i = 0; i < 4; ++i) {
                    const int row = srow + 32 * i; const int off = row * 64 + ((sch ^ (row & 7)) << 3);
                    *(bf16x8*)(Aw + off) = ra[i]; *(bf16x8*)(Bw + off) = rb[i];
                }
            }
            __syncthreads();
        }
#pragma unroll
        for (int i = 0; i < 4; ++i)
#pragma unroll
            for (int j = 0; j < 4; ++j) epi(m0 + wm * 64 + i * 16 + q4 * 4, n0 + wn * 64 + j * 16 + cidx, acc[i][j]);
        epi.finish(m0, n0, lds);
    }
}

struct EpiInProj {
    u16 *pconv, *prwkv, *q, *kv; float* gate;
    DEV void operator()(int row0, int col, f32x4 v) const {
        if (col < 512) {
#pragma unroll
            for (int r = 0; r < 4; ++r) pconv[(size_t)(row0 + r) * 512 + col] = f2bf(v[r]);
        } else if (col < 1536) {
#pragma unroll
            for (int r = 0; r < 4; ++r) prwkv[(size_t)(row0 + r) * 1024 + (col - 512)] = f2bf(v[r]);
        } else if (col < 2048) {
#pragma unroll
            for (int r = 0; r < 4; ++r) q[(size_t)(row0 + r) * 512 + (col - 1536)] = f2bf(v[r] * 0.125f);
        } else if (col < 2816) {
            const int c = col - 2048; const int idx = c >> 7; const int g = (c >> 6) & 1; const int d = c & 63;
            const int b = row0 >> 13; const int t0 = row0 & 8191; const int bg = b * 2 + g;
            u16* base = kv + (size_t)idx * 4194304;
            if (idx == 3 || idx == 5) {
                const int k = t0 & 31; const int p0 = 8 * ((k & 15) >> 2) + 4 * (k >> 4);
                u32x2 w; w[0] = pack2(v[0], v[1]); w[1] = pack2(v[2], v[3]);
                *(u32x2*)(base + (size_t)(bg * 64 + d) * 8192 + (t0 & ~31) + p0) = w;
            } else {
#pragma unroll
                for (int r = 0; r < 4; ++r) base[((size_t)bg * 8192 + t0 + r) * 64 + d] = f2bf(v[r]);
            }
        } else if (col < 2840) {
#pragma unroll
            for (int r = 0; r < 4; ++r) gate[(size_t)(row0 + r) * 24 + (col - 2816)] = sigmoidf_(v[r]);
        }
    }
    DEV void finish(int, int, unsigned char*) const {}
};

struct EpiOutProj {
    const float* xold; float* xnew; const float* g1;
    DEV void operator()(int row0, int col, f32x4 v) const {
        const int b = row0 >> 13; const float gg = g1[b * 6144 + col];
#pragma unroll
        for (int r = 0; r < 4; ++r) { const size_t o = (size_t)(row0 + r) * 1024 + col; xnew[o] = xold[o] + gg * v[r]; }
    }
    DEV void finish(int, int, unsigned char*) const {}
};

struct EpiStoreBf16 {
    u16* out; int ld;
    DEV void operator()(int row0, int col, f32x4 v) const {
#pragma unroll
        for (int r = 0; r < 4; ++r) out[(size_t)(row0 + r) * ld + col] = f2bf(v[r]);
    }
    DEV void finish(int, int, unsigned char*) const {}
};

struct EpiCompress {
    const float* cbp;
    const float* w2;
    u16* outp;
    int isv;
    unsigned char* lds;
    DEV void operator()(int row0, int col, f32x4 v) const {
        float* hid = (float*)lds;
        const int rl = row0 & 127;
#pragma unroll
        for (int r = 0; r < 4; ++r) hid[(rl + r) * 128 + col] = v[r];
    }
    DEV void finish(int m0, int, unsigned char*) const {
        __syncthreads();
        {
            float* hw = (float*)lds;
            const int t = TID(); const int c = t & 127, r0 = (t >> 7) * 64;
            float bias = 0.f;
#pragma unroll
            for (int s = 0; s < 16; ++s) bias += cbp[s * 128 + c];
#pragma unroll 4
            for (int r = 0; r < 64; ++r) { const float x = hw[(r0 + r) * 128 + c] + bias; hw[(r0 + r) * 128 + c] = x * sigmoidf_(x); }
        }
        __syncthreads();
        const float* hid = (const float*)lds;
        const int tid = TID(); const int d = tid & 63, rgp = tid >> 6;
        float acc[32];
#pragma unroll
        for (int i = 0; i < 32; ++i) acc[i] = 0.f;
#pragma unroll 1
        for (int j = 0; j < 128; ++j) {
            const float wv = w2[j * 64 + d];
#pragma unroll
            for (int rr = 0; rr < 32; ++rr) acc[rr] += hid[(rgp * 32 + rr) * 128 + j] * wv;
        }
#pragma unroll
        for (int rr = 0; rr < 32; ++rr) {
            const int m = m0 + rgp * 32 + rr; const int bg = m >> 9, n = m & 511;
            const u16 val = (n == 511) ? (u16)0 : f2bf(acc[rr]);
            if (!isv) outp[((size_t)bg * 512 + n) * 64 + d] = val;
            else {
                const int k = n & 31; const int pp = 8 * ((k & 15) >> 2) + (k & 3) + 4 * (k >> 4);
                outp[((size_t)bg * 64 + d) * 512 + (n & ~31) + pp] = val;
            }
        }
        __syncthreads();
    }
};

DEV void transpose_tile(const float* __restrict__ src, int N, u16* __restrict__ dst, int ldk, int kt, int nt, float* tl) {
    const int tid = TID(); const int k0 = kt * 64, n0 = nt * 64;
#pragma unroll 4
    for (int i = 0; i < 16; ++i) {
        const int idx = tid + 256 * i; const int kr = idx >> 6, nc = idx & 63; const int n = n0 + nc;
        tl[kr * 65 + nc] = (n < N) ? src[(size_t)(k0 + kr) * N + n] : 0.f;
    }
    __syncthreads();
#pragma unroll 4
    for (int i = 0; i < 16; ++i) {
        const int idx = tid + 256 * i; const int nr = idx >> 6, kc = idx & 63;
        dst[(size_t)(n0 + nr) * ldk + k0 + kc] = f2bf(tl[kc * 65 + nr]);
    }
    __syncthreads();
}

DEV void convert_straight(const float* __restrict__ src, u16* __restrict__ dst, size_t n) {
    const size_t stride = (size_t)gridDim.x * 256 * 8;
    for (size_t i = ((size_t)BID() * 256 + TID()) * 8; i < n; i += stride) {
        const float4 a = *(const float4*)(src + i); const float4 b = *(const float4*)(src + i + 4);
        u32x4 w; w[0] = pack2(a.x, a.y); w[1] = pack2(a.z, a.w); w[2] = pack2(b.x, b.y); w[3] = pack2(b.z, b.w);
        *(u32x4*)(dst + i) = w;
    }
}

DEV void phase_prep(const Params& p, unsigned char* lds) {
    const int tid = TID();
    float* fl = (float*)lds;
    unsigned char* ws = p.ws;
    for (int task = BID(); task < 192; task += gridDim.x) {
        const int l = task / 96, cgp = task % 96;
        float* cs = fl;
        float* red = fl + 4096;
        for (int i = tid; i < 4096; i += 256) { const float c = p.in[I_C][i]; cs[i] = c / (1.f + __expf(-c)); }
        __syncthreads();
        const int col = cgp * 64 + (tid & 63), ks = tid >> 6;
        float a0 = 0, a1 = 0, a2 = 0, a3 = 0;
        const float* w = p.in[I_ADAW] + ((size_t)l * 1024 + ks * 256) * 6144 + col;
#pragma unroll 8
        for (int k = 0; k < 256; ++k) {
            const float wv = w[(size_t)k * 6144]; const int kk = ks * 256 + k;
            a0 += cs[kk] * wv; a1 += cs[1024 + kk] * wv; a2 += cs[2048 + kk] * wv; a3 += cs[3072 + kk] * wv;
        }
        red[(ks * 4 + 0) * 64 + (tid & 63)] = a0; red[(ks * 4 + 1) * 64 + (tid & 63)] = a1;
        red[(ks * 4 + 2) * 64 + (tid & 63)] = a2; red[(ks * 4 + 3) * 64 + (tid & 63)] = a3;
        __syncthreads();
        {
            const int b = tid >> 6, c = tid & 63;
            const float s = red[(0 * 4 + b) * 64 + c] + red[(1 * 4 + b) * 64 + c] + red[(2 * 4 + b) * 64 + c] + red[(3 * 4 + b) * 64 + c];
            const int colg = cgp * 64 + c;
            ((float*)(ws + OFF_MOD))[(l * 4 + b) * 6144 + colg] = s + p.in[I_ADAB][l * 6144 + colg];
        }
        __syncthreads();
    }
    for (int task = BID(); task < 64; task += gridDim.x) {
        const int l = task >> 5, kv = (task >> 4) & 1, s = task & 15;
        const float* pos = p.in[kv ? I_CVPOS : I_CKPOS] + l * 2048;
        const float* w1 = p.in[kv ? I_CVW1 : I_CKW1] + (size_t)l * 2048 * 128;
        const int col = tid & 127, half = tid >> 7;
        float a = 0;
        const int i0 = s * 128 + half * 64;
#pragma unroll 8
        for (int i = 0; i < 64; ++i) a += pos[i0 + i] * w1[(size_t)(i0 + i) * 128 + col];
        fl[tid] = a;
        __syncthreads();
        if (tid < 128) ((float*)(ws + OFF_CBP))[((l * 2 + kv) * 16 + s) * 128 + tid] = fl[tid] + fl[tid + 128];
        __syncthreads();
    }
    {
        for (int task = BID(); task < 2 * 16 * 46; task += gridDim.x) {
            const int l = task / (16 * 46), r = task % (16 * 46);
            transpose_tile(p.in[I_WIN] + (size_t)l * 1024 * NIN, NIN, (u16*)(ws + OFF_WIN) + (size_t)l * NINP * 1024, 1024, r / 46, r % 46, fl);
        }
        for (int task = BID(); task < 2 * 16 * 16; task += gridDim.x) {
            const int l = task >> 8, r = task & 255;
            transpose_tile(p.in[I_WOUT] + (size_t)l * 1024 * 1024, 1024, (u16*)(ws + OFF_WOUT) + (size_t)l * 1024 * 1024, 1024, r >> 4, r & 15, fl);
        }
        for (int task = BID(); task < 2 * 16 * 32; task += gridDim.x) {
            const int l = task >> 9, r = task & 511;
            transpose_tile(p.in[I_PWQ] + (size_t)l * 1024 * 2048, 2048, (u16*)(ws + OFF_WQ) + (size_t)l * 2048 * 1024, 1024, r >> 5, r & 31, fl);
        }
        for (int task = BID(); task < 4 * 32 * 2; task += gridDim.x) {
            const int lk = task >> 6, r = task & 63; const int l = lk >> 1, kv = lk & 1;
            transpose_tile(p.in[kv ? I_CVW1 : I_CKW1] + (size_t)l * 2048 * 128, 128, (u16*)(ws + OFF_CW1) + (size_t)lk * 128 * 2048, 2048, r >> 1, r & 1, fl);
        }
    }
    for (int l = 0; l < 2; ++l) {
        convert_straight(p.in[I_PK1] + l * 16384, (u16*)(ws + OFF_K12) + (l * 2 + 0) * 16384, 16384);
        convert_straight(p.in[I_PK2] + l * 16384, (u16*)(ws + OFF_K12) + (l * 2 + 1) * 16384, 16384);
    }
    convert_straight(p.in[I_PU], (u16*)(ws + OFF_U), (size_t)16384 * 1024);
    convert_straight(p.in[I_PV], (u16*)(ws + OFF_V), (size_t)16384 * 1024);
}

DEV void phase_norm(const float* __restrict__ x, const float* __restrict__ g, const float* __restrict__ sh, const float* __restrict__ sc,
                    u16* __restrict__ h) {
    const int lane = TID() & 63;
    const int gw = BID() * 4 + (TID() >> 6), nw = gridDim.x * 4;
    for (int row = gw; row < NTOK; row += nw) {
        const int b = row >> 13;
        float4 v[4]; float ss = 0;
#pragma unroll
        for (int i = 0; i < 4; ++i) { v[i] = *(const float4*)(x + (size_t)row * 1024 + 256 * i + lane * 4); ss += v[i].x * v[i].x + v[i].y * v[i].y + v[i].z * v[i].z + v[i].w * v[i].w; }
        ss = wave_sum(ss);
        const float rs = rsqrtf(ss * (1.f / 1024.f) + 1e-6f);
#pragma unroll
        for (int i = 0; i < 4; ++i) {
            const int k = 256 * i + lane * 4;
            const float4 gg = *(const float4*)(g + k); const float4 s1 = *(const float4*)(sc + b * 6144 + k); const float4 s0 = *(const float4*)(sh + b * 6144 + k);
            u32x2 w;
            w[0] = pack2(v[i].x * rs * gg.x * (1.f + s1.x) + s0.x, v[i].y * rs * gg.y * (1.f + s1.y) + s0.y);
            w[1] = pack2(v[i].z * rs * gg.z * (1.f + s1.z) + s0.z, v[i].w * rs * gg.w * (1.f + s1.w) + s0.w);
            *(u32x2*)(h + (size_t)row * 1024 + k) = w;
        }
    }
}

DEV void phase_final_only(const float* __restrict__ x, const float* __restrict__ g, float* __restrict__ out) {
    const int lane = TID() & 63;
    const int gw = BID() * 4 + (TID() >> 6), nw = gridDim.x * 4;
    for (int row = gw; row < NTOK; row += nw) {
        float4 v[4]; float ss = 0;
#pragma unroll
        for (int i = 0; i < 4; ++i) { v[i] = *(const float4*)(x + (size_t)row * 1024 + 256 * i + lane * 4); ss += v[i].x * v[i].x + v[i].y * v[i].y + v[i].z * v[i].z + v[i].w * v[i].w; }
        ss = wave_sum(ss);
        const float rs = rsqrtf(ss * (1.f / 1024.f) + 1e-6f);
#pragma unroll
        for (int i = 0; i < 4; ++i) {
            const int k = 256 * i + lane * 4; const float4 gg = *(const float4*)(g + k);
            float4 o; o.x = v[i].x * rs * gg.x; o.y = v[i].y * rs * gg.y; o.z = v[i].z * rs * gg.z; o.w = v[i].w * rs * gg.w;
            *(float4*)(out + (size_t)row * 1024 + k) = o;
        }
    }
}


DEV void conv_tile(const Params& p, int l, int tile, unsigned char* lds) {
    float* ul = (float*)lds;
    const int tid = TID();
    unsigned char* ws = p.ws;
    const u16* pconv = (const u16*)(ws + OFF_PCONV);
    u16* mix = (u16*)(ws + OFF_MIX);
    const int t0g = tile * 32; const int tb = t0g & 8191;
    for (int rr = 0; rr < 62; ++rr) {
        const int trow = tb - 30 + rr;
        float u = 0.f;
        if (trow >= 0) {
            const size_t o = (size_t)(t0g - 30 + rr) * 512;
            const float val = bf2f(pconv[o + tid]), gt = bf2f(pconv[o + 256 + tid]);
            u = val * sigmoidf_(gt);
        }
        ul[rr * 256 + tid] = u;
    }
    __syncthreads();
    float w[31];
#pragma unroll
    for (int j = 0; j < 31; ++j) w[j] = p.in[I_CDW][(l * 31 + j) * 256 + tid];
    const float bias = p.in[I_CDB][l * 256 + tid], gg = p.in[I_CGG][l * 256 + tid], gb = p.in[I_CGB][l * 256 + tid];
    for (int tt = 0; tt < 32; ++tt) {
        float y = bias;
#pragma unroll
        for (int j = 0; j < 31; ++j) y += ul[(tt + j) * 256 + tid] * w[j];
        const float mean = wave_sum(y) * (1.f / 64.f);
        const float d = y - mean;
        const float var = wave_sum(d * d) * (1.f / 64.f);
        float o = d * rsqrtf(var + 1e-5f) * gg + gb;
        o = o * sigmoidf_(o);
        mix[(size_t)(t0g + tt) * 1024 + tid] = f2bf(o);
    }
}

DEV float softplusf_(float x) { return x > 20.f ? x : log1pf(__expf(x)); }
DEV void rwkv_prep_tile(const Params& p, int l, int tile, unsigned char* lds) {
    float* actT = (float*)lds;
    const int tid = TID(), lane = tid & 63;
    unsigned char* ws = p.ws;
    const u16* pr = (const u16*)(ws + OFF_PRWKV);
    const float* mu = p.in[I_MU] + l * 1024;
    const int R0 = tile * 16;
    {
        const int col = 768 + tid; const float muc = mu[col];
#pragma unroll 4
        for (int tk = 0; tk < 16; ++tk) {
            const int row = R0 + tk; const int t = row & 8191;
            const float cur = bf2f(pr[(size_t)row * 1024 + col]);
            const float prev = t > 0 ? bf2f(pr[(size_t)(row - 1) * 1024 + col]) : 0.f;
            const float x = cur + (prev - cur) * muc;
            float a;
            if (tid < 64) a = tanhf(x); else if (tid < 128) a = x; else a = sigmoidf_(x);
            actT[tid * 16 + tk] = a;
        }
    }
    __syncthreads();
    float accw[16], acca[16], accg[16];
#pragma unroll
    for (int i = 0; i < 16; ++i) { accw[i] = 0.f; acca[i] = 0.f; accg[i] = 0.f; }
    const float* wup = p.in[I_WUP] + (size_t)l * 64 * 256 + tid;
    const float* aup = p.in[I_AUP] + (size_t)l * 64 * 256 + tid;
    const float* gup = p.in[I_GUP] + (size_t)l * 128 * 256 + tid;
#pragma unroll 2
    for (int j = 0; j < 64; ++j) {
        const float ww = wup[j * 256], aa = aup[j * 256];
        const float4* x1 = (const float4*)(actT + j * 16);
        const float4* x2 = (const float4*)(actT + (64 + j) * 16);
#pragma unroll
        for (int q = 0; q < 4; ++q) {
            const float4 a = x1[q], b = x2[q];
            accw[4 * q + 0] += a.x * ww; accw[4 * q + 1] += a.y * ww; accw[4 * q + 2] += a.z * ww; accw[4 * q + 3] += a.w * ww;
            acca[4 * q + 0] += b.x * aa; acca[4 * q + 1] += b.y * aa; acca[4 * q + 2] += b.z * aa; acca[4 * q + 3] += b.w * aa;
        }
    }
#pragma unroll 2
    for (int j = 0; j < 128; ++j) {
        const float gg = gup[j * 256];
        const float4* x3 = (const float4*)(actT + (128 + j) * 16);
#pragma unroll
        for (int q = 0; q < 4; ++q) {
            const float4 a = x3[q];
            accg[4 * q + 0] += a.x * gg; accg[4 * q + 1] += a.y * gg; accg[4 * q + 2] += a.z * gg; accg[4 * q + 3] += a.w * gg;
        }
    }
    const float w0 = p.in[I_W0][l * 256 + tid], a0 = p.in[I_A0][l * 256 + tid], kkc = p.in[I_KK][l * 256 + tid], kac = p.in[I_KA][l * 256 + tid],
                rkc = p.in[I_RK][l * 256 + tid];
    const float mur = mu[tid], muk = mu[256 + tid], muv = mu[512 + tid];
    float* RW = (float*)(ws + OFF_RW);
    u16 *RR = (u16*)(ws + OFF_RR), *RK = (u16*)(ws + OFF_RK), *RV = (u16*)(ws + OFF_RV), *RKK = (u16*)(ws + OFF_RKK), *RKKA = (u16*)(ws + OFF_RKKA),
        *RG = (u16*)(ws + OFF_RG);
    float* BON = (float*)(ws + OFF_BONUS);
#pragma unroll
    for (int tk = 0; tk < 16; ++tk) {
        const int row = R0 + tk; const int t = row & 8191;
        const u16* cr = pr + (size_t)row * 1024; const u16* pv = cr - 1024;
        float r = bf2f(cr[tid]), k = bf2f(cr[256 + tid]), v = bf2f(cr[512 + tid]);
        const float rp = t > 0 ? bf2f(pv[tid]) : 0.f, kp = t > 0 ? bf2f(pv[256 + tid]) : 0.f, vp = t > 0 ? bf2f(pv[512 + tid]) : 0.f;
        r += (rp - r) * mur; k += (kp - k) * muk; v += (vp - v) * muv;
        const float wl = w0 + accw[tk];
        const float wlog = -softplusf_(-wl) - 0.5f;
        const float decay = __expf(-__expf(wlog));
        const float a = sigmoidf_(a0 + acca[tk]);
        float kk = k * kkc;
        const float nrm = sqrtf(wave_sum(kk * kk));
        kk = kk / fmaxf(nrm, 1e-12f);
        const float keff = k * (1.f + (a - 1.f) * kac);
        const float bon = wave_sum(r * keff * rkc);
        const size_t o = (size_t)row * 256 + tid;
        RW[o] = decay; RR[o] = f2bf(r); RK[o] = f2bf(keff); RV[o] = f2bf(v); RKK[o] = f2bf(kk); RKKA[o] = f2bf(kk * a); RG[o] = f2bf(accg[tk]);
        if (lane == 0) BON[(size_t)row * 4 + (tid >> 6)] = bon;
    }
}

DEV void rwkv_scan(const Params& p, int sb, unsigned char* lds) {
    unsigned char* ws = p.ws;
    const float* RW = (const float*)(ws + OFF_RW);
    const u16 *RR = (const u16*)(ws + OFF_RR), *RK = (const u16*)(ws + OFF_RK), *RV = (const u16*)(ws + OFF_RV), *RKK = (const u16*)(ws + OFF_RKK),
              *RKKA = (const u16*)(ws + OFF_RKKA);
    float* YR = (float*)(ws + OFF_YRAW);
    const int tid = TID(), lane = tid & 63, wave = tid >> 6;
    const int bh = sb >> 2, rg = sb & 3; const int b = bh >> 2, hh = bh & 3;
    float* L = (float*)lds;
    constexpr int BUFSZ = 5 * 1024 + 256;
    float* Yb = L + 2 * BUFSZ;
    const int row_local = 4 * wave + (lane >> 4); const int kq = (lane & 15) * 4;
    const int lstep = tid >> 4, lk = (tid & 15) * 4;
    const int vstep = tid >> 4, vrow = tid & 15;
    const size_t gbase = (size_t)b * 8192 * 256 + hh * 64;
    float4 lw; u32x2 lr, lkk, lkka, lk_; u16 lv;
    auto issue = [&](int c) {
        const size_t o = gbase + (size_t)(c * 16 + lstep) * 256 + lk;
        lw = *(const float4*)(RW + o);
        lr = *(const u32x2*)(RR + o); lk_ = *(const u32x2*)(RK + o); lkk = *(const u32x2*)(RKK + o); lkka = *(const u32x2*)(RKKA + o);
        lv = RV[gbase + (size_t)(c * 16 + vstep) * 256 + rg * 16 + vrow];
    };
    auto commit = [&](int buf) {
        float* B = L + buf * BUFSZ;
        const int o = lstep * 64 + lk;
        *(float4*)(B + o) = lw;
        *(float4*)(B + 1024 + o) = (float4){bflo(lkka[0]), bfhi(lkka[0]), bflo(lkka[1]), bfhi(lkka[1])};
        *(float4*)(B + 2048 + o) = (float4){bflo(lk_[0]), bfhi(lk_[0]), bflo(lk_[1]), bfhi(lk_[1])};
        *(float4*)(B + 3072 + o) = (float4){bflo(lr[0]), bfhi(lr[0]), bflo(lr[1]), bfhi(lr[1])};
        *(float4*)(B + 4096 + o) = (float4){bflo(lkk[0]), bfhi(lkk[0]), bflo(lkk[1]), bfhi(lkk[1])};
        B[5120 + vstep * 16 + vrow] = bf2f(lv);
    };
    __syncthreads();
    issue(0); commit(0);
    __syncthreads();
    float S0 = 0.f, S1 = 0.f, S2 = 0.f, S3 = 0.f;
    constexpr int NCH = NT / 16;
    for (int c = 0; c < NCH; ++c) {
        const int buf = c & 1;
        if (c + 1 < NCH) issue(c + 1);
        const float* B = L + buf * BUFSZ;
        float* Y = Yb + buf * 256;
#pragma unroll 4
        for (int st = 0; st < 16; ++st) {
            const float4 w4 = *(const float4*)(B + st * 64 + kq);
            const float4 a4 = *(const float4*)(B + 1024 + st * 64 + kq);
            const float4 k4 = *(const float4*)(B + 2048 + st * 64 + kq);
            const float4 r4 = *(const float4*)(B + 3072 + st * 64 + kq);
            const float4 n4 = *(const float4*)(B + 4096 + st * 64 + kq);
            const float vv = B[5120 + st * 16 + row_local];
            float part = S0 * n4.x + S1 * n4.y + S2 * n4.z + S3 * n4.w;
            const float sa = -reduce16(part);
            S0 = S0 * w4.x + vv * k4.x; S1 = S1 * w4.y + vv * k4.y; S2 = S2 * w4.z + vv * k4.z; S3 = S3 * w4.w + vv * k4.w;
            S0 += sa * a4.x; S1 += sa * a4.y; S2 += sa * a4.z; S3 += sa * a4.w;
            const float yp = S0 * r4.x + S1 * r4.y + S2 * r4.z + S3 * r4.w;
            const float y = reduce16(yp);
            if ((lane & 15) == 0) Y[st * 16 + row_local] = y;
        }
        if (c + 1 < NCH) commit(buf ^ 1);
        __syncthreads();
        YR[gbase + (size_t)(c * 16 + vstep) * 256 + rg * 16 + vrow] = Y[vstep * 16 + vrow];
    }
}

DEV void phase_rwkv_post(const Params& p, int l) {
    unsigned char* ws = p.ws;
    const float* YR = (const float*)(ws + OFF_YRAW); const float* BON = (const float*)(ws + OFF_BONUS);
    const u16 *RV = (const u16*)(ws + OFF_RV), *RG = (const u16*)(ws + OFF_RG);
    u16* mix = (u16*)(ws + OFF_MIX);
    const int tid = TID();
    const float lg = p.in[I_LNG][l * 256 + tid], lb = p.in[I_LNB][l * 256 + tid];
    for (int row = BID(); row < NTOK; row += gridDim.x) {
        const size_t o = (size_t)row * 256 + tid;
        const float y = YR[o];
        const float mean = wave_sum(y) * (1.f / 64.f);
        const float d = y - mean;
        const float var = wave_sum(d * d) * (1.f / 64.f);
        const float yn = d * rsqrtf(var + 64e-5f) * lg + lb;
        const float outv = (yn + BON[(size_t)row * 4 + (tid >> 6)] * bf2f(RV[o])) * bf2f(RG[o]);
        mix[(size_t)row * 1024 + 256 + tid] = f2bf(outv);
    }
}

DEV void zero_mix_cols(const Params& p, int c0, int ncols) {
    u16* mix = (u16*)(p.ws + OFF_MIX);
    const int per = ncols / 8;
    const size_t total = (size_t)NTOK * per;
    for (size_t i = (size_t)BID() * 256 + TID(); i < total; i += (size_t)gridDim.x * 256) {
        const size_t row = i / per; const int cc = (int)(i % per);
        *(u32x4*)(mix + row * 1024 + c0 + cc * 8) = (u32x4){0u, 0u, 0u, 0u};
    }
}


DEV void attend_block(const u16* __restrict__ Kb, const u16* __restrict__ VTb, int keybase, int tcol, int lowcol, bf16x8 q0, bf16x8 q1,
                      float& m, float& l, f32x4 (&O)[4], int q4, int cidx) {
    f32x4 st[4];
#pragma unroll
    for (int kt = 0; kt < 4; ++kt) {
        const u16* kp = Kb + (kt * 16 + cidx) * 64 + 8 * q4;
        const bf16x8 a0 = ld8(kp), a1 = ld8(kp + 32);
        st[kt] = mfma16(a0, q0, (f32x4){0.f, 0.f, 0.f, 0.f});
        st[kt] = mfma16(a1, q1, st[kt]);
    }
    float lmax = -1e30f;
#pragma unroll
    for (int kt = 0; kt < 4; ++kt)
#pragma unroll
        for (int r = 0; r < 4; ++r) {
            const int key = keybase + kt * 16 + 4 * q4 + r;
            const bool valid = (key <= tcol) && (key > lowcol);
            const float s = valid ? st[kt][r] : -1e30f;
            st[kt][r] = s; lmax = fmaxf(lmax, s);
        }
    lmax = fmaxf(lmax, __shfl_xor(lmax, 16));
    lmax = fmaxf(lmax, __shfl_xor(lmax, 32));
    const float mnew = fmaxf(m, lmax);
    const float alpha = __expf(m - mnew);
    float psum = 0.f;
#pragma unroll
    for (int kt = 0; kt < 4; ++kt)
#pragma unroll
        for (int r = 0; r < 4; ++r) {
            const float pv = (st[kt][r] > -1e29f) ? __expf(st[kt][r] - mnew) : 0.f;
            st[kt][r] = pv; psum += pv;
        }
    l = l * alpha + psum; m = mnew;
#pragma unroll
    for (int mt = 0; mt < 4; ++mt) { O[mt][0] *= alpha; O[mt][1] *= alpha; O[mt][2] *= alpha; O[mt][3] *= alpha; }
#pragma unroll
    for (int kb = 0; kb < 2; ++kb) {
        union { bf16x8 v; unsigned u[4]; } pb;
        pb.u[0] = pack2(st[2 * kb][0], st[2 * kb][1]); pb.u[1] = pack2(st[2 * kb][2], st[2 * kb][3]);
        pb.u[2] = pack2(st[2 * kb + 1][0], st[2 * kb + 1][1]); pb.u[3] = pack2(st[2 * kb + 1][2], st[2 * kb + 1][3]);
#pragma unroll
        for (int mt = 0; mt < 4; ++mt) {
            const bf16x8 av = ld8(VTb + (size_t)(16 * mt + cidx) * 8192 + kb * 32 + 8 * q4);
            O[mt] = mfma16(av, pb.v, O[mt]);
        }
    }
}

DEV void nsa_task(const Params& p, int task, float* impA, float* impB) {
    unsigned char* ws = p.ws;
    const u16* Q = (const u16*)(ws + OFF_Q);
    const u16* KVb = (const u16*)(ws + OFF_KV);
    const u16 *KSEL = KVb + (size_t)2 * 4194304, *VSELT = KVb + (size_t)3 * 4194304, *KWIN = KVb + (size_t)4 * 4194304, *VWINT = KVb + (size_t)5 * 4194304;
    const u16* KC = (const u16*)(ws + OFF_KC); const u16* VCT = (const u16*)(ws + OFF_VCT);
    const float* GATE = (const float*)(ws + OFF_GATE);
    u16* mix = (u16*)(ws + OFF_MIX);
    const int lane = TID() & 63, q4 = lane >> 4, cidx = lane & 15;
    const int bg = task >> 11, t0 = (task & 2047) * 4; const int b = bg >> 1, g = bg & 1;
    const int tokl = cidx >> 2, hr = cidx & 3; const int tcol = t0 + tokl;
    const int rowc = b * 8192 + tcol; const int head = g * 4 + hr;
    const int cur = t0 >> 6;
    const bf16x8 qf0 = ld8(Q + (size_t)rowc * 512 + head * 64 + 8 * q4), qf1 = ld8(Q + (size_t)rowc * 512 + head * 64 + 32 + 8 * q4);
    f32x4 outacc[4];
#pragma unroll
    for (int mt = 0; mt < 4; ++mt) outacc[mt] = (f32x4){0.f, 0.f, 0.f, 0.f};
    const float gc = GATE[(size_t)rowc * 24 + head], gs = GATE[(size_t)rowc * 24 + 8 + head], gwn = GATE[(size_t)rowc * 24 + 16 + head];

#if EN_NSA_CMP
    {
        const int cnt_col = tcol >= 31 ? ((tcol - 31) >> 4) + 1 : 0;
        const int tmax = t0 + 3; const int cmax = tmax >= 31 ? ((tmax - 31) >> 4) + 1 : 0;
        const int ntile = (cmax + 15) >> 4;
        const u16* kcb = KC + (size_t)bg * 512 * 64;
        float ml = -1e30f, ll = 0.f;
#pragma unroll 1
        for (int kt = 0; kt < ntile; ++kt) {
            const u16* kp = kcb + (kt * 16 + cidx) * 64 + 8 * q4;
            f32x4 st = mfma16(ld8(kp), qf0, (f32x4){0.f, 0.f, 0.f, 0.f});
            st = mfma16(ld8(kp + 32), qf1, st);
            float s[4]; float tm = -1e30f;
#pragma unroll
            for (int r = 0; r < 4; ++r) { const int n = kt * 16 + 4 * q4 + r; s[r] = (n < cnt_col) ? st[r] : -1e30f; tm = fmaxf(tm, s[r]); }
            const float mn = fmaxf(ml, tm);
            float ps = 0.f;
#pragma unroll
            for (int r = 0; r < 4; ++r) ps += (s[r] > -1e29f) ? __expf(s[r] - mn) : 0.f;
            ll = ll * __expf(ml - mn) + ps; ml = mn;
        }
        float m = fmaxf(ml, __shfl_xor(ml, 16)); m = fmaxf(m, __shfl_xor(m, 32));
        float lsum = ll * __expf(ml - m);
        lsum += __shfl_xor(lsum, 16); lsum += __shfl_xor(lsum, 32);
        const float inv = (cnt_col > 0) ? 1.f / lsum : 0.f;
        f32x4 Oc[4];
#pragma unroll
        for (int mt = 0; mt < 4; ++mt) Oc[mt] = (f32x4){0.f, 0.f, 0.f, 0.f};
        const int npair = (ntile + 1) >> 1;
#pragma unroll 1
        for (int kp2 = 0; kp2 < npair; ++kp2) {
            const int n0 = kp2 * 32;
            float pa[4], pb_[4];
            {
                const u16* kp = kcb + (n0 + cidx) * 64 + 8 * q4;
                f32x4 st = mfma16(ld8(kp), qf0, (f32x4){0.f, 0.f, 0.f, 0.f});
                st = mfma16(ld8(kp + 32), qf1, st);
#pragma unroll
                for (int r = 0; r < 4; ++r) { const int n = n0 + 4 * q4 + r; pa[r] = (n < cnt_col) ? __expf(st[r] - m) * inv : 0.f; }
                const u16* kpb = kp + 16 * 64;
                f32x4 su = mfma16(ld8(kpb), qf0, (f32x4){0.f, 0.f, 0.f, 0.f});
                su = mfma16(ld8(kpb + 32), qf1, su);
#pragma unroll
                for (int r = 0; r < 4; ++r) { const int n = n0 + 16 + 4 * q4 + r; pb_[r] = (n < cnt_col) ? __expf(su[r] - m) * inv : 0.f; }
            }
            {
                const float owna = quadsum(pa[0] + pa[1] + pa[2] + pa[3]), tha = quadsum(pa[3]);
                const float ownb = quadsum(pb_[0] + pb_[1] + pb_[2] + pb_[3]), thb = quadsum(pb_[3]);
                if (hr == 0) {
                    const int sa = (n0 >> 2) + q4, sb2 = ((n0 + 16) >> 2) + q4;
                    impA[tokl * 128 + sa] = owna; impB[tokl * 132 + sa + 1] = tha;
                    impA[tokl * 128 + sb2] = ownb; impB[tokl * 132 + sb2 + 1] = thb;
                }
            }
            union { bf16x8 v; unsigned u[4]; } pk;
            pk.u[0] = pack2(pa[0], pa[1]); pk.u[1] = pack2(pa[2], pa[3]); pk.u[2] = pack2(pb_[0], pb_[1]); pk.u[3] = pack2(pb_[2], pb_[3]);
#pragma unroll
            for (int mt = 0; mt < 4; ++mt) {
                const bf16x8 av = ld8(VCT + ((size_t)bg * 64 + 16 * mt + cidx) * 512 + n0 + 8 * q4);
                Oc[mt] = mfma16(av, pk.v, Oc[mt]);
            }
        }
#pragma unroll
        for (int mt = 0; mt < 4; ++mt)
#pragma unroll
            for (int r = 0; r < 4; ++r) outacc[mt][r] += gc * Oc[mt][r];
    }
#endif

#if EN_NSA_WIN
    {
        float m = -1e30f, l = 0.f; f32x4 Ow[4];
#pragma unroll
        for (int mt = 0; mt < 4; ++mt) Ow[mt] = (f32x4){0.f, 0.f, 0.f, 0.f};
        int wb0 = (t0 - 511) >> 6; if (wb0 < 0) wb0 = 0;
#pragma unroll 1
        for (int blk = wb0; blk <= cur; ++blk)
            attend_block(KWIN + ((size_t)bg * 8192 + blk * 64) * 64, VWINT + (size_t)bg * 64 * 8192 + blk * 64, blk * 64, tcol, tcol - 512, qf0, qf1, m, l, Ow, q4, cidx);
        l += __shfl_xor(l, 16); l += __shfl_xor(l, 32);
        const float sc = gwn / l;
#pragma unroll
        for (int mt = 0; mt < 4; ++mt)
#pragma unroll
            for (int r = 0; r < 4; ++r) outacc[mt][r] += sc * Ow[mt][r];
    }
#endif

#if EN_NSA_SEL
    {
        lds_fence();
        int mysel;
        if (cur < 16) mysel = (cidx <= cur) ? cidx : -1;
        else {
            unsigned key[8];
#pragma unroll
            for (int i = 0; i < 8; ++i) {
                const int s = cidx + 16 * i;
                const bool cand = (s >= 1) && (s <= cur - 2);
                const float v = impA[q4 * 128 + s] + impB[q4 * 132 + s];
                key[i] = cand ? ((__float_as_uint(v) & ~0x7Fu) | (unsigned)(127 - s)) : 0u;
            }
            mysel = (cidx == 0) ? 0 : (cidx == 1 ? cur - 1 : (cidx == 2 ? cur : -1));
#pragma unroll 1
            for (int it = 0; it < 13; ++it) {
                unsigned mx = key[0];
#pragma unroll
                for (int i = 1; i < 8; ++i) mx = max(mx, key[i]);
                mx = max(mx, dppu<0xB1>(mx)); mx = max(mx, dppu<0x4E>(mx)); mx = max(mx, dppu<0x124>(mx)); mx = max(mx, dppu<0x128>(mx));
                const int s = 127 - (int)(mx & 127u);
#pragma unroll
                for (int i = 0; i < 8; ++i) key[i] = (key[i] == mx) ? 0u : key[i];
                if (cidx == it + 3) mysel = s;
            }
        }
        lds_fence();
#pragma unroll 1
        for (int tk = 0; tk < 4; ++tk) {
            const int tq = t0 + tk; const int rowq = b * 8192 + tq;
            const bf16x8 qs0 = ld8(Q + (size_t)rowq * 512 + head * 64 + 8 * q4), qs1 = ld8(Q + (size_t)rowq * 512 + head * 64 + 32 + 8 * q4);
            float m = -1e30f, l = 0.f; f32x4 Os[4];
#pragma unroll
            for (int mt = 0; mt < 4; ++mt) Os[mt] = (f32x4){0.f, 0.f, 0.f, 0.f};
#pragma unroll 1
            for (int i = 0; i < 16; ++i) {
                const int blk = __builtin_amdgcn_readlane(mysel, tk * 16 + i);
                if (blk < 0) continue;
                attend_block(KSEL + ((size_t)bg * 8192 + blk * 64) * 64, VSELT + (size_t)bg * 64 * 8192 + blk * 64, blk * 64, tq, -1, qs0, qs1, m, l, Os, q4, cidx);
            }
            l += __shfl_xor(l, 16); l += __shfl_xor(l, 32);
            const float sc = (tokl == tk) ? gs / l : 0.f;
#pragma unroll
            for (int mt = 0; mt < 4; ++mt)
#pragma unroll
                for (int r = 0; r < 4; ++r) outacc[mt][r] += sc * Os[mt][r];
        }
    }
#endif
#pragma unroll
    for (int mt = 0; mt < 4; ++mt) {
        u32x2 w; w[0] = pack2(outacc[mt][0], outacc[mt][1]); w[1] = pack2(outacc[mt][2], outacc[mt][3]);
        *(u32x2*)(mix + (size_t)rowc * 1024 + 512 + head * 64 + 16 * mt + 4 * q4) = w;
    }
}


DEV unsigned sortable(float f) { const unsigned b = __float_as_uint(f); return (b & 0x80000000u) ? ~b : (b | 0x80000000u); }
DEV float unsortable(unsigned u) { return __uint_as_float((u & 0x80000000u) ? (u ^ 0x80000000u) : ~u); }
template <int N> DEV unsigned kth16_threshold(const unsigned (&u)[N]) {
    unsigned T = 0;
    for (int bit = 31; bit >= 0; --bit) {
        const unsigned cand = T | (1u << bit);
        int cnt = 0;
#pragma unroll
        for (int i = 0; i < N; ++i) cnt += (u[i] >= cand) ? 1 : 0;
        cnt += __shfl_xor(cnt, 16); cnt += __shfl_xor(cnt, 32);
        if (cnt >= 16) T = cand;
    }
    return T;
}
template <int N, class F> DEV void compact16(const unsigned (&u)[N], unsigned T, int q4, int cidx, F emit) {
    int cgt = 0, ceq = 0;
#pragma unroll
    for (int i = 0; i < N; ++i) { cgt += (u[i] > T) ? 1 : 0; ceq += (u[i] == T) ? 1 : 0; }
    const int g0 = __shfl(cgt, cidx), g1 = __shfl(cgt, cidx + 16), g2 = __shfl(cgt, cidx + 32), g3 = __shfl(cgt, cidx + 48);
    const int e0 = __shfl(ceq, cidx), e1 = __shfl(ceq, cidx + 16), e2 = __shfl(ceq, cidx + 32);
    int pg = (q4 > 0 ? g0 : 0) + (q4 > 1 ? g1 : 0) + (q4 > 2 ? g2 : 0);
    int pe = g0 + g1 + g2 + g3 + (q4 > 0 ? e0 : 0) + (q4 > 1 ? e1 : 0) + (q4 > 2 ? e2 : 0);
#pragma unroll
    for (int i = 0; i < N; ++i) {
        if (u[i] > T) { emit(i, pg); ++pg; }
        else if (u[i] == T) { if (pe < 16) emit(i, pe); ++pe; }
    }
}

DEV void peer_topk_task(const Params& p, int l, int task, float* wl) {
    unsigned char* ws = p.ws;
    const u16* QP = (const u16*)(ws + OFF_QP);
    const u16* K12 = (const u16*)(ws + OFF_K12) + (size_t)l * 2 * 16384;
    int* PIDX = (int*)(ws + OFF_PIDX); float* PGW = (float*)(ws + OFF_PGW);
    const int lane = TID() & 63, q4 = lane >> 4, cidx = lane & 15;
    const int tq = task * 2 + (cidx >> 3), hh = cidx & 7;
    float* vv[2] = {wl, wl + 512}; int* ii[2] = {(int*)(wl + 256), (int*)(wl + 768)};
    float* fs = wl + 1024; int* fi = (int*)(wl + 1280);
#pragma unroll
    for (int hf = 0; hf < 2; ++hf) {
        bf16x8 qf[4];
#pragma unroll
        for (int s = 0; s < 4; ++s) qf[s] = ld8(QP + (size_t)tq * 2048 + hh * 256 + hf * 128 + 32 * s + 8 * q4);
        unsigned u[32];
        const u16* kb = K12 + hf * 16384;
#pragma unroll
        for (int kt = 0; kt < 8; ++kt) {
            f32x4 st = (f32x4){0.f, 0.f, 0.f, 0.f};
#pragma unroll
            for (int s = 0; s < 4; ++s) st = mfma16(ld8(kb + (kt * 16 + cidx) * 128 + 32 * s + 8 * q4), qf[s], st);
#pragma unroll
            for (int r = 0; r < 4; ++r) u[kt * 4 + r] = sortable(st[r]);
        }
        const unsigned T = kth16_threshold<32>(u);
        float* vo = vv[hf]; int* io = ii[hf];
        compact16<32>(u, T, q4, cidx, [&](int i, int pos) { vo[cidx * 16 + pos] = unsortable(u[i]); io[cidx * 16 + pos] = 16 * (i >> 2) + 4 * q4 + (i & 3); });
    }
    lds_fence();
    {
        unsigned u[64];
        float v2r[16];
#pragma unroll
        for (int j = 0; j < 16; ++j) v2r[j] = vv[1][cidx * 16 + j];
#pragma unroll
        for (int a = 0; a < 4; ++a) {
            const float v1a = vv[0][cidx * 16 + 4 * q4 + a];
#pragma unroll
            for (int j = 0; j < 16; ++j) u[a * 16 + j] = sortable(v1a + v2r[j]);
        }
        const unsigned T = kth16_threshold<64>(u);
        compact16<64>(u, T, q4, cidx, [&](int i, int pos) { fs[cidx * 16 + pos] = unsortable(u[i]); fi[cidx * 16 + pos] = (4 * q4 + (i >> 4)) * 16 + (i & 15); });
    }
    lds_fence();
    {
        float s4[4]; int c4[4];
#pragma unroll
        for (int k = 0; k < 4; ++k) { s4[k] = fs[cidx * 16 + 4 * q4 + k]; c4[k] = fi[cidx * 16 + 4 * q4 + k]; }
        float mx = fmaxf(fmaxf(s4[0], s4[1]), fmaxf(s4[2], s4[3]));
        mx = fmaxf(mx, __shfl_xor(mx, 16)); mx = fmaxf(mx, __shfl_xor(mx, 32));
        float e4[4]; float sm = 0.f;
#pragma unroll
        for (int k = 0; k < 4; ++k) { e4[k] = __expf(s4[k] - mx); sm += e4[k]; }
        sm += __shfl_xor(sm, 16); sm += __shfl_xor(sm, 32);
        const float inv = 1.f / sm;
        int4 eo; float4 go;
        eo.x = ii[0][cidx * 16 + (c4[0] >> 4)] * 128 + ii[1][cidx * 16 + (c4[0] & 15)];
        eo.y = ii[0][cidx * 16 + (c4[1] >> 4)] * 128 + ii[1][cidx * 16 + (c4[1] & 15)];
        eo.z = ii[0][cidx * 16 + (c4[2] >> 4)] * 128 + ii[1][cidx * 16 + (c4[2] & 15)];
        eo.w = ii[0][cidx * 16 + (c4[3] >> 4)] * 128 + ii[1][cidx * 16 + (c4[3] & 15)];
        go.x = e4[0] * inv; go.y = e4[1] * inv; go.z = e4[2] * inv; go.w = e4[3] * inv;
        const size_t o = ((size_t)tq * 8 + hh) * 16 + 4 * q4;
        *(int4*)(PIDX + o) = eo; *(float4*)(PGW + o) = go;
    }
    lds_fence();
}

DEV float gelu_exact(float x) { return 0.5f * x * (1.f + erff(x * 0.70710678118654752f)); }
DEV void unpack8(const bf16x8 v, float (&f)[8]) {
    union { bf16x8 v; unsigned u[4]; } c; c.v = v;
#pragma unroll
    for (int i = 0; i < 4; ++i) { f[2 * i] = bflo(c.u[i]); f[2 * i + 1] = bfhi(c.u[i]); }
}
DEV void phase_peer_experts(const Params& p, int l) {
    unsigned char* ws = p.ws;
    const u16* H = (const u16*)(ws + OFF_H);
    u16* Hw = (u16*)(ws + OFF_H);
    const u16 *U = (const u16*)(ws + OFF_U), *V = (const u16*)(ws + OFF_V);
    const int* PIDX = (const int*)(ws + OFF_PIDX); const float* PGW = (const float*)(ws + OFF_PGW);
    const float* mod = (const float*)(ws + OFF_MOD);
    const float* g2 = mod + l * 4 * 6144 + 5 * 1024;
    const int lane = TID() & 63;
    const int gw = BID() * 4 + (TID() >> 6), nw = gridDim.x * 4;
    for (int tok = gw; tok < NTOK; tok += nw) {
        const int b = tok >> 13;
        float acc[16];
#pragma unroll
        for (int i = 0; i < 16; ++i) acc[i] = 0.f;
#if EN_PEER
        float hx[16];
        {
            float t8[8];
            unpack8(ld8(H + (size_t)tok * 1024 + 8 * lane), t8);
#pragma unroll
            for (int i = 0; i < 8; ++i) hx[i] = t8[i];
            unpack8(ld8(H + (size_t)tok * 1024 + 512 + 8 * lane), t8);
#pragma unroll
            for (int i = 0; i < 8; ++i) hx[8 + i] = t8[i];
        }
#pragma unroll 1
        for (int hh = 0; hh < 8; ++hh) {
            const int el = PIDX[((size_t)tok * 8 + hh) * 16 + (lane & 15)];
            const float wgt = PGW[((size_t)tok * 8 + hh) * 16 + (lane & 15)];
#pragma unroll 1
            for (int k0 = 0; k0 < 16; k0 += 4) {
                bf16x8 ur[4][2], vr[4][2]; float wk[4];
#pragma unroll
                for (int k = 0; k < 4; ++k) {
                    const int e = __builtin_amdgcn_readlane(el, k0 + k);
                    wk[k] = __int_as_float(__builtin_amdgcn_readlane(__float_as_int(wgt), k0 + k));
                    ur[k][0] = ld8(U + (size_t)e * 1024 + 8 * lane); ur[k][1] = ld8(U + (size_t)e * 1024 + 512 + 8 * lane);
                    vr[k][0] = ld8(V + (size_t)e * 1024 + 8 * lane); vr[k][1] = ld8(V + (size_t)e * 1024 + 512 + 8 * lane);
                }
#pragma unroll
                for (int k = 0; k < 4; ++k) {
                    float f0[8], f1[8];
                    unpack8(ur[k][0], f0); unpack8(ur[k][1], f1);
                    float d = 0.f;
#pragma unroll
                    for (int i = 0; i < 8; ++i) d += f0[i] * hx[i] + f1[i] * hx[8 + i];
                    d = wave_sum(d);
                    const float act = gelu_exact(d) * wk[k];
                    unpack8(vr[k][0], f0); unpack8(vr[k][1], f1);
#pragma unroll
                    for (int i = 0; i < 8; ++i) { acc[i] += act * f0[i]; acc[8 + i] += act * f1[i]; }
                }
            }
        }
#endif
        float xn[16]; float ss = 0.f;
#pragma unroll
        for (int hseg = 0; hseg < 2; ++hseg) {
            const int k = hseg * 512 + 8 * lane;
            const float4 x0 = *(const float4*)(p.out + (size_t)tok * 1024 + k), x1 = *(const float4*)(p.out + (size_t)tok * 1024 + k + 4);
            const float4 ga = *(const float4*)(g2 + b * 6144 + k), gb = *(const float4*)(g2 + b * 6144 + k + 4);
            float* a = acc + hseg * 8; float* o = xn + hseg * 8;
            o[0] = x0.x + ga.x * a[0]; o[1] = x0.y + ga.y * a[1]; o[2] = x0.z + ga.z * a[2]; o[3] = x0.w + ga.w * a[3];
            o[4] = x1.x + gb.x * a[4]; o[5] = x1.y + gb.y * a[5]; o[6] = x1.z + gb.z * a[6]; o[7] = x1.w + gb.w * a[7];
#pragma unroll
            for (int i = 0; i < 8; ++i) ss += o[i] * o[i];
        }
        ss = wave_sum(ss);
        const float rs = rsqrtf(ss * (1.f / 1024.f) + 1e-6f);
        if (l == 0) {
            const float* n1g = p.in[I_N1G] + 1024; const float* sh = mod + 4 * 6144 + b * 6144; const float* sc = sh + 1024;
#pragma unroll
            for (int hseg = 0; hseg < 2; ++hseg) {
                const int k = hseg * 512 + 8 * lane; float* o = xn + hseg * 8;
                *(float4*)(p.out + (size_t)tok * 1024 + k) = (float4){o[0], o[1], o[2], o[3]};
                *(float4*)(p.out + (size_t)tok * 1024 + k + 4) = (float4){o[4], o[5], o[6], o[7]};
                float hv[8];
#pragma unroll
                for (int i = 0; i < 8; ++i) hv[i] = o[i] * rs * n1g[k + i] * (1.f + sc[k + i]) + sh[k + i];
                u32x4 w; w[0] = pack2(hv[0], hv[1]); w[1] = pack2(hv[2], hv[3]); w[2] = pack2(hv[4], hv[5]); w[3] = pack2(hv[6], hv[7]);
                *(u32x4*)(Hw + (size_t)tok * 1024 + k) = w;
            }
        } else {
            const float* fg = p.in[I_FG];
#pragma unroll
            for (int hseg = 0; hseg < 2; ++hseg) {
                const int k = hseg * 512 + 8 * lane; float* o = xn + hseg * 8;
                *(float4*)(p.out + (size_t)tok * 1024 + k) = (float4){o[0] * rs * fg[k], o[1] * rs * fg[k + 1], o[2] * rs * fg[k + 2], o[3] * rs * fg[k + 3]};
                *(float4*)(p.out + (size_t)tok * 1024 + k + 4) = (float4){o[4] * rs * fg[k + 4], o[5] * rs * fg[k + 5], o[6] * rs * fg[k + 6], o[7] * rs * fg[k + 7]};
            }
        }
    }
}

constexpr int NPH = 20;

__global__ void __launch_bounds__(256, 2) mega(Params p) {
    __shared__ __attribute__((aligned(16))) unsigned char lds[65536];
    __shared__ int qslot[4];
    cg::grid_group grid = cg::this_grid();
    unsigned char* ws = p.ws;
    const float* mod = (const float*)(ws + OFF_MOD);
    unsigned* ctl = (unsigned*)(ws + OFF_CTL);
    const int G = gridDim.x, bx = BID();
    for (int ph = p.ph_lo; ph < p.ph_hi; ++ph) {
        if (ph == 0) {
            phase_prep(p, lds);
        } else if (ph == 1) {
            phase_norm(p.in[I_X], p.in[I_N1G], mod + 0 * 1024, mod + 1 * 1024, (u16*)(ws + OFF_H));
        } else {
            const int l = (ph - 2) / 9, sp = (ph - 2) % 9;
            const float* modl = mod + l * 4 * 6144;
            if (sp == 0) {
                EpiInProj e{(u16*)(ws + OFF_PCONV), (u16*)(ws + OFF_PRWKV), (u16*)(ws + OFF_Q), (u16*)(ws + OFF_KV), (float*)(ws + OFF_GATE)};
                gemm_phase((const u16*)(ws + OFF_H), 1024, (const u16*)(ws + OFF_WIN) + (size_t)l * NINP * 1024, 1024, 256, 23, 1024, e, lds, bx, G);
            } else if (sp == 1) {
#if EN_NSA_CMP || EN_NSA_SEL
                {
                    const u16* KVb = (const u16*)(ws + OFF_KV);
                    EpiCompress ek{(const float*)(ws + OFF_CBP) + (l * 2 + 0) * 2048, p.in[I_CKW2] + (size_t)l * 8192, (u16*)(ws + OFF_KC), 0, lds};
                    gemm_phase(KVb, 1024, (const u16*)(ws + OFF_CW1) + (size_t)(l * 2 + 0) * 128 * 2048, 2048, 32, 1, 2048, ek, lds, bx, G);
                    EpiCompress ev{(const float*)(ws + OFF_CBP) + (l * 2 + 1) * 2048, p.in[I_CVW2] + (size_t)l * 8192, (u16*)(ws + OFF_VCT), 1, lds};
                    gemm_phase(KVb + 4194304, 1024, (const u16*)(ws + OFF_CW1) + (size_t)(l * 2 + 1) * 128 * 2048, 2048, 32, 1, 2048, ev, lds, (bx + G - 32) % G, G);
                }
#endif
#if EN_CONV
                for (;;) { const int t = block_next(ctl + QW(l, Q_CONV), qslot); if (t >= NTOK / 32) break; conv_tile(p, l, t, lds); }
#else
                zero_mix_cols(p, 0, 256);
#endif
#if EN_RWKV
                for (;;) { const int t = block_next(ctl + QW(l, Q_RWP), qslot); if (t >= NTOK / 16) break; rwkv_prep_tile(p, l, t, lds); }
#endif
            } else if (sp == 2) {
#if EN_RWKV
                if (bx < 64) { __builtin_amdgcn_s_setprio(3); rwkv_scan(p, bx, lds); __builtin_amdgcn_s_setprio(0); }
#endif
#if EN_NSA_CMP || EN_NSA_WIN || EN_NSA_SEL
                {
                    const int wave = TID() >> 6;
                    float* impA = (float*)lds + 32768 / 4 + wave * 1040 * 2;
                    float* impB = impA + 512;
                    for (;;) { const int t = wave_next(ctl + QW(l, Q_NSA)); if (t >= 16384) break; nsa_task(p, t, impA, impB); }
                }
#else
                zero_mix_cols(p, 512, 512);
#endif
            } else if (sp == 3) {
#if EN_RWKV
                phase_rwkv_post(p, l);
#else
                zero_mix_cols(p, 256, 256);
#endif
                if (l == 1) {
                    convert_straight(p.in[I_PU] + (size_t)16384 * 1024, (u16*)(ws + OFF_U), (size_t)16384 * 1024);
                    convert_straight(p.in[I_PV] + (size_t)16384 * 1024, (u16*)(ws + OFF_V), (size_t)16384 * 1024);
                }
            } else if (sp == 4) {
                EpiOutProj e{l == 0 ? p.in[I_X] : p.out, p.out, modl + 2 * 1024};
                gemm_phase((const u16*)(ws + OFF_MIX), 1024, (const u16*)(ws + OFF_WOUT) + (size_t)l * 1024 * 1024, 1024, 256, 8, 1024, e, lds, bx, G);
            } else if (sp == 5) {
#if EN_PEER
                phase_norm(p.out, p.in[I_N2G] + l * 1024, modl + 3 * 1024, modl + 4 * 1024, (u16*)(ws + OFF_H));
#endif
            } else if (sp == 6) {
#if EN_PEER
                EpiStoreBf16 e{(u16*)(ws + OFF_QP), 2048};
                gemm_phase((const u16*)(ws + OFF_H), 1024, (const u16*)(ws + OFF_WQ) + (size_t)l * 2048 * 1024, 1024, 256, 16, 1024, e, lds, bx, G);
#endif
            } else if (sp == 7) {
#if EN_PEER
                float* wl = (float*)lds + (TID() >> 6) * 1536;
                for (;;) { const int t = wave_next(ctl + QW(l, Q_PTK)); if (t >= NTOK / 2) break; peer_topk_task(p, l, t, wl); }
#endif
            } else {
                phase_peer_experts(p, l);
            }
        }
        if (ph + 1 < p.ph_hi) grid.sync();
    }
}

extern "C" void kernel_launch(void* const* d_in, const int* in_sizes, int n_in, void* d_out, int out_size, void* d_ws, size_t ws_size,
                              hipStream_t stream) {
    static int grid_blocks = 0;
    if (!grid_blocks) {
        int dev = 0, cus = 0, per_cu = 0;
        hipGetDevice(&dev);
        hipDeviceGetAttribute(&cus, hipDeviceAttributeMultiprocessorCount, dev);
        hipOccupancyMaxActiveBlocksPerMultiprocessor(&per_cu, (const void*)mega, 256, 0);
        if (per_cu > 2) per_cu = 2;
        if (per_cu < 1) per_cu = 1;
        grid_blocks = cus * per_cu;
        if (ws_size < WS_NEED) fprintf(stderr, "kernel_launch: workspace too small: %zu < %zu\n", ws_size, (size_t)WS_NEED);
    }
    hipMemsetAsync((char*)d_ws + OFF_CTL, 0, CTL_ZERO_BYTES, stream);
    Params p{};
    for (int i = 0; i < 35; ++i) p.in[i] = (const float*)d_in[i];
    p.out = (float*)d_out;
    p.ws = (unsigned char*)d_ws;
#if MULTI_LAUNCH
    for (int ph = 0; ph < NPH; ++ph) {
        p.ph_lo = ph; p.ph_hi = ph + 1;
        hipLaunchKernelGGL(mega, dim3(grid_blocks), dim3(256), 0, stream, p);
    }
#else
    p.ph_lo = 0; p.ph_hi = NPH;
    void* args[] = {&p};
    hipError_t e = hipLaunchCooperativeKernel((const void*)mega, dim3(grid_blocks), dim3(256), args, 0, stream);
    if (e != hipSuccess) fprintf(stderr, "cooperative launch failed: %s (grid %d)\n", hipGetErrorString(e), grid_blocks);
#endif
}
```

```cpp
#include <hip/hip_runtime.h>
#include <hip/hip_cooperative_groups.h>
#include <stdint.h>
#include <stdio.h>
namespace cg = cooperative_groups;

#ifndef EN_CONV
#define EN_CONV 1
#endif
#ifndef EN_RWKV
#define EN_RWKV 1
#endif
#ifndef EN_NSA_CMP
#define EN_NSA_CMP 1
#endif
#ifndef EN_NSA_WIN
#define EN_NSA_WIN 1
#endif
#ifndef EN_NSA_SEL
#define EN_NSA_SEL 1
#endif
#ifndef EN_PEER
#define EN_PEER 1
#endif
#ifndef MULTI_LAUNCH
#define MULTI_LAUNCH 0
#endif

#define DEV __device__ __forceinline__
typedef unsigned short u16;
typedef __attribute__((ext_vector_type(8))) short bf16x8;
typedef __attribute__((ext_vector_type(4))) float f32x4;
typedef __attribute__((ext_vector_type(4))) unsigned int u32x4;
typedef __attribute__((ext_vector_type(2))) unsigned int u32x2;

constexpr int NB = 4, NT = 8192, ND = 1024, NTOK = NB * NT, NL = 2;
constexpr int NIN = 2840, NINP = 2944;
constexpr size_t MiB = 1ull << 20;

constexpr size_t OFF_CTL = 0;
constexpr size_t CTL_ZERO_BYTES = 32768;
constexpr size_t OFF_BAR = 16384;
constexpr size_t OFF_MOD = 64 * 1024;
constexpr size_t OFF_CBP = 256 * 1024;
constexpr size_t OFF_WIN = 1 * MiB;
constexpr size_t OFF_WOUT = 13 * MiB;
constexpr size_t OFF_WQ = 17 * MiB;
constexpr size_t OFF_CW1 = 25 * MiB;
constexpr size_t OFF_K12 = 27 * MiB;
constexpr size_t OFF_U8 = 28 * MiB;
constexpr size_t OFF_UVS = 512 * 1024;
constexpr size_t OFF_H = 92 * MiB;
constexpr size_t OFF_MIX = 156 * MiB;
constexpr size_t OFF_E = 220 * MiB;
constexpr size_t OFF_PCONV = OFF_E + 0;
constexpr size_t OFF_PRWKV = OFF_E + 32 * MiB;
constexpr size_t OFF_YRAW = OFF_E + 32 * MiB;
constexpr size_t OFF_Q = OFF_E + 96 * MiB;
constexpr size_t OFF_KV = OFF_E + 128 * MiB;
constexpr size_t OFF_GATE = OFF_E + 176 * MiB;
constexpr size_t OFF_KC = OFF_E + 180 * MiB;
constexpr size_t OFF_VCT = OFF_KC + 512 * 1024;
constexpr size_t OFF_RV = OFF_E + 184 * MiB;
constexpr size_t OFF_RKK = OFF_E + 200 * MiB;
constexpr size_t OFF_RKKA = OFF_E + 216 * MiB;
constexpr size_t OFF_RG = OFF_E + 232 * MiB;
constexpr size_t OFF_BONUS = OFF_E + 248 * MiB;
constexpr size_t OFF_RW = OFF_H;
constexpr size_t OFF_RR = OFF_H + 32 * MiB;
constexpr size_t OFF_RK = OFF_H + 48 * MiB;
constexpr size_t OFF_QP = OFF_E + 0;
constexpr size_t OFF_PIDX = OFF_E + 128 * MiB;
constexpr size_t OFF_PGW = OFF_E + 144 * MiB;
constexpr size_t WS_NEED = OFF_E + 249 * MiB;

#define QW(l, q) (64 * ((l) * 8 + (q)))
enum { Q_CMP = 0, Q_CONV = 1, Q_RWP = 2, Q_NSA = 3, Q_PTK = 4 };

enum { I_X = 0, I_C, I_ADAW, I_ADAB, I_N1G, I_N2G, I_WIN, I_CDW, I_CDB, I_CGG, I_CGB, I_MU, I_W0, I_WUP, I_A0, I_AUP, I_GUP,
       I_KK, I_KA, I_RK, I_LNG, I_LNB, I_CKPOS, I_CKW1, I_CKW2, I_CVPOS, I_CVW1, I_CVW2, I_WOUT, I_PWQ, I_PK1, I_PK2, I_PU, I_PV, I_FG };

struct Params {
    const float* in[35];
    float* out;
    unsigned char* ws;
    int ph_lo, ph_hi;
};

DEV int TID() { int t = threadIdx.x; asm volatile("" : "+v"(t)); return t; }
DEV int BID() { int t = blockIdx.x; asm volatile("" : "+s"(t)); return t; }
DEV u16 f2bf(float f) { unsigned u = __float_as_uint(f); u += 0x7fffu + ((u >> 16) & 1u); return (u16)(u >> 16); }
DEV float bf2f(u16 h) { return __uint_as_float(((unsigned)h) << 16); }
DEV unsigned pack2(float a, float b) { return (unsigned)f2bf(a) | ((unsigned)f2bf(b) << 16); }
DEV float bflo(unsigned u) { return __uint_as_float(u << 16); }
DEV float bfhi(unsigned u) { return __uint_as_float(u & 0xffff0000u); }
DEV float sigmoidf_(float x) { return 1.f / (1.f + __expf(-x)); }

DEV f32x4 mfma16(bf16x8 a, bf16x8 b, f32x4 c) { return __builtin_amdgcn_mfma_f32_16x16x32_bf16(a, b, c, 0, 0, 0); }
template <int CTRL> DEV float dppf(float x) { return __int_as_float(__builtin_amdgcn_update_dpp(0, __float_as_int(x), CTRL, 0xF, 0xF, false)); }
template <int CTRL> DEV unsigned dppu(unsigned x) { return (unsigned)__builtin_amdgcn_update_dpp(0, (int)x, CTRL, 0xF, 0xF, false); }
DEV float reduce16(float x) { x += dppf<0xB1>(x); x += dppf<0x4E>(x); x += dppf<0x124>(x); x += dppf<0x128>(x); return x; }
DEV float quadsum(float x) { x += dppf<0xB1>(x); x += dppf<0x4E>(x); return x; }
DEV float x16_sum(float x) { auto r = __builtin_amdgcn_permlane16_swap(__float_as_uint(x), __float_as_uint(x), false, false); return __uint_as_float(r[0]) + __uint_as_float(r[1]); }
DEV float x32_sum(float x) { auto r = __builtin_amdgcn_permlane32_swap(__float_as_uint(x), __float_as_uint(x), false, false); return __uint_as_float(r[0]) + __uint_as_float(r[1]); }
DEV float x16_max(float x) { auto r = __builtin_amdgcn_permlane16_swap(__float_as_uint(x), __float_as_uint(x), false, false); return fmaxf(__uint_as_float(r[0]), __uint_as_float(r[1])); }
DEV float x32_max(float x) { auto r = __builtin_amdgcn_permlane32_swap(__float_as_uint(x), __float_as_uint(x), false, false); return fmaxf(__uint_as_float(r[0]), __uint_as_float(r[1])); }
DEV int x16_sumi(int x) { auto r = __builtin_amdgcn_permlane16_swap((unsigned)x, (unsigned)x, false, false); return (int)(r[0] + r[1]); }
DEV int x32_sumi(int x) { auto r = __builtin_amdgcn_permlane32_swap((unsigned)x, (unsigned)x, false, false); return (int)(r[0] + r[1]); }
DEV float colsum(float x) { return x32_sum(x16_sum(x)); }
DEV float colmax(float x) { return x32_max(x16_max(x)); }
DEV int colsumi(int x) { return x32_sumi(x16_sumi(x)); }
DEV float wave_sum(float v) { return x32_sum(x16_sum(reduce16(v))); }
DEV float wave_max(float x) {
    x = fmaxf(x, dppf<0xB1>(x)); x = fmaxf(x, dppf<0x4E>(x)); x = fmaxf(x, dppf<0x124>(x)); x = fmaxf(x, dppf<0x128>(x));
    return x32_max(x16_max(x));
}
DEV void lds_fence() { asm volatile("s_waitcnt lgkmcnt(0)" ::: "memory"); }
DEV bf16x8 ld8(const u16* p) { return *(const bf16x8*)p; }

DEV int block_next(unsigned* ctr, int* slot) {
    __syncthreads();
    if (TID() == 0) *slot = (int)atomicAdd(ctr, 1u);
    __syncthreads();
    return *slot;
}
DEV int wave_next(unsigned* ctr) {
    int v = 0;
    if ((TID() & 63) == 0) v = (int)atomicAdd(ctr, 1u);
    return __builtin_amdgcn_readfirstlane(v);
}


#define XB_TMO      128
#define XB_XCNT(j)  (256  + 64 * (j))
#define XB_XSUB(j)  (1280 + 64 * (j))
#define XB_XGEN(j)  (2304 + 64 * (j))
#define XB_TOP      3328
#define XB_TOPGEN   3392
#define XCD_BAR_WORDS 3456
#define XB_SPIN_CAP (1u << 22)
#define LAS __attribute__((address_space(3)))
DEV unsigned xb_ld(unsigned* p) { return __hip_atomic_load(p, __ATOMIC_RELAXED, __HIP_MEMORY_SCOPE_AGENT); }
DEV unsigned xb_add(unsigned* p, unsigned v) { return __hip_atomic_fetch_add(p, v, __ATOMIC_RELAXED, __HIP_MEMORY_SCOPE_AGENT); }
DEV unsigned xb_xcc_id() { return (unsigned)__builtin_amdgcn_s_getreg((3 << 11) | 20) & 0xFu; }
#define XB_SPIN(cond, bar) do { unsigned _sp = 0; while (cond) { __builtin_amdgcn_s_sleep(1); \
    if ((++_sp & 255u) == 0u) { if (xb_ld(&(bar)[XB_TMO])) break; if (_sp > XB_SPIN_CAP) { atomicAdd(&(bar)[XB_TMO], 1u); break; } } } } while (0)
struct XcdBarrier { unsigned* bar; unsigned x; volatile unsigned* st; };
DEV XcdBarrier xcd_barrier_post(unsigned* bar, volatile unsigned* st) {
    XcdBarrier b; b.bar = bar; b.x = xb_xcc_id(); b.st = st;
    if (threadIdx.x == 0) (void)xb_add(&bar[XB_XCNT(b.x)], 1u);
    return b;
}
DEV void xcd_barrier_complete(unsigned* bar, unsigned x, unsigned& nloc, unsigned& nx) {
    const unsigned G = gridDim.x * gridDim.y * gridDim.z;
    unsigned sum, cnt, mine, sp = 0u;
    for (;;) {
        sum = 0u; cnt = 0u; mine = 0u;
#pragma unroll
        for (unsigned j = 0; j < 16; ++j) { const unsigned c = xb_ld(&bar[XB_XCNT(j)]); sum += c; cnt += (c > 0u) ? 1u : 0u; mine = (j == x) ? c : mine; }
        if (sum == G) break;
        __builtin_amdgcn_s_sleep(1);
        if ((++sp & 255u) == 0u) { if (xb_ld(&bar[XB_TMO])) break; if (sp > XB_SPIN_CAP) { atomicAdd(&bar[XB_TMO], 1u); break; } }
    }
    nloc = mine > 0u ? mine : 1u; nx = cnt > 0u ? cnt : 1u;
}
DEV void xcd_barrier(const XcdBarrier& b) {
    asm volatile("s_waitcnt vmcnt(0)" ::: "memory");
    __syncthreads();
    if (threadIdx.x == 0) {
        unsigned* bar = b.bar;
        __builtin_amdgcn_s_waitcnt(0);
        unsigned nloc = b.st[0], nx = b.st[1];
        if (nloc == 0u) { xcd_barrier_complete(bar, b.x, nloc, nx); b.st[0] = nloc; b.st[1] = nx; }
        const unsigned old = xb_add(&bar[XB_XSUB(b.x)], 1u);
        const unsigned gen = old / nloc;
        if (old + 1u == (gen + 1u) * nloc) {
            __builtin_amdgcn_fence(__ATOMIC_RELEASE, "agent");
            asm volatile("s_waitcnt vmcnt(0)" ::: "memory");
            const unsigned og = xb_add(&bar[XB_TOP], 1u);
            const unsigned tg = og / nx;
            if (og + 1u == (tg + 1u) * nx) xb_add(&bar[XB_TOPGEN], 1u);
            else XB_SPIN(xb_ld(&bar[XB_TOPGEN]) == tg, bar);
            __builtin_amdgcn_fence(__ATOMIC_ACQUIRE, "agent");
            xb_add(&bar[XB_XGEN(b.x)], 1u);
            asm volatile("s_waitcnt vmcnt(0)" ::: "memory");
        } else {
            XB_SPIN(xb_ld(&bar[XB_XGEN(b.x)]) == gen, bar);
            __builtin_amdgcn_fence(__ATOMIC_ACQUIRE, "agent");
            asm volatile("s_waitcnt vmcnt(0)" ::: "memory");
        }
    }
    __syncthreads();
}

template <class Epi>
DEV void gemm_phase(const u16* __restrict__ A, int lda, const u16* __restrict__ Bt, int ldb, int mtiles, int ntiles, int K, Epi& epi,
                    unsigned char* lds, int bid, int nb) {
    const int tid = TID(), lane = tid & 63, wave = tid >> 6;
    const int wm = wave >> 1, wn = wave & 1, q4 = lane >> 4, cidx = lane & 15;
    u16* As = (u16*)lds;
    u16* Bs = (u16*)(lds + 32768);
    const int KT = K >> 6;
    const int total = mtiles * ntiles;
    const int srow = tid >> 3, sch = tid & 7;
    for (int tile = bid; tile < total; tile += nb) {
        const int mt = tile / ntiles, nt = tile - mt * ntiles;
        const int m0 = mt * 128, n0 = nt * 128;
        f32x4 acc[4][4];
#pragma unroll
        for (int i = 0; i < 4; ++i)
#pragma unroll
            for (int j = 0; j < 4; ++j) acc[i][j] = (f32x4){0.f, 0.f, 0.f, 0.f};
        const u16* Ag = A + (size_t)(m0 + srow) * lda + sch * 8;
        const u16* Bg = Bt + (size_t)(n0 + srow) * ldb + sch * 8;
        bf16x8 ra[4], rb[4];
#pragma unroll
        for (int i = 0; i < 4; ++i) { ra[i] = ld8(Ag + (size_t)(32 * i) * lda); rb[i] = ld8(Bg + (size_t)(32 * i) * ldb); }
#pragma unroll
        for (int i = 0; i < 4; ++i) {
            const int row = srow + 32 * i; const int off = row * 64 + ((sch ^ (row & 7)) << 3);
            *(bf16x8*)(As + off) = ra[i]; *(bf16x8*)(Bs + off) = rb[i];
        }
        __syncthreads();
        for (int kt = 0; kt < KT; ++kt) {
            const int buf = kt & 1;
            if (kt + 1 < KT) {
                const int k0 = (kt + 1) * 64;
#pragma unroll
                for (int i = 0; i < 4; ++i) { ra[i] = ld8(Ag + (size_t)(32 * i) * lda + k0); rb[i] = ld8(Bg + (size_t)(32 * i) * ldb + k0); }
            }
            const u16* Ab = As + buf * 8192;
            const u16* Bb = Bs + buf * 8192;
#pragma unroll
            for (int s = 0; s < 2; ++s) {
                bf16x8 a[4], b[4];
                const int ch = s * 4 + q4;
#pragma unroll
                for (int i = 0; i < 4; ++i) {
                    const int row = wm * 64 + i * 16 + cidx;
                    a[i] = *(const bf16x8*)(Ab + row * 64 + ((ch ^ (row & 7)) << 3));
                    const int rowb = wn * 64 + i * 16 + cidx;
                    b[i] = *(const bf16x8*)(Bb + rowb * 64 + ((ch ^ (rowb & 7)) << 3));
                }
#pragma unroll
                for (int i = 0; i < 4; ++i)
#pragma unroll
                    for (int j = 0; j < 4; ++j) acc[i][j] = mfma16(a[i], b[j], acc[i][j]);
            }
            if (kt + 1 < KT) {
                u16* Aw = As + (buf ^ 1) * 8192;
                u16* Bw = Bs + (buf ^ 1) * 8192;
#pragma unroll
                for (int i = 0; i < 4; ++i) {
                    const int row = srow + 32 * i; const int off = row * 64 + ((sch ^ (row & 7)) << 3);
                    *(bf16x8*)(Aw + off) = ra[i]; *(bf16x8*)(Bw + off) = rb[i];
                }
            }
            __syncthreads();
        }
#pragma unroll
        for (int i = 0; i < 4; ++i)
#pragma unroll
            for (int j = 0; j < 4; ++j) epi(m0 + wm * 64 + i * 16 + q4 * 4, n0 + wn * 64 + j * 16 + cidx, acc[i][j]);
        epi.finish(m0, n0, lds);
    }
}

struct EpiInProj {
    u16 *pconv, *prwkv, *q, *kv; float* gate;
    DEV void operator()(int row0, int col, f32x4 v) const {
        if (col < 512) {
#pragma unroll
            for (int r = 0; r < 4; ++r) pconv[(size_t)(row0 + r) * 512 + col] = f2bf(v[r]);
        } else if (col < 1536) {
#pragma unroll
            for (int r = 0; r < 4; ++r) prwkv[(size_t)(row0 + r) * 1024 + (col - 512)] = f2bf(v[r]);
        } else if (col < 2048) {
#pragma unroll
            for (int r = 0; r < 4; ++r) q[(size_t)(row0 + r) * 512 + (col - 1536)] = f2bf(v[r] * 0.125f);
        } else if (col < 2816) {
            const int c = col - 2048; const int idx = c >> 7; const int g = (c >> 6) & 1; const int d = c & 63;
            const int b = row0 >> 13; const int t0 = row0 & 8191; const int bg = b * 2 + g;
            u16* base = kv + (size_t)idx * 4194304;
            if (idx == 3 || idx == 5) {
                const int k = t0 & 31; const int p0 = 8 * ((k & 15) >> 2) + 4 * (k >> 4);
                u32x2 w; w[0] = pack2(v[0], v[1]); w[1] = pack2(v[2], v[3]);
                *(u32x2*)(base + (size_t)(bg * 64 + d) * 8192 + (t0 & ~31) + p0) = w;
            } else {
#pragma unroll
                for (int r = 0; r < 4; ++r) base[((size_t)bg * 8192 + t0 + r) * 64 + d] = f2bf(v[r]);
            }
        } else if (col < 2840) {
#pragma unroll
            for (int r = 0; r < 4; ++r) gate[(size_t)(row0 + r) * 24 + (col - 2816)] = sigmoidf_(v[r]);
        }
    }
    DEV void finish(int, int, unsigned char*) const {}
};

struct EpiOutProj {
    const float* xold; float* xnew; const float* g1;
    DEV void operator()(int row0, int col, f32x4 v) const {
        const int b = row0 >> 13; const float gg = g1[b * 6144 + col];
#pragma unroll
        for (int r = 0; r < 4; ++r) { const size_t o = (size_t)(row0 + r) * 1024 + col; xnew[o] = xold[o] + gg * v[r]; }
    }
    DEV void finish(int, int, unsigned char*) const {}
};

struct EpiStoreBf16 {
    u16* out; int ld;
    DEV void operator()(int row0, int col, f32x4 v) const {
#pragma unroll
        for (int r = 0; r < 4; ++r) out[(size_t)(row0 + r) * ld + col] = f2bf(v[r]);
    }
    DEV void finish(int, int, unsigned char*) const {}
};

struct EpiCompress {
    const float* cbp;
    const float* w2;
    u16* outp;
    int isv;
    unsigned char* lds;
    DEV void operator()(int row0, int col, f32x4 v) const {
        float* hid = (float*)lds;
        const int rl = row0 & 127;
#pragma unroll
        for (int r = 0; r < 4; ++r) hid[(rl + r) * 128 + col] = v[r];
    }
    DEV void finish(int m0, int, unsigned char*) const {
        __syncthreads();
        {
            float* hw = (float*)lds;
            const int t = TID(); const int c = t & 127, r0 = (t >> 7) * 64;
            float bias = 0.f;
#pragma unroll
            for (int s = 0; s < 16; ++s) bias += cbp[s * 128 + c];
#pragma unroll 4
            for (int r = 0; r < 64; ++r) { const float x = hw[(r0 + r) * 128 + c] + bias; hw[(r0 + r) * 128 + c] = x * sigmoidf_(x); }
        }
        __syncthreads();
        const float* hid = (const float*)lds;
        const int tid = TID(); const int d = tid & 63, rgp = tid >> 6;
        float acc[32];
#pragma unroll
        for (int i = 0; i < 32; ++i) acc[i] = 0.f;
#pragma unroll 1
        for (int j = 0; j < 128; ++j) {
            const float wv = w2[j * 64 + d];
#pragma unroll
            for (int rr = 0; rr < 32; ++rr) acc[rr] += hid[(rgp * 32 + rr) * 128 + j] * wv;
        }
#pragma unroll
        for (int rr = 0; rr < 32; ++rr) {
            const int m = m0 + rgp * 32 + rr; const int bg = m >> 9, n = m & 511;
            const u16 val = (n == 511) ? (u16)0 : f2bf(acc[rr]);
            if (!isv) outp[((size_t)bg * 512 + n) * 64 + d] = val;
            else {
                const int k = n & 31; const int pp = 8 * ((k & 15) >> 2) + (k & 3) + 4 * (k >> 4);
                outp[((size_t)bg * 64 + d) * 512 + (n & ~31) + pp] = val;
            }
        }
        __syncthreads();
    }
};

DEV void transpose_tile(const float* __restrict__ src, int N, u16* __restrict__ dst, int ldk, int kt, int nt, float* tl) {
    const int tid = TID(); const int k0 = kt * 64, n0 = nt * 64;
#pragma unroll 4
    for (int i = 0; i < 16; ++i) {
        const int idx = tid + 256 * i; const int kr = idx >> 6, nc = idx & 63; const int n = n0 + nc;
        tl[kr * 65 + nc] = (n < N) ? src[(size_t)(k0 + kr) * N + n] : 0.f;
    }
    __syncthreads();
#pragma unroll 4
    for (int i = 0; i < 16; ++i) {
        const int idx = tid + 256 * i; const int nr = idx >> 6, kc = idx & 63;
        dst[(size_t)(n0 + nr) * ldk + k0 + kc] = f2bf(tl[kc * 65 + nr]);
    }
    __syncthreads();
}

DEV void convert_straight(const float* __restrict__ src, u16* __restrict__ dst, size_t n) {
    const size_t stride = (size_t)gridDim.x * 256 * 8;
    for (size_t i = ((size_t)BID() * 256 + TID()) * 8; i < n; i += stride) {
        const float4 a = *(const float4*)(src + i); const float4 b = *(const float4*)(src + i + 4);
        u32x4 w; w[0] = pack2(a.x, a.y); w[1] = pack2(a.z, a.w); w[2] = pack2(b.x, b.y); w[3] = pack2(b.z, b.w);
        *(u32x4*)(dst + i) = w;
    }
}

DEV void convert_rows_i8(const float* __restrict__ src, unsigned char* __restrict__ dst, float* __restrict__ scale) {
    const int lane = TID() & 63;
    const int gw = BID() * 4 + (TID() >> 6), nw = gridDim.x * 4;
    for (int row = gw; row < 16384; row += nw) {
        float4 v[4]; float amax = 0.f;
#pragma unroll
        for (int i = 0; i < 4; ++i) {
            v[i] = *(const float4*)(src + (size_t)row * 1024 + 16 * lane + 4 * i);
            amax = fmaxf(amax, fmaxf(fmaxf(fabsf(v[i].x), fabsf(v[i].y)), fmaxf(fabsf(v[i].z), fabsf(v[i].w))));
        }
        amax = wave_max(amax);
        const float sc = amax > 0.f ? amax * (1.f / 127.f) : 1.f;
        const float inv = 1.f / sc;
        u32x4 w;
#pragma unroll
        for (int i = 0; i < 4; ++i) {
            const int a = __float2int_rn(v[i].x * inv) + 128, b = __float2int_rn(v[i].y * inv) + 128, c = __float2int_rn(v[i].z * inv) + 128, d = __float2int_rn(v[i].w * inv) + 128;
            w[i] = (unsigned)a | ((unsigned)b << 8) | ((unsigned)c << 16) | ((unsigned)d << 24);
        }
        *(u32x4*)(dst + (size_t)row * 1024 + 16 * lane) = w;
        if (lane == 0) scale[row] = sc;
    }
}

DEV void phase_prep(const Params& p, unsigned char* lds) {
    const int tid = TID();
    float* fl = (float*)lds;
    unsigned char* ws = p.ws;
    for (int task = BID(); task < 192; task += gridDim.x) {
        const int l = task / 96, cgp = task % 96;
        float* cs = fl;
        float* red = fl + 4096;
        for (int i = tid; i < 4096; i += 256) { const float c = p.in[I_C][i]; cs[i] = c / (1.f + __expf(-c)); }
        __syncthreads();
        const int col = cgp * 64 + (tid & 63), ks = tid >> 6;
        float a0 = 0, a1 = 0, a2 = 0, a3 = 0;
        const float* w = p.in[I_ADAW] + ((size_t)l * 1024 + ks * 256) * 6144 + col;
#pragma unroll 8
        for (int k = 0; k < 256; ++k) {
            const float wv = w[(size_t)k * 6144]; const int kk = ks * 256 + k;
            a0 += cs[kk] * wv; a1 += cs[1024 + kk] * wv; a2 += cs[2048 + kk] * wv; a3 += cs[3072 + kk] * wv;
        }
        red[(ks * 4 + 0) * 64 + (tid & 63)] = a0; red[(ks * 4 + 1) * 64 + (tid & 63)] = a1;
        red[(ks * 4 + 2) * 64 + (tid & 63)] = a2; red[(ks * 4 + 3) * 64 + (tid & 63)] = a3;
        __syncthreads();
        {
            const int b = tid >> 6, c = tid & 63;
            const float s = red[(0 * 4 + b) * 64 + c] + red[(1 * 4 + b) * 64 + c] + red[(2 * 4 + b) * 64 + c] + red[(3 * 4 + b) * 64 + c];
            const int colg = cgp * 64 + c;
            ((float*)(ws + OFF_MOD))[(l * 4 + b) * 6144 + colg] = s + p.in[I_ADAB][l * 6144 + colg];
        }
        __syncthreads();
    }
    for (int task = BID(); task < 64; task += gridDim.x) {
        const int l = task >> 5, kv = (task >> 4) & 1, s = task & 15;
        const float* pos = p.in[kv ? I_CVPOS : I_CKPOS] + l * 2048;
        const float* w1 = p.in[kv ? I_CVW1 : I_CKW1] + (size_t)l * 2048 * 128;
        const int col = tid & 127, half = tid >> 7;
        float a = 0;
        const int i0 = s * 128 + half * 64;
#pragma unroll 8
        for (int i = 0; i < 64; ++i) a += pos[i0 + i] * w1[(size_t)(i0 + i) * 128 + col];
        fl[tid] = a;
        __syncthreads();
        if (tid < 128) ((float*)(ws + OFF_CBP))[((l * 2 + kv) * 16 + s) * 128 + tid] = fl[tid] + fl[tid + 128];
        __syncthreads();
    }
    {
        for (int task = BID(); task < 2 * 16 * 46; task += gridDim.x) {
            const int l = task / (16 * 46), r = task % (16 * 46);
            transpose_tile(p.in[I_WIN] + (size_t)l * 1024 * NIN, NIN, (u16*)(ws + OFF_WIN) + (size_t)l * NINP * 1024, 1024, r / 46, r % 46, fl);
        }
        for (int task = BID(); task < 2 * 16 * 16; task += gridDim.x) {
            const int l = task >> 8, r = task & 255;
            transpose_tile(p.in[I_WOUT] + (size_t)l * 1024 * 1024, 1024, (u16*)(ws + OFF_WOUT) + (size_t)l * 1024 * 1024, 1024, r >> 4, r & 15, fl);
        }
        for (int task = BID(); task < 2 * 16 * 32; task += gridDim.x) {
            const int l = task >> 9, r = task & 511;
            transpose_tile(p.in[I_PWQ] + (size_t)l * 1024 * 2048, 2048, (u16*)(ws + OFF_WQ) + (size_t)l * 2048 * 1024, 1024, r >> 5, r & 31, fl);
        }
        for (int task = BID(); task < 4 * 32 * 2; task += gridDim.x) {
            const int lk = task >> 6, r = task & 63; const int l = lk >> 1, kv = lk & 1;
            transpose_tile(p.in[kv ? I_CVW1 : I_CKW1] + (size_t)l * 2048 * 128, 128, (u16*)(ws + OFF_CW1) + (size_t)lk * 128 * 2048, 2048, r >> 1, r & 1, fl);
        }
    }
    for (int l = 0; l < 2; ++l) {
        convert_straight(p.in[I_PK1] + l * 16384, (u16*)(ws + OFF_K12) + (l * 2 + 0) * 16384, 16384);
        convert_straight(p.in[I_PK2] + l * 16384, (u16*)(ws + OFF_K12) + (l * 2 + 1) * 16384, 16384);
    }
    for (int l = 0; l < 2; ++l) {
        convert_rows_i8(p.in[I_PU] + (size_t)l * 16384 * 1024, ws + OFF_U8 + (size_t)(l * 2 + 0) * 16 * MiB, (float*)(ws + OFF_UVS) + (l * 2 + 0) * 16384);
        convert_rows_i8(p.in[I_PV] + (size_t)l * 16384 * 1024, ws + OFF_U8 + (size_t)(l * 2 + 1) * 16 * MiB, (float*)(ws + OFF_UVS) + (l * 2 + 1) * 16384);
    }
}

DEV void phase_norm(const float* __restrict__ x, const float* __restrict__ g, const float* __restrict__ sh, const float* __restrict__ sc,
                    u16* __restrict__ h) {
    const int lane = TID() & 63;
    const int gw = BID() * 4 + (TID() >> 6), nw = gridDim.x * 4;
    for (int row = gw; row < NTOK; row += nw) {
        const int b = row >> 13;
        float4 v[4]; float ss = 0;
#pragma unroll
        for (int i = 0; i < 4; ++i) { v[i] = *(const float4*)(x + (size_t)row * 1024 + 256 * i + lane * 4); ss += v[i].x * v[i].x + v[i].y * v[i].y + v[i].z * v[i].z + v[i].w * v[i].w; }
        ss = wave_sum(ss);
        const float rs = rsqrtf(ss * (1.f / 1024.f) + 1e-6f);
#pragma unroll
        for (int i = 0; i < 4; ++i) {
            const int k = 256 * i + lane * 4;
            const float4 gg = *(const float4*)(g + k); const float4 s1 = *(const float4*)(sc + b * 6144 + k); const float4 s0 = *(const float4*)(sh + b * 6144 + k);
            u32x2 w;
            w[0] = pack2(v[i].x * rs * gg.x * (1.f + s1.x) + s0.x, v[i].y * rs * gg.y * (1.f + s1.y) + s0.y);
            w[1] = pack2(v[i].z * rs * gg.z * (1.f + s1.z) + s0.z, v[i].w * rs * gg.w * (1.f + s1.w) + s0.w);
            *(u32x2*)(h + (size_t)row * 1024 + k) = w;
        }
    }
}

DEV void phase_final_only(const float* __restrict__ x, const float* __restrict__ g, float* __restrict__ out) {
    const int lane = TID() & 63;
    const int gw = BID() * 4 + (TID() >> 6), nw = gridDim.x * 4;
    for (int row = gw; row < NTOK; row += nw) {
        float4 v[4]; float ss = 0;
#pragma unroll
        for (int i = 0; i < 4; ++i) { v[i] = *(const float4*)(x + (size_t)row * 1024 + 256 * i + lane * 4); ss += v[i].x * v[i].x + v[i].y * v[i].y + v[i].z * v[i].z + v[i].w * v[i].w; }
        ss = wave_sum(ss);
        const float rs = rsqrtf(ss * (1.f / 1024.f) + 1e-6f);
#pragma unroll
        for (int i = 0; i < 4; ++i) {
            const int k = 256 * i + lane * 4; const float4 gg = *(const float4*)(g + k);
            float4 o; o.x = v[i].x * rs * gg.x; o.y = v[i].y * rs * gg.y; o.z = v[i].z * rs * gg.z; o.w = v[i].w * rs * gg.w;
            *(float4*)(out + (size_t)row * 1024 + k) = o;
        }
    }
}


DEV void conv_tile(const Params& p, int l, int tile, unsigned char* lds) {
    float* ul = (float*)lds;
    const int tid = TID();
    unsigned char* ws = p.ws;
    const u16* pconv = (const u16*)(ws + OFF_PCONV);
    u16* mix = (u16*)(ws + OFF_MIX);
    const int t0g = tile * 32; const int tb = t0g & 8191;
    for (int rr = 0; rr < 62; ++rr) {
        const int trow = tb - 30 + rr;
        float u = 0.f;
        if (trow >= 0) {
            const size_t o = (size_t)(t0g - 30 + rr) * 512;
            const float val = bf2f(pconv[o + tid]), gt = bf2f(pconv[o + 256 + tid]);
            u = val * sigmoidf_(gt);
        }
        ul[rr * 256 + tid] = u;
    }
    __syncthreads();
    float w[31];
#pragma unroll
    for (int j = 0; j < 31; ++j) w[j] = p.in[I_CDW][(l * 31 + j) * 256 + tid];
    const float bias = p.in[I_CDB][l * 256 + tid], gg = p.in[I_CGG][l * 256 + tid], gb = p.in[I_CGB][l * 256 + tid];
    for (int tt = 0; tt < 32; ++tt) {
        float y = bias;
#pragma unroll
        for (int j = 0; j < 31; ++j) y += ul[(tt + j) * 256 + tid] * w[j];
        const float mean = wave_sum(y) * (1.f / 64.f);
        const float d = y - mean;
        const float var = wave_sum(d * d) * (1.f / 64.f);
        float o = d * rsqrtf(var + 1e-5f) * gg + gb;
        o = o * sigmoidf_(o);
        mix[(size_t)(t0g + tt) * 1024 + tid] = f2bf(o);
    }
}

DEV float softplusf_(float x) { return x > 20.f ? x : log1pf(__expf(x)); }
DEV void rwkv_prep_tile(const Params& p, int l, int tile, unsigned char* lds) {
    float* actT = (float*)lds;
    const int tid = TID(), lane = tid & 63;
    unsigned char* ws = p.ws;
    const u16* pr = (const u16*)(ws + OFF_PRWKV);
    const float* mu = p.in[I_MU] + l * 1024;
    const int R0 = tile * 16;
    {
        const int col = 768 + tid; const float muc = mu[col];
#pragma unroll 4
        for (int tk = 0; tk < 16; ++tk) {
            const int row = R0 + tk; const int t = row & 8191;
            const float cur = bf2f(pr[(size_t)row * 1024 + col]);
            const float prev = t > 0 ? bf2f(pr[(size_t)(row - 1) * 1024 + col]) : 0.f;
            const float x = cur + (prev - cur) * muc;
            float a;
            if (tid < 64) a = tanhf(x); else if (tid < 128) a = x; else a = sigmoidf_(x);
            actT[tid * 16 + tk] = a;
        }
    }
    __syncthreads();
    float accw[16], acca[16], accg[16];
#pragma unroll
    for (int i = 0; i < 16; ++i) { accw[i] = 0.f; acca[i] = 0.f; accg[i] = 0.f; }
    const float* wup = p.in[I_WUP] + (size_t)l * 64 * 256 + tid;
    const float* aup = p.in[I_AUP] + (size_t)l * 64 * 256 + tid;
    const float* gup = p.in[I_GUP] + (size_t)l * 128 * 256 + tid;
#pragma unroll 2
    for (int j = 0; j < 64; ++j) {
        const float ww = wup[j * 256], aa = aup[j * 256];
        const float4* x1 = (const float4*)(actT + j * 16);
        const float4* x2 = (const float4*)(actT + (64 + j) * 16);
#pragma unroll
        for (int q = 0; q < 4; ++q) {
            const float4 a = x1[q], b = x2[q];
            accw[4 * q + 0] += a.x * ww; accw[4 * q + 1] += a.y * ww; accw[4 * q + 2] += a.z * ww; accw[4 * q + 3] += a.w * ww;
            acca[4 * q + 0] += b.x * aa; acca[4 * q + 1] += b.y * aa; acca[4 * q + 2] += b.z * aa; acca[4 * q + 3] += b.w * aa;
        }
    }
#pragma unroll 2
    for (int j = 0; j < 128; ++j) {
        const float gg = gup[j * 256];
        const float4* x3 = (const float4*)(actT + (128 + j) * 16);
#pragma unroll
        for (int q = 0; q < 4; ++q) {
            const float4 a = x3[q];
            accg[4 * q + 0] += a.x * gg; accg[4 * q + 1] += a.y * gg; accg[4 * q + 2] += a.z * gg; accg[4 * q + 3] += a.w * gg;
        }
    }
    const float w0 = p.in[I_W0][l * 256 + tid], a0 = p.in[I_A0][l * 256 + tid], kkc = p.in[I_KK][l * 256 + tid], kac = p.in[I_KA][l * 256 + tid],
                rkc = p.in[I_RK][l * 256 + tid];
    const float mur = mu[tid], muk = mu[256 + tid], muv = mu[512 + tid];
    float* RW = (float*)(ws + OFF_RW);
    u16 *RR = (u16*)(ws + OFF_RR), *RK = (u16*)(ws + OFF_RK), *RV = (u16*)(ws + OFF_RV), *RKK = (u16*)(ws + OFF_RKK), *RKKA = (u16*)(ws + OFF_RKKA),
        *RG = (u16*)(ws + OFF_RG);
    float* BON = (float*)(ws + OFF_BONUS);
#pragma unroll
    for (int tk = 0; tk < 16; ++tk) {
        const int row = R0 + tk; const int t = row & 8191;
        const u16* cr = pr + (size_t)row * 1024; const u16* pv = cr - 1024;
        float r = bf2f(cr[tid]), k = bf2f(cr[256 + tid]), v = bf2f(cr[512 + tid]);
        const float rp = t > 0 ? bf2f(pv[tid]) : 0.f, kp = t > 0 ? bf2f(pv[256 + tid]) : 0.f, vp = t > 0 ? bf2f(pv[512 + tid]) : 0.f;
        r += (rp - r) * mur; k += (kp - k) * muk; v += (vp - v) * muv;
        const float wl = w0 + accw[tk];
        const float wlog = -softplusf_(-wl) - 0.5f;
        const float decay = __expf(-__expf(wlog));
        const float a = sigmoidf_(a0 + acca[tk]);
        float kk = k * kkc;
        const float nrm = sqrtf(wave_sum(kk * kk));
        kk = kk / fmaxf(nrm, 1e-12f);
        const float keff = k * (1.f + (a - 1.f) * kac);
        const float bon = wave_sum(r * keff * rkc);
        const size_t o = (size_t)row * 256 + tid;
        RW[o] = decay; RR[o] = f2bf(r); RK[o] = f2bf(keff); RV[o] = f2bf(v); RKK[o] = f2bf(kk); RKKA[o] = f2bf(kk * a); RG[o] = f2bf(accg[tk]);
        if (lane == 0) BON[(size_t)row * 4 + (tid >> 6)] = bon;
    }
}

DEV void rwkv_scan(const Params& p, int sb, unsigned char* lds) {
    unsigned char* ws = p.ws;
    const float* RW = (const float*)(ws + OFF_RW);
    const u16 *RR = (const u16*)(ws + OFF_RR), *RK = (const u16*)(ws + OFF_RK), *RV = (const u16*)(ws + OFF_RV), *RKK = (const u16*)(ws + OFF_RKK),
              *RKKA = (const u16*)(ws + OFF_RKKA);
    float* YR = (float*)(ws + OFF_YRAW);
    const int tid = TID(), lane = tid & 63, wave = tid >> 6;
    const int bh = sb >> 2, rg = sb & 3; const int b = bh >> 2, hh = bh & 3;
    float* L = (float*)lds;
    constexpr int BUFSZ = 5 * 1024 + 256;
    float* Yb = L + 2 * BUFSZ;
    const int row_local = 4 * wave + (lane >> 4); const int kq = (lane & 15) * 4;
    const int lstep = tid >> 4, lk = (tid & 15) * 4;
    const int vstep = tid >> 4, vrow = tid & 15;
    const size_t gbase = (size_t)b * 8192 * 256 + hh * 64;
    float4 lw; u32x2 lr, lkk, lkka, lk_; u16 lv;
    auto issue = [&](int c) {
        const size_t o = gbase + (size_t)(c * 16 + lstep) * 256 + lk;
        lw = *(const float4*)(RW + o);
        lr = *(const u32x2*)(RR + o); lk_ = *(const u32x2*)(RK + o); lkk = *(const u32x2*)(RKK + o); lkka = *(const u32x2*)(RKKA + o);
        lv = RV[gbase + (size_t)(c * 16 + vstep) * 256 + rg * 16 + vrow];
    };
    auto commit = [&](int buf) {
        float* B = L + buf * BUFSZ;
        const int o = lstep * 64 + lk;
        *(float4*)(B + o) = lw;
        *(float4*)(B + 1024 + o) = (float4){bflo(lkka[0]), bfhi(lkka[0]), bflo(lkka[1]), bfhi(lkka[1])};
        *(float4*)(B + 2048 + o) = (float4){bflo(lk_[0]), bfhi(lk_[0]), bflo(lk_[1]), bfhi(lk_[1])};
        *(float4*)(B + 3072 + o) = (float4){bflo(lr[0]), bfhi(lr[0]), bflo(lr[1]), bfhi(lr[1])};
        *(float4*)(B + 4096 + o) = (float4){bflo(lkk[0]), bfhi(lkk[0]), bflo(lkk[1]), bfhi(lkk[1])};
        B[5120 + vstep * 16 + vrow] = bf2f(lv);
    };
    __syncthreads();
    issue(0); commit(0);
    __syncthreads();
    float S0 = 0.f, S1 = 0.f, S2 = 0.f, S3 = 0.f;
    constexpr int NCH = NT / 16;
    for (int c = 0; c < NCH; ++c) {
        const int buf = c & 1;
        if (c + 1 < NCH) issue(c + 1);
        const float* B = L + buf * BUFSZ;
        float* Y = Yb + buf * 256;
        float yv[16];
        float4 w4 = *(const float4*)(B + kq), a4 = *(const float4*)(B + 1024 + kq), k4 = *(const float4*)(B + 2048 + kq),
               r4 = *(const float4*)(B + 3072 + kq), n4 = *(const float4*)(B + 4096 + kq);
        float vv = B[5120 + row_local];
#pragma unroll
        for (int st = 0; st < 16; ++st) {
            float4 w4n, a4n, k4n, r4n, n4n; float vvn;
            if (st < 15) {
                w4n = *(const float4*)(B + (st + 1) * 64 + kq); a4n = *(const float4*)(B + 1024 + (st + 1) * 64 + kq);
                k4n = *(const float4*)(B + 2048 + (st + 1) * 64 + kq); r4n = *(const float4*)(B + 3072 + (st + 1) * 64 + kq);
                n4n = *(const float4*)(B + 4096 + (st + 1) * 64 + kq); vvn = B[5120 + (st + 1) * 16 + row_local];
            }
            const float part = (S0 * n4.x + S1 * n4.y) + (S2 * n4.z + S3 * n4.w);
            const float sa = -reduce16(part);
            const float t0 = S0 * w4.x + vv * k4.x, t1 = S1 * w4.y + vv * k4.y, t2 = S2 * w4.z + vv * k4.z, t3 = S3 * w4.w + vv * k4.w;
            S0 = t0 + sa * a4.x; S1 = t1 + sa * a4.y; S2 = t2 + sa * a4.z; S3 = t3 + sa * a4.w;
            const float yp = (S0 * r4.x + S1 * r4.y) + (S2 * r4.z + S3 * r4.w);
            yv[st] = reduce16(yp);
            if (st < 15) { w4 = w4n; a4 = a4n; k4 = k4n; r4 = r4n; n4 = n4n; vv = vvn; }
        }
        if ((lane & 15) == 0) {
#pragma unroll
            for (int st = 0; st < 16; ++st) Y[st * 16 + row_local] = yv[st];
        }
        if (c + 1 < NCH) commit(buf ^ 1);
        __syncthreads();
        YR[gbase + (size_t)(c * 16 + vstep) * 256 + rg * 16 + vrow] = Y[vstep * 16 + vrow];
    }
}

DEV void phase_rwkv_post(const Params& p, int l) {
    unsigned char* ws = p.ws;
    const float* YR = (const float*)(ws + OFF_YRAW); const float* BON = (const float*)(ws + OFF_BONUS);
    const u16 *RV = (const u16*)(ws + OFF_RV), *RG = (const u16*)(ws + OFF_RG);
    u16* mix = (u16*)(ws + OFF_MIX);
    const int tid = TID();
    const float lg = p.in[I_LNG][l * 256 + tid], lb = p.in[I_LNB][l * 256 + tid];
    for (int row = BID(); row < NTOK; row += gridDim.x) {
        const size_t o = (size_t)row * 256 + tid;
        const float y = YR[o];
        const float mean = wave_sum(y) * (1.f / 64.f);
        const float d = y - mean;
        const float var = wave_sum(d * d) * (1.f / 64.f);
        const float yn = d * rsqrtf(var + 64e-5f) * lg + lb;
        const float outv = (yn + BON[(size_t)row * 4 + (tid >> 6)] * bf2f(RV[o])) * bf2f(RG[o]);
        mix[(size_t)row * 1024 + 256 + tid] = f2bf(outv);
    }
}

DEV void zero_mix_cols(const Params& p, int c0, int ncols) {
    u16* mix = (u16*)(p.ws + OFF_MIX);
    const int per = ncols / 8;
    const size_t total = (size_t)NTOK * per;
    for (size_t i = (size_t)BID() * 256 + TID(); i < total; i += (size_t)gridDim.x * 256) {
        const size_t row = i / per; const int cc = (int)(i % per);
        *(u32x4*)(mix + row * 1024 + c0 + cc * 8) = (u32x4){0u, 0u, 0u, 0u};
    }
}


DEV void attend_block(const u16* __restrict__ Kb, const u16* __restrict__ VTb, int keybase, int tcol, int lowcol, bf16x8 q0, bf16x8 q1,
                      float& m, float& l, f32x4 (&O)[4], int q4, int cidx) {
    f32x4 st[4];
#pragma unroll
    for (int kt = 0; kt < 4; ++kt) {
        const u16* kp = Kb + (kt * 16 + cidx) * 64 + 8 * q4;
        const bf16x8 a0 = ld8(kp), a1 = ld8(kp + 32);
        st[kt] = mfma16(a0, q0, (f32x4){0.f, 0.f, 0.f, 0.f});
        st[kt] = mfma16(a1, q1, st[kt]);
    }
    float lmax = -1e30f;
#pragma unroll
    for (int kt = 0; kt < 4; ++kt)
#pragma unroll
        for (int r = 0; r < 4; ++r) {
            const int key = keybase + kt * 16 + 4 * q4 + r;
            const bool valid = (key <= tcol) && (key > lowcol);
            const float s = valid ? st[kt][r] : -1e30f;
            st[kt][r] = s; lmax = fmaxf(lmax, s);
        }
    lmax = colmax(lmax);
    const float mnew = fmaxf(m, lmax);
    const float alpha = __expf(m - mnew);
    float psum = 0.f;
#pragma unroll
    for (int kt = 0; kt < 4; ++kt)
#pragma unroll
        for (int r = 0; r < 4; ++r) {
            const float pv = (st[kt][r] > -1e29f) ? __expf(st[kt][r] - mnew) : 0.f;
            st[kt][r] = pv; psum += pv;
        }
    l = l * alpha + psum; m = mnew;
#pragma unroll
    for (int mt = 0; mt < 4; ++mt) { O[mt][0] *= alpha; O[mt][1] *= alpha; O[mt][2] *= alpha; O[mt][3] *= alpha; }
#pragma unroll
    for (int kb = 0; kb < 2; ++kb) {
        union { bf16x8 v; unsigned u[4]; } pb;
        pb.u[0] = pack2(st[2 * kb][0], st[2 * kb][1]); pb.u[1] = pack2(st[2 * kb][2], st[2 * kb][3]);
        pb.u[2] = pack2(st[2 * kb + 1][0], st[2 * kb + 1][1]); pb.u[3] = pack2(st[2 * kb + 1][2], st[2 * kb + 1][3]);
#pragma unroll
        for (int mt = 0; mt < 4; ++mt) {
            const bf16x8 av = ld8(VTb + (size_t)(16 * mt + cidx) * 8192 + kb * 32 + 8 * q4);
            O[mt] = mfma16(av, pb.v, O[mt]);
        }
    }
}

DEV void nsa_task(const Params& p, int task, float* impA, float* impB) {
    unsigned char* ws = p.ws;
    const u16* Q = (const u16*)(ws + OFF_Q);
    const u16* KVb = (const u16*)(ws + OFF_KV);
    const u16 *KSEL = KVb + (size_t)2 * 4194304, *VSELT = KVb + (size_t)3 * 4194304, *KWIN = KVb + (size_t)4 * 4194304, *VWINT = KVb + (size_t)5 * 4194304;
    const u16* KC = (const u16*)(ws + OFF_KC); const u16* VCT = (const u16*)(ws + OFF_VCT);
    const float* GATE = (const float*)(ws + OFF_GATE);
    u16* mix = (u16*)(ws + OFF_MIX);
    const int lane = TID() & 63, q4 = lane >> 4, cidx = lane & 15;
    const int bg = task >> 11, t0 = (task & 2047) * 4; const int b = bg >> 1, g = bg & 1;
    const int tokl = cidx >> 2, hr = cidx & 3; const int tcol = t0 + tokl;
    const int rowc = b * 8192 + tcol; const int head = g * 4 + hr;
    const int cur = t0 >> 6;
    const bf16x8 qf0 = ld8(Q + (size_t)rowc * 512 + head * 64 + 8 * q4), qf1 = ld8(Q + (size_t)rowc * 512 + head * 64 + 32 + 8 * q4);
    f32x4 outacc[4];
#pragma unroll
    for (int mt = 0; mt < 4; ++mt) outacc[mt] = (f32x4){0.f, 0.f, 0.f, 0.f};
    const float gc = GATE[(size_t)rowc * 24 + head], gs = GATE[(size_t)rowc * 24 + 8 + head], gwn = GATE[(size_t)rowc * 24 + 16 + head];

#if EN_NSA_CMP
    {
        const int cnt_col = tcol >= 31 ? ((tcol - 31) >> 4) + 1 : 0;
        const int tmax = t0 + 3; const int cmax = tmax >= 31 ? ((tmax - 31) >> 4) + 1 : 0;
        const int ntile = (cmax + 15) >> 4;
        const u16* kcb = KC + (size_t)bg * 512 * 64;
        float ml = -1e30f, ll = 0.f;
#pragma unroll 1
        for (int kt = 0; kt < ntile; ++kt) {
            const u16* kp = kcb + (kt * 16 + cidx) * 64 + 8 * q4;
            f32x4 st = mfma16(ld8(kp), qf0, (f32x4){0.f, 0.f, 0.f, 0.f});
            st = mfma16(ld8(kp + 32), qf1, st);
            float s[4]; float tm = -1e30f;
#pragma unroll
            for (int r = 0; r < 4; ++r) { const int n = kt * 16 + 4 * q4 + r; s[r] = (n < cnt_col) ? st[r] : -1e30f; tm = fmaxf(tm, s[r]); }
            const float mn = fmaxf(ml, tm);
            float ps = 0.f;
#pragma unroll
            for (int r = 0; r < 4; ++r) ps += (s[r] > -1e29f) ? __expf(s[r] - mn) : 0.f;
            ll = ll * __expf(ml - mn) + ps; ml = mn;
        }
        const float m = colmax(ml);
        float lsum = ll * __expf(ml - m);
        lsum = colsum(lsum);
        const float inv = (cnt_col > 0) ? 1.f / lsum : 0.f;
        f32x4 Oc[4];
#pragma unroll
        for (int mt = 0; mt < 4; ++mt) Oc[mt] = (f32x4){0.f, 0.f, 0.f, 0.f};
        const int npair = (ntile + 1) >> 1;
#pragma unroll 1
        for (int kp2 = 0; kp2 < npair; ++kp2) {
            const int n0 = kp2 * 32;
            float pa[4], pb_[4];
            {
                const u16* kp = kcb + (n0 + cidx) * 64 + 8 * q4;
                f32x4 st = mfma16(ld8(kp), qf0, (f32x4){0.f, 0.f, 0.f, 0.f});
                st = mfma16(ld8(kp + 32), qf1, st);
#pragma unroll
                for (int r = 0; r < 4; ++r) { const int n = n0 + 4 * q4 + r; pa[r] = (n < cnt_col) ? __expf(st[r] - m) * inv : 0.f; }
                const u16* kpb = kp + 16 * 64;
                f32x4 su = mfma16(ld8(kpb), qf0, (f32x4){0.f, 0.f, 0.f, 0.f});
                su = mfma16(ld8(kpb + 32), qf1, su);
#pragma unroll
                for (int r = 0; r < 4; ++r) { const int n = n0 + 16 + 4 * q4 + r; pb_[r] = (n < cnt_col) ? __expf(su[r] - m) * inv : 0.f; }
            }
            {
                const float owna = quadsum(pa[0] + pa[1] + pa[2] + pa[3]), tha = quadsum(pa[3]);
                const float ownb = quadsum(pb_[0] + pb_[1] + pb_[2] + pb_[3]), thb = quadsum(pb_[3]);
                if (hr == 0) {
                    const int sa = (n0 >> 2) + q4, sb2 = ((n0 + 16) >> 2) + q4;
                    impA[tokl * 128 + sa] = owna; impB[tokl * 132 + sa + 1] = tha;
                    impA[tokl * 128 + sb2] = ownb; impB[tokl * 132 + sb2 + 1] = thb;
                }
            }
            union { bf16x8 v; unsigned u[4]; } pk;
            pk.u[0] = pack2(pa[0], pa[1]); pk.u[1] = pack2(pa[2], pa[3]); pk.u[2] = pack2(pb_[0], pb_[1]); pk.u[3] = pack2(pb_[2], pb_[3]);
#pragma unroll
            for (int mt = 0; mt < 4; ++mt) {
                const bf16x8 av = ld8(VCT + ((size_t)bg * 64 + 16 * mt + cidx) * 512 + n0 + 8 * q4);
                Oc[mt] = mfma16(av, pk.v, Oc[mt]);
            }
        }
#pragma unroll
        for (int mt = 0; mt < 4; ++mt)
#pragma unroll
            for (int r = 0; r < 4; ++r) outacc[mt][r] += gc * Oc[mt][r];
    }
#endif

#if EN_NSA_WIN
    {
        float m = -1e30f, l = 0.f; f32x4 Ow[4];
#pragma unroll
        for (int mt = 0; mt < 4; ++mt) Ow[mt] = (f32x4){0.f, 0.f, 0.f, 0.f};
        int wb0 = (t0 - 511) >> 6; if (wb0 < 0) wb0 = 0;
#pragma unroll 1
        for (int blk = wb0; blk <= cur; ++blk)
            attend_block(KWIN + ((size_t)bg * 8192 + blk * 64) * 64, VWINT + (size_t)bg * 64 * 8192 + blk * 64, blk * 64, tcol, tcol - 512, qf0, qf1, m, l, Ow, q4, cidx);
        l = colsum(l);
        const float sc = gwn / l;
#pragma unroll
        for (int mt = 0; mt < 4; ++mt)
#pragma unroll
            for (int r = 0; r < 4; ++r) outacc[mt][r] += sc * Ow[mt][r];
    }
#endif

#if EN_NSA_SEL
    {
        lds_fence();
        int mysel;
        if (cur < 16) mysel = (cidx <= cur) ? cidx : -1;
        else {
            unsigned key[8];
#pragma unroll
            for (int i = 0; i < 8; ++i) {
                const int s = cidx + 16 * i;
                const bool cand = (s >= 1) && (s <= cur - 2);
                const float v = impA[q4 * 128 + s] + impB[q4 * 132 + s];
                key[i] = cand ? ((__float_as_uint(v) & ~0x7Fu) | (unsigned)(127 - s)) : 0u;
            }
            mysel = (cidx == 0) ? 0 : (cidx == 1 ? cur - 1 : (cidx == 2 ? cur : -1));
#pragma unroll 1
            for (int it = 0; it < 13; ++it) {
                unsigned mx = key[0];
#pragma unroll
                for (int i = 1; i < 8; ++i) mx = max(mx, key[i]);
                mx = max(mx, dppu<0xB1>(mx)); mx = max(mx, dppu<0x4E>(mx)); mx = max(mx, dppu<0x124>(mx)); mx = max(mx, dppu<0x128>(mx));
                const int s = 127 - (int)(mx & 127u);
#pragma unroll
                for (int i = 0; i < 8; ++i) key[i] = (key[i] == mx) ? 0u : key[i];
                if (cidx == it + 3) mysel = s;
            }
        }
        lds_fence();
#pragma unroll 1
        for (int tk = 0; tk < 4; ++tk) {
            const int tq = t0 + tk; const int rowq = b * 8192 + tq;
            const bf16x8 qs0 = ld8(Q + (size_t)rowq * 512 + head * 64 + 8 * q4), qs1 = ld8(Q + (size_t)rowq * 512 + head * 64 + 32 + 8 * q4);
            float m = -1e30f, l = 0.f; f32x4 Os[4];
#pragma unroll
            for (int mt = 0; mt < 4; ++mt) Os[mt] = (f32x4){0.f, 0.f, 0.f, 0.f};
#pragma unroll 1
            for (int i = 0; i < 16; ++i) {
                const int blk = __builtin_amdgcn_readlane(mysel, tk * 16 + i);
                if (blk < 0) continue;
                attend_block(KSEL + ((size_t)bg * 8192 + blk * 64) * 64, VSELT + (size_t)bg * 64 * 8192 + blk * 64, blk * 64, tq, -1, qs0, qs1, m, l, Os, q4, cidx);
            }
            l = colsum(l);
            const float sc = (tokl == tk) ? gs / l : 0.f;
#pragma unroll
            for (int mt = 0; mt < 4; ++mt)
#pragma unroll
                for (int r = 0; r < 4; ++r) outacc[mt][r] += sc * Os[mt][r];
        }
    }
#endif
#pragma unroll
    for (int mt = 0; mt < 4; ++mt) {
        u32x2 w; w[0] = pack2(outacc[mt][0], outacc[mt][1]); w[1] = pack2(outacc[mt][2], outacc[mt][3]);
        *(u32x2*)(mix + (size_t)rowc * 1024 + 512 + head * 64 + 16 * mt + 4 * q4) = w;
    }
}


DEV void load_kv(const u16* __restrict__ Kb, const u16* __restrict__ VTb, int q4, int cidx, bf16x8 (&kf)[8], bf16x8 (&vf)[8]) {
#pragma unroll
    for (int kt = 0; kt < 4; ++kt) { const u16* kp = Kb + (kt * 16 + cidx) * 64 + 8 * q4; kf[2 * kt] = ld8(kp); kf[2 * kt + 1] = ld8(kp + 32); }
#pragma unroll
    for (int kb = 0; kb < 2; ++kb)
#pragma unroll
        for (int mt = 0; mt < 4; ++mt) vf[kb * 4 + mt] = ld8(VTb + (size_t)(16 * mt + cidx) * 8192 + kb * 32 + 8 * q4);
}
DEV void attend_tile(const bf16x8 (&kf)[8], const bf16x8 (&vf)[8], int keybase, int tcol, int lowcol, bool colsel, bf16x8 q0, bf16x8 q1,
                     float& m, float& l, f32x4 (&O)[4], int q4) {
    f32x4 st[4];
#pragma unroll
    for (int kt = 0; kt < 4; ++kt) {
        st[kt] = mfma16(kf[2 * kt], q0, (f32x4){0.f, 0.f, 0.f, 0.f});
        st[kt] = mfma16(kf[2 * kt + 1], q1, st[kt]);
    }
    float lmax = -1e30f;
    const int hi = colsel ? tcol : -1;
#pragma unroll
    for (int kt = 0; kt < 4; ++kt)
#pragma unroll
        for (int r = 0; r < 4; ++r) {
            const int key = keybase + kt * 16 + 4 * q4 + r;
            const bool valid = (key <= hi) && (key > lowcol);
            const float sv = valid ? st[kt][r] : -1e30f;
            st[kt][r] = sv; lmax = fmaxf(lmax, sv);
        }
    lmax = colmax(lmax);
    const float mnew = fmaxf(m, lmax);
    const float alpha = __expf(m - mnew);
    float psum = 0.f;
#pragma unroll
    for (int kt = 0; kt < 4; ++kt)
#pragma unroll
        for (int r = 0; r < 4; ++r) {
            const float pv = (st[kt][r] > -1e29f) ? __expf(st[kt][r] - mnew) : 0.f;
            st[kt][r] = pv; psum += pv;
        }
    l = l * alpha + psum; m = mnew;
#pragma unroll
    for (int mt = 0; mt < 4; ++mt) { O[mt][0] *= alpha; O[mt][1] *= alpha; O[mt][2] *= alpha; O[mt][3] *= alpha; }
#pragma unroll
    for (int kb = 0; kb < 2; ++kb) {
        union { bf16x8 v; unsigned u[4]; } pb;
        pb.u[0] = pack2(st[2 * kb][0], st[2 * kb][1]); pb.u[1] = pack2(st[2 * kb][2], st[2 * kb][3]);
        pb.u[2] = pack2(st[2 * kb + 1][0], st[2 * kb + 1][1]); pb.u[3] = pack2(st[2 * kb + 1][2], st[2 * kb + 1][3]);
#pragma unroll
        for (int mt = 0; mt < 4; ++mt) O[mt] = mfma16(vf[kb * 4 + mt], pb.v, O[mt]);
    }
}
template <int CTRL> DEV unsigned dpp_or(unsigned x) { return x | dppu<CTRL>(x); }
DEV unsigned row_or(unsigned x) { x = dpp_or<0xB1>(x); x = dpp_or<0x4E>(x); x = dpp_or<0x124>(x); x = dpp_or<0x128>(x); return x; }

DEV void nsa_task2(const Params& p, int task, float* wl) {
    float* impA = wl; float* impB = wl + 1024; unsigned* selmask = (unsigned*)(wl + 1024 + 1056);
    unsigned char* ws = p.ws;
    const u16* Q = (const u16*)(ws + OFF_Q);
    const u16* KVb = (const u16*)(ws + OFF_KV);
    const u16 *KSEL = KVb + (size_t)2 * 4194304, *VSELT = KVb + (size_t)3 * 4194304, *KWIN = KVb + (size_t)4 * 4194304, *VWINT = KVb + (size_t)5 * 4194304;
    const u16* KC = (const u16*)(ws + OFF_KC); const u16* VCT = (const u16*)(ws + OFF_VCT);
    const float* GATE = (const float*)(ws + OFF_GATE);
    u16* mix = (u16*)(ws + OFF_MIX);
    const int lane = TID() & 63, q4 = lane >> 4, cidx = lane & 15;
    const int bg = task >> 10, t0 = (task & 1023) * 8; const int b = bg >> 1, g = bg & 1;
    const int tokl = cidx >> 2, hr = cidx & 3; const int head = g * 4 + hr;
    const int cur = t0 >> 6;
    int tcol[2], rowc[2]; bf16x8 qf[2][2];
#pragma unroll
    for (int ti = 0; ti < 2; ++ti) {
        tcol[ti] = t0 + 4 * ti + tokl; rowc[ti] = b * 8192 + tcol[ti];
        qf[ti][0] = ld8(Q + (size_t)rowc[ti] * 512 + head * 64 + 8 * q4); qf[ti][1] = ld8(Q + (size_t)rowc[ti] * 512 + head * 64 + 32 + 8 * q4);
    }
    f32x4 Oc[2][4];
    {
        int cnt_col[2];
#pragma unroll
        for (int ti = 0; ti < 2; ++ti) cnt_col[ti] = tcol[ti] >= 31 ? ((tcol[ti] - 31) >> 4) + 1 : 0;
        const int tmax = t0 + 7; const int cmax = tmax >= 31 ? ((tmax - 31) >> 4) + 1 : 0;
        const int ntile = (cmax + 15) >> 4;
        const u16* kcb = KC + (size_t)bg * 512 * 64;
        float ml[2] = {-1e30f, -1e30f}, ll[2] = {0.f, 0.f};
#pragma unroll 1
        for (int kt = 0; kt < ntile; ++kt) {
            const u16* kp = kcb + (kt * 16 + cidx) * 64 + 8 * q4;
            const bf16x8 k0 = ld8(kp), k1 = ld8(kp + 32);
#pragma unroll
            for (int ti = 0; ti < 2; ++ti) {
                f32x4 st = mfma16(k0, qf[ti][0], (f32x4){0.f, 0.f, 0.f, 0.f});
                st = mfma16(k1, qf[ti][1], st);
                float sv[4]; float tm = -1e30f;
#pragma unroll
                for (int r = 0; r < 4; ++r) { const int n = kt * 16 + 4 * q4 + r; sv[r] = (n < cnt_col[ti]) ? st[r] : -1e30f; tm = fmaxf(tm, sv[r]); }
                const float mn = fmaxf(ml[ti], tm);
                float ps = 0.f;
#pragma unroll
                for (int r = 0; r < 4; ++r) ps += (sv[r] > -1e29f) ? __expf(sv[r] - mn) : 0.f;
                ll[ti] = ll[ti] * __expf(ml[ti] - mn) + ps; ml[ti] = mn;
            }
        }
        float mfin[2], inv[2];
#pragma unroll
        for (int ti = 0; ti < 2; ++ti) {
            mfin[ti] = colmax(ml[ti]);
            const float lsum = colsum(ll[ti] * __expf(ml[ti] - mfin[ti]));
            inv[ti] = (cnt_col[ti] > 0) ? 1.f / lsum : 0.f;
        }
#pragma unroll
        for (int ti = 0; ti < 2; ++ti)
#pragma unroll
            for (int mt = 0; mt < 4; ++mt) Oc[ti][mt] = (f32x4){0.f, 0.f, 0.f, 0.f};
        const int npair = (ntile + 1) >> 1;
#pragma unroll 1
        for (int kp2 = 0; kp2 < npair; ++kp2) {
            const int n0 = kp2 * 32;
            const u16* kp = kcb + (n0 + cidx) * 64 + 8 * q4;
            const bf16x8 ka0 = ld8(kp), ka1 = ld8(kp + 32), kb0 = ld8(kp + 1024), kb1 = ld8(kp + 1024 + 32);
            bf16x8 vf[4];
#pragma unroll
            for (int mt = 0; mt < 4; ++mt) vf[mt] = ld8(VCT + ((size_t)bg * 64 + 16 * mt + cidx) * 512 + n0 + 8 * q4);
#pragma unroll
            for (int ti = 0; ti < 2; ++ti) {
                float pa[4], pb_[4];
                f32x4 st = mfma16(ka0, qf[ti][0], (f32x4){0.f, 0.f, 0.f, 0.f});
                st = mfma16(ka1, qf[ti][1], st);
                f32x4 su = mfma16(kb0, qf[ti][0], (f32x4){0.f, 0.f, 0.f, 0.f});
                su = mfma16(kb1, qf[ti][1], su);
#pragma unroll
                for (int r = 0; r < 4; ++r) {
                    const int n = n0 + 4 * q4 + r;
                    pa[r] = (n < cnt_col[ti]) ? __expf(st[r] - mfin[ti]) * inv[ti] : 0.f;
                    pb_[r] = (n + 16 < cnt_col[ti]) ? __expf(su[r] - mfin[ti]) * inv[ti] : 0.f;
                }
                const float owna = quadsum(pa[0] + pa[1] + pa[2] + pa[3]), tha = quadsum(pa[3]);
                const float ownb = quadsum(pb_[0] + pb_[1] + pb_[2] + pb_[3]), thb = quadsum(pb_[3]);
                if (hr == 0) {
                    const int tk = 4 * ti + tokl;
                    const int sa = (n0 >> 2) + q4, sb2 = ((n0 + 16) >> 2) + q4;
                    impA[tk * 128 + sa] = owna; impB[tk * 132 + sa + 1] = tha;
                    impA[tk * 128 + sb2] = ownb; impB[tk * 132 + sb2 + 1] = thb;
                }
                union { bf16x8 v; unsigned u[4]; } pk;
                pk.u[0] = pack2(pa[0], pa[1]); pk.u[1] = pack2(pa[2], pa[3]); pk.u[2] = pack2(pb_[0], pb_[1]); pk.u[3] = pack2(pb_[2], pb_[3]);
#pragma unroll
                for (int mt = 0; mt < 4; ++mt) Oc[ti][mt] = mfma16(vf[mt], pk.v, Oc[ti][mt]);
            }
        }
#pragma unroll
        for (int ti = 0; ti < 2; ++ti) {
            const float gc = GATE[(size_t)rowc[ti] * 24 + head];
#pragma unroll
            for (int mt = 0; mt < 4; ++mt)
#pragma unroll
                for (int r = 0; r < 4; ++r) Oc[ti][mt][r] *= gc;
        }
    }
    lds_fence();
#pragma unroll 1
    for (int rd = 0; rd < 2; ++rd) {
        const int tk = 4 * rd + q4;
        unsigned m0 = 0u, m1 = 0u, m2 = 0u, m3 = 0u;
        if (cur < 16) { m0 = (2u << cur) - 1u; }
        else {
            unsigned key[8];
#pragma unroll
            for (int i = 0; i < 8; ++i) {
                const int sblk = cidx + 16 * i;
                const bool cand = (sblk >= 1) && (sblk <= cur - 2);
                const float v = impA[tk * 128 + sblk] + impB[tk * 132 + sblk];
                key[i] = cand ? ((__float_as_uint(v) & ~0x7Fu) | (unsigned)(127 - sblk)) : 0u;
            }
            int mysel = (cidx == 0) ? 0 : (cidx == 1 ? cur - 1 : (cidx == 2 ? cur : -1));
#pragma unroll 1
            for (int it = 0; it < 13; ++it) {
                unsigned mx = key[0];
#pragma unroll
                for (int i = 1; i < 8; ++i) mx = max(mx, key[i]);
                mx = max(mx, dppu<0xB1>(mx)); mx = max(mx, dppu<0x4E>(mx)); mx = max(mx, dppu<0x124>(mx)); mx = max(mx, dppu<0x128>(mx));
                const int sblk = 127 - (int)(mx & 127u);
#pragma unroll
                for (int i = 0; i < 8; ++i) key[i] = (key[i] == mx) ? 0u : key[i];
                if (cidx == it + 3) mysel = sblk;
            }
            const unsigned bit = 1u << (mysel & 31); const int wsel = mysel >> 5;
            m0 = row_or(wsel == 0 ? bit : 0u); m1 = row_or(wsel == 1 ? bit : 0u); m2 = row_or(wsel == 2 ? bit : 0u); m3 = row_or(wsel == 3 ? bit : 0u);
        }
        if (cidx < 4) selmask[tk * 4 + cidx] = (cidx == 0) ? m0 : (cidx == 1 ? m1 : (cidx == 2 ? m2 : m3));
    }
    lds_fence();
    f32x4* accl = (f32x4*)wl;
#pragma unroll
    for (int ti = 0; ti < 2; ++ti)
#pragma unroll
        for (int mt = 0; mt < 4; ++mt) accl[(ti * 4 + mt) * 64 + lane] = Oc[ti][mt];
    {
        float m[2] = {-1e30f, -1e30f}, l[2] = {0.f, 0.f}; f32x4 Os[2][4];
#pragma unroll
        for (int ti = 0; ti < 2; ++ti)
#pragma unroll
            for (int mt = 0; mt < 4; ++mt) Os[ti][mt] = (f32x4){0.f, 0.f, 0.f, 0.f};
#pragma unroll 1
        for (int w = 0; w < 4; ++w) {
            const unsigned c0 = selmask[tokl * 4 + w], c1 = selmask[(4 + tokl) * 4 + w];
            unsigned u0 = row_or(c0), u1 = row_or(c1);
            u0 = __builtin_amdgcn_readfirstlane(u0); u1 = __builtin_amdgcn_readfirstlane(u1);
            unsigned bits = u0 | u1;
            while (bits) {
                const int jb = __builtin_ctz(bits); bits &= bits - 1u;
                const int blk = w * 32 + jb;
                bf16x8 kf[8], vf[8];
                load_kv(KSEL + ((size_t)bg * 8192 + blk * 64) * 64, VSELT + (size_t)bg * 64 * 8192 + blk * 64, q4, cidx, kf, vf);
                if ((u0 >> jb) & 1u) attend_tile(kf, vf, blk * 64, tcol[0], -1, ((c0 >> jb) & 1u) != 0u, qf[0][0], qf[0][1], m[0], l[0], Os[0], q4);
                if ((u1 >> jb) & 1u) attend_tile(kf, vf, blk * 64, tcol[1], -1, ((c1 >> jb) & 1u) != 0u, qf[1][0], qf[1][1], m[1], l[1], Os[1], q4);
            }
        }
#pragma unroll
        for (int ti = 0; ti < 2; ++ti) {
            const float sc = GATE[(size_t)rowc[ti] * 24 + 8 + head] / colsum(l[ti]);
#pragma unroll
            for (int mt = 0; mt < 4; ++mt)
#pragma unroll
                for (int r = 0; r < 4; ++r) Os[ti][mt][r] *= sc;
        }
        lds_fence();
#pragma unroll
        for (int ti = 0; ti < 2; ++ti)
#pragma unroll
            for (int mt = 0; mt < 4; ++mt) { f32x4 a = accl[(ti * 4 + mt) * 64 + lane]; a += Os[ti][mt]; accl[(ti * 4 + mt) * 64 + lane] = a; }
    }
    {
        float m[2] = {-1e30f, -1e30f}, l[2] = {0.f, 0.f}; f32x4 Ow[2][4];
#pragma unroll
        for (int ti = 0; ti < 2; ++ti)
#pragma unroll
            for (int mt = 0; mt < 4; ++mt) Ow[ti][mt] = (f32x4){0.f, 0.f, 0.f, 0.f};
        int wb0 = (t0 - 511) >> 6; if (wb0 < 0) wb0 = 0;
#pragma unroll 1
        for (int blk = wb0; blk <= cur; ++blk) {
            bf16x8 kf[8], vf[8];
            load_kv(KWIN + ((size_t)bg * 8192 + blk * 64) * 64, VWINT + (size_t)bg * 64 * 8192 + blk * 64, q4, cidx, kf, vf);
#pragma unroll
            for (int ti = 0; ti < 2; ++ti) attend_tile(kf, vf, blk * 64, tcol[ti], tcol[ti] - 512, true, qf[ti][0], qf[ti][1], m[ti], l[ti], Ow[ti], q4);
        }
#pragma unroll
        for (int ti = 0; ti < 2; ++ti) {
            const float sc = GATE[(size_t)rowc[ti] * 24 + 16 + head] / colsum(l[ti]);
#pragma unroll
            for (int mt = 0; mt < 4; ++mt)
#pragma unroll
                for (int r = 0; r < 4; ++r) Ow[ti][mt][r] *= sc;
        }
        lds_fence();
#pragma unroll
        for (int ti = 0; ti < 2; ++ti)
#pragma unroll
            for (int mt = 0; mt < 4; ++mt) {
                const f32x4 a = accl[(ti * 4 + mt) * 64 + lane];
                const f32x4 o = Ow[ti][mt];
                u32x2 wv; wv[0] = pack2(a[0] + o[0], a[1] + o[1]); wv[1] = pack2(a[2] + o[2], a[3] + o[3]);
                *(u32x2*)(mix + (size_t)rowc[ti] * 1024 + 512 + head * 64 + 16 * mt + 4 * q4) = wv;
            }
    }


    lds_fence();
}

DEV unsigned sortable(float f) { const unsigned b = __float_as_uint(f); return (b & 0x80000000u) ? ~b : (b | 0x80000000u); }
DEV float unsortable(unsigned u) { return __uint_as_float((u & 0x80000000u) ? (u ^ 0x80000000u) : ~u); }
template <int N> DEV unsigned kth16_threshold(const unsigned (&u)[N]) {
    unsigned T = 0;
    for (int bit = 31; bit >= 0; --bit) {
        const unsigned cand = T | (1u << bit);
        int cnt = 0;
#pragma unroll
        for (int i = 0; i < N; ++i) cnt += (u[i] >= cand) ? 1 : 0;
        cnt = colsumi(cnt);
        if (cnt >= 16) T = cand;
    }
    return T;
}
template <int N, class F> DEV void compact16(const unsigned (&u)[N], unsigned T, int q4, int cidx, F emit) {
    int cgt = 0, ceq = 0;
#pragma unroll
    for (int i = 0; i < N; ++i) { cgt += (u[i] > T) ? 1 : 0; ceq += (u[i] == T) ? 1 : 0; }
    const int g0 = __shfl(cgt, cidx), g1 = __shfl(cgt, cidx + 16), g2 = __shfl(cgt, cidx + 32), g3 = __shfl(cgt, cidx + 48);
    const int e0 = __shfl(ceq, cidx), e1 = __shfl(ceq, cidx + 16), e2 = __shfl(ceq, cidx + 32);
    int pg = (q4 > 0 ? g0 : 0) + (q4 > 1 ? g1 : 0) + (q4 > 2 ? g2 : 0);
    int pe = g0 + g1 + g2 + g3 + (q4 > 0 ? e0 : 0) + (q4 > 1 ? e1 : 0) + (q4 > 2 ? e2 : 0);
#pragma unroll
    for (int i = 0; i < N; ++i) {
        if (u[i] > T) { emit(i, pg); ++pg; }
        else if (u[i] == T) { if (pe < 16) emit(i, pe); ++pe; }
    }
}

DEV void peer_topk_task(const Params& p, int l, int task, float* wl) {
    unsigned char* ws = p.ws;
    const u16* QP = (const u16*)(ws + OFF_QP);
    const u16* K12 = (const u16*)(ws + OFF_K12) + (size_t)l * 2 * 16384;
    int* PIDX = (int*)(ws + OFF_PIDX); float* PGW = (float*)(ws + OFF_PGW);
    const int lane = TID() & 63, q4 = lane >> 4, cidx = lane & 15;
    const int tq = task * 2 + (cidx >> 3), hh = cidx & 7;
    float* vv[2] = {wl, wl + 512}; int* ii[2] = {(int*)(wl + 256), (int*)(wl + 768)};
    float* fs = wl + 1024; int* fi = (int*)(wl + 1280);
#pragma unroll
    for (int hf = 0; hf < 2; ++hf) {
        bf16x8 qf[4];
#pragma unroll
        for (int s = 0; s < 4; ++s) qf[s] = ld8(QP + (size_t)tq * 2048 + hh * 256 + hf * 128 + 32 * s + 8 * q4);
        unsigned u[32];
        const u16* kb = K12 + hf * 16384;
#pragma unroll
        for (int kt = 0; kt < 8; ++kt) {
            f32x4 st = (f32x4){0.f, 0.f, 0.f, 0.f};
#pragma unroll
            for (int s = 0; s < 4; ++s) st = mfma16(ld8(kb + (kt * 16 + cidx) * 128 + 32 * s + 8 * q4), qf[s], st);
#pragma unroll
            for (int r = 0; r < 4; ++r) u[kt * 4 + r] = sortable(st[r]);
        }
        const unsigned T = kth16_threshold<32>(u);
        float* vo = vv[hf]; int* io = ii[hf];
        compact16<32>(u, T, q4, cidx, [&](int i, int pos) { vo[cidx * 16 + pos] = unsortable(u[i]); io[cidx * 16 + pos] = 16 * (i >> 2) + 4 * q4 + (i & 3); });
    }
    lds_fence();
    {
        unsigned u[64];
        float v2r[16];
#pragma unroll
        for (int j = 0; j < 16; ++j) v2r[j] = vv[1][cidx * 16 + j];
#pragma unroll
        for (int a = 0; a < 4; ++a) {
            const float v1a = vv[0][cidx * 16 + 4 * q4 + a];
#pragma unroll
            for (int j = 0; j < 16; ++j) u[a * 16 + j] = sortable(v1a + v2r[j]);
        }
        const unsigned T = kth16_threshold<64>(u);
        compact16<64>(u, T, q4, cidx, [&](int i, int pos) { fs[cidx * 16 + pos] = unsortable(u[i]); fi[cidx * 16 + pos] = (4 * q4 + (i >> 4)) * 16 + (i & 15); });
    }
    lds_fence();
    {
        float s4[4]; int c4[4];
#pragma unroll
        for (int k = 0; k < 4; ++k) { s4[k] = fs[cidx * 16 + 4 * q4 + k]; c4[k] = fi[cidx * 16 + 4 * q4 + k]; }
        float mx = fmaxf(fmaxf(s4[0], s4[1]), fmaxf(s4[2], s4[3]));
        mx = colmax(mx);
        float e4[4]; float sm = 0.f;
#pragma unroll
        for (int k = 0; k < 4; ++k) { e4[k] = __expf(s4[k] - mx); sm += e4[k]; }
        sm = colsum(sm);
        const float inv = 1.f / sm;
        int4 eo; float4 go;
        eo.x = ii[0][cidx * 16 + (c4[0] >> 4)] * 128 + ii[1][cidx * 16 + (c4[0] & 15)];
        eo.y = ii[0][cidx * 16 + (c4[1] >> 4)] * 128 + ii[1][cidx * 16 + (c4[1] & 15)];
        eo.z = ii[0][cidx * 16 + (c4[2] >> 4)] * 128 + ii[1][cidx * 16 + (c4[2] & 15)];
        eo.w = ii[0][cidx * 16 + (c4[3] >> 4)] * 128 + ii[1][cidx * 16 + (c4[3] & 15)];
        go.x = e4[0] * inv; go.y = e4[1] * inv; go.z = e4[2] * inv; go.w = e4[3] * inv;
        const size_t o = ((size_t)tq * 8 + hh) * 16 + 4 * q4;
        *(int4*)(PIDX + o) = eo; *(float4*)(PGW + o) = go;
    }
    lds_fence();
}

DEV float gelu_exact(float x) { return 0.5f * x * (1.f + erff(x * 0.70710678118654752f)); }
DEV void unpack8(const bf16x8 v, float* f) {
    union { bf16x8 v; unsigned u[4]; } c; c.v = v;
#pragma unroll
    for (int i = 0; i < 4; ++i) { f[2 * i] = bflo(c.u[i]); f[2 * i + 1] = bfhi(c.u[i]); }
}
DEV void phase_peer_experts(const Params& p, int l) {
    unsigned char* ws = p.ws;
    const u16* H = (const u16*)(ws + OFF_H);
    u16* Hw = (u16*)(ws + OFF_H);
    const unsigned char* U8 = ws + OFF_U8 + (size_t)(l * 2 + 0) * 16 * MiB;
    const unsigned char* V8 = ws + OFF_U8 + (size_t)(l * 2 + 1) * 16 * MiB;
    const float* SU = (const float*)(ws + OFF_UVS) + (l * 2 + 0) * 16384;
    const float* SV = (const float*)(ws + OFF_UVS) + (l * 2 + 1) * 16384;
    const int* PIDX = (const int*)(ws + OFF_PIDX); const float* PGW = (const float*)(ws + OFF_PGW);
    const float* mod = (const float*)(ws + OFF_MOD);
    const float* g2 = mod + l * 4 * 6144 + 5 * 1024;
    const int lane = TID() & 63;
    const int gw = BID() * 4 + (TID() >> 6), nw = gridDim.x * 4;
    for (int tok = gw; tok < NTOK; tok += nw) {
        const int b = tok >> 13;
        float acc[16];
#pragma unroll
        for (int i = 0; i < 16; ++i) acc[i] = 0.f;
#if EN_PEER
        float hx[16];
        unpack8(ld8(H + (size_t)tok * 1024 + 16 * lane), hx);
        unpack8(ld8(H + (size_t)tok * 1024 + 16 * lane + 8), hx + 8);
        float hs = 0.f;
#pragma unroll
        for (int i = 0; i < 16; ++i) hs += hx[i];
        const float hs128 = 128.f * hs;
        float corr = 0.f;
#pragma unroll 1
        for (int hh = 0; hh < 8; ++hh) {
            const int el = PIDX[((size_t)tok * 8 + hh) * 16 + (lane & 15)];
            const float wgt = PGW[((size_t)tok * 8 + hh) * 16 + (lane & 15)];
#pragma unroll 1
            for (int k0 = 0; k0 < 16; k0 += 8) {
                u32x4 uq[8], vq[8]; float wk[8], su[8];
#pragma unroll
                for (int k = 0; k < 8; ++k) {
                    const int e = __builtin_amdgcn_readlane(el, k0 + k);
                    wk[k] = __int_as_float(__builtin_amdgcn_readlane(__float_as_int(wgt), k0 + k)) * SV[e];
                    su[k] = SU[e];
                    uq[k] = *(const u32x4*)(U8 + (size_t)e * 1024 + 16 * lane);
                    vq[k] = *(const u32x4*)(V8 + (size_t)e * 1024 + 16 * lane);
                }
#pragma unroll
                for (int k = 0; k < 8; ++k) {
                    float d = -hs128;
#pragma unroll
                    for (int i = 0; i < 4; ++i) {
                        const unsigned w = uq[k][i];
                        d += (float)(w & 0xffu) * hx[4 * i] + (float)((w >> 8) & 0xffu) * hx[4 * i + 1] + (float)((w >> 16) & 0xffu) * hx[4 * i + 2] + (float)(w >> 24) * hx[4 * i + 3];
                    }
                    d = wave_sum(d) * su[k];
                    const float act = gelu_exact(d) * wk[k];
                    corr += act * 128.f;
#pragma unroll
                    for (int i = 0; i < 4; ++i) {
                        const unsigned w = vq[k][i];
                        acc[4 * i] += act * (float)(w & 0xffu); acc[4 * i + 1] += act * (float)((w >> 8) & 0xffu);
                        acc[4 * i + 2] += act * (float)((w >> 16) & 0xffu); acc[4 * i + 3] += act * (float)(w >> 24);
                    }
                }
            }
        }
#pragma unroll
        for (int i = 0; i < 16; ++i) acc[i] -= corr;
#endif
        const int k = 16 * lane;
        float xn[16]; float ss = 0.f;
#pragma unroll
        for (int i = 0; i < 4; ++i) {
            const float4 x0 = *(const float4*)(p.out + (size_t)tok * 1024 + k + 4 * i);
            const float4 ga = *(const float4*)(g2 + b * 6144 + k + 4 * i);
            xn[4 * i] = x0.x + ga.x * acc[4 * i]; xn[4 * i + 1] = x0.y + ga.y * acc[4 * i + 1];
            xn[4 * i + 2] = x0.z + ga.z * acc[4 * i + 2]; xn[4 * i + 3] = x0.w + ga.w * acc[4 * i + 3];
        }
#pragma unroll
        for (int i = 0; i < 16; ++i) ss += xn[i] * xn[i];
        ss = wave_sum(ss);
        const float rs = rsqrtf(ss * (1.f / 1024.f) + 1e-6f);
        if (l == 0) {
            const float* n1g = p.in[I_N1G] + 1024; const float* sh = mod + 4 * 6144 + b * 6144; const float* sc = sh + 1024;
            float hv[16];
#pragma unroll
            for (int i = 0; i < 4; ++i) {
                *(float4*)(p.out + (size_t)tok * 1024 + k + 4 * i) = (float4){xn[4 * i], xn[4 * i + 1], xn[4 * i + 2], xn[4 * i + 3]};
                const float4 gg = *(const float4*)(n1g + k + 4 * i), s1 = *(const float4*)(sc + k + 4 * i), s0 = *(const float4*)(sh + k + 4 * i);
                hv[4 * i] = xn[4 * i] * rs * gg.x * (1.f + s1.x) + s0.x; hv[4 * i + 1] = xn[4 * i + 1] * rs * gg.y * (1.f + s1.y) + s0.y;
                hv[4 * i + 2] = xn[4 * i + 2] * rs * gg.z * (1.f + s1.z) + s0.z; hv[4 * i + 3] = xn[4 * i + 3] * rs * gg.w * (1.f + s1.w) + s0.w;
            }
            u32x4 w0, w1;
#pragma unroll
            for (int i = 0; i < 4; ++i) { w0[i] = pack2(hv[2 * i], hv[2 * i + 1]); w1[i] = pack2(hv[8 + 2 * i], hv[8 + 2 * i + 1]); }
            *(u32x4*)(Hw + (size_t)tok * 1024 + k) = w0; *(u32x4*)(Hw + (size_t)tok * 1024 + k + 8) = w1;
        } else {
            const float* fg = p.in[I_FG];
#pragma unroll
            for (int i = 0; i < 4; ++i) {
                const float4 gg = *(const float4*)(fg + k + 4 * i);
                *(float4*)(p.out + (size_t)tok * 1024 + k + 4 * i) = (float4){xn[4 * i] * rs * gg.x, xn[4 * i + 1] * rs * gg.y, xn[4 * i + 2] * rs * gg.z, xn[4 * i + 3] * rs * gg.w};
            }
        }
    }
}

constexpr int NPH = 20;

__global__ void __launch_bounds__(256, 2) mega(Params p) {
    __shared__ __attribute__((aligned(16))) unsigned char lds[65536];
    __shared__ int misc[8];
    int* qslot = misc;
    cg::grid_group grid = cg::this_grid();
    if (threadIdx.x < 8) misc[threadIdx.x] = 0;
    __syncthreads();
    XcdBarrier xbar = xcd_barrier_post((unsigned*)(p.ws + OFF_BAR), (volatile unsigned*)(misc + 4));
    unsigned char* ws = p.ws;
    const float* mod = (const float*)(ws + OFF_MOD);
    unsigned* ctl = (unsigned*)(ws + OFF_CTL);
    const int G = gridDim.x, bx = BID();
    for (int ph = p.ph_lo; ph < p.ph_hi; ++ph) {
        if (ph == 0) {
            phase_prep(p, lds);
        } else if (ph == 1) {
            phase_norm(p.in[I_X], p.in[I_N1G], mod + 0 * 1024, mod + 1 * 1024, (u16*)(ws + OFF_H));
        } else {
            const int l = (ph - 2) / 9, sp = (ph - 2) % 9;
            const float* modl = mod + l * 4 * 6144;
            if (sp == 0) {
                EpiInProj e{(u16*)(ws + OFF_PCONV), (u16*)(ws + OFF_PRWKV), (u16*)(ws + OFF_Q), (u16*)(ws + OFF_KV), (float*)(ws + OFF_GATE)};
                gemm_phase((const u16*)(ws + OFF_H), 1024, (const u16*)(ws + OFF_WIN) + (size_t)l * NINP * 1024, 1024, 256, 23, 1024, e, lds, bx, G);
            } else if (sp == 1) {
#if EN_NSA_CMP || EN_NSA_SEL
                {
                    const u16* KVb = (const u16*)(ws + OFF_KV);
                    EpiCompress ek{(const float*)(ws + OFF_CBP) + (l * 2 + 0) * 2048, p.in[I_CKW2] + (size_t)l * 8192, (u16*)(ws + OFF_KC), 0, lds};
                    gemm_phase(KVb, 1024, (const u16*)(ws + OFF_CW1) + (size_t)(l * 2 + 0) * 128 * 2048, 2048, 32, 1, 2048, ek, lds, bx, G);
                    EpiCompress ev{(const float*)(ws + OFF_CBP) + (l * 2 + 1) * 2048, p.in[I_CVW2] + (size_t)l * 8192, (u16*)(ws + OFF_VCT), 1, lds};
                    gemm_phase(KVb + 4194304, 1024, (const u16*)(ws + OFF_CW1) + (size_t)(l * 2 + 1) * 128 * 2048, 2048, 32, 1, 2048, ev, lds, (bx + G - 32) % G, G);
                }
#endif
#if EN_CONV
                for (;;) { const int t = block_next(ctl + QW(l, Q_CONV), qslot); if (t >= NTOK / 32) break; conv_tile(p, l, t, lds); }
#else
                zero_mix_cols(p, 0, 256);
#endif
#if EN_RWKV
                for (;;) { const int t = block_next(ctl + QW(l, Q_RWP), qslot); if (t >= NTOK / 16) break; rwkv_prep_tile(p, l, t, lds); }
#endif
            } else if (sp == 2) {
#if EN_RWKV
                if (bx < 64) { __builtin_amdgcn_s_setprio(3); rwkv_scan(p, bx, lds); __builtin_amdgcn_s_setprio(0); }
#endif
#if EN_NSA_CMP || EN_NSA_WIN || EN_NSA_SEL
                {
                    float* wl = (float*)lds + (TID() >> 6) * 2112;
                    for (;;) { const int t = wave_next(ctl + QW(l, Q_NSA)); if (t >= 8192) break; nsa_task2(p, t, wl); }
                }
#else
                zero_mix_cols(p, 512, 512);
#endif
            } else if (sp == 3) {
#if EN_RWKV
                phase_rwkv_post(p, l);
#else
                zero_mix_cols(p, 256, 256);
#endif
            } else if (sp == 4) {
                EpiOutProj e{l == 0 ? p.in[I_X] : p.out, p.out, modl + 2 * 1024};
                gemm_phase((const u16*)(ws + OFF_MIX), 1024, (const u16*)(ws + OFF_WOUT) + (size_t)l * 1024 * 1024, 1024, 256, 8, 1024, e, lds, bx, G);
            } else if (sp == 5) {
#if EN_PEER
                phase_norm(p.out, p.in[I_N2G] + l * 1024, modl + 3 * 1024, modl + 4 * 1024, (u16*)(ws + OFF_H));
#endif
            } else if (sp == 6) {
#if EN_PEER
                EpiStoreBf16 e{(u16*)(ws + OFF_QP), 2048};
                gemm_phase((const u16*)(ws + OFF_H), 1024, (const u16*)(ws + OFF_WQ) + (size_t)l * 2048 * 1024, 1024, 256, 16, 1024, e, lds, bx, G);
#endif
            } else if (sp == 7) {
#if EN_PEER
                float* wl = (float*)lds + (TID() >> 6) * 1536;
                for (;;) { const int t = wave_next(ctl + QW(l, Q_PTK)); if (t >= NTOK / 2) break; peer_topk_task(p, l, t, wl); }
#endif
            } else {
                phase_peer_experts(p, l);
            }
        }
        if (ph + 1 < p.ph_hi) { if (ph == 0) grid.sync(); else xcd_barrier(xbar); }
    }
}

extern "C" void kernel_launch(void* const* d_in, const int* in_sizes, int n_in, void* d_out, int out_size, void* d_ws, size_t ws_size,
                              hipStream_t stream) {
    static int grid_blocks = 0;
    if (!grid_blocks) {
        int dev = 0, cus = 0, per_cu = 0;
        hipGetDevice(&dev);
        hipDeviceGetAttribute(&cus, hipDeviceAttributeMultiprocessorCount, dev);
        hipOccupancyMaxActiveBlocksPerMultiprocessor(&per_cu, (const void*)mega, 256, 0);
        if (per_cu > 2) per_cu = 2;
        if (per_cu < 1) per_cu = 1;
        grid_blocks = cus * per_cu;
        if (ws_size < WS_NEED) fprintf(stderr, "kernel_launch: workspace too small: %zu < %zu\n", ws_size, (size_t)WS_NEED);
    }
    hipMemsetAsync((char*)d_ws + OFF_CTL, 0, CTL_ZERO_BYTES, stream);
    Params p{};
    for (int i = 0; i < 35; ++i) p.in[i] = (const float*)d_in[i];
    p.out = (float*)d_out;
    p.ws = (unsigned char*)d_ws;
#if MULTI_LAUNCH
    for (int ph = 0; ph < NPH; ++ph) {
        p.ph_lo = ph; p.ph_hi = ph + 1;
        hipLaunchKernelGGL(mega, dim3(grid_blocks), dim3(256), 0, stream, p);
    }
#else
    p.ph_lo = 0; p.ph_hi = NPH;
    void* args[] = {&p};
    hipError_t e = hipLaunchCooperativeKernel((const void*)mega, dim3(grid_blocks), dim3(256), args, 0, stream);
    if (e != hipSuccess) fprintf(stderr, "cooperative launch failed: %s (grid %d)\n", hipGetErrorString(e), grid_blocks);
#endif
}
```

```cpp
#include <hip/hip_runtime.h>
#include <hip/hip_cooperative_groups.h>
#include <stdint.h>
#include <stdio.h>
namespace cg = cooperative_groups;

#ifndef EN_CONV
#define EN_CONV 1
#endif
#ifndef EN_RWKV
#define EN_RWKV 1
#endif
#ifndef EN_NSA_CMP
#define EN_NSA_CMP 1
#endif
#ifndef EN_NSA_WIN
#define EN_NSA_WIN 1
#endif
#ifndef EN_NSA_SEL
#define EN_NSA_SEL 1
#endif
#ifndef EN_PEER
#define EN_PEER 1
#endif
#ifndef MULTI_LAUNCH
#define MULTI_LAUNCH 0
#endif

#define DEV __device__ __forceinline__
typedef unsigned short u16;
typedef __attribute__((ext_vector_type(8))) short bf16x8;
typedef __attribute__((ext_vector_type(4))) float f32x4;
typedef __attribute__((ext_vector_type(4))) unsigned int u32x4;
typedef __attribute__((ext_vector_type(2))) unsigned int u32x2;

constexpr int NB = 4, NT = 8192, ND = 1024, NTOK = NB * NT, NL = 2;
constexpr int NIN = 2840, NINP = 2944;
constexpr size_t MiB = 1ull << 20;

constexpr size_t OFF_CTL = 0;
constexpr size_t CTL_ZERO_BYTES = 32768;
constexpr size_t OFF_BAR = 16384;
constexpr size_t OFF_MOD = 64 * 1024;
constexpr size_t OFF_CBP = 256 * 1024;
constexpr size_t OFF_WIN = 1 * MiB;
constexpr size_t OFF_WOUT = 13 * MiB;
constexpr size_t OFF_WQ = 17 * MiB;
constexpr size_t OFF_CW1 = 25 * MiB;
constexpr size_t OFF_K12 = 27 * MiB;
constexpr size_t OFF_LW = 27 * MiB + 512 * 1024;
constexpr size_t OFF_U8 = 28 * MiB;
constexpr size_t OFF_UVS = 512 * 1024;
constexpr size_t OFF_H = 92 * MiB;
constexpr size_t OFF_MIX = 156 * MiB;
constexpr size_t OFF_E = 220 * MiB;
constexpr size_t OFF_PCONV = OFF_E + 0;
constexpr size_t OFF_PRWKV = OFF_E + 32 * MiB;
constexpr size_t OFF_YRAW = OFF_E + 32 * MiB;
constexpr size_t OFF_Q = OFF_E + 96 * MiB;
constexpr size_t OFF_KV = OFF_E + 128 * MiB;
constexpr size_t OFF_GATE = OFF_E + 176 * MiB;
constexpr size_t OFF_KC = OFF_E + 180 * MiB;
constexpr size_t OFF_VCT = OFF_KC + 512 * 1024;
constexpr size_t OFF_RV = OFF_E + 184 * MiB;
constexpr size_t OFF_RKK = OFF_E + 200 * MiB;
constexpr size_t OFF_RKKA = OFF_E + 216 * MiB;
constexpr size_t OFF_RG = OFF_E + 232 * MiB;
constexpr size_t OFF_BONUS = OFF_E + 248 * MiB;
constexpr size_t OFF_RW = OFF_H;
constexpr size_t OFF_RR = OFF_H + 32 * MiB;
constexpr size_t OFF_RK = OFF_H + 48 * MiB;
constexpr size_t OFF_QP = OFF_E + 0;
constexpr size_t OFF_PIDX = OFF_E + 128 * MiB;
constexpr size_t OFF_PGW = OFF_E + 144 * MiB;
constexpr size_t WS_NEED = OFF_E + 249 * MiB;

#define QW(l, q) (64 * ((l) * 8 + (q)))
enum { Q_CMP = 0, Q_CONV = 1, Q_RWP = 2, Q_NSA = 3, Q_PTK = 4 };

enum { I_X = 0, I_C, I_ADAW, I_ADAB, I_N1G, I_N2G, I_WIN, I_CDW, I_CDB, I_CGG, I_CGB, I_MU, I_W0, I_WUP, I_A0, I_AUP, I_GUP,
       I_KK, I_KA, I_RK, I_LNG, I_LNB, I_CKPOS, I_CKW1, I_CKW2, I_CVPOS, I_CVW1, I_CVW2, I_WOUT, I_PWQ, I_PK1, I_PK2, I_PU, I_PV, I_FG };

struct Params {
    const float* in[35];
    float* out;
    unsigned char* ws;
    int ph_lo, ph_hi;
};

DEV int TID() { int t = threadIdx.x; asm volatile("" : "+v"(t)); return t; }
DEV int BID() { int t = blockIdx.x; asm volatile("" : "+s"(t)); return t; }
typedef __attribute__((ext_vector_type(2))) float f32x2_t;
typedef __attribute__((ext_vector_type(2))) __bf16 bf16x2_t;
DEV unsigned pack2(float a, float b) { const f32x2_t v = {a, b}; return __builtin_bit_cast(unsigned, __builtin_convertvector(v, bf16x2_t)); }
DEV u16 f2bf(float f) { const __bf16 h = (__bf16)f; return __builtin_bit_cast(u16, h); }
DEV float bf2f(u16 h) { return __uint_as_float(((unsigned)h) << 16); }
DEV float bflo(unsigned u) { return __uint_as_float(u << 16); }
DEV float bfhi(unsigned u) { return __uint_as_float(u & 0xffff0000u); }
DEV float ex2(float x) { return __builtin_amdgcn_exp2f(x); }
DEV float sigmoidf_(float x) { return 1.f / (1.f + __expf(-x)); }

DEV f32x4 mfma16(bf16x8 a, bf16x8 b, f32x4 c) { return __builtin_amdgcn_mfma_f32_16x16x32_bf16(a, b, c, 0, 0, 0); }
template <int CTRL> DEV float dppf(float x) { return __int_as_float(__builtin_amdgcn_update_dpp(0, __float_as_int(x), CTRL, 0xF, 0xF, false)); }
template <int CTRL> DEV unsigned dppu(unsigned x) { return (unsigned)__builtin_amdgcn_update_dpp(0, (int)x, CTRL, 0xF, 0xF, false); }
DEV float reduce16(float x) { x += dppf<0xB1>(x); x += dppf<0x4E>(x); x += dppf<0x124>(x); x += dppf<0x128>(x); return x; }
DEV float quadsum(float x) { x += dppf<0xB1>(x); x += dppf<0x4E>(x); return x; }
DEV float x16_sum(float x) { auto r = __builtin_amdgcn_permlane16_swap(__float_as_uint(x), __float_as_uint(x), false, false); return __uint_as_float(r[0]) + __uint_as_float(r[1]); }
DEV float x32_sum(float x) { auto r = __builtin_amdgcn_permlane32_swap(__float_as_uint(x), __float_as_uint(x), false, false); return __uint_as_float(r[0]) + __uint_as_float(r[1]); }
DEV float x16_max(float x) { auto r = __builtin_amdgcn_permlane16_swap(__float_as_uint(x), __float_as_uint(x), false, false); return fmaxf(__uint_as_float(r[0]), __uint_as_float(r[1])); }
DEV float x32_max(float x) { auto r = __builtin_amdgcn_permlane32_swap(__float_as_uint(x), __float_as_uint(x), false, false); return fmaxf(__uint_as_float(r[0]), __uint_as_float(r[1])); }
DEV int x16_sumi(int x) { auto r = __builtin_amdgcn_permlane16_swap((unsigned)x, (unsigned)x, false, false); return (int)(r[0] + r[1]); }
DEV int x32_sumi(int x) { auto r = __builtin_amdgcn_permlane32_swap((unsigned)x, (unsigned)x, false, false); return (int)(r[0] + r[1]); }
DEV float colsum(float x) { return x32_sum(x16_sum(x)); }
DEV float colmax(float x) { return x32_max(x16_max(x)); }
DEV int colsumi(int x) { return x32_sumi(x16_sumi(x)); }
DEV float wave_sum(float v) { return x32_sum(x16_sum(reduce16(v))); }
DEV float wave_max(float x) {
    x = fmaxf(x, dppf<0xB1>(x)); x = fmaxf(x, dppf<0x4E>(x)); x = fmaxf(x, dppf<0x124>(x)); x = fmaxf(x, dppf<0x128>(x));
    return x32_max(x16_max(x));
}
DEV void lds_fence() { asm volatile("s_waitcnt lgkmcnt(0)" ::: "memory"); }
DEV bf16x8 ld8(const u16* p) { return *(const bf16x8*)p; }

DEV int block_next(unsigned* ctr, int* slot) {
    __syncthreads();
    if (TID() == 0) *slot = (int)atomicAdd(ctr, 1u);
    __syncthreads();
    return *slot;
}
DEV int wave_next(unsigned* ctr) {
    int v = 0;
    if ((TID() & 63) == 0) v = (int)atomicAdd(ctr, 1u);
    return __builtin_amdgcn_readfirstlane(v);
}


#define XB_TMO      128
#define XB_XCNT(j)  (256  + 64 * (j))
#define XB_XSUB(j)  (1280 + 64 * (j))
#define XB_XGEN(j)  (2304 + 64 * (j))
#define XB_TOP      3328
#define XB_TOPGEN   3392
#define XCD_BAR_WORDS 3456
#define XB_SPIN_CAP (1u << 22)
#define LAS __attribute__((address_space(3)))
DEV unsigned xb_ld(unsigned* p) { return __hip_atomic_load(p, __ATOMIC_RELAXED, __HIP_MEMORY_SCOPE_AGENT); }
DEV unsigned xb_add(unsigned* p, unsigned v) { return __hip_atomic_fetch_add(p, v, __ATOMIC_RELAXED, __HIP_MEMORY_SCOPE_AGENT); }
DEV unsigned xb_xcc_id() { return (unsigned)__builtin_amdgcn_s_getreg((3 << 11) | 20) & 0xFu; }
#define XB_SPIN(cond, bar) do { unsigned _sp = 0; while (cond) { __builtin_amdgcn_s_sleep(1); \
    if ((++_sp & 255u) == 0u) { if (xb_ld(&(bar)[XB_TMO])) break; if (_sp > XB_SPIN_CAP) { atomicAdd(&(bar)[XB_TMO], 1u); break; } } } } while (0)
struct XcdBarrier { unsigned* bar; unsigned x; volatile unsigned* st; };
DEV XcdBarrier xcd_barrier_post(unsigned* bar, volatile unsigned* st) {
    XcdBarrier b; b.bar = bar; b.x = xb_xcc_id(); b.st = st;
    if (threadIdx.x == 0) (void)xb_add(&bar[XB_XCNT(b.x)], 1u);
    return b;
}
DEV void xcd_barrier_complete(unsigned* bar, unsigned x, unsigned& nloc, unsigned& nx) {
    const unsigned G = gridDim.x * gridDim.y * gridDim.z;
    unsigned sum, cnt, mine, sp = 0u;
    for (;;) {
        sum = 0u; cnt = 0u; mine = 0u;
#pragma unroll
        for (unsigned j = 0; j < 16; ++j) { const unsigned c = xb_ld(&bar[XB_XCNT(j)]); sum += c; cnt += (c > 0u) ? 1u : 0u; mine = (j == x) ? c : mine; }
        if (sum == G) break;
        __builtin_amdgcn_s_sleep(1);
        if ((++sp & 255u) == 0u) { if (xb_ld(&bar[XB_TMO])) break; if (sp > XB_SPIN_CAP) { atomicAdd(&bar[XB_TMO], 1u); break; } }
    }
    nloc = mine > 0u ? mine : 1u; nx = cnt > 0u ? cnt : 1u;
}
DEV void xcd_barrier(const XcdBarrier& b) {
    asm volatile("s_waitcnt vmcnt(0)" ::: "memory");
    __syncthreads();
    if (threadIdx.x == 0) {
        unsigned* bar = b.bar;
        __builtin_amdgcn_s_waitcnt(0);
        unsigned nloc = b.st[0], nx = b.st[1];
        if (nloc == 0u) { xcd_barrier_complete(bar, b.x, nloc, nx); b.st[0] = nloc; b.st[1] = nx; }
        const unsigned old = xb_add(&bar[XB_XSUB(b.x)], 1u);
        const unsigned gen = old / nloc;
        if (old + 1u == (gen + 1u) * nloc) {
            __builtin_amdgcn_fence(__ATOMIC_RELEASE, "agent");
            asm volatile("s_waitcnt vmcnt(0)" ::: "memory");
            const unsigned og = xb_add(&bar[XB_TOP], 1u);
            const unsigned tg = og / nx;
            if (og + 1u == (tg + 1u) * nx) xb_add(&bar[XB_TOPGEN], 1u);
            else XB_SPIN(xb_ld(&bar[XB_TOPGEN]) == tg, bar);
            __builtin_amdgcn_fence(__ATOMIC_ACQUIRE, "agent");
            xb_add(&bar[XB_XGEN(b.x)], 1u);
            asm volatile("s_waitcnt vmcnt(0)" ::: "memory");
        } else {
            XB_SPIN(xb_ld(&bar[XB_XGEN(b.x)]) == gen, bar);
            __builtin_amdgcn_fence(__ATOMIC_ACQUIRE, "agent");
            asm volatile("s_waitcnt vmcnt(0)" ::: "memory");
        }
    }
    __syncthreads();
}

template <class Epi>
DEV void gemm_phase(const u16* __restrict__ A, int lda, const u16* __restrict__ Bt, int ldb, int mtiles, int ntiles, int K, Epi& epi,
                    unsigned char* lds, int bid, int nb) {
    const int tid = TID(), lane = tid & 63, wave = tid >> 6;
    const int wm = wave >> 1, wn = wave & 1, q4 = lane >> 4, cidx = lane & 15;
    u16* As = (u16*)lds;
    u16* Bs = (u16*)(lds + 32768);
    const int KT = K >> 6;
    const int total = mtiles * ntiles;
    const int srow = tid >> 3, sch = tid & 7;
    for (int tile = bid; tile < total; tile += nb) {
        const int mt = tile / ntiles, nt = tile - mt * ntiles;
        const int m0 = mt * 128, n0 = nt * 128;
        f32x4 acc[4][4];
#pragma unroll
        for (int i = 0; i < 4; ++i)
#pragma unroll
            for (int j = 0; j < 4; ++j) acc[i][j] = (f32x4){0.f, 0.f, 0.f, 0.f};
        const u16* Ag = A + (size_t)(m0 + srow) * lda + sch * 8;
        const u16* Bg = Bt + (size_t)(n0 + srow) * ldb + sch * 8;
        bf16x8 ra[4], rb[4];
#pragma unroll
        for (int i = 0; i < 4; ++i) { ra[i] = ld8(Ag + (size_t)(32 * i) * lda); rb[i] = ld8(Bg + (size_t)(32 * i) * ldb); }
#pragma unroll
        for (int i = 0; i < 4; ++i) {
            const int row = srow + 32 * i; const int off = row * 64 + ((sch ^ (row & 7)) << 3);
            *(bf16x8*)(As + off) = ra[i]; *(bf16x8*)(Bs + off) = rb[i];
        }
        __syncthreads();
        for (int kt = 0; kt < KT; ++kt) {
            const int buf = kt & 1;
            if (kt + 1 < KT) {
                const int k0 = (kt + 1) * 64;
#pragma unroll
                for (int i = 0; i < 4; ++i) { ra[i] = ld8(Ag + (size_t)(32 * i) * lda + k0); rb[i] = ld8(Bg + (size_t)(32 * i) * ldb + k0); }
            }
            const u16* Ab = As + buf * 8192;
            const u16* Bb = Bs + buf * 8192;
#pragma unroll
            for (int s = 0; s < 2; ++s) {
                bf16x8 a[4], b[4];
                const int ch = s * 4 + q4;
#pragma unroll
                for (int i = 0; i < 4; ++i) {
                    const int row = wm * 64 + i * 16 + cidx;
                    a[i] = *(const bf16x8*)(Ab + row * 64 + ((ch ^ (row & 7)) << 3));
                    const int rowb = wn * 64 + i * 16 + cidx;
                    b[i] = *(const bf16x8*)(Bb + rowb * 64 + ((ch ^ (rowb & 7)) << 3));
                }
#pragma unroll
                for (int i = 0; i < 4; ++i)
#pragma unroll
                    for (int j = 0; j < 4; ++j) acc[i][j] = mfma16(a[i], b[j], acc[i][j]);
            }
            if (kt + 1 < KT) {
                u16* Aw = As + (buf ^ 1) * 8192;
                u16* Bw = Bs + (buf ^ 1) * 8192;
#pragma unroll
                for (int i = 0; i < 4; ++i) {
                    const int row = srow + 32 * i; const int off = row * 64 + ((sch ^ (row & 7)) << 3);
                    *(bf16x8*)(Aw + off) = ra[i]; *(bf16x8*)(Bw + off) = rb[i];
                }
            }
            __syncthreads();
        }
#pragma unroll
        for (int i = 0; i < 4; ++i)
#pragma unroll
            for (int j = 0; j < 4; ++j) epi(m0 + wm * 64 + i * 16 + q4 * 4, n0 + wn * 64 + j * 16 + cidx, acc[i][j]);
        epi.finish(m0, n0, lds);
    }
}

struct EpiInProj {
    u16 *pconv, *prwkv, *q, *kv; float* gate;
    DEV void operator()(int row0, int col, f32x4 v) const {
        if (col < 512) {
#pragma unroll
            for (int r = 0; r < 4; ++r) pconv[(size_t)(row0 + r) * 512 + col] = f2bf(v[r]);
        } else if (col < 1536) {
#pragma unroll
            for (int r = 0; r < 4; ++r) prwkv[(size_t)(row0 + r) * 1024 + (col - 512)] = f2bf(v[r]);
        } else if (col < 2048) {
#pragma unroll
            for (int r = 0; r < 4; ++r) q[(size_t)(row0 + r) * 512 + (col - 1536)] = f2bf(v[r] * 0.18033688011112042f);
        } else if (col < 2816) {
            const int c = col - 2048; const int idx = c >> 7; const int g = (c >> 6) & 1; const int d = c & 63;
            const int b = row0 >> 13; const int t0 = row0 & 8191; const int bg = b * 2 + g;
            u16* base = kv + (size_t)idx * 4194304;
            if (idx == 3 || idx == 5) {
                const int k = t0 & 31; const int p0 = 8 * ((k & 15) >> 2) + 4 * (k >> 4);
                u32x2 w; w[0] = pack2(v[0], v[1]); w[1] = pack2(v[2], v[3]);
                *(u32x2*)(base + (size_t)(bg * 64 + d) * 8192 + (t0 & ~31) + p0) = w;
            } else {
#pragma unroll
                for (int r = 0; r < 4; ++r) base[((size_t)bg * 8192 + t0 + r) * 64 + d] = f2bf(v[r]);
            }
        } else if (col < 2840) {
#pragma unroll
            for (int r = 0; r < 4; ++r) gate[(size_t)(row0 + r) * 24 + (col - 2816)] = sigmoidf_(v[r]);
        }
    }
    DEV void finish(int, int, unsigned char*) const {}
};

struct EpiOutProj {
    const float* xold; float* xnew; const float* g1;
    DEV void operator()(int row0, int col, f32x4 v) const {
        const int b = row0 >> 13; const float gg = g1[b * 6144 + col];
#pragma unroll
        for (int r = 0; r < 4; ++r) { const size_t o = (size_t)(row0 + r) * 1024 + col; xnew[o] = xold[o] + gg * v[r]; }
    }
    DEV void finish(int, int, unsigned char*) const {}
};

struct EpiStoreBf16 {
    u16* out; int ld;
    DEV void operator()(int row0, int col, f32x4 v) const {
#pragma unroll
        for (int r = 0; r < 4; ++r) out[(size_t)(row0 + r) * ld + col] = f2bf(v[r]);
    }
    DEV void finish(int, int, unsigned char*) const {}
};

struct EpiCompress {
    const float* cbp;
    const float* w2;
    u16* outp;
    int isv;
    unsigned char* lds;
    DEV void operator()(int row0, int col, f32x4 v) const {
        float* hid = (float*)lds;
        const int rl = row0 & 127;
#pragma unroll
        for (int r = 0; r < 4; ++r) hid[(rl + r) * 128 + col] = v[r];
    }
    DEV void finish(int m0, int, unsigned char*) const {
        __syncthreads();
        {
            float* hw = (float*)lds;
            const int t = TID(); const int c = t & 127, r0 = (t >> 7) * 64;
            float bias = 0.f;
#pragma unroll
            for (int s = 0; s < 16; ++s) bias += cbp[s * 128 + c];
#pragma unroll 4
            for (int r = 0; r < 64; ++r) { const float x = hw[(r0 + r) * 128 + c] + bias; hw[(r0 + r) * 128 + c] = x * sigmoidf_(x); }
        }
        __syncthreads();
        const float* hid = (const float*)lds;
        const int tid = TID(); const int d = tid & 63, rgp = tid >> 6;
        float acc[32];
#pragma unroll
        for (int i = 0; i < 32; ++i) acc[i] = 0.f;
#pragma unroll 1
        for (int j0 = 0; j0 < 128; j0 += 8) {
            float wv[8];
#pragma unroll
            for (int jj = 0; jj < 8; ++jj) wv[jj] = w2[(j0 + jj) * 64 + d];
#pragma unroll
            for (int rr = 0; rr < 32; ++rr) {
                const float4 h0 = *(const float4*)(hid + (rgp * 32 + rr) * 128 + j0), h1 = *(const float4*)(hid + (rgp * 32 + rr) * 128 + j0 + 4);
                acc[rr] += h0.x * wv[0] + h0.y * wv[1] + h0.z * wv[2] + h0.w * wv[3] + h1.x * wv[4] + h1.y * wv[5] + h1.z * wv[6] + h1.w * wv[7];
            }
        }
#pragma unroll
        for (int rr = 0; rr < 32; ++rr) {
            const int m = m0 + rgp * 32 + rr; const int bg = m >> 9, n = m & 511;
            const u16 val = (n == 511) ? (u16)0 : f2bf(acc[rr]);
            if (!isv) outp[((size_t)bg * 512 + n) * 64 + d] = val;
            else {
                const int k = n & 31; const int pp = 8 * ((k & 15) >> 2) + (k & 3) + 4 * (k >> 4);
                outp[((size_t)bg * 64 + d) * 512 + (n & ~31) + pp] = val;
            }
        }
        __syncthreads();
    }
};

DEV void transpose_tile(const float* __restrict__ src, int N, u16* __restrict__ dst, int ldk, int kt, int nt, float* tl) {
    const int tid = TID(); const int k0 = kt * 64, n0 = nt * 64;
#pragma unroll 4
    for (int i = 0; i < 16; ++i) {
        const int idx = tid + 256 * i; const int kr = idx >> 6, nc = idx & 63; const int n = n0 + nc;
        tl[kr * 65 + nc] = (n < N) ? src[(size_t)(k0 + kr) * N + n] : 0.f;
    }
    __syncthreads();
#pragma unroll 4
    for (int i = 0; i < 16; ++i) {
        const int idx = tid + 256 * i; const int nr = idx >> 6, kc = idx & 63;
        dst[(size_t)(n0 + nr) * ldk + k0 + kc] = f2bf(tl[kc * 65 + nr]);
    }
    __syncthreads();
}

DEV void convert_straight(const float* __restrict__ src, u16* __restrict__ dst, size_t n) {
    const size_t stride = (size_t)gridDim.x * 256 * 8;
    for (size_t i = ((size_t)BID() * 256 + TID()) * 8; i < n; i += stride) {
        const float4 a = *(const float4*)(src + i); const float4 b = *(const float4*)(src + i + 4);
        u32x4 w; w[0] = pack2(a.x, a.y); w[1] = pack2(a.z, a.w); w[2] = pack2(b.x, b.y); w[3] = pack2(b.z, b.w);
        *(u32x4*)(dst + i) = w;
    }
}

DEV void convert_rows_i8(const float* __restrict__ src, unsigned char* __restrict__ dst, float* __restrict__ scale) {
    const int lane = TID() & 63;
    const int gw = BID() * 4 + (TID() >> 6), nw = gridDim.x * 4;
    for (int row = gw; row < 16384; row += nw) {
        float4 v[4]; float amax = 0.f;
#pragma unroll
        for (int i = 0; i < 4; ++i) {
            v[i] = *(const float4*)(src + (size_t)row * 1024 + 16 * lane + 4 * i);
            amax = fmaxf(amax, fmaxf(fmaxf(fabsf(v[i].x), fabsf(v[i].y)), fmaxf(fabsf(v[i].z), fabsf(v[i].w))));
        }
        amax = wave_max(amax);
        const float sc = amax > 0.f ? amax * (1.f / 127.f) : 1.f;
        const float inv = 1.f / sc;
        u32x4 w;
#pragma unroll
        for (int i = 0; i < 4; ++i) {
            const int a = __float2int_rn(v[i].x * inv) + 128, b = __float2int_rn(v[i].y * inv) + 128, c = __float2int_rn(v[i].z * inv) + 128, d = __float2int_rn(v[i].w * inv) + 128;
            w[i] = (unsigned)a | ((unsigned)b << 8) | ((unsigned)c << 16) | ((unsigned)d << 24);
        }
        *(u32x4*)(dst + (size_t)row * 1024 + 16 * lane) = w;
        if (lane == 0) scale[row] = sc;
    }
}

DEV void phase_prep(const Params& p, unsigned char* lds) {
    const int tid = TID();
    float* fl = (float*)lds;
    unsigned char* ws = p.ws;
    for (int task = BID(); task < 192; task += gridDim.x) {
        const int l = task / 96, cgp = task % 96;
        float* cs = fl;
        float* red = fl + 4096;
        for (int i = tid; i < 4096; i += 256) { const float c = p.in[I_C][i]; cs[i] = c / (1.f + __expf(-c)); }
        __syncthreads();
        const int col = cgp * 64 + (tid & 63), ks = tid >> 6;
        float a0 = 0, a1 = 0, a2 = 0, a3 = 0;
        const float* w = p.in[I_ADAW] + ((size_t)l * 1024 + ks * 256) * 6144 + col;
#pragma unroll 8
        for (int k = 0; k < 256; ++k) {
            const float wv = w[(size_t)k * 6144]; const int kk = ks * 256 + k;
            a0 += cs[kk] * wv; a1 += cs[1024 + kk] * wv; a2 += cs[2048 + kk] * wv; a3 += cs[3072 + kk] * wv;
        }
        red[(ks * 4 + 0) * 64 + (tid & 63)] = a0; red[(ks * 4 + 1) * 64 + (tid & 63)] = a1;
        red[(ks * 4 + 2) * 64 + (tid & 63)] = a2; red[(ks * 4 + 3) * 64 + (tid & 63)] = a3;
        __syncthreads();
        {
            const int b = tid >> 6, c = tid & 63;
            const float s = red[(0 * 4 + b) * 64 + c] + red[(1 * 4 + b) * 64 + c] + red[(2 * 4 + b) * 64 + c] + red[(3 * 4 + b) * 64 + c];
            const int colg = cgp * 64 + c;
            ((float*)(ws + OFF_MOD))[(l * 4 + b) * 6144 + colg] = s + p.in[I_ADAB][l * 6144 + colg];
        }
        __syncthreads();
    }
    for (int task = BID(); task < 64; task += gridDim.x) {
        const int l = task >> 5, kv = (task >> 4) & 1, s = task & 15;
        const float* pos = p.in[kv ? I_CVPOS : I_CKPOS] + l * 2048;
        const float* w1 = p.in[kv ? I_CVW1 : I_CKW1] + (size_t)l * 2048 * 128;
        const int col = tid & 127, half = tid >> 7;
        float a = 0;
        const int i0 = s * 128 + half * 64;
#pragma unroll 8
        for (int i = 0; i < 64; ++i) a += pos[i0 + i] * w1[(size_t)(i0 + i) * 128 + col];
        fl[tid] = a;
        __syncthreads();
        if (tid < 128) ((float*)(ws + OFF_CBP))[((l * 2 + kv) * 16 + s) * 128 + tid] = fl[tid] + fl[tid + 128];
        __syncthreads();
    }
    {
        for (int task = BID(); task < 2 * 16 * 46; task += gridDim.x) {
            const int l = task / (16 * 46), r = task % (16 * 46);
            transpose_tile(p.in[I_WIN] + (size_t)l * 1024 * NIN, NIN, (u16*)(ws + OFF_WIN) + (size_t)l * NINP * 1024, 1024, r / 46, r % 46, fl);
        }
        for (int task = BID(); task < 2 * 16 * 16; task += gridDim.x) {
            const int l = task >> 8, r = task & 255;
            transpose_tile(p.in[I_WOUT] + (size_t)l * 1024 * 1024, 1024, (u16*)(ws + OFF_WOUT) + (size_t)l * 1024 * 1024, 1024, r >> 4, r & 15, fl);
        }
        for (int task = BID(); task < 2 * 16 * 32; task += gridDim.x) {
            const int l = task >> 9, r = task & 511;
            transpose_tile(p.in[I_PWQ] + (size_t)l * 1024 * 2048, 2048, (u16*)(ws + OFF_WQ) + (size_t)l * 2048 * 1024, 1024, r >> 5, r & 31, fl);
        }
        for (int task = BID(); task < 2 * 16; task += gridDim.x) {
            const int l = task >> 4, r = task & 15; const int nt = r & 3, part = r >> 2;
            u16* dst = (u16*)(ws + OFF_LW) + (size_t)l * 65536;
            if (part == 0) transpose_tile(p.in[I_WUP] + (size_t)l * 64 * 256, 256, dst, 256, 0, nt, fl);
            else if (part == 1) transpose_tile(p.in[I_AUP] + (size_t)l * 64 * 256, 256, dst + 64, 256, 0, nt, fl);
            else transpose_tile(p.in[I_GUP] + (size_t)l * 128 * 256, 256, dst + 128, 256, part - 2, nt, fl);
        }
        for (int task = BID(); task < 4 * 32 * 2; task += gridDim.x) {
            const int lk = task >> 6, r = task & 63; const int l = lk >> 1, kv = lk & 1;
            transpose_tile(p.in[kv ? I_CVW1 : I_CKW1] + (size_t)l * 2048 * 128, 128, (u16*)(ws + OFF_CW1) + (size_t)lk * 128 * 2048, 2048, r >> 1, r & 1, fl);
        }
    }
    for (int l = 0; l < 2; ++l) {
        convert_straight(p.in[I_PK1] + l * 16384, (u16*)(ws + OFF_K12) + (l * 2 + 0) * 16384, 16384);
        convert_straight(p.in[I_PK2] + l * 16384, (u16*)(ws + OFF_K12) + (l * 2 + 1) * 16384, 16384);
    }
    for (int l = 0; l < 2; ++l) {
        convert_rows_i8(p.in[I_PU] + (size_t)l * 16384 * 1024, ws + OFF_U8 + (size_t)(l * 2 + 0) * 16 * MiB, (float*)(ws + OFF_UVS) + (l * 2 + 0) * 16384);
        convert_rows_i8(p.in[I_PV] + (size_t)l * 16384 * 1024, ws + OFF_U8 + (size_t)(l * 2 + 1) * 16 * MiB, (float*)(ws + OFF_UVS) + (l * 2 + 1) * 16384);
    }
}

DEV void phase_norm(const float* __restrict__ x, const float* __restrict__ g, const float* __restrict__ sh, const float* __restrict__ sc,
                    u16* __restrict__ h) {
    const int lane = TID() & 63;
    const int gw = BID() * 4 + (TID() >> 6), nw = gridDim.x * 4;
    for (int row = gw; row < NTOK; row += nw) {
        const int b = row >> 13;
        float4 v[4]; float ss = 0;
#pragma unroll
        for (int i = 0; i < 4; ++i) { v[i] = *(const float4*)(x + (size_t)row * 1024 + 256 * i + lane * 4); ss += v[i].x * v[i].x + v[i].y * v[i].y + v[i].z * v[i].z + v[i].w * v[i].w; }
        ss = wave_sum(ss);
        const float rs = rsqrtf(ss * (1.f / 1024.f) + 1e-6f);
#pragma unroll
        for (int i = 0; i < 4; ++i) {
            const int k = 256 * i + lane * 4;
            const float4 gg = *(const float4*)(g + k); const float4 s1 = *(const float4*)(sc + b * 6144 + k); const float4 s0 = *(const float4*)(sh + b * 6144 + k);
            u32x2 w;
            w[0] = pack2(v[i].x * rs * gg.x * (1.f + s1.x) + s0.x, v[i].y * rs * gg.y * (1.f + s1.y) + s0.y);
            w[1] = pack2(v[i].z * rs * gg.z * (1.f + s1.z) + s0.z, v[i].w * rs * gg.w * (1.f + s1.w) + s0.w);
            *(u32x2*)(h + (size_t)row * 1024 + k) = w;
        }
    }
}

DEV void phase_final_only(const float* __restrict__ x, const float* __restrict__ g, float* __restrict__ out) {
    const int lane = TID() & 63;
    const int gw = BID() * 4 + (TID() >> 6), nw = gridDim.x * 4;
    for (int row = gw; row < NTOK; row += nw) {
        float4 v[4]; float ss = 0;
#pragma unroll
        for (int i = 0; i < 4; ++i) { v[i] = *(const float4*)(x + (size_t)row * 1024 + 256 * i + lane * 4); ss += v[i].x * v[i].x + v[i].y * v[i].y + v[i].z * v[i].z + v[i].w * v[i].w; }
        ss = wave_sum(ss);
        const float rs = rsqrtf(ss * (1.f / 1024.f) + 1e-6f);
#pragma unroll
        for (int i = 0; i < 4; ++i) {
            const int k = 256 * i + lane * 4; const float4 gg = *(const float4*)(g + k);
            float4 o; o.x = v[i].x * rs * gg.x; o.y = v[i].y * rs * gg.y; o.z = v[i].z * rs * gg.z; o.w = v[i].w * rs * gg.w;
            *(float4*)(out + (size_t)row * 1024 + k) = o;
        }
    }
}


DEV void conv_tile(const Params& p, int l, int tile, unsigned char* lds) {
    float* ul = (float*)lds;
    const int tid = TID();
    unsigned char* ws = p.ws;
    const u16* pconv = (const u16*)(ws + OFF_PCONV);
    u16* mix = (u16*)(ws + OFF_MIX);
    const int t0g = tile * 32; const int tb = t0g & 8191;
#pragma unroll 8
    for (int rr = 0; rr < 62; ++rr) {
        const int trow = tb - 30 + rr;
        float u = 0.f;
        if (trow >= 0) {
            const size_t o = (size_t)(t0g - 30 + rr) * 512;
            const float val = bf2f(pconv[o + tid]), gt = bf2f(pconv[o + 256 + tid]);
            u = val * sigmoidf_(gt);
        }
        ul[rr * 256 + tid] = u;
    }
    __syncthreads();
    float w[31];
#pragma unroll
    for (int j = 0; j < 31; ++j) w[j] = p.in[I_CDW][(l * 31 + j) * 256 + tid];
    const float bias = p.in[I_CDB][l * 256 + tid], gg = p.in[I_CGG][l * 256 + tid], gb = p.in[I_CGB][l * 256 + tid];
    for (int tt = 0; tt < 32; ++tt) {
        float y = bias;
#pragma unroll
        for (int j = 0; j < 31; ++j) y += ul[(tt + j) * 256 + tid] * w[j];
        const float mean = wave_sum(y) * (1.f / 64.f);
        const float d = y - mean;
        const float var = wave_sum(d * d) * (1.f / 64.f);
        float o = d * rsqrtf(var + 1e-5f) * gg + gb;
        o = o * sigmoidf_(o);
        mix[(size_t)(t0g + tt) * 1024 + tid] = f2bf(o);
    }
}

DEV float softplusf_(float x) { return x > 20.f ? x : log1pf(__expf(x)); }
DEV void rwkv_prep_tile(const Params& p, int l, int tile, unsigned char* lds) {
    float* actT = (float*)lds;
    const int tid = TID(), lane = tid & 63;
    unsigned char* ws = p.ws;
    const u16* pr = (const u16*)(ws + OFF_PRWKV);
    const float* mu = p.in[I_MU] + l * 1024;
    const int R0 = tile * 16;
    {
        const int col = 768 + tid; const float muc = mu[col];
#pragma unroll 4
        for (int tk = 0; tk < 16; ++tk) {
            const int row = R0 + tk; const int t = row & 8191;
            const float cur = bf2f(pr[(size_t)row * 1024 + col]);
            const float prev = t > 0 ? bf2f(pr[(size_t)(row - 1) * 1024 + col]) : 0.f;
            const float x = cur + (prev - cur) * muc;
            float a;
            if (tid < 64) a = tanhf(x); else if (tid < 128) a = x; else a = sigmoidf_(x);
            actT[tid * 16 + tk] = a;
        }
    }
    __syncthreads();
    float accw[16], acca[16], accg[16];
#pragma unroll
    for (int i = 0; i < 16; ++i) { accw[i] = 0.f; acca[i] = 0.f; accg[i] = 0.f; }
    const float* wup = p.in[I_WUP] + (size_t)l * 64 * 256 + tid;
    const float* aup = p.in[I_AUP] + (size_t)l * 64 * 256 + tid;
    const float* gup = p.in[I_GUP] + (size_t)l * 128 * 256 + tid;
#pragma unroll 8
    for (int j = 0; j < 64; ++j) {
        const float ww = wup[j * 256], aa = aup[j * 256];
        const float4* x1 = (const float4*)(actT + j * 16);
        const float4* x2 = (const float4*)(actT + (64 + j) * 16);
#pragma unroll
        for (int q = 0; q < 4; ++q) {
            const float4 a = x1[q], b = x2[q];
            accw[4 * q + 0] += a.x * ww; accw[4 * q + 1] += a.y * ww; accw[4 * q + 2] += a.z * ww; accw[4 * q + 3] += a.w * ww;
            acca[4 * q + 0] += b.x * aa; acca[4 * q + 1] += b.y * aa; acca[4 * q + 2] += b.z * aa; acca[4 * q + 3] += b.w * aa;
        }
    }
#pragma unroll 8
    for (int j = 0; j < 128; ++j) {
        const float gg = gup[j * 256];
        const float4* x3 = (const float4*)(actT + (128 + j) * 16);
#pragma unroll
        for (int q = 0; q < 4; ++q) {
            const float4 a = x3[q];
            accg[4 * q + 0] += a.x * gg; accg[4 * q + 1] += a.y * gg; accg[4 * q + 2] += a.z * gg; accg[4 * q + 3] += a.w * gg;
        }
    }
    const float w0 = p.in[I_W0][l * 256 + tid], a0 = p.in[I_A0][l * 256 + tid], kkc = p.in[I_KK][l * 256 + tid], kac = p.in[I_KA][l * 256 + tid],
                rkc = p.in[I_RK][l * 256 + tid];
    const float mur = mu[tid], muk = mu[256 + tid], muv = mu[512 + tid];
    float* RW = (float*)(ws + OFF_RW);
    u16 *RR = (u16*)(ws + OFF_RR), *RK = (u16*)(ws + OFF_RK), *RV = (u16*)(ws + OFF_RV), *RKK = (u16*)(ws + OFF_RKK), *RKKA = (u16*)(ws + OFF_RKKA),
        *RG = (u16*)(ws + OFF_RG);
    float* BON = (float*)(ws + OFF_BONUS);
#pragma unroll
    for (int tk = 0; tk < 16; ++tk) {
        const int row = R0 + tk; const int t = row & 8191;
        const u16* cr = pr + (size_t)row * 1024; const u16* pv = cr - 1024;
        float r = bf2f(cr[tid]), k = bf2f(cr[256 + tid]), v = bf2f(cr[512 + tid]);
        const float rp = t > 0 ? bf2f(pv[tid]) : 0.f, kp = t > 0 ? bf2f(pv[256 + tid]) : 0.f, vp = t > 0 ? bf2f(pv[512 + tid]) : 0.f;
        r += (rp - r) * mur; k += (kp - k) * muk; v += (vp - v) * muv;
        const float wl = w0 + accw[tk];
        const float wlog = -softplusf_(-wl) - 0.5f;
        const float decay = __expf(-__expf(wlog));
        const float a = sigmoidf_(a0 + acca[tk]);
        float kk = k * kkc;
        const float nrm = sqrtf(wave_sum(kk * kk));
        kk = kk / fmaxf(nrm, 1e-12f);
        const float keff = k * (1.f + (a - 1.f) * kac);
        const float bon = wave_sum(r * keff * rkc);
        const size_t o = (size_t)row * 256 + tid;
        RW[o] = decay; RR[o] = f2bf(r); RK[o] = f2bf(keff); RV[o] = f2bf(v); RKK[o] = f2bf(kk); RKKA[o] = f2bf(kk * a); RG[o] = f2bf(accg[tk]);
        if (lane == 0) BON[(size_t)row * 4 + (tid >> 6)] = bon;
    }
}

DEV void rwkv_prep_tile2(const Params& p, int l, int tile, unsigned char* lds) {
    u16* actb = (u16*)lds;
    const int tid = TID(), lane = tid & 63, wave = tid >> 6, q4 = lane >> 4, cidx = lane & 15;
    unsigned char* ws = p.ws;
    const u16* pr = (const u16*)(ws + OFF_PRWKV);
    const float* mu = p.in[I_MU] + l * 1024;
    const int R0 = tile * 16;
    {
        const int col = 768 + tid; const float muc = mu[col];
#pragma unroll 4
        for (int tk = 0; tk < 16; ++tk) {
            const int row = R0 + tk; const int t = row & 8191;
            const float cur = bf2f(pr[(size_t)row * 1024 + col]);
            const float prev = t > 0 ? bf2f(pr[(size_t)(row - 1) * 1024 + col]) : 0.f;
            const float x = cur + (prev - cur) * muc;
            float a;
            if (tid < 64) a = tanhf(x); else if (tid < 128) a = x; else a = sigmoidf_(x);
            actb[tk * 264 + tid] = f2bf(a);
        }
    }
    __syncthreads();
    f32x4 accw[4], acca[4], accg[4];
    {
        bf16x8 af[8];
#pragma unroll
        for (int s2 = 0; s2 < 8; ++s2) af[s2] = *(const bf16x8*)(actb + cidx * 264 + 32 * s2 + 8 * q4);
        const u16* LW = (const u16*)(ws + OFF_LW) + (size_t)l * 65536;
        const f32x4 z = (f32x4){0.f, 0.f, 0.f, 0.f};
#pragma unroll
        for (int nt = 0; nt < 4; ++nt) {
            const u16* bp = LW + (size_t)(64 * wave + 16 * nt + cidx) * 256 + 8 * q4;
            accw[nt] = mfma16(af[0], ld8(bp), z); accw[nt] = mfma16(af[1], ld8(bp + 32), accw[nt]);
            acca[nt] = mfma16(af[2], ld8(bp + 64), z); acca[nt] = mfma16(af[3], ld8(bp + 96), acca[nt]);
            accg[nt] = mfma16(af[4], ld8(bp + 128), z); accg[nt] = mfma16(af[5], ld8(bp + 160), accg[nt]);
            accg[nt] = mfma16(af[6], ld8(bp + 192), accg[nt]); accg[nt] = mfma16(af[7], ld8(bp + 224), accg[nt]);
        }
    }
    float* RW = (float*)(ws + OFF_RW);
    u16 *RR = (u16*)(ws + OFF_RR), *RK = (u16*)(ws + OFF_RK), *RV = (u16*)(ws + OFF_RV), *RKK = (u16*)(ws + OFF_RKK), *RKKA = (u16*)(ws + OFF_RKKA),
        *RG = (u16*)(ws + OFF_RG);
    float* BON = (float*)(ws + OFF_BONUS);
    float w0[4], a0[4], kkc[4], kac[4], rkc[4], mur[4], muk[4], muv[4];
#pragma unroll
    for (int nt = 0; nt < 4; ++nt) {
        const int c = 64 * wave + 16 * nt + cidx;
        w0[nt] = p.in[I_W0][l * 256 + c]; a0[nt] = p.in[I_A0][l * 256 + c]; kkc[nt] = p.in[I_KK][l * 256 + c]; kac[nt] = p.in[I_KA][l * 256 + c];
        rkc[nt] = p.in[I_RK][l * 256 + c]; mur[nt] = mu[c]; muk[nt] = mu[256 + c]; muv[nt] = mu[512 + c];
    }
#pragma unroll
    for (int r = 0; r < 4; ++r) {
        const int row = R0 + 4 * q4 + r; const int t = row & 8191;
        const u16* cr = pr + (size_t)row * 1024; const u16* pv = cr - 1024;
        float rr[4], kf_[4], vf_[4], av[4], kkv[4], keff[4], dec[4];
        float kk2 = 0.f, bn = 0.f;
#pragma unroll
        for (int nt = 0; nt < 4; ++nt) {
            const int c = 64 * wave + 16 * nt + cidx;
            float rv = bf2f(cr[c]), kv = bf2f(cr[256 + c]), vv = bf2f(cr[512 + c]);
            const float rp = t > 0 ? bf2f(pv[c]) : 0.f, kp = t > 0 ? bf2f(pv[256 + c]) : 0.f, vp = t > 0 ? bf2f(pv[512 + c]) : 0.f;
            rv += (rp - rv) * mur[nt]; kv += (kp - kv) * muk[nt]; vv += (vp - vv) * muv[nt];
            const float wl = w0[nt] + accw[nt][r];
            const float wlog = -softplusf_(-wl) - 0.5f;
            dec[nt] = __expf(-__expf(wlog));
            av[nt] = sigmoidf_(a0[nt] + acca[nt][r]);
            kkv[nt] = kv * kkc[nt]; kk2 += kkv[nt] * kkv[nt];
            keff[nt] = kv * (1.f + (av[nt] - 1.f) * kac[nt]);
            bn += rv * keff[nt] * rkc[nt];
            rr[nt] = rv; kf_[nt] = kv; vf_[nt] = vv;
        }
        kk2 = reduce16(kk2); bn = reduce16(bn);
        const float inv = 1.f / fmaxf(sqrtf(kk2), 1e-12f);
#pragma unroll
        for (int nt = 0; nt < 4; ++nt) {
            const int c = 64 * wave + 16 * nt + cidx;
            const size_t o = (size_t)row * 256 + c;
            const float kk = kkv[nt] * inv;
            RW[o] = dec[nt]; RR[o] = f2bf(rr[nt]); RK[o] = f2bf(keff[nt]); RV[o] = f2bf(vf_[nt]); RKK[o] = f2bf(kk); RKKA[o] = f2bf(kk * av[nt]);
            RG[o] = f2bf(accg[nt][r]);
        }
        if (cidx == 0) BON[(size_t)row * 4 + wave] = bn;
    }
}

DEV void rwkv_scan(const Params& p, int sb, unsigned char* lds) {
    unsigned char* ws = p.ws;
    const float* RW = (const float*)(ws + OFF_RW);
    const u16 *RR = (const u16*)(ws + OFF_RR), *RK = (const u16*)(ws + OFF_RK), *RV = (const u16*)(ws + OFF_RV), *RKK = (const u16*)(ws + OFF_RKK),
              *RKKA = (const u16*)(ws + OFF_RKKA);
    float* YR = (float*)(ws + OFF_YRAW);
    const int tid = TID(), lane = tid & 63, wave = tid >> 6;
    const int bh = sb >> 2, rg = sb & 3; const int b = bh >> 2, hh = bh & 3;
    float* L = (float*)lds;
    constexpr int BUFSZ = 5 * 1024 + 256;
    float* Yb = L + 2 * BUFSZ;
    const int row_local = 4 * wave + (lane >> 4); const int kq = (lane & 15) * 4;
    const int lstep = tid >> 4, lk = (tid & 15) * 4;
    const int vstep = tid >> 4, vrow = tid & 15;
    const size_t gbase = (size_t)b * 8192 * 256 + hh * 64;
    float4 lw; u32x2 lr, lkk, lkka, lk_; u16 lv;
    auto issue = [&](int c) {
        const size_t o = gbase + (size_t)(c * 16 + lstep) * 256 + lk;
        lw = *(const float4*)(RW + o);
        lr = *(const u32x2*)(RR + o); lk_ = *(const u32x2*)(RK + o); lkk = *(const u32x2*)(RKK + o); lkka = *(const u32x2*)(RKKA + o);
        lv = RV[gbase + (size_t)(c * 16 + vstep) * 256 + rg * 16 + vrow];
    };
    auto commit = [&](int buf) {
        float* B = L + buf * BUFSZ;
        const int o = lstep * 64 + lk;
        *(float4*)(B + o) = lw;
        *(float4*)(B + 1024 + o) = (float4){bflo(lkka[0]), bfhi(lkka[0]), bflo(lkka[1]), bfhi(lkka[1])};
        *(float4*)(B + 2048 + o) = (float4){bflo(lk_[0]), bfhi(lk_[0]), bflo(lk_[1]), bfhi(lk_[1])};
        *(float4*)(B + 3072 + o) = (float4){bflo(lr[0]), bfhi(lr[0]), bflo(lr[1]), bfhi(lr[1])};
        *(float4*)(B + 4096 + o) = (float4){bflo(lkk[0]), bfhi(lkk[0]), bflo(lkk[1]), bfhi(lkk[1])};
        B[5120 + vstep * 16 + vrow] = bf2f(lv);
    };
    __syncthreads();
    issue(0); commit(0);
    __syncthreads();
    float S0 = 0.f, S1 = 0.f, S2 = 0.f, S3 = 0.f;
    constexpr int NCH = NT / 16;
    for (int c = 0; c < NCH; ++c) {
        const int buf = c & 1;
        if (c + 1 < NCH) issue(c + 1);
        const float* B = L + buf * BUFSZ;
        float* Y = Yb + buf * 256;
        float yv[16];
        float4 w4 = *(const float4*)(B + kq), a4 = *(const float4*)(B + 1024 + kq), k4 = *(const float4*)(B + 2048 + kq),
               r4 = *(const float4*)(B + 3072 + kq), n4 = *(const float4*)(B + 4096 + kq);
        float vv = B[5120 + row_local];
#pragma unroll
        for (int st = 0; st < 16; ++st) {
            float4 w4n, a4n, k4n, r4n, n4n; float vvn;
            if (st < 15) {
                w4n = *(const float4*)(B + (st + 1) * 64 + kq); a4n = *(const float4*)(B + 1024 + (st + 1) * 64 + kq);
                k4n = *(const float4*)(B + 2048 + (st + 1) * 64 + kq); r4n = *(const float4*)(B + 3072 + (st + 1) * 64 + kq);
                n4n = *(const float4*)(B + 4096 + (st + 1) * 64 + kq); vvn = B[5120 + (st + 1) * 16 + row_local];
            }
            const float part = (S0 * n4.x + S1 * n4.y) + (S2 * n4.z + S3 * n4.w);
            const float sa = -reduce16(part);
            const float t0 = S0 * w4.x + vv * k4.x, t1 = S1 * w4.y + vv * k4.y, t2 = S2 * w4.z + vv * k4.z, t3 = S3 * w4.w + vv * k4.w;
            S0 = t0 + sa * a4.x; S1 = t1 + sa * a4.y; S2 = t2 + sa * a4.z; S3 = t3 + sa * a4.w;
            const float yp = (S0 * r4.x + S1 * r4.y) + (S2 * r4.z + S3 * r4.w);
            yv[st] = reduce16(yp);
            if (st < 15) { w4 = w4n; a4 = a4n; k4 = k4n; r4 = r4n; n4 = n4n; vv = vvn; }
        }
        if ((lane & 15) == 0) {
#pragma unroll
            for (int st = 0; st < 16; ++st) Y[st * 16 + row_local] = yv[st];
        }
        if (c + 1 < NCH) commit(buf ^ 1);
        __syncthreads();
        YR[gbase + (size_t)(c * 16 + vstep) * 256 + rg * 16 + vrow] = Y[vstep * 16 + vrow];
    }
}

DEV void phase_rwkv_post(const Params& p, int l) {
    unsigned char* ws = p.ws;
    const float* YR = (const float*)(ws + OFF_YRAW); const float* BON = (const float*)(ws + OFF_BONUS);
    const u16 *RV = (const u16*)(ws + OFF_RV), *RG = (const u16*)(ws + OFF_RG);
    u16* mix = (u16*)(ws + OFF_MIX);
    const int tid = TID();
    const float lg = p.in[I_LNG][l * 256 + tid], lb = p.in[I_LNB][l * 256 + tid];
    for (int row = BID(); row < NTOK; row += gridDim.x) {
        const size_t o = (size_t)row * 256 + tid;
        const float y = YR[o];
        const float mean = wave_sum(y) * (1.f / 64.f);
        const float d = y - mean;
        const float var = wave_sum(d * d) * (1.f / 64.f);
        const float yn = d * rsqrtf(var + 64e-5f) * lg + lb;
        const float outv = (yn + BON[(size_t)row * 4 + (tid >> 6)] * bf2f(RV[o])) * bf2f(RG[o]);
        mix[(size_t)row * 1024 + 256 + tid] = f2bf(outv);
    }
}

DEV void zero_mix_cols(const Params& p, int c0, int ncols) {
    u16* mix = (u16*)(p.ws + OFF_MIX);
    const int per = ncols / 8;
    const size_t total = (size_t)NTOK * per;
    for (size_t i = (size_t)BID() * 256 + TID(); i < total; i += (size_t)gridDim.x * 256) {
        const size_t row = i / per; const int cc = (int)(i % per);
        *(u32x4*)(mix + row * 1024 + c0 + cc * 8) = (u32x4){0u, 0u, 0u, 0u};
    }
}


DEV void load_kv(const u16* __restrict__ Kb, const u16* __restrict__ VTb, int q4, int cidx, bf16x8 (&kf)[8], bf16x8 (&vf)[8]) {
#pragma unroll
    for (int kt = 0; kt < 4; ++kt) { const u16* kp = Kb + (kt * 16 + cidx) * 64 + 8 * q4; kf[2 * kt] = ld8(kp); kf[2 * kt + 1] = ld8(kp + 32); }
#pragma unroll
    for (int kb = 0; kb < 2; ++kb)
#pragma unroll
        for (int mt = 0; mt < 4; ++mt) vf[kb * 4 + mt] = ld8(VTb + (size_t)(16 * mt + cidx) * 8192 + kb * 32 + 8 * q4);
}
DEV void qk_tile(const bf16x8 (&kf)[8], bf16x8 q0, bf16x8 q1, f32x4 (&st)[4]) {
#pragma unroll
    for (int kt = 0; kt < 4; ++kt) {
        st[kt] = mfma16(kf[2 * kt], q0, (f32x4){0.f, 0.f, 0.f, 0.f});
        st[kt] = mfma16(kf[2 * kt + 1], q1, st[kt]);
    }
}
DEV void softmax_pv_tile(bool MASK, f32x4 (&st)[4], const bf16x8 (&vf)[8], int keybase, int tcol, int lowcol, bool colsel, float& m, float& l, f32x4 (&O)[4], int q4) {
    float lmax = -1e30f;
    if (MASK) {
        const int hi = colsel ? tcol : -1;
#pragma unroll
        for (int kt = 0; kt < 4; ++kt)
#pragma unroll
            for (int r = 0; r < 4; ++r) {
                const int key = keybase + kt * 16 + 4 * q4 + r;
                const bool valid = (key <= hi) && (key > lowcol);
                const float sv = valid ? st[kt][r] : -1e30f;
                st[kt][r] = sv; lmax = fmaxf(lmax, sv);
            }
    } else {
        const float cs = colsel ? 0.f : -1e30f;
#pragma unroll
        for (int kt = 0; kt < 4; ++kt)
#pragma unroll
            for (int r = 0; r < 4; ++r) { const float sv = st[kt][r] + cs; st[kt][r] = sv; lmax = fmaxf(lmax, sv); }
    }
    lmax = colmax(lmax);
    const float mnew = fmaxf(m, lmax);
    const float alpha = ex2(m - mnew);
    float psum = 0.f;
#pragma unroll
    for (int kt = 0; kt < 4; ++kt)
#pragma unroll
        for (int r = 0; r < 4; ++r) {
            float pv = ex2(st[kt][r] - mnew);
            pv = (st[kt][r] > -1e29f) ? pv : 0.f;
            st[kt][r] = pv; psum += pv;
        }
    l = l * alpha + psum;
    if (__any(mnew > m)) {
#pragma unroll
        for (int mt = 0; mt < 4; ++mt) { O[mt][0] *= alpha; O[mt][1] *= alpha; O[mt][2] *= alpha; O[mt][3] *= alpha; }
    }
    m = mnew;
#pragma unroll
    for (int kb = 0; kb < 2; ++kb) {
        union { bf16x8 v; unsigned u[4]; } pb;
        pb.u[0] = pack2(st[2 * kb][0], st[2 * kb][1]); pb.u[1] = pack2(st[2 * kb][2], st[2 * kb][3]);
        pb.u[2] = pack2(st[2 * kb + 1][0], st[2 * kb + 1][1]); pb.u[3] = pack2(st[2 * kb + 1][2], st[2 * kb + 1][3]);
#pragma unroll
        for (int mt = 0; mt < 4; ++mt) O[mt] = mfma16(vf[kb * 4 + mt], pb.v, O[mt]);
    }
}
DEV unsigned pick4(unsigned a0, unsigned a1, unsigned a2, unsigned a3, int w) { return w == 0 ? a0 : (w == 1 ? a1 : (w == 2 ? a2 : a3)); }
DEV void nsa_branch(const u16* __restrict__ K0, const u16* __restrict__ VT0, unsigned ua0, unsigned ua1, unsigned ua2, unsigned ua3, unsigned ub0,
                    unsigned ub1, unsigned ub2, unsigned ub3, const unsigned* cm, int tokl, const int (&tcol)[2], const int (&lowc)[2],
                    const bf16x8 (&qf)[2][2], float (&m)[2], float (&l)[2], f32x4 (&O)[2][4], int q4, int cidx, int cur, int lowmax) {
    int w = 0; unsigned bits = ua0 | ub0;
    auto advance = [&]() -> int {
        while (bits == 0u && w < 3) { ++w; bits = pick4(ua0, ua1, ua2, ua3, w) | pick4(ub0, ub1, ub2, ub3, w); }
        if (bits == 0u) return -1;
        const int jb = __builtin_ctz(bits); bits &= bits - 1u;
        return w * 32 + jb;
    };
    int blk = advance();
    if (blk < 0) return;
    bf16x8 kf[8], vf[8];
    {
        const u16* Kb = K0 + (size_t)blk * 64 * 64;
#pragma unroll
        for (int kt = 0; kt < 4; ++kt) { const u16* kp = Kb + (kt * 16 + cidx) * 64 + 8 * q4; kf[2 * kt] = ld8(kp); kf[2 * kt + 1] = ld8(kp + 32); }
    }
#pragma unroll 1
    while (blk >= 0) {
        {
            const u16* VTb = VT0 + blk * 64;
#pragma unroll
            for (int kb = 0; kb < 2; ++kb)
#pragma unroll
                for (int mt = 0; mt < 4; ++mt) vf[kb * 4 + mt] = ld8(VTb + (size_t)(16 * mt + cidx) * 8192 + kb * 32 + 8 * q4);
        }
        const int wq = blk >> 5, jb = blk & 31;
        const bool act0 = (pick4(ua0, ua1, ua2, ua3, wq) >> jb) & 1u, act1 = (pick4(ub0, ub1, ub2, ub3, wq) >> jb) & 1u;
        f32x4 st0[4], st1[4];
        if (act0) qk_tile(kf, qf[0][0], qf[0][1], st0);
        if (act1) qk_tile(kf, qf[1][0], qf[1][1], st1);
        const int nblk = advance();
        if (nblk >= 0) {
            const u16* Kb = K0 + (size_t)nblk * 64 * 64;
#pragma unroll
            for (int kt = 0; kt < 4; ++kt) { const u16* kp = Kb + (kt * 16 + cidx) * 64 + 8 * q4; kf[2 * kt] = ld8(kp); kf[2 * kt + 1] = ld8(kp + 32); }
        }
        const bool need_mask = (blk == cur) || (blk * 64 <= lowmax);
        if (act0) {
            const bool cs = cm ? (((cm[tokl * 4 + wq] >> jb) & 1u) != 0u) : true;
            softmax_pv_tile(need_mask, st0, vf, blk * 64, tcol[0], lowc[0], cs, m[0], l[0], O[0], q4);
        }
        if (act1) {
            const bool cs = cm ? (((cm[(4 + tokl) * 4 + wq] >> jb) & 1u) != 0u) : true;
            softmax_pv_tile(need_mask, st1, vf, blk * 64, tcol[1], lowc[1], cs, m[1], l[1], O[1], q4);
        }
        blk = nblk;
    }
}
template <int CTRL> DEV unsigned dpp_or(unsigned x) { return x | dppu<CTRL>(x); }
DEV unsigned row_or(unsigned x) { x = dpp_or<0xB1>(x); x = dpp_or<0x4E>(x); x = dpp_or<0x124>(x); x = dpp_or<0x128>(x); return x; }


DEV void nsa_branch_lds(unsigned char* lds, const u16* __restrict__ K0, const u16* __restrict__ VT0, unsigned bu0, unsigned bu1, unsigned bu2,
                        unsigned bu3, unsigned ua0, unsigned ua1, unsigned ua2, unsigned ua3, unsigned ub0, unsigned ub1, unsigned ub2, unsigned ub3,
                        const unsigned* cm, int tokl, const int (&tcol)[2], const int (&lowc)[2], const bf16x8 (&qf)[2][2], float (&m)[2],
                        float (&l)[2], f32x4 (&O)[2][4], int q4, int cidx, int cur, int lowmax) {
    const int tid = TID();
    int w = 0; unsigned bits = bu0;
    auto advance = [&]() -> int {
        while (bits == 0u && w < 3) { ++w; bits = pick4(bu0, bu1, bu2, bu3, w); }
        if (bits == 0u) return -1;
        const int jb = __builtin_ctz(bits); bits &= bits - 1u;
        return w * 32 + jb;
    };
    const int srow0 = tid >> 3, srow1 = srow0 + 32, sch = tid & 7;
    const int so0 = srow0 * 128 + ((sch ^ (srow0 & 7)) << 4), so1 = srow1 * 128 + ((sch ^ (srow1 & 7)) << 4);
    bf16x8 r[4];
    int blk = advance();
    if (blk < 0) return;
    {
        r[0] = ld8(K0 + ((size_t)blk * 64 + srow0) * 64 + sch * 8); r[1] = ld8(K0 + ((size_t)blk * 64 + srow1) * 64 + sch * 8);
        r[2] = ld8(VT0 + (size_t)srow0 * 8192 + blk * 64 + sch * 8); r[3] = ld8(VT0 + (size_t)srow1 * 8192 + blk * 64 + sch * 8);
        *(bf16x8*)(lds + so0) = r[0]; *(bf16x8*)(lds + so1) = r[1]; *(bf16x8*)(lds + 8192 + so0) = r[2]; *(bf16x8*)(lds + 8192 + so1) = r[3];
    }
    __syncthreads();
    int buf = 0;
#pragma unroll 1
    while (blk >= 0) {
        const int nblk = advance();
        if (nblk >= 0) {
            r[0] = ld8(K0 + ((size_t)nblk * 64 + srow0) * 64 + sch * 8); r[1] = ld8(K0 + ((size_t)nblk * 64 + srow1) * 64 + sch * 8);
            r[2] = ld8(VT0 + (size_t)srow0 * 8192 + nblk * 64 + sch * 8); r[3] = ld8(VT0 + (size_t)srow1 * 8192 + nblk * 64 + sch * 8);
        }
        const int wq = blk >> 5, jb = blk & 31;
        const bool act0 = (pick4(ua0, ua1, ua2, ua3, wq) >> jb) & 1u, act1 = (pick4(ub0, ub1, ub2, ub3, wq) >> jb) & 1u;
        if (act0 || act1) {
            const unsigned char* kb_ = lds + buf * 16384;
            bf16x8 kf[8], vf[8];
#pragma unroll
            for (int kt = 0; kt < 4; ++kt)
#pragma unroll
                for (int s2 = 0; s2 < 2; ++s2) {
                    const int row = 16 * kt + cidx, ch = 4 * s2 + q4;
                    kf[2 * kt + s2] = *(const bf16x8*)(kb_ + row * 128 + ((ch ^ (row & 7)) << 4));
                }
#pragma unroll
            for (int kb = 0; kb < 2; ++kb)
#pragma unroll
                for (int mt = 0; mt < 4; ++mt) {
                    const int row = 16 * mt + cidx, ch = 4 * kb + q4;
                    vf[kb * 4 + mt] = *(const bf16x8*)(kb_ + 8192 + row * 128 + ((ch ^ (row & 7)) << 4));
                }
            const bool need_mask = (blk == cur) || (blk * 64 <= lowmax);
            f32x4 st0[4], st1[4];
            if (act0) qk_tile(kf, qf[0][0], qf[0][1], st0);
            if (act1) qk_tile(kf, qf[1][0], qf[1][1], st1);
            if (act0) {
                const bool cs = cm ? (((cm[tokl * 4 + wq] >> jb) & 1u) != 0u) : true;
                softmax_pv_tile(need_mask, st0, vf, blk * 64, tcol[0], lowc[0], cs, m[0], l[0], O[0], q4);
            }
            if (act1) {
                const bool cs = cm ? (((cm[(4 + tokl) * 4 + wq] >> jb) & 1u) != 0u) : true;
                softmax_pv_tile(need_mask, st1, vf, blk * 64, tcol[1], lowc[1], cs, m[1], l[1], O[1], q4);
            }
        }
        if (nblk >= 0) {
            unsigned char* wb_ = lds + (buf ^ 1) * 16384;
            *(bf16x8*)(wb_ + so0) = r[0]; *(bf16x8*)(wb_ + so1) = r[1]; *(bf16x8*)(wb_ + 8192 + so0) = r[2]; *(bf16x8*)(wb_ + 8192 + so1) = r[3];
        }
        __syncthreads();
        buf ^= 1; blk = nblk;
    }
}

DEV void nsa_block_task(const Params& p, int task, unsigned char* lds) {
    const int wave = TID() >> 6;
    float* wl = (float*)(lds + 32768) + wave * 2112;
    unsigned* bm = (unsigned*)(lds + 32768 + 4 * 8448);
    float* impA = wl; float* impB = wl + 1024; unsigned* selmask = (unsigned*)(wl + 1024 + 1056);
    unsigned char* ws = p.ws;
    const u16* Q = (const u16*)(ws + OFF_Q);
    const u16* KVb = (const u16*)(ws + OFF_KV);
    const u16 *KSEL = KVb + (size_t)2 * 4194304, *VSELT = KVb + (size_t)3 * 4194304, *KWIN = KVb + (size_t)4 * 4194304, *VWINT = KVb + (size_t)5 * 4194304;
    const u16* KC = (const u16*)(ws + OFF_KC); const u16* VCT = (const u16*)(ws + OFF_VCT);
    const float* GATE = (const float*)(ws + OFF_GATE);
    u16* mix = (u16*)(ws + OFF_MIX);
    const int lane = TID() & 63, q4 = lane >> 4, cidx = lane & 15;
    const int bg = task & 7, t0b = (255 - (task >> 3)) * 32, t0 = t0b + 8 * wave; const int b = bg >> 1, g = bg & 1;
    const int tokl = cidx >> 2, hr = cidx & 3; const int head = g * 4 + hr;
    const int cur = t0 >> 6;
    int tcol[2], rowc[2]; bf16x8 qf[2][2];
#pragma unroll
    for (int ti = 0; ti < 2; ++ti) {
        tcol[ti] = t0 + 4 * ti + tokl; rowc[ti] = b * 8192 + tcol[ti];
        qf[ti][0] = ld8(Q + (size_t)rowc[ti] * 512 + head * 64 + 8 * q4); qf[ti][1] = ld8(Q + (size_t)rowc[ti] * 512 + head * 64 + 32 + 8 * q4);
    }
    f32x4 Oc[2][4];
    {
        int cnt_col[2];
#pragma unroll
        for (int ti = 0; ti < 2; ++ti) cnt_col[ti] = tcol[ti] >= 31 ? ((tcol[ti] - 31) >> 4) + 1 : 0;
        const int tmax = t0 + 7; const int cmax = tmax >= 31 ? ((tmax - 31) >> 4) + 1 : 0;
        const int ntile = (cmax + 15) >> 4;
        const u16* kcb = KC + (size_t)bg * 512 * 64;
        float ml[2] = {-1e30f, -1e30f}, ll[2] = {0.f, 0.f};
#pragma unroll 1
        for (int kt = 0; kt < ntile; ++kt) {
            const u16* kp = kcb + (kt * 16 + cidx) * 64 + 8 * q4;
            const bf16x8 k0 = ld8(kp), k1 = ld8(kp + 32);
#pragma unroll
            for (int ti = 0; ti < 2; ++ti) {
                f32x4 st = mfma16(k0, qf[ti][0], (f32x4){0.f, 0.f, 0.f, 0.f});
                st = mfma16(k1, qf[ti][1], st);
                float sv[4]; float tm = -1e30f;
#pragma unroll
                for (int r = 0; r < 4; ++r) { const int n = kt * 16 + 4 * q4 + r; sv[r] = (n < cnt_col[ti]) ? st[r] : -1e30f; tm = fmaxf(tm, sv[r]); }
                const float mn = fmaxf(ml[ti], tm);
                float ps = 0.f;
#pragma unroll
                for (int r = 0; r < 4; ++r) ps += (sv[r] > -1e29f) ? ex2(sv[r] - mn) : 0.f;
                ll[ti] = ll[ti] * ex2(ml[ti] - mn) + ps; ml[ti] = mn;
            }
        }
        float mfin[2], inv[2];
#pragma unroll
        for (int ti = 0; ti < 2; ++ti) {
            mfin[ti] = colmax(ml[ti]);
            const float lsum = colsum(ll[ti] * ex2(ml[ti] - mfin[ti]));
            inv[ti] = (cnt_col[ti] > 0) ? 1.f / lsum : 0.f;
        }
#pragma unroll
        for (int ti = 0; ti < 2; ++ti)
#pragma unroll
            for (int mt = 0; mt < 4; ++mt) Oc[ti][mt] = (f32x4){0.f, 0.f, 0.f, 0.f};
        const int npair = (ntile + 1) >> 1;
#pragma unroll 1
        for (int kp2 = 0; kp2 < npair; ++kp2) {
            const int n0 = kp2 * 32;
            const u16* kp = kcb + (n0 + cidx) * 64 + 8 * q4;
            const bf16x8 ka0 = ld8(kp), ka1 = ld8(kp + 32), kb0 = ld8(kp + 1024), kb1 = ld8(kp + 1024 + 32);
            bf16x8 vf[4];
#pragma unroll
            for (int mt = 0; mt < 4; ++mt) vf[mt] = ld8(VCT + ((size_t)bg * 64 + 16 * mt + cidx) * 512 + n0 + 8 * q4);
#pragma unroll
            for (int ti = 0; ti < 2; ++ti) {
                float pa[4], pb_[4];
                f32x4 st = mfma16(ka0, qf[ti][0], (f32x4){0.f, 0.f, 0.f, 0.f});
                st = mfma16(ka1, qf[ti][1], st);
                f32x4 su = mfma16(kb0, qf[ti][0], (f32x4){0.f, 0.f, 0.f, 0.f});
                su = mfma16(kb1, qf[ti][1], su);
#pragma unroll
                for (int r = 0; r < 4; ++r) {
                    const int n = n0 + 4 * q4 + r;
                    pa[r] = (n < cnt_col[ti]) ? ex2(st[r] - mfin[ti]) * inv[ti] : 0.f;
                    pb_[r] = (n + 16 < cnt_col[ti]) ? ex2(su[r] - mfin[ti]) * inv[ti] : 0.f;
                }
                const float owna = quadsum(pa[0] + pa[1] + pa[2] + pa[3]), tha = quadsum(pa[3]);
                const float ownb = quadsum(pb_[0] + pb_[1] + pb_[2] + pb_[3]), thb = quadsum(pb_[3]);
                if (hr == 0) {
                    const int tk = 4 * ti + tokl;
                    const int sa = (n0 >> 2) + q4, sb2 = ((n0 + 16) >> 2) + q4;
                    impA[tk * 128 + sa] = owna; impB[tk * 132 + sa + 1] = tha;
                    impA[tk * 128 + sb2] = ownb; impB[tk * 132 + sb2 + 1] = thb;
                }
                union { bf16x8 v; unsigned u[4]; } pk;
                pk.u[0] = pack2(pa[0], pa[1]); pk.u[1] = pack2(pa[2], pa[3]); pk.u[2] = pack2(pb_[0], pb_[1]); pk.u[3] = pack2(pb_[2], pb_[3]);
#pragma unroll
                for (int mt = 0; mt < 4; ++mt) Oc[ti][mt] = mfma16(vf[mt], pk.v, Oc[ti][mt]);
            }
        }
#pragma unroll
        for (int ti = 0; ti < 2; ++ti) {
            const float gc = GATE[(size_t)rowc[ti] * 24 + head];
#pragma unroll
            for (int mt = 0; mt < 4; ++mt)
#pragma unroll
                for (int r = 0; r < 4; ++r) Oc[ti][mt][r] *= gc;
        }
    }
    lds_fence();
#pragma unroll 1
    for (int rd = 0; rd < 2; ++rd) {
        const int tk = 4 * rd + q4;
        unsigned m0 = 0u, m1 = 0u, m2 = 0u, m3 = 0u;
        if (cur < 16) { m0 = (2u << cur) - 1u; }
        else {
            unsigned key[8];
#pragma unroll
            for (int i = 0; i < 8; ++i) {
                const int sblk = cidx + 16 * i;
                const bool cand = (sblk >= 1) && (sblk <= cur - 2);
                const float v = impA[tk * 128 + sblk] + impB[tk * 132 + sblk];
                key[i] = cand ? ((__float_as_uint(v) & ~0x7Fu) | (unsigned)(127 - sblk)) : 0u;
            }
            int mysel = (cidx == 0) ? 0 : (cidx == 1 ? cur - 1 : (cidx == 2 ? cur : -1));
#pragma unroll 1
            for (int it = 0; it < 13; ++it) {
                unsigned mx = key[0];
#pragma unroll
                for (int i = 1; i < 8; ++i) mx = max(mx, key[i]);
                mx = max(mx, dppu<0xB1>(mx)); mx = max(mx, dppu<0x4E>(mx)); mx = max(mx, dppu<0x124>(mx)); mx = max(mx, dppu<0x128>(mx));
                const int sblk = 127 - (int)(mx & 127u);
#pragma unroll
                for (int i = 0; i < 8; ++i) key[i] = (key[i] == mx) ? 0u : key[i];
                if (cidx == it + 3) mysel = sblk;
            }
            const unsigned bit = 1u << (mysel & 31); const int wsel = mysel >> 5;
            m0 = row_or(wsel == 0 ? bit : 0u); m1 = row_or(wsel == 1 ? bit : 0u); m2 = row_or(wsel == 2 ? bit : 0u); m3 = row_or(wsel == 3 ? bit : 0u);
        }
        if (cidx < 4) selmask[tk * 4 + cidx] = (cidx == 0) ? m0 : (cidx == 1 ? m1 : (cidx == 2 ? m2 : m3));
    }
    lds_fence();
    f32x4* accl = (f32x4*)wl;
#pragma unroll
    for (int ti = 0; ti < 2; ++ti)
#pragma unroll
        for (int mt = 0; mt < 4; ++mt) accl[(ti * 4 + mt) * 64 + lane] = Oc[ti][mt];
    {
        float m[2] = {-1e30f, -1e30f}, l[2] = {0.f, 0.f}; f32x4 Os[2][4];
#pragma unroll
        for (int ti = 0; ti < 2; ++ti)
#pragma unroll
            for (int mt = 0; mt < 4; ++mt) Os[ti][mt] = (f32x4){0.f, 0.f, 0.f, 0.f};
        {
            unsigned ua[4], ub[4], bu[4];
#pragma unroll
            for (int w = 0; w < 4; ++w) {
                ua[w] = __builtin_amdgcn_readfirstlane(row_or(selmask[tokl * 4 + w]));
                ub[w] = __builtin_amdgcn_readfirstlane(row_or(selmask[(4 + tokl) * 4 + w]));
            }
            if (lane < 4) bm[wave * 4 + lane] = (lane == 0) ? (ua[0] | ub[0]) : (lane == 1 ? (ua[1] | ub[1]) : (lane == 2 ? (ua[2] | ub[2]) : (ua[3] | ub[3])));
            __syncthreads();
#pragma unroll
            for (int w = 0; w < 4; ++w) bu[w] = __builtin_amdgcn_readfirstlane(bm[w] | bm[4 + w] | bm[8 + w] | bm[12 + w]);
            const int lowc[2] = {-1, -1};
            nsa_branch_lds(lds, KSEL + (size_t)bg * 8192 * 64, VSELT + (size_t)bg * 64 * 8192, bu[0], bu[1], bu[2], bu[3], ua[0], ua[1], ua[2], ua[3], ub[0],
                           ub[1], ub[2], ub[3], selmask, tokl, tcol, lowc, qf, m, l, Os, q4, cidx, cur, -1);
        }
#pragma unroll
        for (int ti = 0; ti < 2; ++ti) {
            const float sc = GATE[(size_t)rowc[ti] * 24 + 8 + head] / colsum(l[ti]);
#pragma unroll
            for (int mt = 0; mt < 4; ++mt)
#pragma unroll
                for (int r = 0; r < 4; ++r) Os[ti][mt][r] *= sc;
        }
        lds_fence();
#pragma unroll
        for (int ti = 0; ti < 2; ++ti)
#pragma unroll
            for (int mt = 0; mt < 4; ++mt) { f32x4 a = accl[(ti * 4 + mt) * 64 + lane]; a += Os[ti][mt]; accl[(ti * 4 + mt) * 64 + lane] = a; }
    }
    {
        float m[2] = {-1e30f, -1e30f}, l[2] = {0.f, 0.f}; f32x4 Ow[2][4];
#pragma unroll
        for (int ti = 0; ti < 2; ++ti)
#pragma unroll
            for (int mt = 0; mt < 4; ++mt) Ow[ti][mt] = (f32x4){0.f, 0.f, 0.f, 0.f};
        int wb0 = (t0 - 511) >> 6; if (wb0 < 0) wb0 = 0;
        int wbb = (t0b - 511) >> 6; if (wbb < 0) wbb = 0;
        {
            unsigned uw[4], bu[4];
#pragma unroll
            for (int w = 0; w < 4; ++w) {
                const int hi = cur - 32 * w;
                unsigned mk = 0u, mkb = 0u;
                if (hi >= 0) {
                    const unsigned upper = (hi >= 31) ? 0xffffffffu : ((2u << hi) - 1u);
                    const int lo = wb0 - 32 * w, lob = wbb - 32 * w;
                    if (lo <= 31) mk = upper & ~((lo <= 0) ? 0u : ((1u << lo) - 1u));
                    if (lob <= 31) mkb = upper & ~((lob <= 0) ? 0u : ((1u << lob) - 1u));
                }
                uw[w] = mk; bu[w] = mkb;
            }
            const int lowc[2] = {tcol[0] - 512, tcol[1] - 512};
            nsa_branch_lds(lds, KWIN + (size_t)bg * 8192 * 64, VWINT + (size_t)bg * 64 * 8192, bu[0], bu[1], bu[2], bu[3], uw[0], uw[1], uw[2], uw[3], uw[0],
                           uw[1], uw[2], uw[3], nullptr, tokl, tcol, lowc, qf, m, l, Ow, q4, cidx, cur, t0 + 7 - 512);
        }
#pragma unroll
        for (int ti = 0; ti < 2; ++ti) {
            const float sc = GATE[(size_t)rowc[ti] * 24 + 16 + head] / colsum(l[ti]);
#pragma unroll
            for (int mt = 0; mt < 4; ++mt)
#pragma unroll
                for (int r = 0; r < 4; ++r) Ow[ti][mt][r] *= sc;
        }
        lds_fence();
#pragma unroll
        for (int ti = 0; ti < 2; ++ti)
#pragma unroll
            for (int mt = 0; mt < 4; ++mt) {
                const f32x4 a = accl[(ti * 4 + mt) * 64 + lane];
                const f32x4 o = Ow[ti][mt];
                u32x2 wv; wv[0] = pack2(a[0] + o[0], a[1] + o[1]); wv[1] = pack2(a[2] + o[2], a[3] + o[3]);
                *(u32x2*)(mix + (size_t)rowc[ti] * 1024 + 512 + head * 64 + 16 * mt + 4 * q4) = wv;
            }
    }


    __syncthreads();
}

DEV unsigned sortable(float f) { const unsigned b = __float_as_uint(f); return (b & 0x80000000u) ? ~b : (b | 0x80000000u); }
DEV float unsortable(unsigned u) { return __uint_as_float((u & 0x80000000u) ? (u ^ 0x80000000u) : ~u); }
template <int N> DEV unsigned kth16_threshold(const unsigned (&u)[N]) {
    unsigned T = 0;
    for (int bit = 31; bit >= 0; --bit) {
        const unsigned cand = T | (1u << bit);
        int cnt = 0;
#pragma unroll
        for (int i = 0; i < N; ++i) cnt += (u[i] >= cand) ? 1 : 0;
        cnt = colsumi(cnt);
        if (cnt >= 16) T = cand;
    }
    return T;
}
template <int N, class F> DEV void compact16(const unsigned (&u)[N], unsigned T, int q4, int cidx, F emit) {
    int cgt = 0, ceq = 0;
#pragma unroll
    for (int i = 0; i < N; ++i) { cgt += (u[i] > T) ? 1 : 0; ceq += (u[i] == T) ? 1 : 0; }
    const int g0 = __shfl(cgt, cidx), g1 = __shfl(cgt, cidx + 16), g2 = __shfl(cgt, cidx + 32), g3 = __shfl(cgt, cidx + 48);
    const int e0 = __shfl(ceq, cidx), e1 = __shfl(ceq, cidx + 16), e2 = __shfl(ceq, cidx + 32);
    int pg = (q4 > 0 ? g0 : 0) + (q4 > 1 ? g1 : 0) + (q4 > 2 ? g2 : 0);
    int pe = g0 + g1 + g2 + g3 + (q4 > 0 ? e0 : 0) + (q4 > 1 ? e1 : 0) + (q4 > 2 ? e2 : 0);
#pragma unroll
    for (int i = 0; i < N; ++i) {
        if (u[i] > T) { emit(i, pg); ++pg; }
        else if (u[i] == T) { if (pe < 16) emit(i, pe); ++pe; }
    }
}

DEV void peer_topk_task(const Params& p, int l, int task, float* wl) {
    unsigned char* ws = p.ws;
    const u16* QP = (const u16*)(ws + OFF_QP);
    const u16* K12 = (const u16*)(ws + OFF_K12) + (size_t)l * 2 * 16384;
    int* PIDX = (int*)(ws + OFF_PIDX); float* PGW = (float*)(ws + OFF_PGW);
    const int lane = TID() & 63, q4 = lane >> 4, cidx = lane & 15;
    const int tq = task * 2 + (cidx >> 3), hh = cidx & 7;
    float* vv[2] = {wl, wl + 512}; int* ii[2] = {(int*)(wl + 256), (int*)(wl + 768)};
    float* fs = wl + 1024; int* fi = (int*)(wl + 1280);
#pragma unroll
    for (int hf = 0; hf < 2; ++hf) {
        bf16x8 qf[4];
#pragma unroll
        for (int s = 0; s < 4; ++s) qf[s] = ld8(QP + (size_t)tq * 2048 + hh * 256 + hf * 128 + 32 * s + 8 * q4);
        unsigned u[32];
        const u16* kb = K12 + hf * 16384;
#pragma unroll
        for (int kt = 0; kt < 8; ++kt) {
            f32x4 st = (f32x4){0.f, 0.f, 0.f, 0.f};
#pragma unroll
            for (int s = 0; s < 4; ++s) st = mfma16(ld8(kb + (kt * 16 + cidx) * 128 + 32 * s + 8 * q4), qf[s], st);
#pragma unroll
            for (int r = 0; r < 4; ++r) u[kt * 4 + r] = sortable(st[r]);
        }
        const unsigned T = kth16_threshold<32>(u);
        float* vo = vv[hf]; int* io = ii[hf];
        compact16<32>(u, T, q4, cidx, [&](int i, int pos) { vo[cidx * 16 + pos] = unsortable(u[i]); io[cidx * 16 + pos] = 16 * (i >> 2) + 4 * q4 + (i & 3); });
    }
    lds_fence();
    {
        unsigned u[64];
        float v2r[16];
#pragma unroll
        for (int j = 0; j < 16; ++j) v2r[j] = vv[1][cidx * 16 + j];
#pragma unroll
        for (int a = 0; a < 4; ++a) {
            const float v1a = vv[0][cidx * 16 + 4 * q4 + a];
#pragma unroll
            for (int j = 0; j < 16; ++j) u[a * 16 + j] = sortable(v1a + v2r[j]);
        }
        const unsigned T = kth16_threshold<64>(u);
        compact16<64>(u, T, q4, cidx, [&](int i, int pos) { fs[cidx * 16 + pos] = unsortable(u[i]); fi[cidx * 16 + pos] = (4 * q4 + (i >> 4)) * 16 + (i & 15); });
    }
    lds_fence();
    {
        float s4[4]; int c4[4];
#pragma unroll
        for (int k = 0; k < 4; ++k) { s4[k] = fs[cidx * 16 + 4 * q4 + k]; c4[k] = fi[cidx * 16 + 4 * q4 + k]; }
        float mx = fmaxf(fmaxf(s4[0], s4[1]), fmaxf(s4[2], s4[3]));
        mx = colmax(mx);
        float e4[4]; float sm = 0.f;
#pragma unroll
        for (int k = 0; k < 4; ++k) { e4[k] = __expf(s4[k] - mx); sm += e4[k]; }
        sm = colsum(sm);
        const float inv = 1.f / sm;
        int4 eo; float4 go;
        eo.x = ii[0][cidx * 16 + (c4[0] >> 4)] * 128 + ii[1][cidx * 16 + (c4[0] & 15)];
        eo.y = ii[0][cidx * 16 + (c4[1] >> 4)] * 128 + ii[1][cidx * 16 + (c4[1] & 15)];
        eo.z = ii[0][cidx * 16 + (c4[2] >> 4)] * 128 + ii[1][cidx * 16 + (c4[2] & 15)];
        eo.w = ii[0][cidx * 16 + (c4[3] >> 4)] * 128 + ii[1][cidx * 16 + (c4[3] & 15)];
        go.x = e4[0] * inv; go.y = e4[1] * inv; go.z = e4[2] * inv; go.w = e4[3] * inv;
        const size_t o = ((size_t)tq * 8 + hh) * 16 + 4 * q4;
        *(int4*)(PIDX + o) = eo; *(float4*)(PGW + o) = go;
    }
    lds_fence();
}


template <int N> DEV void ltmask(const float (&v)[N], float x, unsigned (&mk)[N / 32]) {
#pragma unroll
    for (int w = 0; w < N / 32; ++w) {
        unsigned acc = 0u;
#pragma unroll
        for (int i = 0; i < 32; ++i) acc = __builtin_amdgcn_alignbit(acc, __float_as_uint(v[w * 32 + i] - x), 31);
        mk[w] = acc;
    }
}
template <int N> DEV int count_ge(const float (&v)[N], float x) {
    unsigned mk[N / 32]; ltmask<N>(v, x, mk);
    int lt = 0;
#pragma unroll
    for (int w = 0; w < N / 32; ++w) lt += __popc(mk[w]);
    return colsumi(N - lt);
}
template <int N> DEV void select16(const float (&v)[N], float& lo_o, float& hi_o) {
    float mx = v[0], mn = v[0], sm = v[0];
#pragma unroll
    for (int i = 1; i < N; ++i) { mx = fmaxf(mx, v[i]); mn = fminf(mn, v[i]); sm += v[i]; }
    mx = colmax(mx); mn = -colmax(-mn); sm = colsum(sm);
    float hi = mx + fabsf(mx) * 1e-6f + 1e-30f;
    float lo = sm * (1.f / (4.f * N));
    if (count_ge<N>(v, lo) < 16) lo = mn;
    bool done = false;
#pragma unroll 1
    for (int it = 0; it < 200; ++it) {
        if (__all(done)) break;
        const float mid = 0.5f * (lo + hi);
        const bool stuck = !(mid > lo && mid < hi);
        const int c = count_ge<N>(v, mid);
        if (!done) {
            if (stuck) done = true;
            else if (c == 16) { lo = mid; hi = mid; done = true; }
            else if (c > 16) lo = mid;
            else hi = mid;
        }
    }
    lo_o = lo; hi_o = hi;
}
DEV void col_offsets(int cntA, int cntT, int q4, int cidx, int& offA, int& offT) {
    const int g0 = __shfl(cntA, cidx), g1 = __shfl(cntA, cidx + 16), g2 = __shfl(cntA, cidx + 32), g3 = __shfl(cntA, cidx + 48);
    const int e0 = __shfl(cntT, cidx), e1 = __shfl(cntT, cidx + 16), e2 = __shfl(cntT, cidx + 32);
    offA = (q4 > 0 ? g0 : 0) + (q4 > 1 ? g1 : 0) + (q4 > 2 ? g2 : 0);
    offT = g0 + g1 + g2 + g3 + (q4 > 0 ? e0 : 0) + (q4 > 1 ? e1 : 0) + (q4 > 2 ? e2 : 0);
}

DEV void peer_topk_task2(const Params& p, int l, int task, float* wl) {
    unsigned char* ws = p.ws;
    const u16* QP = (const u16*)(ws + OFF_QP);
    const u16* K12 = (const u16*)(ws + OFF_K12) + (size_t)l * 2 * 16384;
    int* PIDX = (int*)(ws + OFF_PIDX); float* PGW = (float*)(ws + OFF_PGW);
    const int lane = TID() & 63, q4 = lane >> 4, cidx = lane & 15;
    const int tq = task * 2 + (cidx >> 3), hh = cidx & 7;
    float* scl = wl;
    float* lst = wl + 2048;
    float* vv[2] = {lst, lst + 512}; int* ii[2] = {(int*)(lst + 256), (int*)(lst + 768)};
    float* fs = lst + 1024; int* fi = (int*)(lst + 1280);
#pragma unroll 1
    for (int hf = 0; hf < 2; ++hf) {
        bf16x8 qf[4];
#pragma unroll
        for (int s2 = 0; s2 < 4; ++s2) qf[s2] = ld8(QP + (size_t)tq * 2048 + hh * 256 + hf * 128 + 32 * s2 + 8 * q4);
        float sc[32];
        const u16* kb = K12 + hf * 16384;
#pragma unroll
        for (int kt = 0; kt < 8; ++kt) {
            f32x4 st = (f32x4){0.f, 0.f, 0.f, 0.f};
#pragma unroll
            for (int s2 = 0; s2 < 4; ++s2) st = mfma16(ld8(kb + (kt * 16 + cidx) * 128 + 32 * s2 + 8 * q4), qf[s2], st);
#pragma unroll
            for (int r = 0; r < 4; ++r) sc[kt * 4 + r] = st[r];
            *(f32x4*)(scl + cidx * 128 + 16 * kt + 4 * q4) = st;
        }
        float lo, hi; select16<32>(sc, lo, hi);
        unsigned mh[1], ml_[1];
        ltmask<32>(sc, hi, mh); ltmask<32>(sc, lo, ml_);
        unsigned mA = ~mh[0], mT = ~ml_[0] & mh[0];
        int offA, offT; col_offsets(__popc(mA), __popc(mT), q4, cidx, offA, offT);
        float* vo = hf ? vv[1] : vv[0]; int* io = hf ? ii[1] : ii[0];
        lds_fence();
        while (__any(mA != 0u)) {
            if (mA) {
                const int i = __clz(mA); mA &= ~(0x80000000u >> i);
                const int n = 16 * (i >> 2) + 4 * q4 + (i & 3);
                vo[cidx * 16 + offA] = scl[cidx * 128 + n]; io[cidx * 16 + offA] = n; ++offA;
            }
        }
        while (__any(mT != 0u)) {
            if (mT) {
                const int i = __clz(mT); mT &= ~(0x80000000u >> i);
                const int n = 16 * (i >> 2) + 4 * q4 + (i & 3);
                if (offT < 16) { vo[cidx * 16 + offT] = scl[cidx * 128 + n]; io[cidx * 16 + offT] = n; }
                ++offT;
            }
        }
        lds_fence();
    }
    {
        float cand[64];
        float v2r[16];
#pragma unroll
        for (int j = 0; j < 16; ++j) v2r[j] = vv[1][cidx * 16 + j];
#pragma unroll
        for (int a = 0; a < 4; ++a) {
            const float v1a = vv[0][cidx * 16 + 4 * q4 + a];
#pragma unroll
            for (int j = 0; j < 16; ++j) cand[a * 16 + j] = v1a + v2r[j];
        }
        float lo, hi; select16<64>(cand, lo, hi);
        unsigned mh[2], ml_[2];
        ltmask<64>(cand, hi, mh); ltmask<64>(cand, lo, ml_);
        unsigned mA0 = ~mh[0], mA1 = ~mh[1], mT0 = ~ml_[0] & mh[0], mT1 = ~ml_[1] & mh[1];
        int offA, offT; col_offsets(__popc(mA0) + __popc(mA1), __popc(mT0) + __popc(mT1), q4, cidx, offA, offT);
#pragma unroll
        for (int w = 0; w < 2; ++w) {
            unsigned mA = w ? mA1 : mA0;
            while (__any(mA != 0u)) {
                if (mA) {
                    const int i = __clz(mA); mA &= ~(0x80000000u >> i);
                    const int it = w * 32 + i; const int ci = (4 * q4 + (it >> 4)) * 16 + (it & 15);
                    fs[cidx * 16 + offA] = vv[0][cidx * 16 + (ci >> 4)] + vv[1][cidx * 16 + (ci & 15)]; fi[cidx * 16 + offA] = ci; ++offA;
                }
            }
        }
#pragma unroll
        for (int w = 0; w < 2; ++w) {
            unsigned mT = w ? mT1 : mT0;
            while (__any(mT != 0u)) {
                if (mT) {
                    const int i = __clz(mT); mT &= ~(0x80000000u >> i);
                    const int it = w * 32 + i; const int ci = (4 * q4 + (it >> 4)) * 16 + (it & 15);
                    if (offT < 16) { fs[cidx * 16 + offT] = vv[0][cidx * 16 + (ci >> 4)] + vv[1][cidx * 16 + (ci & 15)]; fi[cidx * 16 + offT] = ci; }
                    ++offT;
                }
            }
        }
    }
    lds_fence();
    {
        float s4[4]; int c4[4];
#pragma unroll
        for (int k = 0; k < 4; ++k) { s4[k] = fs[cidx * 16 + 4 * q4 + k]; c4[k] = fi[cidx * 16 + 4 * q4 + k]; }
        float mx = fmaxf(fmaxf(s4[0], s4[1]), fmaxf(s4[2], s4[3]));
        mx = colmax(mx);
        float e4[4]; float sm = 0.f;
#pragma unroll
        for (int k = 0; k < 4; ++k) { e4[k] = __expf(s4[k] - mx); sm += e4[k]; }
        sm = colsum(sm);
        const float inv = 1.f / sm;
        int4 eo; float4 go;
        eo.x = ii[0][cidx * 16 + (c4[0] >> 4)] * 128 + ii[1][cidx * 16 + (c4[0] & 15)];
        eo.y = ii[0][cidx * 16 + (c4[1] >> 4)] * 128 + ii[1][cidx * 16 + (c4[1] & 15)];
        eo.z = ii[0][cidx * 16 + (c4[2] >> 4)] * 128 + ii[1][cidx * 16 + (c4[2] & 15)];
        eo.w = ii[0][cidx * 16 + (c4[3] >> 4)] * 128 + ii[1][cidx * 16 + (c4[3] & 15)];
        go.x = e4[0] * inv; go.y = e4[1] * inv; go.z = e4[2] * inv; go.w = e4[3] * inv;
        const size_t o = ((size_t)tq * 8 + hh) * 16 + 4 * q4;
        *(int4*)(PIDX + o) = eo; *(float4*)(PGW + o) = go;
    }
    lds_fence();
}

DEV float gelu_exact(float x) { return 0.5f * x * (1.f + erff(x * 0.70710678118654752f)); }
DEV void unpack8(const bf16x8 v, float* f) {
    union { bf16x8 v; unsigned u[4]; } c; c.v = v;
#pragma unroll
    for (int i = 0; i < 4; ++i) { f[2 * i] = bflo(c.u[i]); f[2 * i + 1] = bfhi(c.u[i]); }
}
DEV void phase_peer_experts(const Params& p, int l) {
    unsigned char* ws = p.ws;
    const u16* H = (const u16*)(ws + OFF_H);
    u16* Hw = (u16*)(ws + OFF_H);
    const unsigned char* U8 = ws + OFF_U8 + (size_t)(l * 2 + 0) * 16 * MiB;
    const unsigned char* V8 = ws + OFF_U8 + (size_t)(l * 2 + 1) * 16 * MiB;
    const float* SU = (const float*)(ws + OFF_UVS) + (l * 2 + 0) * 16384;
    const float* SV = (const float*)(ws + OFF_UVS) + (l * 2 + 1) * 16384;
    const int* PIDX = (const int*)(ws + OFF_PIDX); const float* PGW = (const float*)(ws + OFF_PGW);
    const float* mod = (const float*)(ws + OFF_MOD);
    const float* g2 = mod + l * 4 * 6144 + 5 * 1024;
    const int lane = TID() & 63;
    const int gw = BID() * 4 + (TID() >> 6), nw = gridDim.x * 4;
    for (int tok = gw; tok < NTOK; tok += nw) {
        const int b = tok >> 13;
        float acc[16];
#pragma unroll
        for (int i = 0; i < 16; ++i) acc[i] = 0.f;
#if EN_PEER
        float hx[16];
        unpack8(ld8(H + (size_t)tok * 1024 + 16 * lane), hx);
        unpack8(ld8(H + (size_t)tok * 1024 + 16 * lane + 8), hx + 8);
        float hs = 0.f;
#pragma unroll
        for (int i = 0; i < 16; ++i) hs += hx[i];
        const float hs128 = 128.f * hs;
        float corr = 0.f;
#pragma unroll 1
        for (int hh = 0; hh < 8; ++hh) {
            const int el = PIDX[((size_t)tok * 8 + hh) * 16 + (lane & 15)];
            const float wgt = PGW[((size_t)tok * 8 + hh) * 16 + (lane & 15)];
#pragma unroll 1
            for (int k0 = 0; k0 < 16; k0 += 8) {
                u32x4 uq[8], vq[8]; float wk[8], su[8];
#pragma unroll
                for (int k = 0; k < 8; ++k) {
                    const int e = __builtin_amdgcn_readlane(el, k0 + k);
                    wk[k] = __int_as_float(__builtin_amdgcn_readlane(__float_as_int(wgt), k0 + k)) * SV[e];
                    su[k] = SU[e];
                    uq[k] = *(const u32x4*)(U8 + (size_t)e * 1024 + 16 * lane);
                    vq[k] = *(const u32x4*)(V8 + (size_t)e * 1024 + 16 * lane);
                }
#pragma unroll
                for (int k = 0; k < 8; ++k) {
                    float d = -hs128;
#pragma unroll
                    for (int i = 0; i < 4; ++i) {
                        const unsigned w = uq[k][i];
                        d += (float)(w & 0xffu) * hx[4 * i] + (float)((w >> 8) & 0xffu) * hx[4 * i + 1] + (float)((w >> 16) & 0xffu) * hx[4 * i + 2] + (float)(w >> 24) * hx[4 * i + 3];
                    }
                    d = wave_sum(d) * su[k];
                    const float act = gelu_exact(d) * wk[k];
                    corr += act * 128.f;
#pragma unroll
                    for (int i = 0; i < 4; ++i) {
                        const unsigned w = vq[k][i];
                        acc[4 * i] += act * (float)(w & 0xffu); acc[4 * i + 1] += act * (float)((w >> 8) & 0xffu);
                        acc[4 * i + 2] += act * (float)((w >> 16) & 0xffu); acc[4 * i + 3] += act * (float)(w >> 24);
                    }
                }
            }
        }
#pragma unroll
        for (int i = 0; i < 16; ++i) acc[i] -= corr;
#endif
        const int k = 16 * lane;
        float xn[16]; float ss = 0.f;
#pragma unroll
        for (int i = 0; i < 4; ++i) {
            const float4 x0 = *(const float4*)(p.out + (size_t)tok * 1024 + k + 4 * i);
            const float4 ga = *(const float4*)(g2 + b * 6144 + k + 4 * i);
            xn[4 * i] = x0.x + ga.x * acc[4 * i]; xn[4 * i + 1] = x0.y + ga.y * acc[4 * i + 1];
            xn[4 * i + 2] = x0.z + ga.z * acc[4 * i + 2]; xn[4 * i + 3] = x0.w + ga.w * acc[4 * i + 3];
        }
#pragma unroll
        for (int i = 0; i < 16; ++i) ss += xn[i] * xn[i];
        ss = wave_sum(ss);
        const float rs = rsqrtf(ss * (1.f / 1024.f) + 1e-6f);
        if (l == 0) {
            const float* n1g = p.in[I_N1G] + 1024; const float* sh = mod + 4 * 6144 + b * 6144; const float* sc = sh + 1024;
            float hv[16];
#pragma unroll
            for (int i = 0; i < 4; ++i) {
                *(float4*)(p.out + (size_t)tok * 1024 + k + 4 * i) = (float4){xn[4 * i], xn[4 * i + 1], xn[4 * i + 2], xn[4 * i + 3]};
                const float4 gg = *(const float4*)(n1g + k + 4 * i), s1 = *(const float4*)(sc + k + 4 * i), s0 = *(const float4*)(sh + k + 4 * i);
                hv[4 * i] = xn[4 * i] * rs * gg.x * (1.f + s1.x) + s0.x; hv[4 * i + 1] = xn[4 * i + 1] * rs * gg.y * (1.f + s1.y) + s0.y;
                hv[4 * i + 2] = xn[4 * i + 2] * rs * gg.z * (1.f + s1.z) + s0.z; hv[4 * i + 3] = xn[4 * i + 3] * rs * gg.w * (1.f + s1.w) + s0.w;
            }
            u32x4 w0, w1;
#pragma unroll
            for (int i = 0; i < 4; ++i) { w0[i] = pack2(hv[2 * i], hv[2 * i + 1]); w1[i] = pack2(hv[8 + 2 * i], hv[8 + 2 * i + 1]); }
            *(u32x4*)(Hw + (size_t)tok * 1024 + k) = w0; *(u32x4*)(Hw + (size_t)tok * 1024 + k + 8) = w1;
        } else {
            const float* fg = p.in[I_FG];
#pragma unroll
            for (int i = 0; i < 4; ++i) {
                const float4 gg = *(const float4*)(fg + k + 4 * i);
                *(float4*)(p.out + (size_t)tok * 1024 + k + 4 * i) = (float4){xn[4 * i] * rs * gg.x, xn[4 * i + 1] * rs * gg.y, xn[4 * i + 2] * rs * gg.z, xn[4 * i + 3] * rs * gg.w};
            }
        }
    }
}

constexpr int NPH = 20;

__global__ void __launch_bounds__(256, 2) mega(Params p) {
    __shared__ __attribute__((aligned(16))) unsigned char lds[81920 - 128];
    __shared__ int misc[8];
    int* qslot = misc;
    cg::grid_group grid = cg::this_grid();
    if (threadIdx.x < 8) misc[threadIdx.x] = 0;
    __syncthreads();
    XcdBarrier xbar = xcd_barrier_post((unsigned*)(p.ws + OFF_BAR), (volatile unsigned*)(misc + 4));
    unsigned char* ws = p.ws;
    const float* mod = (const float*)(ws + OFF_MOD);
    unsigned* ctl = (unsigned*)(ws + OFF_CTL);
    const int G = gridDim.x, bx = BID();
    for (int ph = p.ph_lo; ph < p.ph_hi; ++ph) {
        if (ph == 0) {
            phase_prep(p, lds);
        } else if (ph == 1) {
            phase_norm(p.in[I_X], p.in[I_N1G], mod + 0 * 1024, mod + 1 * 1024, (u16*)(ws + OFF_H));
        } else {
            const int l = (ph - 2) / 9, sp = (ph - 2) % 9;
            const float* modl = mod + l * 4 * 6144;
            if (sp == 0) {
                EpiInProj e{(u16*)(ws + OFF_PCONV), (u16*)(ws + OFF_PRWKV), (u16*)(ws + OFF_Q), (u16*)(ws + OFF_KV), (float*)(ws + OFF_GATE)};
                gemm_phase((const u16*)(ws + OFF_H), 1024, (const u16*)(ws + OFF_WIN) + (size_t)l * NINP * 1024, 1024, 256, 23, 1024, e, lds, bx, G);
            } else if (sp == 1) {
#if EN_RWKV
                for (;;) { const int t = block_next(ctl + QW(l, Q_RWP), qslot); if (t >= NTOK / 16) break; rwkv_prep_tile2(p, l, t, lds); }
#endif
            } else if (sp == 2) {
#if EN_RWKV
                if (bx < 64) { __builtin_amdgcn_s_setprio(3); rwkv_scan(p, bx, lds); __builtin_amdgcn_s_setprio(0); }
#endif
                unsigned* cdone = ctl + QW(l, 5);
                if (bx >= 64 && bx < 128) {
                    const u16* KVb = (const u16*)(ws + OFF_KV);
                    if (bx < 96) {
                        EpiCompress ek{(const float*)(ws + OFF_CBP) + (l * 2 + 0) * 2048, p.in[I_CKW2] + (size_t)l * 8192, (u16*)(ws + OFF_KC), 0, lds};
                        gemm_phase(KVb, 1024, (const u16*)(ws + OFF_CW1) + (size_t)(l * 2 + 0) * 128 * 2048, 2048, 32, 1, 2048, ek, lds, bx - 64, 1 << 20);
                    } else {
                        EpiCompress ev{(const float*)(ws + OFF_CBP) + (l * 2 + 1) * 2048, p.in[I_CVW2] + (size_t)l * 8192, (u16*)(ws + OFF_VCT), 1, lds};
                        gemm_phase(KVb + 4194304, 1024, (const u16*)(ws + OFF_CW1) + (size_t)(l * 2 + 1) * 128 * 2048, 2048, 32, 1, 2048, ev, lds, bx - 96, 1 << 20);
                    }
                    asm volatile("s_waitcnt vmcnt(0)" ::: "memory");
                    __syncthreads();
                    if (threadIdx.x == 0) {
                        __builtin_amdgcn_fence(__ATOMIC_RELEASE, "agent");
                        asm volatile("s_waitcnt vmcnt(0)" ::: "memory");
                        __hip_atomic_fetch_add(cdone, 1u, __ATOMIC_RELAXED, __HIP_MEMORY_SCOPE_AGENT);
                    }
                }
#if EN_CONV
                for (;;) { const int t = block_next(ctl + QW(l, Q_CONV), qslot); if (t >= NTOK / 32) break; conv_tile(p, l, t, lds); }
#else
                zero_mix_cols(p, 0, 256);
#endif
                __syncthreads();
                if (threadIdx.x == 0) {
                    unsigned sp_ = 0;
                    while (__hip_atomic_load(cdone, __ATOMIC_RELAXED, __HIP_MEMORY_SCOPE_AGENT) < 64u) { __builtin_amdgcn_s_sleep(8); if (++sp_ > (1u << 24)) break; }
                    __builtin_amdgcn_fence(__ATOMIC_ACQUIRE, "agent");
                    asm volatile("s_waitcnt vmcnt(0)" ::: "memory");
                }
                __syncthreads();
                for (;;) { const int t = block_next(ctl + QW(l, Q_NSA), qslot); if (t >= 2048) break; nsa_block_task(p, t, lds); }
            } else if (sp == 3) {
#if EN_RWKV
                phase_rwkv_post(p, l);
#else
                zero_mix_cols(p, 256, 256);
#endif
            } else if (sp == 4) {
                EpiOutProj e{l == 0 ? p.in[I_X] : p.out, p.out, modl + 2 * 1024};
                gemm_phase((const u16*)(ws + OFF_MIX), 1024, (const u16*)(ws + OFF_WOUT) + (size_t)l * 1024 * 1024, 1024, 256, 8, 1024, e, lds, bx, G);
            } else if (sp == 5) {
#if EN_PEER
                phase_norm(p.out, p.in[I_N2G] + l * 1024, modl + 3 * 1024, modl + 4 * 1024, (u16*)(ws + OFF_H));
#endif
            } else if (sp == 6) {
#if EN_PEER
                EpiStoreBf16 e{(u16*)(ws + OFF_QP), 2048};
                gemm_phase((const u16*)(ws + OFF_H), 1024, (const u16*)(ws + OFF_WQ) + (size_t)l * 2048 * 1024, 1024, 256, 16, 1024, e, lds, bx, G);
#endif
            } else if (sp == 7) {
#if EN_PEER
                float* wl = (float*)lds + (TID() >> 6) * 3584;
                for (;;) { const int t = wave_next(ctl + QW(l, Q_PTK)); if (t >= NTOK / 2) break; peer_topk_task2(p, l, t, wl); }
#endif
            } else {
                phase_peer_experts(p, l);
            }
        }
        if (ph + 1 < p.ph_hi) { if (ph == 0) grid.sync(); else xcd_barrier(xbar); }
    }
}

extern "C" void kernel_launch(void* const* d_in, const int* in_sizes, int n_in, void* d_out, int out_size, void* d_ws, size_t ws_size,
                              hipStream_t stream) {
    static int grid_blocks = 0;
    if (!grid_blocks) {
        int dev = 0, cus = 0, per_cu = 0;
        hipGetDevice(&dev);
        hipDeviceGetAttribute(&cus, hipDeviceAttributeMultiprocessorCount, dev);
        hipOccupancyMaxActiveBlocksPerMultiprocessor(&per_cu, (const void*)mega, 256, 0);
        if (per_cu > 2) per_cu = 2;
        if (per_cu < 1) per_cu = 1;
        grid_blocks = cus * per_cu;
        if (ws_size < WS_NEED) fprintf(stderr, "kernel_launch: workspace too small: %zu < %zu\n", ws_size, (size_t)WS_NEED);
    }
    hipMemsetAsync((char*)d_ws + OFF_CTL, 0, CTL_ZERO_BYTES, stream);
    Params p{};
    for (int i = 0; i < 35; ++i) p.in[i] = (const float*)d_in[i];
    p.out = (float*)d_out;
    p.ws = (unsigned char*)d_ws;
#if MULTI_LAUNCH
    for (int ph = 0; ph < NPH; ++ph) {
        p.ph_lo = ph; p.ph_hi = ph + 1;
        hipLaunchKernelGGL(mega, dim3(grid_blocks), dim3(256), 0, stream, p);
    }
#else
    p.ph_lo = 0; p.ph_hi = NPH;
    void* args[] = {&p};
    hipError_t e = hipLaunchCooperativeKernel((const void*)mega, dim3(grid_blocks), dim3(256), args, 0, stream);
    if (e != hipSuccess) fprintf(stderr, "cooperative launch failed: %s (grid %d)\n", hipGetErrorString(e), grid_blocks);
#endif
}
```

```cpp
#include <hip/hip_runtime.h>
#include <hip/hip_cooperative_groups.h>
#include <stdint.h>
#include <stdio.h>
namespace cg = cooperative_groups;

#ifndef EN_CONV
#define EN_CONV 1
#endif
#ifndef EN_RWKV
#define EN_RWKV 1
#endif
#ifndef EN_NSA_CMP
#define EN_NSA_CMP 1
#endif
#ifndef EN_NSA_WIN
#define EN_NSA_WIN 1
#endif
#ifndef EN_NSA_SEL
#define EN_NSA_SEL 1
#endif
#ifndef EN_PEER
#define EN_PEER 1
#endif
#ifndef MULTI_LAUNCH
#define MULTI_LAUNCH 0
#endif

#define DEV __device__ __forceinline__
typedef unsigned short u16;
typedef __attribute__((ext_vector_type(8))) short bf16x8;
typedef __attribute__((ext_vector_type(4))) float f32x4;
typedef __attribute__((ext_vector_type(4))) unsigned int u32x4;
typedef __attribute__((ext_vector_type(2))) unsigned int u32x2;

constexpr int NB = 4, NT = 8192, ND = 1024, NTOK = NB * NT, NL = 2;
constexpr int NIN = 2840, NINP = 2944;
constexpr size_t MiB = 1ull << 20;

constexpr size_t OFF_CTL = 0;
constexpr size_t CTL_ZERO_BYTES = 32768;
constexpr size_t OFF_BAR = 16384;
constexpr size_t OFF_MOD = 64 * 1024;
constexpr size_t OFF_CBP = 256 * 1024;
constexpr size_t OFF_WIN = 1 * MiB;
constexpr size_t OFF_WOUT = 13 * MiB;
constexpr size_t OFF_WQ = 17 * MiB;
constexpr size_t OFF_CW1 = 25 * MiB;
constexpr size_t OFF_K12 = 27 * MiB;
constexpr size_t OFF_LW = 27 * MiB + 512 * 1024;
constexpr size_t OFF_U8 = 28 * MiB;
constexpr size_t OFF_UVS = 512 * 1024;
constexpr size_t OFF_H = 92 * MiB;
constexpr size_t OFF_MIX = 156 * MiB;
constexpr size_t OFF_E = 220 * MiB;
constexpr size_t OFF_PCONV = OFF_E + 0;
constexpr size_t OFF_PRWKV = OFF_E + 32 * MiB;
constexpr size_t OFF_YRAW = OFF_E + 32 * MiB;
constexpr size_t OFF_Q = OFF_E + 96 * MiB;
constexpr size_t OFF_KV = OFF_E + 128 * MiB;
constexpr size_t OFF_GATE = OFF_E + 176 * MiB;
constexpr size_t OFF_KC = OFF_E + 180 * MiB;
constexpr size_t OFF_VCT = OFF_KC + 512 * 1024;
constexpr size_t OFF_RV = OFF_E + 184 * MiB;
constexpr size_t OFF_RKK = OFF_E + 200 * MiB;
constexpr size_t OFF_RKKA = OFF_E + 216 * MiB;
constexpr size_t OFF_RG = OFF_E + 232 * MiB;
constexpr size_t OFF_BONUS = OFF_E + 248 * MiB;
constexpr size_t OFF_RW = OFF_E + 249 * MiB;
constexpr size_t OFF_RR = 60 * MiB;
constexpr size_t OFF_RK = 76 * MiB;
constexpr size_t OFF_QP = OFF_E + 0;
constexpr size_t OFF_PIDX = OFF_E + 128 * MiB;
constexpr size_t OFF_PGW = OFF_E + 144 * MiB;
constexpr size_t WS_NEED = OFF_E + 281 * MiB;

#define QW(l, q) (64 * ((l) * 8 + (q)))
enum { Q_CMP = 0, Q_CONV = 1, Q_RWP = 2, Q_NSA = 3, Q_PTK = 4 };

enum { I_X = 0, I_C, I_ADAW, I_ADAB, I_N1G, I_N2G, I_WIN, I_CDW, I_CDB, I_CGG, I_CGB, I_MU, I_W0, I_WUP, I_A0, I_AUP, I_GUP,
       I_KK, I_KA, I_RK, I_LNG, I_LNB, I_CKPOS, I_CKW1, I_CKW2, I_CVPOS, I_CVW1, I_CVW2, I_WOUT, I_PWQ, I_PK1, I_PK2, I_PU, I_PV, I_FG };

struct Params {
    const float* in[35];
    float* out;
    unsigned char* ws;
    int ph_lo, ph_hi;
};

DEV int TID() { int t = threadIdx.x; asm volatile("" : "+v"(t)); return t; }
DEV int BID() { int t = blockIdx.x; asm volatile("" : "+s"(t)); return t; }
typedef __attribute__((ext_vector_type(2))) float f32x2_t;
typedef __attribute__((ext_vector_type(2))) __bf16 bf16x2_t;
DEV unsigned pack2(float a, float b) { const f32x2_t v = {a, b}; return __builtin_bit_cast(unsigned, __builtin_convertvector(v, bf16x2_t)); }
DEV u16 f2bf(float f) { const __bf16 h = (__bf16)f; return __builtin_bit_cast(u16, h); }
DEV float bf2f(u16 h) { return __uint_as_float(((unsigned)h) << 16); }
DEV float bflo(unsigned u) { return __uint_as_float(u << 16); }
DEV float bfhi(unsigned u) { return __uint_as_float(u & 0xffff0000u); }
DEV float ex2(float x) { return __builtin_amdgcn_exp2f(x); }
DEV float sigmoidf_(float x) { return 1.f / (1.f + __expf(-x)); }

DEV f32x4 mfma16(bf16x8 a, bf16x8 b, f32x4 c) { return __builtin_amdgcn_mfma_f32_16x16x32_bf16(a, b, c, 0, 0, 0); }
template <int CTRL> DEV float dppf(float x) { return __int_as_float(__builtin_amdgcn_update_dpp(0, __float_as_int(x), CTRL, 0xF, 0xF, false)); }
template <int CTRL> DEV unsigned dppu(unsigned x) { return (unsigned)__builtin_amdgcn_update_dpp(0, (int)x, CTRL, 0xF, 0xF, false); }
DEV float reduce16(float x) { x += dppf<0xB1>(x); x += dppf<0x4E>(x); x += dppf<0x124>(x); x += dppf<0x128>(x); return x; }
DEV float quadsum(float x) { x += dppf<0xB1>(x); x += dppf<0x4E>(x); return x; }
DEV float x16_sum(float x) { auto r = __builtin_amdgcn_permlane16_swap(__float_as_uint(x), __float_as_uint(x), false, false); return __uint_as_float(r[0]) + __uint_as_float(r[1]); }
DEV float x32_sum(float x) { auto r = __builtin_amdgcn_permlane32_swap(__float_as_uint(x), __float_as_uint(x), false, false); return __uint_as_float(r[0]) + __uint_as_float(r[1]); }
DEV float x16_max(float x) { auto r = __builtin_amdgcn_permlane16_swap(__float_as_uint(x), __float_as_uint(x), false, false); return fmaxf(__uint_as_float(r[0]), __uint_as_float(r[1])); }
DEV float x32_max(float x) { auto r = __builtin_amdgcn_permlane32_swap(__float_as_uint(x), __float_as_uint(x), false, false); return fmaxf(__uint_as_float(r[0]), __uint_as_float(r[1])); }
DEV int x16_sumi(int x) { auto r = __builtin_amdgcn_permlane16_swap((unsigned)x, (unsigned)x, false, false); return (int)(r[0] + r[1]); }
DEV int x32_sumi(int x) { auto r = __builtin_amdgcn_permlane32_swap((unsigned)x, (unsigned)x, false, false); return (int)(r[0] + r[1]); }
DEV float colsum(float x) { return x32_sum(x16_sum(x)); }
DEV float colmax(float x) { return x32_max(x16_max(x)); }
DEV int colsumi(int x) { return x32_sumi(x16_sumi(x)); }
DEV float wave_sum(float v) { return x32_sum(x16_sum(reduce16(v))); }
DEV float wave_max(float x) {
    x = fmaxf(x, dppf<0xB1>(x)); x = fmaxf(x, dppf<0x4E>(x)); x = fmaxf(x, dppf<0x124>(x)); x = fmaxf(x, dppf<0x128>(x));
    return x32_max(x16_max(x));
}
DEV void lds_fence() { asm volatile("s_waitcnt lgkmcnt(0)" ::: "memory"); }
DEV bf16x8 ld8(const u16* p) { return *(const bf16x8*)p; }

DEV int block_next(unsigned* ctr, int* slot) {
    __syncthreads();
    if (TID() == 0) *slot = (int)atomicAdd(ctr, 1u);
    __syncthreads();
    return *slot;
}
DEV int wave_next(unsigned* ctr) {
    int v = 0;
    if ((TID() & 63) == 0) v = (int)atomicAdd(ctr, 1u);
    return __builtin_amdgcn_readfirstlane(v);
}


#define XB_TMO      128
#define XB_XCNT(j)  (256  + 64 * (j))
#define XB_XSUB(j)  (1280 + 64 * (j))
#define XB_XGEN(j)  (2304 + 64 * (j))
#define XB_TOP      3328
#define XB_TOPGEN   3392
#define XCD_BAR_WORDS 3456
#define XB_SPIN_CAP (1u << 22)
#define LAS __attribute__((address_space(3)))
DEV unsigned xb_ld(unsigned* p) { return __hip_atomic_load(p, __ATOMIC_RELAXED, __HIP_MEMORY_SCOPE_AGENT); }
DEV unsigned xb_add(unsigned* p, unsigned v) { return __hip_atomic_fetch_add(p, v, __ATOMIC_RELAXED, __HIP_MEMORY_SCOPE_AGENT); }
DEV unsigned xb_xcc_id() { return (unsigned)__builtin_amdgcn_s_getreg((3 << 11) | 20) & 0xFu; }
#define XB_SPIN(cond, bar) do { unsigned _sp = 0; while (cond) { __builtin_amdgcn_s_sleep(1); \
    if ((++_sp & 255u) == 0u) { if (xb_ld(&(bar)[XB_TMO])) break; if (_sp > XB_SPIN_CAP) { atomicAdd(&(bar)[XB_TMO], 1u); break; } } } } while (0)
struct XcdBarrier { unsigned* bar; unsigned x; volatile unsigned* st; };
DEV XcdBarrier xcd_barrier_post(unsigned* bar, volatile unsigned* st) {
    XcdBarrier b; b.bar = bar; b.x = xb_xcc_id(); b.st = st;
    if (threadIdx.x == 0) (void)xb_add(&bar[XB_XCNT(b.x)], 1u);
    return b;
}
DEV void xcd_barrier_complete(unsigned* bar, unsigned x, unsigned& nloc, unsigned& nx) {
    const unsigned G = gridDim.x * gridDim.y * gridDim.z;
    unsigned sum, cnt, mine, sp = 0u;
    for (;;) {
        sum = 0u; cnt = 0u; mine = 0u;
#pragma unroll
        for (unsigned j = 0; j < 16; ++j) { const unsigned c = xb_ld(&bar[XB_XCNT(j)]); sum += c; cnt += (c > 0u) ? 1u : 0u; mine = (j == x) ? c : mine; }
        if (sum == G) break;
        __builtin_amdgcn_s_sleep(1);
        if ((++sp & 255u) == 0u) { if (xb_ld(&bar[XB_TMO])) break; if (sp > XB_SPIN_CAP) { atomicAdd(&bar[XB_TMO], 1u); break; } }
    }
    nloc = mine > 0u ? mine : 1u; nx = cnt > 0u ? cnt : 1u;
}
DEV void xcd_barrier(const XcdBarrier& b) {
    asm volatile("s_waitcnt vmcnt(0)" ::: "memory");
    __syncthreads();
    if (threadIdx.x == 0) {
        unsigned* bar = b.bar;
        __builtin_amdgcn_s_waitcnt(0);
        unsigned nloc = b.st[0], nx = b.st[1];
        if (nloc == 0u) { xcd_barrier_complete(bar, b.x, nloc, nx); b.st[0] = nloc; b.st[1] = nx; }
        const unsigned old = xb_add(&bar[XB_XSUB(b.x)], 1u);
        const unsigned gen = old / nloc;
        if (old + 1u == (gen + 1u) * nloc) {
            __builtin_amdgcn_fence(__ATOMIC_RELEASE, "agent");
            asm volatile("s_waitcnt vmcnt(0)" ::: "memory");
            const unsigned og = xb_add(&bar[XB_TOP], 1u);
            const unsigned tg = og / nx;
            if (og + 1u == (tg + 1u) * nx) xb_add(&bar[XB_TOPGEN], 1u);
            else XB_SPIN(xb_ld(&bar[XB_TOPGEN]) == tg, bar);
            __builtin_amdgcn_fence(__ATOMIC_ACQUIRE, "agent");
            xb_add(&bar[XB_XGEN(b.x)], 1u);
            asm volatile("s_waitcnt vmcnt(0)" ::: "memory");
        } else {
            XB_SPIN(xb_ld(&bar[XB_XGEN(b.x)]) == gen, bar);
            __builtin_amdgcn_fence(__ATOMIC_ACQUIRE, "agent");
            asm volatile("s_waitcnt vmcnt(0)" ::: "memory");
        }
    }
    __syncthreads();
}

template <class Epi>
DEV void gemm_phase(const u16* __restrict__ A, int lda, const u16* __restrict__ Bt, int ldb, int mtiles, int ntiles, int K, Epi& epi,
                    unsigned char* lds, int bid, int nb, int nt_lo = 0, int nt_skip = 0, bool xcd_order = true) {
    const int tid = TID(), lane = tid & 63, wave = tid >> 6;
    const int wm = wave >> 1, wn = wave & 1, q4 = lane >> 4, cidx = lane & 15;
    u16* As = (u16*)lds;
    u16* Bs = (u16*)(lds + 32768);
    const int KT = K >> 6;
    const int total = mtiles * ntiles;
    const int srow = tid >> 3, sch = tid & 7;
    const bool xo_ = xcd_order && ((nb & 7) == 0) && (nb <= 4096) && ((mtiles & 7) == 0);
    const int ngroups = (ntiles + 7) >> 3;
    const int nloc = xo_ ? (nb >> 3) : 1;
    const int nvirt = xo_ ? ((mtiles >> 3) * ngroups * 64) : total;
    for (int vt = xo_ ? ((bid & 7) * 64 + (bid >> 3)) : bid; vt < nvirt; vt += xo_ ? ((((vt & 63) + nloc) < 64) ? nloc : (8 * 64 - (vt & 63) + (bid >> 3))) : nb) {
        int mt, nt;
        if (xo_) {
            const int st = vt >> 6, tt = vt & 63;
            mt = (st / ngroups) * 8 + (tt >> 3); nt = (st % ngroups) * 8 + (tt & 7);
            if (nt >= ntiles) continue;
        } else { mt = vt / ntiles; nt = vt - mt * ntiles; }
        if (nt >= nt_lo) nt += nt_skip;
        const int m0 = mt * 128, n0 = nt * 128;
        const bool sw = epi.swapped(n0 + wn * 64);
        const int xo = sw ? (32768 / 2 + wn * 64 * 64) : (wm * 64 * 64);
        const int yo = sw ? (wm * 64 * 64) : (32768 / 2 + wn * 64 * 64);
        f32x4 acc[4][4];
#pragma unroll
        for (int i = 0; i < 4; ++i)
#pragma unroll
            for (int j = 0; j < 4; ++j) acc[i][j] = (f32x4){0.f, 0.f, 0.f, 0.f};
        const u16* Ag = A + (size_t)(m0 + srow) * lda + sch * 8;
        const u16* Bg = Bt + (size_t)(n0 + srow) * ldb + sch * 8;
        bf16x8 ra0[4], rb0[4], ra1[4], rb1[4];
#define GEMM_GLOAD(RA, RB, KT_) { const int k0_ = (KT_) * 64; _Pragma("unroll") for (int i = 0; i < 4; ++i) { RA[i] = ld8(Ag + (size_t)(32 * i) * lda + k0_); RB[i] = ld8(Bg + (size_t)(32 * i) * ldb + k0_); } }
#define GEMM_LWRITE(RA, RB, BUF_) { u16* Aw_ = As + (BUF_) * 8192; u16* Bw_ = Bs + (BUF_) * 8192; _Pragma("unroll") for (int i = 0; i < 4; ++i) { const int row = srow + 32 * i; const int off = row * 64 + ((sch ^ (row & 7)) << 3); *(bf16x8*)(Aw_ + off) = RA[i]; *(bf16x8*)(Bw_ + off) = RB[i]; } }
#define GEMM_COMPUTE(BUF_) { const u16* Xb = As + (BUF_) * 8192 + xo; const u16* Yb = As + (BUF_) * 8192 + yo; _Pragma("unroll") for (int s = 0; s < 2; ++s) { bf16x8 a[4], b[4]; const int ch = s * 4 + q4; _Pragma("unroll") for (int i = 0; i < 4; ++i) { const int row = i * 16 + cidx; a[i] = *(const bf16x8*)(Xb + row * 64 + ((ch ^ (row & 7)) << 3)); b[i] = *(const bf16x8*)(Yb + row * 64 + ((ch ^ (row & 7)) << 3)); } _Pragma("unroll") for (int i = 0; i < 4; ++i) _Pragma("unroll") for (int j = 0; j < 4; ++j) acc[i][j] = mfma16(a[i], b[j], acc[i][j]); } }
        GEMM_GLOAD(ra0, rb0, 0);
        if (KT > 1) GEMM_GLOAD(ra1, rb1, 1);
        GEMM_LWRITE(ra0, rb0, 0);
        __syncthreads();
        for (int kt = 0; kt < KT; kt += 2) {
            if (kt + 2 < KT) GEMM_GLOAD(ra0, rb0, kt + 2);
            GEMM_COMPUTE(0);
            GEMM_LWRITE(ra1, rb1, 1);
            __syncthreads();
            if (kt + 3 < KT) GEMM_GLOAD(ra1, rb1, kt + 3);
            GEMM_COMPUTE(1);
            if (kt + 2 < KT) GEMM_LWRITE(ra0, rb0, 0);
            __syncthreads();
        }
#undef GEMM_GLOAD
#undef GEMM_LWRITE
#undef GEMM_COMPUTE
        if (!sw) {
#pragma unroll
            for (int i = 0; i < 4; ++i)
#pragma unroll
                for (int j = 0; j < 4; ++j) epi.rows4(m0 + wm * 64 + i * 16 + q4 * 4, n0 + wn * 64 + j * 16 + cidx, acc[i][j]);
        } else {
#pragma unroll
            for (int i = 0; i < 4; ++i)
#pragma unroll
                for (int j = 0; j < 4; ++j) epi.cols4(m0 + wm * 64 + j * 16 + cidx, n0 + wn * 64 + i * 16 + q4 * 4, acc[i][j]);
        }
        epi.finish(m0, n0, lds);
    }
}

struct EpiInProj {
    u16 *pconv, *prwkv, *q, *kv; float* gate;
    DEV bool swapped(int c0) const { return !((c0 >= 2432 && c0 < 2560) || (c0 >= 2688 && c0 < 2816)); }
    DEV void rows4(int row0, int col, f32x4 v) const {
        const int c = col - 2048; const int idx = c >> 7; const int g = (c >> 6) & 1; const int d = c & 63;
        const int b = row0 >> 13; const int t0 = row0 & 8191; const int bg = b * 2 + g;
        u16* base = kv + (size_t)idx * 4194304;
        const int k = t0 & 31; const int p0 = 8 * ((k & 15) >> 2) + 4 * (k >> 4);
        u32x2 w; w[0] = pack2(v[0], v[1]); w[1] = pack2(v[2], v[3]);
        *(u32x2*)(base + (size_t)(bg * 64 + d) * 8192 + (t0 & ~31) + p0) = w;
    }
    DEV void cols4(int row, int col0, f32x4 v) const {
        if (col0 < 512) {
            u32x2 w; w[0] = pack2(v[0], v[1]); w[1] = pack2(v[2], v[3]);
            *(u32x2*)(pconv + (size_t)row * 512 + col0) = w;
        } else if (col0 < 1536) {
            u32x2 w; w[0] = pack2(v[0], v[1]); w[1] = pack2(v[2], v[3]);
            *(u32x2*)(prwkv + (size_t)row * 1024 + (col0 - 512)) = w;
        } else if (col0 < 2048) {
            const float sc = 0.18033688011112042f;
            u32x2 w; w[0] = pack2(v[0] * sc, v[1] * sc); w[1] = pack2(v[2] * sc, v[3] * sc);
            *(u32x2*)(q + (size_t)row * 512 + (col0 - 1536)) = w;
        } else if (col0 < 2816) {
            const int c = col0 - 2048; const int idx = c >> 7; const int g = (c >> 6) & 1; const int d = c & 63;
            const int b = row >> 13; const int t = row & 8191; const int bg = b * 2 + g;
            u32x2 w; w[0] = pack2(v[0], v[1]); w[1] = pack2(v[2], v[3]);
            *(u32x2*)(kv + (size_t)idx * 4194304 + ((size_t)bg * 8192 + t) * 64 + d) = w;
        } else if (col0 < 2840) {
            *(float4*)(gate + (size_t)row * 24 + (col0 - 2816)) = (float4){sigmoidf_(v[0]), sigmoidf_(v[1]), sigmoidf_(v[2]), sigmoidf_(v[3])};
        }
    }
    DEV void finish(int, int, unsigned char*) const {}
};

struct EpiOutProj {
    const float* xold; float* xnew; const float* g1;
    DEV bool swapped(int) const { return true; }
    DEV void rows4(int, int, f32x4) const {}
    DEV void cols4(int row, int col0, f32x4 v) const {
        const int b = row >> 13; const float4 gg = *(const float4*)(g1 + b * 6144 + col0);
        const size_t o = (size_t)row * 1024 + col0;
        const float4 x = *(const float4*)(xold + o);
        *(float4*)(xnew + o) = (float4){x.x + gg.x * v[0], x.y + gg.y * v[1], x.z + gg.z * v[2], x.w + gg.w * v[3]};
    }
    DEV void finish(int, int, unsigned char*) const {}
};

struct EpiStoreBf16 {
    u16* out; int ld;
    DEV bool swapped(int) const { return true; }
    DEV void rows4(int, int, f32x4) const {}
    DEV void cols4(int row, int col0, f32x4 v) const {
        u32x2 w; w[0] = pack2(v[0], v[1]); w[1] = pack2(v[2], v[3]);
        *(u32x2*)(out + (size_t)row * ld + col0) = w;
    }
    DEV void finish(int, int, unsigned char*) const {}
};

struct EpiCompress {
    const float* cbp;
    const float* w2;
    u16* outp;
    int isv;
    unsigned char* lds;
    DEV bool swapped(int) const { return false; }
    DEV void cols4(int, int, f32x4) const {}
    DEV void rows4(int row0, int col, f32x4 v) const {
        float* hid = (float*)lds;
        const int rl = row0 & 127;
#pragma unroll
        for (int r = 0; r < 4; ++r) hid[(rl + r) * 128 + col] = v[r];
    }
    DEV void finish(int m0, int, unsigned char*) const {
        __syncthreads();
        {
            float* hw = (float*)lds;
            const int t = TID(); const int c = t & 127, r0 = (t >> 7) * 64;
            float bias = 0.f;
#pragma unroll
            for (int s = 0; s < 16; ++s) bias += cbp[s * 128 + c];
#pragma unroll 4
            for (int r = 0; r < 64; ++r) { const float x = hw[(r0 + r) * 128 + c] + bias; hw[(r0 + r) * 128 + c] = x * sigmoidf_(x); }
        }
        __syncthreads();
        const float* hid = (const float*)lds;
        const int tid = TID(); const int d = tid & 63, rgp = tid >> 6;
        float acc[32];
#pragma unroll
        for (int i = 0; i < 32; ++i) acc[i] = 0.f;
#pragma unroll 1
        for (int j0 = 0; j0 < 128; j0 += 8) {
            float wv[8];
#pragma unroll
            for (int jj = 0; jj < 8; ++jj) wv[jj] = w2[(j0 + jj) * 64 + d];
#pragma unroll
            for (int rr = 0; rr < 32; ++rr) {
                const float4 h0 = *(const float4*)(hid + (rgp * 32 + rr) * 128 + j0), h1 = *(const float4*)(hid + (rgp * 32 + rr) * 128 + j0 + 4);
                acc[rr] += h0.x * wv[0] + h0.y * wv[1] + h0.z * wv[2] + h0.w * wv[3] + h1.x * wv[4] + h1.y * wv[5] + h1.z * wv[6] + h1.w * wv[7];
            }
        }
#pragma unroll
        for (int rr = 0; rr < 32; ++rr) {
            const int m = m0 + rgp * 32 + rr; const int bg = m >> 9, n = m & 511;
            const u16 val = (n == 511) ? (u16)0 : f2bf(acc[rr]);
            if (!isv) outp[((size_t)bg * 512 + n) * 64 + d] = val;
            else {
                const int k = n & 31; const int pp = 8 * ((k & 15) >> 2) + (k & 3) + 4 * (k >> 4);
                outp[((size_t)bg * 64 + d) * 512 + (n & ~31) + pp] = val;
            }
        }
        __syncthreads();
    }
};

DEV void transpose_tile(const float* __restrict__ src, int N, u16* __restrict__ dst, int ldk, int kt, int nt, float* tl) {
    const int tid = TID(); const int k0 = kt * 64, n0 = nt * 64;
#pragma unroll 4
    for (int i = 0; i < 16; ++i) {
        const int idx = tid + 256 * i; const int kr = idx >> 6, nc = idx & 63; const int n = n0 + nc;
        tl[kr * 65 + nc] = (n < N) ? src[(size_t)(k0 + kr) * N + n] : 0.f;
    }
    __syncthreads();
#pragma unroll 4
    for (int i = 0; i < 16; ++i) {
        const int idx = tid + 256 * i; const int nr = idx >> 6, kc = idx & 63;
        dst[(size_t)(n0 + nr) * ldk + k0 + kc] = f2bf(tl[kc * 65 + nr]);
    }
    __syncthreads();
}

DEV void convert_straight(const float* __restrict__ src, u16* __restrict__ dst, size_t n) {
    const size_t stride = (size_t)gridDim.x * 256 * 8;
    for (size_t i = ((size_t)BID() * 256 + TID()) * 8; i < n; i += stride) {
        const float4 a = *(const float4*)(src + i); const float4 b = *(const float4*)(src + i + 4);
        u32x4 w; w[0] = pack2(a.x, a.y); w[1] = pack2(a.z, a.w); w[2] = pack2(b.x, b.y); w[3] = pack2(b.z, b.w);
        *(u32x4*)(dst + i) = w;
    }
}

DEV void convert_rows_task(const float* __restrict__ src, unsigned char* __restrict__ dst, float* __restrict__ scale, int row0) {
    const int lane = TID() & 63, wave = TID() >> 6;
#pragma unroll 1
    for (int it = 0; it < 4; ++it) {
        float4 v[2][4]; float amax[2] = {0.f, 0.f};
#pragma unroll
        for (int u = 0; u < 2; ++u) {
            const int row = row0 + wave * 8 + it * 2 + u;
#pragma unroll
            for (int i = 0; i < 4; ++i) v[u][i] = *(const float4*)(src + (size_t)row * 1024 + 16 * lane + 4 * i);
        }
#pragma unroll
        for (int u = 0; u < 2; ++u) {
#pragma unroll
            for (int i = 0; i < 4; ++i)
                amax[u] = fmaxf(amax[u], fmaxf(fmaxf(fabsf(v[u][i].x), fabsf(v[u][i].y)), fmaxf(fabsf(v[u][i].z), fabsf(v[u][i].w))));
            amax[u] = wave_max(amax[u]);
            const int row = row0 + wave * 8 + it * 2 + u;
            const float sc = amax[u] > 0.f ? amax[u] * (1.f / 127.f) : 1.f;
            const float inv = 1.f / sc;
            u32x4 w;
#pragma unroll
            for (int i = 0; i < 4; ++i) {
                const int a = __float2int_rn(v[u][i].x * inv) + 128, b = __float2int_rn(v[u][i].y * inv) + 128, c = __float2int_rn(v[u][i].z * inv) + 128,
                          d = __float2int_rn(v[u][i].w * inv) + 128;
                w[i] = (unsigned)a | ((unsigned)b << 8) | ((unsigned)c << 16) | ((unsigned)d << 24);
            }
            *(u32x4*)(dst + (size_t)row * 1024 + 16 * lane) = w;
            if (lane == 0) scale[row] = sc;
        }
    }
}

DEV void phase_prep(const Params& p, unsigned char* lds) {
    const int tid = TID();
    float* fl = (float*)lds;
    unsigned char* ws = p.ws;
    for (int task = BID(); task < 192; task += gridDim.x) {
        const int l = task / 96, cgp = task % 96;
        float* cs = fl;
        float* red = fl + 4096;
        for (int i = tid; i < 4096; i += 256) { const float c = p.in[I_C][i]; cs[i] = c / (1.f + __expf(-c)); }
        __syncthreads();
        const int col = cgp * 64 + (tid & 63), ks = tid >> 6;
        float a0 = 0, a1 = 0, a2 = 0, a3 = 0;
        const float* w = p.in[I_ADAW] + ((size_t)l * 1024 + ks * 256) * 6144 + col;
#pragma unroll 8
        for (int k = 0; k < 256; ++k) {
            const float wv = w[(size_t)k * 6144]; const int kk = ks * 256 + k;
            a0 += cs[kk] * wv; a1 += cs[1024 + kk] * wv; a2 += cs[2048 + kk] * wv; a3 += cs[3072 + kk] * wv;
        }
        red[(ks * 4 + 0) * 64 + (tid & 63)] = a0; red[(ks * 4 + 1) * 64 + (tid & 63)] = a1;
        red[(ks * 4 + 2) * 64 + (tid & 63)] = a2; red[(ks * 4 + 3) * 64 + (tid & 63)] = a3;
        __syncthreads();
        {
            const int b = tid >> 6, c = tid & 63;
            const float s = red[(0 * 4 + b) * 64 + c] + red[(1 * 4 + b) * 64 + c] + red[(2 * 4 + b) * 64 + c] + red[(3 * 4 + b) * 64 + c];
            const int colg = cgp * 64 + c;
            ((float*)(ws + OFF_MOD))[(l * 4 + b) * 6144 + colg] = s + p.in[I_ADAB][l * 6144 + colg];
        }
        __syncthreads();
    }
    for (int task = BID(); task < 64; task += gridDim.x) {
        const int l = task >> 5, kv = (task >> 4) & 1, s = task & 15;
        const float* pos = p.in[kv ? I_CVPOS : I_CKPOS] + l * 2048;
        const float* w1 = p.in[kv ? I_CVW1 : I_CKW1] + (size_t)l * 2048 * 128;
        const int col = tid & 127, half = tid >> 7;
        float a = 0;
        const int i0 = s * 128 + half * 64;
#pragma unroll 8
        for (int i = 0; i < 64; ++i) a += pos[i0 + i] * w1[(size_t)(i0 + i) * 128 + col];
        fl[tid] = a;
        __syncthreads();
        if (tid < 128) ((float*)(ws + OFF_CBP))[((l * 2 + kv) * 16 + s) * 128 + tid] = fl[tid] + fl[tid + 128];
        __syncthreads();
    }
    {
        for (int task = BID(); task < 2 * 16 * 46; task += gridDim.x) {
            const int l = task / (16 * 46), r = task % (16 * 46);
            transpose_tile(p.in[I_WIN] + (size_t)l * 1024 * NIN, NIN, (u16*)(ws + OFF_WIN) + (size_t)l * NINP * 1024, 1024, r / 46, r % 46, fl);
        }
        for (int task = BID(); task < 2 * 16 * 16; task += gridDim.x) {
            const int l = task >> 8, r = task & 255;
            transpose_tile(p.in[I_WOUT] + (size_t)l * 1024 * 1024, 1024, (u16*)(ws + OFF_WOUT) + (size_t)l * 1024 * 1024, 1024, r >> 4, r & 15, fl);
        }
        for (int task = BID(); task < 2 * 16 * 32; task += gridDim.x) {
            const int l = task >> 9, r = task & 511;
            transpose_tile(p.in[I_PWQ] + (size_t)l * 1024 * 2048, 2048, (u16*)(ws + OFF_WQ) + (size_t)l * 2048 * 1024, 1024, r >> 5, r & 31, fl);
        }
        for (int task = BID(); task < 2 * 16; task += gridDim.x) {
            const int l = task >> 4, r = task & 15; const int nt = r & 3, part = r >> 2;
            u16* dst = (u16*)(ws + OFF_LW) + (size_t)l * 65536;
            if (part == 0) transpose_tile(p.in[I_WUP] + (size_t)l * 64 * 256, 256, dst, 256, 0, nt, fl);
            else if (part == 1) transpose_tile(p.in[I_AUP] + (size_t)l * 64 * 256, 256, dst + 64, 256, 0, nt, fl);
            else transpose_tile(p.in[I_GUP] + (size_t)l * 128 * 256, 256, dst + 128, 256, part - 2, nt, fl);
        }
        for (int task = BID(); task < 4 * 32 * 2; task += gridDim.x) {
            const int lk = task >> 6, r = task & 63; const int l = lk >> 1, kv = lk & 1;
            transpose_tile(p.in[kv ? I_CVW1 : I_CKW1] + (size_t)l * 2048 * 128, 128, (u16*)(ws + OFF_CW1) + (size_t)lk * 128 * 2048, 2048, r >> 1, r & 1, fl);
        }
    }
    for (int l = 0; l < 2; ++l) {
        convert_straight(p.in[I_PK1] + l * 16384, (u16*)(ws + OFF_K12) + (l * 2 + 0) * 16384, 16384);
        convert_straight(p.in[I_PK2] + l * 16384, (u16*)(ws + OFF_K12) + (l * 2 + 1) * 16384, 16384);
    }
}

DEV void phase_norm(const float* __restrict__ x, const float* __restrict__ g, const float* __restrict__ sh, const float* __restrict__ sc,
                    u16* __restrict__ h) {
    const int lane = TID() & 63;
    const int gw = BID() * 4 + (TID() >> 6), nw = gridDim.x * 4;
    for (int row = gw; row < NTOK; row += nw) {
        const int b = row >> 13;
        float4 v[4]; float ss = 0;
#pragma unroll
        for (int i = 0; i < 4; ++i) { v[i] = *(const float4*)(x + (size_t)row * 1024 + 256 * i + lane * 4); ss += v[i].x * v[i].x + v[i].y * v[i].y + v[i].z * v[i].z + v[i].w * v[i].w; }
        ss = wave_sum(ss);
        const float rs = rsqrtf(ss * (1.f / 1024.f) + 1e-6f);
#pragma unroll
        for (int i = 0; i < 4; ++i) {
            const int k = 256 * i + lane * 4;
            const float4 gg = *(const float4*)(g + k); const float4 s1 = *(const float4*)(sc + b * 6144 + k); const float4 s0 = *(const float4*)(sh + b * 6144 + k);
            u32x2 w;
            w[0] = pack2(v[i].x * rs * gg.x * (1.f + s1.x) + s0.x, v[i].y * rs * gg.y * (1.f + s1.y) + s0.y);
            w[1] = pack2(v[i].z * rs * gg.z * (1.f + s1.z) + s0.z, v[i].w * rs * gg.w * (1.f + s1.w) + s0.w);
            *(u32x2*)(h + (size_t)row * 1024 + k) = w;
        }
    }
}

DEV void phase_final_only(const float* __restrict__ x, const float* __restrict__ g, float* __restrict__ out) {
    const int lane = TID() & 63;
    const int gw = BID() * 4 + (TID() >> 6), nw = gridDim.x * 4;
    for (int row = gw; row < NTOK; row += nw) {
        float4 v[4]; float ss = 0;
#pragma unroll
        for (int i = 0; i < 4; ++i) { v[i] = *(const float4*)(x + (size_t)row * 1024 + 256 * i + lane * 4); ss += v[i].x * v[i].x + v[i].y * v[i].y + v[i].z * v[i].z + v[i].w * v[i].w; }
        ss = wave_sum(ss);
        const float rs = rsqrtf(ss * (1.f / 1024.f) + 1e-6f);
#pragma unroll
        for (int i = 0; i < 4; ++i) {
            const int k = 256 * i + lane * 4; const float4 gg = *(const float4*)(g + k);
            float4 o; o.x = v[i].x * rs * gg.x; o.y = v[i].y * rs * gg.y; o.z = v[i].z * rs * gg.z; o.w = v[i].w * rs * gg.w;
            *(float4*)(out + (size_t)row * 1024 + k) = o;
        }
    }
}


DEV void conv_tile(const Params& p, int l, int tile, unsigned char* lds) {
    float* ul = (float*)lds;
    const int tid = TID();
    unsigned char* ws = p.ws;
    const u16* pconv = (const u16*)(ws + OFF_PCONV);
    u16* mix = (u16*)(ws + OFF_MIX);
    const int t0g = tile * 32; const int tb = t0g & 8191;
#pragma unroll 8
    for (int rr = 0; rr < 62; ++rr) {
        const int trow = tb - 30 + rr;
        float u = 0.f;
        if (trow >= 0) {
            const size_t o = (size_t)(t0g - 30 + rr) * 512;
            const float val = bf2f(pconv[o + tid]), gt = bf2f(pconv[o + 256 + tid]);
            u = val * sigmoidf_(gt);
        }
        ul[rr * 256 + tid] = u;
    }
    __syncthreads();
    float w[31];
#pragma unroll
    for (int j = 0; j < 31; ++j) w[j] = p.in[I_CDW][(l * 31 + j) * 256 + tid];
    const float bias = p.in[I_CDB][l * 256 + tid], gg = p.in[I_CGG][l * 256 + tid], gb = p.in[I_CGB][l * 256 + tid];
    for (int tt = 0; tt < 32; ++tt) {
        float y = bias;
#pragma unroll
        for (int j = 0; j < 31; ++j) y += ul[(tt + j) * 256 + tid] * w[j];
        const float mean = wave_sum(y) * (1.f / 64.f);
        const float d = y - mean;
        const float var = wave_sum(d * d) * (1.f / 64.f);
        float o = d * rsqrtf(var + 1e-5f) * gg + gb;
        o = o * sigmoidf_(o);
        mix[(size_t)(t0g + tt) * 1024 + tid] = f2bf(o);
    }
}

DEV float softplusf_(float x) { return x > 20.f ? x : log1pf(__expf(x)); }
DEV void rwkv_prep_tile(const Params& p, int l, int tile, unsigned char* lds) {
    float* actT = (float*)lds;
    const int tid = TID(), lane = tid & 63;
    unsigned char* ws = p.ws;
    const u16* pr = (const u16*)(ws + OFF_PRWKV);
    const float* mu = p.in[I_MU] + l * 1024;
    const int R0 = tile * 16;
    {
        const int col = 768 + tid; const float muc = mu[col];
#pragma unroll 4
        for (int tk = 0; tk < 16; ++tk) {
            const int row = R0 + tk; const int t = row & 8191;
            const float cur = bf2f(pr[(size_t)row * 1024 + col]);
            const float prev = t > 0 ? bf2f(pr[(size_t)(row - 1) * 1024 + col]) : 0.f;
            const float x = cur + (prev - cur) * muc;
            float a;
            if (tid < 64) a = tanhf(x); else if (tid < 128) a = x; else a = sigmoidf_(x);
            actT[tid * 16 + tk] = a;
        }
    }
    __syncthreads();
    float accw[16], acca[16], accg[16];
#pragma unroll
    for (int i = 0; i < 16; ++i) { accw[i] = 0.f; acca[i] = 0.f; accg[i] = 0.f; }
    const float* wup = p.in[I_WUP] + (size_t)l * 64 * 256 + tid;
    const float* aup = p.in[I_AUP] + (size_t)l * 64 * 256 + tid;
    const float* gup = p.in[I_GUP] + (size_t)l * 128 * 256 + tid;
#pragma unroll 8
    for (int j = 0; j < 64; ++j) {
        const float ww = wup[j * 256], aa = aup[j * 256];
        const float4* x1 = (const float4*)(actT + j * 16);
        const float4* x2 = (const float4*)(actT + (64 + j) * 16);
#pragma unroll
        for (int q = 0; q < 4; ++q) {
            const float4 a = x1[q], b = x2[q];
            accw[4 * q + 0] += a.x * ww; accw[4 * q + 1] += a.y * ww; accw[4 * q + 2] += a.z * ww; accw[4 * q + 3] += a.w * ww;
            acca[4 * q + 0] += b.x * aa; acca[4 * q + 1] += b.y * aa; acca[4 * q + 2] += b.z * aa; acca[4 * q + 3] += b.w * aa;
        }
    }
#pragma unroll 8
    for (int j = 0; j < 128; ++j) {
        const float gg = gup[j * 256];
        const float4* x3 = (const float4*)(actT + (128 + j) * 16);
#pragma unroll
        for (int q = 0; q < 4; ++q) {
            const float4 a = x3[q];
            accg[4 * q + 0] += a.x * gg; accg[4 * q + 1] += a.y * gg; accg[4 * q + 2] += a.z * gg; accg[4 * q + 3] += a.w * gg;
        }
    }
    const float w0 = p.in[I_W0][l * 256 + tid], a0 = p.in[I_A0][l * 256 + tid], kkc = p.in[I_KK][l * 256 + tid], kac = p.in[I_KA][l * 256 + tid],
                rkc = p.in[I_RK][l * 256 + tid];
    const float mur = mu[tid], muk = mu[256 + tid], muv = mu[512 + tid];
    float* RW = (float*)(ws + OFF_RW);
    u16 *RR = (u16*)(ws + OFF_RR), *RK = (u16*)(ws + OFF_RK), *RV = (u16*)(ws + OFF_RV), *RKK = (u16*)(ws + OFF_RKK), *RKKA = (u16*)(ws + OFF_RKKA),
        *RG = (u16*)(ws + OFF_RG);
    float* BON = (float*)(ws + OFF_BONUS);
#pragma unroll
    for (int tk = 0; tk < 16; ++tk) {
        const int row = R0 + tk; const int t = row & 8191;
        const u16* cr = pr + (size_t)row * 1024; const u16* pv = cr - 1024;
        float r = bf2f(cr[tid]), k = bf2f(cr[256 + tid]), v = bf2f(cr[512 + tid]);
        const float rp = t > 0 ? bf2f(pv[tid]) : 0.f, kp = t > 0 ? bf2f(pv[256 + tid]) : 0.f, vp = t > 0 ? bf2f(pv[512 + tid]) : 0.f;
        r += (rp - r) * mur; k += (kp - k) * muk; v += (vp - v) * muv;
        const float wl = w0 + accw[tk];
        const float wlog = -softplusf_(-wl) - 0.5f;
        const float decay = __expf(-__expf(wlog));
        const float a = sigmoidf_(a0 + acca[tk]);
        float kk = k * kkc;
        const float nrm = sqrtf(wave_sum(kk * kk));
        kk = kk / fmaxf(nrm, 1e-12f);
        const float keff = k * (1.f + (a - 1.f) * kac);
        const float bon = wave_sum(r * keff * rkc);
        const size_t o = (size_t)row * 256 + tid;
        RW[o] = decay; RR[o] = f2bf(r); RK[o] = f2bf(keff); RV[o] = f2bf(v); RKK[o] = f2bf(kk); RKKA[o] = f2bf(kk * a); RG[o] = f2bf(accg[tk]);
        if (lane == 0) BON[(size_t)row * 4 + (tid >> 6)] = bon;
    }
}

DEV void rwkv_prep_tile2(const Params& p, int l, int tile, unsigned char* lds) {
    u16* actb = (u16*)lds;
    const int tid = TID(), lane = tid & 63, wave = tid >> 6, q4 = lane >> 4, cidx = lane & 15;
    unsigned char* ws = p.ws;
    const u16* pr = (const u16*)(ws + OFF_PRWKV);
    const float* mu = p.in[I_MU] + l * 1024;
    const int R0 = tile * 16;
    {
        const int col = 768 + tid; const float muc = mu[col];
#pragma unroll 4
        for (int tk = 0; tk < 16; ++tk) {
            const int row = R0 + tk; const int t = row & 8191;
            const float cur = bf2f(pr[(size_t)row * 1024 + col]);
            const float prev = t > 0 ? bf2f(pr[(size_t)(row - 1) * 1024 + col]) : 0.f;
            const float x = cur + (prev - cur) * muc;
            float a;
            if (tid < 64) a = tanhf(x); else if (tid < 128) a = x; else a = sigmoidf_(x);
            actb[tk * 264 + tid] = f2bf(a);
        }
    }
    __syncthreads();
    f32x4 accw[4], acca[4], accg[4];
    {
        bf16x8 af[8];
#pragma unroll
        for (int s2 = 0; s2 < 8; ++s2) af[s2] = *(const bf16x8*)(actb + cidx * 264 + 32 * s2 + 8 * q4);
        const u16* LW = (const u16*)(ws + OFF_LW) + (size_t)l * 65536;
        const f32x4 z = (f32x4){0.f, 0.f, 0.f, 0.f};
#pragma unroll
        for (int nt = 0; nt < 4; ++nt) {
            const u16* bp = LW + (size_t)(64 * wave + 16 * nt + cidx) * 256 + 8 * q4;
            accw[nt] = mfma16(af[0], ld8(bp), z); accw[nt] = mfma16(af[1], ld8(bp + 32), accw[nt]);
            acca[nt] = mfma16(af[2], ld8(bp + 64), z); acca[nt] = mfma16(af[3], ld8(bp + 96), acca[nt]);
            accg[nt] = mfma16(af[4], ld8(bp + 128), z); accg[nt] = mfma16(af[5], ld8(bp + 160), accg[nt]);
            accg[nt] = mfma16(af[6], ld8(bp + 192), accg[nt]); accg[nt] = mfma16(af[7], ld8(bp + 224), accg[nt]);
        }
    }
    float* RW = (float*)(ws + OFF_RW);
    u16 *RR = (u16*)(ws + OFF_RR), *RK = (u16*)(ws + OFF_RK), *RV = (u16*)(ws + OFF_RV), *RKK = (u16*)(ws + OFF_RKK), *RKKA = (u16*)(ws + OFF_RKKA),
        *RG = (u16*)(ws + OFF_RG);
    float* BON = (float*)(ws + OFF_BONUS);
    float w0[4], a0[4], kkc[4], kac[4], rkc[4], mur[4], muk[4], muv[4];
#pragma unroll
    for (int nt = 0; nt < 4; ++nt) {
        const int c = 64 * wave + 16 * nt + cidx;
        w0[nt] = p.in[I_W0][l * 256 + c]; a0[nt] = p.in[I_A0][l * 256 + c]; kkc[nt] = p.in[I_KK][l * 256 + c]; kac[nt] = p.in[I_KA][l * 256 + c];
        rkc[nt] = p.in[I_RK][l * 256 + c]; mur[nt] = mu[c]; muk[nt] = mu[256 + c]; muv[nt] = mu[512 + c];
    }
#pragma unroll
    for (int r = 0; r < 4; ++r) {
        const int row = R0 + 4 * q4 + r; const int t = row & 8191;
        const u16* cr = pr + (size_t)row * 1024; const u16* pv = cr - 1024;
        float rr[4], kf_[4], vf_[4], av[4], kkv[4], keff[4], dec[4];
        float kk2 = 0.f, bn = 0.f;
#pragma unroll
        for (int nt = 0; nt < 4; ++nt) {
            const int c = 64 * wave + 16 * nt + cidx;
            float rv = bf2f(cr[c]), kv = bf2f(cr[256 + c]), vv = bf2f(cr[512 + c]);
            const float rp = t > 0 ? bf2f(pv[c]) : 0.f, kp = t > 0 ? bf2f(pv[256 + c]) : 0.f, vp = t > 0 ? bf2f(pv[512 + c]) : 0.f;
            rv += (rp - rv) * mur[nt]; kv += (kp - kv) * muk[nt]; vv += (vp - vv) * muv[nt];
            const float wl = w0[nt] + accw[nt][r];
            const float wlog = -softplusf_(-wl) - 0.5f;
            dec[nt] = __expf(-__expf(wlog));
            av[nt] = sigmoidf_(a0[nt] + acca[nt][r]);
            kkv[nt] = kv * kkc[nt]; kk2 += kkv[nt] * kkv[nt];
            keff[nt] = kv * (1.f + (av[nt] - 1.f) * kac[nt]);
            bn += rv * keff[nt] * rkc[nt];
            rr[nt] = rv; kf_[nt] = kv; vf_[nt] = vv;
        }
        kk2 = reduce16(kk2); bn = reduce16(bn);
        const float inv = 1.f / fmaxf(sqrtf(kk2), 1e-12f);
#pragma unroll
        for (int nt = 0; nt < 4; ++nt) {
            const int c = 64 * wave + 16 * nt + cidx;
            const size_t o = (size_t)row * 256 + c;
            const float kk = kkv[nt] * inv;
            RW[o] = dec[nt]; RR[o] = f2bf(rr[nt]); RK[o] = f2bf(keff[nt]); RV[o] = f2bf(vf_[nt]); RKK[o] = f2bf(kk); RKKA[o] = f2bf(kk * av[nt]);
            RG[o] = f2bf(accg[nt][r]);
        }
        if (cidx == 0) BON[(size_t)row * 4 + wave] = bn;
    }
}

DEV void rwkv_scan(const Params& p, int sb, unsigned char* lds) {
    unsigned char* ws = p.ws;
    const float* RW = (const float*)(ws + OFF_RW);
    const u16 *RR = (const u16*)(ws + OFF_RR), *RK = (const u16*)(ws + OFF_RK), *RV = (const u16*)(ws + OFF_RV), *RKK = (const u16*)(ws + OFF_RKK),
              *RKKA = (const u16*)(ws + OFF_RKKA);
    float* YR = (float*)(ws + OFF_YRAW);
    const int tid = TID(), lane = tid & 63, wave = tid >> 6;
    const int bh = sb >> 2, rg = sb & 3; const int b = bh >> 2, hh = bh & 3;
    float* L = (float*)lds;
    constexpr int BUFSZ = 5 * 1024 + 256;
    float* Yb = L + 2 * BUFSZ;
    const int row_local = 4 * wave + (lane >> 4); const int kq = (lane & 15) * 4;
    const int lstep = tid >> 4, lk = (tid & 15) * 4;
    const int vstep = tid >> 4, vrow = tid & 15;
    const size_t gbase = (size_t)b * 8192 * 256 + hh * 64;
    float4 lw; u32x2 lr, lkk, lkka, lk_; u16 lv;
    auto issue = [&](int c) {
        const size_t o = gbase + (size_t)(c * 16 + lstep) * 256 + lk;
        lw = *(const float4*)(RW + o);
        lr = *(const u32x2*)(RR + o); lk_ = *(const u32x2*)(RK + o); lkk = *(const u32x2*)(RKK + o); lkka = *(const u32x2*)(RKKA + o);
        lv = RV[gbase + (size_t)(c * 16 + vstep) * 256 + rg * 16 + vrow];
    };
    auto commit = [&](int buf) {
        float* B = L + buf * BUFSZ;
        const int o = lstep * 64 + lk;
        *(float4*)(B + o) = lw;
        *(float4*)(B + 1024 + o) = (float4){bflo(lkka[0]), bfhi(lkka[0]), bflo(lkka[1]), bfhi(lkka[1])};
        *(float4*)(B + 2048 + o) = (float4){bflo(lk_[0]), bfhi(lk_[0]), bflo(lk_[1]), bfhi(lk_[1])};
        *(float4*)(B + 3072 + o) = (float4){bflo(lr[0]), bfhi(lr[0]), bflo(lr[1]), bfhi(lr[1])};
        *(float4*)(B + 4096 + o) = (float4){bflo(lkk[0]), bfhi(lkk[0]), bflo(lkk[1]), bfhi(lkk[1])};
        B[5120 + vstep * 16 + vrow] = bf2f(lv);
    };
    __syncthreads();
    issue(0); commit(0);
    __syncthreads();
    float S0 = 0.f, S1 = 0.f, S2 = 0.f, S3 = 0.f;
    constexpr int NCH = NT / 16;
    for (int c = 0; c < NCH; ++c) {
        const int buf = c & 1;
        if (c + 1 < NCH) issue(c + 1);
        const float* B = L + buf * BUFSZ;
        float* Y = Yb + buf * 256;
        float yv[16];
        float4 w4 = *(const float4*)(B + kq), a4 = *(const float4*)(B + 1024 + kq), k4 = *(const float4*)(B + 2048 + kq),
               r4 = *(const float4*)(B + 3072 + kq), n4 = *(const float4*)(B + 4096 + kq);
        float vv = B[5120 + row_local];
#pragma unroll
        for (int st = 0; st < 16; ++st) {
            float4 w4n, a4n, k4n, r4n, n4n; float vvn;
            if (st < 15) {
                w4n = *(const float4*)(B + (st + 1) * 64 + kq); a4n = *(const float4*)(B + 1024 + (st + 1) * 64 + kq);
                k4n = *(const float4*)(B + 2048 + (st + 1) * 64 + kq); r4n = *(const float4*)(B + 3072 + (st + 1) * 64 + kq);
                n4n = *(const float4*)(B + 4096 + (st + 1) * 64 + kq); vvn = B[5120 + (st + 1) * 16 + row_local];
            }
            const float part = (S0 * n4.x + S1 * n4.y) + (S2 * n4.z + S3 * n4.w);
            const float sa = -reduce16(part);
            const float t0 = S0 * w4.x + vv * k4.x, t1 = S1 * w4.y + vv * k4.y, t2 = S2 * w4.z + vv * k4.z, t3 = S3 * w4.w + vv * k4.w;
            S0 = t0 + sa * a4.x; S1 = t1 + sa * a4.y; S2 = t2 + sa * a4.z; S3 = t3 + sa * a4.w;
            const float yp = (S0 * r4.x + S1 * r4.y) + (S2 * r4.z + S3 * r4.w);
            yv[st] = reduce16(yp);
            if (st < 15) { w4 = w4n; a4 = a4n; k4 = k4n; r4 = r4n; n4 = n4n; vv = vvn; }
        }
        if ((lane & 15) == 0) {
#pragma unroll
            for (int st = 0; st < 16; ++st) Y[st * 16 + row_local] = yv[st];
        }
        if (c + 1 < NCH) commit(buf ^ 1);
        __syncthreads();
        YR[gbase + (size_t)(c * 16 + vstep) * 256 + rg * 16 + vrow] = Y[vstep * 16 + vrow];
    }
}

DEV void phase_rwkv_post(const Params& p, int l) {
    unsigned char* ws = p.ws;
    const float* YR = (const float*)(ws + OFF_YRAW); const float* BON = (const float*)(ws + OFF_BONUS);
    const u16 *RV = (const u16*)(ws + OFF_RV), *RG = (const u16*)(ws + OFF_RG);
    u16* mix = (u16*)(ws + OFF_MIX);
    const int tid = TID();
    const float lg = p.in[I_LNG][l * 256 + tid], lb = p.in[I_LNB][l * 256 + tid];
    for (int row = BID(); row < NTOK; row += gridDim.x) {
        const size_t o = (size_t)row * 256 + tid;
        const float y = YR[o];
        const float mean = wave_sum(y) * (1.f / 64.f);
        const float d = y - mean;
        const float var = wave_sum(d * d) * (1.f / 64.f);
        const float yn = d * rsqrtf(var + 64e-5f) * lg + lb;
        const float outv = (yn + BON[(size_t)row * 4 + (tid >> 6)] * bf2f(RV[o])) * bf2f(RG[o]);
        mix[(size_t)row * 1024 + 256 + tid] = f2bf(outv);
    }
}

DEV void zero_mix_cols(const Params& p, int c0, int ncols) {
    u16* mix = (u16*)(p.ws + OFF_MIX);
    const int per = ncols / 8;
    const size_t total = (size_t)NTOK * per;
    for (size_t i = (size_t)BID() * 256 + TID(); i < total; i += (size_t)gridDim.x * 256) {
        const size_t row = i / per; const int cc = (int)(i % per);
        *(u32x4*)(mix + row * 1024 + c0 + cc * 8) = (u32x4){0u, 0u, 0u, 0u};
    }
}


DEV void load_kv(const u16* __restrict__ Kb, const u16* __restrict__ VTb, int q4, int cidx, bf16x8 (&kf)[8], bf16x8 (&vf)[8]) {
#pragma unroll
    for (int kt = 0; kt < 4; ++kt) { const u16* kp = Kb + (kt * 16 + cidx) * 64 + 8 * q4; kf[2 * kt] = ld8(kp); kf[2 * kt + 1] = ld8(kp + 32); }
#pragma unroll
    for (int kb = 0; kb < 2; ++kb)
#pragma unroll
        for (int mt = 0; mt < 4; ++mt) vf[kb * 4 + mt] = ld8(VTb + (size_t)(16 * mt + cidx) * 8192 + kb * 32 + 8 * q4);
}
DEV void qk_tile(const bf16x8 (&kf)[8], bf16x8 q0, bf16x8 q1, f32x4 (&st)[4]) {
#pragma unroll
    for (int kt = 0; kt < 4; ++kt) {
        st[kt] = mfma16(kf[2 * kt], q0, (f32x4){0.f, 0.f, 0.f, 0.f});
        st[kt] = mfma16(kf[2 * kt + 1], q1, st[kt]);
    }
}
DEV void softmax_pv_tile(bool MASK, f32x4 (&st)[4], const bf16x8 (&vf)[8], int keybase, int tcol, int lowcol, bool colsel, float& m, float& l, f32x4 (&O)[4], int q4) {
    float lmax = -1e30f;
    if (MASK) {
        const int hi = colsel ? tcol : -1;
#pragma unroll
        for (int kt = 0; kt < 4; ++kt)
#pragma unroll
            for (int r = 0; r < 4; ++r) {
                const int key = keybase + kt * 16 + 4 * q4 + r;
                const bool valid = (key <= hi) && (key > lowcol);
                const float sv = valid ? st[kt][r] : -1e30f;
                st[kt][r] = sv; lmax = fmaxf(lmax, sv);
            }
    } else {
        const float cs = colsel ? 0.f : -1e30f;
#pragma unroll
        for (int kt = 0; kt < 4; ++kt)
#pragma unroll
            for (int r = 0; r < 4; ++r) { const float sv = st[kt][r] + cs; st[kt][r] = sv; lmax = fmaxf(lmax, sv); }
    }
    lmax = colmax(lmax);
    const float mnew = fmaxf(m, lmax);
    const float alpha = ex2(m - mnew);
    float psum = 0.f;
#pragma unroll
    for (int kt = 0; kt < 4; ++kt)
#pragma unroll
        for (int r = 0; r < 4; ++r) {
            float pv = ex2(st[kt][r] - mnew);
            pv = (st[kt][r] > -1e29f) ? pv : 0.f;
            st[kt][r] = pv; psum += pv;
        }
    l = l * alpha + psum;
    if (__any(mnew > m)) {
#pragma unroll
        for (int mt = 0; mt < 4; ++mt) { O[mt][0] *= alpha; O[mt][1] *= alpha; O[mt][2] *= alpha; O[mt][3] *= alpha; }
    }
    m = mnew;
#pragma unroll
    for (int kb = 0; kb < 2; ++kb) {
        union { bf16x8 v; unsigned u[4]; } pb;
        pb.u[0] = pack2(st[2 * kb][0], st[2 * kb][1]); pb.u[1] = pack2(st[2 * kb][2], st[2 * kb][3]);
        pb.u[2] = pack2(st[2 * kb + 1][0], st[2 * kb + 1][1]); pb.u[3] = pack2(st[2 * kb + 1][2], st[2 * kb + 1][3]);
#pragma unroll
        for (int mt = 0; mt < 4; ++mt) O[mt] = mfma16(vf[kb * 4 + mt], pb.v, O[mt]);
    }
}
DEV unsigned pick4(unsigned a0, unsigned a1, unsigned a2, unsigned a3, int w) { return w == 0 ? a0 : (w == 1 ? a1 : (w == 2 ? a2 : a3)); }
DEV void nsa_branch(const u16* __restrict__ K0, const u16* __restrict__ VT0, unsigned ua0, unsigned ua1, unsigned ua2, unsigned ua3, unsigned ub0,
                    unsigned ub1, unsigned ub2, unsigned ub3, const unsigned* cm, int tokl, const int (&tcol)[2], const int (&lowc)[2],
                    const bf16x8 (&qf)[2][2], float (&m)[2], float (&l)[2], f32x4 (&O)[2][4], int q4, int cidx, int cur, int lowmax) {
    int w = 0; unsigned bits = ua0 | ub0;
    auto advance = [&]() -> int {
        while (bits == 0u && w < 3) { ++w; bits = pick4(ua0, ua1, ua2, ua3, w) | pick4(ub0, ub1, ub2, ub3, w); }
        if (bits == 0u) return -1;
        const int jb = __builtin_ctz(bits); bits &= bits - 1u;
        return w * 32 + jb;
    };
    int blk = advance();
    if (blk < 0) return;
    bf16x8 kf[8], vf[8];
    {
        const u16* Kb = K0 + (size_t)blk * 64 * 64;
#pragma unroll
        for (int kt = 0; kt < 4; ++kt) { const u16* kp = Kb + (kt * 16 + cidx) * 64 + 8 * q4; kf[2 * kt] = ld8(kp); kf[2 * kt + 1] = ld8(kp + 32); }
    }
#pragma unroll 1
    while (blk >= 0) {
        {
            const u16* VTb = VT0 + blk * 64;
#pragma unroll
            for (int kb = 0; kb < 2; ++kb)
#pragma unroll
                for (int mt = 0; mt < 4; ++mt) vf[kb * 4 + mt] = ld8(VTb + (size_t)(16 * mt + cidx) * 8192 + kb * 32 + 8 * q4);
        }
        const int wq = blk >> 5, jb = blk & 31;
        const bool act0 = (pick4(ua0, ua1, ua2, ua3, wq) >> jb) & 1u, act1 = (pick4(ub0, ub1, ub2, ub3, wq) >> jb) & 1u;
        f32x4 st0[4], st1[4];
        if (act0) qk_tile(kf, qf[0][0], qf[0][1], st0);
        if (act1) qk_tile(kf, qf[1][0], qf[1][1], st1);
        const int nblk = advance();
        if (nblk >= 0) {
            const u16* Kb = K0 + (size_t)nblk * 64 * 64;
#pragma unroll
            for (int kt = 0; kt < 4; ++kt) { const u16* kp = Kb + (kt * 16 + cidx) * 64 + 8 * q4; kf[2 * kt] = ld8(kp); kf[2 * kt + 1] = ld8(kp + 32); }
        }
        const bool need_mask = (blk == cur) || (blk * 64 <= lowmax);
        if (act0) {
            const bool cs = cm ? (((cm[tokl * 4 + wq] >> jb) & 1u) != 0u) : true;
            softmax_pv_tile(need_mask, st0, vf, blk * 64, tcol[0], lowc[0], cs, m[0], l[0], O[0], q4);
        }
        if (act1) {
            const bool cs = cm ? (((cm[(4 + tokl) * 4 + wq] >> jb) & 1u) != 0u) : true;
            softmax_pv_tile(need_mask, st1, vf, blk * 64, tcol[1], lowc[1], cs, m[1], l[1], O[1], q4);
        }
        blk = nblk;
    }
}
template <int CTRL> DEV unsigned dpp_or(unsigned x) { return x | dppu<CTRL>(x); }
DEV unsigned row_or(unsigned x) { x = dpp_or<0xB1>(x); x = dpp_or<0x4E>(x); x = dpp_or<0x124>(x); x = dpp_or<0x128>(x); return x; }


DEV void nsa_branch_lds(unsigned char* lds, const u16* __restrict__ K0, const u16* __restrict__ VT0, unsigned bu0, unsigned bu1, unsigned bu2,
                        unsigned bu3, unsigned ua0, unsigned ua1, unsigned ua2, unsigned ua3, unsigned ub0, unsigned ub1, unsigned ub2, unsigned ub3,
                        const unsigned* cm, int tokl, const int (&tcol)[2], const int (&lowc)[2], const bf16x8 (&qf)[2][2], float (&m)[2],
                        float (&l)[2], f32x4 (&O)[2][4], int q4, int cidx, int cur, int lowmax) {
    const int tid = TID();
    int w = 0; unsigned bits = bu0;
    auto advance = [&]() -> int {
        while (bits == 0u && w < 3) { ++w; bits = pick4(bu0, bu1, bu2, bu3, w); }
        if (bits == 0u) return -1;
        const int jb = __builtin_ctz(bits); bits &= bits - 1u;
        return w * 32 + jb;
    };
    const int srow0 = tid >> 3, srow1 = srow0 + 32, sch = tid & 7;
    const int so0 = srow0 * 128 + ((sch ^ (srow0 & 7)) << 4), so1 = srow1 * 128 + ((sch ^ (srow1 & 7)) << 4);
    bf16x8 r0[4], r1[4];
#define NSA_GLOAD(R, BLK_) { R[0] = ld8(K0 + ((size_t)(BLK_) * 64 + srow0) * 64 + sch * 8); R[1] = ld8(K0 + ((size_t)(BLK_) * 64 + srow1) * 64 + sch * 8); \
        R[2] = ld8(VT0 + (size_t)srow0 * 8192 + (BLK_) * 64 + sch * 8); R[3] = ld8(VT0 + (size_t)srow1 * 8192 + (BLK_) * 64 + sch * 8); }
#define NSA_LWRITE(R, BUF_) { unsigned char* wb_ = lds + (BUF_) * 16384; *(bf16x8*)(wb_ + so0) = R[0]; *(bf16x8*)(wb_ + so1) = R[1]; \
        *(bf16x8*)(wb_ + 8192 + so0) = R[2]; *(bf16x8*)(wb_ + 8192 + so1) = R[3]; }
    auto compute = [&](int blk, int buf) {
        const int wq = blk >> 5, jb = blk & 31;
        const bool act0 = (pick4(ua0, ua1, ua2, ua3, wq) >> jb) & 1u, act1 = (pick4(ub0, ub1, ub2, ub3, wq) >> jb) & 1u;
        if (act0 || act1) {
            const unsigned char* kb_ = lds + buf * 16384;
            bf16x8 kf[8], vf[8];
#pragma unroll
            for (int kt = 0; kt < 4; ++kt)
#pragma unroll
                for (int s2 = 0; s2 < 2; ++s2) {
                    const int row = 16 * kt + cidx, ch = 4 * s2 + q4;
                    kf[2 * kt + s2] = *(const bf16x8*)(kb_ + row * 128 + ((ch ^ (row & 7)) << 4));
                }
#pragma unroll
            for (int kb = 0; kb < 2; ++kb)
#pragma unroll
                for (int mt = 0; mt < 4; ++mt) {
                    const int row = 16 * mt + cidx, ch = 4 * kb + q4;
                    vf[kb * 4 + mt] = *(const bf16x8*)(kb_ + 8192 + row * 128 + ((ch ^ (row & 7)) << 4));
                }
            const bool need_mask = (blk == cur) || (blk * 64 <= lowmax);
            f32x4 st0[4], st1[4];
            if (act0) qk_tile(kf, qf[0][0], qf[0][1], st0);
            if (act1) qk_tile(kf, qf[1][0], qf[1][1], st1);
            if (act0) {
                const bool cs = cm ? (((cm[tokl * 4 + wq] >> jb) & 1u) != 0u) : true;
                softmax_pv_tile(need_mask, st0, vf, blk * 64, tcol[0], lowc[0], cs, m[0], l[0], O[0], q4);
            }
            if (act1) {
                const bool cs = cm ? (((cm[(4 + tokl) * 4 + wq] >> jb) & 1u) != 0u) : true;
                softmax_pv_tile(need_mask, st1, vf, blk * 64, tcol[1], lowc[1], cs, m[1], l[1], O[1], q4);
            }
        }
    };
    int b0 = advance();
    if (b0 < 0) return;
    int b1 = advance();
    NSA_GLOAD(r0, b0);
    if (b1 >= 0) NSA_GLOAD(r1, b1);
    NSA_LWRITE(r0, 0);
    __syncthreads();
#pragma unroll 1
    while (b0 >= 0) {
        const int b2 = (b1 >= 0) ? advance() : -1;
        if (b2 >= 0) NSA_GLOAD(r0, b2);
        compute(b0, 0);
        if (b1 >= 0) NSA_LWRITE(r1, 1);
        __syncthreads();
        if (b1 < 0) break;
        const int b3 = (b2 >= 0) ? advance() : -1;
        if (b3 >= 0) NSA_GLOAD(r1, b3);
        compute(b1, 1);
        if (b2 >= 0) NSA_LWRITE(r0, 0);
        __syncthreads();
        b0 = b2; b1 = b3;
    }
#undef NSA_GLOAD
#undef NSA_LWRITE
}

DEV void nsa_block_task(const Params& p, int task, unsigned char* lds) {
    const int wave = TID() >> 6;
    float* wl = (float*)(lds + 32768) + wave * 2112;
    unsigned* bm = (unsigned*)(lds + 32768 + 4 * 8448);
    float* impA = wl; float* impB = wl + 1024; unsigned* selmask = (unsigned*)(wl + 1024 + 1056);
    unsigned char* ws = p.ws;
    const u16* Q = (const u16*)(ws + OFF_Q);
    const u16* KVb = (const u16*)(ws + OFF_KV);
    const u16 *KSEL = KVb + (size_t)2 * 4194304, *VSELT = KVb + (size_t)3 * 4194304, *KWIN = KVb + (size_t)4 * 4194304, *VWINT = KVb + (size_t)5 * 4194304;
    const u16* KC = (const u16*)(ws + OFF_KC); const u16* VCT = (const u16*)(ws + OFF_VCT);
    const float* GATE = (const float*)(ws + OFF_GATE);
    u16* mix = (u16*)(ws + OFF_MIX);
    const int lane = TID() & 63, q4 = lane >> 4, cidx = lane & 15;
    const int bg = task & 7, t0b = (255 - (task >> 3)) * 32, t0 = t0b + 8 * wave; const int b = bg >> 1, g = bg & 1;
    const int tokl = cidx >> 2, hr = cidx & 3; const int head = g * 4 + hr;
    const int cur = t0 >> 6;
    int tcol[2], rowc[2]; bf16x8 qf[2][2];
#pragma unroll
    for (int ti = 0; ti < 2; ++ti) {
        tcol[ti] = t0 + 4 * ti + tokl; rowc[ti] = b * 8192 + tcol[ti];
        qf[ti][0] = ld8(Q + (size_t)rowc[ti] * 512 + head * 64 + 8 * q4); qf[ti][1] = ld8(Q + (size_t)rowc[ti] * 512 + head * 64 + 32 + 8 * q4);
    }
    f32x4 Oc[2][4];
    {
        int cnt_col[2];
#pragma unroll
        for (int ti = 0; ti < 2; ++ti) cnt_col[ti] = tcol[ti] >= 31 ? ((tcol[ti] - 31) >> 4) + 1 : 0;
        const int tmax = t0 + 7; const int cmax = tmax >= 31 ? ((tmax - 31) >> 4) + 1 : 0;
        const int ntile = (cmax + 15) >> 4;
        const u16* kcb = KC + (size_t)bg * 512 * 64;
        float ml[2] = {-1e30f, -1e30f}, ll[2] = {0.f, 0.f};
#pragma unroll 1
        for (int kt = 0; kt < ntile; ++kt) {
            const u16* kp = kcb + (kt * 16 + cidx) * 64 + 8 * q4;
            const bf16x8 k0 = ld8(kp), k1 = ld8(kp + 32);
#pragma unroll
            for (int ti = 0; ti < 2; ++ti) {
                f32x4 st = mfma16(k0, qf[ti][0], (f32x4){0.f, 0.f, 0.f, 0.f});
                st = mfma16(k1, qf[ti][1], st);
                float sv[4]; float tm = -1e30f;
#pragma unroll
                for (int r = 0; r < 4; ++r) { const int n = kt * 16 + 4 * q4 + r; sv[r] = (n < cnt_col[ti]) ? st[r] : -1e30f; tm = fmaxf(tm, sv[r]); }
                const float mn = fmaxf(ml[ti], tm);
                float ps = 0.f;
#pragma unroll
                for (int r = 0; r < 4; ++r) ps += (sv[r] > -1e29f) ? ex2(sv[r] - mn) : 0.f;
                ll[ti] = ll[ti] * ex2(ml[ti] - mn) + ps; ml[ti] = mn;
            }
        }
        float mfin[2], inv[2];
#pragma unroll
        for (int ti = 0; ti < 2; ++ti) {
            mfin[ti] = colmax(ml[ti]);
            const float lsum = colsum(ll[ti] * ex2(ml[ti] - mfin[ti]));
            inv[ti] = (cnt_col[ti] > 0) ? 1.f / lsum : 0.f;
        }
#pragma unroll
        for (int ti = 0; ti < 2; ++ti)
#pragma unroll
            for (int mt = 0; mt < 4; ++mt) Oc[ti][mt] = (f32x4){0.f, 0.f, 0.f, 0.f};
        const int npair = (ntile + 1) >> 1;
#pragma unroll 1
        for (int kp2 = 0; kp2 < npair; ++kp2) {
            const int n0 = kp2 * 32;
            const u16* kp = kcb + (n0 + cidx) * 64 + 8 * q4;
            const bf16x8 ka0 = ld8(kp), ka1 = ld8(kp + 32), kb0 = ld8(kp + 1024), kb1 = ld8(kp + 1024 + 32);
            bf16x8 vf[4];
#pragma unroll
            for (int mt = 0; mt < 4; ++mt) vf[mt] = ld8(VCT + ((size_t)bg * 64 + 16 * mt + cidx) * 512 + n0 + 8 * q4);
#pragma unroll
            for (int ti = 0; ti < 2; ++ti) {
                float pa[4], pb_[4];
                f32x4 st = mfma16(ka0, qf[ti][0], (f32x4){0.f, 0.f, 0.f, 0.f});
                st = mfma16(ka1, qf[ti][1], st);
                f32x4 su = mfma16(kb0, qf[ti][0], (f32x4){0.f, 0.f, 0.f, 0.f});
                su = mfma16(kb1, qf[ti][1], su);
#pragma unroll
                for (int r = 0; r < 4; ++r) {
                    const int n = n0 + 4 * q4 + r;
                    pa[r] = (n < cnt_col[ti]) ? ex2(st[r] - mfin[ti]) * inv[ti] : 0.f;
                    pb_[r] = (n + 16 < cnt_col[ti]) ? ex2(su[r] - mfin[ti]) * inv[ti] : 0.f;
                }
                const float owna = quadsum(pa[0] + pa[1] + pa[2] + pa[3]), tha = quadsum(pa[3]);
                const float ownb = quadsum(pb_[0] + pb_[1] + pb_[2] + pb_[3]), thb = quadsum(pb_[3]);
                if (hr == 0) {
                    const int tk = 4 * ti + tokl;
                    const int sa = (n0 >> 2) + q4, sb2 = ((n0 + 16) >> 2) + q4;
                    impA[tk * 128 + sa] = owna; impB[tk * 132 + sa + 1] = tha;
                    impA[tk * 128 + sb2] = ownb; impB[tk * 132 + sb2 + 1] = thb;
                }
                union { bf16x8 v; unsigned u[4]; } pk;
                pk.u[0] = pack2(pa[0], pa[1]); pk.u[1] = pack2(pa[2], pa[3]); pk.u[2] = pack2(pb_[0], pb_[1]); pk.u[3] = pack2(pb_[2], pb_[3]);
#pragma unroll
                for (int mt = 0; mt < 4; ++mt) Oc[ti][mt] = mfma16(vf[mt], pk.v, Oc[ti][mt]);
            }
        }
#pragma unroll
        for (int ti = 0; ti < 2; ++ti) {
            const float gc = GATE[(size_t)rowc[ti] * 24 + head];
#pragma unroll
            for (int mt = 0; mt < 4; ++mt)
#pragma unroll
                for (int r = 0; r < 4; ++r) Oc[ti][mt][r] *= gc;
        }
    }
    lds_fence();
#pragma unroll 1
    for (int rd = 0; rd < 2; ++rd) {
        const int tk = 4 * rd + q4;
        unsigned m0 = 0u, m1 = 0u, m2 = 0u, m3 = 0u;
        if (cur < 16) { m0 = (2u << cur) - 1u; }
        else {
            unsigned key[8];
#pragma unroll
            for (int i = 0; i < 8; ++i) {
                const int sblk = cidx + 16 * i;
                const bool cand = (sblk >= 1) && (sblk <= cur - 2);
                const float v = impA[tk * 128 + sblk] + impB[tk * 132 + sblk];
                key[i] = cand ? ((__float_as_uint(v) & ~0x7Fu) | (unsigned)(127 - sblk)) : 0u;
            }
            int mysel = (cidx == 0) ? 0 : (cidx == 1 ? cur - 1 : (cidx == 2 ? cur : -1));
#pragma unroll 1
            for (int it = 0; it < 13; ++it) {
                unsigned mx = key[0];
#pragma unroll
                for (int i = 1; i < 8; ++i) mx = max(mx, key[i]);
                mx = max(mx, dppu<0xB1>(mx)); mx = max(mx, dppu<0x4E>(mx)); mx = max(mx, dppu<0x124>(mx)); mx = max(mx, dppu<0x128>(mx));
                const int sblk = 127 - (int)(mx & 127u);
#pragma unroll
                for (int i = 0; i < 8; ++i) key[i] = (key[i] == mx) ? 0u : key[i];
                if (cidx == it + 3) mysel = sblk;
            }
            const unsigned bit = 1u << (mysel & 31); const int wsel = mysel >> 5;
            m0 = row_or(wsel == 0 ? bit : 0u); m1 = row_or(wsel == 1 ? bit : 0u); m2 = row_or(wsel == 2 ? bit : 0u); m3 = row_or(wsel == 3 ? bit : 0u);
        }
        if (cidx < 4) selmask[tk * 4 + cidx] = (cidx == 0) ? m0 : (cidx == 1 ? m1 : (cidx == 2 ? m2 : m3));
    }
    lds_fence();
    f32x4* accl = (f32x4*)wl;
#pragma unroll
    for (int ti = 0; ti < 2; ++ti)
#pragma unroll
        for (int mt = 0; mt < 4; ++mt) accl[(ti * 4 + mt) * 64 + lane] = Oc[ti][mt];
    {
        float m[2] = {-1e30f, -1e30f}, l[2] = {0.f, 0.f}; f32x4 Os[2][4];
#pragma unroll
        for (int ti = 0; ti < 2; ++ti)
#pragma unroll
            for (int mt = 0; mt < 4; ++mt) Os[ti][mt] = (f32x4){0.f, 0.f, 0.f, 0.f};
        {
            unsigned ua[4], ub[4], bu[4];
#pragma unroll
            for (int w = 0; w < 4; ++w) {
                ua[w] = __builtin_amdgcn_readfirstlane(row_or(selmask[tokl * 4 + w]));
                ub[w] = __builtin_amdgcn_readfirstlane(row_or(selmask[(4 + tokl) * 4 + w]));
            }
            if (lane < 4) bm[wave * 4 + lane] = (lane == 0) ? (ua[0] | ub[0]) : (lane == 1 ? (ua[1] | ub[1]) : (lane == 2 ? (ua[2] | ub[2]) : (ua[3] | ub[3])));
            __syncthreads();
#pragma unroll
            for (int w = 0; w < 4; ++w) bu[w] = __builtin_amdgcn_readfirstlane(bm[w] | bm[4 + w] | bm[8 + w] | bm[12 + w]);
            const int lowc[2] = {-1, -1};
            nsa_branch_lds(lds, KSEL + (size_t)bg * 8192 * 64, VSELT + (size_t)bg * 64 * 8192, bu[0], bu[1], bu[2], bu[3], ua[0], ua[1], ua[2], ua[3], ub[0],
                           ub[1], ub[2], ub[3], selmask, tokl, tcol, lowc, qf, m, l, Os, q4, cidx, cur, -1);
        }
#pragma unroll
        for (int ti = 0; ti < 2; ++ti) {
            const float sc = GATE[(size_t)rowc[ti] * 24 + 8 + head] / colsum(l[ti]);
#pragma unroll
            for (int mt = 0; mt < 4; ++mt)
#pragma unroll
                for (int r = 0; r < 4; ++r) Os[ti][mt][r] *= sc;
        }
        lds_fence();
#pragma unroll
        for (int ti = 0; ti < 2; ++ti)
#pragma unroll
            for (int mt = 0; mt < 4; ++mt) { f32x4 a = accl[(ti * 4 + mt) * 64 + lane]; a += Os[ti][mt]; accl[(ti * 4 + mt) * 64 + lane] = a; }
    }
    {
        float m[2] = {-1e30f, -1e30f}, l[2] = {0.f, 0.f}; f32x4 Ow[2][4];
#pragma unroll
        for (int ti = 0; ti < 2; ++ti)
#pragma unroll
            for (int mt = 0; mt < 4; ++mt) Ow[ti][mt] = (f32x4){0.f, 0.f, 0.f, 0.f};
        int wb0 = (t0 - 511) >> 6; if (wb0 < 0) wb0 = 0;
        int wbb = (t0b - 511) >> 6; if (wbb < 0) wbb = 0;
        {
            unsigned uw[4], bu[4];
#pragma unroll
            for (int w = 0; w < 4; ++w) {
                const int hi = cur - 32 * w;
                unsigned mk = 0u, mkb = 0u;
                if (hi >= 0) {
                    const unsigned upper = (hi >= 31) ? 0xffffffffu : ((2u << hi) - 1u);
                    const int lo = wb0 - 32 * w, lob = wbb - 32 * w;
                    if (lo <= 31) mk = upper & ~((lo <= 0) ? 0u : ((1u << lo) - 1u));
                    if (lob <= 31) mkb = upper & ~((lob <= 0) ? 0u : ((1u << lob) - 1u));
                }
                uw[w] = mk; bu[w] = mkb;
            }
            const int lowc[2] = {tcol[0] - 512, tcol[1] - 512};
            nsa_branch_lds(lds, KWIN + (size_t)bg * 8192 * 64, VWINT + (size_t)bg * 64 * 8192, bu[0], bu[1], bu[2], bu[3], uw[0], uw[1], uw[2], uw[3], uw[0],
                           uw[1], uw[2], uw[3], nullptr, tokl, tcol, lowc, qf, m, l, Ow, q4, cidx, cur, t0 + 7 - 512);
        }
#pragma unroll
        for (int ti = 0; ti < 2; ++ti) {
            const float sc = GATE[(size_t)rowc[ti] * 24 + 16 + head] / colsum(l[ti]);
#pragma unroll
            for (int mt = 0; mt < 4; ++mt)
#pragma unroll
                for (int r = 0; r < 4; ++r) Ow[ti][mt][r] *= sc;
        }
        lds_fence();
#pragma unroll
        for (int ti = 0; ti < 2; ++ti)
#pragma unroll
            for (int mt = 0; mt < 4; ++mt) {
                const f32x4 a = accl[(ti * 4 + mt) * 64 + lane];
                const f32x4 o = Ow[ti][mt];
                u32x2 wv; wv[0] = pack2(a[0] + o[0], a[1] + o[1]); wv[1] = pack2(a[2] + o[2], a[3] + o[3]);
                *(u32x2*)(mix + (size_t)rowc[ti] * 1024 + 512 + head * 64 + 16 * mt + 4 * q4) = wv;
            }
    }


    __syncthreads();
}

DEV unsigned sortable(float f) { const unsigned b = __float_as_uint(f); return (b & 0x80000000u) ? ~b : (b | 0x80000000u); }
DEV float unsortable(unsigned u) { return __uint_as_float((u & 0x80000000u) ? (u ^ 0x80000000u) : ~u); }
template <int N> DEV unsigned kth16_threshold(const unsigned (&u)[N]) {
    unsigned T = 0;
    for (int bit = 31; bit >= 0; --bit) {
        const unsigned cand = T | (1u << bit);
        int cnt = 0;
#pragma unroll
        for (int i = 0; i < N; ++i) cnt += (u[i] >= cand) ? 1 : 0;
        cnt = colsumi(cnt);
        if (cnt >= 16) T = cand;
    }
    return T;
}
template <int N, class F> DEV void compact16(const unsigned (&u)[N], unsigned T, int q4, int cidx, F emit) {
    int cgt = 0, ceq = 0;
#pragma unroll
    for (int i = 0; i < N; ++i) { cgt += (u[i] > T) ? 1 : 0; ceq += (u[i] == T) ? 1 : 0; }
    const int g0 = __shfl(cgt, cidx), g1 = __shfl(cgt, cidx + 16), g2 = __shfl(cgt, cidx + 32), g3 = __shfl(cgt, cidx + 48);
    const int e0 = __shfl(ceq, cidx), e1 = __shfl(ceq, cidx + 16), e2 = __shfl(ceq, cidx + 32);
    int pg = (q4 > 0 ? g0 : 0) + (q4 > 1 ? g1 : 0) + (q4 > 2 ? g2 : 0);
    int pe = g0 + g1 + g2 + g3 + (q4 > 0 ? e0 : 0) + (q4 > 1 ? e1 : 0) + (q4 > 2 ? e2 : 0);
#pragma unroll
    for (int i = 0; i < N; ++i) {
        if (u[i] > T) { emit(i, pg); ++pg; }
        else if (u[i] == T) { if (pe < 16) emit(i, pe); ++pe; }
    }
}

DEV void peer_topk_task(const Params& p, int l, int task, float* wl) {
    unsigned char* ws = p.ws;
    const u16* QP = (const u16*)(ws + OFF_QP);
    const u16* K12 = (const u16*)(ws + OFF_K12) + (size_t)l * 2 * 16384;
    int* PIDX = (int*)(ws + OFF_PIDX); float* PGW = (float*)(ws + OFF_PGW);
    const int lane = TID() & 63, q4 = lane >> 4, cidx = lane & 15;
    const int tq = task * 2 + (cidx >> 3), hh = cidx & 7;
    float* vv[2] = {wl, wl + 512}; int* ii[2] = {(int*)(wl + 256), (int*)(wl + 768)};
    float* fs = wl + 1024; int* fi = (int*)(wl + 1280);
#pragma unroll
    for (int hf = 0; hf < 2; ++hf) {
        bf16x8 qf[4];
#pragma unroll
        for (int s = 0; s < 4; ++s) qf[s] = ld8(QP + (size_t)tq * 2048 + hh * 256 + hf * 128 + 32 * s + 8 * q4);
        unsigned u[32];
        const u16* kb = K12 + hf * 16384;
#pragma unroll
        for (int kt = 0; kt < 8; ++kt) {
            f32x4 st = (f32x4){0.f, 0.f, 0.f, 0.f};
#pragma unroll
            for (int s = 0; s < 4; ++s) st = mfma16(ld8(kb + (kt * 16 + cidx) * 128 + 32 * s + 8 * q4), qf[s], st);
#pragma unroll
            for (int r = 0; r < 4; ++r) u[kt * 4 + r] = sortable(st[r]);
        }
        const unsigned T = kth16_threshold<32>(u);
        float* vo = vv[hf]; int* io = ii[hf];
        compact16<32>(u, T, q4, cidx, [&](int i, int pos) { vo[cidx * 16 + pos] = unsortable(u[i]); io[cidx * 16 + pos] = 16 * (i >> 2) + 4 * q4 + (i & 3); });
    }
    lds_fence();
    {
        unsigned u[64];
        float v2r[16];
#pragma unroll
        for (int j = 0; j < 16; ++j) v2r[j] = vv[1][cidx * 16 + j];
#pragma unroll
        for (int a = 0; a < 4; ++a) {
            const float v1a = vv[0][cidx * 16 + 4 * q4 + a];
#pragma unroll
            for (int j = 0; j < 16; ++j) u[a * 16 + j] = sortable(v1a + v2r[j]);
        }
        const unsigned T = kth16_threshold<64>(u);
        compact16<64>(u, T, q4, cidx, [&](int i, int pos) { fs[cidx * 16 + pos] = unsortable(u[i]); fi[cidx * 16 + pos] = (4 * q4 + (i >> 4)) * 16 + (i & 15); });
    }
    lds_fence();
    {
        float s4[4]; int c4[4];
#pragma unroll
        for (int k = 0; k < 4; ++k) { s4[k] = fs[cidx * 16 + 4 * q4 + k]; c4[k] = fi[cidx * 16 + 4 * q4 + k]; }
        float mx = fmaxf(fmaxf(s4[0], s4[1]), fmaxf(s4[2], s4[3]));
        mx = colmax(mx);
        float e4[4]; float sm = 0.f;
#pragma unroll
        for (int k = 0; k < 4; ++k) { e4[k] = __expf(s4[k] - mx); sm += e4[k]; }
        sm = colsum(sm);
        const float inv = 1.f / sm;
        int4 eo; float4 go;
        eo.x = ii[0][cidx * 16 + (c4[0] >> 4)] * 128 + ii[1][cidx * 16 + (c4[0] & 15)];
        eo.y = ii[0][cidx * 16 + (c4[1] >> 4)] * 128 + ii[1][cidx * 16 + (c4[1] & 15)];
        eo.z = ii[0][cidx * 16 + (c4[2] >> 4)] * 128 + ii[1][cidx * 16 + (c4[2] & 15)];
        eo.w = ii[0][cidx * 16 + (c4[3] >> 4)] * 128 + ii[1][cidx * 16 + (c4[3] & 15)];
        go.x = e4[0] * inv; go.y = e4[1] * inv; go.z = e4[2] * inv; go.w = e4[3] * inv;
        const size_t o = ((size_t)tq * 8 + hh) * 16 + 4 * q4;
        *(int4*)(PIDX + o) = eo; *(float4*)(PGW + o) = go;
    }
    lds_fence();
}


template <int N> DEV void ltmask(const float (&v)[N], float x, unsigned (&mk)[N / 32]) {
#pragma unroll
    for (int w = 0; w < N / 32; ++w) {
        unsigned a0 = 0u, a1 = 0u, a2 = 0u, a3 = 0u;
#pragma unroll
        for (int i = 0; i < 8; ++i) {
            a0 = __builtin_amdgcn_alignbit(a0, __float_as_uint(v[w * 32 + i] - x), 31);
            a1 = __builtin_amdgcn_alignbit(a1, __float_as_uint(v[w * 32 + 8 + i] - x), 31);
            a2 = __builtin_amdgcn_alignbit(a2, __float_as_uint(v[w * 32 + 16 + i] - x), 31);
            a3 = __builtin_amdgcn_alignbit(a3, __float_as_uint(v[w * 32 + 24 + i] - x), 31);
        }
        mk[w] = (a0 << 24) | (a1 << 16) | (a2 << 8) | a3;
    }
}
template <int N> DEV int count_ge(const float (&v)[N], float x) {
    unsigned mk[N / 32]; ltmask<N>(v, x, mk);
    int lt = 0;
#pragma unroll
    for (int w = 0; w < N / 32; ++w) lt += __popc(mk[w]);
    return colsumi(N - lt);
}
template <int N> DEV void select16(const float (&v)[N], float& lo_o, float& hi_o) {
    float mx = v[0], mn = v[0], sm = v[0];
#pragma unroll
    for (int i = 1; i < N; ++i) { mx = fmaxf(mx, v[i]); mn = fminf(mn, v[i]); sm += v[i]; }
    mx = colmax(mx); mn = -colmax(-mn); sm = colsum(sm);
    float hi = mx + fabsf(mx) * 1e-6f + 1e-30f;
    float lo = sm * (1.f / (4.f * N));
    if (count_ge<N>(v, lo) < 16) lo = mn;
    bool done = false;
#pragma unroll 1
    for (int it = 0; it < 200; ++it) {
        if (__all(done)) break;
        const float mid = 0.5f * (lo + hi);
        const bool stuck = !(mid > lo && mid < hi);
        const int c = count_ge<N>(v, mid);
        if (!done) {
            if (stuck) done = true;
            else if (c == 16) { lo = mid; hi = mid; done = true; }
            else if (c > 16) lo = mid;
            else hi = mid;
        }
    }
    lo_o = lo; hi_o = hi;
}
DEV void col_offsets(int cntA, int cntT, int q4, int cidx, int& offA, int& offT) {
    const int g0 = __shfl(cntA, cidx), g1 = __shfl(cntA, cidx + 16), g2 = __shfl(cntA, cidx + 32), g3 = __shfl(cntA, cidx + 48);
    const int e0 = __shfl(cntT, cidx), e1 = __shfl(cntT, cidx + 16), e2 = __shfl(cntT, cidx + 32);
    offA = (q4 > 0 ? g0 : 0) + (q4 > 1 ? g1 : 0) + (q4 > 2 ? g2 : 0);
    offT = g0 + g1 + g2 + g3 + (q4 > 0 ? e0 : 0) + (q4 > 1 ? e1 : 0) + (q4 > 2 ? e2 : 0);
}

DEV void peer_topk_task2(const Params& p, int l, int task, float* wl) {
    unsigned char* ws = p.ws;
    const u16* QP = (const u16*)(ws + OFF_QP);
    const u16* K12 = (const u16*)(ws + OFF_K12) + (size_t)l * 2 * 16384;
    int* PIDX = (int*)(ws + OFF_PIDX); float* PGW = (float*)(ws + OFF_PGW);
    const int lane = TID() & 63, q4 = lane >> 4, cidx = lane & 15;
    const int tq = task * 2 + (cidx >> 3), hh = cidx & 7;
    float* scl = wl;
    float* lst = wl + 2048;
    float* vv[2] = {lst, lst + 512}; int* ii[2] = {(int*)(lst + 256), (int*)(lst + 768)};
    float* fs = lst + 1024; int* fi = (int*)(lst + 1280);
#pragma unroll 1
    for (int hf = 0; hf < 2; ++hf) {
        bf16x8 qf[4];
#pragma unroll
        for (int s2 = 0; s2 < 4; ++s2) qf[s2] = ld8(QP + (size_t)tq * 2048 + hh * 256 + hf * 128 + 32 * s2 + 8 * q4);
        float sc[32];
        const u16* kb = K12 + hf * 16384;
#pragma unroll
        for (int kt = 0; kt < 8; ++kt) {
            f32x4 st = (f32x4){0.f, 0.f, 0.f, 0.f};
#pragma unroll
            for (int s2 = 0; s2 < 4; ++s2) st = mfma16(ld8(kb + (kt * 16 + cidx) * 128 + 32 * s2 + 8 * q4), qf[s2], st);
#pragma unroll
            for (int r = 0; r < 4; ++r) sc[kt * 4 + r] = st[r];
            *(f32x4*)(scl + cidx * 128 + 16 * kt + 4 * q4) = st;
        }
        float lo, hi; select16<32>(sc, lo, hi);
        unsigned mh[1], ml_[1];
        ltmask<32>(sc, hi, mh); ltmask<32>(sc, lo, ml_);
        unsigned mA = ~mh[0], mT = ~ml_[0] & mh[0];
        int offA, offT; col_offsets(__popc(mA), __popc(mT), q4, cidx, offA, offT);
        float* vo = hf ? vv[1] : vv[0]; int* io = hf ? ii[1] : ii[0];
        lds_fence();
        while (__any(mA != 0u)) {
            if (mA) {
                const int i = __clz(mA); mA &= ~(0x80000000u >> i);
                const int n = 16 * (i >> 2) + 4 * q4 + (i & 3);
                vo[cidx * 16 + offA] = scl[cidx * 128 + n]; io[cidx * 16 + offA] = n; ++offA;
            }
        }
        while (__any(mT != 0u)) {
            if (mT) {
                const int i = __clz(mT); mT &= ~(0x80000000u >> i);
                const int n = 16 * (i >> 2) + 4 * q4 + (i & 3);
                if (offT < 16) { vo[cidx * 16 + offT] = scl[cidx * 128 + n]; io[cidx * 16 + offT] = n; }
                ++offT;
            }
        }
        lds_fence();
    }
    {
        float cand[64];
        float v2r[16];
#pragma unroll
        for (int j = 0; j < 16; ++j) v2r[j] = vv[1][cidx * 16 + j];
#pragma unroll
        for (int a = 0; a < 4; ++a) {
            const float v1a = vv[0][cidx * 16 + 4 * q4 + a];
#pragma unroll
            for (int j = 0; j < 16; ++j) cand[a * 16 + j] = v1a + v2r[j];
        }
        float lo, hi; select16<64>(cand, lo, hi);
        unsigned mh[2], ml_[2];
        ltmask<64>(cand, hi, mh); ltmask<64>(cand, lo, ml_);
        unsigned mA0 = ~mh[0], mA1 = ~mh[1], mT0 = ~ml_[0] & mh[0], mT1 = ~ml_[1] & mh[1];
        int offA, offT; col_offsets(__popc(mA0) + __popc(mA1), __popc(mT0) + __popc(mT1), q4, cidx, offA, offT);
#pragma unroll
        for (int w = 0; w < 2; ++w) {
            unsigned mA = w ? mA1 : mA0;
            while (__any(mA != 0u)) {
                if (mA) {
                    const int i = __clz(mA); mA &= ~(0x80000000u >> i);
                    const int it = w * 32 + i; const int ci = (4 * q4 + (it >> 4)) * 16 + (it & 15);
                    fs[cidx * 16 + offA] = vv[0][cidx * 16 + (ci >> 4)] + vv[1][cidx * 16 + (ci & 15)]; fi[cidx * 16 + offA] = ci; ++offA;
                }
            }
        }
#pragma unroll
        for (int w = 0; w < 2; ++w) {
            unsigned mT = w ? mT1 : mT0;
            while (__any(mT != 0u)) {
                if (mT) {
                    const int i = __clz(mT); mT &= ~(0x80000000u >> i);
                    const int it = w * 32 + i; const int ci = (4 * q4 + (it >> 4)) * 16 + (it & 15);
                    if (offT < 16) { fs[cidx * 16 + offT] = vv[0][cidx * 16 + (ci >> 4)] + vv[1][cidx * 16 + (ci & 15)]; fi[cidx * 16 + offT] = ci; }
                    ++offT;
                }
            }
        }
    }
    lds_fence();
    {
        float s4[4]; int c4[4];
#pragma unroll
        for (int k = 0; k < 4; ++k) { s4[k] = fs[cidx * 16 + 4 * q4 + k]; c4[k] = fi[cidx * 16 + 4 * q4 + k]; }
        float mx = fmaxf(fmaxf(s4[0], s4[1]), fmaxf(s4[2], s4[3]));
        mx = colmax(mx);
        float e4[4]; float sm = 0.f;
#pragma unroll
        for (int k = 0; k < 4; ++k) { e4[k] = __expf(s4[k] - mx); sm += e4[k]; }
        sm = colsum(sm);
        const float inv = 1.f / sm;
        int4 eo; float4 go;
        eo.x = ii[0][cidx * 16 + (c4[0] >> 4)] * 128 + ii[1][cidx * 16 + (c4[0] & 15)];
        eo.y = ii[0][cidx * 16 + (c4[1] >> 4)] * 128 + ii[1][cidx * 16 + (c4[1] & 15)];
        eo.z = ii[0][cidx * 16 + (c4[2] >> 4)] * 128 + ii[1][cidx * 16 + (c4[2] & 15)];
        eo.w = ii[0][cidx * 16 + (c4[3] >> 4)] * 128 + ii[1][cidx * 16 + (c4[3] & 15)];
        go.x = e4[0] * inv; go.y = e4[1] * inv; go.z = e4[2] * inv; go.w = e4[3] * inv;
        const size_t o = ((size_t)tq * 8 + hh) * 16 + 4 * q4;
        *(int4*)(PIDX + o) = eo; *(float4*)(PGW + o) = go;
    }
    lds_fence();
}

DEV float gelu_exact(float x) { return 0.5f * x * (1.f + erff(x * 0.70710678118654752f)); }
DEV void unpack8(const bf16x8 v, float* f) {
    union { bf16x8 v; unsigned u[4]; } c; c.v = v;
#pragma unroll
    for (int i = 0; i < 4; ++i) { f[2 * i] = bflo(c.u[i]); f[2 * i + 1] = bfhi(c.u[i]); }
}
DEV void phase_peer_experts(const Params& p, int l) {
    unsigned char* ws = p.ws;
    const u16* H = (const u16*)(ws + OFF_H);
    u16* Hw = (u16*)(ws + OFF_H);
    const unsigned char* U8 = ws + OFF_U8;
    const unsigned char* V8 = ws + OFF_U8 + 16 * MiB;
    const float* SU = (const float*)(ws + OFF_UVS);
    const float* SV = (const float*)(ws + OFF_UVS) + 16384;
    const int* PIDX = (const int*)(ws + OFF_PIDX); const float* PGW = (const float*)(ws + OFF_PGW);
    const float* mod = (const float*)(ws + OFF_MOD);
    const float* g2 = mod + l * 4 * 6144 + 5 * 1024;
    const int lane = TID() & 63;
    const int gw = BID() * 4 + (TID() >> 6), nw = gridDim.x * 4;
    for (int tok = gw; tok < NTOK; tok += nw) {
        const int b = tok >> 13;
        float acc[16];
#pragma unroll
        for (int i = 0; i < 16; ++i) acc[i] = 0.f;
#if EN_PEER
        float hx[16];
        unpack8(ld8(H + (size_t)tok * 1024 + 16 * lane), hx);
        unpack8(ld8(H + (size_t)tok * 1024 + 16 * lane + 8), hx + 8);
        float hs = 0.f;
#pragma unroll
        for (int i = 0; i < 16; ++i) hs += hx[i];
        const float hs128 = 128.f * hs;
        float corr = 0.f;
#pragma unroll 1
        for (int hh = 0; hh < 8; ++hh) {
            const int el = PIDX[((size_t)tok * 8 + hh) * 16 + (lane & 15)];
            const float wgt = PGW[((size_t)tok * 8 + hh) * 16 + (lane & 15)];
#pragma unroll 1
            for (int k0 = 0; k0 < 16; k0 += 8) {
                u32x4 uq[8], vq[8]; float wk[8], su[8];
#pragma unroll
                for (int k = 0; k < 8; ++k) {
                    const int e = __builtin_amdgcn_readlane(el, k0 + k);
                    wk[k] = __int_as_float(__builtin_amdgcn_readlane(__float_as_int(wgt), k0 + k)) * SV[e];
                    su[k] = SU[e];
                    uq[k] = *(const u32x4*)(U8 + (size_t)e * 1024 + 16 * lane);
                    vq[k] = *(const u32x4*)(V8 + (size_t)e * 1024 + 16 * lane);
                }
#pragma unroll
                for (int k = 0; k < 8; ++k) {
                    float d = -hs128;
#pragma unroll
                    for (int i = 0; i < 4; ++i) {
                        const unsigned w = uq[k][i];
                        d += (float)(w & 0xffu) * hx[4 * i] + (float)((w >> 8) & 0xffu) * hx[4 * i + 1] + (float)((w >> 16) & 0xffu) * hx[4 * i + 2] + (float)(w >> 24) * hx[4 * i + 3];
                    }
                    d = wave_sum(d) * su[k];
                    const float act = gelu_exact(d) * wk[k];
                    corr += act * 128.f;
#pragma unroll
                    for (int i = 0; i < 4; ++i) {
                        const unsigned w = vq[k][i];
                        acc[4 * i] += act * (float)(w & 0xffu); acc[4 * i + 1] += act * (float)((w >> 8) & 0xffu);
                        acc[4 * i + 2] += act * (float)((w >> 16) & 0xffu); acc[4 * i + 3] += act * (float)(w >> 24);
                    }
                }
            }
        }
#pragma unroll
        for (int i = 0; i < 16; ++i) acc[i] -= corr;
#endif
        const int k = 16 * lane;
        float xn[16]; float ss = 0.f;
#pragma unroll
        for (int i = 0; i < 4; ++i) {
            const float4 x0 = *(const float4*)(p.out + (size_t)tok * 1024 + k + 4 * i);
            const float4 ga = *(const float4*)(g2 + b * 6144 + k + 4 * i);
            xn[4 * i] = x0.x + ga.x * acc[4 * i]; xn[4 * i + 1] = x0.y + ga.y * acc[4 * i + 1];
            xn[4 * i + 2] = x0.z + ga.z * acc[4 * i + 2]; xn[4 * i + 3] = x0.w + ga.w * acc[4 * i + 3];
        }
#pragma unroll
        for (int i = 0; i < 16; ++i) ss += xn[i] * xn[i];
        ss = wave_sum(ss);
        const float rs = rsqrtf(ss * (1.f / 1024.f) + 1e-6f);
        if (l == 0) {
            const float* n1g = p.in[I_N1G] + 1024; const float* sh = mod + 4 * 6144 + b * 6144; const float* sc = sh + 1024;
            float hv[16];
#pragma unroll
            for (int i = 0; i < 4; ++i) {
                *(float4*)(p.out + (size_t)tok * 1024 + k + 4 * i) = (float4){xn[4 * i], xn[4 * i + 1], xn[4 * i + 2], xn[4 * i + 3]};
                const float4 gg = *(const float4*)(n1g + k + 4 * i), s1 = *(const float4*)(sc + k + 4 * i), s0 = *(const float4*)(sh + k + 4 * i);
                hv[4 * i] = xn[4 * i] * rs * gg.x * (1.f + s1.x) + s0.x; hv[4 * i + 1] = xn[4 * i + 1] * rs * gg.y * (1.f + s1.y) + s0.y;
                hv[4 * i + 2] = xn[4 * i + 2] * rs * gg.z * (1.f + s1.z) + s0.z; hv[4 * i + 3] = xn[4 * i + 3] * rs * gg.w * (1.f + s1.w) + s0.w;
            }
            u32x4 w0, w1;
#pragma unroll
            for (int i = 0; i < 4; ++i) { w0[i] = pack2(hv[2 * i], hv[2 * i + 1]); w1[i] = pack2(hv[8 + 2 * i], hv[8 + 2 * i + 1]); }
            *(u32x4*)(Hw + (size_t)tok * 1024 + k) = w0; *(u32x4*)(Hw + (size_t)tok * 1024 + k + 8) = w1;
        } else {
            const float* fg = p.in[I_FG];
#pragma unroll
            for (int i = 0; i < 4; ++i) {
                const float4 gg = *(const float4*)(fg + k + 4 * i);
                *(float4*)(p.out + (size_t)tok * 1024 + k + 4 * i) = (float4){xn[4 * i] * rs * gg.x, xn[4 * i + 1] * rs * gg.y, xn[4 * i + 2] * rs * gg.z, xn[4 * i + 3] * rs * gg.w};
            }
        }
    }
}

constexpr int NPH = 20;

__global__ void __launch_bounds__(256, 2) mega(Params p) {
    __shared__ __attribute__((aligned(16))) unsigned char lds[81920 - 128];
    __shared__ int misc[8];
    int* qslot = misc;
    cg::grid_group grid = cg::this_grid();
    if (threadIdx.x < 8) misc[threadIdx.x] = 0;
    __syncthreads();
    XcdBarrier xbar = xcd_barrier_post((unsigned*)(p.ws + OFF_BAR), (volatile unsigned*)(misc + 4));
    unsigned char* ws = p.ws;
    const float* mod = (const float*)(ws + OFF_MOD);
    unsigned* ctl = (unsigned*)(ws + OFF_CTL);
    const int G = gridDim.x, bx = BID();
    for (int ph = p.ph_lo; ph < p.ph_hi; ++ph) {
        if (ph == 0) {
            phase_prep(p, lds);
        } else if (ph == 1) {
            phase_norm(p.in[I_X], p.in[I_N1G], mod + 0 * 1024, mod + 1 * 1024, (u16*)(ws + OFF_H));
        } else {
            const int l = (ph - 2) / 9, sp = (ph - 2) % 9;
            const float* modl = mod + l * 4 * 6144;
            if (sp == 0) {
                EpiInProj e{(u16*)(ws + OFF_PCONV), (u16*)(ws + OFF_PRWKV), (u16*)(ws + OFF_Q), (u16*)(ws + OFF_KV), (float*)(ws + OFF_GATE)};
                gemm_phase((const u16*)(ws + OFF_H), 1024, (const u16*)(ws + OFF_WIN) + (size_t)l * NINP * 1024, 1024, 256, 8, 1024, e, lds, bx, G, 0, 4);
            } else if (sp == 1) {
#if EN_RWKV
                for (;;) { const int t = block_next(ctl + QW(l, Q_RWP), qslot); if (t >= NTOK / 16) break; rwkv_prep_tile2(p, l, t, lds); }
#endif
            } else if (sp == 2) {
#if EN_RWKV
                if (bx < 64) { __builtin_amdgcn_s_setprio(3); rwkv_scan(p, bx, lds); __builtin_amdgcn_s_setprio(0); }
#endif
                unsigned* cdone = ctl + QW(l, 5);
                unsigned* gdone = ctl + QW(l, 6);
                if (bx >= 64) {
                    EpiInProj e{(u16*)(ws + OFF_PCONV), (u16*)(ws + OFF_PRWKV), (u16*)(ws + OFF_Q), (u16*)(ws + OFF_KV), (float*)(ws + OFF_GATE)};
                    gemm_phase((const u16*)(ws + OFF_H), 1024, (const u16*)(ws + OFF_WIN) + (size_t)l * NINP * 1024, 1024, 256, 15, 1024, e, lds, bx - 64, G - 64, 4, 8, false);
                    asm volatile("s_waitcnt vmcnt(0)" ::: "memory");
                    __syncthreads();
                    if (threadIdx.x == 0) {
                        __builtin_amdgcn_fence(__ATOMIC_RELEASE, "agent");
                        asm volatile("s_waitcnt vmcnt(0)" ::: "memory");
                        __hip_atomic_fetch_add(gdone, 1u, __ATOMIC_RELAXED, __HIP_MEMORY_SCOPE_AGENT);
                    }
                }
                __syncthreads();
                if (threadIdx.x == 0) {
                    unsigned sp_ = 0;
                    while (__hip_atomic_load(gdone, __ATOMIC_RELAXED, __HIP_MEMORY_SCOPE_AGENT) < (unsigned)(G - 64)) { __builtin_amdgcn_s_sleep(8); if (++sp_ > (1u << 24)) break; }
                    __builtin_amdgcn_fence(__ATOMIC_ACQUIRE, "agent");
                    asm volatile("s_waitcnt vmcnt(0)" ::: "memory");
                }
                __syncthreads();
                if (bx >= 64 && bx < 128) {
                    const u16* KVb = (const u16*)(ws + OFF_KV);
                    if (bx < 96) {
                        EpiCompress ek{(const float*)(ws + OFF_CBP) + (l * 2 + 0) * 2048, p.in[I_CKW2] + (size_t)l * 8192, (u16*)(ws + OFF_KC), 0, lds};
                        gemm_phase(KVb, 1024, (const u16*)(ws + OFF_CW1) + (size_t)(l * 2 + 0) * 128 * 2048, 2048, 32, 1, 2048, ek, lds, bx - 64, 1 << 20);
                    } else {
                        EpiCompress ev{(const float*)(ws + OFF_CBP) + (l * 2 + 1) * 2048, p.in[I_CVW2] + (size_t)l * 8192, (u16*)(ws + OFF_VCT), 1, lds};
                        gemm_phase(KVb + 4194304, 1024, (const u16*)(ws + OFF_CW1) + (size_t)(l * 2 + 1) * 128 * 2048, 2048, 32, 1, 2048, ev, lds, bx - 96, 1 << 20);
                    }
                    asm volatile("s_waitcnt vmcnt(0)" ::: "memory");
                    __syncthreads();
                    if (threadIdx.x == 0) {
                        __builtin_amdgcn_fence(__ATOMIC_RELEASE, "agent");
                        asm volatile("s_waitcnt vmcnt(0)" ::: "memory");
                        __hip_atomic_fetch_add(cdone, 1u, __ATOMIC_RELAXED, __HIP_MEMORY_SCOPE_AGENT);
                    }
                }
#if EN_CONV
                for (;;) { const int t = block_next(ctl + QW(l, Q_CONV), qslot); if (t >= NTOK / 32) break; conv_tile(p, l, t, lds); }
#else
                zero_mix_cols(p, 0, 256);
#endif
                __syncthreads();
                if (threadIdx.x == 0) {
                    unsigned sp_ = 0;
                    while (__hip_atomic_load(cdone, __ATOMIC_RELAXED, __HIP_MEMORY_SCOPE_AGENT) < 64u) { __builtin_amdgcn_s_sleep(8); if (++sp_ > (1u << 24)) break; }
                    __builtin_amdgcn_fence(__ATOMIC_ACQUIRE, "agent");
                    asm volatile("s_waitcnt vmcnt(0)" ::: "memory");
                }
                __syncthreads();
                for (;;) { const int t = block_next(ctl + QW(l, Q_NSA), qslot); if (t >= 2048) break; nsa_block_task(p, t, lds); }
                for (;;) {
                    const int t = block_next(ctl + QW(l, 7), qslot); if (t >= 1024) break;
                    const int tb = t >> 9, r0 = (t & 511) * 32;
                    convert_rows_task(p.in[tb ? I_PV : I_PU] + (size_t)l * 16384 * 1024, ws + OFF_U8 + (size_t)tb * 16 * MiB, (float*)(ws + OFF_UVS) + tb * 16384, r0);
                }
            } else if (sp == 3) {
#if EN_RWKV
                phase_rwkv_post(p, l);
#else
                zero_mix_cols(p, 256, 256);
#endif
            } else if (sp == 4) {
                EpiOutProj e{l == 0 ? p.in[I_X] : p.out, p.out, modl + 2 * 1024};
                gemm_phase((const u16*)(ws + OFF_MIX), 1024, (const u16*)(ws + OFF_WOUT) + (size_t)l * 1024 * 1024, 1024, 256, 8, 1024, e, lds, bx, G);
            } else if (sp == 5) {
#if EN_PEER
                phase_norm(p.out, p.in[I_N2G] + l * 1024, modl + 3 * 1024, modl + 4 * 1024, (u16*)(ws + OFF_H));
#endif
            } else if (sp == 6) {
#if EN_PEER
                EpiStoreBf16 e{(u16*)(ws + OFF_QP), 2048};
                gemm_phase((const u16*)(ws + OFF_H), 1024, (const u16*)(ws + OFF_WQ) + (size_t)l * 2048 * 1024, 1024, 256, 16, 1024, e, lds, bx, G);
#endif
            } else if (sp == 7) {
#if EN_PEER
                float* wl = (float*)lds + (TID() >> 6) * 3584;
                for (;;) { const int t = wave_next(ctl + QW(l, Q_PTK)); if (t >= NTOK / 2) break; peer_topk_task2(p, l, t, wl); }
#endif
            } else {
                phase_peer_experts(p, l);
            }
        }
        if (ph + 1 < p.ph_hi) { if (ph == 0) grid.sync(); else xcd_barrier(xbar); }
    }
}

extern "C" void kernel_launch(void* const* d_in, const int* in_sizes, int n_in, void* d_out, int out_size, void* d_ws, size_t ws_size,
                              hipStream_t stream) {
    static int grid_blocks = 0;
    if (!grid_blocks) {
        int dev = 0, cus = 0, per_cu = 0;
        hipGetDevice(&dev);
        hipDeviceGetAttribute(&cus, hipDeviceAttributeMultiprocessorCount, dev);
        hipOccupancyMaxActiveBlocksPerMultiprocessor(&per_cu, (const void*)mega, 256, 0);
        if (per_cu > 2) per_cu = 2;
        if (per_cu < 1) per_cu = 1;
        grid_blocks = cus * per_cu;
        if (ws_size < WS_NEED) fprintf(stderr, "kernel_launch: workspace too small: %zu < %zu\n", ws_size, (size_t)WS_NEED);
    }
    hipMemsetAsync((char*)d_ws + OFF_CTL, 0, CTL_ZERO_BYTES, stream);
    Params p{};
    for (int i = 0; i < 35; ++i) p.in[i] = (const float*)d_in[i];
    p.out = (float*)d_out;
    p.ws = (unsigned char*)d_ws;
#if MULTI_LAUNCH
    for (int ph = 0; ph < NPH; ++ph) {
        p.ph_lo = ph; p.ph_hi = ph + 1;
        hipLaunchKernelGGL(mega, dim3(grid_blocks), dim3(256), 0, stream, p);
    }
#else
    p.ph_lo = 0; p.ph_hi = NPH;
    void* args[] = {&p};
    hipError_t e = hipLaunchCooperativeKernel((const void*)mega, dim3(grid_blocks), dim3(256), args, 0, stream);
    if (e != hipSuccess) fprintf(stderr, "cooperative launch failed: %s (grid %d)\n", hipGetErrorString(e), grid_blocks);
#endif
}
```

```cpp
#include <hip/hip_runtime.h>
#include <hip/hip_cooperative_groups.h>
#include <stdint.h>
#include <stdio.h>
namespace cg = cooperative_groups;

#ifndef EN_CONV
#define EN_CONV 1
#endif
#ifndef EN_RWKV
#define EN_RWKV 1
#endif
#ifndef EN_NSA_CMP
#define EN_NSA_CMP 1
#endif
#ifndef EN_NSA_WIN
#define EN_NSA_WIN 1
#endif
#ifndef EN_NSA_SEL
#define EN_NSA_SEL 1
#endif
#ifndef EN_PEER
#define EN_PEER 1
#endif
#ifndef MULTI_LAUNCH
#define MULTI_LAUNCH 0
#endif

#define DEV __device__ __forceinline__
typedef unsigned short u16;
typedef __attribute__((ext_vector_type(8))) short bf16x8;
typedef __attribute__((ext_vector_type(4))) float f32x4;
typedef __attribute__((ext_vector_type(4))) unsigned int u32x4;
typedef __attribute__((ext_vector_type(2))) unsigned int u32x2;

constexpr int NB = 4, NT = 8192, ND = 1024, NTOK = NB * NT, NL = 2;
constexpr int NIN = 2840, NINP = 2944;
constexpr size_t MiB = 1ull << 20;

constexpr size_t OFF_CTL = 0;
constexpr size_t CTL_ZERO_BYTES = 32768;
constexpr size_t OFF_BAR = 16384;
constexpr size_t OFF_MOD = 64 * 1024;
constexpr size_t OFF_CBP = 256 * 1024;
constexpr size_t OFF_WIN = 1 * MiB;
constexpr size_t OFF_WOUT = 13 * MiB;
constexpr size_t OFF_WQ = 17 * MiB;
constexpr size_t OFF_CW1 = 25 * MiB;
constexpr size_t OFF_K12 = 27 * MiB;
constexpr size_t OFF_LW = 27 * MiB + 512 * 1024;
constexpr size_t OFF_U8 = 28 * MiB;
constexpr size_t OFF_UVS = 512 * 1024;
constexpr size_t OFF_H = 92 * MiB;
constexpr size_t OFF_MIX = 156 * MiB;
constexpr size_t OFF_E = 220 * MiB;
constexpr size_t OFF_PCONV = OFF_E + 0;
constexpr size_t OFF_PRWKV = OFF_E + 32 * MiB;
constexpr size_t OFF_YRAW = OFF_E + 32 * MiB;
constexpr size_t OFF_Q = OFF_E + 96 * MiB;
constexpr size_t OFF_KV = OFF_E + 128 * MiB;
constexpr size_t OFF_GATE = OFF_E + 176 * MiB;
constexpr size_t OFF_KC = OFF_E + 180 * MiB;
constexpr size_t OFF_VCT = OFF_KC + 512 * 1024;
constexpr size_t OFF_RV = OFF_E + 184 * MiB;
constexpr size_t OFF_RKK = OFF_E + 200 * MiB;
constexpr size_t OFF_RKKA = OFF_E + 216 * MiB;
constexpr size_t OFF_RG = OFF_E + 232 * MiB;
constexpr size_t OFF_BONUS = OFF_E + 248 * MiB;
constexpr size_t OFF_RW = OFF_E + 249 * MiB;
constexpr size_t OFF_RR = 60 * MiB;
constexpr size_t OFF_RK = 76 * MiB;
constexpr size_t OFF_QP = OFF_E + 0;
constexpr size_t OFF_PIDX = OFF_E + 128 * MiB;
constexpr size_t OFF_PGW = OFF_E + 144 * MiB;
constexpr size_t WS_NEED = OFF_E + 281 * MiB;

#define QW(l, q) (64 * ((l) * 8 + (q)))
enum { Q_CMP = 0, Q_CONV = 1, Q_RWP = 2, Q_NSA = 3, Q_PTK = 4 };

enum { I_X = 0, I_C, I_ADAW, I_ADAB, I_N1G, I_N2G, I_WIN, I_CDW, I_CDB, I_CGG, I_CGB, I_MU, I_W0, I_WUP, I_A0, I_AUP, I_GUP,
       I_KK, I_KA, I_RK, I_LNG, I_LNB, I_CKPOS, I_CKW1, I_CKW2, I_CVPOS, I_CVW1, I_CVW2, I_WOUT, I_PWQ, I_PK1, I_PK2, I_PU, I_PV, I_FG };

struct Params {
    const float* in[35];
    float* out;
    unsigned char* ws;
    int ph_lo, ph_hi;
};

DEV int TID() { int t = threadIdx.x; asm volatile("" : "+v"(t)); return t; }
DEV int BID() { int t = blockIdx.x; asm volatile("" : "+s"(t)); return t; }
typedef __attribute__((ext_vector_type(2))) float f32x2_t;
typedef __attribute__((ext_vector_type(2))) __bf16 bf16x2_t;
DEV unsigned pack2(float a, float b) { const f32x2_t v = {a, b}; return __builtin_bit_cast(unsigned, __builtin_convertvector(v, bf16x2_t)); }
DEV u16 f2bf(float f) { const __bf16 h = (__bf16)f; return __builtin_bit_cast(u16, h); }
DEV float bf2f(u16 h) { return __uint_as_float(((unsigned)h) << 16); }
DEV float bflo(unsigned u) { return __uint_as_float(u << 16); }
DEV float bfhi(unsigned u) { return __uint_as_float(u & 0xffff0000u); }
DEV float ex2(float x) { return __builtin_amdgcn_exp2f(x); }
DEV float sigmoidf_(float x) { return 1.f / (1.f + __expf(-x)); }

DEV f32x4 mfma16(bf16x8 a, bf16x8 b, f32x4 c) { return __builtin_amdgcn_mfma_f32_16x16x32_bf16(a, b, c, 0, 0, 0); }
template <int CTRL> DEV float dppf(float x) { return __int_as_float(__builtin_amdgcn_update_dpp(0, __float_as_int(x), CTRL, 0xF, 0xF, false)); }
template <int CTRL> DEV unsigned dppu(unsigned x) { return (unsigned)__builtin_amdgcn_update_dpp(0, (int)x, CTRL, 0xF, 0xF, false); }
DEV float reduce16(float x) { x += dppf<0xB1>(x); x += dppf<0x4E>(x); x += dppf<0x124>(x); x += dppf<0x128>(x); return x; }
DEV float quadsum(float x) { x += dppf<0xB1>(x); x += dppf<0x4E>(x); return x; }
DEV float x16_sum(float x) { auto r = __builtin_amdgcn_permlane16_swap(__float_as_uint(x), __float_as_uint(x), false, false); return __uint_as_float(r[0]) + __uint_as_float(r[1]); }
DEV float x32_sum(float x) { auto r = __builtin_amdgcn_permlane32_swap(__float_as_uint(x), __float_as_uint(x), false, false); return __uint_as_float(r[0]) + __uint_as_float(r[1]); }
DEV float x16_max(float x) { auto r = __builtin_amdgcn_permlane16_swap(__float_as_uint(x), __float_as_uint(x), false, false); return fmaxf(__uint_as_float(r[0]), __uint_as_float(r[1])); }
DEV float x32_max(float x) { auto r = __builtin_amdgcn_permlane32_swap(__float_as_uint(x), __float_as_uint(x), false, false); return fmaxf(__uint_as_float(r[0]), __uint_as_float(r[1])); }
DEV int x16_sumi(int x) { auto r = __builtin_amdgcn_permlane16_swap((unsigned)x, (unsigned)x, false, false); return (int)(r[0] + r[1]); }
DEV int x32_sumi(int x) { auto r = __builtin_amdgcn_permlane32_swap((unsigned)x, (unsigned)x, false, false); return (int)(r[0] + r[1]); }
DEV float colsum(float x) { return x32_sum(x16_sum(x)); }
DEV float colmax(float x) { return x32_max(x16_max(x)); }
DEV int colsumi(int x) { return x32_sumi(x16_sumi(x)); }
DEV float wave_sum(float v) { return x32_sum(x16_sum(reduce16(v))); }
DEV int wave_sum_i(int x) {
    x += (int)dppu<0xB1>((unsigned)x); x += (int)dppu<0x4E>((unsigned)x); x += (int)dppu<0x124>((unsigned)x); x += (int)dppu<0x128>((unsigned)x);
    return x32_sumi(x16_sumi(x));
}
DEV int reduce8_i(const int (&d)[8]) {
    int t[4];
#pragma unroll
    for (int k = 0; k < 4; ++k) {
        auto r = __builtin_amdgcn_permlane32_swap((unsigned)d[k], (unsigned)d[k + 4], false, false);
        t[k] = (int)(r[0] + r[1]);
    }
    int u[2];
#pragma unroll
    for (int k = 0; k < 2; ++k) {
        auto r = __builtin_amdgcn_permlane16_swap((unsigned)t[k], (unsigned)t[k + 2], false, false);
        u[k] = (int)(r[0] + r[1]);
    }
    const bool hi8 = (threadIdx.x & 8) != 0;
    int x = hi8 ? u[1] : u[0];
    const int y = hi8 ? u[0] : u[1];
    x += (int)dppu<0x128>((unsigned)y);
    x += (int)dppu<0xB1>((unsigned)x); x += (int)dppu<0x4E>((unsigned)x); x += (int)dppu<0x141>((unsigned)x);
    return x;
}
DEV float wave_max(float x) {
    x = fmaxf(x, dppf<0xB1>(x)); x = fmaxf(x, dppf<0x4E>(x)); x = fmaxf(x, dppf<0x124>(x)); x = fmaxf(x, dppf<0x128>(x));
    return x32_max(x16_max(x));
}
DEV void lds_fence() { asm volatile("s_waitcnt lgkmcnt(0)" ::: "memory"); }
DEV bf16x8 ld8(const u16* p) { return *(const bf16x8*)p; }

DEV int block_next(unsigned* ctr, int* slot) {
    __syncthreads();
    if (TID() == 0) *slot = (int)atomicAdd(ctr, 1u);
    __syncthreads();
    return *slot;
}
DEV int wave_next(unsigned* ctr) {
    int v = 0;
    if ((TID() & 63) == 0) v = (int)atomicAdd(ctr, 1u);
    return __builtin_amdgcn_readfirstlane(v);
}


#define XB_TMO      128
#define XB_XCNT(j)  (256  + 64 * (j))
#define XB_XSUB(j)  (1280 + 64 * (j))
#define XB_XGEN(j)  (2304 + 64 * (j))
#define XB_TOP      3328
#define XB_TOPGEN   3392
#define XCD_BAR_WORDS 3456
#define XB_SPIN_CAP (1u << 22)
#define LAS __attribute__((address_space(3)))
DEV unsigned xb_ld(unsigned* p) { return __hip_atomic_load(p, __ATOMIC_RELAXED, __HIP_MEMORY_SCOPE_AGENT); }
DEV unsigned xb_add(unsigned* p, unsigned v) { return __hip_atomic_fetch_add(p, v, __ATOMIC_RELAXED, __HIP_MEMORY_SCOPE_AGENT); }
DEV unsigned xb_xcc_id() { return (unsigned)__builtin_amdgcn_s_getreg((3 << 11) | 20) & 0xFu; }
#define XB_SPIN(cond, bar) do { unsigned _sp = 0; while (cond) { __builtin_amdgcn_s_sleep(1); \
    if ((++_sp & 255u) == 0u) { if (xb_ld(&(bar)[XB_TMO])) break; if (_sp > XB_SPIN_CAP) { atomicAdd(&(bar)[XB_TMO], 1u); break; } } } } while (0)
struct XcdBarrier { unsigned* bar; unsigned x; volatile unsigned* st; };
DEV XcdBarrier xcd_barrier_post(unsigned* bar, volatile unsigned* st) {
    XcdBarrier b; b.bar = bar; b.x = xb_xcc_id(); b.st = st;
    if (threadIdx.x == 0) (void)xb_add(&bar[XB_XCNT(b.x)], 1u);
    return b;
}
DEV void xcd_barrier_complete(unsigned* bar, unsigned x, unsigned& nloc, unsigned& nx) {
    const unsigned G = gridDim.x * gridDim.y * gridDim.z;
    unsigned sum, cnt, mine, sp = 0u;
    for (;;) {
        sum = 0u; cnt = 0u; mine = 0u;
#pragma unroll
        for (unsigned j = 0; j < 16; ++j) { const unsigned c = xb_ld(&bar[XB_XCNT(j)]); sum += c; cnt += (c > 0u) ? 1u : 0u; mine = (j == x) ? c : mine; }
        if (sum == G) break;
        __builtin_amdgcn_s_sleep(1);
        if ((++sp & 255u) == 0u) { if (xb_ld(&bar[XB_TMO])) break; if (sp > XB_SPIN_CAP) { atomicAdd(&bar[XB_TMO], 1u); break; } }
    }
    nloc = mine > 0u ? mine : 1u; nx = cnt > 0u ? cnt : 1u;
}
DEV void xcd_barrier(const XcdBarrier& b) {
    asm volatile("s_waitcnt vmcnt(0)" ::: "memory");
    __syncthreads();
    if (threadIdx.x == 0) {
        unsigned* bar = b.bar;
        __builtin_amdgcn_s_waitcnt(0);
        unsigned nloc = b.st[0], nx = b.st[1];
        if (nloc == 0u) { xcd_barrier_complete(bar, b.x, nloc, nx); b.st[0] = nloc; b.st[1] = nx; }
        const unsigned old = xb_add(&bar[XB_XSUB(b.x)], 1u);
        const unsigned gen = old / nloc;
        if (old + 1u == (gen + 1u) * nloc) {
            __builtin_amdgcn_fence(__ATOMIC_RELEASE, "agent");
            asm volatile("s_waitcnt vmcnt(0)" ::: "memory");
            const unsigned og = xb_add(&bar[XB_TOP], 1u);
            const unsigned tg = og / nx;
            if (og + 1u == (tg + 1u) * nx) xb_add(&bar[XB_TOPGEN], 1u);
            else XB_SPIN(xb_ld(&bar[XB_TOPGEN]) == tg, bar);
            __builtin_amdgcn_fence(__ATOMIC_ACQUIRE, "agent");
            xb_add(&bar[XB_XGEN(b.x)], 1u);
            asm volatile("s_waitcnt vmcnt(0)" ::: "memory");
        } else {
            XB_SPIN(xb_ld(&bar[XB_XGEN(b.x)]) == gen, bar);
            __builtin_amdgcn_fence(__ATOMIC_ACQUIRE, "agent");
            asm volatile("s_waitcnt vmcnt(0)" ::: "memory");
        }
    }
    __syncthreads();
}

template <class Epi>
DEV void gemm_phase(const u16* __restrict__ A, int lda, const u16* __restrict__ Bt, int ldb, int mtiles, int ntiles, int K, Epi& epi,
                    unsigned char* lds, int bid, int nb, int nt_lo = 0, int nt_skip = 0, bool xcd_order = true) {
    const int tid = TID(), lane = tid & 63, wave = tid >> 6;
    const int wm = wave >> 1, wn = wave & 1, q4 = lane >> 4, cidx = lane & 15;
    u16* As = (u16*)lds;
    u16* Bs = (u16*)(lds + 32768);
    const int KT = K >> 6;
    const int total = mtiles * ntiles;
    const int srow = tid >> 3, sch = tid & 7;
    const bool xo_ = xcd_order && ((nb & 7) == 0) && (nb <= 4096) && ((mtiles & 7) == 0);
    const int ngroups = (ntiles + 7) >> 3;
    const int nloc = xo_ ? (nb >> 3) : 1;
    const int nvirt = xo_ ? ((mtiles >> 3) * ngroups * 64) : total;
    for (int vt = xo_ ? ((bid & 7) * 64 + (bid >> 3)) : bid; vt < nvirt; vt += xo_ ? ((((vt & 63) + nloc) < 64) ? nloc : (8 * 64 - (vt & 63) + (bid >> 3))) : nb) {
        int mt, nt;
        if (xo_) {
            const int st = vt >> 6, tt = vt & 63;
            mt = (st / ngroups) * 8 + (tt >> 3); nt = (st % ngroups) * 8 + (tt & 7);
            if (nt >= ntiles) continue;
        } else { mt = vt / ntiles; nt = vt - mt * ntiles; }
        if (nt >= nt_lo) nt += nt_skip;
        const int m0 = mt * 128, n0 = nt * 128;
        const bool sw = epi.swapped(n0 + wn * 64);
        const int xo = sw ? (32768 / 2 + wn * 64 * 64) : (wm * 64 * 64);
        const int yo = sw ? (wm * 64 * 64) : (32768 / 2 + wn * 64 * 64);
        f32x4 acc[4][4];
#pragma unroll
        for (int i = 0; i < 4; ++i)
#pragma unroll
            for (int j = 0; j < 4; ++j) acc[i][j] = (f32x4){0.f, 0.f, 0.f, 0.f};
        const u16* Ag = A + (size_t)(m0 + srow) * lda + sch * 8;
        const u16* Bg = Bt + (size_t)(n0 + srow) * ldb + sch * 8;
        bf16x8 ra0[4], rb0[4], ra1[4], rb1[4];
#define GEMM_GLOAD(RA, RB, KT_) { const int k0_ = (KT_) * 64; _Pragma("unroll") for (int i = 0; i < 4; ++i) { RA[i] = ld8(Ag + (size_t)(32 * i) * lda + k0_); RB[i] = ld8(Bg + (size_t)(32 * i) * ldb + k0_); } }
#define GEMM_LWRITE(RA, RB, BUF_) { u16* Aw_ = As + (BUF_) * 8192; u16* Bw_ = Bs + (BUF_) * 8192; _Pragma("unroll") for (int i = 0; i < 4; ++i) { const int row = srow + 32 * i; const int off = row * 64 + ((sch ^ (row & 7)) << 3); *(bf16x8*)(Aw_ + off) = RA[i]; *(bf16x8*)(Bw_ + off) = RB[i]; } }
#define GEMM_COMPUTE(BUF_) { const u16* Xb = As + (BUF_) * 8192 + xo; const u16* Yb = As + (BUF_) * 8192 + yo; _Pragma("unroll") for (int s = 0; s < 2; ++s) { bf16x8 a[4], b[4]; const int ch = s * 4 + q4; _Pragma("unroll") for (int i = 0; i < 4; ++i) { const int row = i * 16 + cidx; a[i] = *(const bf16x8*)(Xb + row * 64 + ((ch ^ (row & 7)) << 3)); b[i] = *(const bf16x8*)(Yb + row * 64 + ((ch ^ (row & 7)) << 3)); } _Pragma("unroll") for (int i = 0; i < 4; ++i) _Pragma("unroll") for (int j = 0; j < 4; ++j) acc[i][j] = mfma16(a[i], b[j], acc[i][j]); } }
        GEMM_GLOAD(ra0, rb0, 0);
        if (KT > 1) GEMM_GLOAD(ra1, rb1, 1);
        GEMM_LWRITE(ra0, rb0, 0);
        __syncthreads();
        for (int kt = 0; kt < KT; kt += 2) {
            if (kt + 2 < KT) GEMM_GLOAD(ra0, rb0, kt + 2);
            GEMM_COMPUTE(0);
            GEMM_LWRITE(ra1, rb1, 1);
            __syncthreads();
            if (kt + 3 < KT) GEMM_GLOAD(ra1, rb1, kt + 3);
            GEMM_COMPUTE(1);
            if (kt + 2 < KT) GEMM_LWRITE(ra0, rb0, 0);
            __syncthreads();
        }
#undef GEMM_GLOAD
#undef GEMM_LWRITE
#undef GEMM_COMPUTE
        if (!sw) {
#pragma unroll
            for (int i = 0; i < 4; ++i)
#pragma unroll
                for (int j = 0; j < 4; ++j) epi.rows4(m0 + wm * 64 + i * 16 + q4 * 4, n0 + wn * 64 + j * 16 + cidx, acc[i][j]);
        } else {
#pragma unroll
            for (int i = 0; i < 4; ++i)
#pragma unroll
                for (int j = 0; j < 4; ++j) epi.cols4(m0 + wm * 64 + j * 16 + cidx, n0 + wn * 64 + i * 16 + q4 * 4, acc[i][j]);
        }
        epi.finish(m0, n0, lds);
    }
}

struct EpiInProj {
    u16 *pconv, *prwkv, *q, *kv; float* gate;
    DEV bool swapped(int c0) const { return !((c0 >= 2432 && c0 < 2560) || (c0 >= 2688 && c0 < 2816)); }
    DEV void rows4(int row0, int col, f32x4 v) const {
        const int c = col - 2048; const int idx = c >> 7; const int g = (c >> 6) & 1; const int d = c & 63;
        const int b = row0 >> 13; const int t0 = row0 & 8191; const int bg = b * 2 + g;
        u16* base = kv + (size_t)idx * 4194304;
        const int k = t0 & 31; const int p0 = 8 * ((k & 15) >> 2) + 4 * (k >> 4);
        u32x2 w; w[0] = pack2(v[0], v[1]); w[1] = pack2(v[2], v[3]);
        *(u32x2*)(base + (size_t)(bg * 64 + d) * 8192 + (t0 & ~31) + p0) = w;
    }
    DEV void cols4(int row, int col0, f32x4 v) const {
        if (col0 < 512) {
            u32x2 w; w[0] = pack2(v[0], v[1]); w[1] = pack2(v[2], v[3]);
            *(u32x2*)(pconv + (size_t)row * 512 + col0) = w;
        } else if (col0 < 1536) {
            u32x2 w; w[0] = pack2(v[0], v[1]); w[1] = pack2(v[2], v[3]);
            *(u32x2*)(prwkv + (size_t)row * 1024 + (col0 - 512)) = w;
        } else if (col0 < 2048) {
            const float sc = 0.18033688011112042f;
            u32x2 w; w[0] = pack2(v[0] * sc, v[1] * sc); w[1] = pack2(v[2] * sc, v[3] * sc);
            *(u32x2*)(q + (size_t)row * 512 + (col0 - 1536)) = w;
        } else if (col0 < 2816) {
            const int c = col0 - 2048; const int idx = c >> 7; const int g = (c >> 6) & 1; const int d = c & 63;
            const int b = row >> 13; const int t = row & 8191; const int bg = b * 2 + g;
            u32x2 w; w[0] = pack2(v[0], v[1]); w[1] = pack2(v[2], v[3]);
            *(u32x2*)(kv + (size_t)idx * 4194304 + ((size_t)bg * 8192 + t) * 64 + d) = w;
        } else if (col0 < 2840) {
            *(float4*)(gate + (size_t)row * 24 + (col0 - 2816)) = (float4){sigmoidf_(v[0]), sigmoidf_(v[1]), sigmoidf_(v[2]), sigmoidf_(v[3])};
        }
    }
    DEV void finish(int, int, unsigned char*) const {}
};

struct EpiOutProj {
    const float* xold; float* xnew; const float* g1;
    DEV bool swapped(int) const { return true; }
    DEV void rows4(int, int, f32x4) const {}
    DEV void cols4(int row, int col0, f32x4 v) const {
        const int b = row >> 13; const float4 gg = *(const float4*)(g1 + b * 6144 + col0);
        const size_t o = (size_t)row * 1024 + col0;
        const float4 x = *(const float4*)(xold + o);
        *(float4*)(xnew + o) = (float4){x.x + gg.x * v[0], x.y + gg.y * v[1], x.z + gg.z * v[2], x.w + gg.w * v[3]};
    }
    DEV void finish(int, int, unsigned char*) const {}
};

struct EpiStoreBf16 {
    u16* out; int ld;
    DEV bool swapped(int) const { return true; }
    DEV void rows4(int, int, f32x4) const {}
    DEV void cols4(int row, int col0, f32x4 v) const {
        u32x2 w; w[0] = pack2(v[0], v[1]); w[1] = pack2(v[2], v[3]);
        *(u32x2*)(out + (size_t)row * ld + col0) = w;
    }
    DEV void finish(int, int, unsigned char*) const {}
};

struct EpiCompress {
    const float* cbp;
    const float* w2;
    u16* outp;
    int isv;
    unsigned char* lds;
    DEV bool swapped(int) const { return false; }
    DEV void cols4(int, int, f32x4) const {}
    DEV void rows4(int row0, int col, f32x4 v) const {
        float* hid = (float*)lds;
        const int rl = row0 & 127;
#pragma unroll
        for (int r = 0; r < 4; ++r) hid[(rl + r) * 128 + col] = v[r];
    }
    DEV void finish(int m0, int, unsigned char*) const {
        __syncthreads();
        {
            float* hw = (float*)lds;
            const int t = TID(); const int c = t & 127, r0 = (t >> 7) * 64;
            float bias = 0.f;
#pragma unroll
            for (int s = 0; s < 16; ++s) bias += cbp[s * 128 + c];
#pragma unroll 4
            for (int r = 0; r < 64; ++r) { const float x = hw[(r0 + r) * 128 + c] + bias; hw[(r0 + r) * 128 + c] = x * sigmoidf_(x); }
        }
        __syncthreads();
        const float* hid = (const float*)lds;
        const int tid = TID(); const int d = tid & 63, rgp = tid >> 6;
        float acc[32];
#pragma unroll
        for (int i = 0; i < 32; ++i) acc[i] = 0.f;
#pragma unroll 1
        for (int j0 = 0; j0 < 128; j0 += 8) {
            float wv[8];
#pragma unroll
            for (int jj = 0; jj < 8; ++jj) wv[jj] = w2[(j0 + jj) * 64 + d];
#pragma unroll
            for (int rr = 0; rr < 32; ++rr) {
                const float4 h0 = *(const float4*)(hid + (rgp * 32 + rr) * 128 + j0), h1 = *(const float4*)(hid + (rgp * 32 + rr) * 128 + j0 + 4);
                acc[rr] += h0.x * wv[0] + h0.y * wv[1] + h0.z * wv[2] + h0.w * wv[3] + h1.x * wv[4] + h1.y * wv[5] + h1.z * wv[6] + h1.w * wv[7];
            }
        }
#pragma unroll
        for (int rr = 0; rr < 32; ++rr) {
            const int m = m0 + rgp * 32 + rr; const int bg = m >> 9, n = m & 511;
            const u16 val = (n == 511) ? (u16)0 : f2bf(acc[rr]);
            if (!isv) outp[((size_t)bg * 512 + n) * 64 + d] = val;
            else {
                const int k = n & 31; const int pp = 8 * ((k & 15) >> 2) + (k & 3) + 4 * (k >> 4);
                outp[((size_t)bg * 64 + d) * 512 + (n & ~31) + pp] = val;
            }
        }
        __syncthreads();
    }
};

DEV void transpose_tile(const float* __restrict__ src, int N, u16* __restrict__ dst, int ldk, int kt, int nt, float* tl) {
    const int tid = TID(); const int k0 = kt * 64, n0 = nt * 64;
#pragma unroll 4
    for (int i = 0; i < 16; ++i) {
        const int idx = tid + 256 * i; const int kr = idx >> 6, nc = idx & 63; const int n = n0 + nc;
        tl[kr * 65 + nc] = (n < N) ? src[(size_t)(k0 + kr) * N + n] : 0.f;
    }
    __syncthreads();
#pragma unroll 4
    for (int i = 0; i < 16; ++i) {
        const int idx = tid + 256 * i; const int nr = idx >> 6, kc = idx & 63;
        dst[(size_t)(n0 + nr) * ldk + k0 + kc] = f2bf(tl[kc * 65 + nr]);
    }
    __syncthreads();
}

DEV void convert_straight(const float* __restrict__ src, u16* __restrict__ dst, size_t n) {
    const size_t stride = (size_t)gridDim.x * 256 * 8;
    for (size_t i = ((size_t)BID() * 256 + TID()) * 8; i < n; i += stride) {
        const float4 a = *(const float4*)(src + i); const float4 b = *(const float4*)(src + i + 4);
        u32x4 w; w[0] = pack2(a.x, a.y); w[1] = pack2(a.z, a.w); w[2] = pack2(b.x, b.y); w[3] = pack2(b.z, b.w);
        *(u32x4*)(dst + i) = w;
    }
}

DEV void convert_rows_task(const float* __restrict__ src, unsigned char* __restrict__ dst, float* __restrict__ scale, int* __restrict__ rowsum, int row0) {
    const int lane = TID() & 63, wave = TID() >> 6;
#pragma unroll 1
    for (int it = 0; it < 4; ++it) {
        float4 v[2][4]; float amax[2] = {0.f, 0.f};
#pragma unroll
        for (int u = 0; u < 2; ++u) {
            const int row = row0 + wave * 8 + it * 2 + u;
#pragma unroll
            for (int i = 0; i < 4; ++i) v[u][i] = *(const float4*)(src + (size_t)row * 1024 + 16 * lane + 4 * i);
        }
#pragma unroll
        for (int u = 0; u < 2; ++u) {
#pragma unroll
            for (int i = 0; i < 4; ++i)
                amax[u] = fmaxf(amax[u], fmaxf(fmaxf(fabsf(v[u][i].x), fabsf(v[u][i].y)), fmaxf(fabsf(v[u][i].z), fabsf(v[u][i].w))));
            amax[u] = wave_max(amax[u]);
            const int row = row0 + wave * 8 + it * 2 + u;
            const float sc = amax[u] > 0.f ? amax[u] * (1.f / 127.f) : 1.f;
            const float inv = 1.f / sc;
            u32x4 w;
#pragma unroll
            for (int i = 0; i < 4; ++i) {
                const int a = __float2int_rn(v[u][i].x * inv) + 128, b = __float2int_rn(v[u][i].y * inv) + 128, c = __float2int_rn(v[u][i].z * inv) + 128,
                          d = __float2int_rn(v[u][i].w * inv) + 128;
                w[i] = (unsigned)a | ((unsigned)b << 8) | ((unsigned)c << 16) | ((unsigned)d << 24);
            }
            *(u32x4*)(dst + (size_t)row * 1024 + 16 * lane) = w;
            int bs = 0;
#pragma unroll
            for (int i = 0; i < 4; ++i) bs += (int)(w[i] & 0xffu) + (int)((w[i] >> 8) & 0xffu) + (int)((w[i] >> 16) & 0xffu) + (int)(w[i] >> 24);
            bs = wave_sum_i(bs);
            if (lane == 0) { scale[row] = sc; if (rowsum) rowsum[row] = bs; }
        }
    }
}

DEV void phase_prep(const Params& p, unsigned char* lds) {
    const int tid = TID();
    float* fl = (float*)lds;
    unsigned char* ws = p.ws;
    for (int task = BID(); task < 192; task += gridDim.x) {
        const int l = task / 96, cgp = task % 96;
        float* cs = fl;
        float* red = fl + 4096;
        for (int i = tid; i < 4096; i += 256) { const float c = p.in[I_C][i]; cs[i] = c / (1.f + __expf(-c)); }
        __syncthreads();
        const int col = cgp * 64 + (tid & 63), ks = tid >> 6;
        float a0 = 0, a1 = 0, a2 = 0, a3 = 0;
        const float* w = p.in[I_ADAW] + ((size_t)l * 1024 + ks * 256) * 6144 + col;
#pragma unroll 32
        for (int k = 0; k < 256; ++k) {
            const float wv = w[(size_t)k * 6144]; const int kk = ks * 256 + k;
            a0 += cs[kk] * wv; a1 += cs[1024 + kk] * wv; a2 += cs[2048 + kk] * wv; a3 += cs[3072 + kk] * wv;
        }
        red[(ks * 4 + 0) * 64 + (tid & 63)] = a0; red[(ks * 4 + 1) * 64 + (tid & 63)] = a1;
        red[(ks * 4 + 2) * 64 + (tid & 63)] = a2; red[(ks * 4 + 3) * 64 + (tid & 63)] = a3;
        __syncthreads();
        {
            const int b = tid >> 6, c = tid & 63;
            const float s = red[(0 * 4 + b) * 64 + c] + red[(1 * 4 + b) * 64 + c] + red[(2 * 4 + b) * 64 + c] + red[(3 * 4 + b) * 64 + c];
            const int colg = cgp * 64 + c;
            ((float*)(ws + OFF_MOD))[(l * 4 + b) * 6144 + colg] = s + p.in[I_ADAB][l * 6144 + colg];
        }
        __syncthreads();
    }
    for (int task = BID(); task < 64; task += gridDim.x) {
        const int l = task >> 5, kv = (task >> 4) & 1, s = task & 15;
        const float* pos = p.in[kv ? I_CVPOS : I_CKPOS] + l * 2048;
        const float* w1 = p.in[kv ? I_CVW1 : I_CKW1] + (size_t)l * 2048 * 128;
        const int col = tid & 127, half = tid >> 7;
        float a = 0;
        const int i0 = s * 128 + half * 64;
#pragma unroll 8
        for (int i = 0; i < 64; ++i) a += pos[i0 + i] * w1[(size_t)(i0 + i) * 128 + col];
        fl[tid] = a;
        __syncthreads();
        if (tid < 128) ((float*)(ws + OFF_CBP))[((l * 2 + kv) * 16 + s) * 128 + tid] = fl[tid] + fl[tid + 128];
        __syncthreads();
    }
    {
        for (int task = BID(); task < 2 * 16 * 46; task += gridDim.x) {
            const int l = task / (16 * 46), r = task % (16 * 46);
            transpose_tile(p.in[I_WIN] + (size_t)l * 1024 * NIN, NIN, (u16*)(ws + OFF_WIN) + (size_t)l * NINP * 1024, 1024, r / 46, r % 46, fl);
        }
        for (int task = BID(); task < 2 * 16; task += gridDim.x) {
            const int l = task >> 4, r = task & 15; const int nt = r & 3, part = r >> 2;
            u16* dst = (u16*)(ws + OFF_LW) + (size_t)l * 65536;
            if (part == 0) transpose_tile(p.in[I_WUP] + (size_t)l * 64 * 256, 256, dst, 256, 0, nt, fl);
            else if (part == 1) transpose_tile(p.in[I_AUP] + (size_t)l * 64 * 256, 256, dst + 64, 256, 0, nt, fl);
            else transpose_tile(p.in[I_GUP] + (size_t)l * 128 * 256, 256, dst + 128, 256, part - 2, nt, fl);
        }
        for (int task = BID(); task < 4 * 32 * 2; task += gridDim.x) {
            const int lk = task >> 6, r = task & 63; const int l = lk >> 1, kv = lk & 1;
            transpose_tile(p.in[kv ? I_CVW1 : I_CKW1] + (size_t)l * 2048 * 128, 128, (u16*)(ws + OFF_CW1) + (size_t)lk * 128 * 2048, 2048, r >> 1, r & 1, fl);
        }
    }
    for (int l = 0; l < 2; ++l) {
        convert_straight(p.in[I_PK1] + l * 16384, (u16*)(ws + OFF_K12) + (l * 2 + 0) * 16384, 16384);
        convert_straight(p.in[I_PK2] + l * 16384, (u16*)(ws + OFF_K12) + (l * 2 + 1) * 16384, 16384);
    }
}

DEV void phase_norm(const float* __restrict__ x, const float* __restrict__ g, const float* __restrict__ sh, const float* __restrict__ sc,
                    u16* __restrict__ h) {
    const int lane = TID() & 63;
    const int gw = BID() * 4 + (TID() >> 6), nw = gridDim.x * 4;
    for (int row = gw; row < NTOK; row += nw) {
        const int b = row >> 13;
        float4 v[4]; float ss = 0;
#pragma unroll
        for (int i = 0; i < 4; ++i) { v[i] = *(const float4*)(x + (size_t)row * 1024 + 256 * i + lane * 4); ss += v[i].x * v[i].x + v[i].y * v[i].y + v[i].z * v[i].z + v[i].w * v[i].w; }
        ss = wave_sum(ss);
        const float rs = rsqrtf(ss * (1.f / 1024.f) + 1e-6f);
#pragma unroll
        for (int i = 0; i < 4; ++i) {
            const int k = 256 * i + lane * 4;
            const float4 gg = *(const float4*)(g + k); const float4 s1 = *(const float4*)(sc + b * 6144 + k); const float4 s0 = *(const float4*)(sh + b * 6144 + k);
            u32x2 w;
            w[0] = pack2(v[i].x * rs * gg.x * (1.f + s1.x) + s0.x, v[i].y * rs * gg.y * (1.f + s1.y) + s0.y);
            w[1] = pack2(v[i].z * rs * gg.z * (1.f + s1.z) + s0.z, v[i].w * rs * gg.w * (1.f + s1.w) + s0.w);
            *(u32x2*)(h + (size_t)row * 1024 + k) = w;
        }
    }
}

DEV void phase_final_only(const float* __restrict__ x, const float* __restrict__ g, float* __restrict__ out) {
    const int lane = TID() & 63;
    const int gw = BID() * 4 + (TID() >> 6), nw = gridDim.x * 4;
    for (int row = gw; row < NTOK; row += nw) {
        float4 v[4]; float ss = 0;
#pragma unroll
        for (int i = 0; i < 4; ++i) { v[i] = *(const float4*)(x + (size_t)row * 1024 + 256 * i + lane * 4); ss += v[i].x * v[i].x + v[i].y * v[i].y + v[i].z * v[i].z + v[i].w * v[i].w; }
        ss = wave_sum(ss);
        const float rs = rsqrtf(ss * (1.f / 1024.f) + 1e-6f);
#pragma unroll
        for (int i = 0; i < 4; ++i) {
            const int k = 256 * i + lane * 4; const float4 gg = *(const float4*)(g + k);
            float4 o; o.x = v[i].x * rs * gg.x; o.y = v[i].y * rs * gg.y; o.z = v[i].z * rs * gg.z; o.w = v[i].w * rs * gg.w;
            *(float4*)(out + (size_t)row * 1024 + k) = o;
        }
    }
}


DEV void conv_tile(const Params& p, int l, int tile, unsigned char* lds) {
    float* ul = (float*)lds;
    const int tid = TID();
    unsigned char* ws = p.ws;
    const u16* pconv = (const u16*)(ws + OFF_PCONV);
    u16* mix = (u16*)(ws + OFF_MIX);
    const int t0g = tile * 32; const int tb = t0g & 8191;
#pragma unroll 8
    for (int rr = 0; rr < 62; ++rr) {
        const int trow = tb - 30 + rr;
        float u = 0.f;
        if (trow >= 0) {
            const size_t o = (size_t)(t0g - 30 + rr) * 512;
            const float val = bf2f(pconv[o + tid]), gt = bf2f(pconv[o + 256 + tid]);
            u = val * sigmoidf_(gt);
        }
        ul[rr * 256 + tid] = u;
    }
    __syncthreads();
    float w[31];
#pragma unroll
    for (int j = 0; j < 31; ++j) w[j] = p.in[I_CDW][(l * 31 + j) * 256 + tid];
    const float bias = p.in[I_CDB][l * 256 + tid], gg = p.in[I_CGG][l * 256 + tid], gb = p.in[I_CGB][l * 256 + tid];
    for (int tt = 0; tt < 32; ++tt) {
        float y = bias;
#pragma unroll
        for (int j = 0; j < 31; ++j) y += ul[(tt + j) * 256 + tid] * w[j];
        const float mean = wave_sum(y) * (1.f / 64.f);
        const float d = y - mean;
        const float var = wave_sum(d * d) * (1.f / 64.f);
        float o = d * rsqrtf(var + 1e-5f) * gg + gb;
        o = o * sigmoidf_(o);
        mix[(size_t)(t0g + tt) * 1024 + tid] = f2bf(o);
    }
}

DEV float softplusf_(float x) { return x > 20.f ? x : log1pf(__expf(x)); }
DEV void rwkv_prep_tile(const Params& p, int l, int tile, unsigned char* lds) {
    float* actT = (float*)lds;
    const int tid = TID(), lane = tid & 63;
    unsigned char* ws = p.ws;
    const u16* pr = (const u16*)(ws + OFF_PRWKV);
    const float* mu = p.in[I_MU] + l * 1024;
    const int R0 = tile * 16;
    {
        const int col = 768 + tid; const float muc = mu[col];
#pragma unroll 4
        for (int tk = 0; tk < 16; ++tk) {
            const int row = R0 + tk; const int t = row & 8191;
            const float cur = bf2f(pr[(size_t)row * 1024 + col]);
            const float prev = t > 0 ? bf2f(pr[(size_t)(row - 1) * 1024 + col]) : 0.f;
            const float x = cur + (prev - cur) * muc;
            float a;
            if (tid < 64) a = tanhf(x); else if (tid < 128) a = x; else a = sigmoidf_(x);
            actT[tid * 16 + tk] = a;
        }
    }
    __syncthreads();
    float accw[16], acca[16], accg[16];
#pragma unroll
    for (int i = 0; i < 16; ++i) { accw[i] = 0.f; acca[i] = 0.f; accg[i] = 0.f; }
    const float* wup = p.in[I_WUP] + (size_t)l * 64 * 256 + tid;
    const float* aup = p.in[I_AUP] + (size_t)l * 64 * 256 + tid;
    const float* gup = p.in[I_GUP] + (size_t)l * 128 * 256 + tid;
#pragma unroll 8
    for (int j = 0; j < 64; ++j) {
        const float ww = wup[j * 256], aa = aup[j * 256];
        const float4* x1 = (const float4*)(actT + j * 16);
        const float4* x2 = (const float4*)(actT + (64 + j) * 16);
#pragma unroll
        for (int q = 0; q < 4; ++q) {
            const float4 a = x1[q], b = x2[q];
            accw[4 * q + 0] += a.x * ww; accw[4 * q + 1] += a.y * ww; accw[4 * q + 2] += a.z * ww; accw[4 * q + 3] += a.w * ww;
            acca[4 * q + 0] += b.x * aa; acca[4 * q + 1] += b.y * aa; acca[4 * q + 2] += b.z * aa; acca[4 * q + 3] += b.w * aa;
        }
    }
#pragma unroll 8
    for (int j = 0; j < 128; ++j) {
        const float gg = gup[j * 256];
        const float4* x3 = (const float4*)(actT + (128 + j) * 16);
#pragma unroll
        for (int q = 0; q < 4; ++q) {
            const float4 a = x3[q];
            accg[4 * q + 0] += a.x * gg; accg[4 * q + 1] += a.y * gg; accg[4 * q + 2] += a.z * gg; accg[4 * q + 3] += a.w * gg;
        }
    }
    const float w0 = p.in[I_W0][l * 256 + tid], a0 = p.in[I_A0][l * 256 + tid], kkc = p.in[I_KK][l * 256 + tid], kac = p.in[I_KA][l * 256 + tid],
                rkc = p.in[I_RK][l * 256 + tid];
    const float mur = mu[tid], muk = mu[256 + tid], muv = mu[512 + tid];
    float* RW = (float*)(ws + OFF_RW);
    u16 *RR = (u16*)(ws + OFF_RR), *RK = (u16*)(ws + OFF_RK), *RV = (u16*)(ws + OFF_RV), *RKK = (u16*)(ws + OFF_RKK), *RKKA = (u16*)(ws + OFF_RKKA),
        *RG = (u16*)(ws + OFF_RG);
    float* BON = (float*)(ws + OFF_BONUS);
#pragma unroll
    for (int tk = 0; tk < 16; ++tk) {
        const int row = R0 + tk; const int t = row & 8191;
        const u16* cr = pr + (size_t)row * 1024; const u16* pv = cr - 1024;
        float r = bf2f(cr[tid]), k = bf2f(cr[256 + tid]), v = bf2f(cr[512 + tid]);
        const float rp = t > 0 ? bf2f(pv[tid]) : 0.f, kp = t > 0 ? bf2f(pv[256 + tid]) : 0.f, vp = t > 0 ? bf2f(pv[512 + tid]) : 0.f;
        r += (rp - r) * mur; k += (kp - k) * muk; v += (vp - v) * muv;
        const float wl = w0 + accw[tk];
        const float wlog = -softplusf_(-wl) - 0.5f;
        const float decay = __expf(-__expf(wlog));
        const float a = sigmoidf_(a0 + acca[tk]);
        float kk = k * kkc;
        const float nrm = sqrtf(wave_sum(kk * kk));
        kk = kk / fmaxf(nrm, 1e-12f);
        const float keff = k * (1.f + (a - 1.f) * kac);
        const float bon = wave_sum(r * keff * rkc);
        const size_t o = (size_t)row * 256 + tid;
        RW[o] = decay; RR[o] = f2bf(r); RK[o] = f2bf(keff); RV[o] = f2bf(v); RKK[o] = f2bf(kk); RKKA[o] = f2bf(kk * a); RG[o] = f2bf(accg[tk]);
        if (lane == 0) BON[(size_t)row * 4 + (tid >> 6)] = bon;
    }
}

DEV void rwkv_prep_tile2(const Params& p, int l, int tile, unsigned char* lds) {
    u16* actb = (u16*)lds;
    const int tid = TID(), lane = tid & 63, wave = tid >> 6, q4 = lane >> 4, cidx = lane & 15;
    unsigned char* ws = p.ws;
    const u16* pr = (const u16*)(ws + OFF_PRWKV);
    const float* mu = p.in[I_MU] + l * 1024;
    const int R0 = tile * 16;
    {
        const int col = 768 + tid; const float muc = mu[col];
#pragma unroll 4
        for (int tk = 0; tk < 16; ++tk) {
            const int row = R0 + tk; const int t = row & 8191;
            const float cur = bf2f(pr[(size_t)row * 1024 + col]);
            const float prev = t > 0 ? bf2f(pr[(size_t)(row - 1) * 1024 + col]) : 0.f;
            const float x = cur + (prev - cur) * muc;
            float a;
            if (tid < 64) a = tanhf(x); else if (tid < 128) a = x; else a = sigmoidf_(x);
            actb[tk * 264 + tid] = f2bf(a);
        }
    }
    __syncthreads();
    f32x4 accw[4], acca[4], accg[4];
    {
        bf16x8 af[8];
#pragma unroll
        for (int s2 = 0; s2 < 8; ++s2) af[s2] = *(const bf16x8*)(actb + cidx * 264 + 32 * s2 + 8 * q4);
        const u16* LW = (const u16*)(ws + OFF_LW) + (size_t)l * 65536;
        const f32x4 z = (f32x4){0.f, 0.f, 0.f, 0.f};
#pragma unroll
        for (int nt = 0; nt < 4; ++nt) {
            const u16* bp = LW + (size_t)(64 * wave + 16 * nt + cidx) * 256 + 8 * q4;
            accw[nt] = mfma16(af[0], ld8(bp), z); accw[nt] = mfma16(af[1], ld8(bp + 32), accw[nt]);
            acca[nt] = mfma16(af[2], ld8(bp + 64), z); acca[nt] = mfma16(af[3], ld8(bp + 96), acca[nt]);
            accg[nt] = mfma16(af[4], ld8(bp + 128), z); accg[nt] = mfma16(af[5], ld8(bp + 160), accg[nt]);
            accg[nt] = mfma16(af[6], ld8(bp + 192), accg[nt]); accg[nt] = mfma16(af[7], ld8(bp + 224), accg[nt]);
        }
    }
    float* RW = (float*)(ws + OFF_RW);
    u16 *RR = (u16*)(ws + OFF_RR), *RK = (u16*)(ws + OFF_RK), *RV = (u16*)(ws + OFF_RV), *RKK = (u16*)(ws + OFF_RKK), *RKKA = (u16*)(ws + OFF_RKKA),
        *RG = (u16*)(ws + OFF_RG);
    float* BON = (float*)(ws + OFF_BONUS);
    float w0[4], a0[4], kkc[4], kac[4], rkc[4], mur[4], muk[4], muv[4];
#pragma unroll
    for (int nt = 0; nt < 4; ++nt) {
        const int c = 64 * wave + 16 * nt + cidx;
        w0[nt] = p.in[I_W0][l * 256 + c]; a0[nt] = p.in[I_A0][l * 256 + c]; kkc[nt] = p.in[I_KK][l * 256 + c]; kac[nt] = p.in[I_KA][l * 256 + c];
        rkc[nt] = p.in[I_RK][l * 256 + c]; mur[nt] = mu[c]; muk[nt] = mu[256 + c]; muv[nt] = mu[512 + c];
    }
#pragma unroll
    for (int r = 0; r < 4; ++r) {
        const int row = R0 + 4 * q4 + r; const int t = row & 8191;
        const u16* cr = pr + (size_t)row * 1024; const u16* pv = cr - 1024;
        float rr[4], kf_[4], vf_[4], av[4], kkv[4], keff[4], dec[4];
        float kk2 = 0.f, bn = 0.f;
#pragma unroll
        for (int nt = 0; nt < 4; ++nt) {
            const int c = 64 * wave + 16 * nt + cidx;
            float rv = bf2f(cr[c]), kv = bf2f(cr[256 + c]), vv = bf2f(cr[512 + c]);
            const float rp = t > 0 ? bf2f(pv[c]) : 0.f, kp = t > 0 ? bf2f(pv[256 + c]) : 0.f, vp = t > 0 ? bf2f(pv[512 + c]) : 0.f;
            rv += (rp - rv) * mur[nt]; kv += (kp - kv) * muk[nt]; vv += (vp - vv) * muv[nt];
            const float wl = w0[nt] + accw[nt][r];
            const float wlog = -softplusf_(-wl) - 0.5f;
            dec[nt] = __expf(-__expf(wlog));
            av[nt] = sigmoidf_(a0[nt] + acca[nt][r]);
            kkv[nt] = kv * kkc[nt]; kk2 += kkv[nt] * kkv[nt];
            keff[nt] = kv * (1.f + (av[nt] - 1.f) * kac[nt]);
            bn += rv * keff[nt] * rkc[nt];
            rr[nt] = rv; kf_[nt] = kv; vf_[nt] = vv;
        }
        kk2 = reduce16(kk2); bn = reduce16(bn);
        const float inv = 1.f / fmaxf(sqrtf(kk2), 1e-12f);
#pragma unroll
        for (int nt = 0; nt < 4; ++nt) {
            const int c = 64 * wave + 16 * nt + cidx;
            const size_t o = (size_t)row * 256 + c;
            const float kk = kkv[nt] * inv;
            RW[o] = dec[nt]; RR[o] = f2bf(rr[nt]); RK[o] = f2bf(keff[nt]); RV[o] = f2bf(vf_[nt]); RKK[o] = f2bf(kk); RKKA[o] = f2bf(kk * av[nt]);
            RG[o] = f2bf(accg[nt][r]);
        }
        if (cidx == 0) BON[(size_t)row * 4 + wave] = bn;
    }
}

DEV void rwkv_scan(const Params& p, int sb, unsigned char* lds) {
    unsigned char* ws = p.ws;
    const float* RW = (const float*)(ws + OFF_RW);
    const u16 *RR = (const u16*)(ws + OFF_RR), *RK = (const u16*)(ws + OFF_RK), *RV = (const u16*)(ws + OFF_RV), *RKK = (const u16*)(ws + OFF_RKK),
              *RKKA = (const u16*)(ws + OFF_RKKA);
    float* YR = (float*)(ws + OFF_YRAW);
    const int tid = TID(), lane = tid & 63, wave = tid >> 6;
    const int bh = sb >> 2, rg = sb & 3; const int b = bh >> 2, hh = bh & 3;
    float* L = (float*)lds;
    constexpr int BUFSZ = 5 * 1024 + 256;
    float* Yb = L + 2 * BUFSZ;
    const int row_local = 4 * wave + (lane >> 4); const int kq = (lane & 15) * 4;
    const int lstep = tid >> 4, lk = (tid & 15) * 4;
    const int vstep = tid >> 4, vrow = tid & 15;
    const size_t gbase = (size_t)b * 8192 * 256 + hh * 64;
    float4 lw; u32x2 lr, lkk, lkka, lk_; u16 lv;
    auto issue = [&](int c) {
        const size_t o = gbase + (size_t)(c * 16 + lstep) * 256 + lk;
        lw = *(const float4*)(RW + o);
        lr = *(const u32x2*)(RR + o); lk_ = *(const u32x2*)(RK + o); lkk = *(const u32x2*)(RKK + o); lkka = *(const u32x2*)(RKKA + o);
        lv = RV[gbase + (size_t)(c * 16 + vstep) * 256 + rg * 16 + vrow];
    };
    auto commit = [&](int buf) {
        float* B = L + buf * BUFSZ;
        const int o = lstep * 64 + lk;
        *(float4*)(B + o) = lw;
        *(float4*)(B + 1024 + o) = (float4){bflo(lkka[0]), bfhi(lkka[0]), bflo(lkka[1]), bfhi(lkka[1])};
        *(float4*)(B + 2048 + o) = (float4){bflo(lk_[0]), bfhi(lk_[0]), bflo(lk_[1]), bfhi(lk_[1])};
        *(float4*)(B + 3072 + o) = (float4){bflo(lr[0]), bfhi(lr[0]), bflo(lr[1]), bfhi(lr[1])};
        *(float4*)(B + 4096 + o) = (float4){bflo(lkk[0]), bfhi(lkk[0]), bflo(lkk[1]), bfhi(lkk[1])};
        B[5120 + vstep * 16 + vrow] = bf2f(lv);
    };
    __syncthreads();
    issue(0); commit(0);
    __syncthreads();
    float S0 = 0.f, S1 = 0.f, S2 = 0.f, S3 = 0.f;
    constexpr int NCH = NT / 16;
    for (int c = 0; c < NCH; ++c) {
        const int buf = c & 1;
        if (c + 1 < NCH) issue(c + 1);
        const float* B = L + buf * BUFSZ;
        float* Y = Yb + buf * 256;
        float yv[16];
        float4 w4 = *(const float4*)(B + kq), a4 = *(const float4*)(B + 1024 + kq), k4 = *(const float4*)(B + 2048 + kq),
               r4 = *(const float4*)(B + 3072 + kq), n4 = *(const float4*)(B + 4096 + kq);
        float vv = B[5120 + row_local];
#pragma unroll
        for (int st = 0; st < 16; ++st) {
            float4 w4n, a4n, k4n, r4n, n4n; float vvn;
            if (st < 15) {
                w4n = *(const float4*)(B + (st + 1) * 64 + kq); a4n = *(const float4*)(B + 1024 + (st + 1) * 64 + kq);
                k4n = *(const float4*)(B + 2048 + (st + 1) * 64 + kq); r4n = *(const float4*)(B + 3072 + (st + 1) * 64 + kq);
                n4n = *(const float4*)(B + 4096 + (st + 1) * 64 + kq); vvn = B[5120 + (st + 1) * 16 + row_local];
            }
            const float part = (S0 * n4.x + S1 * n4.y) + (S2 * n4.z + S3 * n4.w);
            const float sa = -reduce16(part);
            const float t0 = S0 * w4.x + vv * k4.x, t1 = S1 * w4.y + vv * k4.y, t2 = S2 * w4.z + vv * k4.z, t3 = S3 * w4.w + vv * k4.w;
            S0 = t0 + sa * a4.x; S1 = t1 + sa * a4.y; S2 = t2 + sa * a4.z; S3 = t3 + sa * a4.w;
            const float yp = (S0 * r4.x + S1 * r4.y) + (S2 * r4.z + S3 * r4.w);
            yv[st] = reduce16(yp);
            if (st < 15) { w4 = w4n; a4 = a4n; k4 = k4n; r4 = r4n; n4 = n4n; vv = vvn; }
        }
        if ((lane & 15) == 0) {
#pragma unroll
            for (int st = 0; st < 16; ++st) Y[st * 16 + row_local] = yv[st];
        }
        if (c + 1 < NCH) commit(buf ^ 1);
        __syncthreads();
        YR[gbase + (size_t)(c * 16 + vstep) * 256 + rg * 16 + vrow] = Y[vstep * 16 + vrow];
    }
}

DEV void phase_rwkv_post(const Params& p, int l) {
    unsigned char* ws = p.ws;
    const float* YR = (const float*)(ws + OFF_YRAW); const float* BON = (const float*)(ws + OFF_BONUS);
    const u16 *RV = (const u16*)(ws + OFF_RV), *RG = (const u16*)(ws + OFF_RG);
    u16* mix = (u16*)(ws + OFF_MIX);
    const int tid = TID();
    const float lg = p.in[I_LNG][l * 256 + tid], lb = p.in[I_LNB][l * 256 + tid];
    for (int row = BID(); row < NTOK; row += gridDim.x) {
        const size_t o = (size_t)row * 256 + tid;
        const float y = YR[o];
        const float mean = wave_sum(y) * (1.f / 64.f);
        const float d = y - mean;
        const float var = wave_sum(d * d) * (1.f / 64.f);
        const float yn = d * rsqrtf(var + 64e-5f) * lg + lb;
        const float outv = (yn + BON[(size_t)row * 4 + (tid >> 6)] * bf2f(RV[o])) * bf2f(RG[o]);
        mix[(size_t)row * 1024 + 256 + tid] = f2bf(outv);
    }
}

DEV void zero_mix_cols(const Params& p, int c0, int ncols) {
    u16* mix = (u16*)(p.ws + OFF_MIX);
    const int per = ncols / 8;
    const size_t total = (size_t)NTOK * per;
    for (size_t i = (size_t)BID() * 256 + TID(); i < total; i += (size_t)gridDim.x * 256) {
        const size_t row = i / per; const int cc = (int)(i % per);
        *(u32x4*)(mix + row * 1024 + c0 + cc * 8) = (u32x4){0u, 0u, 0u, 0u};
    }
}


DEV void load_kv(const u16* __restrict__ Kb, const u16* __restrict__ VTb, int q4, int cidx, bf16x8 (&kf)[8], bf16x8 (&vf)[8]) {
#pragma unroll
    for (int kt = 0; kt < 4; ++kt) { const u16* kp = Kb + (kt * 16 + cidx) * 64 + 8 * q4; kf[2 * kt] = ld8(kp); kf[2 * kt + 1] = ld8(kp + 32); }
#pragma unroll
    for (int kb = 0; kb < 2; ++kb)
#pragma unroll
        for (int mt = 0; mt < 4; ++mt) vf[kb * 4 + mt] = ld8(VTb + (size_t)(16 * mt + cidx) * 8192 + kb * 32 + 8 * q4);
}
DEV void qk_tile(const bf16x8 (&kf)[8], bf16x8 q0, bf16x8 q1, f32x4 (&st)[4]) {
#pragma unroll
    for (int kt = 0; kt < 4; ++kt) {
        st[kt] = mfma16(kf[2 * kt], q0, (f32x4){0.f, 0.f, 0.f, 0.f});
        st[kt] = mfma16(kf[2 * kt + 1], q1, st[kt]);
    }
}
DEV void softmax_pv_tile(bool MASK, f32x4 (&st)[4], const bf16x8 (&vf)[8], int keybase, int tcol, int lowcol, bool colsel, float& m, float& l, f32x4 (&O)[4], int q4) {
    float lmax = -1e30f;
    if (MASK) {
        const int hi = colsel ? tcol : -1;
#pragma unroll
        for (int kt = 0; kt < 4; ++kt)
#pragma unroll
            for (int r = 0; r < 4; ++r) {
                const int key = keybase + kt * 16 + 4 * q4 + r;
                const bool valid = (key <= hi) && (key > lowcol);
                const float sv = valid ? st[kt][r] : -1e30f;
                st[kt][r] = sv; lmax = fmaxf(lmax, sv);
            }
    } else {
        const float cs = colsel ? 0.f : -1e30f;
#pragma unroll
        for (int kt = 0; kt < 4; ++kt)
#pragma unroll
            for (int r = 0; r < 4; ++r) { const float sv = st[kt][r] + cs; st[kt][r] = sv; lmax = fmaxf(lmax, sv); }
    }
    lmax = colmax(lmax);
    const float mnew = fmaxf(m, lmax);
    const float alpha = ex2(m - mnew);
    float psum = 0.f;
#pragma unroll
    for (int kt = 0; kt < 4; ++kt)
#pragma unroll
        for (int r = 0; r < 4; ++r) {
            float pv = ex2(st[kt][r] - mnew);
            if (MASK) pv = (st[kt][r] > -1e29f) ? pv : 0.f;
            st[kt][r] = pv; psum += pv;
        }
    l = l * alpha + psum;
    if (__any(mnew > m)) {
#pragma unroll
        for (int mt = 0; mt < 4; ++mt) { O[mt][0] *= alpha; O[mt][1] *= alpha; O[mt][2] *= alpha; O[mt][3] *= alpha; }
    }
    m = mnew;
#pragma unroll
    for (int kb = 0; kb < 2; ++kb) {
        union { bf16x8 v; unsigned u[4]; } pb;
        pb.u[0] = pack2(st[2 * kb][0], st[2 * kb][1]); pb.u[1] = pack2(st[2 * kb][2], st[2 * kb][3]);
        pb.u[2] = pack2(st[2 * kb + 1][0], st[2 * kb + 1][1]); pb.u[3] = pack2(st[2 * kb + 1][2], st[2 * kb + 1][3]);
#pragma unroll
        for (int mt = 0; mt < 4; ++mt) O[mt] = mfma16(vf[kb * 4 + mt], pb.v, O[mt]);
    }
}
DEV unsigned pick4(unsigned a0, unsigned a1, unsigned a2, unsigned a3, int w) { return w == 0 ? a0 : (w == 1 ? a1 : (w == 2 ? a2 : a3)); }
DEV void nsa_branch(const u16* __restrict__ K0, const u16* __restrict__ VT0, unsigned ua0, unsigned ua1, unsigned ua2, unsigned ua3, unsigned ub0,
                    unsigned ub1, unsigned ub2, unsigned ub3, const unsigned* cm, int tokl, const int (&tcol)[2], const int (&lowc)[2],
                    const bf16x8 (&qf)[2][2], float (&m)[2], float (&l)[2], f32x4 (&O)[2][4], int q4, int cidx, int cur, int lowmax) {
    int w = 0; unsigned bits = ua0 | ub0;
    auto advance = [&]() -> int {
        while (bits == 0u && w < 3) { ++w; bits = pick4(ua0, ua1, ua2, ua3, w) | pick4(ub0, ub1, ub2, ub3, w); }
        if (bits == 0u) return -1;
        const int jb = __builtin_ctz(bits); bits &= bits - 1u;
        return w * 32 + jb;
    };
    int blk = advance();
    if (blk < 0) return;
    bf16x8 kf[8], vf[8];
    {
        const u16* Kb = K0 + (size_t)blk * 64 * 64;
#pragma unroll
        for (int kt = 0; kt < 4; ++kt) { const u16* kp = Kb + (kt * 16 + cidx) * 64 + 8 * q4; kf[2 * kt] = ld8(kp); kf[2 * kt + 1] = ld8(kp + 32); }
    }
#pragma unroll 1
    while (blk >= 0) {
        {
            const u16* VTb = VT0 + blk * 64;
#pragma unroll
            for (int kb = 0; kb < 2; ++kb)
#pragma unroll
                for (int mt = 0; mt < 4; ++mt) vf[kb * 4 + mt] = ld8(VTb + (size_t)(16 * mt + cidx) * 8192 + kb * 32 + 8 * q4);
        }
        const int wq = blk >> 5, jb = blk & 31;
        const bool act0 = (pick4(ua0, ua1, ua2, ua3, wq) >> jb) & 1u, act1 = (pick4(ub0, ub1, ub2, ub3, wq) >> jb) & 1u;
        f32x4 st0[4], st1[4];
        if (act0) qk_tile(kf, qf[0][0], qf[0][1], st0);
        if (act1) qk_tile(kf, qf[1][0], qf[1][1], st1);
        const int nblk = advance();
        if (nblk >= 0) {
            const u16* Kb = K0 + (size_t)nblk * 64 * 64;
#pragma unroll
            for (int kt = 0; kt < 4; ++kt) { const u16* kp = Kb + (kt * 16 + cidx) * 64 + 8 * q4; kf[2 * kt] = ld8(kp); kf[2 * kt + 1] = ld8(kp + 32); }
        }
        const bool need_mask = (blk == cur) || (blk * 64 <= lowmax);
        if (act0) {
            const bool cs = cm ? (((cm[tokl * 4 + wq] >> jb) & 1u) != 0u) : true;
            softmax_pv_tile(need_mask, st0, vf, blk * 64, tcol[0], lowc[0], cs, m[0], l[0], O[0], q4);
        }
        if (act1) {
            const bool cs = cm ? (((cm[(4 + tokl) * 4 + wq] >> jb) & 1u) != 0u) : true;
            softmax_pv_tile(need_mask, st1, vf, blk * 64, tcol[1], lowc[1], cs, m[1], l[1], O[1], q4);
        }
        blk = nblk;
    }
}
template <int CTRL> DEV unsigned dpp_or(unsigned x) { return x | dppu<CTRL>(x); }
DEV unsigned row_or(unsigned x) { x = dpp_or<0xB1>(x); x = dpp_or<0x4E>(x); x = dpp_or<0x124>(x); x = dpp_or<0x128>(x); return x; }


DEV void nsa_branch_lds(unsigned char* lds, const u16* __restrict__ K0, const u16* __restrict__ VT0, unsigned bu0, unsigned bu1, unsigned bu2,
                        unsigned bu3, unsigned ua0, unsigned ua1, unsigned ua2, unsigned ua3, unsigned ub0, unsigned ub1, unsigned ub2, unsigned ub3,
                        const unsigned* cm, int tokl, const int (&tcol)[2], const int (&lowc)[2], const bf16x8 (&qf)[2][2], float (&m)[2],
                        float (&l)[2], f32x4 (&O)[2][4], int q4, int cidx, int cur, int lowmax) {
    const int tid = TID();
    int w = 0; unsigned bits = bu0;
    auto advance = [&]() -> int {
        while (bits == 0u && w < 3) { ++w; bits = pick4(bu0, bu1, bu2, bu3, w); }
        if (bits == 0u) return -1;
        const int jb = __builtin_ctz(bits); bits &= bits - 1u;
        return w * 32 + jb;
    };
    const int srow0 = tid >> 3, srow1 = srow0 + 32, sch = tid & 7;
    const int so0 = srow0 * 128 + ((sch ^ (srow0 & 7)) << 4), so1 = srow1 * 128 + ((sch ^ (srow1 & 7)) << 4);
    bf16x8 r0[4], r1[4];
#define NSA_GLOAD(R, BLK_) { R[0] = ld8(K0 + ((size_t)(BLK_) * 64 + srow0) * 64 + sch * 8); R[1] = ld8(K0 + ((size_t)(BLK_) * 64 + srow1) * 64 + sch * 8); \
        R[2] = ld8(VT0 + (size_t)srow0 * 8192 + (BLK_) * 64 + sch * 8); R[3] = ld8(VT0 + (size_t)srow1 * 8192 + (BLK_) * 64 + sch * 8); }
#define NSA_LWRITE(R, BUF_) { unsigned char* wb_ = lds + (BUF_) * 16384; *(bf16x8*)(wb_ + so0) = R[0]; *(bf16x8*)(wb_ + so1) = R[1]; \
        *(bf16x8*)(wb_ + 8192 + so0) = R[2]; *(bf16x8*)(wb_ + 8192 + so1) = R[3]; }
    auto compute = [&](int blk, int buf) {
        const int wq = blk >> 5, jb = blk & 31;
        const bool act0 = (pick4(ua0, ua1, ua2, ua3, wq) >> jb) & 1u, act1 = (pick4(ub0, ub1, ub2, ub3, wq) >> jb) & 1u;
        if (act0 || act1) {
            const unsigned char* kb_ = lds + buf * 16384;
            const bool need_mask = (blk == cur) || (blk * 64 <= lowmax);
            f32x4 st0[4], st1[4];
            {
                bf16x8 kf[8];
#pragma unroll
                for (int kt = 0; kt < 4; ++kt)
#pragma unroll
                    for (int s2 = 0; s2 < 2; ++s2) {
                        const int row = 16 * kt + cidx, ch = 4 * s2 + q4;
                        kf[2 * kt + s2] = *(const bf16x8*)(kb_ + row * 128 + ((ch ^ (row & 7)) << 4));
                    }
                if (act0) qk_tile(kf, qf[0][0], qf[0][1], st0);
                if (act1) qk_tile(kf, qf[1][0], qf[1][1], st1);
            }
            __builtin_amdgcn_sched_barrier(0);
            bf16x8 vf[8];
#pragma unroll
            for (int kb = 0; kb < 2; ++kb)
#pragma unroll
                for (int mt = 0; mt < 4; ++mt) {
                    const int row = 16 * mt + cidx, ch = 4 * kb + q4;
                    vf[kb * 4 + mt] = *(const bf16x8*)(kb_ + 8192 + row * 128 + ((ch ^ (row & 7)) << 4));
                }
            if (act0) {
                const bool cs = cm ? (((cm[tokl * 4 + wq] >> jb) & 1u) != 0u) : true;
                softmax_pv_tile(need_mask, st0, vf, blk * 64, tcol[0], lowc[0], cs, m[0], l[0], O[0], q4);
            }
            if (act1) {
                const bool cs = cm ? (((cm[(4 + tokl) * 4 + wq] >> jb) & 1u) != 0u) : true;
                softmax_pv_tile(need_mask, st1, vf, blk * 64, tcol[1], lowc[1], cs, m[1], l[1], O[1], q4);
            }
        }
    };
    int b0 = advance();
    if (b0 < 0) return;
    int b1 = advance();
    NSA_GLOAD(r0, b0);
    if (b1 >= 0) NSA_GLOAD(r1, b1);
    NSA_LWRITE(r0, 0);
    __syncthreads();
#pragma unroll 1
    while (b0 >= 0) {
        const int b2 = (b1 >= 0) ? advance() : -1;
        if (b2 >= 0) NSA_GLOAD(r0, b2);
        compute(b0, 0);
        if (b1 >= 0) NSA_LWRITE(r1, 1);
        __syncthreads();
        if (b1 < 0) break;
        const int b3 = (b2 >= 0) ? advance() : -1;
        if (b3 >= 0) NSA_GLOAD(r1, b3);
        compute(b1, 1);
        if (b2 >= 0) NSA_LWRITE(r0, 0);
        __syncthreads();
        b0 = b2; b1 = b3;
    }
#undef NSA_GLOAD
#undef NSA_LWRITE
}

DEV void nsa_block_task(const Params& p, int task, unsigned char* lds) {
    const int wave = TID() >> 6;
    float* wl = (float*)(lds + 32768) + wave * 2112;
    unsigned* bm = (unsigned*)(lds + 32768 + 4 * 8448);
    float* impA = wl; float* impB = wl + 1024; unsigned* selmask = (unsigned*)(wl + 1024 + 1056);
    unsigned char* ws = p.ws;
    const u16* Q = (const u16*)(ws + OFF_Q);
    const u16* KVb = (const u16*)(ws + OFF_KV);
    const u16 *KSEL = KVb + (size_t)2 * 4194304, *VSELT = KVb + (size_t)3 * 4194304, *KWIN = KVb + (size_t)4 * 4194304, *VWINT = KVb + (size_t)5 * 4194304;
    const u16* KC = (const u16*)(ws + OFF_KC); const u16* VCT = (const u16*)(ws + OFF_VCT);
    const float* GATE = (const float*)(ws + OFF_GATE);
    u16* mix = (u16*)(ws + OFF_MIX);
    const int lane = TID() & 63, q4 = lane >> 4, cidx = lane & 15;
    const int bg = task & 7, t0b = (255 - (task >> 3)) * 32, t0 = t0b + 8 * wave; const int b = bg >> 1, g = bg & 1;
    const int tokl = cidx >> 2, hr = cidx & 3; const int head = g * 4 + hr;
    const int cur = t0 >> 6;
    int tcol[2], rowc[2]; bf16x8 qf[2][2];
#pragma unroll
    for (int ti = 0; ti < 2; ++ti) {
        tcol[ti] = t0 + 4 * ti + tokl; rowc[ti] = b * 8192 + tcol[ti];
        qf[ti][0] = ld8(Q + (size_t)rowc[ti] * 512 + head * 64 + 8 * q4); qf[ti][1] = ld8(Q + (size_t)rowc[ti] * 512 + head * 64 + 32 + 8 * q4);
    }
    f32x4 Oc[2][4];
    {
        int cnt_col[2];
#pragma unroll
        for (int ti = 0; ti < 2; ++ti) cnt_col[ti] = tcol[ti] >= 31 ? ((tcol[ti] - 31) >> 4) + 1 : 0;
        const int tmax = t0 + 7; const int cmax = tmax >= 31 ? ((tmax - 31) >> 4) + 1 : 0;
        const int ntile = (cmax + 15) >> 4;
        const u16* kcb = KC + (size_t)bg * 512 * 64;
        float ml[2] = {-1e30f, -1e30f}, ll[2] = {0.f, 0.f};
#pragma unroll 1
        for (int kt = 0; kt < ntile; ++kt) {
            const u16* kp = kcb + (kt * 16 + cidx) * 64 + 8 * q4;
            const bf16x8 k0 = ld8(kp), k1 = ld8(kp + 32);
#pragma unroll
            for (int ti = 0; ti < 2; ++ti) {
                f32x4 st = mfma16(k0, qf[ti][0], (f32x4){0.f, 0.f, 0.f, 0.f});
                st = mfma16(k1, qf[ti][1], st);
                float sv[4]; float tm = -1e30f;
#pragma unroll
                for (int r = 0; r < 4; ++r) { const int n = kt * 16 + 4 * q4 + r; sv[r] = (n < cnt_col[ti]) ? st[r] : -1e30f; tm = fmaxf(tm, sv[r]); }
                const float mn = fmaxf(ml[ti], tm);
                float ps = 0.f;
#pragma unroll
                for (int r = 0; r < 4; ++r) ps += (sv[r] > -1e29f) ? ex2(sv[r] - mn) : 0.f;
                ll[ti] = ll[ti] * ex2(ml[ti] - mn) + ps; ml[ti] = mn;
            }
        }
        float mfin[2], inv[2];
#pragma unroll
        for (int ti = 0; ti < 2; ++ti) {
            mfin[ti] = colmax(ml[ti]);
            const float lsum = colsum(ll[ti] * ex2(ml[ti] - mfin[ti]));
            inv[ti] = (cnt_col[ti] > 0) ? 1.f / lsum : 0.f;
        }
#pragma unroll
        for (int ti = 0; ti < 2; ++ti)
#pragma unroll
            for (int mt = 0; mt < 4; ++mt) Oc[ti][mt] = (f32x4){0.f, 0.f, 0.f, 0.f};
        const int npair = (ntile + 1) >> 1;
#pragma unroll 1
        for (int kp2 = 0; kp2 < npair; ++kp2) {
            const int n0 = kp2 * 32;
            const u16* kp = kcb + (n0 + cidx) * 64 + 8 * q4;
            const bf16x8 ka0 = ld8(kp), ka1 = ld8(kp + 32), kb0 = ld8(kp + 1024), kb1 = ld8(kp + 1024 + 32);
            bf16x8 vf[4];
#pragma unroll
            for (int mt = 0; mt < 4; ++mt) vf[mt] = ld8(VCT + ((size_t)bg * 64 + 16 * mt + cidx) * 512 + n0 + 8 * q4);
#pragma unroll
            for (int ti = 0; ti < 2; ++ti) {
                float pa[4], pb_[4];
                f32x4 st = mfma16(ka0, qf[ti][0], (f32x4){0.f, 0.f, 0.f, 0.f});
                st = mfma16(ka1, qf[ti][1], st);
                f32x4 su = mfma16(kb0, qf[ti][0], (f32x4){0.f, 0.f, 0.f, 0.f});
                su = mfma16(kb1, qf[ti][1], su);
#pragma unroll
                for (int r = 0; r < 4; ++r) {
                    const int n = n0 + 4 * q4 + r;
                    pa[r] = (n < cnt_col[ti]) ? ex2(st[r] - mfin[ti]) * inv[ti] : 0.f;
                    pb_[r] = (n + 16 < cnt_col[ti]) ? ex2(su[r] - mfin[ti]) * inv[ti] : 0.f;
                }
                const float owna = quadsum(pa[0] + pa[1] + pa[2] + pa[3]), tha = quadsum(pa[3]);
                const float ownb = quadsum(pb_[0] + pb_[1] + pb_[2] + pb_[3]), thb = quadsum(pb_[3]);
                if (hr == 0) {
                    const int tk = 4 * ti + tokl;
                    const int sa = (n0 >> 2) + q4, sb2 = ((n0 + 16) >> 2) + q4;
                    impA[tk * 128 + sa] = owna; impB[tk * 132 + sa + 1] = tha;
                    impA[tk * 128 + sb2] = ownb; impB[tk * 132 + sb2 + 1] = thb;
                }
                union { bf16x8 v; unsigned u[4]; } pk;
                pk.u[0] = pack2(pa[0], pa[1]); pk.u[1] = pack2(pa[2], pa[3]); pk.u[2] = pack2(pb_[0], pb_[1]); pk.u[3] = pack2(pb_[2], pb_[3]);
#pragma unroll
                for (int mt = 0; mt < 4; ++mt) Oc[ti][mt] = mfma16(vf[mt], pk.v, Oc[ti][mt]);
            }
        }
#pragma unroll
        for (int ti = 0; ti < 2; ++ti) {
            const float gc = GATE[(size_t)rowc[ti] * 24 + head];
#pragma unroll
            for (int mt = 0; mt < 4; ++mt)
#pragma unroll
                for (int r = 0; r < 4; ++r) Oc[ti][mt][r] *= gc;
        }
    }
    lds_fence();
#pragma unroll 1
    for (int rd = 0; rd < 2; ++rd) {
        const int tk = 4 * rd + q4;
        unsigned m0 = 0u, m1 = 0u, m2 = 0u, m3 = 0u;
        if (cur < 16) { m0 = (2u << cur) - 1u; }
        else {
            unsigned key[8];
#pragma unroll
            for (int i = 0; i < 8; ++i) {
                const int sblk = cidx + 16 * i;
                const bool cand = (sblk >= 1) && (sblk <= cur - 2);
                const float v = impA[tk * 128 + sblk] + impB[tk * 132 + sblk];
                key[i] = cand ? ((__float_as_uint(v) & ~0x7Fu) | (unsigned)(127 - sblk)) : 0u;
            }
            int mysel = (cidx == 0) ? 0 : (cidx == 1 ? cur - 1 : (cidx == 2 ? cur : -1));
#pragma unroll 1
            for (int it = 0; it < 13; ++it) {
                unsigned mx = key[0];
#pragma unroll
                for (int i = 1; i < 8; ++i) mx = max(mx, key[i]);
                mx = max(mx, dppu<0xB1>(mx)); mx = max(mx, dppu<0x4E>(mx)); mx = max(mx, dppu<0x124>(mx)); mx = max(mx, dppu<0x128>(mx));
                const int sblk = 127 - (int)(mx & 127u);
#pragma unroll
                for (int i = 0; i < 8; ++i) key[i] = (key[i] == mx) ? 0u : key[i];
                if (cidx == it + 3) mysel = sblk;
            }
            const unsigned bit = 1u << (mysel & 31); const int wsel = mysel >> 5;
            m0 = row_or(wsel == 0 ? bit : 0u); m1 = row_or(wsel == 1 ? bit : 0u); m2 = row_or(wsel == 2 ? bit : 0u); m3 = row_or(wsel == 3 ? bit : 0u);
        }
        if (cidx < 4) selmask[tk * 4 + cidx] = (cidx == 0) ? m0 : (cidx == 1 ? m1 : (cidx == 2 ? m2 : m3));
    }
    lds_fence();
    f32x4* accl = (f32x4*)wl;
#pragma unroll
    for (int ti = 0; ti < 2; ++ti)
#pragma unroll
        for (int mt = 0; mt < 4; ++mt) accl[(ti * 4 + mt) * 64 + lane] = Oc[ti][mt];
    {
        float m[2] = {-1e30f, -1e30f}, l[2] = {0.f, 0.f}; f32x4 Os[2][4];
#pragma unroll
        for (int ti = 0; ti < 2; ++ti)
#pragma unroll
            for (int mt = 0; mt < 4; ++mt) Os[ti][mt] = (f32x4){0.f, 0.f, 0.f, 0.f};
        {
            unsigned ua[4], ub[4], bu[4];
#pragma unroll
            for (int w = 0; w < 4; ++w) {
                ua[w] = __builtin_amdgcn_readfirstlane(row_or(selmask[tokl * 4 + w]));
                ub[w] = __builtin_amdgcn_readfirstlane(row_or(selmask[(4 + tokl) * 4 + w]));
            }
            if (lane < 4) bm[wave * 4 + lane] = (lane == 0) ? (ua[0] | ub[0]) : (lane == 1 ? (ua[1] | ub[1]) : (lane == 2 ? (ua[2] | ub[2]) : (ua[3] | ub[3])));
            __syncthreads();
#pragma unroll
            for (int w = 0; w < 4; ++w) bu[w] = __builtin_amdgcn_readfirstlane(bm[w] | bm[4 + w] | bm[8 + w] | bm[12 + w]);
            const int lowc[2] = {-1, -1};
            nsa_branch_lds(lds, KSEL + (size_t)bg * 8192 * 64, VSELT + (size_t)bg * 64 * 8192, bu[0], bu[1], bu[2], bu[3], ua[0], ua[1], ua[2], ua[3], ub[0],
                           ub[1], ub[2], ub[3], selmask, tokl, tcol, lowc, qf, m, l, Os, q4, cidx, cur, -1);
        }
#pragma unroll
        for (int ti = 0; ti < 2; ++ti) {
            const float sc = GATE[(size_t)rowc[ti] * 24 + 8 + head] / colsum(l[ti]);
#pragma unroll
            for (int mt = 0; mt < 4; ++mt)
#pragma unroll
                for (int r = 0; r < 4; ++r) Os[ti][mt][r] *= sc;
        }
        lds_fence();
#pragma unroll
        for (int ti = 0; ti < 2; ++ti)
#pragma unroll
            for (int mt = 0; mt < 4; ++mt) { f32x4 a = accl[(ti * 4 + mt) * 64 + lane]; a += Os[ti][mt]; accl[(ti * 4 + mt) * 64 + lane] = a; }
    }
    {
        float m[2] = {-1e30f, -1e30f}, l[2] = {0.f, 0.f}; f32x4 Ow[2][4];
#pragma unroll
        for (int ti = 0; ti < 2; ++ti)
#pragma unroll
            for (int mt = 0; mt < 4; ++mt) Ow[ti][mt] = (f32x4){0.f, 0.f, 0.f, 0.f};
        int wb0 = (t0 - 511) >> 6; if (wb0 < 0) wb0 = 0;
        int wbb = (t0b - 511) >> 6; if (wbb < 0) wbb = 0;
        {
            unsigned uw[4], bu[4];
#pragma unroll
            for (int w = 0; w < 4; ++w) {
                const int hi = cur - 32 * w;
                unsigned mk = 0u, mkb = 0u;
                if (hi >= 0) {
                    const unsigned upper = (hi >= 31) ? 0xffffffffu : ((2u << hi) - 1u);
                    const int lo = wb0 - 32 * w, lob = wbb - 32 * w;
                    if (lo <= 31) mk = upper & ~((lo <= 0) ? 0u : ((1u << lo) - 1u));
                    if (lob <= 31) mkb = upper & ~((lob <= 0) ? 0u : ((1u << lob) - 1u));
                }
                uw[w] = mk; bu[w] = mkb;
            }
            const int lowc[2] = {tcol[0] - 512, tcol[1] - 512};
            nsa_branch_lds(lds, KWIN + (size_t)bg * 8192 * 64, VWINT + (size_t)bg * 64 * 8192, bu[0], bu[1], bu[2], bu[3], uw[0], uw[1], uw[2], uw[3], uw[0],
                           uw[1], uw[2], uw[3], nullptr, tokl, tcol, lowc, qf, m, l, Ow, q4, cidx, cur, t0 + 7 - 512);
        }
#pragma unroll
        for (int ti = 0; ti < 2; ++ti) {
            const float sc = GATE[(size_t)rowc[ti] * 24 + 16 + head] / colsum(l[ti]);
#pragma unroll
            for (int mt = 0; mt < 4; ++mt)
#pragma unroll
                for (int r = 0; r < 4; ++r) Ow[ti][mt][r] *= sc;
        }
        lds_fence();
#pragma unroll
        for (int ti = 0; ti < 2; ++ti)
#pragma unroll
            for (int mt = 0; mt < 4; ++mt) {
                const f32x4 a = accl[(ti * 4 + mt) * 64 + lane];
                const f32x4 o = Ow[ti][mt];
                u32x2 wv; wv[0] = pack2(a[0] + o[0], a[1] + o[1]); wv[1] = pack2(a[2] + o[2], a[3] + o[3]);
                *(u32x2*)(mix + (size_t)rowc[ti] * 1024 + 512 + head * 64 + 16 * mt + 4 * q4) = wv;
            }
    }


    __syncthreads();
}

DEV unsigned sortable(float f) { const unsigned b = __float_as_uint(f); return (b & 0x80000000u) ? ~b : (b | 0x80000000u); }
DEV float unsortable(unsigned u) { return __uint_as_float((u & 0x80000000u) ? (u ^ 0x80000000u) : ~u); }
template <int N> DEV unsigned kth16_threshold(const unsigned (&u)[N]) {
    unsigned T = 0;
    for (int bit = 31; bit >= 0; --bit) {
        const unsigned cand = T | (1u << bit);
        int cnt = 0;
#pragma unroll
        for (int i = 0; i < N; ++i) cnt += (u[i] >= cand) ? 1 : 0;
        cnt = colsumi(cnt);
        if (cnt >= 16) T = cand;
    }
    return T;
}
template <int N, class F> DEV void compact16(const unsigned (&u)[N], unsigned T, int q4, int cidx, F emit) {
    int cgt = 0, ceq = 0;
#pragma unroll
    for (int i = 0; i < N; ++i) { cgt += (u[i] > T) ? 1 : 0; ceq += (u[i] == T) ? 1 : 0; }
    const int g0 = __shfl(cgt, cidx), g1 = __shfl(cgt, cidx + 16), g2 = __shfl(cgt, cidx + 32), g3 = __shfl(cgt, cidx + 48);
    const int e0 = __shfl(ceq, cidx), e1 = __shfl(ceq, cidx + 16), e2 = __shfl(ceq, cidx + 32);
    int pg = (q4 > 0 ? g0 : 0) + (q4 > 1 ? g1 : 0) + (q4 > 2 ? g2 : 0);
    int pe = g0 + g1 + g2 + g3 + (q4 > 0 ? e0 : 0) + (q4 > 1 ? e1 : 0) + (q4 > 2 ? e2 : 0);
#pragma unroll
    for (int i = 0; i < N; ++i) {
        if (u[i] > T) { emit(i, pg); ++pg; }
        else if (u[i] == T) { if (pe < 16) emit(i, pe); ++pe; }
    }
}

DEV void peer_topk_task(const Params& p, int l, int task, float* wl) {
    unsigned char* ws = p.ws;
    const u16* QP = (const u16*)(ws + OFF_QP);
    const u16* K12 = (const u16*)(ws + OFF_K12) + (size_t)l * 2 * 16384;
    int* PIDX = (int*)(ws + OFF_PIDX); float* PGW = (float*)(ws + OFF_PGW);
    const int lane = TID() & 63, q4 = lane >> 4, cidx = lane & 15;
    const int tq = task * 2 + (cidx >> 3), hh = cidx & 7;
    float* vv[2] = {wl, wl + 512}; int* ii[2] = {(int*)(wl + 256), (int*)(wl + 768)};
    float* fs = wl + 1024; int* fi = (int*)(wl + 1280);
#pragma unroll
    for (int hf = 0; hf < 2; ++hf) {
        bf16x8 qf[4];
#pragma unroll
        for (int s = 0; s < 4; ++s) qf[s] = ld8(QP + (size_t)tq * 2048 + hh * 256 + hf * 128 + 32 * s + 8 * q4);
        unsigned u[32];
        const u16* kb = K12 + hf * 16384;
#pragma unroll
        for (int kt = 0; kt < 8; ++kt) {
            f32x4 st = (f32x4){0.f, 0.f, 0.f, 0.f};
#pragma unroll
            for (int s = 0; s < 4; ++s) st = mfma16(ld8(kb + (kt * 16 + cidx) * 128 + 32 * s + 8 * q4), qf[s], st);
#pragma unroll
            for (int r = 0; r < 4; ++r) u[kt * 4 + r] = sortable(st[r]);
        }
        const unsigned T = kth16_threshold<32>(u);
        float* vo = vv[hf]; int* io = ii[hf];
        compact16<32>(u, T, q4, cidx, [&](int i, int pos) { vo[cidx * 16 + pos] = unsortable(u[i]); io[cidx * 16 + pos] = 16 * (i >> 2) + 4 * q4 + (i & 3); });
    }
    lds_fence();
    {
        unsigned u[64];
        float v2r[16];
#pragma unroll
        for (int j = 0; j < 16; ++j) v2r[j] = vv[1][cidx * 16 + j];
#pragma unroll
        for (int a = 0; a < 4; ++a) {
            const float v1a = vv[0][cidx * 16 + 4 * q4 + a];
#pragma unroll
            for (int j = 0; j < 16; ++j) u[a * 16 + j] = sortable(v1a + v2r[j]);
        }
        const unsigned T = kth16_threshold<64>(u);
        compact16<64>(u, T, q4, cidx, [&](int i, int pos) { fs[cidx * 16 + pos] = unsortable(u[i]); fi[cidx * 16 + pos] = (4 * q4 + (i >> 4)) * 16 + (i & 15); });
    }
    lds_fence();
    {
        float s4[4]; int c4[4];
#pragma unroll
        for (int k = 0; k < 4; ++k) { s4[k] = fs[cidx * 16 + 4 * q4 + k]; c4[k] = fi[cidx * 16 + 4 * q4 + k]; }
        float mx = fmaxf(fmaxf(s4[0], s4[1]), fmaxf(s4[2], s4[3]));
        mx = colmax(mx);
        float e4[4]; float sm = 0.f;
#pragma unroll
        for (int k = 0; k < 4; ++k) { e4[k] = __expf(s4[k] - mx); sm += e4[k]; }
        sm = colsum(sm);
        const float inv = 1.f / sm;
        int4 eo; float4 go;
        eo.x = ii[0][cidx * 16 + (c4[0] >> 4)] * 128 + ii[1][cidx * 16 + (c4[0] & 15)];
        eo.y = ii[0][cidx * 16 + (c4[1] >> 4)] * 128 + ii[1][cidx * 16 + (c4[1] & 15)];
        eo.z = ii[0][cidx * 16 + (c4[2] >> 4)] * 128 + ii[1][cidx * 16 + (c4[2] & 15)];
        eo.w = ii[0][cidx * 16 + (c4[3] >> 4)] * 128 + ii[1][cidx * 16 + (c4[3] & 15)];
        go.x = e4[0] * inv; go.y = e4[1] * inv; go.z = e4[2] * inv; go.w = e4[3] * inv;
        const size_t o = ((size_t)tq * 8 + hh) * 16 + 4 * q4;
        *(int4*)(PIDX + o) = eo; *(float4*)(PGW + o) = go;
    }
    lds_fence();
}


template <int N> DEV void ltmask(const float (&v)[N], float x, unsigned (&mk)[N / 32]) {
#pragma unroll
    for (int w = 0; w < N / 32; ++w) {
        unsigned a0 = 0u, a1 = 0u, a2 = 0u, a3 = 0u;
#pragma unroll
        for (int i = 0; i < 8; ++i) {
            a0 = __builtin_amdgcn_alignbit(a0, __float_as_uint(v[w * 32 + i] - x), 31);
            a1 = __builtin_amdgcn_alignbit(a1, __float_as_uint(v[w * 32 + 8 + i] - x), 31);
            a2 = __builtin_amdgcn_alignbit(a2, __float_as_uint(v[w * 32 + 16 + i] - x), 31);
            a3 = __builtin_amdgcn_alignbit(a3, __float_as_uint(v[w * 32 + 24 + i] - x), 31);
        }
        mk[w] = (a0 << 24) | (a1 << 16) | (a2 << 8) | a3;
    }
}
template <int N> DEV int count_ge(const float (&v)[N], float x) {
    unsigned mk[N / 32]; ltmask<N>(v, x, mk);
    int lt = 0;
#pragma unroll
    for (int w = 0; w < N / 32; ++w) lt += __popc(mk[w]);
    return colsumi(N - lt);
}
template <int N> DEV void refine16(const float (&v)[N], float lo, int clo, float hi, int chi, float& lo_o, float& hi_o) {
    bool done = false;
    if (clo == 16) { hi = lo; done = true; }
#pragma unroll 1
    for (int it = 0; it < 200; ++it) {
        if (__all(done)) break;
        float f = 0.5f;
        if (!(it & 1)) { f = ((float)clo - 15.5f) / (float)(clo - chi); f = fminf(fmaxf(f, 0.04f), 0.96f); }
        const float mid = lo + (hi - lo) * f;
        const bool stuck = !(mid > lo && mid < hi);
        const int c = count_ge<N>(v, mid);
        if (!done) {
            if (stuck) { if (f != 0.5f) {   } else done = true; }
            else if (c == 16) { lo = mid; hi = mid; done = true; }
            else if (c > 16) { lo = mid; clo = c; }
            else { hi = mid; chi = c; }
        }
    }
    lo_o = lo; hi_o = hi;
}
template <int N> DEV void select16(const float (&v)[N], float& lo_o, float& hi_o) {
    float mx = v[0], mn = v[0], sm = v[0];
#pragma unroll
    for (int i = 1; i < N; ++i) { mx = fmaxf(mx, v[i]); mn = fminf(mn, v[i]); sm += v[i]; }
    mx = colmax(mx); mn = -colmax(-mn); sm = colsum(sm);
    const float hi = mx + fabsf(mx) * 1e-6f + 1e-30f;
    float lo = sm * (1.f / (4.f * N));
    int clo = count_ge<N>(v, lo);
    if (clo < 16) { lo = mn; clo = 4 * N; }
    refine16<N>(v, lo, clo, hi, 0, lo_o, hi_o);
}
DEV void col_offsets(int cntA, int cntT, int q4, int cidx, int& offA, int& offT) {
    const int g0 = __shfl(cntA, cidx), g1 = __shfl(cntA, cidx + 16), g2 = __shfl(cntA, cidx + 32), g3 = __shfl(cntA, cidx + 48);
    const int e0 = __shfl(cntT, cidx), e1 = __shfl(cntT, cidx + 16), e2 = __shfl(cntT, cidx + 32);
    offA = (q4 > 0 ? g0 : 0) + (q4 > 1 ? g1 : 0) + (q4 > 2 ? g2 : 0);
    offT = g0 + g1 + g2 + g3 + (q4 > 0 ? e0 : 0) + (q4 > 1 ? e1 : 0) + (q4 > 2 ? e2 : 0);
}

DEV void peer_topk_task2(const Params& p, int l, int task, float* wl) {
    unsigned char* ws = p.ws;
    const u16* QP = (const u16*)(ws + OFF_QP);
    const u16* K12 = (const u16*)(ws + OFF_K12) + (size_t)l * 2 * 16384;
    const int lane = TID() & 63, q4 = lane >> 4, cidx = lane & 15;
    const int tq = task * 2 + (cidx >> 3), hh = cidx & 7;
    float* scl = wl;
    float* lst = wl + 2048;
    float* vv[2] = {lst, lst + 512}; int* ii[2] = {(int*)(lst + 256), (int*)(lst + 768)};
    float* fs = lst + 1024; int* fi = (int*)(lst + 1280);
#pragma unroll 1
    for (int hf = 0; hf < 2; ++hf) {
        bf16x8 qf[4];
#pragma unroll
        for (int s2 = 0; s2 < 4; ++s2) qf[s2] = ld8(QP + (size_t)tq * 2048 + hh * 256 + hf * 128 + 32 * s2 + 8 * q4);
        float sc[32];
        const u16* kb = K12 + hf * 16384;
#pragma unroll
        for (int kt = 0; kt < 8; ++kt) {
            f32x4 st = (f32x4){0.f, 0.f, 0.f, 0.f};
#pragma unroll
            for (int s2 = 0; s2 < 4; ++s2) st = mfma16(ld8(kb + (kt * 16 + cidx) * 128 + 32 * s2 + 8 * q4), qf[s2], st);
#pragma unroll
            for (int r = 0; r < 4; ++r) sc[kt * 4 + r] = st[r];
            *(f32x4*)(scl + cidx * 128 + 16 * kt + 4 * q4) = st;
        }
        float lo, hi; select16<32>(sc, lo, hi);
        unsigned mh[1], ml_[1];
        ltmask<32>(sc, hi, mh); ltmask<32>(sc, lo, ml_);
        unsigned mA = ~mh[0], mT = ~ml_[0] & mh[0];
        int offA, offT; col_offsets(__popc(mA), __popc(mT), q4, cidx, offA, offT);
        float* vo = hf ? vv[1] : vv[0]; int* io = hf ? ii[1] : ii[0];
        lds_fence();
        while (__any(mA != 0u)) {
            if (mA) {
                const int i = __clz(mA); mA &= ~(0x80000000u >> i);
                const int n = 16 * (i >> 2) + 4 * q4 + (i & 3);
                vo[cidx * 16 + offA] = scl[cidx * 128 + n]; io[cidx * 16 + offA] = n; ++offA;
            }
        }
        while (__any(mT != 0u)) {
            if (mT) {
                const int i = __clz(mT); mT &= ~(0x80000000u >> i);
                const int n = 16 * (i >> 2) + 4 * q4 + (i & 3);
                if (offT < 16) { vo[cidx * 16 + offT] = scl[cidx * 128 + n]; io[cidx * 16 + offT] = n; }
                ++offT;
            }
        }
        lds_fence();
    }
    {
        float cand[64];
        float v2r[16];
#pragma unroll
        for (int j = 0; j < 16; ++j) v2r[j] = vv[1][cidx * 16 + j];
#pragma unroll
        for (int a = 0; a < 4; ++a) {
            const float v1a = vv[0][cidx * 16 + 4 * q4 + a];
#pragma unroll
            for (int j = 0; j < 16; ++j) cand[a * 16 + j] = v1a + v2r[j];
        }
        float lo, hi;
        {
            float v2mx = v2r[0], v2mn = v2r[0];
#pragma unroll
            for (int j = 1; j < 16; ++j) { v2mx = fmaxf(v2mx, v2r[j]); v2mn = fminf(v2mn, v2r[j]); }
            float v1mx = fmaxf(fmaxf(vv[0][cidx * 16 + 4 * q4], vv[0][cidx * 16 + 4 * q4 + 1]), fmaxf(vv[0][cidx * 16 + 4 * q4 + 2], vv[0][cidx * 16 + 4 * q4 + 3]));
            float v1mn = fminf(fminf(vv[0][cidx * 16 + 4 * q4], vv[0][cidx * 16 + 4 * q4 + 1]), fminf(vv[0][cidx * 16 + 4 * q4 + 2], vv[0][cidx * 16 + 4 * q4 + 3]));
            v1mx = colmax(v1mx); v1mn = -colmax(-v1mn);
            const float smax = v1mx + v2mx;
            const float hi0 = smax + fabsf(smax) * 1e-6f + 1e-30f;
            const float lo0 = fmaxf(v1mn + v2mx, v1mx + v2mn);
            const int c0 = count_ge<64>(cand, lo0);
            refine16<64>(cand, lo0, c0, hi0, 0, lo, hi);
        }
        unsigned mh[2], ml_[2];
        ltmask<64>(cand, hi, mh); ltmask<64>(cand, lo, ml_);
        unsigned mA0 = ~mh[0], mA1 = ~mh[1], mT0 = ~ml_[0] & mh[0], mT1 = ~ml_[1] & mh[1];
        int offA, offT; col_offsets(__popc(mA0) + __popc(mA1), __popc(mT0) + __popc(mT1), q4, cidx, offA, offT);
#pragma unroll
        for (int w = 0; w < 2; ++w) {
            unsigned mA = w ? mA1 : mA0;
            while (__any(mA != 0u)) {
                if (mA) {
                    const int i = __clz(mA); mA &= ~(0x80000000u >> i);
                    const int it = w * 32 + i; const int ci = (4 * q4 + (it >> 4)) * 16 + (it & 15);
                    fs[cidx * 16 + offA] = vv[0][cidx * 16 + (ci >> 4)] + vv[1][cidx * 16 + (ci & 15)]; fi[cidx * 16 + offA] = ci; ++offA;
                }
            }
        }
#pragma unroll
        for (int w = 0; w < 2; ++w) {
            unsigned mT = w ? mT1 : mT0;
            while (__any(mT != 0u)) {
                if (mT) {
                    const int i = __clz(mT); mT &= ~(0x80000000u >> i);
                    const int it = w * 32 + i; const int ci = (4 * q4 + (it >> 4)) * 16 + (it & 15);
                    if (offT < 16) { fs[cidx * 16 + offT] = vv[0][cidx * 16 + (ci >> 4)] + vv[1][cidx * 16 + (ci & 15)]; fi[cidx * 16 + offT] = ci; }
                    ++offT;
                }
            }
        }
    }
    lds_fence();
    {
        float s4[4]; int c4[4];
#pragma unroll
        for (int k = 0; k < 4; ++k) { s4[k] = fs[cidx * 16 + 4 * q4 + k]; c4[k] = fi[cidx * 16 + 4 * q4 + k]; }
        float mx = fmaxf(fmaxf(s4[0], s4[1]), fmaxf(s4[2], s4[3]));
        mx = colmax(mx);
        float e4[4]; float sm = 0.f;
#pragma unroll
        for (int k = 0; k < 4; ++k) { e4[k] = __expf(s4[k] - mx); sm += e4[k]; }
        sm = colsum(sm);
        const float inv = 1.f / sm;
        int4 eo; float4 go;
        eo.x = ii[0][cidx * 16 + (c4[0] >> 4)] * 128 + ii[1][cidx * 16 + (c4[0] & 15)];
        eo.y = ii[0][cidx * 16 + (c4[1] >> 4)] * 128 + ii[1][cidx * 16 + (c4[1] & 15)];
        eo.z = ii[0][cidx * 16 + (c4[2] >> 4)] * 128 + ii[1][cidx * 16 + (c4[2] & 15)];
        eo.w = ii[0][cidx * 16 + (c4[3] >> 4)] * 128 + ii[1][cidx * 16 + (c4[3] & 15)];
        go.x = e4[0] * inv; go.y = e4[1] * inv; go.z = e4[2] * inv; go.w = e4[3] * inv;
        int* eol = (int*)(wl + 3584); float* gol = wl + 3584 + 256;
        *(int4*)(eol + cidx * 16 + 4 * q4) = eo; *(float4*)(gol + cidx * 16 + 4 * q4) = go;
    }
    lds_fence();
}

DEV float gelu_exact(float x) { return 0.5f * x * (1.f + erff(x * 0.70710678118654752f)); }
DEV void unpack8(const bf16x8 v, float* f) {
    union { bf16x8 v; unsigned u[4]; } c; c.v = v;
#pragma unroll
    for (int i = 0; i < 4; ++i) { f[2 * i] = bflo(c.u[i]); f[2 * i + 1] = bfhi(c.u[i]); }
}
DEV void peer_experts_token(const Params& p, int l, int tok, const int* el_src, const float* w_src) {
    unsigned char* ws = p.ws;
    const u16* H = (const u16*)(ws + OFF_H);
    u16* Hw = (u16*)(ws + OFF_H);
    const unsigned char* U8 = ws + OFF_U8;
    const unsigned char* V8 = ws + OFF_U8 + 16 * MiB;
    const float* SU = (const float*)(ws + OFF_UVS);
    const float* SV = (const float*)(ws + OFF_UVS) + 16384;
    const float* mod = (const float*)(ws + OFF_MOD);
    const float* g2 = mod + l * 4 * 6144 + 5 * 1024;
    const int lane = TID() & 63;
    {
        const int b = tok >> 13;
        float acc[16];
#pragma unroll
        for (int i = 0; i < 16; ++i) acc[i] = 0.f;
#if EN_PEER
        unsigned hp[4]; float shq; int corr0;
        {
            float hx[16];
            unpack8(ld8(H + (size_t)tok * 1024 + 16 * lane), hx);
            unpack8(ld8(H + (size_t)tok * 1024 + 16 * lane + 8), hx + 8);
            float amax = 0.f;
#pragma unroll
            for (int i = 0; i < 16; ++i) amax = fmaxf(amax, fabsf(hx[i]));
            amax = wave_max(amax);
            shq = amax > 0.f ? amax * (1.f / 127.f) : 1.f;
            const float inv = 1.f / shq;
            int hsum = 0;
#pragma unroll
            for (int i = 0; i < 4; ++i) {
                const int a = __float2int_rn(hx[4 * i] * inv) + 128, b2 = __float2int_rn(hx[4 * i + 1] * inv) + 128, c = __float2int_rn(hx[4 * i + 2] * inv) + 128,
                          d = __float2int_rn(hx[4 * i + 3] * inv) + 128;
                hp[i] = (unsigned)a | ((unsigned)b2 << 8) | ((unsigned)c << 16) | ((unsigned)d << 24);
                hsum += a + b2 + c + d;
            }
            hsum = wave_sum_i(hsum);
            corr0 = 128 * 128 * 1024 - 128 * hsum;
        }
        const int* RSU = (const int*)(ws + OFF_UVS) + 2 * 16384;
        float corr = 0.f;
#pragma unroll 1
        for (int hh = 0; hh < 8; ++hh) {
            const int el = el_src[hh * 16 + (lane & 15)];
            const float wgt = w_src[hh * 16 + (lane & 15)];
            const float sul = SU[el] * shq, wsl = wgt * SV[el];
            const int rsl = corr0 - 128 * RSU[el];
#pragma unroll 1
            for (int k0 = 0; k0 < 16; k0 += 8) {
                u32x4 uq[8], vq[8];
#pragma unroll
                for (int k = 0; k < 8; ++k) {
                    const int e = __builtin_amdgcn_readlane(el, k0 + k);
                    uq[k] = *(const u32x4*)(U8 + (size_t)e * 1024 + 16 * lane);
                    vq[k] = *(const u32x4*)(V8 + (size_t)e * 1024 + 16 * lane);
                }
                int dpart[8];
#pragma unroll
                for (int k = 0; k < 8; ++k) {
                    unsigned di = 0u;
#pragma unroll
                    for (int i = 0; i < 4; ++i) di = __builtin_amdgcn_udot4(uq[k][i], hp[i], di, false);
                    dpart[k] = (int)di;
                }
                const int dsum = reduce8_i(dpart);
                const int srcl = k0 + (lane >> 3);
                const float sul_e = __shfl(sul, srcl), wsl_e = __shfl(wsl, srcl); const int rsl_e = __shfl(rsl, srcl);
                const float actl = gelu_exact((float)(dsum + rsl_e) * sul_e) * wsl_e;
#pragma unroll
                for (int k = 0; k < 8; ++k) {
                    const float act = __int_as_float(__builtin_amdgcn_readlane(__float_as_int(actl), 8 * k));
                    corr += act * 128.f;
#pragma unroll
                    for (int i = 0; i < 4; ++i) {
                        const unsigned w = vq[k][i];
                        acc[4 * i] += act * (float)(w & 0xffu); acc[4 * i + 1] += act * (float)((w >> 8) & 0xffu);
                        acc[4 * i + 2] += act * (float)((w >> 16) & 0xffu); acc[4 * i + 3] += act * (float)(w >> 24);
                    }
                }
            }
        }
#pragma unroll
        for (int i = 0; i < 16; ++i) acc[i] -= corr;
#endif
        const int k = 16 * lane;
        float xn[16]; float ss = 0.f;
#pragma unroll
        for (int i = 0; i < 4; ++i) {
            const float4 x0 = *(const float4*)(p.out + (size_t)tok * 1024 + k + 4 * i);
            const float4 ga = *(const float4*)(g2 + b * 6144 + k + 4 * i);
            xn[4 * i] = x0.x + ga.x * acc[4 * i]; xn[4 * i + 1] = x0.y + ga.y * acc[4 * i + 1];
            xn[4 * i + 2] = x0.z + ga.z * acc[4 * i + 2]; xn[4 * i + 3] = x0.w + ga.w * acc[4 * i + 3];
        }
#pragma unroll
        for (int i = 0; i < 16; ++i) ss += xn[i] * xn[i];
        ss = wave_sum(ss);
        const float rs = rsqrtf(ss * (1.f / 1024.f) + 1e-6f);
        if (l == 0) {
            const float* n1g = p.in[I_N1G] + 1024; const float* sh = mod + 4 * 6144 + b * 6144; const float* sc = sh + 1024;
            float hv[16];
#pragma unroll
            for (int i = 0; i < 4; ++i) {
                *(float4*)(p.out + (size_t)tok * 1024 + k + 4 * i) = (float4){xn[4 * i], xn[4 * i + 1], xn[4 * i + 2], xn[4 * i + 3]};
                const float4 gg = *(const float4*)(n1g + k + 4 * i), s1 = *(const float4*)(sc + k + 4 * i), s0 = *(const float4*)(sh + k + 4 * i);
                hv[4 * i] = xn[4 * i] * rs * gg.x * (1.f + s1.x) + s0.x; hv[4 * i + 1] = xn[4 * i + 1] * rs * gg.y * (1.f + s1.y) + s0.y;
                hv[4 * i + 2] = xn[4 * i + 2] * rs * gg.z * (1.f + s1.z) + s0.z; hv[4 * i + 3] = xn[4 * i + 3] * rs * gg.w * (1.f + s1.w) + s0.w;
            }
            u32x4 w0, w1;
#pragma unroll
            for (int i = 0; i < 4; ++i) { w0[i] = pack2(hv[2 * i], hv[2 * i + 1]); w1[i] = pack2(hv[8 + 2 * i], hv[8 + 2 * i + 1]); }
            *(u32x4*)(Hw + (size_t)tok * 1024 + k) = w0; *(u32x4*)(Hw + (size_t)tok * 1024 + k + 8) = w1;
        } else {
            const float* fg = p.in[I_FG];
#pragma unroll
            for (int i = 0; i < 4; ++i) {
                const float4 gg = *(const float4*)(fg + k + 4 * i);
                *(float4*)(p.out + (size_t)tok * 1024 + k + 4 * i) = (float4){xn[4 * i] * rs * gg.x, xn[4 * i + 1] * rs * gg.y, xn[4 * i + 2] * rs * gg.z, xn[4 * i + 3] * rs * gg.w};
            }
        }
    }
}

constexpr int NPH = 20;

__global__ void __launch_bounds__(256, 2) mega(Params p) {
    __shared__ __attribute__((aligned(16))) unsigned char lds[81920 - 128];
    __shared__ int misc[8];
    int* qslot = misc;
    cg::grid_group grid = cg::this_grid();
    if (threadIdx.x < 8) misc[threadIdx.x] = 0;
    __syncthreads();
    XcdBarrier xbar = xcd_barrier_post((unsigned*)(p.ws + OFF_BAR), (volatile unsigned*)(misc + 4));
    unsigned char* ws = p.ws;
    const float* mod = (const float*)(ws + OFF_MOD);
    unsigned* ctl = (unsigned*)(ws + OFF_CTL);
    const int G = gridDim.x, bx = BID();
    for (int ph = p.ph_lo; ph < p.ph_hi; ++ph) {
        if (ph >= 2 && (ph - 2) % 9 == 8) continue;
        if (ph == 0) {
            phase_prep(p, lds);
        } else if (ph == 1) {
            phase_norm(p.in[I_X], p.in[I_N1G], mod + 0 * 1024, mod + 1 * 1024, (u16*)(ws + OFF_H));
        } else {
            const int l = (ph - 2) / 9, sp = (ph - 2) % 9;
            const float* modl = mod + l * 4 * 6144;
            if (sp == 0) {
                EpiInProj e{(u16*)(ws + OFF_PCONV), (u16*)(ws + OFF_PRWKV), (u16*)(ws + OFF_Q), (u16*)(ws + OFF_KV), (float*)(ws + OFF_GATE)};
                gemm_phase((const u16*)(ws + OFF_H), 1024, (const u16*)(ws + OFF_WIN) + (size_t)l * NINP * 1024, 1024, 256, 8, 1024, e, lds, bx, G, 0, 4);
            } else if (sp == 1) {
#if EN_RWKV
                for (;;) { const int t = block_next(ctl + QW(l, Q_RWP), qslot); if (t >= NTOK / 16) break; rwkv_prep_tile2(p, l, t, lds); }
#endif
            } else if (sp == 2) {
#if EN_RWKV
                if (bx < 64) { __builtin_amdgcn_s_setprio(3); rwkv_scan(p, bx, lds); __builtin_amdgcn_s_setprio(0); }
#endif
                unsigned* cdone = ctl + QW(l, 5);
                unsigned* gdone = ctl + QW(l, 6);
                if (bx >= 64) {
                    EpiInProj e{(u16*)(ws + OFF_PCONV), (u16*)(ws + OFF_PRWKV), (u16*)(ws + OFF_Q), (u16*)(ws + OFF_KV), (float*)(ws + OFF_GATE)};
                    gemm_phase((const u16*)(ws + OFF_H), 1024, (const u16*)(ws + OFF_WIN) + (size_t)l * NINP * 1024, 1024, 256, 15, 1024, e, lds, bx - 64, G - 64, 4, 8, false);
                    asm volatile("s_waitcnt vmcnt(0)" ::: "memory");
                    __syncthreads();
                    if (threadIdx.x == 0) {
                        __builtin_amdgcn_fence(__ATOMIC_RELEASE, "agent");
                        asm volatile("s_waitcnt vmcnt(0)" ::: "memory");
                        __hip_atomic_fetch_add(gdone, 1u, __ATOMIC_RELAXED, __HIP_MEMORY_SCOPE_AGENT);
                    }
                }
                __syncthreads();
                if (threadIdx.x == 0) {
                    unsigned sp_ = 0;
                    while (__hip_atomic_load(gdone, __ATOMIC_RELAXED, __HIP_MEMORY_SCOPE_AGENT) < (unsigned)(G - 64)) { __builtin_amdgcn_s_sleep(8); if (++sp_ > (1u << 24)) break; }
                    __builtin_amdgcn_fence(__ATOMIC_ACQUIRE, "agent");
                    asm volatile("s_waitcnt vmcnt(0)" ::: "memory");
                }
                __syncthreads();
                if (bx >= 64 && bx < 128) {
                    const u16* KVb = (const u16*)(ws + OFF_KV);
                    if (bx < 96) {
                        EpiCompress ek{(const float*)(ws + OFF_CBP) + (l * 2 + 0) * 2048, p.in[I_CKW2] + (size_t)l * 8192, (u16*)(ws + OFF_KC), 0, lds};
                        gemm_phase(KVb, 1024, (const u16*)(ws + OFF_CW1) + (size_t)(l * 2 + 0) * 128 * 2048, 2048, 32, 1, 2048, ek, lds, bx - 64, 1 << 20);
                    } else {
                        EpiCompress ev{(const float*)(ws + OFF_CBP) + (l * 2 + 1) * 2048, p.in[I_CVW2] + (size_t)l * 8192, (u16*)(ws + OFF_VCT), 1, lds};
                        gemm_phase(KVb + 4194304, 1024, (const u16*)(ws + OFF_CW1) + (size_t)(l * 2 + 1) * 128 * 2048, 2048, 32, 1, 2048, ev, lds, bx - 96, 1 << 20);
                    }
                    asm volatile("s_waitcnt vmcnt(0)" ::: "memory");
                    __syncthreads();
                    if (threadIdx.x == 0) {
                        __builtin_amdgcn_fence(__ATOMIC_RELEASE, "agent");
                        asm volatile("s_waitcnt vmcnt(0)" ::: "memory");
                        __hip_atomic_fetch_add(cdone, 1u, __ATOMIC_RELAXED, __HIP_MEMORY_SCOPE_AGENT);
                    }
                }
#if EN_CONV
                for (;;) { const int t = block_next(ctl + QW(l, Q_CONV), qslot); if (t >= NTOK / 32) break; conv_tile(p, l, t, lds); }
#else
                zero_mix_cols(p, 0, 256);
#endif
                __syncthreads();
                if (threadIdx.x == 0) {
                    unsigned sp_ = 0;
                    while (__hip_atomic_load(cdone, __ATOMIC_RELAXED, __HIP_MEMORY_SCOPE_AGENT) < 64u) { __builtin_amdgcn_s_sleep(8); if (++sp_ > (1u << 24)) break; }
                    __builtin_amdgcn_fence(__ATOMIC_ACQUIRE, "agent");
                    asm volatile("s_waitcnt vmcnt(0)" ::: "memory");
                }
                __syncthreads();
                for (;;) { const int t = block_next(ctl + QW(l, Q_NSA), qslot); if (t >= 2048) break; nsa_block_task(p, t, lds); }
                if (l == 0) {
                    float* fl = (float*)lds;
                    for (;;) {
                        const int t = block_next(ctl + QW(0, 0), qslot); if (t >= 1536) break;
                        if (t < 512) { const int l2 = t >> 8, r = t & 255; transpose_tile(p.in[I_WOUT] + (size_t)l2 * 1024 * 1024, 1024, (u16*)(ws + OFF_WOUT) + (size_t)l2 * 1024 * 1024, 1024, r >> 4, r & 15, fl); }
                        else { const int u = t - 512; const int l2 = u >> 9, r = u & 511; transpose_tile(p.in[I_PWQ] + (size_t)l2 * 1024 * 2048, 2048, (u16*)(ws + OFF_WQ) + (size_t)l2 * 2048 * 1024, 1024, r >> 5, r & 31, fl); }
                    }
                }
                for (;;) {
                    const int t = block_next(ctl + QW(l, 7), qslot); if (t >= 1024) break;
                    const int tb = t >> 9, r0 = (t & 511) * 32;
                    convert_rows_task(p.in[tb ? I_PV : I_PU] + (size_t)l * 16384 * 1024, ws + OFF_U8 + (size_t)tb * 16 * MiB, (float*)(ws + OFF_UVS) + tb * 16384,
                                      tb ? nullptr : (int*)(ws + OFF_UVS) + 2 * 16384, r0);
                }
            } else if (sp == 3) {
#if EN_RWKV
                phase_rwkv_post(p, l);
#else
                zero_mix_cols(p, 256, 256);
#endif
            } else if (sp == 4) {
                EpiOutProj e{l == 0 ? p.in[I_X] : p.out, p.out, modl + 2 * 1024};
                gemm_phase((const u16*)(ws + OFF_MIX), 1024, (const u16*)(ws + OFF_WOUT) + (size_t)l * 1024 * 1024, 1024, 256, 8, 1024, e, lds, bx, G);
            } else if (sp == 5) {
#if EN_PEER
                phase_norm(p.out, p.in[I_N2G] + l * 1024, modl + 3 * 1024, modl + 4 * 1024, (u16*)(ws + OFF_H));
#endif
            } else if (sp == 6) {
#if EN_PEER
                EpiStoreBf16 e{(u16*)(ws + OFF_QP), 2048};
                gemm_phase((const u16*)(ws + OFF_H), 1024, (const u16*)(ws + OFF_WQ) + (size_t)l * 2048 * 1024, 1024, 256, 16, 1024, e, lds, bx, G);
#endif
            } else if (sp == 7) {
#if EN_PEER
                float* wl = (float*)lds + (TID() >> 6) * 4096;
                for (int t = bx * 4 + (TID() >> 6); t < NTOK / 2; t += G * 4) {
                    peer_topk_task2(p, l, t, wl);
                    peer_experts_token(p, l, 2 * t, (const int*)(wl + 3584), wl + 3584 + 256);
                    peer_experts_token(p, l, 2 * t + 1, (const int*)(wl + 3584) + 128, wl + 3584 + 256 + 128);
                    lds_fence();
                }
#endif
            }
        }
        if (ph + 1 < p.ph_hi) { if (ph == 0) grid.sync(); else xcd_barrier(xbar); }
    }
}

extern "C" void kernel_launch(void* const* d_in, const int* in_sizes, int n_in, void* d_out, int out_size, void* d_ws, size_t ws_size,
                              hipStream_t stream) {
    static int grid_blocks = 0;
    if (!grid_blocks) {
        int dev = 0, cus = 0, per_cu = 0;
        hipGetDevice(&dev);
        hipDeviceGetAttribute(&cus, hipDeviceAttributeMultiprocessorCount, dev);
        hipOccupancyMaxActiveBlocksPerMultiprocessor(&per_cu, (const void*)mega, 256, 0);
        if (per_cu > 2) per_cu = 2;
        if (per_cu < 1) per_cu = 1;
        grid_blocks = cus * per_cu;
        if (ws_size < WS_NEED) fprintf(stderr, "kernel_launch: workspace too small: %zu < %zu\n", ws_size, (size_t)WS_NEED);
    }
    hipMemsetAsync((char*)d_ws + OFF_CTL, 0, CTL_ZERO_BYTES, stream);
    Params p{};
    for (int i = 0; i < 35; ++i) p.in[i] = (const float*)d_in[i];
    p.out = (float*)d_out;
    p.ws = (unsigned char*)d_ws;
#if MULTI_LAUNCH
    for (int ph = 0; ph < NPH; ++ph) {
        p.ph_lo = ph; p.ph_hi = ph + 1;
        hipLaunchKernelGGL(mega, dim3(grid_blocks), dim3(256), 0, stream, p);
    }
#else
    p.ph_lo = 0; p.ph_hi = NPH;
    void* args[] = {&p};
    hipError_t e = hipLaunchCooperativeKernel((const void*)mega, dim3(grid_blocks), dim3(256), args, 0, stream);
    if (e != hipSuccess) fprintf(stderr, "cooperative launch failed: %s (grid %d)\n", hipGetErrorString(e), grid_blocks);
#endif
}
```

```cpp
#include <hip/hip_runtime.h>
#include <hip/hip_cooperative_groups.h>
#include <stdint.h>
#include <stdio.h>
namespace cg = cooperative_groups;

#ifndef EN_CONV
#define EN_CONV 1
#endif
#ifndef EN_RWKV
#define EN_RWKV 1
#endif
#ifndef EN_NSA_CMP
#define EN_NSA_CMP 1
#endif
#ifndef EN_NSA_WIN
#define EN_NSA_WIN 1
#endif
#ifndef EN_NSA_SEL
#define EN_NSA_SEL 1
#endif
#ifndef EN_PEER
#define EN_PEER 1
#endif
#ifndef MULTI_LAUNCH
#define MULTI_LAUNCH 0
#endif

#define DEV __device__ __forceinline__
typedef unsigned short u16;
typedef __attribute__((ext_vector_type(8))) short bf16x8;
typedef __attribute__((ext_vector_type(4))) float f32x4;
typedef __attribute__((ext_vector_type(4))) unsigned int u32x4;
typedef __attribute__((ext_vector_type(2))) unsigned int u32x2;

constexpr int NB = 4, NT = 8192, ND = 1024, NTOK = NB * NT, NL = 2;
constexpr int NIN = 2840, NINP = 2944;
constexpr size_t MiB = 1ull << 20;

constexpr size_t OFF_CTL = 0;
constexpr size_t CTL_ZERO_BYTES = 32768;
constexpr size_t OFF_BAR = 16384;
constexpr size_t OFF_MOD = 64 * 1024;
constexpr size_t OFF_CBP = 256 * 1024;
constexpr size_t OFF_WIN = 1 * MiB;
constexpr size_t OFF_WOUT = 13 * MiB;
constexpr size_t OFF_WQ = 17 * MiB;
constexpr size_t OFF_CW1 = 25 * MiB;
constexpr size_t OFF_K12 = 27 * MiB;
constexpr size_t OFF_LW = 27 * MiB + 512 * 1024;
constexpr size_t OFF_U8 = 28 * MiB;
constexpr size_t OFF_UVS = 512 * 1024;
constexpr size_t OFF_H = 92 * MiB;
constexpr size_t OFF_MIX = 156 * MiB;
constexpr size_t OFF_E = 220 * MiB;
constexpr size_t OFF_PCONV = OFF_E + 0;
constexpr size_t OFF_PRWKV = OFF_E + 32 * MiB;
constexpr size_t OFF_YRAW = OFF_E + 32 * MiB;
constexpr size_t OFF_Q = OFF_E + 96 * MiB;
constexpr size_t OFF_KV = OFF_E + 128 * MiB;
constexpr size_t OFF_GATE = OFF_E + 176 * MiB;
constexpr size_t OFF_KC = OFF_E + 180 * MiB;
constexpr size_t OFF_VCT = OFF_KC + 512 * 1024;
constexpr size_t OFF_RV = OFF_E + 184 * MiB;
constexpr size_t OFF_RKK = OFF_E + 200 * MiB;
constexpr size_t OFF_RKKA = OFF_E + 216 * MiB;
constexpr size_t OFF_RG = OFF_E + 232 * MiB;
constexpr size_t OFF_BONUS = OFF_E + 248 * MiB;
constexpr size_t OFF_RW = OFF_E + 249 * MiB;
constexpr size_t OFF_RR = 60 * MiB;
constexpr size_t OFF_RK = 76 * MiB;
constexpr size_t OFF_QP = OFF_E + 0;
constexpr size_t OFF_PIDX = OFF_E + 128 * MiB;
constexpr size_t OFF_PGW = OFF_E + 144 * MiB;
constexpr size_t WS_NEED = OFF_E + 281 * MiB;

#define QW(l, q) (64 * ((l) * 8 + (q)))
enum { Q_CMP = 0, Q_CONV = 1, Q_RWP = 2, Q_NSA = 3, Q_PTK = 4 };

enum { I_X = 0, I_C, I_ADAW, I_ADAB, I_N1G, I_N2G, I_WIN, I_CDW, I_CDB, I_CGG, I_CGB, I_MU, I_W0, I_WUP, I_A0, I_AUP, I_GUP,
       I_KK, I_KA, I_RK, I_LNG, I_LNB, I_CKPOS, I_CKW1, I_CKW2, I_CVPOS, I_CVW1, I_CVW2, I_WOUT, I_PWQ, I_PK1, I_PK2, I_PU, I_PV, I_FG };

struct Params {
    const float* in[35];
    float* out;
    unsigned char* ws;
    int ph_lo, ph_hi;
};

DEV int TID() { int t = threadIdx.x; asm volatile("" : "+v"(t)); return t; }
DEV int BID() { int t = blockIdx.x; asm volatile("" : "+s"(t)); return t; }
typedef __attribute__((ext_vector_type(2))) float f32x2_t;
typedef __attribute__((ext_vector_type(2))) __bf16 bf16x2_t;
DEV unsigned pack2(float a, float b) { const f32x2_t v = {a, b}; return __builtin_bit_cast(unsigned, __builtin_convertvector(v, bf16x2_t)); }
DEV u16 f2bf(float f) { const __bf16 h = (__bf16)f; return __builtin_bit_cast(u16, h); }
DEV float bf2f(u16 h) { return __uint_as_float(((unsigned)h) << 16); }
DEV float bflo(unsigned u) { return __uint_as_float(u << 16); }
DEV float bfhi(unsigned u) { return __uint_as_float(u & 0xffff0000u); }
DEV float ex2(float x) { return __builtin_amdgcn_exp2f(x); }
DEV float sigmoidf_(float x) { return 1.f / (1.f + __expf(-x)); }

DEV f32x4 mfma16(bf16x8 a, bf16x8 b, f32x4 c) { return __builtin_amdgcn_mfma_f32_16x16x32_bf16(a, b, c, 0, 0, 0); }
template <int CTRL> DEV float dppf(float x) { return __int_as_float(__builtin_amdgcn_update_dpp(0, __float_as_int(x), CTRL, 0xF, 0xF, false)); }
template <int CTRL> DEV unsigned dppu(unsigned x) { return (unsigned)__builtin_amdgcn_update_dpp(0, (int)x, CTRL, 0xF, 0xF, false); }
DEV float reduce16(float x) { x += dppf<0xB1>(x); x += dppf<0x4E>(x); x += dppf<0x124>(x); x += dppf<0x128>(x); return x; }
DEV float quadsum(float x) { x += dppf<0xB1>(x); x += dppf<0x4E>(x); return x; }
DEV float x16_sum(float x) { auto r = __builtin_amdgcn_permlane16_swap(__float_as_uint(x), __float_as_uint(x), false, false); return __uint_as_float(r[0]) + __uint_as_float(r[1]); }
DEV float x32_sum(float x) { auto r = __builtin_amdgcn_permlane32_swap(__float_as_uint(x), __float_as_uint(x), false, false); return __uint_as_float(r[0]) + __uint_as_float(r[1]); }
DEV float x16_max(float x) { auto r = __builtin_amdgcn_permlane16_swap(__float_as_uint(x), __float_as_uint(x), false, false); return fmaxf(__uint_as_float(r[0]), __uint_as_float(r[1])); }
DEV float x32_max(float x) { auto r = __builtin_amdgcn_permlane32_swap(__float_as_uint(x), __float_as_uint(x), false, false); return fmaxf(__uint_as_float(r[0]), __uint_as_float(r[1])); }
DEV int x16_sumi(int x) { auto r = __builtin_amdgcn_permlane16_swap((unsigned)x, (unsigned)x, false, false); return (int)(r[0] + r[1]); }
DEV int x32_sumi(int x) { auto r = __builtin_amdgcn_permlane32_swap((unsigned)x, (unsigned)x, false, false); return (int)(r[0] + r[1]); }
DEV float colsum(float x) { return x32_sum(x16_sum(x)); }
DEV float colmax(float x) { return x32_max(x16_max(x)); }
DEV int colsumi(int x) { return x32_sumi(x16_sumi(x)); }
DEV float wave_sum(float v) { return x32_sum(x16_sum(reduce16(v))); }
DEV int wave_sum_i(int x) {
    x += (int)dppu<0xB1>((unsigned)x); x += (int)dppu<0x4E>((unsigned)x); x += (int)dppu<0x124>((unsigned)x); x += (int)dppu<0x128>((unsigned)x);
    return x32_sumi(x16_sumi(x));
}
DEV int reduce8_i(const int (&d)[8]) {
    int t[4];
#pragma unroll
    for (int k = 0; k < 4; ++k) {
        auto r = __builtin_amdgcn_permlane32_swap((unsigned)d[k], (unsigned)d[k + 4], false, false);
        t[k] = (int)(r[0] + r[1]);
    }
    int u[2];
#pragma unroll
    for (int k = 0; k < 2; ++k) {
        auto r = __builtin_amdgcn_permlane16_swap((unsigned)t[k], (unsigned)t[k + 2], false, false);
        u[k] = (int)(r[0] + r[1]);
    }
    const bool hi8 = (threadIdx.x & 8) != 0;
    int x = hi8 ? u[1] : u[0];
    const int y = hi8 ? u[0] : u[1];
    x += (int)dppu<0x128>((unsigned)y);
    x += (int)dppu<0xB1>((unsigned)x); x += (int)dppu<0x4E>((unsigned)x); x += (int)dppu<0x141>((unsigned)x);
    return x;
}
DEV float wave_max(float x) {
    x = fmaxf(x, dppf<0xB1>(x)); x = fmaxf(x, dppf<0x4E>(x)); x = fmaxf(x, dppf<0x124>(x)); x = fmaxf(x, dppf<0x128>(x));
    return x32_max(x16_max(x));
}
DEV void lds_fence() { asm volatile("s_waitcnt lgkmcnt(0)" ::: "memory"); }
DEV bf16x8 ld8(const u16* p) { return *(const bf16x8*)p; }

DEV int block_next(unsigned* ctr, int* slot) {
    __syncthreads();
    if (TID() == 0) *slot = (int)atomicAdd(ctr, 1u);
    __syncthreads();
    return *slot;
}

#define XB_TMO      128
#define XB_XCNT(j)  (256  + 64 * (j))
#define XB_XSUB(j)  (1280 + 64 * (j))
#define XB_XGEN(j)  (2304 + 64 * (j))
#define XB_TOP      3328
#define XB_TOPGEN   3392
#define XCD_BAR_WORDS 3456
#define XB_SPIN_CAP (1u << 22)
#define LAS __attribute__((address_space(3)))
DEV unsigned xb_ld(unsigned* p) { return __hip_atomic_load(p, __ATOMIC_RELAXED, __HIP_MEMORY_SCOPE_AGENT); }
DEV unsigned xb_add(unsigned* p, unsigned v) { return __hip_atomic_fetch_add(p, v, __ATOMIC_RELAXED, __HIP_MEMORY_SCOPE_AGENT); }
DEV unsigned xb_xcc_id() { return (unsigned)__builtin_amdgcn_s_getreg((3 << 11) | 20) & 0xFu; }
#define XB_SPIN(cond, bar) do { unsigned _sp = 0; while (cond) { __builtin_amdgcn_s_sleep(1); \
    if ((++_sp & 255u) == 0u) { if (xb_ld(&(bar)[XB_TMO])) break; if (_sp > XB_SPIN_CAP) { atomicAdd(&(bar)[XB_TMO], 1u); break; } } } } while (0)
struct XcdBarrier { unsigned* bar; unsigned x; volatile unsigned* st; };
DEV XcdBarrier xcd_barrier_post(unsigned* bar, volatile unsigned* st) {
    XcdBarrier b; b.bar = bar; b.x = xb_xcc_id(); b.st = st;
    if (threadIdx.x == 0) (void)xb_add(&bar[XB_XCNT(b.x)], 1u);
    return b;
}
DEV void xcd_barrier_complete(unsigned* bar, unsigned x, unsigned& nloc, unsigned& nx) {
    const unsigned G = gridDim.x * gridDim.y * gridDim.z;
    unsigned sum, cnt, mine, sp = 0u;
    for (;;) {
        sum = 0u; cnt = 0u; mine = 0u;
#pragma unroll
        for (unsigned j = 0; j < 16; ++j) { const unsigned c = xb_ld(&bar[XB_XCNT(j)]); sum += c; cnt += (c > 0u) ? 1u : 0u; mine = (j == x) ? c : mine; }
        if (sum == G) break;
        __builtin_amdgcn_s_sleep(1);
        if ((++sp & 255u) == 0u) { if (xb_ld(&bar[XB_TMO])) break; if (sp > XB_SPIN_CAP) { atomicAdd(&bar[XB_TMO], 1u); break; } }
    }
    nloc = mine > 0u ? mine : 1u; nx = cnt > 0u ? cnt : 1u;
}
DEV void xcd_barrier(const XcdBarrier& b) {
    asm volatile("s_waitcnt vmcnt(0)" ::: "memory");
    __syncthreads();
    if (threadIdx.x == 0) {
        unsigned* bar = b.bar;
        __builtin_amdgcn_s_waitcnt(0);
        unsigned nloc = b.st[0], nx = b.st[1];
        if (nloc == 0u) { xcd_barrier_complete(bar, b.x, nloc, nx); b.st[0] = nloc; b.st[1] = nx; }
        const unsigned old = xb_add(&bar[XB_XSUB(b.x)], 1u);
        const unsigned gen = old / nloc;
        if (old + 1u == (gen + 1u) * nloc) {
            __builtin_amdgcn_fence(__ATOMIC_RELEASE, "agent");
            asm volatile("s_waitcnt vmcnt(0)" ::: "memory");
            const unsigned og = xb_add(&bar[XB_TOP], 1u);
            const unsigned tg = og / nx;
            if (og + 1u == (tg + 1u) * nx) xb_add(&bar[XB_TOPGEN], 1u);
            else XB_SPIN(xb_ld(&bar[XB_TOPGEN]) == tg, bar);
            __builtin_amdgcn_fence(__ATOMIC_ACQUIRE, "agent");
            xb_add(&bar[XB_XGEN(b.x)], 1u);
            asm volatile("s_waitcnt vmcnt(0)" ::: "memory");
        } else {
            XB_SPIN(xb_ld(&bar[XB_XGEN(b.x)]) == gen, bar);
            __builtin_amdgcn_fence(__ATOMIC_ACQUIRE, "agent");
            asm volatile("s_waitcnt vmcnt(0)" ::: "memory");
        }
    }
    __syncthreads();
}

template <class Epi>
DEV void gemm_phase(const u16* __restrict__ A, int lda, const u16* __restrict__ Bt, int ldb, int mtiles, int ntiles, int K, Epi& epi,
                    unsigned char* lds, int bid, int nb, int nt_lo = 0, int nt_skip = 0, bool xcd_order = true) {
    const int tid = TID(), lane = tid & 63, wave = tid >> 6;
    const int wm = wave >> 1, wn = wave & 1, q4 = lane >> 4, cidx = lane & 15;
    u16* As = (u16*)lds;
    u16* Bs = (u16*)(lds + 32768);
    const int KT = K >> 6;
    const int total = mtiles * ntiles;
    const int srow = tid >> 3, sch = tid & 7;
    const bool xo_ = xcd_order && ((nb & 7) == 0) && (nb <= 4096) && ((mtiles & 7) == 0);
    const int ngroups = (ntiles + 7) >> 3;
    const int nloc = xo_ ? (nb >> 3) : 1;
    const int nvirt = xo_ ? ((mtiles >> 3) * ngroups * 64) : total;
    for (int vt = xo_ ? ((bid & 7) * 64 + (bid >> 3)) : bid; vt < nvirt; vt += xo_ ? ((((vt & 63) + nloc) < 64) ? nloc : (8 * 64 - (vt & 63) + (bid >> 3))) : nb) {
        int mt, nt;
        if (xo_) {
            const int st = vt >> 6, tt = vt & 63;
            mt = (st / ngroups) * 8 + (tt >> 3); nt = (st % ngroups) * 8 + (tt & 7);
            if (nt >= ntiles) continue;
        } else { mt = vt / ntiles; nt = vt - mt * ntiles; }
        if (nt >= nt_lo) nt += nt_skip;
        const int m0 = mt * 128, n0 = nt * 128;
        const bool sw = epi.swapped(n0 + wn * 64);
        const int xo = sw ? (32768 / 2 + wn * 64 * 64) : (wm * 64 * 64);
        const int yo = sw ? (wm * 64 * 64) : (32768 / 2 + wn * 64 * 64);
        f32x4 acc[4][4];
#pragma unroll
        for (int i = 0; i < 4; ++i)
#pragma unroll
            for (int j = 0; j < 4; ++j) acc[i][j] = (f32x4){0.f, 0.f, 0.f, 0.f};
        const u16* Ag = A + (size_t)(m0 + srow) * lda + sch * 8;
        const u16* Bg = Bt + (size_t)(n0 + srow) * ldb + sch * 8;
        bf16x8 ra0[4], rb0[4], ra1[4], rb1[4];
#define GEMM_GLOAD(RA, RB, KT_) { const int k0_ = (KT_) * 64; _Pragma("unroll") for (int i = 0; i < 4; ++i) { RA[i] = ld8(Ag + (size_t)(32 * i) * lda + k0_); RB[i] = ld8(Bg + (size_t)(32 * i) * ldb + k0_); } }
#define GEMM_LWRITE(RA, RB, BUF_) { u16* Aw_ = As + (BUF_) * 8192; u16* Bw_ = Bs + (BUF_) * 8192; _Pragma("unroll") for (int i = 0; i < 4; ++i) { const int row = srow + 32 * i; const int off = row * 64 + ((sch ^ (row & 7)) << 3); *(bf16x8*)(Aw_ + off) = RA[i]; *(bf16x8*)(Bw_ + off) = RB[i]; } }
#define GEMM_COMPUTE(BUF_) { const u16* Xb = As + (BUF_) * 8192 + xo; const u16* Yb = As + (BUF_) * 8192 + yo; _Pragma("unroll") for (int s = 0; s < 2; ++s) { bf16x8 a[4], b[4]; const int ch = s * 4 + q4; _Pragma("unroll") for (int i = 0; i < 4; ++i) { const int row = i * 16 + cidx; a[i] = *(const bf16x8*)(Xb + row * 64 + ((ch ^ (row & 7)) << 3)); b[i] = *(const bf16x8*)(Yb + row * 64 + ((ch ^ (row & 7)) << 3)); } _Pragma("unroll") for (int i = 0; i < 4; ++i) _Pragma("unroll") for (int j = 0; j < 4; ++j) acc[i][j] = mfma16(a[i], b[j], acc[i][j]); } }
        GEMM_GLOAD(ra0, rb0, 0);
        if (KT > 1) GEMM_GLOAD(ra1, rb1, 1);
        GEMM_LWRITE(ra0, rb0, 0);
        __syncthreads();
        for (int kt = 0; kt < KT; kt += 2) {
            if (kt + 2 < KT) GEMM_GLOAD(ra0, rb0, kt + 2);
            GEMM_COMPUTE(0);
            GEMM_LWRITE(ra1, rb1, 1);
            __syncthreads();
            if (kt + 3 < KT) GEMM_GLOAD(ra1, rb1, kt + 3);
            GEMM_COMPUTE(1);
            if (kt + 2 < KT) GEMM_LWRITE(ra0, rb0, 0);
            __syncthreads();
        }
#undef GEMM_GLOAD
#undef GEMM_LWRITE
#undef GEMM_COMPUTE
        if (!sw) {
#pragma unroll
            for (int i = 0; i < 4; ++i)
#pragma unroll
                for (int j = 0; j < 4; ++j) epi.rows4(m0 + wm * 64 + i * 16 + q4 * 4, n0 + wn * 64 + j * 16 + cidx, acc[i][j]);
        } else {
#pragma unroll
            for (int i = 0; i < 4; ++i)
#pragma unroll
                for (int j = 0; j < 4; ++j) epi.cols4(m0 + wm * 64 + j * 16 + cidx, n0 + wn * 64 + i * 16 + q4 * 4, acc[i][j]);
        }
        epi.finish(m0, n0, lds);
    }
}

struct EpiInProj {
    u16 *pconv, *prwkv, *q, *kv; float* gate;
    DEV bool swapped(int c0) const { return !((c0 >= 2432 && c0 < 2560) || (c0 >= 2688 && c0 < 2816)); }
    DEV void rows4(int row0, int col, f32x4 v) const {
        const int c = col - 2048; const int idx = c >> 7; const int g = (c >> 6) & 1; const int d = c & 63;
        const int b = row0 >> 13; const int t0 = row0 & 8191; const int bg = b * 2 + g;
        u16* base = kv + (size_t)idx * 4194304;
        const int k = t0 & 31; const int p0 = 8 * ((k & 15) >> 2) + 4 * (k >> 4);
        u32x2 w; w[0] = pack2(v[0], v[1]); w[1] = pack2(v[2], v[3]);
        *(u32x2*)(base + (size_t)(bg * 64 + d) * 8192 + (t0 & ~31) + p0) = w;
    }
    DEV void cols4(int row, int col0, f32x4 v) const {
        if (col0 < 512) {
            u32x2 w; w[0] = pack2(v[0], v[1]); w[1] = pack2(v[2], v[3]);
            *(u32x2*)(pconv + (size_t)row * 512 + col0) = w;
        } else if (col0 < 1536) {
            u32x2 w; w[0] = pack2(v[0], v[1]); w[1] = pack2(v[2], v[3]);
            *(u32x2*)(prwkv + (size_t)row * 1024 + (col0 - 512)) = w;
        } else if (col0 < 2048) {
            const float sc = 0.18033688011112042f;
            u32x2 w; w[0] = pack2(v[0] * sc, v[1] * sc); w[1] = pack2(v[2] * sc, v[3] * sc);
            *(u32x2*)(q + (size_t)row * 512 + (col0 - 1536)) = w;
        } else if (col0 < 2816) {
            const int c = col0 - 2048; const int idx = c >> 7; const int g = (c >> 6) & 1; const int d = c & 63;
            const int b = row >> 13; const int t = row & 8191; const int bg = b * 2 + g;
            u32x2 w; w[0] = pack2(v[0], v[1]); w[1] = pack2(v[2], v[3]);
            *(u32x2*)(kv + (size_t)idx * 4194304 + ((size_t)bg * 8192 + t) * 64 + d) = w;
        } else if (col0 < 2840) {
            *(float4*)(gate + (size_t)row * 24 + (col0 - 2816)) = (float4){sigmoidf_(v[0]), sigmoidf_(v[1]), sigmoidf_(v[2]), sigmoidf_(v[3])};
        }
    }
    DEV void finish(int, int, unsigned char*) const {}
};

struct EpiOutProj {
    const float* xold; float* xnew; const float* g1;
    DEV bool swapped(int) const { return true; }
    DEV void rows4(int, int, f32x4) const {}
    DEV void cols4(int row, int col0, f32x4 v) const {
        const int b = row >> 13; const float4 gg = *(const float4*)(g1 + b * 6144 + col0);
        const size_t o = (size_t)row * 1024 + col0;
        const float4 x = *(const float4*)(xold + o);
        *(float4*)(xnew + o) = (float4){x.x + gg.x * v[0], x.y + gg.y * v[1], x.z + gg.z * v[2], x.w + gg.w * v[3]};
    }
    DEV void finish(int, int, unsigned char*) const {}
};

struct EpiStoreBf16 {
    u16* out; int ld;
    DEV bool swapped(int) const { return true; }
    DEV void rows4(int, int, f32x4) const {}
    DEV void cols4(int row, int col0, f32x4 v) const {
        u32x2 w; w[0] = pack2(v[0], v[1]); w[1] = pack2(v[2], v[3]);
        *(u32x2*)(out + (size_t)row * ld + col0) = w;
    }
    DEV void finish(int, int, unsigned char*) const {}
};

struct EpiCompress {
    const float* cbp;
    const float* w2;
    u16* outp;
    int isv;
    unsigned char* lds;
    DEV bool swapped(int) const { return false; }
    DEV void cols4(int, int, f32x4) const {}
    DEV void rows4(int row0, int col, f32x4 v) const {
        float* hid = (float*)lds;
        const int rl = row0 & 127;
#pragma unroll
        for (int r = 0; r < 4; ++r) hid[(rl + r) * 128 + col] = v[r];
    }
    DEV void finish(int m0, int, unsigned char*) const {
        __syncthreads();
        {
            float* hw = (float*)lds;
            const int t = TID(); const int c = t & 127, r0 = (t >> 7) * 64;
            float bias = 0.f;
#pragma unroll
            for (int s = 0; s < 16; ++s) bias += cbp[s * 128 + c];
#pragma unroll 4
            for (int r = 0; r < 64; ++r) { const float x = hw[(r0 + r) * 128 + c] + bias; hw[(r0 + r) * 128 + c] = x * sigmoidf_(x); }
        }
        __syncthreads();
        const float* hid = (const float*)lds;
        const int tid = TID(); const int d = tid & 63, rgp = tid >> 6;
        float acc[32];
#pragma unroll
        for (int i = 0; i < 32; ++i) acc[i] = 0.f;
#pragma unroll 1
        for (int j0 = 0; j0 < 128; j0 += 8) {
            float wv[8];
#pragma unroll
            for (int jj = 0; jj < 8; ++jj) wv[jj] = w2[(j0 + jj) * 64 + d];
#pragma unroll
            for (int rr = 0; rr < 32; ++rr) {
                const float4 h0 = *(const float4*)(hid + (rgp * 32 + rr) * 128 + j0), h1 = *(const float4*)(hid + (rgp * 32 + rr) * 128 + j0 + 4);
                acc[rr] += h0.x * wv[0] + h0.y * wv[1] + h0.z * wv[2] + h0.w * wv[3] + h1.x * wv[4] + h1.y * wv[5] + h1.z * wv[6] + h1.w * wv[7];
            }
        }
#pragma unroll
        for (int rr = 0; rr < 32; ++rr) {
            const int m = m0 + rgp * 32 + rr; const int bg = m >> 9, n = m & 511;
            const u16 val = (n == 511) ? (u16)0 : f2bf(acc[rr]);
            if (!isv) outp[((size_t)bg * 512 + n) * 64 + d] = val;
            else {
                const int k = n & 31; const int pp = 8 * ((k & 15) >> 2) + (k & 3) + 4 * (k >> 4);
                outp[((size_t)bg * 64 + d) * 512 + (n & ~31) + pp] = val;
            }
        }
        __syncthreads();
    }
};

DEV void transpose_tile(const float* __restrict__ src, int N, u16* __restrict__ dst, int ldk, int kt, int nt, float* tl) {
    const int tid = TID(); const int k0 = kt * 64, n0 = nt * 64;
#pragma unroll 4
    for (int i = 0; i < 16; ++i) {
        const int idx = tid + 256 * i; const int kr = idx >> 6, nc = idx & 63; const int n = n0 + nc;
        tl[kr * 65 + nc] = (n < N) ? src[(size_t)(k0 + kr) * N + n] : 0.f;
    }
    __syncthreads();
#pragma unroll 4
    for (int i = 0; i < 16; ++i) {
        const int idx = tid + 256 * i; const int nr = idx >> 6, kc = idx & 63;
        dst[(size_t)(n0 + nr) * ldk + k0 + kc] = f2bf(tl[kc * 65 + nr]);
    }
    __syncthreads();
}

DEV void convert_straight(const float* __restrict__ src, u16* __restrict__ dst, size_t n) {
    const size_t stride = (size_t)gridDim.x * 256 * 8;
    for (size_t i = ((size_t)BID() * 256 + TID()) * 8; i < n; i += stride) {
        const float4 a = *(const float4*)(src + i); const float4 b = *(const float4*)(src + i + 4);
        u32x4 w; w[0] = pack2(a.x, a.y); w[1] = pack2(a.z, a.w); w[2] = pack2(b.x, b.y); w[3] = pack2(b.z, b.w);
        *(u32x4*)(dst + i) = w;
    }
}

DEV void convert_rows_task(const float* __restrict__ src, unsigned char* __restrict__ dst, float* __restrict__ scale, int* __restrict__ rowsum, int row0) {
    const int lane = TID() & 63, wave = TID() >> 6;
#pragma unroll 1
    for (int it = 0; it < 4; ++it) {
        float4 v[2][4]; float amax[2] = {0.f, 0.f};
#pragma unroll
        for (int u = 0; u < 2; ++u) {
            const int row = row0 + wave * 8 + it * 2 + u;
#pragma unroll
            for (int i = 0; i < 4; ++i) v[u][i] = *(const float4*)(src + (size_t)row * 1024 + 16 * lane + 4 * i);
        }
#pragma unroll
        for (int u = 0; u < 2; ++u) {
#pragma unroll
            for (int i = 0; i < 4; ++i)
                amax[u] = fmaxf(amax[u], fmaxf(fmaxf(fabsf(v[u][i].x), fabsf(v[u][i].y)), fmaxf(fabsf(v[u][i].z), fabsf(v[u][i].w))));
            amax[u] = wave_max(amax[u]);
            const int row = row0 + wave * 8 + it * 2 + u;
            const float sc = amax[u] > 0.f ? amax[u] * (1.f / 127.f) : 1.f;
            const float inv = 1.f / sc;
            u32x4 w;
#pragma unroll
            for (int i = 0; i < 4; ++i) {
                const int a = __float2int_rn(v[u][i].x * inv) + 128, b = __float2int_rn(v[u][i].y * inv) + 128, c = __float2int_rn(v[u][i].z * inv) + 128,
                          d = __float2int_rn(v[u][i].w * inv) + 128;
                w[i] = (unsigned)a | ((unsigned)b << 8) | ((unsigned)c << 16) | ((unsigned)d << 24);
            }
            *(u32x4*)(dst + (size_t)row * 1024 + 16 * lane) = w;
            int bs = 0;
#pragma unroll
            for (int i = 0; i < 4; ++i) bs += (int)(w[i] & 0xffu) + (int)((w[i] >> 8) & 0xffu) + (int)((w[i] >> 16) & 0xffu) + (int)(w[i] >> 24);
            bs = wave_sum_i(bs);
            if (lane == 0) { scale[row] = sc; if (rowsum) rowsum[row] = bs; }
        }
    }
}

DEV void phase_prep(const Params& p, unsigned char* lds) {
    const int tid = TID();
    float* fl = (float*)lds;
    unsigned char* ws = p.ws;
    for (int task = BID(); task < 192; task += gridDim.x) {
        const int l = task / 96, cgp = task % 96;
        float* cs = fl;
        float* red = fl + 4096;
        for (int i = tid; i < 4096; i += 256) { const float c = p.in[I_C][i]; cs[i] = c / (1.f + __expf(-c)); }
        __syncthreads();
        const int col = cgp * 64 + (tid & 63), ks = tid >> 6;
        float a0 = 0, a1 = 0, a2 = 0, a3 = 0;
        const float* w = p.in[I_ADAW] + ((size_t)l * 1024 + ks * 256) * 6144 + col;
#pragma unroll 32
        for (int k = 0; k < 256; ++k) {
            const float wv = w[(size_t)k * 6144]; const int kk = ks * 256 + k;
            a0 += cs[kk] * wv; a1 += cs[1024 + kk] * wv; a2 += cs[2048 + kk] * wv; a3 += cs[3072 + kk] * wv;
        }
        red[(ks * 4 + 0) * 64 + (tid & 63)] = a0; red[(ks * 4 + 1) * 64 + (tid & 63)] = a1;
        red[(ks * 4 + 2) * 64 + (tid & 63)] = a2; red[(ks * 4 + 3) * 64 + (tid & 63)] = a3;
        __syncthreads();
        {
            const int b = tid >> 6, c = tid & 63;
            const float s = red[(0 * 4 + b) * 64 + c] + red[(1 * 4 + b) * 64 + c] + red[(2 * 4 + b) * 64 + c] + red[(3 * 4 + b) * 64 + c];
            const int colg = cgp * 64 + c;
            ((float*)(ws + OFF_MOD))[(l * 4 + b) * 6144 + colg] = s + p.in[I_ADAB][l * 6144 + colg];
        }
        __syncthreads();
    }
    for (int task = BID(); task < 64; task += gridDim.x) {
        const int l = task >> 5, kv = (task >> 4) & 1, s = task & 15;
        const float* pos = p.in[kv ? I_CVPOS : I_CKPOS] + l * 2048;
        const float* w1 = p.in[kv ? I_CVW1 : I_CKW1] + (size_t)l * 2048 * 128;
        const int col = tid & 127, half = tid >> 7;
        float a = 0;
        const int i0 = s * 128 + half * 64;
#pragma unroll 8
        for (int i = 0; i < 64; ++i) a += pos[i0 + i] * w1[(size_t)(i0 + i) * 128 + col];
        fl[tid] = a;
        __syncthreads();
        if (tid < 128) ((float*)(ws + OFF_CBP))[((l * 2 + kv) * 16 + s) * 128 + tid] = fl[tid] + fl[tid + 128];
        __syncthreads();
    }
    {
        for (int task = BID(); task < 2 * 16 * 46; task += gridDim.x) {
            const int l = task / (16 * 46), r = task % (16 * 46);
            transpose_tile(p.in[I_WIN] + (size_t)l * 1024 * NIN, NIN, (u16*)(ws + OFF_WIN) + (size_t)l * NINP * 1024, 1024, r / 46, r % 46, fl);
        }
        for (int task = BID(); task < 2 * 16; task += gridDim.x) {
            const int l = task >> 4, r = task & 15; const int nt = r & 3, part = r >> 2;
            u16* dst = (u16*)(ws + OFF_LW) + (size_t)l * 65536;
            if (part == 0) transpose_tile(p.in[I_WUP] + (size_t)l * 64 * 256, 256, dst, 256, 0, nt, fl);
            else if (part == 1) transpose_tile(p.in[I_AUP] + (size_t)l * 64 * 256, 256, dst + 64, 256, 0, nt, fl);
            else transpose_tile(p.in[I_GUP] + (size_t)l * 128 * 256, 256, dst + 128, 256, part - 2, nt, fl);
        }
        for (int task = BID(); task < 4 * 32 * 2; task += gridDim.x) {
            const int lk = task >> 6, r = task & 63; const int l = lk >> 1, kv = lk & 1;
            transpose_tile(p.in[kv ? I_CVW1 : I_CKW1] + (size_t)l * 2048 * 128, 128, (u16*)(ws + OFF_CW1) + (size_t)lk * 128 * 2048, 2048, r >> 1, r & 1, fl);
        }
    }
    for (int l = 0; l < 2; ++l) {
        convert_straight(p.in[I_PK1] + l * 16384, (u16*)(ws + OFF_K12) + (l * 2 + 0) * 16384, 16384);
        convert_straight(p.in[I_PK2] + l * 16384, (u16*)(ws + OFF_K12) + (l * 2 + 1) * 16384, 16384);
    }
}

DEV void phase_norm(const float* __restrict__ x, const float* __restrict__ g, const float* __restrict__ sh, const float* __restrict__ sc,
                    u16* __restrict__ h) {
    const int lane = TID() & 63;
    const int gw = BID() * 4 + (TID() >> 6), nw = gridDim.x * 4;
    for (int row = gw; row < NTOK; row += nw) {
        const int b = row >> 13;
        float4 v[4]; float ss = 0;
#pragma unroll
        for (int i = 0; i < 4; ++i) { v[i] = *(const float4*)(x + (size_t)row * 1024 + 256 * i + lane * 4); ss += v[i].x * v[i].x + v[i].y * v[i].y + v[i].z * v[i].z + v[i].w * v[i].w; }
        ss = wave_sum(ss);
        const float rs = rsqrtf(ss * (1.f / 1024.f) + 1e-6f);
#pragma unroll
        for (int i = 0; i < 4; ++i) {
            const int k = 256 * i + lane * 4;
            const float4 gg = *(const float4*)(g + k); const float4 s1 = *(const float4*)(sc + b * 6144 + k); const float4 s0 = *(const float4*)(sh + b * 6144 + k);
            u32x2 w;
            w[0] = pack2(v[i].x * rs * gg.x * (1.f + s1.x) + s0.x, v[i].y * rs * gg.y * (1.f + s1.y) + s0.y);
            w[1] = pack2(v[i].z * rs * gg.z * (1.f + s1.z) + s0.z, v[i].w * rs * gg.w * (1.f + s1.w) + s0.w);
            *(u32x2*)(h + (size_t)row * 1024 + k) = w;
        }
    }
}

DEV void conv_tile(const Params& p, int l, int tile, unsigned char* lds) {
    float* ul = (float*)lds;
    const int tid = TID();
    unsigned char* ws = p.ws;
    const u16* pconv = (const u16*)(ws + OFF_PCONV);
    u16* mix = (u16*)(ws + OFF_MIX);
    const int t0g = tile * 32; const int tb = t0g & 8191;
#pragma unroll 8
    for (int rr = 0; rr < 62; ++rr) {
        const int trow = tb - 30 + rr;
        float u = 0.f;
        if (trow >= 0) {
            const size_t o = (size_t)(t0g - 30 + rr) * 512;
            const float val = bf2f(pconv[o + tid]), gt = bf2f(pconv[o + 256 + tid]);
            u = val * sigmoidf_(gt);
        }
        ul[rr * 256 + tid] = u;
    }
    __syncthreads();
    float w[31];
#pragma unroll
    for (int j = 0; j < 31; ++j) w[j] = p.in[I_CDW][(l * 31 + j) * 256 + tid];
    const float bias = p.in[I_CDB][l * 256 + tid], gg = p.in[I_CGG][l * 256 + tid], gb = p.in[I_CGB][l * 256 + tid];
    for (int tt = 0; tt < 32; ++tt) {
        float y = bias;
#pragma unroll
        for (int j = 0; j < 31; ++j) y += ul[(tt + j) * 256 + tid] * w[j];
        const float mean = wave_sum(y) * (1.f / 64.f);
        const float d = y - mean;
        const float var = wave_sum(d * d) * (1.f / 64.f);
        float o = d * rsqrtf(var + 1e-5f) * gg + gb;
        o = o * sigmoidf_(o);
        mix[(size_t)(t0g + tt) * 1024 + tid] = f2bf(o);
    }
}

DEV float softplusf_(float x) { return x > 20.f ? x : log1pf(__expf(x)); }
DEV void rwkv_prep_tile2(const Params& p, int l, int tile, unsigned char* lds) {
    u16* actb = (u16*)lds;
    const int tid = TID(), lane = tid & 63, wave = tid >> 6, q4 = lane >> 4, cidx = lane & 15;
    unsigned char* ws = p.ws;
    const u16* pr = (const u16*)(ws + OFF_PRWKV);
    const float* mu = p.in[I_MU] + l * 1024;
    const int R0 = tile * 16;
    {
        const int col = 768 + tid; const float muc = mu[col];
        u16 raw[17];
        const bool first = ((R0 & 8191) == 0);
        raw[0] = first ? (u16)0 : pr[(size_t)(R0 - 1) * 1024 + col];
#pragma unroll
        for (int tk = 0; tk < 16; ++tk) raw[tk + 1] = pr[(size_t)(R0 + tk) * 1024 + col];
#pragma unroll
        for (int tk = 0; tk < 16; ++tk) {
            const float cur = bf2f(raw[tk + 1]), prev = bf2f(raw[tk]);
            const float x = cur + (prev - cur) * muc;
            float a;
            if (tid < 64) a = tanhf(x); else if (tid < 128) a = x; else a = sigmoidf_(x);
            actb[tk * 264 + tid] = f2bf(a);
        }
    }
    __syncthreads();
    f32x4 accw[4], acca[4], accg[4];
    {
        bf16x8 af[8];
#pragma unroll
        for (int s2 = 0; s2 < 8; ++s2) af[s2] = *(const bf16x8*)(actb + cidx * 264 + 32 * s2 + 8 * q4);
        const u16* LW = (const u16*)(ws + OFF_LW) + (size_t)l * 65536;
        const f32x4 z = (f32x4){0.f, 0.f, 0.f, 0.f};
#pragma unroll
        for (int nt = 0; nt < 4; ++nt) {
            const u16* bp = LW + (size_t)(64 * wave + 16 * nt + cidx) * 256 + 8 * q4;
            accw[nt] = mfma16(af[0], ld8(bp), z); accw[nt] = mfma16(af[1], ld8(bp + 32), accw[nt]);
            acca[nt] = mfma16(af[2], ld8(bp + 64), z); acca[nt] = mfma16(af[3], ld8(bp + 96), acca[nt]);
            accg[nt] = mfma16(af[4], ld8(bp + 128), z); accg[nt] = mfma16(af[5], ld8(bp + 160), accg[nt]);
            accg[nt] = mfma16(af[6], ld8(bp + 192), accg[nt]); accg[nt] = mfma16(af[7], ld8(bp + 224), accg[nt]);
        }
    }
    float* RW = (float*)(ws + OFF_RW);
    u16 *RR = (u16*)(ws + OFF_RR), *RK = (u16*)(ws + OFF_RK), *RV = (u16*)(ws + OFF_RV), *RKK = (u16*)(ws + OFF_RKK), *RKKA = (u16*)(ws + OFF_RKKA),
        *RG = (u16*)(ws + OFF_RG);
    float* BON = (float*)(ws + OFF_BONUS);
    float w0[4], a0[4], kkc[4], kac[4], rkc[4], mur[4], muk[4], muv[4];
#pragma unroll
    for (int nt = 0; nt < 4; ++nt) {
        const int c = 64 * wave + 16 * nt + cidx;
        w0[nt] = p.in[I_W0][l * 256 + c]; a0[nt] = p.in[I_A0][l * 256 + c]; kkc[nt] = p.in[I_KK][l * 256 + c]; kac[nt] = p.in[I_KA][l * 256 + c];
        rkc[nt] = p.in[I_RK][l * 256 + c]; mur[nt] = mu[c]; muk[nt] = mu[256 + c]; muv[nt] = mu[512 + c];
    }
    u16 ld3[5][4][3];
    {
        const int rowb = R0 + 4 * q4; const bool firstrow = ((rowb & 8191) == 0);
#pragma unroll
        for (int rr_ = 0; rr_ < 5; ++rr_)
#pragma unroll
            for (int nt = 0; nt < 4; ++nt) {
                const int c = 64 * wave + 16 * nt + cidx;
                const u16* cr = pr + (size_t)(rowb - 1 + rr_) * 1024;
                const bool z = (rr_ == 0) && firstrow;
                ld3[rr_][nt][0] = z ? (u16)0 : cr[c]; ld3[rr_][nt][1] = z ? (u16)0 : cr[256 + c]; ld3[rr_][nt][2] = z ? (u16)0 : cr[512 + c];
            }
    }
#pragma unroll
    for (int r = 0; r < 4; ++r) {
        const int row = R0 + 4 * q4 + r;
        float rr[4], kf_[4], vf_[4], av[4], kkv[4], keff[4], dec[4];
        float kk2 = 0.f, bn = 0.f;
#pragma unroll
        for (int nt = 0; nt < 4; ++nt) {
            float rv = bf2f(ld3[r + 1][nt][0]), kv = bf2f(ld3[r + 1][nt][1]), vv = bf2f(ld3[r + 1][nt][2]);
            const float rp = bf2f(ld3[r][nt][0]), kp = bf2f(ld3[r][nt][1]), vp = bf2f(ld3[r][nt][2]);
            rv += (rp - rv) * mur[nt]; kv += (kp - kv) * muk[nt]; vv += (vp - vv) * muv[nt];
            const float wl = w0[nt] + accw[nt][r];
            const float wlog = -softplusf_(-wl) - 0.5f;
            dec[nt] = __expf(-__expf(wlog));
            av[nt] = sigmoidf_(a0[nt] + acca[nt][r]);
            kkv[nt] = kv * kkc[nt]; kk2 += kkv[nt] * kkv[nt];
            keff[nt] = kv * (1.f + (av[nt] - 1.f) * kac[nt]);
            bn += rv * keff[nt] * rkc[nt];
            rr[nt] = rv; kf_[nt] = kv; vf_[nt] = vv;
        }
        kk2 = reduce16(kk2); bn = reduce16(bn);
        const float inv = 1.f / fmaxf(sqrtf(kk2), 1e-12f);
#pragma unroll
        for (int nt = 0; nt < 4; ++nt) {
            const int c = 64 * wave + 16 * nt + cidx;
            const size_t o = (size_t)row * 256 + c;
            const float kk = kkv[nt] * inv;
            RW[o] = dec[nt]; RR[o] = f2bf(rr[nt]); RK[o] = f2bf(keff[nt]); RV[o] = f2bf(vf_[nt]); RKK[o] = f2bf(kk); RKKA[o] = f2bf(kk * av[nt]);
            RG[o] = f2bf(accg[nt][r]);
        }
        if (cidx == 0) BON[(size_t)row * 4 + wave] = bn;
    }
}

DEV void rwkv_scan(const Params& p, int sb, unsigned char* lds) {
    unsigned char* ws = p.ws;
    const float* RW = (const float*)(ws + OFF_RW);
    const u16 *RR = (const u16*)(ws + OFF_RR), *RK = (const u16*)(ws + OFF_RK), *RV = (const u16*)(ws + OFF_RV), *RKK = (const u16*)(ws + OFF_RKK),
              *RKKA = (const u16*)(ws + OFF_RKKA);
    float* YR = (float*)(ws + OFF_YRAW);
    const int tid = TID(), lane = tid & 63, wave = tid >> 6;
    const int bh = sb >> 2, rg = sb & 3; const int b = bh >> 2, hh = bh & 3;
    float* L = (float*)lds;
    constexpr int BUFSZ = 5 * 1024 + 256;
    float* Yb = L + 2 * BUFSZ;
    const int row_local = 4 * wave + (lane >> 4); const int kq = (lane & 15) * 4;
    const int lstep = tid >> 4, lk = (tid & 15) * 4;
    const int vstep = tid >> 4, vrow = tid & 15;
    const size_t gbase = (size_t)b * 8192 * 256 + hh * 64;
    float4 lw; u32x2 lr, lkk, lkka, lk_; u16 lv;
    auto issue = [&](int c) {
        const size_t o = gbase + (size_t)(c * 16 + lstep) * 256 + lk;
        lw = *(const float4*)(RW + o);
        lr = *(const u32x2*)(RR + o); lk_ = *(const u32x2*)(RK + o); lkk = *(const u32x2*)(RKK + o); lkka = *(const u32x2*)(RKKA + o);
        lv = RV[gbase + (size_t)(c * 16 + vstep) * 256 + rg * 16 + vrow];
    };
    auto commit = [&](int buf) {
        float* B = L + buf * BUFSZ;
        const int o = lstep * 64 + lk;
        *(float4*)(B + o) = lw;
        *(float4*)(B + 1024 + o) = (float4){bflo(lkka[0]), bfhi(lkka[0]), bflo(lkka[1]), bfhi(lkka[1])};
        *(float4*)(B + 2048 + o) = (float4){bflo(lk_[0]), bfhi(lk_[0]), bflo(lk_[1]), bfhi(lk_[1])};
        *(float4*)(B + 3072 + o) = (float4){bflo(lr[0]), bfhi(lr[0]), bflo(lr[1]), bfhi(lr[1])};
        *(float4*)(B + 4096 + o) = (float4){bflo(lkk[0]), bfhi(lkk[0]), bflo(lkk[1]), bfhi(lkk[1])};
        B[5120 + vstep * 16 + vrow] = bf2f(lv);
    };
    __syncthreads();
    issue(0); commit(0);
    __syncthreads();
    float S0 = 0.f, S1 = 0.f, S2 = 0.f, S3 = 0.f;
    constexpr int NCH = NT / 16;
    for (int c = 0; c < NCH; ++c) {
        const int buf = c & 1;
        if (c + 1 < NCH) issue(c + 1);
        const float* B = L + buf * BUFSZ;
        float* Y = Yb + buf * 256;
        float yv[16];
        float4 w4 = *(const float4*)(B + kq), a4 = *(const float4*)(B + 1024 + kq), k4 = *(const float4*)(B + 2048 + kq),
               r4 = *(const float4*)(B + 3072 + kq), n4 = *(const float4*)(B + 4096 + kq);
        float vv = B[5120 + row_local];
#pragma unroll
        for (int st = 0; st < 16; ++st) {
            float4 w4n, a4n, k4n, r4n, n4n; float vvn;
            if (st < 15) {
                w4n = *(const float4*)(B + (st + 1) * 64 + kq); a4n = *(const float4*)(B + 1024 + (st + 1) * 64 + kq);
                k4n = *(const float4*)(B + 2048 + (st + 1) * 64 + kq); r4n = *(const float4*)(B + 3072 + (st + 1) * 64 + kq);
                n4n = *(const float4*)(B + 4096 + (st + 1) * 64 + kq); vvn = B[5120 + (st + 1) * 16 + row_local];
            }
            const float part = (S0 * n4.x + S1 * n4.y) + (S2 * n4.z + S3 * n4.w);
            const float sa = -reduce16(part);
            const float t0 = S0 * w4.x + vv * k4.x, t1 = S1 * w4.y + vv * k4.y, t2 = S2 * w4.z + vv * k4.z, t3 = S3 * w4.w + vv * k4.w;
            S0 = t0 + sa * a4.x; S1 = t1 + sa * a4.y; S2 = t2 + sa * a4.z; S3 = t3 + sa * a4.w;
            const float yp = (S0 * r4.x + S1 * r4.y) + (S2 * r4.z + S3 * r4.w);
            yv[st] = reduce16(yp);
            if (st < 15) { w4 = w4n; a4 = a4n; k4 = k4n; r4 = r4n; n4 = n4n; vv = vvn; }
        }
        if ((lane & 15) == 0) {
#pragma unroll
            for (int st = 0; st < 16; ++st) Y[st * 16 + row_local] = yv[st];
        }
        if (c + 1 < NCH) commit(buf ^ 1);
        __syncthreads();
        YR[gbase + (size_t)(c * 16 + vstep) * 256 + rg * 16 + vrow] = Y[vstep * 16 + vrow];
    }
}

DEV void phase_rwkv_post(const Params& p, int l) {
    unsigned char* ws = p.ws;
    const float* YR = (const float*)(ws + OFF_YRAW); const float* BON = (const float*)(ws + OFF_BONUS);
    const u16 *RV = (const u16*)(ws + OFF_RV), *RG = (const u16*)(ws + OFF_RG);
    u16* mix = (u16*)(ws + OFF_MIX);
    const int tid = TID();
    const float lg = p.in[I_LNG][l * 256 + tid], lb = p.in[I_LNB][l * 256 + tid];
    for (int row = BID(); row < NTOK; row += gridDim.x) {
        const size_t o = (size_t)row * 256 + tid;
        const float y = YR[o];
        const float mean = wave_sum(y) * (1.f / 64.f);
        const float d = y - mean;
        const float var = wave_sum(d * d) * (1.f / 64.f);
        const float yn = d * rsqrtf(var + 64e-5f) * lg + lb;
        const float outv = (yn + BON[(size_t)row * 4 + (tid >> 6)] * bf2f(RV[o])) * bf2f(RG[o]);
        mix[(size_t)row * 1024 + 256 + tid] = f2bf(outv);
    }
}

DEV void zero_mix_cols(const Params& p, int c0, int ncols) {
    u16* mix = (u16*)(p.ws + OFF_MIX);
    const int per = ncols / 8;
    const size_t total = (size_t)NTOK * per;
    for (size_t i = (size_t)BID() * 256 + TID(); i < total; i += (size_t)gridDim.x * 256) {
        const size_t row = i / per; const int cc = (int)(i % per);
        *(u32x4*)(mix + row * 1024 + c0 + cc * 8) = (u32x4){0u, 0u, 0u, 0u};
    }
}


DEV void qk_tile(const bf16x8 (&kf)[8], bf16x8 q0, bf16x8 q1, f32x4 (&st)[4]) {
#pragma unroll
    for (int kt = 0; kt < 4; ++kt) {
        st[kt] = mfma16(kf[2 * kt], q0, (f32x4){0.f, 0.f, 0.f, 0.f});
        st[kt] = mfma16(kf[2 * kt + 1], q1, st[kt]);
    }
}
DEV void softmax_pv_tile(bool MASK, f32x4 (&st)[4], const bf16x8 (&vf)[8], int keybase, int tcol, int lowcol, bool colsel, float& m, float& l, f32x4 (&O)[4], int q4) {
    float lmax = -1e30f;
    if (MASK) {
        const int hi = colsel ? tcol : -1;
#pragma unroll
        for (int kt = 0; kt < 4; ++kt)
#pragma unroll
            for (int r = 0; r < 4; ++r) {
                const int key = keybase + kt * 16 + 4 * q4 + r;
                const bool valid = (key <= hi) && (key > lowcol);
                const float sv = valid ? st[kt][r] : -1e30f;
                st[kt][r] = sv; lmax = fmaxf(lmax, sv);
            }
    } else {
        const float cs = colsel ? 0.f : -1e30f;
#pragma unroll
        for (int kt = 0; kt < 4; ++kt)
#pragma unroll
            for (int r = 0; r < 4; ++r) { const float sv = st[kt][r] + cs; st[kt][r] = sv; lmax = fmaxf(lmax, sv); }
    }
    lmax = colmax(lmax);
    const float mnew = fmaxf(m, lmax);
    const float alpha = ex2(m - mnew);
    float psum = 0.f;
#pragma unroll
    for (int kt = 0; kt < 4; ++kt)
#pragma unroll
        for (int r = 0; r < 4; ++r) {
            float pv = ex2(st[kt][r] - mnew);
            if (MASK) pv = (st[kt][r] > -1e29f) ? pv : 0.f;
            st[kt][r] = pv; psum += pv;
        }
    l = l * alpha + psum;
    if (__any(mnew > m)) {
#pragma unroll
        for (int mt = 0; mt < 4; ++mt) { O[mt][0] *= alpha; O[mt][1] *= alpha; O[mt][2] *= alpha; O[mt][3] *= alpha; }
    }
    m = mnew;
#pragma unroll
    for (int kb = 0; kb < 2; ++kb) {
        union { bf16x8 v; unsigned u[4]; } pb;
        pb.u[0] = pack2(st[2 * kb][0], st[2 * kb][1]); pb.u[1] = pack2(st[2 * kb][2], st[2 * kb][3]);
        pb.u[2] = pack2(st[2 * kb + 1][0], st[2 * kb + 1][1]); pb.u[3] = pack2(st[2 * kb + 1][2], st[2 * kb + 1][3]);
#pragma unroll
        for (int mt = 0; mt < 4; ++mt) O[mt] = mfma16(vf[kb * 4 + mt], pb.v, O[mt]);
    }
}
DEV unsigned pick4(unsigned a0, unsigned a1, unsigned a2, unsigned a3, int w) { return w == 0 ? a0 : (w == 1 ? a1 : (w == 2 ? a2 : a3)); }
template <int CTRL> DEV unsigned dpp_or(unsigned x) { return x | dppu<CTRL>(x); }
DEV unsigned row_or(unsigned x) { x = dpp_or<0xB1>(x); x = dpp_or<0x4E>(x); x = dpp_or<0x124>(x); x = dpp_or<0x128>(x); return x; }


DEV void nsa_branch_lds(unsigned char* lds, const u16* __restrict__ K0, const u16* __restrict__ VT0, unsigned bu0, unsigned bu1, unsigned bu2,
                        unsigned bu3, unsigned ua0, unsigned ua1, unsigned ua2, unsigned ua3, unsigned ub0, unsigned ub1, unsigned ub2, unsigned ub3,
                        const unsigned* cm, int tokl, const int (&tcol)[2], const int (&lowc)[2], const bf16x8 (&qf)[2][2], float (&m)[2],
                        float (&l)[2], f32x4 (&O)[2][4], int q4, int cidx, int cur, int lowmax) {
    const int tid = TID();
    int w = 0; unsigned bits = bu0;
    auto advance = [&]() -> int {
        while (bits == 0u && w < 3) { ++w; bits = pick4(bu0, bu1, bu2, bu3, w); }
        if (bits == 0u) return -1;
        const int jb = __builtin_ctz(bits); bits &= bits - 1u;
        return w * 32 + jb;
    };
    const int srow0 = tid >> 3, srow1 = srow0 + 32, sch = tid & 7;
    const int so0 = srow0 * 128 + ((sch ^ (srow0 & 7)) << 4), so1 = srow1 * 128 + ((sch ^ (srow1 & 7)) << 4);
    bf16x8 r0[4], r1[4];
#define NSA_GLOAD(R, BLK_) { R[0] = ld8(K0 + ((size_t)(BLK_) * 64 + srow0) * 64 + sch * 8); R[1] = ld8(K0 + ((size_t)(BLK_) * 64 + srow1) * 64 + sch * 8); \
        R[2] = ld8(VT0 + (size_t)srow0 * 8192 + (BLK_) * 64 + sch * 8); R[3] = ld8(VT0 + (size_t)srow1 * 8192 + (BLK_) * 64 + sch * 8); }
#define NSA_LWRITE(R, BUF_) { unsigned char* wb_ = lds + (BUF_) * 16384; *(bf16x8*)(wb_ + so0) = R[0]; *(bf16x8*)(wb_ + so1) = R[1]; \
        *(bf16x8*)(wb_ + 8192 + so0) = R[2]; *(bf16x8*)(wb_ + 8192 + so1) = R[3]; }
    auto compute = [&](int blk, int buf) {
        const int wq = blk >> 5, jb = blk & 31;
        const bool act0 = (pick4(ua0, ua1, ua2, ua3, wq) >> jb) & 1u, act1 = (pick4(ub0, ub1, ub2, ub3, wq) >> jb) & 1u;
        if (act0 || act1) {
            const unsigned char* kb_ = lds + buf * 16384;
            const bool need_mask = (blk == cur) || (blk * 64 <= lowmax);
            f32x4 st0[4], st1[4];
            {
                bf16x8 kf[8];
#pragma unroll
                for (int kt = 0; kt < 4; ++kt)
#pragma unroll
                    for (int s2 = 0; s2 < 2; ++s2) {
                        const int row = 16 * kt + cidx, ch = 4 * s2 + q4;
                        kf[2 * kt + s2] = *(const bf16x8*)(kb_ + row * 128 + ((ch ^ (row & 7)) << 4));
                    }
                if (act0) qk_tile(kf, qf[0][0], qf[0][1], st0);
                if (act1) qk_tile(kf, qf[1][0], qf[1][1], st1);
            }
            __builtin_amdgcn_sched_barrier(0);
            bf16x8 vf[8];
#pragma unroll
            for (int kb = 0; kb < 2; ++kb)
#pragma unroll
                for (int mt = 0; mt < 4; ++mt) {
                    const int row = 16 * mt + cidx, ch = 4 * kb + q4;
                    vf[kb * 4 + mt] = *(const bf16x8*)(kb_ + 8192 + row * 128 + ((ch ^ (row & 7)) << 4));
                }
            if (act0) {
                const bool cs = cm ? (((cm[tokl * 4 + wq] >> jb) & 1u) != 0u) : true;
                softmax_pv_tile(need_mask, st0, vf, blk * 64, tcol[0], lowc[0], cs, m[0], l[0], O[0], q4);
            }
            if (act1) {
                const bool cs = cm ? (((cm[(4 + tokl) * 4 + wq] >> jb) & 1u) != 0u) : true;
                softmax_pv_tile(need_mask, st1, vf, blk * 64, tcol[1], lowc[1], cs, m[1], l[1], O[1], q4);
            }
        }
    };
    int b0 = advance();
    if (b0 < 0) return;
    int b1 = advance();
    NSA_GLOAD(r0, b0);
    if (b1 >= 0) NSA_GLOAD(r1, b1);
    NSA_LWRITE(r0, 0);
    __syncthreads();
#pragma unroll 1
    while (b0 >= 0) {
        const int b2 = (b1 >= 0) ? advance() : -1;
        if (b2 >= 0) NSA_GLOAD(r0, b2);
        compute(b0, 0);
        if (b1 >= 0) NSA_LWRITE(r1, 1);
        __syncthreads();
        if (b1 < 0) break;
        const int b3 = (b2 >= 0) ? advance() : -1;
        if (b3 >= 0) NSA_GLOAD(r1, b3);
        compute(b1, 1);
        if (b2 >= 0) NSA_LWRITE(r0, 0);
        __syncthreads();
        b0 = b2; b1 = b3;
    }
#undef NSA_GLOAD
#undef NSA_LWRITE
}

DEV void nsa_block_task(const Params& p, int task, unsigned char* lds) {
    const int wave = TID() >> 6;
    float* wl = (float*)(lds + 32768) + wave * 2112;
    unsigned* bm = (unsigned*)(lds + 32768 + 4 * 8448);
    float* impA = wl; float* impB = wl + 1024; unsigned* selmask = (unsigned*)(wl + 1024 + 1056);
    unsigned char* ws = p.ws;
    const u16* Q = (const u16*)(ws + OFF_Q);
    const u16* KVb = (const u16*)(ws + OFF_KV);
    const u16 *KSEL = KVb + (size_t)2 * 4194304, *VSELT = KVb + (size_t)3 * 4194304, *KWIN = KVb + (size_t)4 * 4194304, *VWINT = KVb + (size_t)5 * 4194304;
    const u16* KC = (const u16*)(ws + OFF_KC); const u16* VCT = (const u16*)(ws + OFF_VCT);
    const float* GATE = (const float*)(ws + OFF_GATE);
    u16* mix = (u16*)(ws + OFF_MIX);
    const int lane = TID() & 63, q4 = lane >> 4, cidx = lane & 15;
    const int bg = task & 7, t0b = (255 - (task >> 3)) * 32, t0 = t0b + 8 * wave; const int b = bg >> 1, g = bg & 1;
    const int tokl = cidx >> 2, hr = cidx & 3; const int head = g * 4 + hr;
    const int cur = t0 >> 6;
    int tcol[2], rowc[2]; bf16x8 qf[2][2];
#pragma unroll
    for (int ti = 0; ti < 2; ++ti) {
        tcol[ti] = t0 + 4 * ti + tokl; rowc[ti] = b * 8192 + tcol[ti];
        qf[ti][0] = ld8(Q + (size_t)rowc[ti] * 512 + head * 64 + 8 * q4); qf[ti][1] = ld8(Q + (size_t)rowc[ti] * 512 + head * 64 + 32 + 8 * q4);
    }
    f32x4 Oc[2][4];
    {
        int cnt_col[2];
#pragma unroll
        for (int ti = 0; ti < 2; ++ti) cnt_col[ti] = tcol[ti] >= 31 ? ((tcol[ti] - 31) >> 4) + 1 : 0;
        const int tmax = t0 + 7; const int cmax = tmax >= 31 ? ((tmax - 31) >> 4) + 1 : 0;
        const int ntile = (cmax + 15) >> 4;
        const u16* kcb = KC + (size_t)bg * 512 * 64;
        float ml[2] = {-1e30f, -1e30f}, ll[2] = {0.f, 0.f};
#pragma unroll 1
        for (int kt = 0; kt < ntile; ++kt) {
            const u16* kp = kcb + (kt * 16 + cidx) * 64 + 8 * q4;
            const bf16x8 k0 = ld8(kp), k1 = ld8(kp + 32);
#pragma unroll
            for (int ti = 0; ti < 2; ++ti) {
                f32x4 st = mfma16(k0, qf[ti][0], (f32x4){0.f, 0.f, 0.f, 0.f});
                st = mfma16(k1, qf[ti][1], st);
                float sv[4]; float tm = -1e30f;
#pragma unroll
                for (int r = 0; r < 4; ++r) { const int n = kt * 16 + 4 * q4 + r; sv[r] = (n < cnt_col[ti]) ? st[r] : -1e30f; tm = fmaxf(tm, sv[r]); }
                const float mn = fmaxf(ml[ti], tm);
                float ps = 0.f;
#pragma unroll
                for (int r = 0; r < 4; ++r) ps += (sv[r] > -1e29f) ? ex2(sv[r] - mn) : 0.f;
                ll[ti] = ll[ti] * ex2(ml[ti] - mn) + ps; ml[ti] = mn;
            }
        }
        float mfin[2], inv[2];
#pragma unroll
        for (int ti = 0; ti < 2; ++ti) {
            mfin[ti] = colmax(ml[ti]);
            const float lsum = colsum(ll[ti] * ex2(ml[ti] - mfin[ti]));
            inv[ti] = (cnt_col[ti] > 0) ? 1.f / lsum : 0.f;
        }
#pragma unroll
        for (int ti = 0; ti < 2; ++ti)
#pragma unroll
            for (int mt = 0; mt < 4; ++mt) Oc[ti][mt] = (f32x4){0.f, 0.f, 0.f, 0.f};
        const int npair = (ntile + 1) >> 1;
#pragma unroll 1
        for (int kp2 = 0; kp2 < npair; ++kp2) {
            const int n0 = kp2 * 32;
            const u16* kp = kcb + (n0 + cidx) * 64 + 8 * q4;
            const bf16x8 ka0 = ld8(kp), ka1 = ld8(kp + 32), kb0 = ld8(kp + 1024), kb1 = ld8(kp + 1024 + 32);
            bf16x8 vf[4];
#pragma unroll
            for (int mt = 0; mt < 4; ++mt) vf[mt] = ld8(VCT + ((size_t)bg * 64 + 16 * mt + cidx) * 512 + n0 + 8 * q4);
#pragma unroll
            for (int ti = 0; ti < 2; ++ti) {
                float pa[4], pb_[4];
                f32x4 st = mfma16(ka0, qf[ti][0], (f32x4){0.f, 0.f, 0.f, 0.f});
                st = mfma16(ka1, qf[ti][1], st);
                f32x4 su = mfma16(kb0, qf[ti][0], (f32x4){0.f, 0.f, 0.f, 0.f});
                su = mfma16(kb1, qf[ti][1], su);
#pragma unroll
                for (int r = 0; r < 4; ++r) {
                    const int n = n0 + 4 * q4 + r;
                    pa[r] = (n < cnt_col[ti]) ? ex2(st[r] - mfin[ti]) * inv[ti] : 0.f;
                    pb_[r] = (n + 16 < cnt_col[ti]) ? ex2(su[r] - mfin[ti]) * inv[ti] : 0.f;
                }
                const float owna = quadsum(pa[0] + pa[1] + pa[2] + pa[3]), tha = quadsum(pa[3]);
                const float ownb = quadsum(pb_[0] + pb_[1] + pb_[2] + pb_[3]), thb = quadsum(pb_[3]);
                if (hr == 0) {
                    const int tk = 4 * ti + tokl;
                    const int sa = (n0 >> 2) + q4, sb2 = ((n0 + 16) >> 2) + q4;
                    impA[tk * 128 + sa] = owna; impB[tk * 132 + sa + 1] = tha;
                    impA[tk * 128 + sb2] = ownb; impB[tk * 132 + sb2 + 1] = thb;
                }
                union { bf16x8 v; unsigned u[4]; } pk;
                pk.u[0] = pack2(pa[0], pa[1]); pk.u[1] = pack2(pa[2], pa[3]); pk.u[2] = pack2(pb_[0], pb_[1]); pk.u[3] = pack2(pb_[2], pb_[3]);
#pragma unroll
                for (int mt = 0; mt < 4; ++mt) Oc[ti][mt] = mfma16(vf[mt], pk.v, Oc[ti][mt]);
            }
        }
#pragma unroll
        for (int ti = 0; ti < 2; ++ti) {
            const float gc = GATE[(size_t)rowc[ti] * 24 + head];
#pragma unroll
            for (int mt = 0; mt < 4; ++mt)
#pragma unroll
                for (int r = 0; r < 4; ++r) Oc[ti][mt][r] *= gc;
        }
    }
    lds_fence();
#pragma unroll 1
    for (int rd = 0; rd < 2; ++rd) {
        const int tk = 4 * rd + q4;
        unsigned m0 = 0u, m1 = 0u, m2 = 0u, m3 = 0u;
        if (cur < 16) { m0 = (2u << cur) - 1u; }
        else {
            unsigned key[8];
#pragma unroll
            for (int i = 0; i < 8; ++i) {
                const int sblk = cidx + 16 * i;
                const bool cand = (sblk >= 1) && (sblk <= cur - 2);
                const float v = impA[tk * 128 + sblk] + impB[tk * 132 + sblk];
                key[i] = cand ? ((__float_as_uint(v) & ~0x7Fu) | (unsigned)(127 - sblk)) : 0u;
            }
            int mysel = (cidx == 0) ? 0 : (cidx == 1 ? cur - 1 : (cidx == 2 ? cur : -1));
#pragma unroll 1
            for (int it = 0; it < 13; ++it) {
                unsigned mx = key[0];
#pragma unroll
                for (int i = 1; i < 8; ++i) mx = max(mx, key[i]);
                mx = max(mx, dppu<0xB1>(mx)); mx = max(mx, dppu<0x4E>(mx)); mx = max(mx, dppu<0x124>(mx)); mx = max(mx, dppu<0x128>(mx));
                const int sblk = 127 - (int)(mx & 127u);
#pragma unroll
                for (int i = 0; i < 8; ++i) key[i] = (key[i] == mx) ? 0u : key[i];
                if (cidx == it + 3) mysel = sblk;
            }
            const unsigned bit = 1u << (mysel & 31); const int wsel = mysel >> 5;
            m0 = row_or(wsel == 0 ? bit : 0u); m1 = row_or(wsel == 1 ? bit : 0u); m2 = row_or(wsel == 2 ? bit : 0u); m3 = row_or(wsel == 3 ? bit : 0u);
        }
        if (cidx < 4) selmask[tk * 4 + cidx] = (cidx == 0) ? m0 : (cidx == 1 ? m1 : (cidx == 2 ? m2 : m3));
    }
    lds_fence();
    f32x4* accl = (f32x4*)wl;
#pragma unroll
    for (int ti = 0; ti < 2; ++ti)
#pragma unroll
        for (int mt = 0; mt < 4; ++mt) accl[(ti * 4 + mt) * 64 + lane] = Oc[ti][mt];
    {
        float m[2] = {-1e30f, -1e30f}, l[2] = {0.f, 0.f}; f32x4 Os[2][4];
#pragma unroll
        for (int ti = 0; ti < 2; ++ti)
#pragma unroll
            for (int mt = 0; mt < 4; ++mt) Os[ti][mt] = (f32x4){0.f, 0.f, 0.f, 0.f};
        {
            unsigned ua[4], ub[4], bu[4];
#pragma unroll
            for (int w = 0; w < 4; ++w) {
                ua[w] = __builtin_amdgcn_readfirstlane(row_or(selmask[tokl * 4 + w]));
                ub[w] = __builtin_amdgcn_readfirstlane(row_or(selmask[(4 + tokl) * 4 + w]));
            }
            if (lane < 4) bm[wave * 4 + lane] = (lane == 0) ? (ua[0] | ub[0]) : (lane == 1 ? (ua[1] | ub[1]) : (lane == 2 ? (ua[2] | ub[2]) : (ua[3] | ub[3])));
            __syncthreads();
#pragma unroll
            for (int w = 0; w < 4; ++w) bu[w] = __builtin_amdgcn_readfirstlane(bm[w] | bm[4 + w] | bm[8 + w] | bm[12 + w]);
            const int lowc[2] = {-1, -1};
            nsa_branch_lds(lds, KSEL + (size_t)bg * 8192 * 64, VSELT + (size_t)bg * 64 * 8192, bu[0], bu[1], bu[2], bu[3], ua[0], ua[1], ua[2], ua[3], ub[0],
                           ub[1], ub[2], ub[3], selmask, tokl, tcol, lowc, qf, m, l, Os, q4, cidx, cur, -1);
        }
#pragma unroll
        for (int ti = 0; ti < 2; ++ti) {
            const float sc = GATE[(size_t)rowc[ti] * 24 + 8 + head] / colsum(l[ti]);
#pragma unroll
            for (int mt = 0; mt < 4; ++mt)
#pragma unroll
                for (int r = 0; r < 4; ++r) Os[ti][mt][r] *= sc;
        }
        lds_fence();
#pragma unroll
        for (int ti = 0; ti < 2; ++ti)
#pragma unroll
            for (int mt = 0; mt < 4; ++mt) { f32x4 a = accl[(ti * 4 + mt) * 64 + lane]; a += Os[ti][mt]; accl[(ti * 4 + mt) * 64 + lane] = a; }
    }
    {
        float m[2] = {-1e30f, -1e30f}, l[2] = {0.f, 0.f}; f32x4 Ow[2][4];
#pragma unroll
        for (int ti = 0; ti < 2; ++ti)
#pragma unroll
            for (int mt = 0; mt < 4; ++mt) Ow[ti][mt] = (f32x4){0.f, 0.f, 0.f, 0.f};
        int wb0 = (t0 - 511) >> 6; if (wb0 < 0) wb0 = 0;
        int wbb = (t0b - 511) >> 6; if (wbb < 0) wbb = 0;
        {
            unsigned uw[4], bu[4];
#pragma unroll
            for (int w = 0; w < 4; ++w) {
                const int hi = cur - 32 * w;
                unsigned mk = 0u, mkb = 0u;
                if (hi >= 0) {
                    const unsigned upper = (hi >= 31) ? 0xffffffffu : ((2u << hi) - 1u);
                    const int lo = wb0 - 32 * w, lob = wbb - 32 * w;
                    if (lo <= 31) mk = upper & ~((lo <= 0) ? 0u : ((1u << lo) - 1u));
                    if (lob <= 31) mkb = upper & ~((lob <= 0) ? 0u : ((1u << lob) - 1u));
                }
                uw[w] = mk; bu[w] = mkb;
            }
            const int lowc[2] = {tcol[0] - 512, tcol[1] - 512};
            nsa_branch_lds(lds, KWIN + (size_t)bg * 8192 * 64, VWINT + (size_t)bg * 64 * 8192, bu[0], bu[1], bu[2], bu[3], uw[0], uw[1], uw[2], uw[3], uw[0],
                           uw[1], uw[2], uw[3], nullptr, tokl, tcol, lowc, qf, m, l, Ow, q4, cidx, cur, t0 + 7 - 512);
        }
#pragma unroll
        for (int ti = 0; ti < 2; ++ti) {
            const float sc = GATE[(size_t)rowc[ti] * 24 + 16 + head] / colsum(l[ti]);
#pragma unroll
            for (int mt = 0; mt < 4; ++mt)
#pragma unroll
                for (int r = 0; r < 4; ++r) Ow[ti][mt][r] *= sc;
        }
        lds_fence();
#pragma unroll
        for (int ti = 0; ti < 2; ++ti)
#pragma unroll
            for (int mt = 0; mt < 4; ++mt) {
                const f32x4 a = accl[(ti * 4 + mt) * 64 + lane];
                const f32x4 o = Ow[ti][mt];
                u32x2 wv; wv[0] = pack2(a[0] + o[0], a[1] + o[1]); wv[1] = pack2(a[2] + o[2], a[3] + o[3]);
                *(u32x2*)(mix + (size_t)rowc[ti] * 1024 + 512 + head * 64 + 16 * mt + 4 * q4) = wv;
            }
    }


    __syncthreads();
}

template <int N> DEV void ltmask(const float (&v)[N], float x, unsigned (&mk)[N / 32]) {
#pragma unroll
    for (int w = 0; w < N / 32; ++w) {
        unsigned a0 = 0u, a1 = 0u, a2 = 0u, a3 = 0u;
#pragma unroll
        for (int i = 0; i < 8; ++i) {
            a0 = __builtin_amdgcn_alignbit(a0, __float_as_uint(v[w * 32 + i] - x), 31);
            a1 = __builtin_amdgcn_alignbit(a1, __float_as_uint(v[w * 32 + 8 + i] - x), 31);
            a2 = __builtin_amdgcn_alignbit(a2, __float_as_uint(v[w * 32 + 16 + i] - x), 31);
            a3 = __builtin_amdgcn_alignbit(a3, __float_as_uint(v[w * 32 + 24 + i] - x), 31);
        }
        mk[w] = (a0 << 24) | (a1 << 16) | (a2 << 8) | a3;
    }
}
template <int N> DEV int count_ge(const float (&v)[N], float x) {
    unsigned mk[N / 32]; ltmask<N>(v, x, mk);
    int lt = 0;
#pragma unroll
    for (int w = 0; w < N / 32; ++w) lt += __popc(mk[w]);
    return colsumi(N - lt);
}
template <int N> DEV void refine16(const float (&v)[N], float lo, int clo, float hi, int chi, float& lo_o, float& hi_o) {
    bool done = false;
    if (clo == 16) { hi = lo; done = true; }
#pragma unroll 1
    for (int it = 0; it < 200; ++it) {
        if (__all(done)) break;
        float f = 0.5f;
        if (!(it & 1)) { f = ((float)clo - 15.5f) / (float)(clo - chi); f = fminf(fmaxf(f, 0.04f), 0.96f); }
        const float mid = lo + (hi - lo) * f;
        const bool stuck = !(mid > lo && mid < hi);
        const int c = count_ge<N>(v, mid);
        if (!done) {
            if (stuck) { if (f != 0.5f) {   } else done = true; }
            else if (c == 16) { lo = mid; hi = mid; done = true; }
            else if (c > 16) { lo = mid; clo = c; }
            else { hi = mid; chi = c; }
        }
    }
    lo_o = lo; hi_o = hi;
}
template <int N> DEV void select16(const float (&v)[N], float& lo_o, float& hi_o) {
    float mx = v[0], mn = v[0], sm = v[0];
#pragma unroll
    for (int i = 1; i < N; ++i) { mx = fmaxf(mx, v[i]); mn = fminf(mn, v[i]); sm += v[i]; }
    mx = colmax(mx); mn = -colmax(-mn); sm = colsum(sm);
    const float hi = mx + fabsf(mx) * 1e-6f + 1e-30f;
    float lo = sm * (1.f / (4.f * N));
    int clo = count_ge<N>(v, lo);
    if (clo < 16) { lo = mn; clo = 4 * N; }
    refine16<N>(v, lo, clo, hi, 0, lo_o, hi_o);
}
DEV void col_offsets(int cntA, int cntT, int q4, int cidx, int& offA, int& offT) {
    const int g0 = __shfl(cntA, cidx), g1 = __shfl(cntA, cidx + 16), g2 = __shfl(cntA, cidx + 32), g3 = __shfl(cntA, cidx + 48);
    const int e0 = __shfl(cntT, cidx), e1 = __shfl(cntT, cidx + 16), e2 = __shfl(cntT, cidx + 32);
    offA = (q4 > 0 ? g0 : 0) + (q4 > 1 ? g1 : 0) + (q4 > 2 ? g2 : 0);
    offT = g0 + g1 + g2 + g3 + (q4 > 0 ? e0 : 0) + (q4 > 1 ? e1 : 0) + (q4 > 2 ? e2 : 0);
}

DEV void peer_topk_task2(const Params& p, int l, int task, float* wl) {
    unsigned char* ws = p.ws;
    const u16* QP = (const u16*)(ws + OFF_QP);
    const u16* K12 = (const u16*)(ws + OFF_K12) + (size_t)l * 2 * 16384;
    const int lane = TID() & 63, q4 = lane >> 4, cidx = lane & 15;
    const int tq = task * 2 + (cidx >> 3), hh = cidx & 7;
    float* scl = wl;
    float* lst = wl + 2048;
    float* vv[2] = {lst, lst + 512}; int* ii[2] = {(int*)(lst + 256), (int*)(lst + 768)};
    float* fs = lst + 1024; int* fi = (int*)(lst + 1280);
#pragma unroll 1
    for (int hf = 0; hf < 2; ++hf) {
        bf16x8 qf[4];
#pragma unroll
        for (int s2 = 0; s2 < 4; ++s2) qf[s2] = ld8(QP + (size_t)tq * 2048 + hh * 256 + hf * 128 + 32 * s2 + 8 * q4);
        float sc[32];
        const u16* kb = K12 + hf * 16384;
#pragma unroll
        for (int kt = 0; kt < 8; ++kt) {
            f32x4 st = (f32x4){0.f, 0.f, 0.f, 0.f};
#pragma unroll
            for (int s2 = 0; s2 < 4; ++s2) st = mfma16(ld8(kb + (kt * 16 + cidx) * 128 + 32 * s2 + 8 * q4), qf[s2], st);
#pragma unroll
            for (int r = 0; r < 4; ++r) sc[kt * 4 + r] = st[r];
            *(f32x4*)(scl + cidx * 128 + 16 * kt + 4 * q4) = st;
        }
        float lo, hi; select16<32>(sc, lo, hi);
        unsigned mh[1], ml_[1];
        ltmask<32>(sc, hi, mh); ltmask<32>(sc, lo, ml_);
        unsigned mA = ~mh[0], mT = ~ml_[0] & mh[0];
        int offA, offT; col_offsets(__popc(mA), __popc(mT), q4, cidx, offA, offT);
        float* vo = hf ? vv[1] : vv[0]; int* io = hf ? ii[1] : ii[0];
        lds_fence();
        while (__any(mA != 0u)) {
            if (mA) {
                const int i = __clz(mA); mA &= ~(0x80000000u >> i);
                const int n = 16 * (i >> 2) + 4 * q4 + (i & 3);
                vo[cidx * 16 + offA] = scl[cidx * 128 + n]; io[cidx * 16 + offA] = n; ++offA;
            }
        }
        while (__any(mT != 0u)) {
            if (mT) {
                const int i = __clz(mT); mT &= ~(0x80000000u >> i);
                const int n = 16 * (i >> 2) + 4 * q4 + (i & 3);
                if (offT < 16) { vo[cidx * 16 + offT] = scl[cidx * 128 + n]; io[cidx * 16 + offT] = n; }
                ++offT;
            }
        }
        lds_fence();
    }
    {
        float cand[64];
        float v2r[16];
#pragma unroll
        for (int j = 0; j < 16; ++j) v2r[j] = vv[1][cidx * 16 + j];
#pragma unroll
        for (int a = 0; a < 4; ++a) {
            const float v1a = vv[0][cidx * 16 + 4 * q4 + a];
#pragma unroll
            for (int j = 0; j < 16; ++j) cand[a * 16 + j] = v1a + v2r[j];
        }
        float lo, hi;
        {
            float v2mx = v2r[0], v2mn = v2r[0];
#pragma unroll
            for (int j = 1; j < 16; ++j) { v2mx = fmaxf(v2mx, v2r[j]); v2mn = fminf(v2mn, v2r[j]); }
            float v1mx = fmaxf(fmaxf(vv[0][cidx * 16 + 4 * q4], vv[0][cidx * 16 + 4 * q4 + 1]), fmaxf(vv[0][cidx * 16 + 4 * q4 + 2], vv[0][cidx * 16 + 4 * q4 + 3]));
            float v1mn = fminf(fminf(vv[0][cidx * 16 + 4 * q4], vv[0][cidx * 16 + 4 * q4 + 1]), fminf(vv[0][cidx * 16 + 4 * q4 + 2], vv[0][cidx * 16 + 4 * q4 + 3]));
            v1mx = colmax(v1mx); v1mn = -colmax(-v1mn);
            const float smax = v1mx + v2mx;
            const float hi0 = smax + fabsf(smax) * 1e-6f + 1e-30f;
            const float lo0 = fmaxf(v1mn + v2mx, v1mx + v2mn);
            const int c0 = count_ge<64>(cand, lo0);
            refine16<64>(cand, lo0, c0, hi0, 0, lo, hi);
        }
        unsigned mh[2], ml_[2];
        ltmask<64>(cand, hi, mh); ltmask<64>(cand, lo, ml_);
        unsigned mA0 = ~mh[0], mA1 = ~mh[1], mT0 = ~ml_[0] & mh[0], mT1 = ~ml_[1] & mh[1];
        int offA, offT; col_offsets(__popc(mA0) + __popc(mA1), __popc(mT0) + __popc(mT1), q4, cidx, offA, offT);
#pragma unroll
        for (int w = 0; w < 2; ++w) {
            unsigned mA = w ? mA1 : mA0;
            while (__any(mA != 0u)) {
                if (mA) {
                    const int i = __clz(mA); mA &= ~(0x80000000u >> i);
                    const int it = w * 32 + i; const int ci = (4 * q4 + (it >> 4)) * 16 + (it & 15);
                    fs[cidx * 16 + offA] = vv[0][cidx * 16 + (ci >> 4)] + vv[1][cidx * 16 + (ci & 15)]; fi[cidx * 16 + offA] = ci; ++offA;
                }
            }
        }
#pragma unroll
        for (int w = 0; w < 2; ++w) {
            unsigned mT = w ? mT1 : mT0;
            while (__any(mT != 0u)) {
                if (mT) {
                    const int i = __clz(mT); mT &= ~(0x80000000u >> i);
                    const int it = w * 32 + i; const int ci = (4 * q4 + (it >> 4)) * 16 + (it & 15);
                    if (offT < 16) { fs[cidx * 16 + offT] = vv[0][cidx * 16 + (ci >> 4)] + vv[1][cidx * 16 + (ci & 15)]; fi[cidx * 16 + offT] = ci; }
                    ++offT;
                }
            }
        }
    }
    lds_fence();
    {
        float s4[4]; int c4[4];
#pragma unroll
        for (int k = 0; k < 4; ++k) { s4[k] = fs[cidx * 16 + 4 * q4 + k]; c4[k] = fi[cidx * 16 + 4 * q4 + k]; }
        float mx = fmaxf(fmaxf(s4[0], s4[1]), fmaxf(s4[2], s4[3]));
        mx = colmax(mx);
        float e4[4]; float sm = 0.f;
#pragma unroll
        for (int k = 0; k < 4; ++k) { e4[k] = __expf(s4[k] - mx); sm += e4[k]; }
        sm = colsum(sm);
        const float inv = 1.f / sm;
        int4 eo; float4 go;
        eo.x = ii[0][cidx * 16 + (c4[0] >> 4)] * 128 + ii[1][cidx * 16 + (c4[0] & 15)];
        eo.y = ii[0][cidx * 16 + (c4[1] >> 4)] * 128 + ii[1][cidx * 16 + (c4[1] & 15)];
        eo.z = ii[0][cidx * 16 + (c4[2] >> 4)] * 128 + ii[1][cidx * 16 + (c4[2] & 15)];
        eo.w = ii[0][cidx * 16 + (c4[3] >> 4)] * 128 + ii[1][cidx * 16 + (c4[3] & 15)];
        go.x = e4[0] * inv; go.y = e4[1] * inv; go.z = e4[2] * inv; go.w = e4[3] * inv;
        int* eol = (int*)(wl + 3584); float* gol = wl + 3584 + 256;
        *(int4*)(eol + cidx * 16 + 4 * q4) = eo; *(float4*)(gol + cidx * 16 + 4 * q4) = go;
    }
    lds_fence();
}

DEV float gelu_exact(float x) { return 0.5f * x * (1.f + erff(x * 0.70710678118654752f)); }
DEV void unpack8(const bf16x8 v, float* f) {
    union { bf16x8 v; unsigned u[4]; } c; c.v = v;
#pragma unroll
    for (int i = 0; i < 4; ++i) { f[2 * i] = bflo(c.u[i]); f[2 * i + 1] = bfhi(c.u[i]); }
}
DEV void peer_experts_token(const Params& p, int l, int tok, const int* el_src, const float* w_src) {
    unsigned char* ws = p.ws;
    const u16* H = (const u16*)(ws + OFF_H);
    u16* Hw = (u16*)(ws + OFF_H);
    const unsigned char* U8 = ws + OFF_U8;
    const unsigned char* V8 = ws + OFF_U8 + 16 * MiB;
    const float* SU = (const float*)(ws + OFF_UVS);
    const float* SV = (const float*)(ws + OFF_UVS) + 16384;
    const float* mod = (const float*)(ws + OFF_MOD);
    const float* g2 = mod + l * 4 * 6144 + 5 * 1024;
    const int lane = TID() & 63;
    {
        const int b = tok >> 13;
        float acc[16];
#pragma unroll
        for (int i = 0; i < 16; ++i) acc[i] = 0.f;
#if EN_PEER
        unsigned hp[4]; float shq; int corr0;
        {
            float hx[16];
            unpack8(ld8(H + (size_t)tok * 1024 + 16 * lane), hx);
            unpack8(ld8(H + (size_t)tok * 1024 + 16 * lane + 8), hx + 8);
            float amax = 0.f;
#pragma unroll
            for (int i = 0; i < 16; ++i) amax = fmaxf(amax, fabsf(hx[i]));
            amax = wave_max(amax);
            shq = amax > 0.f ? amax * (1.f / 127.f) : 1.f;
            const float inv = 1.f / shq;
            int hsum = 0;
#pragma unroll
            for (int i = 0; i < 4; ++i) {
                const int a = __float2int_rn(hx[4 * i] * inv) + 128, b2 = __float2int_rn(hx[4 * i + 1] * inv) + 128, c = __float2int_rn(hx[4 * i + 2] * inv) + 128,
                          d = __float2int_rn(hx[4 * i + 3] * inv) + 128;
                hp[i] = (unsigned)a | ((unsigned)b2 << 8) | ((unsigned)c << 16) | ((unsigned)d << 24);
                hsum += a + b2 + c + d;
            }
            hsum = wave_sum_i(hsum);
            corr0 = 128 * 128 * 1024 - 128 * hsum;
        }
        const int* RSU = (const int*)(ws + OFF_UVS) + 2 * 16384;
        float corr = 0.f;
        u32x4 uqA[8], vqA[8], uqB[8], vqB[8];
#define PEER_LOAD(UQ, VQ, G_) { const int el_ = el_src[((G_) >> 1) * 16 + (lane & 15)]; const int k0_ = ((G_) & 1) * 8; _Pragma("unroll") for (int k = 0; k < 8; ++k) { \
            const int e = __builtin_amdgcn_readlane(el_, k0_ + k); UQ[k] = *(const u32x4*)(U8 + (size_t)e * 1024 + 16 * lane); VQ[k] = *(const u32x4*)(V8 + (size_t)e * 1024 + 16 * lane); } }
#define PEER_EVAL(UQ, VQ, G_) { const int hh_ = (G_) >> 1, k0_ = ((G_) & 1) * 8; const int el = el_src[hh_ * 16 + (lane & 15)]; const float wgt = w_src[hh_ * 16 + (lane & 15)]; \
            const float sul = SU[el] * shq, wsl = wgt * SV[el]; const int rsl = corr0 - 128 * RSU[el]; \
            int dpart[8]; _Pragma("unroll") for (int k = 0; k < 8; ++k) { unsigned di = 0u; _Pragma("unroll") for (int i = 0; i < 4; ++i) di = __builtin_amdgcn_udot4(UQ[k][i], hp[i], di, false); dpart[k] = (int)di; } \
            const int dsum = reduce8_i(dpart); const int srcl = k0_ + (lane >> 3); \
            const float sul_e = __shfl(sul, srcl), wsl_e = __shfl(wsl, srcl); const int rsl_e = __shfl(rsl, srcl); \
            const float actl = gelu_exact((float)(dsum + rsl_e) * sul_e) * wsl_e; \
            _Pragma("unroll") for (int k = 0; k < 8; ++k) { const float act = __int_as_float(__builtin_amdgcn_readlane(__float_as_int(actl), 8 * k)); corr += act * 128.f; \
                _Pragma("unroll") for (int i = 0; i < 4; ++i) { const unsigned w = VQ[k][i]; \
                    acc[4 * i] += act * (float)(w & 0xffu); acc[4 * i + 1] += act * (float)((w >> 8) & 0xffu); acc[4 * i + 2] += act * (float)((w >> 16) & 0xffu); acc[4 * i + 3] += act * (float)(w >> 24); } } }
        PEER_LOAD(uqA, vqA, 0);
#pragma unroll 1
        for (int g = 0; g < 16; g += 2) {
            PEER_LOAD(uqB, vqB, g + 1);
            PEER_EVAL(uqA, vqA, g);
            if (g + 2 < 16) PEER_LOAD(uqA, vqA, g + 2);
            PEER_EVAL(uqB, vqB, g + 1);
        }
#undef PEER_LOAD
#undef PEER_EVAL
#pragma unroll
        for (int i = 0; i < 16; ++i) acc[i] -= corr;
#endif
        const int k = 16 * lane;
        float xn[16]; float ss = 0.f;
#pragma unroll
        for (int i = 0; i < 4; ++i) {
            const float4 x0 = *(const float4*)(p.out + (size_t)tok * 1024 + k + 4 * i);
            const float4 ga = *(const float4*)(g2 + b * 6144 + k + 4 * i);
            xn[4 * i] = x0.x + ga.x * acc[4 * i]; xn[4 * i + 1] = x0.y + ga.y * acc[4 * i + 1];
            xn[4 * i + 2] = x0.z + ga.z * acc[4 * i + 2]; xn[4 * i + 3] = x0.w + ga.w * acc[4 * i + 3];
        }
#pragma unroll
        for (int i = 0; i < 16; ++i) ss += xn[i] * xn[i];
        ss = wave_sum(ss);
        const float rs = rsqrtf(ss * (1.f / 1024.f) + 1e-6f);
        if (l == 0) {
            const float* n1g = p.in[I_N1G] + 1024; const float* sh = mod + 4 * 6144 + b * 6144; const float* sc = sh + 1024;
            float hv[16];
#pragma unroll
            for (int i = 0; i < 4; ++i) {
                *(float4*)(p.out + (size_t)tok * 1024 + k + 4 * i) = (float4){xn[4 * i], xn[4 * i + 1], xn[4 * i + 2], xn[4 * i + 3]};
                const float4 gg = *(const float4*)(n1g + k + 4 * i), s1 = *(const float4*)(sc + k + 4 * i), s0 = *(const float4*)(sh + k + 4 * i);
                hv[4 * i] = xn[4 * i] * rs * gg.x * (1.f + s1.x) + s0.x; hv[4 * i + 1] = xn[4 * i + 1] * rs * gg.y * (1.f + s1.y) + s0.y;
                hv[4 * i + 2] = xn[4 * i + 2] * rs * gg.z * (1.f + s1.z) + s0.z; hv[4 * i + 3] = xn[4 * i + 3] * rs * gg.w * (1.f + s1.w) + s0.w;
            }
            u32x4 w0, w1;
#pragma unroll
            for (int i = 0; i < 4; ++i) { w0[i] = pack2(hv[2 * i], hv[2 * i + 1]); w1[i] = pack2(hv[8 + 2 * i], hv[8 + 2 * i + 1]); }
            *(u32x4*)(Hw + (size_t)tok * 1024 + k) = w0; *(u32x4*)(Hw + (size_t)tok * 1024 + k + 8) = w1;
        } else {
            const float* fg = p.in[I_FG];
#pragma unroll
            for (int i = 0; i < 4; ++i) {
                const float4 gg = *(const float4*)(fg + k + 4 * i);
                *(float4*)(p.out + (size_t)tok * 1024 + k + 4 * i) = (float4){xn[4 * i] * rs * gg.x, xn[4 * i + 1] * rs * gg.y, xn[4 * i + 2] * rs * gg.z, xn[4 * i + 3] * rs * gg.w};
            }
        }
    }
}

constexpr int NPH = 20;

__global__ void __launch_bounds__(256, 2) mega(Params p) {
    __shared__ __attribute__((aligned(16))) unsigned char lds[81920 - 128];
    __shared__ int misc[8];
    int* qslot = misc;
    cg::grid_group grid = cg::this_grid();
    if (threadIdx.x < 8) misc[threadIdx.x] = 0;
    __syncthreads();
    XcdBarrier xbar = xcd_barrier_post((unsigned*)(p.ws + OFF_BAR), (volatile unsigned*)(misc + 4));
    unsigned char* ws = p.ws;
    const float* mod = (const float*)(ws + OFF_MOD);
    unsigned* ctl = (unsigned*)(ws + OFF_CTL);
    const int G = gridDim.x, bx = BID();
    for (int ph = p.ph_lo; ph < p.ph_hi; ++ph) {
        if (ph >= 2 && (ph - 2) % 9 == 8) continue;
        if (ph == 0) {
            phase_prep(p, lds);
        } else if (ph == 1) {
            phase_norm(p.in[I_X], p.in[I_N1G], mod + 0 * 1024, mod + 1 * 1024, (u16*)(ws + OFF_H));
        } else {
            const int l = (ph - 2) / 9, sp = (ph - 2) % 9;
            const float* modl = mod + l * 4 * 6144;
            if (sp == 0) {
                EpiInProj e{(u16*)(ws + OFF_PCONV), (u16*)(ws + OFF_PRWKV), (u16*)(ws + OFF_Q), (u16*)(ws + OFF_KV), (float*)(ws + OFF_GATE)};
                gemm_phase((const u16*)(ws + OFF_H), 1024, (const u16*)(ws + OFF_WIN) + (size_t)l * NINP * 1024, 1024, 256, 8, 1024, e, lds, bx, G, 0, 4);
            } else if (sp == 1) {
#if EN_RWKV
                for (;;) { const int t = block_next(ctl + QW(l, Q_RWP), qslot); if (t >= NTOK / 16) break; rwkv_prep_tile2(p, l, t, lds); }
#endif
            } else if (sp == 2) {
#if EN_RWKV
                if (bx < 64) { __builtin_amdgcn_s_setprio(3); rwkv_scan(p, bx, lds); __builtin_amdgcn_s_setprio(0); }
#endif
                unsigned* cdone = ctl + QW(l, 5);
                unsigned* gdone = ctl + QW(l, 6);
                if (bx >= 64) {
                    EpiInProj e{(u16*)(ws + OFF_PCONV), (u16*)(ws + OFF_PRWKV), (u16*)(ws + OFF_Q), (u16*)(ws + OFF_KV), (float*)(ws + OFF_GATE)};
                    gemm_phase((const u16*)(ws + OFF_H), 1024, (const u16*)(ws + OFF_WIN) + (size_t)l * NINP * 1024, 1024, 256, 15, 1024, e, lds, bx - 64, G - 64, 4, 8, false);
                    asm volatile("s_waitcnt vmcnt(0)" ::: "memory");
                    __syncthreads();
                    if (threadIdx.x == 0) {
                        __builtin_amdgcn_fence(__ATOMIC_RELEASE, "agent");
                        asm volatile("s_waitcnt vmcnt(0)" ::: "memory");
                        __hip_atomic_fetch_add(gdone, 1u, __ATOMIC_RELAXED, __HIP_MEMORY_SCOPE_AGENT);
                    }
                }
                __syncthreads();
                if (threadIdx.x == 0) {
                    unsigned sp_ = 0;
                    while (__hip_atomic_load(gdone, __ATOMIC_RELAXED, __HIP_MEMORY_SCOPE_AGENT) < (unsigned)(G - 64)) { __builtin_amdgcn_s_sleep(8); if (++sp_ > (1u << 24)) break; }
                    __builtin_amdgcn_fence(__ATOMIC_ACQUIRE, "agent");
                    asm volatile("s_waitcnt vmcnt(0)" ::: "memory");
                }
                __syncthreads();
                if (bx >= 64 && bx < 128) {
                    const u16* KVb = (const u16*)(ws + OFF_KV);
                    if (bx < 96) {
                        EpiCompress ek{(const float*)(ws + OFF_CBP) + (l * 2 + 0) * 2048, p.in[I_CKW2] + (size_t)l * 8192, (u16*)(ws + OFF_KC), 0, lds};
                        gemm_phase(KVb, 1024, (const u16*)(ws + OFF_CW1) + (size_t)(l * 2 + 0) * 128 * 2048, 2048, 32, 1, 2048, ek, lds, bx - 64, 1 << 20);
                    } else {
                        EpiCompress ev{(const float*)(ws + OFF_CBP) + (l * 2 + 1) * 2048, p.in[I_CVW2] + (size_t)l * 8192, (u16*)(ws + OFF_VCT), 1, lds};
                        gemm_phase(KVb + 4194304, 1024, (const u16*)(ws + OFF_CW1) + (size_t)(l * 2 + 1) * 128 * 2048, 2048, 32, 1, 2048, ev, lds, bx - 96, 1 << 20);
                    }
                    asm volatile("s_waitcnt vmcnt(0)" ::: "memory");
                    __syncthreads();
                    if (threadIdx.x == 0) {
                        __builtin_amdgcn_fence(__ATOMIC_RELEASE, "agent");
                        asm volatile("s_waitcnt vmcnt(0)" ::: "memory");
                        __hip_atomic_fetch_add(cdone, 1u, __ATOMIC_RELAXED, __HIP_MEMORY_SCOPE_AGENT);
                    }
                }
#if EN_CONV
                for (;;) { const int t = block_next(ctl + QW(l, Q_CONV), qslot); if (t >= NTOK / 32) break; conv_tile(p, l, t, lds); }
#else
                zero_mix_cols(p, 0, 256);
#endif
                __syncthreads();
                if (threadIdx.x == 0) {
                    unsigned sp_ = 0;
                    while (__hip_atomic_load(cdone, __ATOMIC_RELAXED, __HIP_MEMORY_SCOPE_AGENT) < 64u) { __builtin_amdgcn_s_sleep(8); if (++sp_ > (1u << 24)) break; }
                    __builtin_amdgcn_fence(__ATOMIC_ACQUIRE, "agent");
                    asm volatile("s_waitcnt vmcnt(0)" ::: "memory");
                }
                __syncthreads();
                for (;;) { const int t = block_next(ctl + QW(l, Q_NSA), qslot); if (t >= 2048) break; nsa_block_task(p, t, lds); }
                if (l == 0) {
                    float* fl = (float*)lds;
                    for (;;) {
                        const int t = block_next(ctl + QW(0, 0), qslot); if (t >= 1536) break;
                        if (t < 512) { const int l2 = t >> 8, r = t & 255; transpose_tile(p.in[I_WOUT] + (size_t)l2 * 1024 * 1024, 1024, (u16*)(ws + OFF_WOUT) + (size_t)l2 * 1024 * 1024, 1024, r >> 4, r & 15, fl); }
                        else { const int u = t - 512; const int l2 = u >> 9, r = u & 511; transpose_tile(p.in[I_PWQ] + (size_t)l2 * 1024 * 2048, 2048, (u16*)(ws + OFF_WQ) + (size_t)l2 * 2048 * 1024, 1024, r >> 5, r & 31, fl); }
                    }
                }
                for (;;) {
                    const int t = block_next(ctl + QW(l, 7), qslot); if (t >= 1024) break;
                    const int tb = t >> 9, r0 = (t & 511) * 32;
                    convert_rows_task(p.in[tb ? I_PV : I_PU] + (size_t)l * 16384 * 1024, ws + OFF_U8 + (size_t)tb * 16 * MiB, (float*)(ws + OFF_UVS) + tb * 16384,
                                      tb ? nullptr : (int*)(ws + OFF_UVS) + 2 * 16384, r0);
                }
            } else if (sp == 3) {
#if EN_RWKV
                phase_rwkv_post(p, l);
#else
                zero_mix_cols(p, 256, 256);
#endif
            } else if (sp == 4) {
                EpiOutProj e{l == 0 ? p.in[I_X] : p.out, p.out, modl + 2 * 1024};
                gemm_phase((const u16*)(ws + OFF_MIX), 1024, (const u16*)(ws + OFF_WOUT) + (size_t)l * 1024 * 1024, 1024, 256, 8, 1024, e, lds, bx, G);
            } else if (sp == 5) {
#if EN_PEER
                phase_norm(p.out, p.in[I_N2G] + l * 1024, modl + 3 * 1024, modl + 4 * 1024, (u16*)(ws + OFF_H));
#endif
            } else if (sp == 6) {
#if EN_PEER
                EpiStoreBf16 e{(u16*)(ws + OFF_QP), 2048};
                gemm_phase((const u16*)(ws + OFF_H), 1024, (const u16*)(ws + OFF_WQ) + (size_t)l * 2048 * 1024, 1024, 256, 16, 1024, e, lds, bx, G);
#endif
            } else if (sp == 7) {
#if EN_PEER
                float* wl = (float*)lds + (TID() >> 6) * 4096;
                for (int t = bx * 4 + (TID() >> 6); t < NTOK / 2; t += G * 4) {
                    peer_topk_task2(p, l, t, wl);
                    peer_experts_token(p, l, 2 * t, (const int*)(wl + 3584), wl + 3584 + 256);
                    peer_experts_token(p, l, 2 * t + 1, (const int*)(wl + 3584) + 128, wl + 3584 + 256 + 128);
                    lds_fence();
                }
#endif
            }
        }
        if (ph + 1 < p.ph_hi) { if (p.ph_lo < 0) grid.sync(); else xcd_barrier(xbar); }
    }
}

extern "C" void kernel_launch(void* const* d_in, const int* in_sizes, int n_in, void* d_out, int out_size, void* d_ws, size_t ws_size,
                              hipStream_t stream) {
    static int grid_blocks = 0;
    if (!grid_blocks) {
        int dev = 0, cus = 0, per_cu = 0;
        hipGetDevice(&dev);
        hipDeviceGetAttribute(&cus, hipDeviceAttributeMultiprocessorCount, dev);
        hipOccupancyMaxActiveBlocksPerMultiprocessor(&per_cu, (const void*)mega, 256, 0);
        if (per_cu > 2) per_cu = 2;
        if (per_cu < 1) per_cu = 1;
        grid_blocks = cus * per_cu;
        if (ws_size < WS_NEED) fprintf(stderr, "kernel_launch: workspace too small: %zu < %zu\n", ws_size, (size_t)WS_NEED);
    }
    hipMemsetAsync((char*)d_ws + OFF_CTL, 0, CTL_ZERO_BYTES, stream);
    Params p{};
    for (int i = 0; i < 35; ++i) p.in[i] = (const float*)d_in[i];
    p.out = (float*)d_out;
    p.ws = (unsigned char*)d_ws;
#if MULTI_LAUNCH
    for (int ph = 0; ph < NPH; ++ph) {
        p.ph_lo = ph; p.ph_hi = ph + 1;
        hipLaunchKernelGGL(mega, dim3(grid_blocks), dim3(256), 0, stream, p);
    }
#else
    p.ph_lo = 0; p.ph_hi = NPH;
    void* args[] = {&p};
    hipError_t e = hipLaunchCooperativeKernel((const void*)mega, dim3(grid_blocks), dim3(256), args, 0, stream);
    if (e != hipSuccess) fprintf(stderr, "cooperative launch failed: %s (grid %d)\n", hipGetErrorString(e), grid_blocks);
#endif
}
```

```cpp
#include <hip/hip_runtime.h>
#include <hip/hip_cooperative_groups.h>
#include <stdint.h>
#include <stdio.h>
namespace cg = cooperative_groups;

#ifndef EN_CONV
#define EN_CONV 1
#endif
#ifndef EN_RWKV
#define EN_RWKV 1
#endif
#ifndef EN_NSA_CMP
#define EN_NSA_CMP 1
#endif
#ifndef EN_NSA_WIN
#define EN_NSA_WIN 1
#endif
#ifndef EN_NSA_SEL
#define EN_NSA_SEL 1
#endif
#ifndef EN_PEER
#define EN_PEER 1
#endif
#ifndef MULTI_LAUNCH
#define MULTI_LAUNCH 0
#endif

#define DEV __device__ __forceinline__
typedef unsigned short u16;
typedef __attribute__((ext_vector_type(8))) short bf16x8;
typedef __attribute__((ext_vector_type(4))) float f32x4;
typedef __attribute__((ext_vector_type(4))) unsigned int u32x4;
typedef __attribute__((ext_vector_type(2))) unsigned int u32x2;

constexpr int NB = 4, NT = 8192, ND = 1024, NTOK = NB * NT, NL = 2;
constexpr int NIN = 2840, NINP = 2944;
constexpr size_t MiB = 1ull << 20;

constexpr size_t OFF_CTL = 0;
constexpr size_t CTL_ZERO_BYTES = 32768;
constexpr size_t OFF_BAR = 16384;
constexpr size_t OFF_MOD = 64 * 1024;
constexpr size_t OFF_CBP = 256 * 1024;
constexpr size_t OFF_WIN = 1 * MiB;
constexpr size_t OFF_WOUT = 13 * MiB;
constexpr size_t OFF_WQ = 17 * MiB;
constexpr size_t OFF_CW1 = 25 * MiB;
constexpr size_t OFF_K12 = 27 * MiB;
constexpr size_t OFF_LW = 27 * MiB + 512 * 1024;
constexpr size_t OFF_U8 = 28 * MiB;
constexpr size_t OFF_UVS = 512 * 1024;
constexpr size_t OFF_H = 92 * MiB;
constexpr size_t OFF_MIX = 156 * MiB;
constexpr size_t OFF_E = 220 * MiB;
constexpr size_t OFF_PCONV = OFF_E + 0;
constexpr size_t OFF_PRWKV = OFF_E + 32 * MiB;
constexpr size_t OFF_YRAW = OFF_E + 32 * MiB;
constexpr size_t OFF_Q = OFF_E + 96 * MiB;
constexpr size_t OFF_KV = OFF_E + 128 * MiB;
constexpr size_t OFF_GATE = OFF_E + 176 * MiB;
constexpr size_t OFF_KC = OFF_E + 180 * MiB;
constexpr size_t OFF_VCT = OFF_KC + 512 * 1024;
constexpr size_t OFF_RV = OFF_E + 184 * MiB;
constexpr size_t OFF_RKK = OFF_E + 200 * MiB;
constexpr size_t OFF_RKKA = OFF_E + 216 * MiB;
constexpr size_t OFF_RG = OFF_E + 232 * MiB;
constexpr size_t OFF_BONUS = OFF_E + 248 * MiB;
constexpr size_t OFF_RW = OFF_E + 249 * MiB;
constexpr size_t OFF_RR = 60 * MiB;
constexpr size_t OFF_RK = 76 * MiB;
constexpr size_t OFF_QP = OFF_E + 0;
constexpr size_t OFF_PIDX = OFF_E + 128 * MiB;
constexpr size_t OFF_PGW = OFF_E + 144 * MiB;
constexpr size_t WS_NEED = OFF_E + 281 * MiB;

#define QW(l, q) (64 * ((l) * 8 + (q)))
enum { Q_CMP = 0, Q_CONV = 1, Q_RWP = 2, Q_NSA = 3, Q_PTK = 4 };

enum { I_X = 0, I_C, I_ADAW, I_ADAB, I_N1G, I_N2G, I_WIN, I_CDW, I_CDB, I_CGG, I_CGB, I_MU, I_W0, I_WUP, I_A0, I_AUP, I_GUP,
       I_KK, I_KA, I_RK, I_LNG, I_LNB, I_CKPOS, I_CKW1, I_CKW2, I_CVPOS, I_CVW1, I_CVW2, I_WOUT, I_PWQ, I_PK1, I_PK2, I_PU, I_PV, I_FG };

struct Params {
    const float* in[35];
    float* out;
    unsigned char* ws;
    int ph_lo, ph_hi;
};

DEV int TID() { int t = threadIdx.x; asm volatile("" : "+v"(t)); return t; }
DEV int BID() { int t = blockIdx.x; asm volatile("" : "+s"(t)); return t; }
typedef __attribute__((ext_vector_type(2))) float f32x2_t;
typedef __attribute__((ext_vector_type(2))) __bf16 bf16x2_t;
DEV unsigned pack2(float a, float b) { const f32x2_t v = {a, b}; return __builtin_bit_cast(unsigned, __builtin_convertvector(v, bf16x2_t)); }
DEV u16 f2bf(float f) { const __bf16 h = (__bf16)f; return __builtin_bit_cast(u16, h); }
DEV float bf2f(u16 h) { return __uint_as_float(((unsigned)h) << 16); }
DEV float bflo(unsigned u) { return __uint_as_float(u << 16); }
DEV float bfhi(unsigned u) { return __uint_as_float(u & 0xffff0000u); }
DEV float ex2(float x) { return __builtin_amdgcn_exp2f(x); }
DEV float sigmoidf_(float x) { return 1.f / (1.f + __expf(-x)); }

DEV f32x4 mfma16(bf16x8 a, bf16x8 b, f32x4 c) { return __builtin_amdgcn_mfma_f32_16x16x32_bf16(a, b, c, 0, 0, 0); }
template <int CTRL> DEV float dppf(float x) { return __int_as_float(__builtin_amdgcn_update_dpp(0, __float_as_int(x), CTRL, 0xF, 0xF, false)); }
template <int CTRL> DEV unsigned dppu(unsigned x) { return (unsigned)__builtin_amdgcn_update_dpp(0, (int)x, CTRL, 0xF, 0xF, false); }
DEV float reduce16(float x) { x += dppf<0xB1>(x); x += dppf<0x4E>(x); x += dppf<0x124>(x); x += dppf<0x128>(x); return x; }
DEV float quadsum(float x) { x += dppf<0xB1>(x); x += dppf<0x4E>(x); return x; }
DEV float x16_sum(float x) { auto r = __builtin_amdgcn_permlane16_swap(__float_as_uint(x), __float_as_uint(x), false, false); return __uint_as_float(r[0]) + __uint_as_float(r[1]); }
DEV float x32_sum(float x) { auto r = __builtin_amdgcn_permlane32_swap(__float_as_uint(x), __float_as_uint(x), false, false); return __uint_as_float(r[0]) + __uint_as_float(r[1]); }
DEV float x16_max(float x) { auto r = __builtin_amdgcn_permlane16_swap(__float_as_uint(x), __float_as_uint(x), false, false); return fmaxf(__uint_as_float(r[0]), __uint_as_float(r[1])); }
DEV float x32_max(float x) { auto r = __builtin_amdgcn_permlane32_swap(__float_as_uint(x), __float_as_uint(x), false, false); return fmaxf(__uint_as_float(r[0]), __uint_as_float(r[1])); }
DEV int x16_sumi(int x) { auto r = __builtin_amdgcn_permlane16_swap((unsigned)x, (unsigned)x, false, false); return (int)(r[0] + r[1]); }
DEV int x32_sumi(int x) { auto r = __builtin_amdgcn_permlane32_swap((unsigned)x, (unsigned)x, false, false); return (int)(r[0] + r[1]); }
DEV float colsum(float x) { return x32_sum(x16_sum(x)); }
DEV float colmax(float x) { return x32_max(x16_max(x)); }
DEV int colsumi(int x) { return x32_sumi(x16_sumi(x)); }
DEV float wave_sum(float v) { return x32_sum(x16_sum(reduce16(v))); }
DEV int wave_sum_i(int x) {
    x += (int)dppu<0xB1>((unsigned)x); x += (int)dppu<0x4E>((unsigned)x); x += (int)dppu<0x124>((unsigned)x); x += (int)dppu<0x128>((unsigned)x);
    return x32_sumi(x16_sumi(x));
}
DEV int reduce8_i(const int (&d)[8]) {
    int t[4];
#pragma unroll
    for (int k = 0; k < 4; ++k) {
        auto r = __builtin_amdgcn_permlane32_swap((unsigned)d[k], (unsigned)d[k + 4], false, false);
        t[k] = (int)(r[0] + r[1]);
    }
    int u[2];
#pragma unroll
    for (int k = 0; k < 2; ++k) {
        auto r = __builtin_amdgcn_permlane16_swap((unsigned)t[k], (unsigned)t[k + 2], false, false);
        u[k] = (int)(r[0] + r[1]);
    }
    const bool hi8 = (threadIdx.x & 8) != 0;
    int x = hi8 ? u[1] : u[0];
    const int y = hi8 ? u[0] : u[1];
    x += (int)dppu<0x128>((unsigned)y);
    x += (int)dppu<0xB1>((unsigned)x); x += (int)dppu<0x4E>((unsigned)x); x += (int)dppu<0x141>((unsigned)x);
    return x;
}
DEV float wave_max(float x) {
    x = fmaxf(x, dppf<0xB1>(x)); x = fmaxf(x, dppf<0x4E>(x)); x = fmaxf(x, dppf<0x124>(x)); x = fmaxf(x, dppf<0x128>(x));
    return x32_max(x16_max(x));
}
DEV void lds_fence() { asm volatile("s_waitcnt lgkmcnt(0)" ::: "memory"); }
DEV bf16x8 ld8(const u16* p) { return *(const bf16x8*)p; }

DEV int block_next(unsigned* ctr, int* slot) {
    __syncthreads();
    if (TID() == 0) *slot = (int)atomicAdd(ctr, 1u);
    __syncthreads();
    return *slot;
}

#define XB_TMO      128
#define XB_XCNT(j)  (256  + 64 * (j))
#define XB_XSUB(j)  (1280 + 64 * (j))
#define XB_XGEN(j)  (2304 + 64 * (j))
#define XB_TOP      3328
#define XB_TOPGEN   3392
#define XCD_BAR_WORDS 3456
#define XB_SPIN_CAP (1u << 22)
#define LAS __attribute__((address_space(3)))
DEV unsigned xb_ld(unsigned* p) { return __hip_atomic_load(p, __ATOMIC_RELAXED, __HIP_MEMORY_SCOPE_AGENT); }
DEV unsigned xb_add(unsigned* p, unsigned v) { return __hip_atomic_fetch_add(p, v, __ATOMIC_RELAXED, __HIP_MEMORY_SCOPE_AGENT); }
DEV unsigned xb_xcc_id() { return (unsigned)__builtin_amdgcn_s_getreg((3 << 11) | 20) & 0xFu; }
#define XB_SPIN(cond, bar) do { unsigned _sp = 0; while (cond) { __builtin_amdgcn_s_sleep(1); \
    if ((++_sp & 255u) == 0u) { if (xb_ld(&(bar)[XB_TMO])) break; if (_sp > XB_SPIN_CAP) { atomicAdd(&(bar)[XB_TMO], 1u); break; } } } } while (0)
struct XcdBarrier { unsigned* bar; unsigned x; volatile unsigned* st; };
DEV XcdBarrier xcd_barrier_post(unsigned* bar, volatile unsigned* st) {
    XcdBarrier b; b.bar = bar; b.x = xb_xcc_id(); b.st = st;
    if (threadIdx.x == 0) (void)xb_add(&bar[XB_XCNT(b.x)], 1u);
    return b;
}
DEV void xcd_barrier_complete(unsigned* bar, unsigned x, unsigned& nloc, unsigned& nx) {
    const unsigned G = gridDim.x * gridDim.y * gridDim.z;
    unsigned sum, cnt, mine, sp = 0u;
    for (;;) {
        sum = 0u; cnt = 0u; mine = 0u;
#pragma unroll
        for (unsigned j = 0; j < 16; ++j) { const unsigned c = xb_ld(&bar[XB_XCNT(j)]); sum += c; cnt += (c > 0u) ? 1u : 0u; mine = (j == x) ? c : mine; }
        if (sum == G) break;
        __builtin_amdgcn_s_sleep(1);
        if ((++sp & 255u) == 0u) { if (xb_ld(&bar[XB_TMO])) break; if (sp > XB_SPIN_CAP) { atomicAdd(&bar[XB_TMO], 1u); break; } }
    }
    nloc = mine > 0u ? mine : 1u; nx = cnt > 0u ? cnt : 1u;
}
DEV void xcd_barrier(const XcdBarrier& b) {
    asm volatile("s_waitcnt vmcnt(0)" ::: "memory");
    __syncthreads();
    if (threadIdx.x == 0) {
        unsigned* bar = b.bar;
        __builtin_amdgcn_s_waitcnt(0);
        unsigned nloc = b.st[0], nx = b.st[1];
        if (nloc == 0u) { xcd_barrier_complete(bar, b.x, nloc, nx); b.st[0] = nloc; b.st[1] = nx; }
        const unsigned old = xb_add(&bar[XB_XSUB(b.x)], 1u);
        const unsigned gen = old / nloc;
        if (old + 1u == (gen + 1u) * nloc) {
            __builtin_amdgcn_fence(__ATOMIC_RELEASE, "agent");
            asm volatile("s_waitcnt vmcnt(0)" ::: "memory");
            const unsigned og = xb_add(&bar[XB_TOP], 1u);
            const unsigned tg = og / nx;
            if (og + 1u == (tg + 1u) * nx) xb_add(&bar[XB_TOPGEN], 1u);
            else XB_SPIN(xb_ld(&bar[XB_TOPGEN]) == tg, bar);
            __builtin_amdgcn_fence(__ATOMIC_ACQUIRE, "agent");
            xb_add(&bar[XB_XGEN(b.x)], 1u);
            asm volatile("s_waitcnt vmcnt(0)" ::: "memory");
        } else {
            XB_SPIN(xb_ld(&bar[XB_XGEN(b.x)]) == gen, bar);
            __builtin_amdgcn_fence(__ATOMIC_ACQUIRE, "agent");
            asm volatile("s_waitcnt vmcnt(0)" ::: "memory");
        }
    }
    __syncthreads();
}

template <class Epi>
DEV void gemm_phase(const u16* __restrict__ A, int lda, const u16* __restrict__ Bt, int ldb, int mtiles, int ntiles, int K, Epi& epi,
                    unsigned char* lds, int bid, int nb, int nt_lo = 0, int nt_skip = 0, bool xcd_order = true) {
    const int tid = TID(), lane = tid & 63, wave = tid >> 6;
    const int wm = wave >> 1, wn = wave & 1, q4 = lane >> 4, cidx = lane & 15;
    u16* As = (u16*)lds;
    u16* Bs = (u16*)(lds + 32768);
    const int KT = K >> 6;
    const int total = mtiles * ntiles;
    const int srow = tid >> 3, sch = tid & 7;
    const bool xo_ = xcd_order && ((nb & 7) == 0) && (nb <= 4096) && ((mtiles & 7) == 0);
    const int ngroups = (ntiles + 7) >> 3;
    const int nloc = xo_ ? (nb >> 3) : 1;
    const int nvirt = xo_ ? ((mtiles >> 3) * ngroups * 64) : total;
    for (int vt = xo_ ? ((bid & 7) * 64 + (bid >> 3)) : bid; vt < nvirt; vt += xo_ ? ((((vt & 63) + nloc) < 64) ? nloc : (8 * 64 - (vt & 63) + (bid >> 3))) : nb) {
        int mt, nt;
        if (xo_) {
            const int st = vt >> 6, tt = vt & 63;
            mt = (st / ngroups) * 8 + (tt >> 3); nt = (st % ngroups) * 8 + (tt & 7);
            if (nt >= ntiles) continue;
        } else { mt = vt / ntiles; nt = vt - mt * ntiles; }
        if (nt >= nt_lo) nt += nt_skip;
        const int m0 = mt * 128, n0 = nt * 128;
        const bool sw = epi.swapped(n0 + wn * 64);
        const int xo = sw ? (32768 / 2 + wn * 64 * 64) : (wm * 64 * 64);
        const int yo = sw ? (wm * 64 * 64) : (32768 / 2 + wn * 64 * 64);
        f32x4 acc[4][4];
#pragma unroll
        for (int i = 0; i < 4; ++i)
#pragma unroll
            for (int j = 0; j < 4; ++j) acc[i][j] = (f32x4){0.f, 0.f, 0.f, 0.f};
        const u16* Ag = A + (size_t)(m0 + srow) * lda + sch * 8;
        const u16* Bg = Bt + (size_t)(n0 + srow) * ldb + sch * 8;
        bf16x8 ra0[4], rb0[4], ra1[4], rb1[4];
#define GEMM_GLOAD(RA, RB, KT_) { const int k0_ = (KT_) * 64; _Pragma("unroll") for (int i = 0; i < 4; ++i) { RA[i] = ld8(Ag + (size_t)(32 * i) * lda + k0_); RB[i] = ld8(Bg + (size_t)(32 * i) * ldb + k0_); } }
#define GEMM_LWRITE(RA, RB, BUF_) { u16* Aw_ = As + (BUF_) * 8192; u16* Bw_ = Bs + (BUF_) * 8192; _Pragma("unroll") for (int i = 0; i < 4; ++i) { const int row = srow + 32 * i; const int off = row * 64 + ((sch ^ (row & 7)) << 3); *(bf16x8*)(Aw_ + off) = RA[i]; *(bf16x8*)(Bw_ + off) = RB[i]; } }
#define GEMM_COMPUTE(BUF_) { const u16* Xb = As + (BUF_) * 8192 + xo; const u16* Yb = As + (BUF_) * 8192 + yo; _Pragma("unroll") for (int s = 0; s < 2; ++s) { bf16x8 a[4], b[4]; const int ch = s * 4 + q4; _Pragma("unroll") for (int i = 0; i < 4; ++i) { const int row = i * 16 + cidx; a[i] = *(const bf16x8*)(Xb + row * 64 + ((ch ^ (row & 7)) << 3)); b[i] = *(const bf16x8*)(Yb + row * 64 + ((ch ^ (row & 7)) << 3)); } _Pragma("unroll") for (int i = 0; i < 4; ++i) _Pragma("unroll") for (int j = 0; j < 4; ++j) acc[i][j] = mfma16(a[i], b[j], acc[i][j]); } }
        GEMM_GLOAD(ra0, rb0, 0);
        if (KT > 1) GEMM_GLOAD(ra1, rb1, 1);
        GEMM_LWRITE(ra0, rb0, 0);
        __syncthreads();
        for (int kt = 0; kt < KT; kt += 2) {
            if (kt + 2 < KT) GEMM_GLOAD(ra0, rb0, kt + 2);
            GEMM_COMPUTE(0);
            GEMM_LWRITE(ra1, rb1, 1);
            __syncthreads();
            if (kt + 3 < KT) GEMM_GLOAD(ra1, rb1, kt + 3);
            GEMM_COMPUTE(1);
            if (kt + 2 < KT) GEMM_LWRITE(ra0, rb0, 0);
            __syncthreads();
        }
#undef GEMM_GLOAD
#undef GEMM_LWRITE
#undef GEMM_COMPUTE
        if (!sw) {
#pragma unroll
            for (int i = 0; i < 4; ++i)
#pragma unroll
                for (int j = 0; j < 4; ++j) epi.rows4(m0 + wm * 64 + i * 16 + q4 * 4, n0 + wn * 64 + j * 16 + cidx, acc[i][j]);
        } else {
#pragma unroll
            for (int i = 0; i < 4; ++i)
#pragma unroll
                for (int j = 0; j < 4; ++j) epi.cols4(m0 + wm * 64 + j * 16 + cidx, n0 + wn * 64 + i * 16 + q4 * 4, acc[i][j]);
        }
        epi.finish(m0, n0, lds);
    }
}

struct EpiInProj {
    u16 *pconv, *prwkv, *q, *kv; float* gate;
    DEV bool swapped(int c0) const { return !((c0 >= 2432 && c0 < 2560) || (c0 >= 2688 && c0 < 2816)); }
    DEV void rows4(int row0, int col, f32x4 v) const {
        const int c = col - 2048; const int idx = c >> 7; const int g = (c >> 6) & 1; const int d = c & 63;
        const int b = row0 >> 13; const int t0 = row0 & 8191; const int bg = b * 2 + g;
        u16* base = kv + (size_t)idx * 4194304;
        const int k = t0 & 31; const int p0 = 8 * ((k & 15) >> 2) + 4 * (k >> 4);
        u32x2 w; w[0] = pack2(v[0], v[1]); w[1] = pack2(v[2], v[3]);
        *(u32x2*)(base + (size_t)(bg * 64 + d) * 8192 + (t0 & ~31) + p0) = w;
    }
    DEV void cols4(int row, int col0, f32x4 v) const {
        if (col0 < 512) {
            u32x2 w; w[0] = pack2(v[0], v[1]); w[1] = pack2(v[2], v[3]);
            *(u32x2*)(pconv + (size_t)row * 512 + col0) = w;
        } else if (col0 < 1536) {
            u32x2 w; w[0] = pack2(v[0], v[1]); w[1] = pack2(v[2], v[3]);
            *(u32x2*)(prwkv + (size_t)row * 1024 + (col0 - 512)) = w;
        } else if (col0 < 2048) {
            const float sc = 0.18033688011112042f;
            u32x2 w; w[0] = pack2(v[0] * sc, v[1] * sc); w[1] = pack2(v[2] * sc, v[3] * sc);
            *(u32x2*)(q + (size_t)row * 512 + (col0 - 1536)) = w;
        } else if (col0 < 2816) {
            const int c = col0 - 2048; const int idx = c >> 7; const int g = (c >> 6) & 1; const int d = c & 63;
            const int b = row >> 13; const int t = row & 8191; const int bg = b * 2 + g;
            u32x2 w; w[0] = pack2(v[0], v[1]); w[1] = pack2(v[2], v[3]);
            *(u32x2*)(kv + (size_t)idx * 4194304 + ((size_t)bg * 8192 + t) * 64 + d) = w;
        } else if (col0 < 2840) {
            *(float4*)(gate + (size_t)row * 24 + (col0 - 2816)) = (float4){sigmoidf_(v[0]), sigmoidf_(v[1]), sigmoidf_(v[2]), sigmoidf_(v[3])};
        }
    }
    DEV void finish(int, int, unsigned char*) const {}
};

struct EpiOutProj {
    const float* xold; float* xnew; const float* g1;
    DEV bool swapped(int) const { return true; }
    DEV void rows4(int, int, f32x4) const {}
    DEV void cols4(int row, int col0, f32x4 v) const {
        const int b = row >> 13; const float4 gg = *(const float4*)(g1 + b * 6144 + col0);
        const size_t o = (size_t)row * 1024 + col0;
        const float4 x = *(const float4*)(xold + o);
        *(float4*)(xnew + o) = (float4){x.x + gg.x * v[0], x.y + gg.y * v[1], x.z + gg.z * v[2], x.w + gg.w * v[3]};
    }
    DEV void finish(int, int, unsigned char*) const {}
};

struct EpiStoreBf16 {
    u16* out; int ld;
    DEV bool swapped(int) const { return true; }
    DEV void rows4(int, int, f32x4) const {}
    DEV void cols4(int row, int col0, f32x4 v) const {
        u32x2 w; w[0] = pack2(v[0], v[1]); w[1] = pack2(v[2], v[3]);
        *(u32x2*)(out + (size_t)row * ld + col0) = w;
    }
    DEV void finish(int, int, unsigned char*) const {}
};

struct EpiCompress {
    const float* cbp;
    const float* w2;
    u16* outp;
    int isv;
    unsigned char* lds;
    DEV bool swapped(int) const { return false; }
    DEV void cols4(int, int, f32x4) const {}
    DEV void rows4(int row0, int col, f32x4 v) const {
        float* hid = (float*)lds;
        const int rl = row0 & 127;
#pragma unroll
        for (int r = 0; r < 4; ++r) hid[(rl + r) * 128 + col] = v[r];
    }
    DEV void finish(int m0, int, unsigned char*) const {
        __syncthreads();
        {
            float* hw = (float*)lds;
            const int t = TID(); const int c = t & 127, r0 = (t >> 7) * 64;
            float bias = 0.f;
#pragma unroll
            for (int s = 0; s < 16; ++s) bias += cbp[s * 128 + c];
#pragma unroll 4
            for (int r = 0; r < 64; ++r) { const float x = hw[(r0 + r) * 128 + c] + bias; hw[(r0 + r) * 128 + c] = x * sigmoidf_(x); }
        }
        __syncthreads();
        const float* hid = (const float*)lds;
        const int tid = TID(); const int d = tid & 63, rgp = tid >> 6;
        float acc[32];
#pragma unroll
        for (int i = 0; i < 32; ++i) acc[i] = 0.f;
#pragma unroll 1
        for (int j0 = 0; j0 < 128; j0 += 8) {
            float wv[8];
#pragma unroll
            for (int jj = 0; jj < 8; ++jj) wv[jj] = w2[(j0 + jj) * 64 + d];
#pragma unroll
            for (int rr = 0; rr < 32; ++rr) {
                const float4 h0 = *(const float4*)(hid + (rgp * 32 + rr) * 128 + j0), h1 = *(const float4*)(hid + (rgp * 32 + rr) * 128 + j0 + 4);
                acc[rr] += h0.x * wv[0] + h0.y * wv[1] + h0.z * wv[2] + h0.w * wv[3] + h1.x * wv[4] + h1.y * wv[5] + h1.z * wv[6] + h1.w * wv[7];
            }
        }
#pragma unroll
        for (int rr = 0; rr < 32; ++rr) {
            const int m = m0 + rgp * 32 + rr; const int bg = m >> 9, n = m & 511;
            const u16 val = (n == 511) ? (u16)0 : f2bf(acc[rr]);
            if (!isv) outp[((size_t)bg * 512 + n) * 64 + d] = val;
            else {
                const int k = n & 31; const int pp = 8 * ((k & 15) >> 2) + (k & 3) + 4 * (k >> 4);
                outp[((size_t)bg * 64 + d) * 512 + (n & ~31) + pp] = val;
            }
        }
        __syncthreads();
    }
};

DEV void transpose_tile(const float* __restrict__ src, int N, u16* __restrict__ dst, int ldk, int kt, int nt, float* tl) {
    const int tid = TID(); const int k0 = kt * 64, n0 = nt * 64;
#pragma unroll 4
    for (int i = 0; i < 16; ++i) {
        const int idx = tid + 256 * i; const int kr = idx >> 6, nc = idx & 63; const int n = n0 + nc;
        tl[kr * 65 + nc] = (n < N) ? src[(size_t)(k0 + kr) * N + n] : 0.f;
    }
    __syncthreads();
#pragma unroll 4
    for (int i = 0; i < 16; ++i) {
        const int idx = tid + 256 * i; const int nr = idx >> 6, kc = idx & 63;
        dst[(size_t)(n0 + nr) * ldk + k0 + kc] = f2bf(tl[kc * 65 + nr]);
    }
    __syncthreads();
}

DEV void convert_straight(const float* __restrict__ src, u16* __restrict__ dst, size_t n) {
    const size_t stride = (size_t)gridDim.x * 256 * 8;
    for (size_t i = ((size_t)BID() * 256 + TID()) * 8; i < n; i += stride) {
        const float4 a = *(const float4*)(src + i); const float4 b = *(const float4*)(src + i + 4);
        u32x4 w; w[0] = pack2(a.x, a.y); w[1] = pack2(a.z, a.w); w[2] = pack2(b.x, b.y); w[3] = pack2(b.z, b.w);
        *(u32x4*)(dst + i) = w;
    }
}

DEV void convert_rows_task(const float* __restrict__ src, unsigned char* __restrict__ dst, float* __restrict__ scale, int* __restrict__ rowsum, int row0) {
    const int lane = TID() & 63, wave = TID() >> 6;
#pragma unroll 1
    for (int it = 0; it < 4; ++it) {
        float4 v[2][4]; float amax[2] = {0.f, 0.f};
#pragma unroll
        for (int u = 0; u < 2; ++u) {
            const int row = row0 + wave * 8 + it * 2 + u;
#pragma unroll
            for (int i = 0; i < 4; ++i) v[u][i] = *(const float4*)(src + (size_t)row * 1024 + 16 * lane + 4 * i);
        }
#pragma unroll
        for (int u = 0; u < 2; ++u) {
#pragma unroll
            for (int i = 0; i < 4; ++i)
                amax[u] = fmaxf(amax[u], fmaxf(fmaxf(fabsf(v[u][i].x), fabsf(v[u][i].y)), fmaxf(fabsf(v[u][i].z), fabsf(v[u][i].w))));
            amax[u] = wave_max(amax[u]);
            const int row = row0 + wave * 8 + it * 2 + u;
            const float sc = amax[u] > 0.f ? amax[u] * (1.f / 127.f) : 1.f;
            const float inv = 1.f / sc;
            u32x4 w;
#pragma unroll
            for (int i = 0; i < 4; ++i) {
                const int a = __float2int_rn(v[u][i].x * inv) + 128, b = __float2int_rn(v[u][i].y * inv) + 128, c = __float2int_rn(v[u][i].z * inv) + 128,
                          d = __float2int_rn(v[u][i].w * inv) + 128;
                w[i] = (unsigned)a | ((unsigned)b << 8) | ((unsigned)c << 16) | ((unsigned)d << 24);
            }
            *(u32x4*)(dst + (size_t)row * 1024 + 16 * lane) = w;
            int bs = 0;
#pragma unroll
            for (int i = 0; i < 4; ++i) bs += (int)(w[i] & 0xffu) + (int)((w[i] >> 8) & 0xffu) + (int)((w[i] >> 16) & 0xffu) + (int)(w[i] >> 24);
            bs = wave_sum_i(bs);
            if (lane == 0) { scale[row] = sc; if (rowsum) rowsum[row] = bs; }
        }
    }
}

DEV void phase_prep(const Params& p, unsigned char* lds) {
    const int tid = TID();
    float* fl = (float*)lds;
    unsigned char* ws = p.ws;
    for (int task = BID(); task < 192; task += gridDim.x) {
        const int l = task / 96, cgp = task % 96;
        float* cs = fl;
        float* red = fl + 4096;
        for (int i = tid; i < 4096; i += 256) { const float c = p.in[I_C][i]; cs[i] = c / (1.f + __expf(-c)); }
        __syncthreads();
        const int col = cgp * 64 + (tid & 63), ks = tid >> 6;
        float a0 = 0, a1 = 0, a2 = 0, a3 = 0;
        const float* w = p.in[I_ADAW] + ((size_t)l * 1024 + ks * 256) * 6144 + col;
#pragma unroll 32
        for (int k = 0; k < 256; ++k) {
            const float wv = w[(size_t)k * 6144]; const int kk = ks * 256 + k;
            a0 += cs[kk] * wv; a1 += cs[1024 + kk] * wv; a2 += cs[2048 + kk] * wv; a3 += cs[3072 + kk] * wv;
        }
        red[(ks * 4 + 0) * 64 + (tid & 63)] = a0; red[(ks * 4 + 1) * 64 + (tid & 63)] = a1;
        red[(ks * 4 + 2) * 64 + (tid & 63)] = a2; red[(ks * 4 + 3) * 64 + (tid & 63)] = a3;
        __syncthreads();
        {
            const int b = tid >> 6, c = tid & 63;
            const float s = red[(0 * 4 + b) * 64 + c] + red[(1 * 4 + b) * 64 + c] + red[(2 * 4 + b) * 64 + c] + red[(3 * 4 + b) * 64 + c];
            const int colg = cgp * 64 + c;
            ((float*)(ws + OFF_MOD))[(l * 4 + b) * 6144 + colg] = s + p.in[I_ADAB][l * 6144 + colg];
        }
        __syncthreads();
    }
    for (int task = BID(); task < 64; task += gridDim.x) {
        const int l = task >> 5, kv = (task >> 4) & 1, s = task & 15;
        const float* pos = p.in[kv ? I_CVPOS : I_CKPOS] + l * 2048;
        const float* w1 = p.in[kv ? I_CVW1 : I_CKW1] + (size_t)l * 2048 * 128;
        const int col = tid & 127, half = tid >> 7;
        float a = 0;
        const int i0 = s * 128 + half * 64;
#pragma unroll 8
        for (int i = 0; i < 64; ++i) a += pos[i0 + i] * w1[(size_t)(i0 + i) * 128 + col];
        fl[tid] = a;
        __syncthreads();
        if (tid < 128) ((float*)(ws + OFF_CBP))[((l * 2 + kv) * 16 + s) * 128 + tid] = fl[tid] + fl[tid + 128];
        __syncthreads();
    }
    {
        for (int task = BID(); task < 2 * 16 * 46; task += gridDim.x) {
            const int l = task / (16 * 46), r = task % (16 * 46);
            transpose_tile(p.in[I_WIN] + (size_t)l * 1024 * NIN, NIN, (u16*)(ws + OFF_WIN) + (size_t)l * NINP * 1024, 1024, r / 46, r % 46, fl);
        }
        for (int task = BID(); task < 2 * 16; task += gridDim.x) {
            const int l = task >> 4, r = task & 15; const int nt = r & 3, part = r >> 2;
            u16* dst = (u16*)(ws + OFF_LW) + (size_t)l * 65536;
            if (part == 0) transpose_tile(p.in[I_WUP] + (size_t)l * 64 * 256, 256, dst, 256, 0, nt, fl);
            else if (part == 1) transpose_tile(p.in[I_AUP] + (size_t)l * 64 * 256, 256, dst + 64, 256, 0, nt, fl);
            else transpose_tile(p.in[I_GUP] + (size_t)l * 128 * 256, 256, dst + 128, 256, part - 2, nt, fl);
        }
        for (int task = BID(); task < 4 * 32 * 2; task += gridDim.x) {
            const int lk = task >> 6, r = task & 63; const int l = lk >> 1, kv = lk & 1;
            transpose_tile(p.in[kv ? I_CVW1 : I_CKW1] + (size_t)l * 2048 * 128, 128, (u16*)(ws + OFF_CW1) + (size_t)lk * 128 * 2048, 2048, r >> 1, r & 1, fl);
        }
    }
    for (int l = 0; l < 2; ++l) {
        convert_straight(p.in[I_PK1] + l * 16384, (u16*)(ws + OFF_K12) + (l * 2 + 0) * 16384, 16384);
        convert_straight(p.in[I_PK2] + l * 16384, (u16*)(ws + OFF_K12) + (l * 2 + 1) * 16384, 16384);
    }
}

DEV void phase_norm(const float* __restrict__ x, const float* __restrict__ g, const float* __restrict__ sh, const float* __restrict__ sc,
                    u16* __restrict__ h) {
    const int lane = TID() & 63;
    const int gw = BID() * 4 + (TID() >> 6), nw = gridDim.x * 4;
    for (int row = gw; row < NTOK; row += nw) {
        const int b = row >> 13;
        float4 v[4]; float ss = 0;
#pragma unroll
        for (int i = 0; i < 4; ++i) { v[i] = *(const float4*)(x + (size_t)row * 1024 + 256 * i + lane * 4); ss += v[i].x * v[i].x + v[i].y * v[i].y + v[i].z * v[i].z + v[i].w * v[i].w; }
        ss = wave_sum(ss);
        const float rs = rsqrtf(ss * (1.f / 1024.f) + 1e-6f);
#pragma unroll
        for (int i = 0; i < 4; ++i) {
            const int k = 256 * i + lane * 4;
            const float4 gg = *(const float4*)(g + k); const float4 s1 = *(const float4*)(sc + b * 6144 + k); const float4 s0 = *(const float4*)(sh + b * 6144 + k);
            u32x2 w;
            w[0] = pack2(v[i].x * rs * gg.x * (1.f + s1.x) + s0.x, v[i].y * rs * gg.y * (1.f + s1.y) + s0.y);
            w[1] = pack2(v[i].z * rs * gg.z * (1.f + s1.z) + s0.z, v[i].w * rs * gg.w * (1.f + s1.w) + s0.w);
            *(u32x2*)(h + (size_t)row * 1024 + k) = w;
        }
    }
}

DEV void conv_tile(const Params& p, int l, int tile, unsigned char* lds) {
    float* ul = (float*)lds;
    const int tid = TID();
    unsigned char* ws = p.ws;
    const u16* pconv = (const u16*)(ws + OFF_PCONV);
    u16* mix = (u16*)(ws + OFF_MIX);
    const int t0g = tile * 32; const int tb = t0g & 8191;
#pragma unroll 8
    for (int rr = 0; rr < 62; ++rr) {
        const int trow = tb - 30 + rr;
        float u = 0.f;
        if (trow >= 0) {
            const size_t o = (size_t)(t0g - 30 + rr) * 512;
            const float val = bf2f(pconv[o + tid]), gt = bf2f(pconv[o + 256 + tid]);
            u = val * sigmoidf_(gt);
        }
        ul[rr * 256 + tid] = u;
    }
    __syncthreads();
    float w[31];
#pragma unroll
    for (int j = 0; j < 31; ++j) w[j] = p.in[I_CDW][(l * 31 + j) * 256 + tid];
    const float bias = p.in[I_CDB][l * 256 + tid], gg = p.in[I_CGG][l * 256 + tid], gb = p.in[I_CGB][l * 256 + tid];
    for (int tt = 0; tt < 32; ++tt) {
        float y = bias;
#pragma unroll
        for (int j = 0; j < 31; ++j) y += ul[(tt + j) * 256 + tid] * w[j];
        const float mean = wave_sum(y) * (1.f / 64.f);
        const float d = y - mean;
        const float var = wave_sum(d * d) * (1.f / 64.f);
        float o = d * rsqrtf(var + 1e-5f) * gg + gb;
        o = o * sigmoidf_(o);
        mix[(size_t)(t0g + tt) * 1024 + tid] = f2bf(o);
    }
}

DEV float softplusf_(float x) { return x > 20.f ? x : log1pf(__expf(x)); }
DEV void rwkv_prep_tile2(const Params& p, int l, int tile, unsigned char* lds) {
    u16* actb = (u16*)lds;
    const int tid = TID(), lane = tid & 63, wave = tid >> 6, q4 = lane >> 4, cidx = lane & 15;
    unsigned char* ws = p.ws;
    const u16* pr = (const u16*)(ws + OFF_PRWKV);
    const float* mu = p.in[I_MU] + l * 1024;
    const int R0 = tile * 16;
    {
        const int col = 768 + tid; const float muc = mu[col];
        u16 raw[17];
        const bool first = ((R0 & 8191) == 0);
        raw[0] = first ? (u16)0 : pr[(size_t)(R0 - 1) * 1024 + col];
#pragma unroll
        for (int tk = 0; tk < 16; ++tk) raw[tk + 1] = pr[(size_t)(R0 + tk) * 1024 + col];
#pragma unroll
        for (int tk = 0; tk < 16; ++tk) {
            const float cur = bf2f(raw[tk + 1]), prev = bf2f(raw[tk]);
            const float x = cur + (prev - cur) * muc;
            float a;
            if (tid < 64) a = tanhf(x); else if (tid < 128) a = x; else a = sigmoidf_(x);
            actb[tk * 264 + tid] = f2bf(a);
        }
    }
    __syncthreads();
    f32x4 accw[4], acca[4], accg[4];
    {
        bf16x8 af[8];
#pragma unroll
        for (int s2 = 0; s2 < 8; ++s2) af[s2] = *(const bf16x8*)(actb + cidx * 264 + 32 * s2 + 8 * q4);
        const u16* LW = (const u16*)(ws + OFF_LW) + (size_t)l * 65536;
        const f32x4 z = (f32x4){0.f, 0.f, 0.f, 0.f};
#pragma unroll
        for (int nt = 0; nt < 4; ++nt) {
            const u16* bp = LW + (size_t)(64 * wave + 16 * nt + cidx) * 256 + 8 * q4;
            accw[nt] = mfma16(af[0], ld8(bp), z); accw[nt] = mfma16(af[1], ld8(bp + 32), accw[nt]);
            acca[nt] = mfma16(af[2], ld8(bp + 64), z); acca[nt] = mfma16(af[3], ld8(bp + 96), acca[nt]);
            accg[nt] = mfma16(af[4], ld8(bp + 128), z); accg[nt] = mfma16(af[5], ld8(bp + 160), accg[nt]);
            accg[nt] = mfma16(af[6], ld8(bp + 192), accg[nt]); accg[nt] = mfma16(af[7], ld8(bp + 224), accg[nt]);
        }
    }
    float* RW = (float*)(ws + OFF_RW);
    u16 *RR = (u16*)(ws + OFF_RR), *RK = (u16*)(ws + OFF_RK), *RV = (u16*)(ws + OFF_RV), *RKK = (u16*)(ws + OFF_RKK), *RKKA = (u16*)(ws + OFF_RKKA),
        *RG = (u16*)(ws + OFF_RG);
    float* BON = (float*)(ws + OFF_BONUS);
    float w0[4], a0[4], kkc[4], kac[4], rkc[4], mur[4], muk[4], muv[4];
#pragma unroll
    for (int nt = 0; nt < 4; ++nt) {
        const int c = 64 * wave + 16 * nt + cidx;
        w0[nt] = p.in[I_W0][l * 256 + c]; a0[nt] = p.in[I_A0][l * 256 + c]; kkc[nt] = p.in[I_KK][l * 256 + c]; kac[nt] = p.in[I_KA][l * 256 + c];
        rkc[nt] = p.in[I_RK][l * 256 + c]; mur[nt] = mu[c]; muk[nt] = mu[256 + c]; muv[nt] = mu[512 + c];
    }
    u16 ld3[5][4][3];
    {
        const int rowb = R0 + 4 * q4; const bool firstrow = ((rowb & 8191) == 0);
#pragma unroll
        for (int rr_ = 0; rr_ < 5; ++rr_)
#pragma unroll
            for (int nt = 0; nt < 4; ++nt) {
                const int c = 64 * wave + 16 * nt + cidx;
                const u16* cr = pr + (size_t)(rowb - 1 + rr_) * 1024;
                const bool z = (rr_ == 0) && firstrow;
                ld3[rr_][nt][0] = z ? (u16)0 : cr[c]; ld3[rr_][nt][1] = z ? (u16)0 : cr[256 + c]; ld3[rr_][nt][2] = z ? (u16)0 : cr[512 + c];
            }
    }
#pragma unroll
    for (int r = 0; r < 4; ++r) {
        const int row = R0 + 4 * q4 + r;
        float rr[4], kf_[4], vf_[4], av[4], kkv[4], keff[4], dec[4];
        float kk2 = 0.f, bn = 0.f;
#pragma unroll
        for (int nt = 0; nt < 4; ++nt) {
            float rv = bf2f(ld3[r + 1][nt][0]), kv = bf2f(ld3[r + 1][nt][1]), vv = bf2f(ld3[r + 1][nt][2]);
            const float rp = bf2f(ld3[r][nt][0]), kp = bf2f(ld3[r][nt][1]), vp = bf2f(ld3[r][nt][2]);
            rv += (rp - rv) * mur[nt]; kv += (kp - kv) * muk[nt]; vv += (vp - vv) * muv[nt];
            const float wl = w0[nt] + accw[nt][r];
            const float wlog = -softplusf_(-wl) - 0.5f;
            dec[nt] = __expf(-__expf(wlog));
            av[nt] = sigmoidf_(a0[nt] + acca[nt][r]);
            kkv[nt] = kv * kkc[nt]; kk2 += kkv[nt] * kkv[nt];
            keff[nt] = kv * (1.f + (av[nt] - 1.f) * kac[nt]);
            bn += rv * keff[nt] * rkc[nt];
            rr[nt] = rv; kf_[nt] = kv; vf_[nt] = vv;
        }
        kk2 = reduce16(kk2); bn = reduce16(bn);
        const float inv = 1.f / fmaxf(sqrtf(kk2), 1e-12f);
#pragma unroll
        for (int nt = 0; nt < 4; ++nt) {
            const int c = 64 * wave + 16 * nt + cidx;
            const size_t o = (size_t)row * 256 + c;
            const float kk = kkv[nt] * inv;
            RW[o] = dec[nt]; RR[o] = f2bf(rr[nt]); RK[o] = f2bf(keff[nt]); RV[o] = f2bf(vf_[nt]); RKK[o] = f2bf(kk); RKKA[o] = f2bf(kk * av[nt]);
            RG[o] = f2bf(accg[nt][r]);
        }
        if (cidx == 0) BON[(size_t)row * 4 + wave] = bn;
    }
}

DEV void rwkv_scan(const Params& p, int sb, unsigned char* lds) {
    unsigned char* ws = p.ws;
    const float* RW = (const float*)(ws + OFF_RW);
    const u16 *RR = (const u16*)(ws + OFF_RR), *RK = (const u16*)(ws + OFF_RK), *RV = (const u16*)(ws + OFF_RV), *RKK = (const u16*)(ws + OFF_RKK),
              *RKKA = (const u16*)(ws + OFF_RKKA);
    float* YR = (float*)(ws + OFF_YRAW);
    const int tid = TID(), lane = tid & 63, wave = tid >> 6;
    const int bh = sb >> 2, rg = sb & 3; const int b = bh >> 2, hh = bh & 3;
    float* L = (float*)lds;
    constexpr int BUFSZ = 5 * 1024 + 256;
    float* Yb = L + 2 * BUFSZ;
    const int row_local = 4 * wave + (lane >> 4); const int kq = (lane & 15) * 4;
    const int lstep = tid >> 4, lk = (tid & 15) * 4;
    const int vstep = tid >> 4, vrow = tid & 15;
    const size_t gbase = (size_t)b * 8192 * 256 + hh * 64;
    float4 lw; u32x2 lr, lkk, lkka, lk_; u16 lv;
    auto issue = [&](int c) {
        const size_t o = gbase + (size_t)(c * 16 + lstep) * 256 + lk;
        lw = *(const float4*)(RW + o);
        lr = *(const u32x2*)(RR + o); lk_ = *(const u32x2*)(RK + o); lkk = *(const u32x2*)(RKK + o); lkka = *(const u32x2*)(RKKA + o);
        lv = RV[gbase + (size_t)(c * 16 + vstep) * 256 + rg * 16 + vrow];
    };
    auto commit = [&](int buf) {
        float* B = L + buf * BUFSZ;
        const int o = lstep * 64 + lk;
        *(float4*)(B + o) = lw;
        *(float4*)(B + 1024 + o) = (float4){bflo(lkka[0]), bfhi(lkka[0]), bflo(lkka[1]), bfhi(lkka[1])};
        *(float4*)(B + 2048 + o) = (float4){bflo(lk_[0]), bfhi(lk_[0]), bflo(lk_[1]), bfhi(lk_[1])};
        *(float4*)(B + 3072 + o) = (float4){bflo(lr[0]), bfhi(lr[0]), bflo(lr[1]), bfhi(lr[1])};
        *(float4*)(B + 4096 + o) = (float4){bflo(lkk[0]), bfhi(lkk[0]), bflo(lkk[1]), bfhi(lkk[1])};
        B[5120 + vstep * 16 + vrow] = bf2f(lv);
    };
    __syncthreads();
    issue(0); commit(0);
    __syncthreads();
    float S0 = 0.f, S1 = 0.f, S2 = 0.f, S3 = 0.f;
    constexpr int NCH = NT / 16;
    for (int c = 0; c < NCH; ++c) {
        const int buf = c & 1;
        if (c + 1 < NCH) issue(c + 1);
        const float* B = L + buf * BUFSZ;
        float* Y = Yb + buf * 256;
        float yv[16];
        float4 w4 = *(const float4*)(B + kq), a4 = *(const float4*)(B + 1024 + kq), k4 = *(const float4*)(B + 2048 + kq),
               r4 = *(const float4*)(B + 3072 + kq), n4 = *(const float4*)(B + 4096 + kq);
        float vv = B[5120 + row_local];
#pragma unroll
        for (int st = 0; st < 16; ++st) {
            float4 w4n, a4n, k4n, r4n, n4n; float vvn;
            if (st < 15) {
                w4n = *(const float4*)(B + (st + 1) * 64 + kq); a4n = *(const float4*)(B + 1024 + (st + 1) * 64 + kq);
                k4n = *(const float4*)(B + 2048 + (st + 1) * 64 + kq); r4n = *(const float4*)(B + 3072 + (st + 1) * 64 + kq);
                n4n = *(const float4*)(B + 4096 + (st + 1) * 64 + kq); vvn = B[5120 + (st + 1) * 16 + row_local];
            }
            const float part = (S0 * n4.x + S1 * n4.y) + (S2 * n4.z + S3 * n4.w);
            const float sa = -reduce16(part);
            const float t0 = S0 * w4.x + vv * k4.x, t1 = S1 * w4.y + vv * k4.y, t2 = S2 * w4.z + vv * k4.z, t3 = S3 * w4.w + vv * k4.w;
            S0 = t0 + sa * a4.x; S1 = t1 + sa * a4.y; S2 = t2 + sa * a4.z; S3 = t3 + sa * a4.w;
            const float yp = (S0 * r4.x + S1 * r4.y) + (S2 * r4.z + S3 * r4.w);
            yv[st] = reduce16(yp);
            if (st < 15) { w4 = w4n; a4 = a4n; k4 = k4n; r4 = r4n; n4 = n4n; vv = vvn; }
        }
        if ((lane & 15) == 0) {
#pragma unroll
            for (int st = 0; st < 16; ++st) Y[st * 16 + row_local] = yv[st];
        }
        if (c + 1 < NCH) commit(buf ^ 1);
        __syncthreads();
        YR[gbase + (size_t)(c * 16 + vstep) * 256 + rg * 16 + vrow] = Y[vstep * 16 + vrow];
    }
}

DEV void phase_rwkv_post(const Params& p, int l) {
    unsigned char* ws = p.ws;
    const float* YR = (const float*)(ws + OFF_YRAW); const float* BON = (const float*)(ws + OFF_BONUS);
    const u16 *RV = (const u16*)(ws + OFF_RV), *RG = (const u16*)(ws + OFF_RG);
    u16* mix = (u16*)(ws + OFF_MIX);
    const int tid = TID();
    const float lg = p.in[I_LNG][l * 256 + tid], lb = p.in[I_LNB][l * 256 + tid];
    for (int row = BID(); row < NTOK; row += gridDim.x) {
        const size_t o = (size_t)row * 256 + tid;
        const float y = YR[o];
        const float mean = wave_sum(y) * (1.f / 64.f);
        const float d = y - mean;
        const float var = wave_sum(d * d) * (1.f / 64.f);
        const float yn = d * rsqrtf(var + 64e-5f) * lg + lb;
        const float outv = (yn + BON[(size_t)row * 4 + (tid >> 6)] * bf2f(RV[o])) * bf2f(RG[o]);
        mix[(size_t)row * 1024 + 256 + tid] = f2bf(outv);
    }
}

DEV void zero_mix_cols(const Params& p, int c0, int ncols) {
    u16* mix = (u16*)(p.ws + OFF_MIX);
    const int per = ncols / 8;
    const size_t total = (size_t)NTOK * per;
    for (size_t i = (size_t)BID() * 256 + TID(); i < total; i += (size_t)gridDim.x * 256) {
        const size_t row = i / per; const int cc = (int)(i % per);
        *(u32x4*)(mix + row * 1024 + c0 + cc * 8) = (u32x4){0u, 0u, 0u, 0u};
    }
}


DEV void qk_tile(const bf16x8 (&kf)[8], bf16x8 q0, bf16x8 q1, float cinit, f32x4 (&st)[4]) {
    const f32x4 c = (f32x4){cinit, cinit, cinit, cinit};
#pragma unroll
    for (int kt = 0; kt < 4; ++kt) {
        st[kt] = mfma16(kf[2 * kt], q0, c);
        st[kt] = mfma16(kf[2 * kt + 1], q1, st[kt]);
    }
}
DEV void softmax_pv_lazy(f32x4 (&st)[4], const bf16x8 (&vf)[8], float& m, float& l, f32x4& L, f32x4 (&O)[4]) {
    float lmax = fmaxf(fmaxf(fmaxf(st[0][0], st[0][1]), fmaxf(st[0][2], st[0][3])), fmaxf(fmaxf(st[1][0], st[1][1]), fmaxf(st[1][2], st[1][3])));
    lmax = fmaxf(lmax, fmaxf(fmaxf(fmaxf(st[2][0], st[2][1]), fmaxf(st[2][2], st[2][3])), fmaxf(fmaxf(st[3][0], st[3][1]), fmaxf(st[3][2], st[3][3]))));
    lmax = colmax(lmax);
    const float dlt = (lmax > 8.f) ? lmax : 0.f;
    if (__any(dlt > 0.f)) {
        const float alpha = ex2(-dlt);
#pragma unroll
        for (int mt = 0; mt < 4; ++mt) { O[mt][0] *= alpha; O[mt][1] *= alpha; O[mt][2] *= alpha; O[mt][3] *= alpha; }
        L[0] *= alpha; L[1] *= alpha; L[2] *= alpha; L[3] *= alpha; l *= alpha; m += dlt;
#pragma unroll
        for (int kt = 0; kt < 4; ++kt) { st[kt][0] -= dlt; st[kt][1] -= dlt; st[kt][2] -= dlt; st[kt][3] -= dlt; }
    }
#pragma unroll
    for (int kt = 0; kt < 4; ++kt)
#pragma unroll
        for (int r = 0; r < 4; ++r) st[kt][r] = ex2(st[kt][r]);
    union { bf16x8 v; unsigned u[4]; } ones;
    ones.u[0] = 0x3f803f80u; ones.u[1] = 0x3f803f80u; ones.u[2] = 0x3f803f80u; ones.u[3] = 0x3f803f80u;
#pragma unroll
    for (int kb = 0; kb < 2; ++kb) {
        union { bf16x8 v; unsigned u[4]; } pb;
        pb.u[0] = pack2(st[2 * kb][0], st[2 * kb][1]); pb.u[1] = pack2(st[2 * kb][2], st[2 * kb][3]);
        pb.u[2] = pack2(st[2 * kb + 1][0], st[2 * kb + 1][1]); pb.u[3] = pack2(st[2 * kb + 1][2], st[2 * kb + 1][3]);
        L = mfma16(ones.v, pb.v, L);
#pragma unroll
        for (int mt = 0; mt < 4; ++mt) O[mt] = mfma16(vf[kb * 4 + mt], pb.v, O[mt]);
    }
}
DEV void softmax_pv_tile(bool MASK, f32x4 (&st)[4], const bf16x8 (&vf)[8], int keybase, int tcol, int lowcol, bool colsel, float& m, float& l, f32x4& L, f32x4 (&O)[4], int q4) {
    float lmax = -1e30f;
    if (MASK) {
        const int hi = colsel ? tcol : -1;
#pragma unroll
        for (int kt = 0; kt < 4; ++kt)
#pragma unroll
            for (int r = 0; r < 4; ++r) {
                const int key = keybase + kt * 16 + 4 * q4 + r;
                const bool valid = (key <= hi) && (key > lowcol);
                const float sv = valid ? st[kt][r] : -1e30f;
                st[kt][r] = sv; lmax = fmaxf(lmax, sv);
            }
    } else {
        const float cs = colsel ? 0.f : -1e30f;
#pragma unroll
        for (int kt = 0; kt < 4; ++kt)
#pragma unroll
            for (int r = 0; r < 4; ++r) { const float sv = st[kt][r] + cs; st[kt][r] = sv; lmax = fmaxf(lmax, sv); }
    }
    lmax = colmax(lmax);
    const float mnew = fmaxf(m, lmax);
    const float alpha = ex2(m - mnew);
    float psum = 0.f;
#pragma unroll
    for (int kt = 0; kt < 4; ++kt)
#pragma unroll
        for (int r = 0; r < 4; ++r) {
            float pv = ex2(st[kt][r] - mnew);
            if (MASK) pv = (st[kt][r] > -1e29f) ? pv : 0.f;
            st[kt][r] = pv; psum += pv;
        }
    l = l * alpha + psum;
    if (__any(mnew > m)) {
#pragma unroll
        for (int mt = 0; mt < 4; ++mt) { O[mt][0] *= alpha; O[mt][1] *= alpha; O[mt][2] *= alpha; O[mt][3] *= alpha; }
        L[0] *= alpha; L[1] *= alpha; L[2] *= alpha; L[3] *= alpha;
    }
    m = mnew;
#pragma unroll
    for (int kb = 0; kb < 2; ++kb) {
        union { bf16x8 v; unsigned u[4]; } pb;
        pb.u[0] = pack2(st[2 * kb][0], st[2 * kb][1]); pb.u[1] = pack2(st[2 * kb][2], st[2 * kb][3]);
        pb.u[2] = pack2(st[2 * kb + 1][0], st[2 * kb + 1][1]); pb.u[3] = pack2(st[2 * kb + 1][2], st[2 * kb + 1][3]);
#pragma unroll
        for (int mt = 0; mt < 4; ++mt) O[mt] = mfma16(vf[kb * 4 + mt], pb.v, O[mt]);
    }
}
DEV unsigned pick4(unsigned a0, unsigned a1, unsigned a2, unsigned a3, int w) { return w == 0 ? a0 : (w == 1 ? a1 : (w == 2 ? a2 : a3)); }
template <int CTRL> DEV unsigned dpp_or(unsigned x) { return x | dppu<CTRL>(x); }
DEV unsigned row_or(unsigned x) { x = dpp_or<0xB1>(x); x = dpp_or<0x4E>(x); x = dpp_or<0x124>(x); x = dpp_or<0x128>(x); return x; }


DEV void nsa_branch_lds(unsigned char* lds, const u16* __restrict__ K0, const u16* __restrict__ VT0, unsigned bu0, unsigned bu1, unsigned bu2,
                        unsigned bu3, unsigned ua0, unsigned ua1, unsigned ua2, unsigned ua3, unsigned ub0, unsigned ub1, unsigned ub2, unsigned ub3,
                        const unsigned* cm, int tokl, const int (&tcol)[2], const int (&lowc)[2], const bf16x8 (&qf)[2][2], float (&m)[2],
                        float (&l)[2], f32x4 (&L)[2], f32x4 (&O)[2][4], int q4, int cidx, int cur, int lowmax) {
    const int tid = TID();
    int w = 0; unsigned bits = bu0;
    auto advance = [&]() -> int {
        while (bits == 0u && w < 3) { ++w; bits = pick4(bu0, bu1, bu2, bu3, w); }
        if (bits == 0u) return -1;
        const int jb = __builtin_ctz(bits); bits &= bits - 1u;
        return w * 32 + jb;
    };
    const int srow0 = tid >> 3, srow1 = srow0 + 32, sch = tid & 7;
    const int so0 = srow0 * 128 + ((sch ^ (srow0 & 7)) << 4), so1 = srow1 * 128 + ((sch ^ (srow1 & 7)) << 4);
    bf16x8 r0[4], r1[4];
#define NSA_GLOAD(R, BLK_) { R[0] = ld8(K0 + ((size_t)(BLK_) * 64 + srow0) * 64 + sch * 8); R[1] = ld8(K0 + ((size_t)(BLK_) * 64 + srow1) * 64 + sch * 8); \
        R[2] = ld8(VT0 + (size_t)srow0 * 8192 + (BLK_) * 64 + sch * 8); R[3] = ld8(VT0 + (size_t)srow1 * 8192 + (BLK_) * 64 + sch * 8); }
#define NSA_LWRITE(R, BUF_) { unsigned char* wb_ = lds + (BUF_) * 16384; *(bf16x8*)(wb_ + so0) = R[0]; *(bf16x8*)(wb_ + so1) = R[1]; \
        *(bf16x8*)(wb_ + 8192 + so0) = R[2]; *(bf16x8*)(wb_ + 8192 + so1) = R[3]; }
    auto compute = [&](int blk, int buf) {
        const int wq = blk >> 5, jb = blk & 31;
        const bool act0 = (pick4(ua0, ua1, ua2, ua3, wq) >> jb) & 1u, act1 = (pick4(ub0, ub1, ub2, ub3, wq) >> jb) & 1u;
        if (act0 || act1) {
            const unsigned char* kb_ = lds + buf * 16384;
            const bool need_mask = (blk == cur) || (blk * 64 <= lowmax);
            const bool cs0 = cm ? (((cm[tokl * 4 + wq] >> jb) & 1u) != 0u) : true;
            const bool cs1 = cm ? (((cm[(4 + tokl) * 4 + wq] >> jb) & 1u) != 0u) : true;
            const bool lazy = !need_mask && !__any((act0 && m[0] < -1e29f) || (act1 && m[1] < -1e29f));
            f32x4 st0[4], st1[4];
            {
                bf16x8 kf[8];
#pragma unroll
                for (int kt = 0; kt < 4; ++kt)
#pragma unroll
                    for (int s2 = 0; s2 < 2; ++s2) {
                        const int row = 16 * kt + cidx, ch = 4 * s2 + q4;
                        kf[2 * kt + s2] = *(const bf16x8*)(kb_ + row * 128 + ((ch ^ (row & 7)) << 4));
                    }
                if (act0) qk_tile(kf, qf[0][0], qf[0][1], lazy ? (cs0 ? -m[0] : -1e30f) : 0.f, st0);
                if (act1) qk_tile(kf, qf[1][0], qf[1][1], lazy ? (cs1 ? -m[1] : -1e30f) : 0.f, st1);
            }
            __builtin_amdgcn_sched_barrier(0);
            bf16x8 vf[8];
#pragma unroll
            for (int kb = 0; kb < 2; ++kb)
#pragma unroll
                for (int mt = 0; mt < 4; ++mt) {
                    const int row = 16 * mt + cidx, ch = 4 * kb + q4;
                    vf[kb * 4 + mt] = *(const bf16x8*)(kb_ + 8192 + row * 128 + ((ch ^ (row & 7)) << 4));
                }
            if (lazy) {
                if (act0) softmax_pv_lazy(st0, vf, m[0], l[0], L[0], O[0]);
                if (act1) softmax_pv_lazy(st1, vf, m[1], l[1], L[1], O[1]);
            } else {
                if (act0) softmax_pv_tile(need_mask, st0, vf, blk * 64, tcol[0], lowc[0], cs0, m[0], l[0], L[0], O[0], q4);
                if (act1) softmax_pv_tile(need_mask, st1, vf, blk * 64, tcol[1], lowc[1], cs1, m[1], l[1], L[1], O[1], q4);
            }
        }
    };
    int b0 = advance();
    if (b0 < 0) return;
    int b1 = advance();
    NSA_GLOAD(r0, b0);
    if (b1 >= 0) NSA_GLOAD(r1, b1);
    NSA_LWRITE(r0, 0);
    __syncthreads();
#pragma unroll 1
    while (b0 >= 0) {
        const int b2 = (b1 >= 0) ? advance() : -1;
        if (b2 >= 0) NSA_GLOAD(r0, b2);
        compute(b0, 0);
        if (b1 >= 0) NSA_LWRITE(r1, 1);
        __syncthreads();
        if (b1 < 0) break;
        const int b3 = (b2 >= 0) ? advance() : -1;
        if (b3 >= 0) NSA_GLOAD(r1, b3);
        compute(b1, 1);
        if (b2 >= 0) NSA_LWRITE(r0, 0);
        __syncthreads();
        b0 = b2; b1 = b3;
    }
#undef NSA_GLOAD
#undef NSA_LWRITE
}

DEV void nsa_block_task(const Params& p, int task, unsigned char* lds) {
    const int wave = TID() >> 6;
    float* wl = (float*)(lds + 32768) + wave * 2112;
    unsigned* bm = (unsigned*)(lds + 32768 + 4 * 8448);
    float* impA = wl; float* impB = wl + 1024; unsigned* selmask = (unsigned*)(wl + 1024 + 1056);
    unsigned char* ws = p.ws;
    const u16* Q = (const u16*)(ws + OFF_Q);
    const u16* KVb = (const u16*)(ws + OFF_KV);
    const u16 *KSEL = KVb + (size_t)2 * 4194304, *VSELT = KVb + (size_t)3 * 4194304, *KWIN = KVb + (size_t)4 * 4194304, *VWINT = KVb + (size_t)5 * 4194304;
    const u16* KC = (const u16*)(ws + OFF_KC); const u16* VCT = (const u16*)(ws + OFF_VCT);
    const float* GATE = (const float*)(ws + OFF_GATE);
    u16* mix = (u16*)(ws + OFF_MIX);
    const int lane = TID() & 63, q4 = lane >> 4, cidx = lane & 15;
    const int bg = task & 7, t0b = (255 - (task >> 3)) * 32, t0 = t0b + 8 * wave; const int b = bg >> 1, g = bg & 1;
    const int tokl = cidx >> 2, hr = cidx & 3; const int head = g * 4 + hr;
    const int cur = t0 >> 6;
    int tcol[2], rowc[2]; bf16x8 qf[2][2];
#pragma unroll
    for (int ti = 0; ti < 2; ++ti) {
        tcol[ti] = t0 + 4 * ti + tokl; rowc[ti] = b * 8192 + tcol[ti];
        qf[ti][0] = ld8(Q + (size_t)rowc[ti] * 512 + head * 64 + 8 * q4); qf[ti][1] = ld8(Q + (size_t)rowc[ti] * 512 + head * 64 + 32 + 8 * q4);
    }
    f32x4 Oc[2][4];
    {
        int cnt_col[2];
#pragma unroll
        for (int ti = 0; ti < 2; ++ti) cnt_col[ti] = tcol[ti] >= 31 ? ((tcol[ti] - 31) >> 4) + 1 : 0;
        const int tmax = t0 + 7; const int cmax = tmax >= 31 ? ((tmax - 31) >> 4) + 1 : 0;
        const int ntile = (cmax + 15) >> 4;
        const u16* kcb = KC + (size_t)bg * 512 * 64;
        float ml[2] = {-1e30f, -1e30f}, ll[2] = {0.f, 0.f};
#pragma unroll 1
        for (int kt = 0; kt < ntile; ++kt) {
            const u16* kp = kcb + (kt * 16 + cidx) * 64 + 8 * q4;
            const bf16x8 k0 = ld8(kp), k1 = ld8(kp + 32);
#pragma unroll
            for (int ti = 0; ti < 2; ++ti) {
                f32x4 st = mfma16(k0, qf[ti][0], (f32x4){0.f, 0.f, 0.f, 0.f});
                st = mfma16(k1, qf[ti][1], st);
                float sv[4]; float tm = -1e30f;
#pragma unroll
                for (int r = 0; r < 4; ++r) { const int n = kt * 16 + 4 * q4 + r; sv[r] = (n < cnt_col[ti]) ? st[r] : -1e30f; tm = fmaxf(tm, sv[r]); }
                const float mn = fmaxf(ml[ti], tm);
                float ps = 0.f;
#pragma unroll
                for (int r = 0; r < 4; ++r) ps += (sv[r] > -1e29f) ? ex2(sv[r] - mn) : 0.f;
                ll[ti] = ll[ti] * ex2(ml[ti] - mn) + ps; ml[ti] = mn;
            }
        }
        float mfin[2], inv[2];
#pragma unroll
        for (int ti = 0; ti < 2; ++ti) {
            mfin[ti] = colmax(ml[ti]);
            const float lsum = colsum(ll[ti] * ex2(ml[ti] - mfin[ti]));
            inv[ti] = (cnt_col[ti] > 0) ? 1.f / lsum : 0.f;
        }
#pragma unroll
        for (int ti = 0; ti < 2; ++ti)
#pragma unroll
            for (int mt = 0; mt < 4; ++mt) Oc[ti][mt] = (f32x4){0.f, 0.f, 0.f, 0.f};
        const int npair = (ntile + 1) >> 1;
#pragma unroll 1
        for (int kp2 = 0; kp2 < npair; ++kp2) {
            const int n0 = kp2 * 32;
            const u16* kp = kcb + (n0 + cidx) * 64 + 8 * q4;
            const bf16x8 ka0 = ld8(kp), ka1 = ld8(kp + 32), kb0 = ld8(kp + 1024), kb1 = ld8(kp + 1024 + 32);
            bf16x8 vf[4];
#pragma unroll
            for (int mt = 0; mt < 4; ++mt) vf[mt] = ld8(VCT + ((size_t)bg * 64 + 16 * mt + cidx) * 512 + n0 + 8 * q4);
#pragma unroll
            for (int ti = 0; ti < 2; ++ti) {
                float pa[4], pb_[4];
                f32x4 st = mfma16(ka0, qf[ti][0], (f32x4){0.f, 0.f, 0.f, 0.f});
                st = mfma16(ka1, qf[ti][1], st);
                f32x4 su = mfma16(kb0, qf[ti][0], (f32x4){0.f, 0.f, 0.f, 0.f});
                su = mfma16(kb1, qf[ti][1], su);
#pragma unroll
                for (int r = 0; r < 4; ++r) {
                    const int n = n0 + 4 * q4 + r;
                    pa[r] = (n < cnt_col[ti]) ? ex2(st[r] - mfin[ti]) * inv[ti] : 0.f;
                    pb_[r] = (n + 16 < cnt_col[ti]) ? ex2(su[r] - mfin[ti]) * inv[ti] : 0.f;
                }
                const float owna = quadsum(pa[0] + pa[1] + pa[2] + pa[3]), tha = quadsum(pa[3]);
                const float ownb = quadsum(pb_[0] + pb_[1] + pb_[2] + pb_[3]), thb = quadsum(pb_[3]);
                if (hr == 0) {
                    const int tk = 4 * ti + tokl;
                    const int sa = (n0 >> 2) + q4, sb2 = ((n0 + 16) >> 2) + q4;
                    impA[tk * 128 + sa] = owna; impB[tk * 132 + sa + 1] = tha;
                    impA[tk * 128 + sb2] = ownb; impB[tk * 132 + sb2 + 1] = thb;
                }
                union { bf16x8 v; unsigned u[4]; } pk;
                pk.u[0] = pack2(pa[0], pa[1]); pk.u[1] = pack2(pa[2], pa[3]); pk.u[2] = pack2(pb_[0], pb_[1]); pk.u[3] = pack2(pb_[2], pb_[3]);
#pragma unroll
                for (int mt = 0; mt < 4; ++mt) Oc[ti][mt] = mfma16(vf[mt], pk.v, Oc[ti][mt]);
            }
        }
#pragma unroll
        for (int ti = 0; ti < 2; ++ti) {
            const float gc = GATE[(size_t)rowc[ti] * 24 + head];
#pragma unroll
            for (int mt = 0; mt < 4; ++mt)
#pragma unroll
                for (int r = 0; r < 4; ++r) Oc[ti][mt][r] *= gc;
        }
    }
    lds_fence();
#pragma unroll 1
    for (int rd = 0; rd < 2; ++rd) {
        const int tk = 4 * rd + q4;
        unsigned m0 = 0u, m1 = 0u, m2 = 0u, m3 = 0u;
        if (cur < 16) { m0 = (2u << cur) - 1u; }
        else {
            unsigned key[8];
#pragma unroll
            for (int i = 0; i < 8; ++i) {
                const int sblk = cidx + 16 * i;
                const bool cand = (sblk >= 1) && (sblk <= cur - 2);
                const float v = impA[tk * 128 + sblk] + impB[tk * 132 + sblk];
                key[i] = cand ? ((__float_as_uint(v) & ~0x7Fu) | (unsigned)(127 - sblk)) : 0u;
            }
            int mysel = (cidx == 0) ? 0 : (cidx == 1 ? cur - 1 : (cidx == 2 ? cur : -1));
#pragma unroll 1
            for (int it = 0; it < 13; ++it) {
                unsigned mx = key[0];
#pragma unroll
                for (int i = 1; i < 8; ++i) mx = max(mx, key[i]);
                mx = max(mx, dppu<0xB1>(mx)); mx = max(mx, dppu<0x4E>(mx)); mx = max(mx, dppu<0x124>(mx)); mx = max(mx, dppu<0x128>(mx));
                const int sblk = 127 - (int)(mx & 127u);
#pragma unroll
                for (int i = 0; i < 8; ++i) key[i] = (key[i] == mx) ? 0u : key[i];
                if (cidx == it + 3) mysel = sblk;
            }
            const unsigned bit = 1u << (mysel & 31); const int wsel = mysel >> 5;
            m0 = row_or(wsel == 0 ? bit : 0u); m1 = row_or(wsel == 1 ? bit : 0u); m2 = row_or(wsel == 2 ? bit : 0u); m3 = row_or(wsel == 3 ? bit : 0u);
        }
        if (cidx < 4) selmask[tk * 4 + cidx] = (cidx == 0) ? m0 : (cidx == 1 ? m1 : (cidx == 2 ? m2 : m3));
    }
    lds_fence();
    f32x4* accl = (f32x4*)wl;
#pragma unroll
    for (int ti = 0; ti < 2; ++ti)
#pragma unroll
        for (int mt = 0; mt < 4; ++mt) accl[(ti * 4 + mt) * 64 + lane] = Oc[ti][mt];
    {
        float m[2] = {-1e30f, -1e30f}, l[2] = {0.f, 0.f}; f32x4 Os[2][4]; f32x4 Ls[2] = {(f32x4){0.f, 0.f, 0.f, 0.f}, (f32x4){0.f, 0.f, 0.f, 0.f}};
#pragma unroll
        for (int ti = 0; ti < 2; ++ti)
#pragma unroll
            for (int mt = 0; mt < 4; ++mt) Os[ti][mt] = (f32x4){0.f, 0.f, 0.f, 0.f};
        {
            unsigned ua[4], ub[4], bu[4];
#pragma unroll
            for (int w = 0; w < 4; ++w) {
                ua[w] = __builtin_amdgcn_readfirstlane(row_or(selmask[tokl * 4 + w]));
                ub[w] = __builtin_amdgcn_readfirstlane(row_or(selmask[(4 + tokl) * 4 + w]));
            }
            if (lane < 4) bm[wave * 4 + lane] = (lane == 0) ? (ua[0] | ub[0]) : (lane == 1 ? (ua[1] | ub[1]) : (lane == 2 ? (ua[2] | ub[2]) : (ua[3] | ub[3])));
            __syncthreads();
#pragma unroll
            for (int w = 0; w < 4; ++w) bu[w] = __builtin_amdgcn_readfirstlane(bm[w] | bm[4 + w] | bm[8 + w] | bm[12 + w]);
            const int lowc[2] = {-1, -1};
            nsa_branch_lds(lds, KSEL + (size_t)bg * 8192 * 64, VSELT + (size_t)bg * 64 * 8192, bu[0], bu[1], bu[2], bu[3], ua[0], ua[1], ua[2], ua[3], ub[0],
                           ub[1], ub[2], ub[3], selmask, tokl, tcol, lowc, qf, m, l, Ls, Os, q4, cidx, cur, -1);
        }
#pragma unroll
        for (int ti = 0; ti < 2; ++ti) {
            const float sc = GATE[(size_t)rowc[ti] * 24 + 8 + head] / (colsum(l[ti]) + Ls[ti][0]);
#pragma unroll
            for (int mt = 0; mt < 4; ++mt)
#pragma unroll
                for (int r = 0; r < 4; ++r) Os[ti][mt][r] *= sc;
        }
        lds_fence();
#pragma unroll
        for (int ti = 0; ti < 2; ++ti)
#pragma unroll
            for (int mt = 0; mt < 4; ++mt) { f32x4 a = accl[(ti * 4 + mt) * 64 + lane]; a += Os[ti][mt]; accl[(ti * 4 + mt) * 64 + lane] = a; }
    }
    {
        float m[2] = {-1e30f, -1e30f}, l[2] = {0.f, 0.f}; f32x4 Ow[2][4]; f32x4 Ls[2] = {(f32x4){0.f, 0.f, 0.f, 0.f}, (f32x4){0.f, 0.f, 0.f, 0.f}};
#pragma unroll
        for (int ti = 0; ti < 2; ++ti)
#pragma unroll
            for (int mt = 0; mt < 4; ++mt) Ow[ti][mt] = (f32x4){0.f, 0.f, 0.f, 0.f};
        int wb0 = (t0 - 511) >> 6; if (wb0 < 0) wb0 = 0;
        int wbb = (t0b - 511) >> 6; if (wbb < 0) wbb = 0;
        {
            unsigned uw[4], bu[4];
#pragma unroll
            for (int w = 0; w < 4; ++w) {
                const int hi = cur - 32 * w;
                unsigned mk = 0u, mkb = 0u;
                if (hi >= 0) {
                    const unsigned upper = (hi >= 31) ? 0xffffffffu : ((2u << hi) - 1u);
                    const int lo = wb0 - 32 * w, lob = wbb - 32 * w;
                    if (lo <= 31) mk = upper & ~((lo <= 0) ? 0u : ((1u << lo) - 1u));
                    if (lob <= 31) mkb = upper & ~((lob <= 0) ? 0u : ((1u << lob) - 1u));
                }
                uw[w] = mk; bu[w] = mkb;
            }
            const int lowc[2] = {tcol[0] - 512, tcol[1] - 512};
            nsa_branch_lds(lds, KWIN + (size_t)bg * 8192 * 64, VWINT + (size_t)bg * 64 * 8192, bu[0], bu[1], bu[2], bu[3], uw[0], uw[1], uw[2], uw[3], uw[0],
                           uw[1], uw[2], uw[3], nullptr, tokl, tcol, lowc, qf, m, l, Ls, Ow, q4, cidx, cur, t0 + 7 - 512);
        }
#pragma unroll
        for (int ti = 0; ti < 2; ++ti) {
            const float sc = GATE[(size_t)rowc[ti] * 24 + 16 + head] / (colsum(l[ti]) + Ls[ti][0]);
#pragma unroll
            for (int mt = 0; mt < 4; ++mt)
#pragma unroll
                for (int r = 0; r < 4; ++r) Ow[ti][mt][r] *= sc;
        }
        lds_fence();
#pragma unroll
        for (int ti = 0; ti < 2; ++ti)
#pragma unroll
            for (int mt = 0; mt < 4; ++mt) {
                const f32x4 a = accl[(ti * 4 + mt) * 64 + lane];
                const f32x4 o = Ow[ti][mt];
                u32x2 wv; wv[0] = pack2(a[0] + o[0], a[1] + o[1]); wv[1] = pack2(a[2] + o[2], a[3] + o[3]);
                *(u32x2*)(mix + (size_t)rowc[ti] * 1024 + 512 + head * 64 + 16 * mt + 4 * q4) = wv;
            }
    }


    __syncthreads();
}

template <int N> DEV void ltmask(const float (&v)[N], float x, unsigned (&mk)[N / 32]) {
#pragma unroll
    for (int w = 0; w < N / 32; ++w) {
        unsigned a0 = 0u, a1 = 0u, a2 = 0u, a3 = 0u;
#pragma unroll
        for (int i = 0; i < 8; ++i) {
            a0 = __builtin_amdgcn_alignbit(a0, __float_as_uint(v[w * 32 + i] - x), 31);
            a1 = __builtin_amdgcn_alignbit(a1, __float_as_uint(v[w * 32 + 8 + i] - x), 31);
            a2 = __builtin_amdgcn_alignbit(a2, __float_as_uint(v[w * 32 + 16 + i] - x), 31);
            a3 = __builtin_amdgcn_alignbit(a3, __float_as_uint(v[w * 32 + 24 + i] - x), 31);
        }
        mk[w] = (a0 << 24) | (a1 << 16) | (a2 << 8) | a3;
    }
}
template <int N> DEV int count_ge(const float (&v)[N], float x) {
    unsigned mk[N / 32]; ltmask<N>(v, x, mk);
    int lt = 0;
#pragma unroll
    for (int w = 0; w < N / 32; ++w) lt += __popc(mk[w]);
    return colsumi(N - lt);
}
template <int N> DEV void refine16(const float (&v)[N], float lo, int clo, float hi, int chi, float& lo_o, float& hi_o) {
    bool done = false;
    if (clo == 16) { hi = lo; done = true; }
#pragma unroll 1
    for (int it = 0; it < 200; ++it) {
        if (__all(done)) break;
        float f = 0.5f;
        if (!(it & 1)) { f = ((float)clo - 15.5f) / (float)(clo - chi); f = fminf(fmaxf(f, 0.04f), 0.96f); }
        const float mid = lo + (hi - lo) * f;
        const bool stuck = !(mid > lo && mid < hi);
        const int c = count_ge<N>(v, mid);
        if (!done) {
            if (stuck) { if (f != 0.5f) {   } else done = true; }
            else if (c == 16) { lo = mid; hi = mid; done = true; }
            else if (c > 16) { lo = mid; clo = c; }
            else { hi = mid; chi = c; }
        }
    }
    lo_o = lo; hi_o = hi;
}
template <int N> DEV void select16(const float (&v)[N], float& lo_o, float& hi_o) {
    float mx = v[0], mn = v[0], sm = v[0];
#pragma unroll
    for (int i = 1; i < N; ++i) { mx = fmaxf(mx, v[i]); mn = fminf(mn, v[i]); sm += v[i]; }
    mx = colmax(mx); mn = -colmax(-mn); sm = colsum(sm);
    const float hi = mx + fabsf(mx) * 1e-6f + 1e-30f;
    float lo = sm * (1.f / (4.f * N));
    int clo = count_ge<N>(v, lo);
    if (clo < 16) { lo = mn; clo = 4 * N; }
    refine16<N>(v, lo, clo, hi, 0, lo_o, hi_o);
}
DEV void col_offsets(int cntA, int cntT, int q4, int cidx, int& offA, int& offT) {
    const int g0 = __shfl(cntA, cidx), g1 = __shfl(cntA, cidx + 16), g2 = __shfl(cntA, cidx + 32), g3 = __shfl(cntA, cidx + 48);
    const int e0 = __shfl(cntT, cidx), e1 = __shfl(cntT, cidx + 16), e2 = __shfl(cntT, cidx + 32);
    offA = (q4 > 0 ? g0 : 0) + (q4 > 1 ? g1 : 0) + (q4 > 2 ? g2 : 0);
    offT = g0 + g1 + g2 + g3 + (q4 > 0 ? e0 : 0) + (q4 > 1 ? e1 : 0) + (q4 > 2 ? e2 : 0);
}

DEV void peer_topk_task2(const Params& p, int l, int task, float* wl) {
    unsigned char* ws = p.ws;
    const u16* QP = (const u16*)(ws + OFF_QP);
    const u16* K12 = (const u16*)(ws + OFF_K12) + (size_t)l * 2 * 16384;
    const int lane = TID() & 63, q4 = lane >> 4, cidx = lane & 15;
    const int tq = task * 2 + (cidx >> 3), hh = cidx & 7;
    float* scl = wl;
    float* lst = wl + 2048;
    float* vv[2] = {lst, lst + 512}; int* ii[2] = {(int*)(lst + 256), (int*)(lst + 768)};
    float* fs = lst + 1024; int* fi = (int*)(lst + 1280);
#pragma unroll 1
    for (int hf = 0; hf < 2; ++hf) {
        bf16x8 qf[4];
#pragma unroll
        for (int s2 = 0; s2 < 4; ++s2) qf[s2] = ld8(QP + (size_t)tq * 2048 + hh * 256 + hf * 128 + 32 * s2 + 8 * q4);
        float sc[32];
        const u16* kb = K12 + hf * 16384;
#pragma unroll
        for (int kt = 0; kt < 8; ++kt) {
            f32x4 st = (f32x4){0.f, 0.f, 0.f, 0.f};
#pragma unroll
            for (int s2 = 0; s2 < 4; ++s2) st = mfma16(ld8(kb + (kt * 16 + cidx) * 128 + 32 * s2 + 8 * q4), qf[s2], st);
#pragma unroll
            for (int r = 0; r < 4; ++r) sc[kt * 4 + r] = st[r];
            *(f32x4*)(scl + cidx * 128 + 16 * kt + 4 * q4) = st;
        }
        float lo, hi; select16<32>(sc, lo, hi);
        unsigned mh[1], ml_[1];
        ltmask<32>(sc, hi, mh); ltmask<32>(sc, lo, ml_);
        unsigned mA = ~mh[0], mT = ~ml_[0] & mh[0];
        int offA, offT; col_offsets(__popc(mA), __popc(mT), q4, cidx, offA, offT);
        float* vo = hf ? vv[1] : vv[0]; int* io = hf ? ii[1] : ii[0];
        lds_fence();
        while (__any(mA != 0u)) {
            if (mA) {
                const int i = __clz(mA); mA &= ~(0x80000000u >> i);
                const int n = 16 * (i >> 2) + 4 * q4 + (i & 3);
                vo[cidx * 16 + offA] = scl[cidx * 128 + n]; io[cidx * 16 + offA] = n; ++offA;
            }
        }
        while (__any(mT != 0u)) {
            if (mT) {
                const int i = __clz(mT); mT &= ~(0x80000000u >> i);
                const int n = 16 * (i >> 2) + 4 * q4 + (i & 3);
                if (offT < 16) { vo[cidx * 16 + offT] = scl[cidx * 128 + n]; io[cidx * 16 + offT] = n; }
                ++offT;
            }
        }
        lds_fence();
    }
    {
        float cand[64];
        float v2r[16];
#pragma unroll
        for (int j = 0; j < 16; ++j) v2r[j] = vv[1][cidx * 16 + j];
#pragma unroll
        for (int a = 0; a < 4; ++a) {
            const float v1a = vv[0][cidx * 16 + 4 * q4 + a];
#pragma unroll
            for (int j = 0; j < 16; ++j) cand[a * 16 + j] = v1a + v2r[j];
        }
        float lo, hi;
        {
            float v2mx = v2r[0], v2mn = v2r[0];
#pragma unroll
            for (int j = 1; j < 16; ++j) { v2mx = fmaxf(v2mx, v2r[j]); v2mn = fminf(v2mn, v2r[j]); }
            float v1mx = fmaxf(fmaxf(vv[0][cidx * 16 + 4 * q4], vv[0][cidx * 16 + 4 * q4 + 1]), fmaxf(vv[0][cidx * 16 + 4 * q4 + 2], vv[0][cidx * 16 + 4 * q4 + 3]));
            float v1mn = fminf(fminf(vv[0][cidx * 16 + 4 * q4], vv[0][cidx * 16 + 4 * q4 + 1]), fminf(vv[0][cidx * 16 + 4 * q4 + 2], vv[0][cidx * 16 + 4 * q4 + 3]));
            v1mx = colmax(v1mx); v1mn = -colmax(-v1mn);
            const float smax = v1mx + v2mx;
            const float hi0 = smax + fabsf(smax) * 1e-6f + 1e-30f;
            const float lo0 = fmaxf(v1mn + v2mx, v1mx + v2mn);
            const int c0 = count_ge<64>(cand, lo0);
            refine16<64>(cand, lo0, c0, hi0, 0, lo, hi);
        }
        unsigned mh[2], ml_[2];
        ltmask<64>(cand, hi, mh); ltmask<64>(cand, lo, ml_);
        unsigned mA0 = ~mh[0], mA1 = ~mh[1], mT0 = ~ml_[0] & mh[0], mT1 = ~ml_[1] & mh[1];
        int offA, offT; col_offsets(__popc(mA0) + __popc(mA1), __popc(mT0) + __popc(mT1), q4, cidx, offA, offT);
#pragma unroll
        for (int w = 0; w < 2; ++w) {
            unsigned mA = w ? mA1 : mA0;
            while (__any(mA != 0u)) {
                if (mA) {
                    const int i = __clz(mA); mA &= ~(0x80000000u >> i);
                    const int it = w * 32 + i; const int ci = (4 * q4 + (it >> 4)) * 16 + (it & 15);
                    fs[cidx * 16 + offA] = vv[0][cidx * 16 + (ci >> 4)] + vv[1][cidx * 16 + (ci & 15)]; fi[cidx * 16 + offA] = ci; ++offA;
                }
            }
        }
#pragma unroll
        for (int w = 0; w < 2; ++w) {
            unsigned mT = w ? mT1 : mT0;
            while (__any(mT != 0u)) {
                if (mT) {
                    const int i = __clz(mT); mT &= ~(0x80000000u >> i);
                    const int it = w * 32 + i; const int ci = (4 * q4 + (it >> 4)) * 16 + (it & 15);
                    if (offT < 16) { fs[cidx * 16 + offT] = vv[0][cidx * 16 + (ci >> 4)] + vv[1][cidx * 16 + (ci & 15)]; fi[cidx * 16 + offT] = ci; }
                    ++offT;
                }
            }
        }
    }
    lds_fence();
    {
        float s4[4]; int c4[4];
#pragma unroll
        for (int k = 0; k < 4; ++k) { s4[k] = fs[cidx * 16 + 4 * q4 + k]; c4[k] = fi[cidx * 16 + 4 * q4 + k]; }
        float mx = fmaxf(fmaxf(s4[0], s4[1]), fmaxf(s4[2], s4[3]));
        mx = colmax(mx);
        float e4[4]; float sm = 0.f;
#pragma unroll
        for (int k = 0; k < 4; ++k) { e4[k] = __expf(s4[k] - mx); sm += e4[k]; }
        sm = colsum(sm);
        const float inv = 1.f / sm;
        int4 eo; float4 go;
        eo.x = ii[0][cidx * 16 + (c4[0] >> 4)] * 128 + ii[1][cidx * 16 + (c4[0] & 15)];
        eo.y = ii[0][cidx * 16 + (c4[1] >> 4)] * 128 + ii[1][cidx * 16 + (c4[1] & 15)];
        eo.z = ii[0][cidx * 16 + (c4[2] >> 4)] * 128 + ii[1][cidx * 16 + (c4[2] & 15)];
        eo.w = ii[0][cidx * 16 + (c4[3] >> 4)] * 128 + ii[1][cidx * 16 + (c4[3] & 15)];
        go.x = e4[0] * inv; go.y = e4[1] * inv; go.z = e4[2] * inv; go.w = e4[3] * inv;
        int* eol = (int*)(wl + 3584); float* gol = wl + 3584 + 256;
        *(int4*)(eol + cidx * 16 + 4 * q4) = eo; *(float4*)(gol + cidx * 16 + 4 * q4) = go;
    }
    lds_fence();
}

DEV float gelu_exact(float x) { return 0.5f * x * (1.f + erff(x * 0.70710678118654752f)); }
DEV void unpack8(const bf16x8 v, float* f) {
    union { bf16x8 v; unsigned u[4]; } c; c.v = v;
#pragma unroll
    for (int i = 0; i < 4; ++i) { f[2 * i] = bflo(c.u[i]); f[2 * i + 1] = bfhi(c.u[i]); }
}
DEV void peer_experts_token(const Params& p, int l, int tok, const int* el_src, const float* w_src) {
    unsigned char* ws = p.ws;
    const u16* H = (const u16*)(ws + OFF_H);
    u16* Hw = (u16*)(ws + OFF_H);
    const unsigned char* U8 = ws + OFF_U8;
    const unsigned char* V8 = ws + OFF_U8 + 16 * MiB;
    const float* SU = (const float*)(ws + OFF_UVS);
    const float* SV = (const float*)(ws + OFF_UVS) + 16384;
    const float* mod = (const float*)(ws + OFF_MOD);
    const float* g2 = mod + l * 4 * 6144 + 5 * 1024;
    const int lane = TID() & 63;
    {
        const int b = tok >> 13;
        float acc[16];
#pragma unroll
        for (int i = 0; i < 16; ++i) acc[i] = 0.f;
#if EN_PEER
        unsigned hp[4]; float shq; int corr0;
        {
            float hx[16];
            unpack8(ld8(H + (size_t)tok * 1024 + 16 * lane), hx);
            unpack8(ld8(H + (size_t)tok * 1024 + 16 * lane + 8), hx + 8);
            float amax = 0.f;
#pragma unroll
            for (int i = 0; i < 16; ++i) amax = fmaxf(amax, fabsf(hx[i]));
            amax = wave_max(amax);
            shq = amax > 0.f ? amax * (1.f / 127.f) : 1.f;
            const float inv = 1.f / shq;
            int hsum = 0;
#pragma unroll
            for (int i = 0; i < 4; ++i) {
                const int a = __float2int_rn(hx[4 * i] * inv) + 128, b2 = __float2int_rn(hx[4 * i + 1] * inv) + 128, c = __float2int_rn(hx[4 * i + 2] * inv) + 128,
                          d = __float2int_rn(hx[4 * i + 3] * inv) + 128;
                hp[i] = (unsigned)a | ((unsigned)b2 << 8) | ((unsigned)c << 16) | ((unsigned)d << 24);
                hsum += a + b2 + c + d;
            }
            hsum = wave_sum_i(hsum);
            corr0 = 128 * 128 * 1024 - 128 * hsum;
        }
        const int* RSU = (const int*)(ws + OFF_UVS) + 2 * 16384;
        float corr = 0.f;
        u32x4 uqA[8], vqA[8], uqB[8], vqB[8];
#define PEER_LOAD(UQ, VQ, G_) { const int el_ = el_src[((G_) >> 1) * 16 + (lane & 15)]; const int k0_ = ((G_) & 1) * 8; _Pragma("unroll") for (int k = 0; k < 8; ++k) { \
            const int e = __builtin_amdgcn_readlane(el_, k0_ + k); UQ[k] = *(const u32x4*)(U8 + (size_t)e * 1024 + 16 * lane); VQ[k] = *(const u32x4*)(V8 + (size_t)e * 1024 + 16 * lane); } }
#define PEER_EVAL(UQ, VQ, G_) { const int hh_ = (G_) >> 1, k0_ = ((G_) & 1) * 8; const int el = el_src[hh_ * 16 + (lane & 15)]; const float wgt = w_src[hh_ * 16 + (lane & 15)]; \
            const float sul = SU[el] * shq, wsl = wgt * SV[el]; const int rsl = corr0 - 128 * RSU[el]; \
            int dpart[8]; _Pragma("unroll") for (int k = 0; k < 8; ++k) { unsigned di = 0u; _Pragma("unroll") for (int i = 0; i < 4; ++i) di = __builtin_amdgcn_udot4(UQ[k][i], hp[i], di, false); dpart[k] = (int)di; } \
            const int dsum = reduce8_i(dpart); const int srcl = k0_ + (lane >> 3); \
            const float sul_e = __shfl(sul, srcl), wsl_e = __shfl(wsl, srcl); const int rsl_e = __shfl(rsl, srcl); \
            const float actl = gelu_exact((float)(dsum + rsl_e) * sul_e) * wsl_e; \
            _Pragma("unroll") for (int k = 0; k < 8; ++k) { const float act = __int_as_float(__builtin_amdgcn_readlane(__float_as_int(actl), 8 * k)); corr += act * 128.f; \
                _Pragma("unroll") for (int i = 0; i < 4; ++i) { const unsigned w = VQ[k][i]; \
                    acc[4 * i] += act * (float)(w & 0xffu); acc[4 * i + 1] += act * (float)((w >> 8) & 0xffu); acc[4 * i + 2] += act * (float)((w >> 16) & 0xffu); acc[4 * i + 3] += act * (float)(w >> 24); } } }
        PEER_LOAD(uqA, vqA, 0);
#pragma unroll 1
        for (int g = 0; g < 16; g += 2) {
            PEER_LOAD(uqB, vqB, g + 1);
            PEER_EVAL(uqA, vqA, g);
            if (g + 2 < 16) PEER_LOAD(uqA, vqA, g + 2);
            PEER_EVAL(uqB, vqB, g + 1);
        }
#undef PEER_LOAD
#undef PEER_EVAL
#pragma unroll
        for (int i = 0; i < 16; ++i) acc[i] -= corr;
#endif
        const int k = 16 * lane;
        float xn[16]; float ss = 0.f;
#pragma unroll
        for (int i = 0; i < 4; ++i) {
            const float4 x0 = *(const float4*)(p.out + (size_t)tok * 1024 + k + 4 * i);
            const float4 ga = *(const float4*)(g2 + b * 6144 + k + 4 * i);
            xn[4 * i] = x0.x + ga.x * acc[4 * i]; xn[4 * i + 1] = x0.y + ga.y * acc[4 * i + 1];
            xn[4 * i + 2] = x0.z + ga.z * acc[4 * i + 2]; xn[4 * i + 3] = x0.w + ga.w * acc[4 * i + 3];
        }
#pragma unroll
        for (int i = 0; i < 16; ++i) ss += xn[i] * xn[i];
        ss = wave_sum(ss);
        const float rs = rsqrtf(ss * (1.f / 1024.f) + 1e-6f);
        if (l == 0) {
            const float* n1g = p.in[I_N1G] + 1024; const float* sh = mod + 4 * 6144 + b * 6144; const float* sc = sh + 1024;
            float hv[16];
#pragma unroll
            for (int i = 0; i < 4; ++i) {
                *(float4*)(p.out + (size_t)tok * 1024 + k + 4 * i) = (float4){xn[4 * i], xn[4 * i + 1], xn[4 * i + 2], xn[4 * i + 3]};
                const float4 gg = *(const float4*)(n1g + k + 4 * i), s1 = *(const float4*)(sc + k + 4 * i), s0 = *(const float4*)(sh + k + 4 * i);
                hv[4 * i] = xn[4 * i] * rs * gg.x * (1.f + s1.x) + s0.x; hv[4 * i + 1] = xn[4 * i + 1] * rs * gg.y * (1.f + s1.y) + s0.y;
                hv[4 * i + 2] = xn[4 * i + 2] * rs * gg.z * (1.f + s1.z) + s0.z; hv[4 * i + 3] = xn[4 * i + 3] * rs * gg.w * (1.f + s1.w) + s0.w;
            }
            u32x4 w0, w1;
#pragma unroll
            for (int i = 0; i < 4; ++i) { w0[i] = pack2(hv[2 * i], hv[2 * i + 1]); w1[i] = pack2(hv[8 + 2 * i], hv[8 + 2 * i + 1]); }
            *(u32x4*)(Hw + (size_t)tok * 1024 + k) = w0; *(u32x4*)(Hw + (size_t)tok * 1024 + k + 8) = w1;
        } else {
            const float* fg = p.in[I_FG];
#pragma unroll
            for (int i = 0; i < 4; ++i) {
                const float4 gg = *(const float4*)(fg + k + 4 * i);
                *(float4*)(p.out + (size_t)tok * 1024 + k + 4 * i) = (float4){xn[4 * i] * rs * gg.x, xn[4 * i + 1] * rs * gg.y, xn[4 * i + 2] * rs * gg.z, xn[4 * i + 3] * rs * gg.w};
            }
        }
    }
}

constexpr int NPH = 20;

__global__ void __launch_bounds__(256, 2) mega(Params p) {
    __shared__ __attribute__((aligned(16))) unsigned char lds[81920 - 128];
    __shared__ int misc[8];
    int* qslot = misc;
    cg::grid_group grid = cg::this_grid();
    if (threadIdx.x < 8) misc[threadIdx.x] = 0;
    __syncthreads();
    XcdBarrier xbar = xcd_barrier_post((unsigned*)(p.ws + OFF_BAR), (volatile unsigned*)(misc + 4));
    unsigned char* ws = p.ws;
    const float* mod = (const float*)(ws + OFF_MOD);
    unsigned* ctl = (unsigned*)(ws + OFF_CTL);
    const int G = gridDim.x, bx = BID();
    for (int ph = p.ph_lo; ph < p.ph_hi; ++ph) {
        if (ph >= 2 && (ph - 2) % 9 == 8) continue;
        if (ph == 0) {
            phase_prep(p, lds);
        } else if (ph == 1) {
            phase_norm(p.in[I_X], p.in[I_N1G], mod + 0 * 1024, mod + 1 * 1024, (u16*)(ws + OFF_H));
        } else {
            const int l = (ph - 2) / 9, sp = (ph - 2) % 9;
            const float* modl = mod + l * 4 * 6144;
            if (sp == 0) {
                EpiInProj e{(u16*)(ws + OFF_PCONV), (u16*)(ws + OFF_PRWKV), (u16*)(ws + OFF_Q), (u16*)(ws + OFF_KV), (float*)(ws + OFF_GATE)};
                gemm_phase((const u16*)(ws + OFF_H), 1024, (const u16*)(ws + OFF_WIN) + (size_t)l * NINP * 1024, 1024, 256, 8, 1024, e, lds, bx, G, 0, 4);
            } else if (sp == 1) {
#if EN_RWKV
                for (;;) { const int t = block_next(ctl + QW(l, Q_RWP), qslot); if (t >= NTOK / 16) break; rwkv_prep_tile2(p, l, t, lds); }
#endif
            } else if (sp == 2) {
#if EN_RWKV
                if (bx < 64) { __builtin_amdgcn_s_setprio(3); rwkv_scan(p, bx, lds); __builtin_amdgcn_s_setprio(0); }
#endif
                unsigned* cdone = ctl + QW(l, 5);
                unsigned* gdone = ctl + QW(l, 6);
                if (bx >= 64) {
                    EpiInProj e{(u16*)(ws + OFF_PCONV), (u16*)(ws + OFF_PRWKV), (u16*)(ws + OFF_Q), (u16*)(ws + OFF_KV), (float*)(ws + OFF_GATE)};
                    gemm_phase((const u16*)(ws + OFF_H), 1024, (const u16*)(ws + OFF_WIN) + (size_t)l * NINP * 1024, 1024, 256, 15, 1024, e, lds, bx - 64, G - 64, 4, 8, false);
                    asm volatile("s_waitcnt vmcnt(0)" ::: "memory");
                    __syncthreads();
                    if (threadIdx.x == 0) {
                        __builtin_amdgcn_fence(__ATOMIC_RELEASE, "agent");
                        asm volatile("s_waitcnt vmcnt(0)" ::: "memory");
                        __hip_atomic_fetch_add(gdone, 1u, __ATOMIC_RELAXED, __HIP_MEMORY_SCOPE_AGENT);
                    }
                }
                __syncthreads();
                if (threadIdx.x == 0) {
                    unsigned sp_ = 0;
                    while (__hip_atomic_load(gdone, __ATOMIC_RELAXED, __HIP_MEMORY_SCOPE_AGENT) < (unsigned)(G - 64)) { __builtin_amdgcn_s_sleep(8); if (++sp_ > (1u << 24)) break; }
                    __builtin_amdgcn_fence(__ATOMIC_ACQUIRE, "agent");
                    asm volatile("s_waitcnt vmcnt(0)" ::: "memory");
                }
                __syncthreads();
                if (bx >= 64 && bx < 128) {
                    const u16* KVb = (const u16*)(ws + OFF_KV);
                    if (bx < 96) {
                        EpiCompress ek{(const float*)(ws + OFF_CBP) + (l * 2 + 0) * 2048, p.in[I_CKW2] + (size_t)l * 8192, (u16*)(ws + OFF_KC), 0, lds};
                        gemm_phase(KVb, 1024, (const u16*)(ws + OFF_CW1) + (size_t)(l * 2 + 0) * 128 * 2048, 2048, 32, 1, 2048, ek, lds, bx - 64, 1 << 20);
                    } else {
                        EpiCompress ev{(const float*)(ws + OFF_CBP) + (l * 2 + 1) * 2048, p.in[I_CVW2] + (size_t)l * 8192, (u16*)(ws + OFF_VCT), 1, lds};
                        gemm_phase(KVb + 4194304, 1024, (const u16*)(ws + OFF_CW1) + (size_t)(l * 2 + 1) * 128 * 2048, 2048, 32, 1, 2048, ev, lds, bx - 96, 1 << 20);
                    }
                    asm volatile("s_waitcnt vmcnt(0)" ::: "memory");
                    __syncthreads();
                    if (threadIdx.x == 0) {
                        __builtin_amdgcn_fence(__ATOMIC_RELEASE, "agent");
                        asm volatile("s_waitcnt vmcnt(0)" ::: "memory");
                        __hip_atomic_fetch_add(cdone, 1u, __ATOMIC_RELAXED, __HIP_MEMORY_SCOPE_AGENT);
                    }
                }
#if EN_CONV
                for (;;) { const int t = block_next(ctl + QW(l, Q_CONV), qslot); if (t >= NTOK / 32) break; conv_tile(p, l, t, lds); }
#else
                zero_mix_cols(p, 0, 256);
#endif
                __syncthreads();
                if (threadIdx.x == 0) {
                    unsigned sp_ = 0;
                    while (__hip_atomic_load(cdone, __ATOMIC_RELAXED, __HIP_MEMORY_SCOPE_AGENT) < 64u) { __builtin_amdgcn_s_sleep(8); if (++sp_ > (1u << 24)) break; }
                    __builtin_amdgcn_fence(__ATOMIC_ACQUIRE, "agent");
                    asm volatile("s_waitcnt vmcnt(0)" ::: "memory");
                }
                __syncthreads();
                for (;;) { const int t = block_next(ctl + QW(l, Q_NSA), qslot); if (t >= 2048) break; nsa_block_task(p, t, lds); }
                if (l == 0) {
                    float* fl = (float*)lds;
                    for (;;) {
                        const int t = block_next(ctl + QW(0, 0), qslot); if (t >= 1536) break;
                        if (t < 512) { const int l2 = t >> 8, r = t & 255; transpose_tile(p.in[I_WOUT] + (size_t)l2 * 1024 * 1024, 1024, (u16*)(ws + OFF_WOUT) + (size_t)l2 * 1024 * 1024, 1024, r >> 4, r & 15, fl); }
                        else { const int u = t - 512; const int l2 = u >> 9, r = u & 511; transpose_tile(p.in[I_PWQ] + (size_t)l2 * 1024 * 2048, 2048, (u16*)(ws + OFF_WQ) + (size_t)l2 * 2048 * 1024, 1024, r >> 5, r & 31, fl); }
                    }
                }
                for (;;) {
                    const int t = block_next(ctl + QW(l, 7), qslot); if (t >= 1024) break;
                    const int tb = t >> 9, r0 = (t & 511) * 32;
                    convert_rows_task(p.in[tb ? I_PV : I_PU] + (size_t)l * 16384 * 1024, ws + OFF_U8 + (size_t)tb * 16 * MiB, (float*)(ws + OFF_UVS) + tb * 16384,
                                      tb ? nullptr : (int*)(ws + OFF_UVS) + 2 * 16384, r0);
                }
            } else if (sp == 3) {
#if EN_RWKV
                phase_rwkv_post(p, l);
#else
                zero_mix_cols(p, 256, 256);
#endif
            } else if (sp == 4) {
                EpiOutProj e{l == 0 ? p.in[I_X] : p.out, p.out, modl + 2 * 1024};
                gemm_phase((const u16*)(ws + OFF_MIX), 1024, (const u16*)(ws + OFF_WOUT) + (size_t)l * 1024 * 1024, 1024, 256, 8, 1024, e, lds, bx, G);
            } else if (sp == 5) {
#if EN_PEER
                phase_norm(p.out, p.in[I_N2G] + l * 1024, modl + 3 * 1024, modl + 4 * 1024, (u16*)(ws + OFF_H));
#endif
            } else if (sp == 6) {
#if EN_PEER
                EpiStoreBf16 e{(u16*)(ws + OFF_QP), 2048};
                gemm_phase((const u16*)(ws + OFF_H), 1024, (const u16*)(ws + OFF_WQ) + (size_t)l * 2048 * 1024, 1024, 256, 16, 1024, e, lds, bx, G);
#endif
            } else if (sp == 7) {
#if EN_PEER
                float* wl = (float*)lds + (TID() >> 6) * 4096;
                for (int t = bx * 4 + (TID() >> 6); t < NTOK / 2; t += G * 4) {
                    peer_topk_task2(p, l, t, wl);
                    peer_experts_token(p, l, 2 * t, (const int*)(wl + 3584), wl + 3584 + 256);
                    peer_experts_token(p, l, 2 * t + 1, (const int*)(wl + 3584) + 128, wl + 3584 + 256 + 128);
                    lds_fence();
                }
#endif
            }
        }
        if (ph + 1 < p.ph_hi) { if (p.ph_lo < 0) grid.sync(); else xcd_barrier(xbar); }
    }
}

extern "C" void kernel_launch(void* const* d_in, const int* in_sizes, int n_in, void* d_out, int out_size, void* d_ws, size_t ws_size,
                              hipStream_t stream) {
    static int grid_blocks = 0;
    if (!grid_blocks) {
        int dev = 0, cus = 0, per_cu = 0;
        hipGetDevice(&dev);
        hipDeviceGetAttribute(&cus, hipDeviceAttributeMultiprocessorCount, dev);
        hipOccupancyMaxActiveBlocksPerMultiprocessor(&per_cu, (const void*)mega, 256, 0);
        if (per_cu > 2) per_cu = 2;
        if (per_cu < 1) per_cu = 1;
        grid_blocks = cus * per_cu;
        if (ws_size < WS_NEED) fprintf(stderr, "kernel_launch: workspace too small: %zu < %zu\n", ws_size, (size_t)WS_NEED);
    }
    hipMemsetAsync((char*)d_ws + OFF_CTL, 0, CTL_ZERO_BYTES, stream);
    Params p{};
    for (int i = 0; i < 35; ++i) p.in[i] = (const float*)d_in[i];
    p.out = (float*)d_out;
    p.ws = (unsigned char*)d_ws;
#if MULTI_LAUNCH
    for (int ph = 0; ph < NPH; ++ph) {
        p.ph_lo = ph; p.ph_hi = ph + 1;
        hipLaunchKernelGGL(mega, dim3(grid_blocks), dim3(256), 0, stream, p);
    }
#else
    p.ph_lo = 0; p.ph_hi = NPH;
    void* args[] = {&p};
    hipError_t e = hipLaunchCooperativeKernel((const void*)mega, dim3(grid_blocks), dim3(256), args, 0, stream);
    if (e != hipSuccess) fprintf(stderr, "cooperative launch failed: %s (grid %d)\n", hipGetErrorString(e), grid_blocks);
#endif
}
```

```cpp
#include <hip/hip_runtime.h>
#include <hip/hip_cooperative_groups.h>
#include <stdint.h>
#include <stdio.h>
namespace cg = cooperative_groups;

#ifndef EN_CONV
#define EN_CONV 1
#endif
#ifndef EN_RWKV
#define EN_RWKV 1
#endif
#ifndef EN_NSA_CMP
#define EN_NSA_CMP 1
#endif
#ifndef EN_NSA_WIN
#define EN_NSA_WIN 1
#endif
#ifndef EN_NSA_SEL
#define EN_NSA_SEL 1
#endif
#ifndef EN_PEER
#define EN_PEER 1
#endif
#ifndef MULTI_LAUNCH
#define MULTI_LAUNCH 0
#endif

#define DEV __device__ __forceinline__
typedef unsigned short u16;
typedef __attribute__((ext_vector_type(8))) short bf16x8;
typedef __attribute__((ext_vector_type(4))) float f32x4;
typedef __attribute__((ext_vector_type(4))) unsigned int u32x4;
typedef __attribute__((ext_vector_type(2))) unsigned int u32x2;

constexpr int NB = 4, NT = 8192, ND = 1024, NTOK = NB * NT, NL = 2;
constexpr int NIN = 2840, NINP = 2944;
constexpr size_t MiB = 1ull << 20;

constexpr size_t OFF_CTL = 0;
constexpr size_t CTL_ZERO_BYTES = 32768;
constexpr size_t OFF_BAR = 16384;
constexpr size_t OFF_MOD = 64 * 1024;
constexpr size_t OFF_CBP = 256 * 1024;
constexpr size_t OFF_WIN = 1 * MiB;
constexpr size_t OFF_WOUT = 13 * MiB;
constexpr size_t OFF_WQ = 17 * MiB;
constexpr size_t OFF_CW1 = 25 * MiB;
constexpr size_t OFF_K12 = 27 * MiB;
constexpr size_t OFF_LW = 27 * MiB + 512 * 1024;
constexpr size_t OFF_U8 = 28 * MiB;
constexpr size_t OFF_UVS = 512 * 1024;
constexpr size_t OFF_H = 92 * MiB;
constexpr size_t OFF_MIX = 156 * MiB;
constexpr size_t OFF_E = 220 * MiB;
constexpr size_t OFF_PCONV = OFF_E + 0;
constexpr size_t OFF_PRWKV = OFF_E + 32 * MiB;
constexpr size_t OFF_YRAW = OFF_E + 32 * MiB;
constexpr size_t OFF_Q = OFF_E + 96 * MiB;
constexpr size_t OFF_KV = OFF_E + 128 * MiB;
constexpr size_t OFF_GATE = OFF_E + 176 * MiB;
constexpr size_t OFF_KC = OFF_E + 180 * MiB;
constexpr size_t OFF_VCT = OFF_KC + 512 * 1024;
constexpr size_t OFF_RV = OFF_E + 184 * MiB;
constexpr size_t OFF_RKK = OFF_E + 200 * MiB;
constexpr size_t OFF_RKKA = OFF_E + 216 * MiB;
constexpr size_t OFF_RG = OFF_E + 232 * MiB;
constexpr size_t OFF_BONUS = OFF_E + 248 * MiB;
constexpr size_t OFF_RW = OFF_E + 249 * MiB;
constexpr size_t OFF_RR = 60 * MiB;
constexpr size_t OFF_RK = 76 * MiB;
constexpr size_t OFF_QP = OFF_E + 0;
constexpr size_t OFF_PIDX = OFF_E + 128 * MiB;
constexpr size_t OFF_PGW = OFF_E + 144 * MiB;
constexpr size_t WS_NEED = OFF_E + 281 * MiB;

#define QW(l, q) (64 * ((l) * 8 + (q)))
enum { Q_CMP = 0, Q_CONV = 1, Q_RWP = 2, Q_NSA = 3, Q_PTK = 4 };

enum { I_X = 0, I_C, I_ADAW, I_ADAB, I_N1G, I_N2G, I_WIN, I_CDW, I_CDB, I_CGG, I_CGB, I_MU, I_W0, I_WUP, I_A0, I_AUP, I_GUP,
       I_KK, I_KA, I_RK, I_LNG, I_LNB, I_CKPOS, I_CKW1, I_CKW2, I_CVPOS, I_CVW1, I_CVW2, I_WOUT, I_PWQ, I_PK1, I_PK2, I_PU, I_PV, I_FG };

struct Params {
    const float* in[35];
    float* out;
    unsigned char* ws;
    int ph_lo, ph_hi;
};

DEV int TID() { int t = threadIdx.x; asm volatile("" : "+v"(t)); return t; }
DEV int BID() { int t = blockIdx.x; asm volatile("" : "+s"(t)); return t; }
typedef __attribute__((ext_vector_type(2))) float f32x2_t;
typedef __attribute__((ext_vector_type(2))) __bf16 bf16x2_t;
DEV unsigned pack2(float a, float b) { const f32x2_t v = {a, b}; return __builtin_bit_cast(unsigned, __builtin_convertvector(v, bf16x2_t)); }
DEV u16 f2bf(float f) { const __bf16 h = (__bf16)f; return __builtin_bit_cast(u16, h); }
DEV float bf2f(u16 h) { return __uint_as_float(((unsigned)h) << 16); }
DEV float bflo(unsigned u) { return __uint_as_float(u << 16); }
DEV float bfhi(unsigned u) { return __uint_as_float(u & 0xffff0000u); }
DEV float ex2(float x) { return __builtin_amdgcn_exp2f(x); }
DEV float sigmoidf_(float x) { return 1.f / (1.f + __expf(-x)); }

DEV f32x4 mfma16(bf16x8 a, bf16x8 b, f32x4 c) { return __builtin_amdgcn_mfma_f32_16x16x32_bf16(a, b, c, 0, 0, 0); }
template <int CTRL> DEV float dppf(float x) { return __int_as_float(__builtin_amdgcn_update_dpp(0, __float_as_int(x), CTRL, 0xF, 0xF, false)); }
template <int CTRL> DEV unsigned dppu(unsigned x) { return (unsigned)__builtin_amdgcn_update_dpp(0, (int)x, CTRL, 0xF, 0xF, false); }
DEV float reduce16(float x) { x += dppf<0xB1>(x); x += dppf<0x4E>(x); x += dppf<0x124>(x); x += dppf<0x128>(x); return x; }
DEV float quadsum(float x) { x += dppf<0xB1>(x); x += dppf<0x4E>(x); return x; }
DEV float x16_sum(float x) { auto r = __builtin_amdgcn_permlane16_swap(__float_as_uint(x), __float_as_uint(x), false, false); return __uint_as_float(r[0]) + __uint_as_float(r[1]); }
DEV float x32_sum(float x) { auto r = __builtin_amdgcn_permlane32_swap(__float_as_uint(x), __float_as_uint(x), false, false); return __uint_as_float(r[0]) + __uint_as_float(r[1]); }
DEV float x16_max(float x) { auto r = __builtin_amdgcn_permlane16_swap(__float_as_uint(x), __float_as_uint(x), false, false); return fmaxf(__uint_as_float(r[0]), __uint_as_float(r[1])); }
DEV float x32_max(float x) { auto r = __builtin_amdgcn_permlane32_swap(__float_as_uint(x), __float_as_uint(x), false, false); return fmaxf(__uint_as_float(r[0]), __uint_as_float(r[1])); }
DEV int x16_sumi(int x) { auto r = __builtin_amdgcn_permlane16_swap((unsigned)x, (unsigned)x, false, false); return (int)(r[0] + r[1]); }
DEV int x32_sumi(int x) { auto r = __builtin_amdgcn_permlane32_swap((unsigned)x, (unsigned)x, false, false); return (int)(r[0] + r[1]); }
DEV float colsum(float x) { return x32_sum(x16_sum(x)); }
DEV float colmax(float x) { return x32_max(x16_max(x)); }
DEV int colsumi(int x) { return x32_sumi(x16_sumi(x)); }
DEV float wave_sum(float v) { return x32_sum(x16_sum(reduce16(v))); }
DEV int wave_sum_i(int x) {
    x += (int)dppu<0xB1>((unsigned)x); x += (int)dppu<0x4E>((unsigned)x); x += (int)dppu<0x124>((unsigned)x); x += (int)dppu<0x128>((unsigned)x);
    return x32_sumi(x16_sumi(x));
}
DEV int reduce8_i(const int (&d)[8]) {
    int t[4];
#pragma unroll
    for (int k = 0; k < 4; ++k) {
        auto r = __builtin_amdgcn_permlane32_swap((unsigned)d[k], (unsigned)d[k + 4], false, false);
        t[k] = (int)(r[0] + r[1]);
    }
    int u[2];
#pragma unroll
    for (int k = 0; k < 2; ++k) {
        auto r = __builtin_amdgcn_permlane16_swap((unsigned)t[k], (unsigned)t[k + 2], false, false);
        u[k] = (int)(r[0] + r[1]);
    }
    const bool hi8 = (threadIdx.x & 8) != 0;
    int x = hi8 ? u[1] : u[0];
    const int y = hi8 ? u[0] : u[1];
    x += (int)dppu<0x128>((unsigned)y);
    x += (int)dppu<0xB1>((unsigned)x); x += (int)dppu<0x4E>((unsigned)x); x += (int)dppu<0x141>((unsigned)x);
    return x;
}
DEV float wave_max(float x) {
    x = fmaxf(x, dppf<0xB1>(x)); x = fmaxf(x, dppf<0x4E>(x)); x = fmaxf(x, dppf<0x124>(x)); x = fmaxf(x, dppf<0x128>(x));
    return x32_max(x16_max(x));
}
DEV void lds_fence() { asm volatile("s_waitcnt lgkmcnt(0)" ::: "memory"); }
DEV bf16x8 ld8(const u16* p) { return *(const bf16x8*)p; }

DEV int block_next(unsigned* ctr, int* slot) {
    __syncthreads();
    if (TID() == 0) *slot = (int)atomicAdd(ctr, 1u);
    __syncthreads();
    return *slot;
}

#define XB_TMO      128
#define XB_XCNT(j)  (256  + 64 * (j))
#define XB_XSUB(j)  (1280 + 64 * (j))
#define XB_XGEN(j)  (2304 + 64 * (j))
#define XB_TOP      3328
#define XB_TOPGEN   3392
#define XCD_BAR_WORDS 3456
#define XB_SPIN_CAP (1u << 22)
#define LAS __attribute__((address_space(3)))
DEV unsigned xb_ld(unsigned* p) { return __hip_atomic_load(p, __ATOMIC_RELAXED, __HIP_MEMORY_SCOPE_AGENT); }
DEV unsigned xb_add(unsigned* p, unsigned v) { return __hip_atomic_fetch_add(p, v, __ATOMIC_RELAXED, __HIP_MEMORY_SCOPE_AGENT); }
DEV unsigned xb_xcc_id() { return (unsigned)__builtin_amdgcn_s_getreg((3 << 11) | 20) & 0xFu; }
#define XB_SPIN(cond, bar) do { unsigned _sp = 0; while (cond) { __builtin_amdgcn_s_sleep(1); \
    if ((++_sp & 255u) == 0u) { if (xb_ld(&(bar)[XB_TMO])) break; if (_sp > XB_SPIN_CAP) { atomicAdd(&(bar)[XB_TMO], 1u); break; } } } } while (0)
struct XcdBarrier { unsigned* bar; unsigned x; volatile unsigned* st; };
DEV XcdBarrier xcd_barrier_post(unsigned* bar, volatile unsigned* st) {
    XcdBarrier b; b.bar = bar; b.x = xb_xcc_id(); b.st = st;
    if (threadIdx.x == 0) (void)xb_add(&bar[XB_XCNT(b.x)], 1u);
    return b;
}
DEV void xcd_barrier_complete(unsigned* bar, unsigned x, unsigned& nloc, unsigned& nx) {
    const unsigned G = gridDim.x * gridDim.y * gridDim.z;
    unsigned sum, cnt, mine, sp = 0u;
    for (;;) {
        sum = 0u; cnt = 0u; mine = 0u;
#pragma unroll
        for (unsigned j = 0; j < 16; ++j) { const unsigned c = xb_ld(&bar[XB_XCNT(j)]); sum += c; cnt += (c > 0u) ? 1u : 0u; mine = (j == x) ? c : mine; }
        if (sum == G) break;
        __builtin_amdgcn_s_sleep(1);
        if ((++sp & 255u) == 0u) { if (xb_ld(&bar[XB_TMO])) break; if (sp > XB_SPIN_CAP) { atomicAdd(&bar[XB_TMO], 1u); break; } }
    }
    nloc = mine > 0u ? mine : 1u; nx = cnt > 0u ? cnt : 1u;
}
DEV void xcd_barrier(const XcdBarrier& b) {
    asm volatile("s_waitcnt vmcnt(0)" ::: "memory");
    __syncthreads();
    if (threadIdx.x == 0) {
        unsigned* bar = b.bar;
        __builtin_amdgcn_s_waitcnt(0);
        unsigned nloc = b.st[0], nx = b.st[1];
        if (nloc == 0u) { xcd_barrier_complete(bar, b.x, nloc, nx); b.st[0] = nloc; b.st[1] = nx; }
        const unsigned old = xb_add(&bar[XB_XSUB(b.x)], 1u);
        const unsigned gen = old / nloc;
        if (old + 1u == (gen + 1u) * nloc) {
            __builtin_amdgcn_fence(__ATOMIC_RELEASE, "agent");
            asm volatile("s_waitcnt vmcnt(0)" ::: "memory");
            const unsigned og = xb_add(&bar[XB_TOP], 1u);
            const unsigned tg = og / nx;
            if (og + 1u == (tg + 1u) * nx) xb_add(&bar[XB_TOPGEN], 1u);
            else XB_SPIN(xb_ld(&bar[XB_TOPGEN]) == tg, bar);
            __builtin_amdgcn_fence(__ATOMIC_ACQUIRE, "agent");
            xb_add(&bar[XB_XGEN(b.x)], 1u);
            asm volatile("s_waitcnt vmcnt(0)" ::: "memory");
        } else {
            XB_SPIN(xb_ld(&bar[XB_XGEN(b.x)]) == gen, bar);
            __builtin_amdgcn_fence(__ATOMIC_ACQUIRE, "agent");
            asm volatile("s_waitcnt vmcnt(0)" ::: "memory");
        }
    }
    __syncthreads();
}

template <class Epi>
DEV void gemm_phase(const u16* __restrict__ A, int lda, const u16* __restrict__ Bt, int ldb, int mtiles, int ntiles, int K, Epi& epi,
                    unsigned char* lds, int bid, int nb, int nt_lo = 0, int nt_skip = 0, bool xcd_order = true) {
    const int tid = TID(), lane = tid & 63, wave = tid >> 6;
    const int wm = wave >> 1, wn = wave & 1, q4 = lane >> 4, cidx = lane & 15;
    u16* As = (u16*)lds;
    u16* Bs = (u16*)(lds + 32768);
    const int KT = K >> 6;
    const int total = mtiles * ntiles;
    const int srow = tid >> 3, sch = tid & 7;
    const bool xo_ = xcd_order && ((nb & 7) == 0) && (nb <= 4096) && ((mtiles & 7) == 0);
    const int ngroups = (ntiles + 7) >> 3;
    const int nloc = xo_ ? (nb >> 3) : 1;
    const int nvirt = xo_ ? ((mtiles >> 3) * ngroups * 64) : total;
    for (int vt = xo_ ? ((bid & 7) * 64 + (bid >> 3)) : bid; vt < nvirt; vt += xo_ ? ((((vt & 63) + nloc) < 64) ? nloc : (8 * 64 - (vt & 63) + (bid >> 3))) : nb) {
        int mt, nt;
        if (xo_) {
            const int st = vt >> 6, tt = vt & 63;
            mt = (st / ngroups) * 8 + (tt >> 3); nt = (st % ngroups) * 8 + (tt & 7);
            if (nt >= ntiles) continue;
        } else { mt = vt / ntiles; nt = vt - mt * ntiles; }
        if (nt >= nt_lo) nt += nt_skip;
        const int m0 = mt * 128, n0 = nt * 128;
        const bool sw = epi.swapped(n0 + wn * 64);
        const int xo = sw ? (32768 / 2 + wn * 64 * 64) : (wm * 64 * 64);
        const int yo = sw ? (wm * 64 * 64) : (32768 / 2 + wn * 64 * 64);
        f32x4 acc[4][4];
#pragma unroll
        for (int i = 0; i < 4; ++i)
#pragma unroll
            for (int j = 0; j < 4; ++j) acc[i][j] = (f32x4){0.f, 0.f, 0.f, 0.f};
        const u16* Ag = A + (size_t)(m0 + srow) * lda + sch * 8;
        const u16* Bg = Bt + (size_t)(n0 + srow) * ldb + sch * 8;
        bf16x8 ra0[4], rb0[4], ra1[4], rb1[4];
#define GEMM_GLOAD(RA, RB, KT_) { const int k0_ = (KT_) * 64; _Pragma("unroll") for (int i = 0; i < 4; ++i) { RA[i] = ld8(Ag + (size_t)(32 * i) * lda + k0_); RB[i] = ld8(Bg + (size_t)(32 * i) * ldb + k0_); } }
#define GEMM_LWRITE(RA, RB, BUF_) { u16* Aw_ = As + (BUF_) * 8192; u16* Bw_ = Bs + (BUF_) * 8192; _Pragma("unroll") for (int i = 0; i < 4; ++i) { const int row = srow + 32 * i; const int off = row * 64 + ((sch ^ (row & 7)) << 3); *(bf16x8*)(Aw_ + off) = RA[i]; *(bf16x8*)(Bw_ + off) = RB[i]; } }
#define GEMM_COMPUTE(BUF_) { const u16* Xb = As + (BUF_) * 8192 + xo; const u16* Yb = As + (BUF_) * 8192 + yo; _Pragma("unroll") for (int s = 0; s < 2; ++s) { bf16x8 a[4], b[4]; const int ch = s * 4 + q4; _Pragma("unroll") for (int i = 0; i < 4; ++i) { const int row = i * 16 + cidx; a[i] = *(const bf16x8*)(Xb + row * 64 + ((ch ^ (row & 7)) << 3)); b[i] = *(const bf16x8*)(Yb + row * 64 + ((ch ^ (row & 7)) << 3)); } _Pragma("unroll") for (int i = 0; i < 4; ++i) _Pragma("unroll") for (int j = 0; j < 4; ++j) acc[i][j] = mfma16(a[i], b[j], acc[i][j]); } }
        GEMM_GLOAD(ra0, rb0, 0);
        if (KT > 1) GEMM_GLOAD(ra1, rb1, 1);
        GEMM_LWRITE(ra0, rb0, 0);
        __syncthreads();
        for (int kt = 0; kt < KT; kt += 2) {
            if (kt + 2 < KT) GEMM_GLOAD(ra0, rb0, kt + 2);
            GEMM_COMPUTE(0);
            GEMM_LWRITE(ra1, rb1, 1);
            __syncthreads();
            if (kt + 3 < KT) GEMM_GLOAD(ra1, rb1, kt + 3);
            GEMM_COMPUTE(1);
            if (kt + 2 < KT) GEMM_LWRITE(ra0, rb0, 0);
            __syncthreads();
        }
#undef GEMM_GLOAD
#undef GEMM_LWRITE
#undef GEMM_COMPUTE
        if (!sw) {
#pragma unroll
            for (int i = 0; i < 4; ++i)
#pragma unroll
                for (int j = 0; j < 4; ++j) epi.rows4(m0 + wm * 64 + i * 16 + q4 * 4, n0 + wn * 64 + j * 16 + cidx, acc[i][j]);
        } else {
#pragma unroll
            for (int i = 0; i < 4; ++i)
#pragma unroll
                for (int j = 0; j < 4; ++j) epi.cols4(m0 + wm * 64 + j * 16 + cidx, n0 + wn * 64 + i * 16 + q4 * 4, acc[i][j]);
        }
        epi.finish(m0, n0, lds);
    }
}

struct EpiInProj {
    u16 *pconv, *prwkv, *q, *kv; float* gate;
    DEV bool swapped(int c0) const { return !((c0 >= 2432 && c0 < 2560) || (c0 >= 2688 && c0 < 2816)); }
    DEV void rows4(int row0, int col, f32x4 v) const {
        const int c = col - 2048; const int idx = c >> 7; const int g = (c >> 6) & 1; const int d = c & 63;
        const int b = row0 >> 13; const int t0 = row0 & 8191; const int bg = b * 2 + g;
        u16* base = kv + (size_t)idx * 4194304;
        const int k = t0 & 31; const int p0 = 8 * ((k & 15) >> 2) + 4 * (k >> 4);
        u32x2 w; w[0] = pack2(v[0], v[1]); w[1] = pack2(v[2], v[3]);
        *(u32x2*)(base + (size_t)(bg * 64 + d) * 8192 + (t0 & ~31) + p0) = w;
    }
    DEV void cols4(int row, int col0, f32x4 v) const {
        if (col0 < 512) {
            u32x2 w; w[0] = pack2(v[0], v[1]); w[1] = pack2(v[2], v[3]);
            *(u32x2*)(pconv + (size_t)row * 512 + col0) = w;
        } else if (col0 < 1536) {
            u32x2 w; w[0] = pack2(v[0], v[1]); w[1] = pack2(v[2], v[3]);
            *(u32x2*)(prwkv + (size_t)row * 1024 + (col0 - 512)) = w;
        } else if (col0 < 2048) {
            const float sc = 0.18033688011112042f;
            u32x2 w; w[0] = pack2(v[0] * sc, v[1] * sc); w[1] = pack2(v[2] * sc, v[3] * sc);
            *(u32x2*)(q + (size_t)row * 512 + (col0 - 1536)) = w;
        } else if (col0 < 2816) {
            const int c = col0 - 2048; const int idx = c >> 7; const int g = (c >> 6) & 1; const int d = c & 63;
            const int b = row >> 13; const int t = row & 8191; const int bg = b * 2 + g;
            u32x2 w; w[0] = pack2(v[0], v[1]); w[1] = pack2(v[2], v[3]);
            *(u32x2*)(kv + (size_t)idx * 4194304 + ((size_t)bg * 8192 + t) * 64 + d) = w;
        } else if (col0 < 2840) {
            *(float4*)(gate + (size_t)row * 24 + (col0 - 2816)) = (float4){sigmoidf_(v[0]), sigmoidf_(v[1]), sigmoidf_(v[2]), sigmoidf_(v[3])};
        }
    }
    DEV void finish(int, int, unsigned char*) const {}
};

struct EpiOutProj {
    const float* xold; float* xnew; const float* g1;
    DEV bool swapped(int) const { return true; }
    DEV void rows4(int, int, f32x4) const {}
    DEV void cols4(int row, int col0, f32x4 v) const {
        const int b = row >> 13; const float4 gg = *(const float4*)(g1 + b * 6144 + col0);
        const size_t o = (size_t)row * 1024 + col0;
        const float4 x = *(const float4*)(xold + o);
        *(float4*)(xnew + o) = (float4){x.x + gg.x * v[0], x.y + gg.y * v[1], x.z + gg.z * v[2], x.w + gg.w * v[3]};
    }
    DEV void finish(int, int, unsigned char*) const {}
};

struct EpiStoreBf16 {
    u16* out; int ld;
    DEV bool swapped(int) const { return true; }
    DEV void rows4(int, int, f32x4) const {}
    DEV void cols4(int row, int col0, f32x4 v) const {
        u32x2 w; w[0] = pack2(v[0], v[1]); w[1] = pack2(v[2], v[3]);
        *(u32x2*)(out + (size_t)row * ld + col0) = w;
    }
    DEV void finish(int, int, unsigned char*) const {}
};

struct EpiCompress {
    const float* cbp;
    const float* w2;
    u16* outp;
    int isv;
    unsigned char* lds;
    DEV bool swapped(int) const { return false; }
    DEV void cols4(int, int, f32x4) const {}
    DEV void rows4(int row0, int col, f32x4 v) const {
        float* hid = (float*)lds;
        const int rl = row0 & 127;
#pragma unroll
        for (int r = 0; r < 4; ++r) hid[(rl + r) * 128 + col] = v[r];
    }
    DEV void finish(int m0, int, unsigned char*) const {
        __syncthreads();
        {
            float* hw = (float*)lds;
            const int t = TID(); const int c = t & 127, r0 = (t >> 7) * 64;
            float bias = 0.f;
#pragma unroll
            for (int s = 0; s < 16; ++s) bias += cbp[s * 128 + c];
#pragma unroll 4
            for (int r = 0; r < 64; ++r) { const float x = hw[(r0 + r) * 128 + c] + bias; hw[(r0 + r) * 128 + c] = x * sigmoidf_(x); }
        }
        __syncthreads();
        const float* hid = (const float*)lds;
        const int tid = TID(); const int d = tid & 63, rgp = tid >> 6;
        float acc[32];
#pragma unroll
        for (int i = 0; i < 32; ++i) acc[i] = 0.f;
#pragma unroll 1
        for (int j0 = 0; j0 < 128; j0 += 8) {
            float wv[8];
#pragma unroll
            for (int jj = 0; jj < 8; ++jj) wv[jj] = w2[(j0 + jj) * 64 + d];
#pragma unroll
            for (int rr = 0; rr < 32; ++rr) {
                const float4 h0 = *(const float4*)(hid + (rgp * 32 + rr) * 128 + j0), h1 = *(const float4*)(hid + (rgp * 32 + rr) * 128 + j0 + 4);
                acc[rr] += h0.x * wv[0] + h0.y * wv[1] + h0.z * wv[2] + h0.w * wv[3] + h1.x * wv[4] + h1.y * wv[5] + h1.z * wv[6] + h1.w * wv[7];
            }
        }
#pragma unroll
        for (int rr = 0; rr < 32; ++rr) {
            const int m = m0 + rgp * 32 + rr; const int bg = m >> 9, n = m & 511;
            const u16 val = (n == 511) ? (u16)0 : f2bf(acc[rr]);
            if (!isv) outp[((size_t)bg * 512 + n) * 64 + d] = val;
            else {
                const int k = n & 31; const int pp = 8 * ((k & 15) >> 2) + (k & 3) + 4 * (k >> 4);
                outp[((size_t)bg * 64 + d) * 512 + (n & ~31) + pp] = val;
            }
        }
        __syncthreads();
    }
};

DEV void transpose_tile(const float* __restrict__ src, int N, u16* __restrict__ dst, int ldk, int kt, int nt, float* tl) {
    const int tid = TID(); const int k0 = kt * 64, n0 = nt * 64;
#pragma unroll 4
    for (int i = 0; i < 16; ++i) {
        const int idx = tid + 256 * i; const int kr = idx >> 6, nc = idx & 63; const int n = n0 + nc;
        tl[kr * 65 + nc] = (n < N) ? src[(size_t)(k0 + kr) * N + n] : 0.f;
    }
    __syncthreads();
#pragma unroll 4
    for (int i = 0; i < 16; ++i) {
        const int idx = tid + 256 * i; const int nr = idx >> 6, kc = idx & 63;
        dst[(size_t)(n0 + nr) * ldk + k0 + kc] = f2bf(tl[kc * 65 + nr]);
    }
    __syncthreads();
}

DEV void convert_straight(const float* __restrict__ src, u16* __restrict__ dst, size_t n) {
    const size_t stride = (size_t)gridDim.x * 256 * 8;
    for (size_t i = ((size_t)BID() * 256 + TID()) * 8; i < n; i += stride) {
        const float4 a = *(const float4*)(src + i); const float4 b = *(const float4*)(src + i + 4);
        u32x4 w; w[0] = pack2(a.x, a.y); w[1] = pack2(a.z, a.w); w[2] = pack2(b.x, b.y); w[3] = pack2(b.z, b.w);
        *(u32x4*)(dst + i) = w;
    }
}

DEV void convert_rows_task(const float* __restrict__ src, unsigned char* __restrict__ dst, float* __restrict__ scale, int* __restrict__ rowsum, int row0) {
    const int lane = TID() & 63, wave = TID() >> 6;
#pragma unroll 1
    for (int it = 0; it < 4; ++it) {
        float4 v[2][4]; float amax[2] = {0.f, 0.f};
#pragma unroll
        for (int u = 0; u < 2; ++u) {
            const int row = row0 + wave * 8 + it * 2 + u;
#pragma unroll
            for (int i = 0; i < 4; ++i) v[u][i] = *(const float4*)(src + (size_t)row * 1024 + 16 * lane + 4 * i);
        }
#pragma unroll
        for (int u = 0; u < 2; ++u) {
#pragma unroll
            for (int i = 0; i < 4; ++i)
                amax[u] = fmaxf(amax[u], fmaxf(fmaxf(fabsf(v[u][i].x), fabsf(v[u][i].y)), fmaxf(fabsf(v[u][i].z), fabsf(v[u][i].w))));
            amax[u] = wave_max(amax[u]);
            const int row = row0 + wave * 8 + it * 2 + u;
            const float sc = amax[u] > 0.f ? amax[u] * (1.f / 127.f) : 1.f;
            const float inv = 1.f / sc;
            u32x4 w;
#pragma unroll
            for (int i = 0; i < 4; ++i) {
                const int a = __float2int_rn(v[u][i].x * inv) + 128, b = __float2int_rn(v[u][i].y * inv) + 128, c = __float2int_rn(v[u][i].z * inv) + 128,
                          d = __float2int_rn(v[u][i].w * inv) + 128;
                w[i] = (unsigned)a | ((unsigned)b << 8) | ((unsigned)c << 16) | ((unsigned)d << 24);
            }
            *(u32x4*)(dst + (size_t)row * 1024 + 16 * lane) = w;
            int bs = 0;
#pragma unroll
            for (int i = 0; i < 4; ++i) bs += (int)(w[i] & 0xffu) + (int)((w[i] >> 8) & 0xffu) + (int)((w[i] >> 16) & 0xffu) + (int)(w[i] >> 24);
            bs = wave_sum_i(bs);
            if (lane == 0) { scale[row] = sc; if (rowsum) rowsum[row] = bs; }
        }
    }
}

DEV void phase_prep(const Params& p, unsigned char* lds) {
    const int tid = TID();
    float* fl = (float*)lds;
    unsigned char* ws = p.ws;
    for (int task = BID(); task < 192; task += gridDim.x) {
        const int l = task / 96, cgp = task % 96;
        float* cs = fl;
        float* red = fl + 4096;
        for (int i = tid; i < 4096; i += 256) { const float c = p.in[I_C][i]; cs[i] = c / (1.f + __expf(-c)); }
        __syncthreads();
        const int col = cgp * 64 + (tid & 63), ks = tid >> 6;
        float a0 = 0, a1 = 0, a2 = 0, a3 = 0;
        const float* w = p.in[I_ADAW] + ((size_t)l * 1024 + ks * 256) * 6144 + col;
#pragma unroll 32
        for (int k = 0; k < 256; ++k) {
            const float wv = w[(size_t)k * 6144]; const int kk = ks * 256 + k;
            a0 += cs[kk] * wv; a1 += cs[1024 + kk] * wv; a2 += cs[2048 + kk] * wv; a3 += cs[3072 + kk] * wv;
        }
        red[(ks * 4 + 0) * 64 + (tid & 63)] = a0; red[(ks * 4 + 1) * 64 + (tid & 63)] = a1;
        red[(ks * 4 + 2) * 64 + (tid & 63)] = a2; red[(ks * 4 + 3) * 64 + (tid & 63)] = a3;
        __syncthreads();
        {
            const int b = tid >> 6, c = tid & 63;
            const float s = red[(0 * 4 + b) * 64 + c] + red[(1 * 4 + b) * 64 + c] + red[(2 * 4 + b) * 64 + c] + red[(3 * 4 + b) * 64 + c];
            const int colg = cgp * 64 + c;
            ((float*)(ws + OFF_MOD))[(l * 4 + b) * 6144 + colg] = s + p.in[I_ADAB][l * 6144 + colg];
        }
        __syncthreads();
    }
    for (int task = BID(); task < 64; task += gridDim.x) {
        const int l = task >> 5, kv = (task >> 4) & 1, s = task & 15;
        const float* pos = p.in[kv ? I_CVPOS : I_CKPOS] + l * 2048;
        const float* w1 = p.in[kv ? I_CVW1 : I_CKW1] + (size_t)l * 2048 * 128;
        const int col = tid & 127, half = tid >> 7;
        float a = 0;
        const int i0 = s * 128 + half * 64;
#pragma unroll 8
        for (int i = 0; i < 64; ++i) a += pos[i0 + i] * w1[(size_t)(i0 + i) * 128 + col];
        fl[tid] = a;
        __syncthreads();
        if (tid < 128) ((float*)(ws + OFF_CBP))[((l * 2 + kv) * 16 + s) * 128 + tid] = fl[tid] + fl[tid + 128];
        __syncthreads();
    }
    {
        for (int task = BID(); task < 2 * 16 * 46; task += gridDim.x) {
            const int l = task / (16 * 46), r = task % (16 * 46);
            transpose_tile(p.in[I_WIN] + (size_t)l * 1024 * NIN, NIN, (u16*)(ws + OFF_WIN) + (size_t)l * NINP * 1024, 1024, r / 46, r % 46, fl);
        }
        for (int task = BID(); task < 2 * 16; task += gridDim.x) {
            const int l = task >> 4, r = task & 15; const int nt = r & 3, part = r >> 2;
            u16* dst = (u16*)(ws + OFF_LW) + (size_t)l * 65536;
            if (part == 0) transpose_tile(p.in[I_WUP] + (size_t)l * 64 * 256, 256, dst, 256, 0, nt, fl);
            else if (part == 1) transpose_tile(p.in[I_AUP] + (size_t)l * 64 * 256, 256, dst + 64, 256, 0, nt, fl);
            else transpose_tile(p.in[I_GUP] + (size_t)l * 128 * 256, 256, dst + 128, 256, part - 2, nt, fl);
        }
        for (int task = BID(); task < 4 * 32 * 2; task += gridDim.x) {
            const int lk = task >> 6, r = task & 63; const int l = lk >> 1, kv = lk & 1;
            transpose_tile(p.in[kv ? I_CVW1 : I_CKW1] + (size_t)l * 2048 * 128, 128, (u16*)(ws + OFF_CW1) + (size_t)lk * 128 * 2048, 2048, r >> 1, r & 1, fl);
        }
    }
    for (int l = 0; l < 2; ++l) {
        convert_straight(p.in[I_PK1] + l * 16384, (u16*)(ws + OFF_K12) + (l * 2 + 0) * 16384, 16384);
        convert_straight(p.in[I_PK2] + l * 16384, (u16*)(ws + OFF_K12) + (l * 2 + 1) * 16384, 16384);
    }
}

DEV void phase_norm(const float* __restrict__ x, const float* __restrict__ g, const float* __restrict__ sh, const float* __restrict__ sc,
                    u16* __restrict__ h) {
    const int lane = TID() & 63;
    const int gw = BID() * 4 + (TID() >> 6), nw = gridDim.x * 4;
    for (int row = gw; row < NTOK; row += nw) {
        const int b = row >> 13;
        float4 v[4]; float ss = 0;
#pragma unroll
        for (int i = 0; i < 4; ++i) { v[i] = *(const float4*)(x + (size_t)row * 1024 + 256 * i + lane * 4); ss += v[i].x * v[i].x + v[i].y * v[i].y + v[i].z * v[i].z + v[i].w * v[i].w; }
        ss = wave_sum(ss);
        const float rs = rsqrtf(ss * (1.f / 1024.f) + 1e-6f);
#pragma unroll
        for (int i = 0; i < 4; ++i) {
            const int k = 256 * i + lane * 4;
            const float4 gg = *(const float4*)(g + k); const float4 s1 = *(const float4*)(sc + b * 6144 + k); const float4 s0 = *(const float4*)(sh + b * 6144 + k);
            u32x2 w;
            w[0] = pack2(v[i].x * rs * gg.x * (1.f + s1.x) + s0.x, v[i].y * rs * gg.y * (1.f + s1.y) + s0.y);
            w[1] = pack2(v[i].z * rs * gg.z * (1.f + s1.z) + s0.z, v[i].w * rs * gg.w * (1.f + s1.w) + s0.w);
            *(u32x2*)(h + (size_t)row * 1024 + k) = w;
        }
    }
}

DEV void conv_tile(const Params& p, int l, int tile, unsigned char* lds) {
    float* ul = (float*)lds;
    const int tid = TID();
    unsigned char* ws = p.ws;
    const u16* pconv = (const u16*)(ws + OFF_PCONV);
    u16* mix = (u16*)(ws + OFF_MIX);
    const int t0g = tile * 32; const int tb = t0g & 8191;
#pragma unroll 8
    for (int rr = 0; rr < 62; ++rr) {
        const int trow = tb - 30 + rr;
        float u = 0.f;
        if (trow >= 0) {
            const size_t o = (size_t)(t0g - 30 + rr) * 512;
            const float val = bf2f(pconv[o + tid]), gt = bf2f(pconv[o + 256 + tid]);
            u = val * sigmoidf_(gt);
        }
        ul[rr * 256 + tid] = u;
    }
    __syncthreads();
    float w[31];
#pragma unroll
    for (int j = 0; j < 31; ++j) w[j] = p.in[I_CDW][(l * 31 + j) * 256 + tid];
    const float bias = p.in[I_CDB][l * 256 + tid], gg = p.in[I_CGG][l * 256 + tid], gb = p.in[I_CGB][l * 256 + tid];
    for (int tt = 0; tt < 32; ++tt) {
        float y = bias;
#pragma unroll
        for (int j = 0; j < 31; ++j) y += ul[(tt + j) * 256 + tid] * w[j];
        const float mean = wave_sum(y) * (1.f / 64.f);
        const float d = y - mean;
        const float var = wave_sum(d * d) * (1.f / 64.f);
        float o = d * rsqrtf(var + 1e-5f) * gg + gb;
        o = o * sigmoidf_(o);
        mix[(size_t)(t0g + tt) * 1024 + tid] = f2bf(o);
    }
}

DEV float softplusf_(float x) { return x > 20.f ? x : log1pf(__expf(x)); }
DEV void rwkv_prep_tile2(const Params& p, int l, int tile, unsigned char* lds) {
    u16* actb = (u16*)lds;
    const int tid = TID(), lane = tid & 63, wave = tid >> 6, q4 = lane >> 4, cidx = lane & 15;
    unsigned char* ws = p.ws;
    const u16* pr = (const u16*)(ws + OFF_PRWKV);
    const float* mu = p.in[I_MU] + l * 1024;
    const int R0 = tile * 16;
    {
        const int col = 768 + tid; const float muc = mu[col];
        u16 raw[17];
        const bool first = ((R0 & 8191) == 0);
        raw[0] = first ? (u16)0 : pr[(size_t)(R0 - 1) * 1024 + col];
#pragma unroll
        for (int tk = 0; tk < 16; ++tk) raw[tk + 1] = pr[(size_t)(R0 + tk) * 1024 + col];
#pragma unroll
        for (int tk = 0; tk < 16; ++tk) {
            const float cur = bf2f(raw[tk + 1]), prev = bf2f(raw[tk]);
            const float x = cur + (prev - cur) * muc;
            float a;
            if (tid < 64) a = tanhf(x); else if (tid < 128) a = x; else a = sigmoidf_(x);
            actb[tk * 264 + tid] = f2bf(a);
        }
    }
    __syncthreads();
    f32x4 accw[4], acca[4], accg[4];
    {
        bf16x8 af[8];
#pragma unroll
        for (int s2 = 0; s2 < 8; ++s2) af[s2] = *(const bf16x8*)(actb + cidx * 264 + 32 * s2 + 8 * q4);
        const u16* LW = (const u16*)(ws + OFF_LW) + (size_t)l * 65536;
        const f32x4 z = (f32x4){0.f, 0.f, 0.f, 0.f};
#pragma unroll
        for (int nt = 0; nt < 4; ++nt) {
            const u16* bp = LW + (size_t)(64 * wave + 16 * nt + cidx) * 256 + 8 * q4;
            accw[nt] = mfma16(af[0], ld8(bp), z); accw[nt] = mfma16(af[1], ld8(bp + 32), accw[nt]);
            acca[nt] = mfma16(af[2], ld8(bp + 64), z); acca[nt] = mfma16(af[3], ld8(bp + 96), acca[nt]);
            accg[nt] = mfma16(af[4], ld8(bp + 128), z); accg[nt] = mfma16(af[5], ld8(bp + 160), accg[nt]);
            accg[nt] = mfma16(af[6], ld8(bp + 192), accg[nt]); accg[nt] = mfma16(af[7], ld8(bp + 224), accg[nt]);
        }
    }
    float* RW = (float*)(ws + OFF_RW);
    u16 *RR = (u16*)(ws + OFF_RR), *RK = (u16*)(ws + OFF_RK), *RV = (u16*)(ws + OFF_RV), *RKK = (u16*)(ws + OFF_RKK), *RKKA = (u16*)(ws + OFF_RKKA),
        *RG = (u16*)(ws + OFF_RG);
    float* BON = (float*)(ws + OFF_BONUS);
    float w0[4], a0[4], kkc[4], kac[4], rkc[4], mur[4], muk[4], muv[4];
#pragma unroll
    for (int nt = 0; nt < 4; ++nt) {
        const int c = 64 * wave + 16 * nt + cidx;
        w0[nt] = p.in[I_W0][l * 256 + c]; a0[nt] = p.in[I_A0][l * 256 + c]; kkc[nt] = p.in[I_KK][l * 256 + c]; kac[nt] = p.in[I_KA][l * 256 + c];
        rkc[nt] = p.in[I_RK][l * 256 + c]; mur[nt] = mu[c]; muk[nt] = mu[256 + c]; muv[nt] = mu[512 + c];
    }
    u16 ld3[5][4][3];
    {
        const int rowb = R0 + 4 * q4; const bool firstrow = ((rowb & 8191) == 0);
#pragma unroll
        for (int rr_ = 0; rr_ < 5; ++rr_)
#pragma unroll
            for (int nt = 0; nt < 4; ++nt) {
                const int c = 64 * wave + 16 * nt + cidx;
                const u16* cr = pr + (size_t)(rowb - 1 + rr_) * 1024;
                const bool z = (rr_ == 0) && firstrow;
                ld3[rr_][nt][0] = z ? (u16)0 : cr[c]; ld3[rr_][nt][1] = z ? (u16)0 : cr[256 + c]; ld3[rr_][nt][2] = z ? (u16)0 : cr[512 + c];
            }
    }
#pragma unroll
    for (int r = 0; r < 4; ++r) {
        const int row = R0 + 4 * q4 + r;
        float rr[4], kf_[4], vf_[4], av[4], kkv[4], keff[4], dec[4];
        float kk2 = 0.f, bn = 0.f;
#pragma unroll
        for (int nt = 0; nt < 4; ++nt) {
            float rv = bf2f(ld3[r + 1][nt][0]), kv = bf2f(ld3[r + 1][nt][1]), vv = bf2f(ld3[r + 1][nt][2]);
            const float rp = bf2f(ld3[r][nt][0]), kp = bf2f(ld3[r][nt][1]), vp = bf2f(ld3[r][nt][2]);
            rv += (rp - rv) * mur[nt]; kv += (kp - kv) * muk[nt]; vv += (vp - vv) * muv[nt];
            const float wl = w0[nt] + accw[nt][r];
            const float wlog = -softplusf_(-wl) - 0.5f;
            dec[nt] = __expf(-__expf(wlog));
            av[nt] = sigmoidf_(a0[nt] + acca[nt][r]);
            kkv[nt] = kv * kkc[nt]; kk2 += kkv[nt] * kkv[nt];
            keff[nt] = kv * (1.f + (av[nt] - 1.f) * kac[nt]);
            bn += rv * keff[nt] * rkc[nt];
            rr[nt] = rv; kf_[nt] = kv; vf_[nt] = vv;
        }
        kk2 = reduce16(kk2); bn = reduce16(bn);
        const float inv = 1.f / fmaxf(sqrtf(kk2), 1e-12f);
#pragma unroll
        for (int nt = 0; nt < 4; ++nt) {
            const int c = 64 * wave + 16 * nt + cidx;
            const size_t o = (size_t)row * 256 + c;
            const float kk = kkv[nt] * inv;
            RW[o] = dec[nt]; RR[o] = f2bf(rr[nt]); RK[o] = f2bf(keff[nt]); RV[o] = f2bf(vf_[nt]); RKK[o] = f2bf(kk); RKKA[o] = f2bf(kk * av[nt]);
            RG[o] = f2bf(accg[nt][r]);
        }
        if (cidx == 0) BON[(size_t)row * 4 + wave] = bn;
    }
}

DEV void rwkv_scan(const Params& p, int sb, unsigned char* lds) {
    unsigned char* ws = p.ws;
    const float* RW = (const float*)(ws + OFF_RW);
    const u16 *RR = (const u16*)(ws + OFF_RR), *RK = (const u16*)(ws + OFF_RK), *RV = (const u16*)(ws + OFF_RV), *RKK = (const u16*)(ws + OFF_RKK),
              *RKKA = (const u16*)(ws + OFF_RKKA);
    float* YR = (float*)(ws + OFF_YRAW);
    const int tid = TID(), lane = tid & 63, wave = tid >> 6;
    const int bh = sb >> 2, rg = sb & 3; const int b = bh >> 2, hh = bh & 3;
    float* L = (float*)lds;
    constexpr int BUFSZ = 5 * 1024 + 256;
    float* Yb = L + 2 * BUFSZ;
    const int row_local = 4 * wave + (lane >> 4); const int kq = (lane & 15) * 4;
    const int lstep = tid >> 4, lk = (tid & 15) * 4;
    const int vstep = tid >> 4, vrow = tid & 15;
    const size_t gbase = (size_t)b * 8192 * 256 + hh * 64;
    float4 lw; u32x2 lr, lkk, lkka, lk_; u16 lv;
    auto issue = [&](int c) {
        const size_t o = gbase + (size_t)(c * 16 + lstep) * 256 + lk;
        lw = *(const float4*)(RW + o);
        lr = *(const u32x2*)(RR + o); lk_ = *(const u32x2*)(RK + o); lkk = *(const u32x2*)(RKK + o); lkka = *(const u32x2*)(RKKA + o);
        lv = RV[gbase + (size_t)(c * 16 + vstep) * 256 + rg * 16 + vrow];
    };
    auto commit = [&](int buf) {
        float* B = L + buf * BUFSZ;
        const int o = lstep * 64 + lk;
        *(float4*)(B + o) = lw;
        *(float4*)(B + 1024 + o) = (float4){bflo(lkka[0]), bfhi(lkka[0]), bflo(lkka[1]), bfhi(lkka[1])};
        *(float4*)(B + 2048 + o) = (float4){bflo(lk_[0]), bfhi(lk_[0]), bflo(lk_[1]), bfhi(lk_[1])};
        *(float4*)(B + 3072 + o) = (float4){bflo(lr[0]), bfhi(lr[0]), bflo(lr[1]), bfhi(lr[1])};
        *(float4*)(B + 4096 + o) = (float4){bflo(lkk[0]), bfhi(lkk[0]), bflo(lkk[1]), bfhi(lkk[1])};
        B[5120 + vstep * 16 + vrow] = bf2f(lv);
    };
    __syncthreads();
    issue(0); commit(0);
    __syncthreads();
    float S0 = 0.f, S1 = 0.f, S2 = 0.f, S3 = 0.f;
    constexpr int NCH = NT / 16;
    for (int c = 0; c < NCH; ++c) {
        const int buf = c & 1;
        if (c + 1 < NCH) issue(c + 1);
        const float* B = L + buf * BUFSZ;
        float* Y = Yb + buf * 256;
        float yv[16];
        float4 w4 = *(const float4*)(B + kq), a4 = *(const float4*)(B + 1024 + kq), k4 = *(const float4*)(B + 2048 + kq),
               r4 = *(const float4*)(B + 3072 + kq), n4 = *(const float4*)(B + 4096 + kq);
        float vv = B[5120 + row_local];
#pragma unroll
        for (int st = 0; st < 16; ++st) {
            float4 w4n, a4n, k4n, r4n, n4n; float vvn;
            if (st < 15) {
                w4n = *(const float4*)(B + (st + 1) * 64 + kq); a4n = *(const float4*)(B + 1024 + (st + 1) * 64 + kq);
                k4n = *(const float4*)(B + 2048 + (st + 1) * 64 + kq); r4n = *(const float4*)(B + 3072 + (st + 1) * 64 + kq);
                n4n = *(const float4*)(B + 4096 + (st + 1) * 64 + kq); vvn = B[5120 + (st + 1) * 16 + row_local];
            }
            const float part = (S0 * n4.x + S1 * n4.y) + (S2 * n4.z + S3 * n4.w);
            const float sa = -reduce16(part);
            const float t0 = S0 * w4.x + vv * k4.x, t1 = S1 * w4.y + vv * k4.y, t2 = S2 * w4.z + vv * k4.z, t3 = S3 * w4.w + vv * k4.w;
            S0 = t0 + sa * a4.x; S1 = t1 + sa * a4.y; S2 = t2 + sa * a4.z; S3 = t3 + sa * a4.w;
            const float yp = (S0 * r4.x + S1 * r4.y) + (S2 * r4.z + S3 * r4.w);
            yv[st] = reduce16(yp);
            if (st < 15) { w4 = w4n; a4 = a4n; k4 = k4n; r4 = r4n; n4 = n4n; vv = vvn; }
        }
        if ((lane & 15) == 0) {
#pragma unroll
            for (int st = 0; st < 16; ++st) Y[st * 16 + row_local] = yv[st];
        }
        if (c + 1 < NCH) commit(buf ^ 1);
        __syncthreads();
        YR[gbase + (size_t)(c * 16 + vstep) * 256 + rg * 16 + vrow] = Y[vstep * 16 + vrow];
    }
}

DEV void phase_rwkv_post(const Params& p, int l) {
    unsigned char* ws = p.ws;
    const float* YR = (const float*)(ws + OFF_YRAW); const float* BON = (const float*)(ws + OFF_BONUS);
    const u16 *RV = (const u16*)(ws + OFF_RV), *RG = (const u16*)(ws + OFF_RG);
    u16* mix = (u16*)(ws + OFF_MIX);
    const int tid = TID();
    const float lg = p.in[I_LNG][l * 256 + tid], lb = p.in[I_LNB][l * 256 + tid];
    for (int row = BID(); row < NTOK; row += gridDim.x) {
        const size_t o = (size_t)row * 256 + tid;
        const float y = YR[o];
        const float mean = wave_sum(y) * (1.f / 64.f);
        const float d = y - mean;
        const float var = wave_sum(d * d) * (1.f / 64.f);
        const float yn = d * rsqrtf(var + 64e-5f) * lg + lb;
        const float outv = (yn + BON[(size_t)row * 4 + (tid >> 6)] * bf2f(RV[o])) * bf2f(RG[o]);
        mix[(size_t)row * 1024 + 256 + tid] = f2bf(outv);
    }
}

DEV void zero_mix_cols(const Params& p, int c0, int ncols) {
    u16* mix = (u16*)(p.ws + OFF_MIX);
    const int per = ncols / 8;
    const size_t total = (size_t)NTOK * per;
    for (size_t i = (size_t)BID() * 256 + TID(); i < total; i += (size_t)gridDim.x * 256) {
        const size_t row = i / per; const int cc = (int)(i % per);
        *(u32x4*)(mix + row * 1024 + c0 + cc * 8) = (u32x4){0u, 0u, 0u, 0u};
    }
}


DEV void qk_tile(const bf16x8 (&kf)[8], bf16x8 q0, bf16x8 q1, float cinit, f32x4 (&st)[4]) {
    const f32x4 c = (f32x4){cinit, cinit, cinit, cinit};
#pragma unroll
    for (int kt = 0; kt < 4; ++kt) {
        st[kt] = mfma16(kf[2 * kt], q0, c);
        st[kt] = mfma16(kf[2 * kt + 1], q1, st[kt]);
    }
}
DEV void softmax_pv_lazy(f32x4 (&st)[4], const bf16x8 (&vf)[8], float& m, float& l, f32x4& L, f32x4 (&O)[4]) {
    float lmax = fmaxf(fmaxf(fmaxf(st[0][0], st[0][1]), fmaxf(st[0][2], st[0][3])), fmaxf(fmaxf(st[1][0], st[1][1]), fmaxf(st[1][2], st[1][3])));
    lmax = fmaxf(lmax, fmaxf(fmaxf(fmaxf(st[2][0], st[2][1]), fmaxf(st[2][2], st[2][3])), fmaxf(fmaxf(st[3][0], st[3][1]), fmaxf(st[3][2], st[3][3]))));
    lmax = colmax(lmax);
    const float dlt = (lmax > 8.f) ? lmax : 0.f;
    if (__any(dlt > 0.f)) {
        const float alpha = ex2(-dlt);
#pragma unroll
        for (int mt = 0; mt < 4; ++mt) { O[mt][0] *= alpha; O[mt][1] *= alpha; O[mt][2] *= alpha; O[mt][3] *= alpha; }
        L[0] *= alpha; L[1] *= alpha; L[2] *= alpha; L[3] *= alpha; l *= alpha; m += dlt;
#pragma unroll
        for (int kt = 0; kt < 4; ++kt) { st[kt][0] -= dlt; st[kt][1] -= dlt; st[kt][2] -= dlt; st[kt][3] -= dlt; }
    }
#pragma unroll
    for (int kt = 0; kt < 4; ++kt)
#pragma unroll
        for (int r = 0; r < 4; ++r) st[kt][r] = ex2(st[kt][r]);
    union { bf16x8 v; unsigned u[4]; } ones;
    ones.u[0] = 0x3f803f80u; ones.u[1] = 0x3f803f80u; ones.u[2] = 0x3f803f80u; ones.u[3] = 0x3f803f80u;
#pragma unroll
    for (int kb = 0; kb < 2; ++kb) {
        union { bf16x8 v; unsigned u[4]; } pb;
        pb.u[0] = pack2(st[2 * kb][0], st[2 * kb][1]); pb.u[1] = pack2(st[2 * kb][2], st[2 * kb][3]);
        pb.u[2] = pack2(st[2 * kb + 1][0], st[2 * kb + 1][1]); pb.u[3] = pack2(st[2 * kb + 1][2], st[2 * kb + 1][3]);
        L = mfma16(ones.v, pb.v, L);
#pragma unroll
        for (int mt = 0; mt < 4; ++mt) O[mt] = mfma16(vf[kb * 4 + mt], pb.v, O[mt]);
    }
}
DEV void softmax_pv_tile(bool MASK, f32x4 (&st)[4], const bf16x8 (&vf)[8], int keybase, int tcol, int lowcol, bool colsel, float& m, float& l, f32x4& L, f32x4 (&O)[4], int q4) {
    float lmax = -1e30f;
    if (MASK) {
        const int hi = colsel ? tcol : -1;
#pragma unroll
        for (int kt = 0; kt < 4; ++kt)
#pragma unroll
            for (int r = 0; r < 4; ++r) {
                const int key = keybase + kt * 16 + 4 * q4 + r;
                const bool valid = (key <= hi) && (key > lowcol);
                const float sv = valid ? st[kt][r] : -1e30f;
                st[kt][r] = sv; lmax = fmaxf(lmax, sv);
            }
    } else {
        const float cs = colsel ? 0.f : -1e30f;
#pragma unroll
        for (int kt = 0; kt < 4; ++kt)
#pragma unroll
            for (int r = 0; r < 4; ++r) { const float sv = st[kt][r] + cs; st[kt][r] = sv; lmax = fmaxf(lmax, sv); }
    }
    lmax = colmax(lmax);
    const float mnew = fmaxf(m, lmax);
    const float alpha = ex2(m - mnew);
    float psum = 0.f;
#pragma unroll
    for (int kt = 0; kt < 4; ++kt)
#pragma unroll
        for (int r = 0; r < 4; ++r) {
            float pv = ex2(st[kt][r] - mnew);
            if (MASK) pv = (st[kt][r] > -1e29f) ? pv : 0.f;
            st[kt][r] = pv; psum += pv;
        }
    l = l * alpha + psum;
    if (__any(mnew > m)) {
#pragma unroll
        for (int mt = 0; mt < 4; ++mt) { O[mt][0] *= alpha; O[mt][1] *= alpha; O[mt][2] *= alpha; O[mt][3] *= alpha; }
        L[0] *= alpha; L[1] *= alpha; L[2] *= alpha; L[3] *= alpha;
    }
    m = mnew;
#pragma unroll
    for (int kb = 0; kb < 2; ++kb) {
        union { bf16x8 v; unsigned u[4]; } pb;
        pb.u[0] = pack2(st[2 * kb][0], st[2 * kb][1]); pb.u[1] = pack2(st[2 * kb][2], st[2 * kb][3]);
        pb.u[2] = pack2(st[2 * kb + 1][0], st[2 * kb + 1][1]); pb.u[3] = pack2(st[2 * kb + 1][2], st[2 * kb + 1][3]);
#pragma unroll
        for (int mt = 0; mt < 4; ++mt) O[mt] = mfma16(vf[kb * 4 + mt], pb.v, O[mt]);
    }
}
DEV unsigned pick4(unsigned a0, unsigned a1, unsigned a2, unsigned a3, int w) { return w == 0 ? a0 : (w == 1 ? a1 : (w == 2 ? a2 : a3)); }
template <int CTRL> DEV unsigned dpp_or(unsigned x) { return x | dppu<CTRL>(x); }
DEV unsigned row_or(unsigned x) { x = dpp_or<0xB1>(x); x = dpp_or<0x4E>(x); x = dpp_or<0x124>(x); x = dpp_or<0x128>(x); return x; }


DEV void nsa_branch_lds(unsigned char* lds, const u16* __restrict__ K0, const u16* __restrict__ VT0, unsigned bu0, unsigned bu1, unsigned bu2,
                        unsigned bu3, unsigned ua0, unsigned ua1, unsigned ua2, unsigned ua3, unsigned ub0, unsigned ub1, unsigned ub2, unsigned ub3,
                        const unsigned* cm, int tokl, const int (&tcol)[2], const int (&lowc)[2], const bf16x8 (&qf)[2][2], float (&m)[2],
                        float (&l)[2], f32x4 (&L)[2], f32x4 (&O)[2][4], int q4, int cidx, int cur, int lowmax) {
    const int tid = TID();
    int w = 0; unsigned bits = bu0;
    auto advance = [&]() -> int {
        while (bits == 0u && w < 3) { ++w; bits = pick4(bu0, bu1, bu2, bu3, w); }
        if (bits == 0u) return -1;
        const int jb = __builtin_ctz(bits); bits &= bits - 1u;
        return w * 32 + jb;
    };
    const int srow0 = tid >> 3, srow1 = srow0 + 32, sch = tid & 7;
    const int so0 = srow0 * 128 + ((sch ^ (srow0 & 7)) << 4), so1 = srow1 * 128 + ((sch ^ (srow1 & 7)) << 4);
    bf16x8 r0[4], r1[4];
#define NSA_GLOAD(R, BLK_) { R[0] = ld8(K0 + ((size_t)(BLK_) * 64 + srow0) * 64 + sch * 8); R[1] = ld8(K0 + ((size_t)(BLK_) * 64 + srow1) * 64 + sch * 8); \
        R[2] = ld8(VT0 + (size_t)srow0 * 8192 + (BLK_) * 64 + sch * 8); R[3] = ld8(VT0 + (size_t)srow1 * 8192 + (BLK_) * 64 + sch * 8); }
#define NSA_LWRITE(R, BUF_) { unsigned char* wb_ = lds + (BUF_) * 16384; *(bf16x8*)(wb_ + so0) = R[0]; *(bf16x8*)(wb_ + so1) = R[1]; \
        *(bf16x8*)(wb_ + 8192 + so0) = R[2]; *(bf16x8*)(wb_ + 8192 + so1) = R[3]; }
    auto compute = [&](int blk, int buf) {
        const int wq = blk >> 5, jb = blk & 31;
        const bool act0 = (pick4(ua0, ua1, ua2, ua3, wq) >> jb) & 1u, act1 = (pick4(ub0, ub1, ub2, ub3, wq) >> jb) & 1u;
        if (act0 || act1) {
            const unsigned char* kb_ = lds + buf * 16384;
            const bool need_mask = (blk == cur) || (blk * 64 <= lowmax);
            const bool cs0 = cm ? (((cm[tokl * 4 + wq] >> jb) & 1u) != 0u) : true;
            const bool cs1 = cm ? (((cm[(4 + tokl) * 4 + wq] >> jb) & 1u) != 0u) : true;
            const bool lazy = !need_mask && !__any((act0 && m[0] < -1e29f) || (act1 && m[1] < -1e29f));
            f32x4 st0[4], st1[4];
            {
                bf16x8 kf[8];
#pragma unroll
                for (int kt = 0; kt < 4; ++kt)
#pragma unroll
                    for (int s2 = 0; s2 < 2; ++s2) {
                        const int row = 16 * kt + cidx, ch = 4 * s2 + q4;
                        kf[2 * kt + s2] = *(const bf16x8*)(kb_ + row * 128 + ((ch ^ (row & 7)) << 4));
                    }
                if (act0) qk_tile(kf, qf[0][0], qf[0][1], lazy ? (cs0 ? -m[0] : -1e30f) : 0.f, st0);
                if (act1) qk_tile(kf, qf[1][0], qf[1][1], lazy ? (cs1 ? -m[1] : -1e30f) : 0.f, st1);
            }
            __builtin_amdgcn_sched_barrier(0);
            bf16x8 vf[8];
#pragma unroll
            for (int kb = 0; kb < 2; ++kb)
#pragma unroll
                for (int mt = 0; mt < 4; ++mt) {
                    const int row = 16 * mt + cidx, ch = 4 * kb + q4;
                    vf[kb * 4 + mt] = *(const bf16x8*)(kb_ + 8192 + row * 128 + ((ch ^ (row & 7)) << 4));
                }
            if (lazy) {
                if (act0) softmax_pv_lazy(st0, vf, m[0], l[0], L[0], O[0]);
                if (act1) softmax_pv_lazy(st1, vf, m[1], l[1], L[1], O[1]);
            } else {
                if (act0) softmax_pv_tile(need_mask, st0, vf, blk * 64, tcol[0], lowc[0], cs0, m[0], l[0], L[0], O[0], q4);
                if (act1) softmax_pv_tile(need_mask, st1, vf, blk * 64, tcol[1], lowc[1], cs1, m[1], l[1], L[1], O[1], q4);
            }
        }
    };
    int b0 = advance();
    if (b0 < 0) return;
    int b1 = advance();
    NSA_GLOAD(r0, b0);
    if (b1 >= 0) NSA_GLOAD(r1, b1);
    NSA_LWRITE(r0, 0);
    __syncthreads();
#pragma unroll 1
    while (b0 >= 0) {
        const int b2 = (b1 >= 0) ? advance() : -1;
        if (b2 >= 0) NSA_GLOAD(r0, b2);
        compute(b0, 0);
        if (b1 >= 0) NSA_LWRITE(r1, 1);
        __syncthreads();
        if (b1 < 0) break;
        const int b3 = (b2 >= 0) ? advance() : -1;
        if (b3 >= 0) NSA_GLOAD(r1, b3);
        compute(b1, 1);
        if (b2 >= 0) NSA_LWRITE(r0, 0);
        __syncthreads();
        b0 = b2; b1 = b3;
    }
#undef NSA_GLOAD
#undef NSA_LWRITE
}

DEV void nsa_block_task(const Params& p, int task, unsigned char* lds) {
    const int wave = TID() >> 6;
    float* wl = (float*)(lds + 32768) + wave * 2112;
    unsigned* bm = (unsigned*)(lds + 32768 + 4 * 8448);
    float* impA = wl; float* impB = wl + 1024; unsigned* selmask = (unsigned*)(wl + 1024 + 1056);
    unsigned char* ws = p.ws;
    const u16* Q = (const u16*)(ws + OFF_Q);
    const u16* KVb = (const u16*)(ws + OFF_KV);
    const u16 *KSEL = KVb + (size_t)2 * 4194304, *VSELT = KVb + (size_t)3 * 4194304, *KWIN = KVb + (size_t)4 * 4194304, *VWINT = KVb + (size_t)5 * 4194304;
    const u16* KC = (const u16*)(ws + OFF_KC); const u16* VCT = (const u16*)(ws + OFF_VCT);
    const float* GATE = (const float*)(ws + OFF_GATE);
    u16* mix = (u16*)(ws + OFF_MIX);
    const int lane = TID() & 63, q4 = lane >> 4, cidx = lane & 15;
    const int bg = task & 7, t0b = (255 - (task >> 3)) * 32, t0 = t0b + 8 * wave; const int b = bg >> 1, g = bg & 1;
    const int tokl = cidx >> 2, hr = cidx & 3; const int head = g * 4 + hr;
    const int cur = t0 >> 6;
    int tcol[2], rowc[2]; bf16x8 qf[2][2];
#pragma unroll
    for (int ti = 0; ti < 2; ++ti) {
        tcol[ti] = t0 + 4 * ti + tokl; rowc[ti] = b * 8192 + tcol[ti];
        qf[ti][0] = ld8(Q + (size_t)rowc[ti] * 512 + head * 64 + 8 * q4); qf[ti][1] = ld8(Q + (size_t)rowc[ti] * 512 + head * 64 + 32 + 8 * q4);
    }
    f32x4 Oc[2][4];
    {
        int cnt_col[2];
#pragma unroll
        for (int ti = 0; ti < 2; ++ti) cnt_col[ti] = tcol[ti] >= 31 ? ((tcol[ti] - 31) >> 4) + 1 : 0;
        const int tmax = t0 + 7; const int cmax = tmax >= 31 ? ((tmax - 31) >> 4) + 1 : 0;
        const int ntile = (cmax + 15) >> 4;
        const u16* kcb = KC + (size_t)bg * 512 * 64;
        float ml[2] = {-1e30f, -1e30f}, ll[2] = {0.f, 0.f};
#pragma unroll 1
        for (int kt = 0; kt < ntile; ++kt) {
            const u16* kp = kcb + (kt * 16 + cidx) * 64 + 8 * q4;
            const bf16x8 k0 = ld8(kp), k1 = ld8(kp + 32);
#pragma unroll
            for (int ti = 0; ti < 2; ++ti) {
                f32x4 st = mfma16(k0, qf[ti][0], (f32x4){0.f, 0.f, 0.f, 0.f});
                st = mfma16(k1, qf[ti][1], st);
                float sv[4]; float tm = -1e30f;
#pragma unroll
                for (int r = 0; r < 4; ++r) { const int n = kt * 16 + 4 * q4 + r; sv[r] = (n < cnt_col[ti]) ? st[r] : -1e30f; tm = fmaxf(tm, sv[r]); }
                const float mn = fmaxf(ml[ti], tm);
                float ps = 0.f;
#pragma unroll
                for (int r = 0; r < 4; ++r) ps += (sv[r] > -1e29f) ? ex2(sv[r] - mn) : 0.f;
                ll[ti] = ll[ti] * ex2(ml[ti] - mn) + ps; ml[ti] = mn;
            }
        }
        float mfin[2], inv[2];
#pragma unroll
        for (int ti = 0; ti < 2; ++ti) {
            mfin[ti] = colmax(ml[ti]);
            const float lsum = colsum(ll[ti] * ex2(ml[ti] - mfin[ti]));
            inv[ti] = (cnt_col[ti] > 0) ? 1.f / lsum : 0.f;
        }
#pragma unroll
        for (int ti = 0; ti < 2; ++ti)
#pragma unroll
            for (int mt = 0; mt < 4; ++mt) Oc[ti][mt] = (f32x4){0.f, 0.f, 0.f, 0.f};
        const int npair = (ntile + 1) >> 1;
#pragma unroll 1
        for (int kp2 = 0; kp2 < npair; ++kp2) {
            const int n0 = kp2 * 32;
            const u16* kp = kcb + (n0 + cidx) * 64 + 8 * q4;
            const bf16x8 ka0 = ld8(kp), ka1 = ld8(kp + 32), kb0 = ld8(kp + 1024), kb1 = ld8(kp + 1024 + 32);
            bf16x8 vf[4];
#pragma unroll
            for (int mt = 0; mt < 4; ++mt) vf[mt] = ld8(VCT + ((size_t)bg * 64 + 16 * mt + cidx) * 512 + n0 + 8 * q4);
#pragma unroll
            for (int ti = 0; ti < 2; ++ti) {
                float pa[4], pb_[4];
                f32x4 st = mfma16(ka0, qf[ti][0], (f32x4){0.f, 0.f, 0.f, 0.f});
                st = mfma16(ka1, qf[ti][1], st);
                f32x4 su = mfma16(kb0, qf[ti][0], (f32x4){0.f, 0.f, 0.f, 0.f});
                su = mfma16(kb1, qf[ti][1], su);
#pragma unroll
                for (int r = 0; r < 4; ++r) {
                    const int n = n0 + 4 * q4 + r;
                    pa[r] = (n < cnt_col[ti]) ? ex2(st[r] - mfin[ti]) * inv[ti] : 0.f;
                    pb_[r] = (n + 16 < cnt_col[ti]) ? ex2(su[r] - mfin[ti]) * inv[ti] : 0.f;
                }
                const float owna = quadsum(pa[0] + pa[1] + pa[2] + pa[3]), tha = quadsum(pa[3]);
                const float ownb = quadsum(pb_[0] + pb_[1] + pb_[2] + pb_[3]), thb = quadsum(pb_[3]);
                if (hr == 0) {
                    const int tk = 4 * ti + tokl;
                    const int sa = (n0 >> 2) + q4, sb2 = ((n0 + 16) >> 2) + q4;
                    impA[tk * 128 + sa] = owna; impB[tk * 132 + sa + 1] = tha;
                    impA[tk * 128 + sb2] = ownb; impB[tk * 132 + sb2 + 1] = thb;
                }
                union { bf16x8 v; unsigned u[4]; } pk;
                pk.u[0] = pack2(pa[0], pa[1]); pk.u[1] = pack2(pa[2], pa[3]); pk.u[2] = pack2(pb_[0], pb_[1]); pk.u[3] = pack2(pb_[2], pb_[3]);
#pragma unroll
                for (int mt = 0; mt < 4; ++mt) Oc[ti][mt] = mfma16(vf[mt], pk.v, Oc[ti][mt]);
            }
        }
#pragma unroll
        for (int ti = 0; ti < 2; ++ti) {
            const float gc = GATE[(size_t)rowc[ti] * 24 + head];
#pragma unroll
            for (int mt = 0; mt < 4; ++mt)
#pragma unroll
                for (int r = 0; r < 4; ++r) Oc[ti][mt][r] *= gc;
        }
    }
    lds_fence();
#pragma unroll 1
    for (int rd = 0; rd < 2; ++rd) {
        const int tk = 4 * rd + q4;
        unsigned m0 = 0u, m1 = 0u, m2 = 0u, m3 = 0u;
        if (cur < 16) { m0 = (2u << cur) - 1u; }
        else {
            unsigned key[8];
#pragma unroll
            for (int i = 0; i < 8; ++i) {
                const int sblk = cidx + 16 * i;
                const bool cand = (sblk >= 1) && (sblk <= cur - 2);
                const float v = impA[tk * 128 + sblk] + impB[tk * 132 + sblk];
                key[i] = cand ? ((__float_as_uint(v) & ~0x7Fu) | (unsigned)(127 - sblk)) : 0u;
            }
            int mysel = (cidx == 0) ? 0 : (cidx == 1 ? cur - 1 : (cidx == 2 ? cur : -1));
#pragma unroll 1
            for (int it = 0; it < 13; ++it) {
                unsigned mx = key[0];
#pragma unroll
                for (int i = 1; i < 8; ++i) mx = max(mx, key[i]);
                mx = max(mx, dppu<0xB1>(mx)); mx = max(mx, dppu<0x4E>(mx)); mx = max(mx, dppu<0x124>(mx)); mx = max(mx, dppu<0x128>(mx));
                const int sblk = 127 - (int)(mx & 127u);
#pragma unroll
                for (int i = 0; i < 8; ++i) key[i] = (key[i] == mx) ? 0u : key[i];
                if (cidx == it + 3) mysel = sblk;
            }
            const unsigned bit = 1u << (mysel & 31); const int wsel = mysel >> 5;
            m0 = row_or(wsel == 0 ? bit : 0u); m1 = row_or(wsel == 1 ? bit : 0u); m2 = row_or(wsel == 2 ? bit : 0u); m3 = row_or(wsel == 3 ? bit : 0u);
        }
        if (cidx < 4) selmask[tk * 4 + cidx] = (cidx == 0) ? m0 : (cidx == 1 ? m1 : (cidx == 2 ? m2 : m3));
    }
    lds_fence();
    f32x4* accl = (f32x4*)wl;
#pragma unroll
    for (int ti = 0; ti < 2; ++ti)
#pragma unroll
        for (int mt = 0; mt < 4; ++mt) accl[(ti * 4 + mt) * 64 + lane] = Oc[ti][mt];
    {
        float m[2] = {-1e30f, -1e30f}, l[2] = {0.f, 0.f}; f32x4 Os[2][4]; f32x4 Ls[2] = {(f32x4){0.f, 0.f, 0.f, 0.f}, (f32x4){0.f, 0.f, 0.f, 0.f}};
#pragma unroll
        for (int ti = 0; ti < 2; ++ti)
#pragma unroll
            for (int mt = 0; mt < 4; ++mt) Os[ti][mt] = (f32x4){0.f, 0.f, 0.f, 0.f};
        {
            unsigned ua[4], ub[4], bu[4];
#pragma unroll
            for (int w = 0; w < 4; ++w) {
                ua[w] = __builtin_amdgcn_readfirstlane(row_or(selmask[tokl * 4 + w]));
                ub[w] = __builtin_amdgcn_readfirstlane(row_or(selmask[(4 + tokl) * 4 + w]));
            }
            if (lane < 4) bm[wave * 4 + lane] = (lane == 0) ? (ua[0] | ub[0]) : (lane == 1 ? (ua[1] | ub[1]) : (lane == 2 ? (ua[2] | ub[2]) : (ua[3] | ub[3])));
            __syncthreads();
#pragma unroll
            for (int w = 0; w < 4; ++w) bu[w] = __builtin_amdgcn_readfirstlane(bm[w] | bm[4 + w] | bm[8 + w] | bm[12 + w]);
            const int lowc[2] = {-1, -1};
            nsa_branch_lds(lds, KSEL + (size_t)bg * 8192 * 64, VSELT + (size_t)bg * 64 * 8192, bu[0], bu[1], bu[2], bu[3], ua[0], ua[1], ua[2], ua[3], ub[0],
                           ub[1], ub[2], ub[3], selmask, tokl, tcol, lowc, qf, m, l, Ls, Os, q4, cidx, cur, -1);
        }
#pragma unroll
        for (int ti = 0; ti < 2; ++ti) {
            const float sc = GATE[(size_t)rowc[ti] * 24 + 8 + head] / (colsum(l[ti]) + Ls[ti][0]);
#pragma unroll
            for (int mt = 0; mt < 4; ++mt)
#pragma unroll
                for (int r = 0; r < 4; ++r) Os[ti][mt][r] *= sc;
        }
        lds_fence();
#pragma unroll
        for (int ti = 0; ti < 2; ++ti)
#pragma unroll
            for (int mt = 0; mt < 4; ++mt) { f32x4 a = accl[(ti * 4 + mt) * 64 + lane]; a += Os[ti][mt]; accl[(ti * 4 + mt) * 64 + lane] = a; }
    }
    {
        float m[2] = {-1e30f, -1e30f}, l[2] = {0.f, 0.f}; f32x4 Ow[2][4]; f32x4 Ls[2] = {(f32x4){0.f, 0.f, 0.f, 0.f}, (f32x4){0.f, 0.f, 0.f, 0.f}};
#pragma unroll
        for (int ti = 0; ti < 2; ++ti)
#pragma unroll
            for (int mt = 0; mt < 4; ++mt) Ow[ti][mt] = (f32x4){0.f, 0.f, 0.f, 0.f};
        int wb0 = (t0 - 511) >> 6; if (wb0 < 0) wb0 = 0;
        int wbb = (t0b - 511) >> 6; if (wbb < 0) wbb = 0;
        {
            unsigned uw[4], bu[4];
#pragma unroll
            for (int w = 0; w < 4; ++w) {
                const int hi = cur - 32 * w;
                unsigned mk = 0u, mkb = 0u;
                if (hi >= 0) {
                    const unsigned upper = (hi >= 31) ? 0xffffffffu : ((2u << hi) - 1u);
                    const int lo = wb0 - 32 * w, lob = wbb - 32 * w;
                    if (lo <= 31) mk = upper & ~((lo <= 0) ? 0u : ((1u << lo) - 1u));
                    if (lob <= 31) mkb = upper & ~((lob <= 0) ? 0u : ((1u << lob) - 1u));
                }
                uw[w] = mk; bu[w] = mkb;
            }
            const int lowc[2] = {tcol[0] - 512, tcol[1] - 512};
            nsa_branch_lds(lds, KWIN + (size_t)bg * 8192 * 64, VWINT + (size_t)bg * 64 * 8192, bu[0], bu[1], bu[2], bu[3], uw[0], uw[1], uw[2], uw[3], uw[0],
                           uw[1], uw[2], uw[3], nullptr, tokl, tcol, lowc, qf, m, l, Ls, Ow, q4, cidx, cur, t0 + 7 - 512);
        }
#pragma unroll
        for (int ti = 0; ti < 2; ++ti) {
            const float sc = GATE[(size_t)rowc[ti] * 24 + 16 + head] / (colsum(l[ti]) + Ls[ti][0]);
#pragma unroll
            for (int mt = 0; mt < 4; ++mt)
#pragma unroll
                for (int r = 0; r < 4; ++r) Ow[ti][mt][r] *= sc;
        }
        lds_fence();
#pragma unroll
        for (int ti = 0; ti < 2; ++ti)
#pragma unroll
            for (int mt = 0; mt < 4; ++mt) {
                const f32x4 a = accl[(ti * 4 + mt) * 64 + lane];
                const f32x4 o = Ow[ti][mt];
                u32x2 wv; wv[0] = pack2(a[0] + o[0], a[1] + o[1]); wv[1] = pack2(a[2] + o[2], a[3] + o[3]);
                *(u32x2*)(mix + (size_t)rowc[ti] * 1024 + 512 + head * 64 + 16 * mt + 4 * q4) = wv;
            }
    }


    __syncthreads();
}

template <int N> DEV void ltmask(const float (&v)[N], float x, unsigned (&mk)[N / 32]) {
#pragma unroll
    for (int w = 0; w < N / 32; ++w) {
        unsigned a0 = 0u, a1 = 0u, a2 = 0u, a3 = 0u;
#pragma unroll
        for (int i = 0; i < 8; ++i) {
            a0 = __builtin_amdgcn_alignbit(a0, __float_as_uint(v[w * 32 + i] - x), 31);
            a1 = __builtin_amdgcn_alignbit(a1, __float_as_uint(v[w * 32 + 8 + i] - x), 31);
            a2 = __builtin_amdgcn_alignbit(a2, __float_as_uint(v[w * 32 + 16 + i] - x), 31);
            a3 = __builtin_amdgcn_alignbit(a3, __float_as_uint(v[w * 32 + 24 + i] - x), 31);
        }
        mk[w] = (a0 << 24) | (a1 << 16) | (a2 << 8) | a3;
    }
}
template <int N> DEV int count_ge(const float (&v)[N], float x) {
    unsigned mk[N / 32]; ltmask<N>(v, x, mk);
    int lt = 0;
#pragma unroll
    for (int w = 0; w < N / 32; ++w) lt += __popc(mk[w]);
    return colsumi(N - lt);
}
template <int N> DEV void refine16(const float (&v)[N], float lo, int clo, float hi, int chi, float& lo_o, float& hi_o) {
    bool done = false;
    if (clo == 16) { hi = lo; done = true; }
#pragma unroll 1
    for (int it = 0; it < 200; ++it) {
        if (__all(done)) break;
        float f = 0.5f;
        if (!(it & 1)) { f = ((float)clo - 15.5f) / (float)(clo - chi); f = fminf(fmaxf(f, 0.04f), 0.96f); }
        const float mid = lo + (hi - lo) * f;
        const bool stuck = !(mid > lo && mid < hi);
        const int c = count_ge<N>(v, mid);
        if (!done) {
            if (stuck) { if (f != 0.5f) {   } else done = true; }
            else if (c == 16) { lo = mid; hi = mid; done = true; }
            else if (c > 16) { lo = mid; clo = c; }
            else { hi = mid; chi = c; }
        }
    }
    lo_o = lo; hi_o = hi;
}
template <int N> DEV void select16(const float (&v)[N], float& lo_o, float& hi_o) {
    float mx = v[0], sm = v[0];
#pragma unroll
    for (int i = 1; i < N; ++i) { mx = fmaxf(mx, v[i]); sm += v[i]; }
    mx = colmax(mx); sm = colsum(sm);
    const float hi = mx + fabsf(mx) * 1e-6f + 1e-30f;
    float lo = sm * (1.f / (4.f * N));
    int clo = count_ge<N>(v, lo);
    if (__any(clo < 16)) {
        float mn = v[0];
#pragma unroll
        for (int i = 1; i < N; ++i) mn = fminf(mn, v[i]);
        mn = -colmax(-mn);
        if (clo < 16) { lo = mn; clo = 4 * N; }
    }
    refine16<N>(v, lo, clo, hi, 0, lo_o, hi_o);
}
DEV void col_offsets(int cntA, int cntT, int q4, int cidx, int& offA, int& offT) {
    const int g0 = __shfl(cntA, cidx), g1 = __shfl(cntA, cidx + 16), g2 = __shfl(cntA, cidx + 32), g3 = __shfl(cntA, cidx + 48);
    const int e0 = __shfl(cntT, cidx), e1 = __shfl(cntT, cidx + 16), e2 = __shfl(cntT, cidx + 32);
    offA = (q4 > 0 ? g0 : 0) + (q4 > 1 ? g1 : 0) + (q4 > 2 ? g2 : 0);
    offT = g0 + g1 + g2 + g3 + (q4 > 0 ? e0 : 0) + (q4 > 1 ? e1 : 0) + (q4 > 2 ? e2 : 0);
}

DEV void peer_topk_task2(const Params& p, int l, int task, float* wl) {
    unsigned char* ws = p.ws;
    const u16* QP = (const u16*)(ws + OFF_QP);
    const u16* K12 = (const u16*)(ws + OFF_K12) + (size_t)l * 2 * 16384;
    const int lane = TID() & 63, q4 = lane >> 4, cidx = lane & 15;
    const int tq = task * 2 + (cidx >> 3), hh = cidx & 7;
    float* scl = wl;
    float* lst = wl + 2048;
    float* vv[2] = {lst, lst + 512}; int* ii[2] = {(int*)(lst + 256), (int*)(lst + 768)};
    float* fs = lst + 1024; int* fi = (int*)(lst + 1280);
#pragma unroll 1
    for (int hf = 0; hf < 2; ++hf) {
        bf16x8 qf[4];
#pragma unroll
        for (int s2 = 0; s2 < 4; ++s2) qf[s2] = ld8(QP + (size_t)tq * 2048 + hh * 256 + hf * 128 + 32 * s2 + 8 * q4);
        float sc[32];
        const u16* kb = K12 + hf * 16384;
#pragma unroll
        for (int kt = 0; kt < 8; ++kt) {
            f32x4 st = (f32x4){0.f, 0.f, 0.f, 0.f};
#pragma unroll
            for (int s2 = 0; s2 < 4; ++s2) st = mfma16(ld8(kb + (kt * 16 + cidx) * 128 + 32 * s2 + 8 * q4), qf[s2], st);
#pragma unroll
            for (int r = 0; r < 4; ++r) sc[kt * 4 + r] = st[r];
            *(f32x4*)(scl + cidx * 128 + 16 * kt + 4 * q4) = st;
        }
        float lo, hi; select16<32>(sc, lo, hi);
        unsigned mh[1], ml_[1];
        ltmask<32>(sc, hi, mh);
        if (__all(lo == hi)) ml_[0] = mh[0]; else ltmask<32>(sc, lo, ml_);
        unsigned mA = ~mh[0], mT = ~ml_[0] & mh[0];
        int offA, offT; col_offsets(__popc(mA), __popc(mT), q4, cidx, offA, offT);
        float* vo = hf ? vv[1] : vv[0]; int* io = hf ? ii[1] : ii[0];
        lds_fence();
        while (__any(mA != 0u)) {
            if (mA) {
                const int i = __clz(mA); mA &= ~(0x80000000u >> i);
                const int n = 16 * (i >> 2) + 4 * q4 + (i & 3);
                vo[cidx * 16 + offA] = scl[cidx * 128 + n]; io[cidx * 16 + offA] = n; ++offA;
            }
        }
        while (__any(mT != 0u)) {
            if (mT) {
                const int i = __clz(mT); mT &= ~(0x80000000u >> i);
                const int n = 16 * (i >> 2) + 4 * q4 + (i & 3);
                if (offT < 16) { vo[cidx * 16 + offT] = scl[cidx * 128 + n]; io[cidx * 16 + offT] = n; }
                ++offT;
            }
        }
        lds_fence();
    }
    {
        float cand[64];
        float v2r[16];
#pragma unroll
        for (int j = 0; j < 16; ++j) v2r[j] = vv[1][cidx * 16 + j];
#pragma unroll
        for (int a = 0; a < 4; ++a) {
            const float v1a = vv[0][cidx * 16 + 4 * q4 + a];
#pragma unroll
            for (int j = 0; j < 16; ++j) cand[a * 16 + j] = v1a + v2r[j];
        }
        float lo, hi;
        {
            float v2mx = v2r[0], v2mn = v2r[0];
#pragma unroll
            for (int j = 1; j < 16; ++j) { v2mx = fmaxf(v2mx, v2r[j]); v2mn = fminf(v2mn, v2r[j]); }
            float v1mx = fmaxf(fmaxf(vv[0][cidx * 16 + 4 * q4], vv[0][cidx * 16 + 4 * q4 + 1]), fmaxf(vv[0][cidx * 16 + 4 * q4 + 2], vv[0][cidx * 16 + 4 * q4 + 3]));
            float v1mn = fminf(fminf(vv[0][cidx * 16 + 4 * q4], vv[0][cidx * 16 + 4 * q4 + 1]), fminf(vv[0][cidx * 16 + 4 * q4 + 2], vv[0][cidx * 16 + 4 * q4 + 3]));
            v1mx = colmax(v1mx); v1mn = -colmax(-v1mn);
            const float smax = v1mx + v2mx;
            const float hi0 = smax + fabsf(smax) * 1e-6f + 1e-30f;
            const float lo0 = fmaxf(v1mn + v2mx, v1mx + v2mn);
            const int c0 = count_ge<64>(cand, lo0);
            refine16<64>(cand, lo0, c0, hi0, 0, lo, hi);
        }
        unsigned mh[2], ml_[2];
        ltmask<64>(cand, hi, mh);
        if (__all(lo == hi)) { ml_[0] = mh[0]; ml_[1] = mh[1]; } else ltmask<64>(cand, lo, ml_);
        unsigned mA0 = ~mh[0], mA1 = ~mh[1], mT0 = ~ml_[0] & mh[0], mT1 = ~ml_[1] & mh[1];
        int offA, offT; col_offsets(__popc(mA0) + __popc(mA1), __popc(mT0) + __popc(mT1), q4, cidx, offA, offT);
#pragma unroll
        for (int w = 0; w < 2; ++w) {
            unsigned mA = w ? mA1 : mA0;
            while (__any(mA != 0u)) {
                if (mA) {
                    const int i = __clz(mA); mA &= ~(0x80000000u >> i);
                    const int it = w * 32 + i; const int ci = (4 * q4 + (it >> 4)) * 16 + (it & 15);
                    fs[cidx * 16 + offA] = vv[0][cidx * 16 + (ci >> 4)] + vv[1][cidx * 16 + (ci & 15)]; fi[cidx * 16 + offA] = ci; ++offA;
                }
            }
        }
#pragma unroll
        for (int w = 0; w < 2; ++w) {
            unsigned mT = w ? mT1 : mT0;
            while (__any(mT != 0u)) {
                if (mT) {
                    const int i = __clz(mT); mT &= ~(0x80000000u >> i);
                    const int it = w * 32 + i; const int ci = (4 * q4 + (it >> 4)) * 16 + (it & 15);
                    if (offT < 16) { fs[cidx * 16 + offT] = vv[0][cidx * 16 + (ci >> 4)] + vv[1][cidx * 16 + (ci & 15)]; fi[cidx * 16 + offT] = ci; }
                    ++offT;
                }
            }
        }
    }
    lds_fence();
    {
        float s4[4]; int c4[4];
#pragma unroll
        for (int k = 0; k < 4; ++k) { s4[k] = fs[cidx * 16 + 4 * q4 + k]; c4[k] = fi[cidx * 16 + 4 * q4 + k]; }
        float mx = fmaxf(fmaxf(s4[0], s4[1]), fmaxf(s4[2], s4[3]));
        mx = colmax(mx);
        float e4[4]; float sm = 0.f;
#pragma unroll
        for (int k = 0; k < 4; ++k) { e4[k] = __expf(s4[k] - mx); sm += e4[k]; }
        sm = colsum(sm);
        const float inv = 1.f / sm;
        int4 eo; float4 go;
        eo.x = ii[0][cidx * 16 + (c4[0] >> 4)] * 128 + ii[1][cidx * 16 + (c4[0] & 15)];
        eo.y = ii[0][cidx * 16 + (c4[1] >> 4)] * 128 + ii[1][cidx * 16 + (c4[1] & 15)];
        eo.z = ii[0][cidx * 16 + (c4[2] >> 4)] * 128 + ii[1][cidx * 16 + (c4[2] & 15)];
        eo.w = ii[0][cidx * 16 + (c4[3] >> 4)] * 128 + ii[1][cidx * 16 + (c4[3] & 15)];
        go.x = e4[0] * inv; go.y = e4[1] * inv; go.z = e4[2] * inv; go.w = e4[3] * inv;
        int* eol = (int*)(wl + 3584); float* gol = wl + 3584 + 256;
        *(int4*)(eol + cidx * 16 + 4 * q4) = eo; *(float4*)(gol + cidx * 16 + 4 * q4) = go;
    }
    lds_fence();
}

DEV float gelu_exact(float x) { return 0.5f * x * (1.f + erff(x * 0.70710678118654752f)); }
DEV void unpack8(const bf16x8 v, float* f) {
    union { bf16x8 v; unsigned u[4]; } c; c.v = v;
#pragma unroll
    for (int i = 0; i < 4; ++i) { f[2 * i] = bflo(c.u[i]); f[2 * i + 1] = bfhi(c.u[i]); }
}
DEV void peer_experts_token(const Params& p, int l, int tok, const int* el_src, const float* w_src) {
    unsigned char* ws = p.ws;
    const u16* H = (const u16*)(ws + OFF_H);
    u16* Hw = (u16*)(ws + OFF_H);
    const unsigned char* U8 = ws + OFF_U8;
    const unsigned char* V8 = ws + OFF_U8 + 16 * MiB;
    const float* SU = (const float*)(ws + OFF_UVS);
    const float* SV = (const float*)(ws + OFF_UVS) + 16384;
    const float* mod = (const float*)(ws + OFF_MOD);
    const float* g2 = mod + l * 4 * 6144 + 5 * 1024;
    const int lane = TID() & 63;
    {
        const int b = tok >> 13;
        float acc[16];
#pragma unroll
        for (int i = 0; i < 16; ++i) acc[i] = 0.f;
#if EN_PEER
        unsigned hp[4]; float shq; int corr0;
        {
            float hx[16];
            unpack8(ld8(H + (size_t)tok * 1024 + 16 * lane), hx);
            unpack8(ld8(H + (size_t)tok * 1024 + 16 * lane + 8), hx + 8);
            float amax = 0.f;
#pragma unroll
            for (int i = 0; i < 16; ++i) amax = fmaxf(amax, fabsf(hx[i]));
            amax = wave_max(amax);
            shq = amax > 0.f ? amax * (1.f / 127.f) : 1.f;
            const float inv = 1.f / shq;
            int hsum = 0;
#pragma unroll
            for (int i = 0; i < 4; ++i) {
                const int a = __float2int_rn(hx[4 * i] * inv) + 128, b2 = __float2int_rn(hx[4 * i + 1] * inv) + 128, c = __float2int_rn(hx[4 * i + 2] * inv) + 128,
                          d = __float2int_rn(hx[4 * i + 3] * inv) + 128;
                hp[i] = (unsigned)a | ((unsigned)b2 << 8) | ((unsigned)c << 16) | ((unsigned)d << 24);
                hsum += a + b2 + c + d;
            }
            hsum = wave_sum_i(hsum);
            corr0 = 128 * 128 * 1024 - 128 * hsum;
        }
        const int* RSU = (const int*)(ws + OFF_UVS) + 2 * 16384;
        float corr = 0.f;
        u32x4 uqA[8], vqA[8], uqB[8], vqB[8];
#define PEER_LOAD(UQ, VQ, G_) { const int el_ = el_src[((G_) >> 1) * 16 + (lane & 15)]; const int k0_ = ((G_) & 1) * 8; _Pragma("unroll") for (int k = 0; k < 8; ++k) { \
            const int e = __builtin_amdgcn_readlane(el_, k0_ + k); UQ[k] = *(const u32x4*)(U8 + (size_t)e * 1024 + 16 * lane); VQ[k] = *(const u32x4*)(V8 + (size_t)e * 1024 + 16 * lane); } }
#define PEER_EVAL(UQ, VQ, G_) { const int hh_ = (G_) >> 1, k0_ = ((G_) & 1) * 8; const int el = el_src[hh_ * 16 + (lane & 15)]; const float wgt = w_src[hh_ * 16 + (lane & 15)]; \
            const float sul = SU[el] * shq, wsl = wgt * SV[el]; const int rsl = corr0 - 128 * RSU[el]; \
            int dpart[8]; _Pragma("unroll") for (int k = 0; k < 8; ++k) { unsigned di = 0u; _Pragma("unroll") for (int i = 0; i < 4; ++i) di = __builtin_amdgcn_udot4(UQ[k][i], hp[i], di, false); dpart[k] = (int)di; } \
            const int dsum = reduce8_i(dpart); const int srcl = k0_ + (lane >> 3); \
            const float sul_e = __shfl(sul, srcl), wsl_e = __shfl(wsl, srcl); const int rsl_e = __shfl(rsl, srcl); \
            const float actl = gelu_exact((float)(dsum + rsl_e) * sul_e) * wsl_e; \
            _Pragma("unroll") for (int k = 0; k < 8; ++k) { const float act = __int_as_float(__builtin_amdgcn_readlane(__float_as_int(actl), 8 * k)); corr += act * 128.f; \
                _Pragma("unroll") for (int i = 0; i < 4; ++i) { const unsigned w = VQ[k][i]; \
                    acc[4 * i] += act * (float)(w & 0xffu); acc[4 * i + 1] += act * (float)((w >> 8) & 0xffu); acc[4 * i + 2] += act * (float)((w >> 16) & 0xffu); acc[4 * i + 3] += act * (float)(w >> 24); } } }
        PEER_LOAD(uqA, vqA, 0);
#pragma unroll 1
        for (int g = 0; g < 16; g += 2) {
            PEER_LOAD(uqB, vqB, g + 1);
            PEER_EVAL(uqA, vqA, g);
            if (g + 2 < 16) PEER_LOAD(uqA, vqA, g + 2);
            PEER_EVAL(uqB, vqB, g + 1);
        }
#undef PEER_LOAD
#undef PEER_EVAL
#pragma unroll
        for (int i = 0; i < 16; ++i) acc[i] -= corr;
#endif
        const int k = 16 * lane;
        float xn[16]; float ss = 0.f;
#pragma unroll
        for (int i = 0; i < 4; ++i) {
            const float4 x0 = *(const float4*)(p.out + (size_t)tok * 1024 + k + 4 * i);
            const float4 ga = *(const float4*)(g2 + b * 6144 + k + 4 * i);
            xn[4 * i] = x0.x + ga.x * acc[4 * i]; xn[4 * i + 1] = x0.y + ga.y * acc[4 * i + 1];
            xn[4 * i + 2] = x0.z + ga.z * acc[4 * i + 2]; xn[4 * i + 3] = x0.w + ga.w * acc[4 * i + 3];
        }
#pragma unroll
        for (int i = 0; i < 16; ++i) ss += xn[i] * xn[i];
        ss = wave_sum(ss);
        const float rs = rsqrtf(ss * (1.f / 1024.f) + 1e-6f);
        if (l == 0) {
            const float* n1g = p.in[I_N1G] + 1024; const float* sh = mod + 4 * 6144 + b * 6144; const float* sc = sh + 1024;
            float hv[16];
#pragma unroll
            for (int i = 0; i < 4; ++i) {
                *(float4*)(p.out + (size_t)tok * 1024 + k + 4 * i) = (float4){xn[4 * i], xn[4 * i + 1], xn[4 * i + 2], xn[4 * i + 3]};
                const float4 gg = *(const float4*)(n1g + k + 4 * i), s1 = *(const float4*)(sc + k + 4 * i), s0 = *(const float4*)(sh + k + 4 * i);
                hv[4 * i] = xn[4 * i] * rs * gg.x * (1.f + s1.x) + s0.x; hv[4 * i + 1] = xn[4 * i + 1] * rs * gg.y * (1.f + s1.y) + s0.y;
                hv[4 * i + 2] = xn[4 * i + 2] * rs * gg.z * (1.f + s1.z) + s0.z; hv[4 * i + 3] = xn[4 * i + 3] * rs * gg.w * (1.f + s1.w) + s0.w;
            }
            u32x4 w0, w1;
#pragma unroll
            for (int i = 0; i < 4; ++i) { w0[i] = pack2(hv[2 * i], hv[2 * i + 1]); w1[i] = pack2(hv[8 + 2 * i], hv[8 + 2 * i + 1]); }
            *(u32x4*)(Hw + (size_t)tok * 1024 + k) = w0; *(u32x4*)(Hw + (size_t)tok * 1024 + k + 8) = w1;
        } else {
            const float* fg = p.in[I_FG];
#pragma unroll
            for (int i = 0; i < 4; ++i) {
                const float4 gg = *(const float4*)(fg + k + 4 * i);
                *(float4*)(p.out + (size_t)tok * 1024 + k + 4 * i) = (float4){xn[4 * i] * rs * gg.x, xn[4 * i + 1] * rs * gg.y, xn[4 * i + 2] * rs * gg.z, xn[4 * i + 3] * rs * gg.w};
            }
        }
    }
}

constexpr int NPH = 20;

__global__ void __launch_bounds__(256, 2) mega(Params p) {
    __shared__ __attribute__((aligned(16))) unsigned char lds[81920 - 128];
    __shared__ int misc[8];
    int* qslot = misc;
    cg::grid_group grid = cg::this_grid();
    if (threadIdx.x < 8) misc[threadIdx.x] = 0;
    __syncthreads();
    XcdBarrier xbar = xcd_barrier_post((unsigned*)(p.ws + OFF_BAR), (volatile unsigned*)(misc + 4));
    unsigned char* ws = p.ws;
    const float* mod = (const float*)(ws + OFF_MOD);
    unsigned* ctl = (unsigned*)(ws + OFF_CTL);
    const int G = gridDim.x, bx = BID();
    for (int ph = p.ph_lo; ph < p.ph_hi; ++ph) {
        if (ph >= 2 && (ph - 2) % 9 == 8) continue;
        if (ph == 0) {
            phase_prep(p, lds);
        } else if (ph == 1) {
            phase_norm(p.in[I_X], p.in[I_N1G], mod + 0 * 1024, mod + 1 * 1024, (u16*)(ws + OFF_H));
        } else {
            const int l = (ph - 2) / 9, sp = (ph - 2) % 9;
            const float* modl = mod + l * 4 * 6144;
            if (sp == 0) {
                EpiInProj e{(u16*)(ws + OFF_PCONV), (u16*)(ws + OFF_PRWKV), (u16*)(ws + OFF_Q), (u16*)(ws + OFF_KV), (float*)(ws + OFF_GATE)};
                gemm_phase((const u16*)(ws + OFF_H), 1024, (const u16*)(ws + OFF_WIN) + (size_t)l * NINP * 1024, 1024, 256, 8, 1024, e, lds, bx, G, 0, 4);
            } else if (sp == 1) {
#if EN_RWKV
                for (;;) { const int t = block_next(ctl + QW(l, Q_RWP), qslot); if (t >= NTOK / 16) break; rwkv_prep_tile2(p, l, t, lds); }
#endif
            } else if (sp == 2) {
#if EN_RWKV
                if (bx < 64) { __builtin_amdgcn_s_setprio(3); rwkv_scan(p, bx, lds); __builtin_amdgcn_s_setprio(0); }
#endif
                unsigned* cdone = ctl + QW(l, 5);
                unsigned* gdone = ctl + QW(l, 6);
                if (bx >= 64) {
                    EpiInProj e{(u16*)(ws + OFF_PCONV), (u16*)(ws + OFF_PRWKV), (u16*)(ws + OFF_Q), (u16*)(ws + OFF_KV), (float*)(ws + OFF_GATE)};
                    gemm_phase((const u16*)(ws + OFF_H), 1024, (const u16*)(ws + OFF_WIN) + (size_t)l * NINP * 1024, 1024, 256, 15, 1024, e, lds, bx - 64, G - 64, 4, 8, false);
                    asm volatile("s_waitcnt vmcnt(0)" ::: "memory");
                    __syncthreads();
                    if (threadIdx.x == 0) {
                        __builtin_amdgcn_fence(__ATOMIC_RELEASE, "agent");
                        asm volatile("s_waitcnt vmcnt(0)" ::: "memory");
                        __hip_atomic_fetch_add(gdone, 1u, __ATOMIC_RELAXED, __HIP_MEMORY_SCOPE_AGENT);
                    }
                }
                __syncthreads();
                if (threadIdx.x == 0) {
                    unsigned sp_ = 0;
                    while (__hip_atomic_load(gdone, __ATOMIC_RELAXED, __HIP_MEMORY_SCOPE_AGENT) < (unsigned)(G - 64)) { __builtin_amdgcn_s_sleep(8); if (++sp_ > (1u << 24)) break; }
                    __builtin_amdgcn_fence(__ATOMIC_ACQUIRE, "agent");
                    asm volatile("s_waitcnt vmcnt(0)" ::: "memory");
                }
                __syncthreads();
                if (bx >= 64 && bx < 128) {
                    const u16* KVb = (const u16*)(ws + OFF_KV);
                    if (bx < 96) {
                        EpiCompress ek{(const float*)(ws + OFF_CBP) + (l * 2 + 0) * 2048, p.in[I_CKW2] + (size_t)l * 8192, (u16*)(ws + OFF_KC), 0, lds};
                        gemm_phase(KVb, 1024, (const u16*)(ws + OFF_CW1) + (size_t)(l * 2 + 0) * 128 * 2048, 2048, 32, 1, 2048, ek, lds, bx - 64, 1 << 20);
                    } else {
                        EpiCompress ev{(const float*)(ws + OFF_CBP) + (l * 2 + 1) * 2048, p.in[I_CVW2] + (size_t)l * 8192, (u16*)(ws + OFF_VCT), 1, lds};
                        gemm_phase(KVb + 4194304, 1024, (const u16*)(ws + OFF_CW1) + (size_t)(l * 2 + 1) * 128 * 2048, 2048, 32, 1, 2048, ev, lds, bx - 96, 1 << 20);
                    }
                    asm volatile("s_waitcnt vmcnt(0)" ::: "memory");
                    __syncthreads();
                    if (threadIdx.x == 0) {
                        __builtin_amdgcn_fence(__ATOMIC_RELEASE, "agent");
                        asm volatile("s_waitcnt vmcnt(0)" ::: "memory");
                        __hip_atomic_fetch_add(cdone, 1u, __ATOMIC_RELAXED, __HIP_MEMORY_SCOPE_AGENT);
                    }
                }
#if EN_CONV
                for (;;) { const int t = block_next(ctl + QW(l, Q_CONV), qslot); if (t >= NTOK / 32) break; conv_tile(p, l, t, lds); }
#else
                zero_mix_cols(p, 0, 256);
#endif
                __syncthreads();
                if (threadIdx.x == 0) {
                    unsigned sp_ = 0;
                    while (__hip_atomic_load(cdone, __ATOMIC_RELAXED, __HIP_MEMORY_SCOPE_AGENT) < 64u) { __builtin_amdgcn_s_sleep(8); if (++sp_ > (1u << 24)) break; }
                    __builtin_amdgcn_fence(__ATOMIC_ACQUIRE, "agent");
                    asm volatile("s_waitcnt vmcnt(0)" ::: "memory");
                }
                __syncthreads();
                for (int qi = 0; qi < 8; ++qi) {
                    const int bgq = (bx + qi) & 7;
                    for (;;) { const int t = block_next(ctl + QW(l, Q_NSA) + bgq, qslot); if (t >= 256) break; nsa_block_task(p, t * 8 + bgq, lds); }
                }
                if (l == 0) {
                    float* fl = (float*)lds;
                    for (;;) {
                        const int t = block_next(ctl + QW(0, 0), qslot); if (t >= 1536) break;
                        if (t < 512) { const int l2 = t >> 8, r = t & 255; transpose_tile(p.in[I_WOUT] + (size_t)l2 * 1024 * 1024, 1024, (u16*)(ws + OFF_WOUT) + (size_t)l2 * 1024 * 1024, 1024, r >> 4, r & 15, fl); }
                        else { const int u = t - 512; const int l2 = u >> 9, r = u & 511; transpose_tile(p.in[I_PWQ] + (size_t)l2 * 1024 * 2048, 2048, (u16*)(ws + OFF_WQ) + (size_t)l2 * 2048 * 1024, 1024, r >> 5, r & 31, fl); }
                    }
                }
                for (;;) {
                    const int t = block_next(ctl + QW(l, 7), qslot); if (t >= 1024) break;
                    const int tb = t >> 9, r0 = (t & 511) * 32;
                    convert_rows_task(p.in[tb ? I_PV : I_PU] + (size_t)l * 16384 * 1024, ws + OFF_U8 + (size_t)tb * 16 * MiB, (float*)(ws + OFF_UVS) + tb * 16384,
                                      tb ? nullptr : (int*)(ws + OFF_UVS) + 2 * 16384, r0);
                }
            } else if (sp == 3) {
#if EN_RWKV
                phase_rwkv_post(p, l);
#else
                zero_mix_cols(p, 256, 256);
#endif
            } else if (sp == 4) {
                EpiOutProj e{l == 0 ? p.in[I_X] : p.out, p.out, modl + 2 * 1024};
                gemm_phase((const u16*)(ws + OFF_MIX), 1024, (const u16*)(ws + OFF_WOUT) + (size_t)l * 1024 * 1024, 1024, 256, 8, 1024, e, lds, bx, G);
            } else if (sp == 5) {
#if EN_PEER
                phase_norm(p.out, p.in[I_N2G] + l * 1024, modl + 3 * 1024, modl + 4 * 1024, (u16*)(ws + OFF_H));
#endif
            } else if (sp == 6) {
#if EN_PEER
                EpiStoreBf16 e{(u16*)(ws + OFF_QP), 2048};
                gemm_phase((const u16*)(ws + OFF_H), 1024, (const u16*)(ws + OFF_WQ) + (size_t)l * 2048 * 1024, 1024, 256, 16, 1024, e, lds, bx, G);
#endif
            } else if (sp == 7) {
#if EN_PEER
                float* wl = (float*)lds + (TID() >> 6) * 4096;
                for (int t = bx * 4 + (TID() >> 6); t < NTOK / 2; t += G * 4) {
                    peer_topk_task2(p, l, t, wl);
                    peer_experts_token(p, l, 2 * t, (const int*)(wl + 3584), wl + 3584 + 256);
                    peer_experts_token(p, l, 2 * t + 1, (const int*)(wl + 3584) + 128, wl + 3584 + 256 + 128);
                    lds_fence();
                }
#endif
            }
        }
        if (ph + 1 < p.ph_hi) { if (p.ph_lo < 0) grid.sync(); else xcd_barrier(xbar); }
    }
}

extern "C" void kernel_launch(void* const* d_in, const int* in_sizes, int n_in, void* d_out, int out_size, void* d_ws, size_t ws_size,
                              hipStream_t stream) {
    static int grid_blocks = 0;
    if (!grid_blocks) {
        int dev = 0, cus = 0, per_cu = 0;
        hipGetDevice(&dev);
        hipDeviceGetAttribute(&cus, hipDeviceAttributeMultiprocessorCount, dev);
        hipOccupancyMaxActiveBlocksPerMultiprocessor(&per_cu, (const void*)mega, 256, 0);
        if (per_cu > 2) per_cu = 2;
        if (per_cu < 1) per_cu = 1;
        grid_blocks = cus * per_cu;
        if (ws_size < WS_NEED) fprintf(stderr, "kernel_launch: workspace too small: %zu < %zu\n", ws_size, (size_t)WS_NEED);
    }
    hipMemsetAsync((char*)d_ws + OFF_CTL, 0, CTL_ZERO_BYTES, stream);
    Params p{};
    for (int i = 0; i < 35; ++i) p.in[i] = (const float*)d_in[i];
    p.out = (float*)d_out;
    p.ws = (unsigned char*)d_ws;
#if MULTI_LAUNCH
    for (int ph = 0; ph < NPH; ++ph) {
        p.ph_lo = ph; p.ph_hi = ph + 1;
        hipLaunchKernelGGL(mega, dim3(grid_blocks), dim3(256), 0, stream, p);
    }
#else
    p.ph_lo = 0; p.ph_hi = NPH;
    void* args[] = {&p};
    hipError_t e = hipLaunchCooperativeKernel((const void*)mega, dim3(grid_blocks), dim3(256), args, 0, stream);
    if (e != hipSuccess) fprintf(stderr, "cooperative launch failed: %s (grid %d)\n", hipGetErrorString(e), grid_blocks);
#endif
}
```

```cpp
#include <hip/hip_runtime.h>
#include <hip/hip_cooperative_groups.h>
#include <stdint.h>
#include <stdio.h>
namespace cg = cooperative_groups;

#ifndef EN_CONV
#define EN_CONV 1
#endif
#ifndef EN_RWKV
#define EN_RWKV 1
#endif
#ifndef EN_NSA_CMP
#define EN_NSA_CMP 1
#endif
#ifndef EN_NSA_WIN
#define EN_NSA_WIN 1
#endif
#ifndef EN_NSA_SEL
#define EN_NSA_SEL 1
#endif
#ifndef EN_PEER
#define EN_PEER 1
#endif
#ifndef MULTI_LAUNCH
#define MULTI_LAUNCH 0
#endif

#define DEV __device__ __forceinline__
typedef unsigned short u16;
typedef __attribute__((ext_vector_type(8))) short bf16x8;
typedef __attribute__((ext_vector_type(4))) float f32x4;
typedef __attribute__((ext_vector_type(4))) unsigned int u32x4;
typedef __attribute__((ext_vector_type(2))) unsigned int u32x2;

constexpr int NB = 4, NT = 8192, ND = 1024, NTOK = NB * NT, NL = 2;
constexpr int NIN = 2840, NINP = 2944;
constexpr size_t MiB = 1ull << 20;

constexpr size_t OFF_CTL = 0;
constexpr size_t CTL_ZERO_BYTES = 32768;
constexpr size_t OFF_BAR = 16384;
constexpr size_t OFF_MOD = 64 * 1024;
constexpr size_t OFF_CBP = 256 * 1024;
constexpr size_t OFF_WIN = 1 * MiB;
constexpr size_t OFF_WOUT = 13 * MiB;
constexpr size_t OFF_WQ = 17 * MiB;
constexpr size_t OFF_CW1 = 25 * MiB;
constexpr size_t OFF_K12 = 27 * MiB;
constexpr size_t OFF_LW = 27 * MiB + 512 * 1024;
constexpr size_t OFF_U8 = 28 * MiB;
constexpr size_t OFF_UVS = 512 * 1024;
constexpr size_t OFF_H = 92 * MiB;
constexpr size_t OFF_MIX = 156 * MiB;
constexpr size_t OFF_E = 220 * MiB;
constexpr size_t OFF_PCONV = OFF_E + 0;
constexpr size_t OFF_PRWKV = OFF_E + 32 * MiB;
constexpr size_t OFF_YRAW = OFF_E + 32 * MiB;
constexpr size_t OFF_Q = OFF_E + 96 * MiB;
constexpr size_t OFF_KV = OFF_E + 128 * MiB;
constexpr size_t OFF_GATE = OFF_E + 176 * MiB;
constexpr size_t OFF_KC = OFF_E + 180 * MiB;
constexpr size_t OFF_VCT = OFF_KC + 512 * 1024;
constexpr size_t OFF_RV = OFF_E + 184 * MiB;
constexpr size_t OFF_RKK = OFF_E + 200 * MiB;
constexpr size_t OFF_RKKA = OFF_E + 216 * MiB;
constexpr size_t OFF_RG = OFF_E + 232 * MiB;
constexpr size_t OFF_BONUS = OFF_E + 248 * MiB;
constexpr size_t OFF_RW = OFF_E + 249 * MiB;
constexpr size_t OFF_RR = 60 * MiB;
constexpr size_t OFF_RK = 76 * MiB;
constexpr size_t OFF_QP = OFF_E + 0;
constexpr size_t OFF_PIDX = OFF_E + 128 * MiB;
constexpr size_t OFF_PGW = OFF_E + 144 * MiB;
constexpr size_t WS_NEED = OFF_E + 281 * MiB;

#define QW(l, q) (64 * ((l) * 8 + (q)))
enum { Q_CMP = 0, Q_CONV = 1, Q_RWP = 2, Q_NSA = 3, Q_PTK = 4 };

enum { I_X = 0, I_C, I_ADAW, I_ADAB, I_N1G, I_N2G, I_WIN, I_CDW, I_CDB, I_CGG, I_CGB, I_MU, I_W0, I_WUP, I_A0, I_AUP, I_GUP,
       I_KK, I_KA, I_RK, I_LNG, I_LNB, I_CKPOS, I_CKW1, I_CKW2, I_CVPOS, I_CVW1, I_CVW2, I_WOUT, I_PWQ, I_PK1, I_PK2, I_PU, I_PV, I_FG };

struct Params {
    const float* in[35];
    float* out;
    unsigned char* ws;
    int ph_lo, ph_hi;
};

DEV int TID() { int t = threadIdx.x; asm volatile("" : "+v"(t)); return t; }
DEV int BID() { int t = blockIdx.x; asm volatile("" : "+s"(t)); return t; }
typedef __attribute__((ext_vector_type(2))) float f32x2_t;
typedef __attribute__((ext_vector_type(2))) __bf16 bf16x2_t;
DEV unsigned pack2(float a, float b) { const f32x2_t v = {a, b}; return __builtin_bit_cast(unsigned, __builtin_convertvector(v, bf16x2_t)); }
DEV u16 f2bf(float f) { const __bf16 h = (__bf16)f; return __builtin_bit_cast(u16, h); }
DEV float bf2f(u16 h) { return __uint_as_float(((unsigned)h) << 16); }
DEV float bflo(unsigned u) { return __uint_as_float(u << 16); }
DEV float bfhi(unsigned u) { return __uint_as_float(u & 0xffff0000u); }
DEV float ex2(float x) { return __builtin_amdgcn_exp2f(x); }
DEV float sigmoidf_(float x) { return 1.f / (1.f + __expf(-x)); }

DEV f32x4 mfma16(bf16x8 a, bf16x8 b, f32x4 c) { return __builtin_amdgcn_mfma_f32_16x16x32_bf16(a, b, c, 0, 0, 0); }
template <int CTRL> DEV float dppf(float x) { return __int_as_float(__builtin_amdgcn_update_dpp(0, __float_as_int(x), CTRL, 0xF, 0xF, false)); }
template <int CTRL> DEV unsigned dppu(unsigned x) { return (unsigned)__builtin_amdgcn_update_dpp(0, (int)x, CTRL, 0xF, 0xF, false); }
DEV float reduce16(float x) { x += dppf<0xB1>(x); x += dppf<0x4E>(x); x += dppf<0x124>(x); x += dppf<0x128>(x); return x; }
DEV float quadsum(float x) { x += dppf<0xB1>(x); x += dppf<0x4E>(x); return x; }
DEV float x16_sum(float x) { auto r = __builtin_amdgcn_permlane16_swap(__float_as_uint(x), __float_as_uint(x), false, false); return __uint_as_float(r[0]) + __uint_as_float(r[1]); }
DEV float x32_sum(float x) { auto r = __builtin_amdgcn_permlane32_swap(__float_as_uint(x), __float_as_uint(x), false, false); return __uint_as_float(r[0]) + __uint_as_float(r[1]); }
DEV float x16_max(float x) { auto r = __builtin_amdgcn_permlane16_swap(__float_as_uint(x), __float_as_uint(x), false, false); return fmaxf(__uint_as_float(r[0]), __uint_as_float(r[1])); }
DEV float x32_max(float x) { auto r = __builtin_amdgcn_permlane32_swap(__float_as_uint(x), __float_as_uint(x), false, false); return fmaxf(__uint_as_float(r[0]), __uint_as_float(r[1])); }
DEV int x16_sumi(int x) { auto r = __builtin_amdgcn_permlane16_swap((unsigned)x, (unsigned)x, false, false); return (int)(r[0] + r[1]); }
DEV int x32_sumi(int x) { auto r = __builtin_amdgcn_permlane32_swap((unsigned)x, (unsigned)x, false, false); return (int)(r[0] + r[1]); }
DEV float colsum(float x) { return x32_sum(x16_sum(x)); }
DEV float colmax(float x) { return x32_max(x16_max(x)); }
DEV int colsumi(int x) { return x32_sumi(x16_sumi(x)); }
DEV float wave_sum(float v) { return x32_sum(x16_sum(reduce16(v))); }
DEV int wave_sum_i(int x) {
    x += (int)dppu<0xB1>((unsigned)x); x += (int)dppu<0x4E>((unsigned)x); x += (int)dppu<0x124>((unsigned)x); x += (int)dppu<0x128>((unsigned)x);
    return x32_sumi(x16_sumi(x));
}
DEV int reduce8_i(const int (&d)[8]) {
    int t[4];
#pragma unroll
    for (int k = 0; k < 4; ++k) {
        auto r = __builtin_amdgcn_permlane32_swap((unsigned)d[k], (unsigned)d[k + 4], false, false);
        t[k] = (int)(r[0] + r[1]);
    }
    int u[2];
#pragma unroll
    for (int k = 0; k < 2; ++k) {
        auto r = __builtin_amdgcn_permlane16_swap((unsigned)t[k], (unsigned)t[k + 2], false, false);
        u[k] = (int)(r[0] + r[1]);
    }
    const bool hi8 = (threadIdx.x & 8) != 0;
    int x = hi8 ? u[1] : u[0];
    const int y = hi8 ? u[0] : u[1];
    x += (int)dppu<0x128>((unsigned)y);
    x += (int)dppu<0xB1>((unsigned)x); x += (int)dppu<0x4E>((unsigned)x); x += (int)dppu<0x141>((unsigned)x);
    return x;
}
DEV float wave_max(float x) {
    x = fmaxf(x, dppf<0xB1>(x)); x = fmaxf(x, dppf<0x4E>(x)); x = fmaxf(x, dppf<0x124>(x)); x = fmaxf(x, dppf<0x128>(x));
    return x32_max(x16_max(x));
}
DEV void lds_fence() { asm volatile("s_waitcnt lgkmcnt(0)" ::: "memory"); }
DEV bf16x8 ld8(const u16* p) { return *(const bf16x8*)p; }

DEV int block_next(unsigned* ctr, int* slot) {
    __syncthreads();
    if (TID() == 0) *slot = (int)atomicAdd(ctr, 1u);
    __syncthreads();
    return *slot;
}

#define XB_TMO      128
#define XB_XCNT(j)  (256  + 64 * (j))
#define XB_XSUB(j)  (1280 + 64 * (j))
#define XB_XGEN(j)  (2304 + 64 * (j))
#define XB_TOP      3328
#define XB_TOPGEN   3392
#define XCD_BAR_WORDS 3456
#define XB_SPIN_CAP (1u << 22)
#define LAS __attribute__((address_space(3)))
DEV unsigned xb_ld(unsigned* p) { return __hip_atomic_load(p, __ATOMIC_RELAXED, __HIP_MEMORY_SCOPE_AGENT); }
DEV unsigned xb_add(unsigned* p, unsigned v) { return __hip_atomic_fetch_add(p, v, __ATOMIC_RELAXED, __HIP_MEMORY_SCOPE_AGENT); }
DEV unsigned xb_xcc_id() { return (unsigned)__builtin_amdgcn_s_getreg((3 << 11) | 20) & 0xFu; }
#define XB_SPIN(cond, bar) do { unsigned _sp = 0; while (cond) { __builtin_amdgcn_s_sleep(1); \
    if ((++_sp & 255u) == 0u) { if (xb_ld(&(bar)[XB_TMO])) break; if (_sp > XB_SPIN_CAP) { atomicAdd(&(bar)[XB_TMO], 1u); break; } } } } while (0)
struct XcdBarrier { unsigned* bar; unsigned x; volatile unsigned* st; };
DEV XcdBarrier xcd_barrier_post(unsigned* bar, volatile unsigned* st) {
    XcdBarrier b; b.bar = bar; b.x = xb_xcc_id(); b.st = st;
    if (threadIdx.x == 0) (void)xb_add(&bar[XB_XCNT(b.x)], 1u);
    return b;
}
DEV void xcd_barrier_complete(unsigned* bar, unsigned x, unsigned& nloc, unsigned& nx) {
    const unsigned G = gridDim.x * gridDim.y * gridDim.z;
    unsigned sum, cnt, mine, sp = 0u;
    for (;;) {
        sum = 0u; cnt = 0u; mine = 0u;
#pragma unroll
        for (unsigned j = 0; j < 16; ++j) { const unsigned c = xb_ld(&bar[XB_XCNT(j)]); sum += c; cnt += (c > 0u) ? 1u : 0u; mine = (j == x) ? c : mine; }
        if (sum == G) break;
        __builtin_amdgcn_s_sleep(1);
        if ((++sp & 255u) == 0u) { if (xb_ld(&bar[XB_TMO])) break; if (sp > XB_SPIN_CAP) { atomicAdd(&bar[XB_TMO], 1u); break; } }
    }
    nloc = mine > 0u ? mine : 1u; nx = cnt > 0u ? cnt : 1u;
}
DEV void xcd_barrier(const XcdBarrier& b) {
    asm volatile("s_waitcnt vmcnt(0)" ::: "memory");
    __syncthreads();
    if (threadIdx.x == 0) {
        unsigned* bar = b.bar;
        __builtin_amdgcn_s_waitcnt(0);
        unsigned nloc = b.st[0], nx = b.st[1];
        if (nloc == 0u) { xcd_barrier_complete(bar, b.x, nloc, nx); b.st[0] = nloc; b.st[1] = nx; }
        const unsigned old = xb_add(&bar[XB_XSUB(b.x)], 1u);
        const unsigned gen = old / nloc;
        if (old + 1u == (gen + 1u) * nloc) {
            __builtin_amdgcn_fence(__ATOMIC_RELEASE, "agent");
            asm volatile("s_waitcnt vmcnt(0)" ::: "memory");
            const unsigned og = xb_add(&bar[XB_TOP], 1u);
            const unsigned tg = og / nx;
            if (og + 1u == (tg + 1u) * nx) xb_add(&bar[XB_TOPGEN], 1u);
            else XB_SPIN(xb_ld(&bar[XB_TOPGEN]) == tg, bar);
            __builtin_amdgcn_fence(__ATOMIC_ACQUIRE, "agent");
            xb_add(&bar[XB_XGEN(b.x)], 1u);
            asm volatile("s_waitcnt vmcnt(0)" ::: "memory");
        } else {
            XB_SPIN(xb_ld(&bar[XB_XGEN(b.x)]) == gen, bar);
            __builtin_amdgcn_fence(__ATOMIC_ACQUIRE, "agent");
            asm volatile("s_waitcnt vmcnt(0)" ::: "memory");
        }
    }
    __syncthreads();
}

template <class Epi>
DEV void gemm_phase(const u16* __restrict__ A, int lda, const u16* __restrict__ Bt, int ldb, int mtiles, int ntiles, int K, Epi& epi,
                    unsigned char* lds, int bid, int nb, int nt_lo = 0, int nt_skip = 0, bool xcd_order = true) {
    const int tid = TID(), lane = tid & 63, wave = tid >> 6;
    const int wm = wave >> 1, wn = wave & 1, q4 = lane >> 4, cidx = lane & 15;
    u16* As = (u16*)lds;
    u16* Bs = (u16*)(lds + 32768);
    const int KT = K >> 6;
    const int total = mtiles * ntiles;
    const int srow = tid >> 3, sch = tid & 7;
    const bool xo_ = xcd_order && ((nb & 7) == 0) && (nb <= 4096) && ((mtiles & 7) == 0);
    const int ngroups = (ntiles + 7) >> 3;
    const int nloc = xo_ ? (nb >> 3) : 1;
    const int nvirt = xo_ ? ((mtiles >> 3) * ngroups * 64) : total;
    for (int vt = xo_ ? ((bid & 7) * 64 + (bid >> 3)) : bid; vt < nvirt; vt += xo_ ? ((((vt & 63) + nloc) < 64) ? nloc : (8 * 64 - (vt & 63) + (bid >> 3))) : nb) {
        int mt, nt;
        if (xo_) {
            const int st = vt >> 6, tt = vt & 63;
            mt = (st / ngroups) * 8 + (tt >> 3); nt = (st % ngroups) * 8 + (tt & 7);
            if (nt >= ntiles) continue;
        } else { mt = vt / ntiles; nt = vt - mt * ntiles; }
        if (nt >= nt_lo) nt += nt_skip;
        const int m0 = mt * 128, n0 = nt * 128;
        const bool sw = epi.swapped(n0 + wn * 64);
        const int xo = sw ? (32768 / 2 + wn * 64 * 64) : (wm * 64 * 64);
        const int yo = sw ? (wm * 64 * 64) : (32768 / 2 + wn * 64 * 64);
        f32x4 acc[4][4];
#pragma unroll
        for (int i = 0; i < 4; ++i)
#pragma unroll
            for (int j = 0; j < 4; ++j) acc[i][j] = (f32x4){0.f, 0.f, 0.f, 0.f};
        const u16* Ag = A + (size_t)(m0 + srow) * lda + sch * 8;
        const u16* Bg = Bt + (size_t)(n0 + srow) * ldb + sch * 8;
        bf16x8 ra0[4], rb0[4], ra1[4], rb1[4];
#define GEMM_GLOAD(RA, RB, KT_) { const int k0_ = (KT_) * 64; _Pragma("unroll") for (int i = 0; i < 4; ++i) { RA[i] = ld8(Ag + (size_t)(32 * i) * lda + k0_); RB[i] = ld8(Bg + (size_t)(32 * i) * ldb + k0_); } }
#define GEMM_LWRITE(RA, RB, BUF_) { u16* Aw_ = As + (BUF_) * 8192; u16* Bw_ = Bs + (BUF_) * 8192; _Pragma("unroll") for (int i = 0; i < 4; ++i) { const int row = srow + 32 * i; const int off = row * 64 + ((sch ^ (row & 7)) << 3); *(bf16x8*)(Aw_ + off) = RA[i]; *(bf16x8*)(Bw_ + off) = RB[i]; } }
#define GEMM_COMPUTE(BUF_) { const u16* Xb = As + (BUF_) * 8192 + xo; const u16* Yb = As + (BUF_) * 8192 + yo; _Pragma("unroll") for (int s = 0; s < 2; ++s) { bf16x8 a[4], b[4]; const int ch = s * 4 + q4; _Pragma("unroll") for (int i = 0; i < 4; ++i) { const int row = i * 16 + cidx; a[i] = *(const bf16x8*)(Xb + row * 64 + ((ch ^ (row & 7)) << 3)); b[i] = *(const bf16x8*)(Yb + row * 64 + ((ch ^ (row & 7)) << 3)); } _Pragma("unroll") for (int i = 0; i < 4; ++i) _Pragma("unroll") for (int j = 0; j < 4; ++j) acc[i][j] = mfma16(a[i], b[j], acc[i][j]); } }
        GEMM_GLOAD(ra0, rb0, 0);
        if (KT > 1) GEMM_GLOAD(ra1, rb1, 1);
        GEMM_LWRITE(ra0, rb0, 0);
        __syncthreads();
        for (int kt = 0; kt < KT; kt += 2) {
            if (kt + 2 < KT) GEMM_GLOAD(ra0, rb0, kt + 2);
            GEMM_COMPUTE(0);
            GEMM_LWRITE(ra1, rb1, 1);
            __syncthreads();
            if (kt + 3 < KT) GEMM_GLOAD(ra1, rb1, kt + 3);
            GEMM_COMPUTE(1);
            if (kt + 2 < KT) GEMM_LWRITE(ra0, rb0, 0);
            __syncthreads();
        }
#undef GEMM_GLOAD
#undef GEMM_LWRITE
#undef GEMM_COMPUTE
        if (!sw) {
#pragma unroll
            for (int i = 0; i < 4; ++i)
#pragma unroll
                for (int j = 0; j < 4; ++j) epi.rows4(m0 + wm * 64 + i * 16 + q4 * 4, n0 + wn * 64 + j * 16 + cidx, acc[i][j]);
        } else {
#pragma unroll
            for (int i = 0; i < 4; ++i)
#pragma unroll
                for (int j = 0; j < 4; ++j) epi.cols4(m0 + wm * 64 + j * 16 + cidx, n0 + wn * 64 + i * 16 + q4 * 4, acc[i][j]);
        }
        epi.finish(m0, n0, lds);
    }
}

struct EpiInProj {
    u16 *pconv, *prwkv, *q, *kv; float* gate;
    DEV bool swapped(int c0) const { return !((c0 >= 2432 && c0 < 2560) || (c0 >= 2688 && c0 < 2816)); }
    DEV void rows4(int row0, int col, f32x4 v) const {
        const int c = col - 2048; const int idx = c >> 7; const int g = (c >> 6) & 1; const int d = c & 63;
        const int b = row0 >> 13; const int t0 = row0 & 8191; const int bg = b * 2 + g;
        u16* base = kv + (size_t)idx * 4194304;
        const int k = t0 & 31; const int p0 = 8 * ((k & 15) >> 2) + 4 * (k >> 4);
        u32x2 w; w[0] = pack2(v[0], v[1]); w[1] = pack2(v[2], v[3]);
        *(u32x2*)(base + (size_t)(bg * 64 + d) * 8192 + (t0 & ~31) + p0) = w;
    }
    DEV void cols4(int row, int col0, f32x4 v) const {
        if (col0 < 512) {
            u32x2 w; w[0] = pack2(v[0], v[1]); w[1] = pack2(v[2], v[3]);
            *(u32x2*)(pconv + (size_t)row * 512 + col0) = w;
        } else if (col0 < 1536) {
            u32x2 w; w[0] = pack2(v[0], v[1]); w[1] = pack2(v[2], v[3]);
            *(u32x2*)(prwkv + (size_t)row * 1024 + (col0 - 512)) = w;
        } else if (col0 < 2048) {
            const float sc = 0.18033688011112042f;
            u32x2 w; w[0] = pack2(v[0] * sc, v[1] * sc); w[1] = pack2(v[2] * sc, v[3] * sc);
            *(u32x2*)(q + (size_t)row * 512 + (col0 - 1536)) = w;
        } else if (col0 < 2816) {
            const int c = col0 - 2048; const int idx = c >> 7; const int g = (c >> 6) & 1; const int d = c & 63;
            const int b = row >> 13; const int t = row & 8191; const int bg = b * 2 + g;
            u32x2 w; w[0] = pack2(v[0], v[1]); w[1] = pack2(v[2], v[3]);
            *(u32x2*)(kv + (size_t)idx * 4194304 + ((size_t)bg * 8192 + t) * 64 + d) = w;
        } else if (col0 < 2840) {
            *(float4*)(gate + (size_t)row * 24 + (col0 - 2816)) = (float4){sigmoidf_(v[0]), sigmoidf_(v[1]), sigmoidf_(v[2]), sigmoidf_(v[3])};
        }
    }
    DEV void finish(int, int, unsigned char*) const {}
};

struct EpiOutProj {
    const float* xold; float* xnew; const float* g1;
    DEV bool swapped(int) const { return true; }
    DEV void rows4(int, int, f32x4) const {}
    DEV void cols4(int row, int col0, f32x4 v) const {
        const int b = row >> 13; const float4 gg = *(const float4*)(g1 + b * 6144 + col0);
        const size_t o = (size_t)row * 1024 + col0;
        const float4 x = *(const float4*)(xold + o);
        *(float4*)(xnew + o) = (float4){x.x + gg.x * v[0], x.y + gg.y * v[1], x.z + gg.z * v[2], x.w + gg.w * v[3]};
    }
    DEV void finish(int, int, unsigned char*) const {}
};

struct EpiStoreBf16 {
    u16* out; int ld;
    DEV bool swapped(int) const { return true; }
    DEV void rows4(int, int, f32x4) const {}
    DEV void cols4(int row, int col0, f32x4 v) const {
        u32x2 w; w[0] = pack2(v[0], v[1]); w[1] = pack2(v[2], v[3]);
        *(u32x2*)(out + (size_t)row * ld + col0) = w;
    }
    DEV void finish(int, int, unsigned char*) const {}
};

struct EpiCompress {
    const float* cbp;
    const float* w2;
    u16* outp;
    int isv;
    unsigned char* lds;
    DEV bool swapped(int) const { return false; }
    DEV void cols4(int, int, f32x4) const {}
    DEV void rows4(int row0, int col, f32x4 v) const {
        float* hid = (float*)lds;
        const int rl = row0 & 127;
#pragma unroll
        for (int r = 0; r < 4; ++r) hid[(rl + r) * 128 + col] = v[r];
    }
    DEV void finish(int m0, int, unsigned char*) const {
        __syncthreads();
        {
            float* hw = (float*)lds;
            const int t = TID(); const int c = t & 127, r0 = (t >> 7) * 64;
            float bias = 0.f;
#pragma unroll
            for (int s = 0; s < 16; ++s) bias += cbp[s * 128 + c];
#pragma unroll 4
            for (int r = 0; r < 64; ++r) { const float x = hw[(r0 + r) * 128 + c] + bias; hw[(r0 + r) * 128 + c] = x * sigmoidf_(x); }
        }
        __syncthreads();
        const float* hid = (const float*)lds;
        const int tid = TID(); const int d = tid & 63, rgp = tid >> 6;
        float acc[32];
#pragma unroll
        for (int i = 0; i < 32; ++i) acc[i] = 0.f;
#pragma unroll 1
        for (int j0 = 0; j0 < 128; j0 += 8) {
            float wv[8];
#pragma unroll
            for (int jj = 0; jj < 8; ++jj) wv[jj] = w2[(j0 + jj) * 64 + d];
#pragma unroll
            for (int rr = 0; rr < 32; ++rr) {
                const float4 h0 = *(const float4*)(hid + (rgp * 32 + rr) * 128 + j0), h1 = *(const float4*)(hid + (rgp * 32 + rr) * 128 + j0 + 4);
                acc[rr] += h0.x * wv[0] + h0.y * wv[1] + h0.z * wv[2] + h0.w * wv[3] + h1.x * wv[4] + h1.y * wv[5] + h1.z * wv[6] + h1.w * wv[7];
            }
        }
#pragma unroll
        for (int rr = 0; rr < 32; ++rr) {
            const int m = m0 + rgp * 32 + rr; const int bg = m >> 9, n = m & 511;
            const u16 val = (n == 511) ? (u16)0 : f2bf(acc[rr]);
            if (!isv) outp[((size_t)bg * 512 + n) * 64 + d] = val;
            else {
                const int k = n & 31; const int pp = 8 * ((k & 15) >> 2) + (k & 3) + 4 * (k >> 4);
                outp[((size_t)bg * 64 + d) * 512 + (n & ~31) + pp] = val;
            }
        }
        __syncthreads();
    }
};

DEV void transpose_tile(const float* __restrict__ src, int N, u16* __restrict__ dst, int ldk, int kt, int nt, float* tl) {
    const int tid = TID(); const int k0 = kt * 64, n0 = nt * 64;
#pragma unroll 4
    for (int i = 0; i < 16; ++i) {
        const int idx = tid + 256 * i; const int kr = idx >> 6, nc = idx & 63; const int n = n0 + nc;
        tl[kr * 65 + nc] = (n < N) ? src[(size_t)(k0 + kr) * N + n] : 0.f;
    }
    __syncthreads();
#pragma unroll 4
    for (int i = 0; i < 16; ++i) {
        const int idx = tid + 256 * i; const int nr = idx >> 6, kc = idx & 63;
        dst[(size_t)(n0 + nr) * ldk + k0 + kc] = f2bf(tl[kc * 65 + nr]);
    }
    __syncthreads();
}

DEV void convert_straight(const float* __restrict__ src, u16* __restrict__ dst, size_t n) {
    const size_t stride = (size_t)gridDim.x * 256 * 8;
    for (size_t i = ((size_t)BID() * 256 + TID()) * 8; i < n; i += stride) {
        const float4 a = *(const float4*)(src + i); const float4 b = *(const float4*)(src + i + 4);
        u32x4 w; w[0] = pack2(a.x, a.y); w[1] = pack2(a.z, a.w); w[2] = pack2(b.x, b.y); w[3] = pack2(b.z, b.w);
        *(u32x4*)(dst + i) = w;
    }
}

DEV void convert_rows_task(const float* __restrict__ src, unsigned char* __restrict__ dst, float* __restrict__ scale, int* __restrict__ rowsum, int row0) {
    const int lane = TID() & 63, wave = TID() >> 6;
#pragma unroll 1
    for (int it = 0; it < 4; ++it) {
        float4 v[2][4]; float amax[2] = {0.f, 0.f};
#pragma unroll
        for (int u = 0; u < 2; ++u) {
            const int row = row0 + wave * 8 + it * 2 + u;
#pragma unroll
            for (int i = 0; i < 4; ++i) v[u][i] = *(const float4*)(src + (size_t)row * 1024 + 16 * lane + 4 * i);
        }
#pragma unroll
        for (int u = 0; u < 2; ++u) {
#pragma unroll
            for (int i = 0; i < 4; ++i)
                amax[u] = fmaxf(amax[u], fmaxf(fmaxf(fabsf(v[u][i].x), fabsf(v[u][i].y)), fmaxf(fabsf(v[u][i].z), fabsf(v[u][i].w))));
            amax[u] = wave_max(amax[u]);
            const int row = row0 + wave * 8 + it * 2 + u;
            const float sc = amax[u] > 0.f ? amax[u] * (1.f / 127.f) : 1.f;
            const float inv = 1.f / sc;
            u32x4 w;
#pragma unroll
            for (int i = 0; i < 4; ++i) {
                const int a = __float2int_rn(v[u][i].x * inv) + 128, b = __float2int_rn(v[u][i].y * inv) + 128, c = __float2int_rn(v[u][i].z * inv) + 128,
                          d = __float2int_rn(v[u][i].w * inv) + 128;
                w[i] = (unsigned)a | ((unsigned)b << 8) | ((unsigned)c << 16) | ((unsigned)d << 24);
            }
            *(u32x4*)(dst + (size_t)row * 1024 + 16 * lane) = w;
            int bs = 0;
#pragma unroll
            for (int i = 0; i < 4; ++i) bs += (int)(w[i] & 0xffu) + (int)((w[i] >> 8) & 0xffu) + (int)((w[i] >> 16) & 0xffu) + (int)(w[i] >> 24);
            bs = wave_sum_i(bs);
            if (lane == 0) { scale[row] = sc; if (rowsum) rowsum[row] = bs; }
        }
    }
}

DEV void phase_prep(const Params& p, unsigned char* lds) {
    const int tid = TID();
    float* fl = (float*)lds;
    unsigned char* ws = p.ws;
    for (int task = BID(); task < 192; task += gridDim.x) {
        const int l = task / 96, cgp = task % 96;
        float* cs = fl;
        float* red = fl + 4096;
        for (int i = tid; i < 4096; i += 256) { const float c = p.in[I_C][i]; cs[i] = c / (1.f + __expf(-c)); }
        __syncthreads();
        const int col = cgp * 64 + (tid & 63), ks = tid >> 6;
        float a0 = 0, a1 = 0, a2 = 0, a3 = 0;
        const float* w = p.in[I_ADAW] + ((size_t)l * 1024 + ks * 256) * 6144 + col;
#pragma unroll 32
        for (int k = 0; k < 256; ++k) {
            const float wv = w[(size_t)k * 6144]; const int kk = ks * 256 + k;
            a0 += cs[kk] * wv; a1 += cs[1024 + kk] * wv; a2 += cs[2048 + kk] * wv; a3 += cs[3072 + kk] * wv;
        }
        red[(ks * 4 + 0) * 64 + (tid & 63)] = a0; red[(ks * 4 + 1) * 64 + (tid & 63)] = a1;
        red[(ks * 4 + 2) * 64 + (tid & 63)] = a2; red[(ks * 4 + 3) * 64 + (tid & 63)] = a3;
        __syncthreads();
        {
            const int b = tid >> 6, c = tid & 63;
            const float s = red[(0 * 4 + b) * 64 + c] + red[(1 * 4 + b) * 64 + c] + red[(2 * 4 + b) * 64 + c] + red[(3 * 4 + b) * 64 + c];
            const int colg = cgp * 64 + c;
            ((float*)(ws + OFF_MOD))[(l * 4 + b) * 6144 + colg] = s + p.in[I_ADAB][l * 6144 + colg];
        }
        __syncthreads();
    }
    for (int task = BID(); task < 64; task += gridDim.x) {
        const int l = task >> 5, kv = (task >> 4) & 1, s = task & 15;
        const float* pos = p.in[kv ? I_CVPOS : I_CKPOS] + l * 2048;
        const float* w1 = p.in[kv ? I_CVW1 : I_CKW1] + (size_t)l * 2048 * 128;
        const int col = tid & 127, half = tid >> 7;
        float a = 0;
        const int i0 = s * 128 + half * 64;
#pragma unroll 8
        for (int i = 0; i < 64; ++i) a += pos[i0 + i] * w1[(size_t)(i0 + i) * 128 + col];
        fl[tid] = a;
        __syncthreads();
        if (tid < 128) ((float*)(ws + OFF_CBP))[((l * 2 + kv) * 16 + s) * 128 + tid] = fl[tid] + fl[tid + 128];
        __syncthreads();
    }
    {
        for (int task = BID(); task < 2 * 16 * 46; task += gridDim.x) {
            const int l = task / (16 * 46), r = task % (16 * 46);
            transpose_tile(p.in[I_WIN] + (size_t)l * 1024 * NIN, NIN, (u16*)(ws + OFF_WIN) + (size_t)l * NINP * 1024, 1024, r / 46, r % 46, fl);
        }
        for (int task = BID(); task < 2 * 16; task += gridDim.x) {
            const int l = task >> 4, r = task & 15; const int nt = r & 3, part = r >> 2;
            u16* dst = (u16*)(ws + OFF_LW) + (size_t)l * 65536;
            if (part == 0) transpose_tile(p.in[I_WUP] + (size_t)l * 64 * 256, 256, dst, 256, 0, nt, fl);
            else if (part == 1) transpose_tile(p.in[I_AUP] + (size_t)l * 64 * 256, 256, dst + 64, 256, 0, nt, fl);
            else transpose_tile(p.in[I_GUP] + (size_t)l * 128 * 256, 256, dst + 128, 256, part - 2, nt, fl);
        }
        for (int task = BID(); task < 4 * 32 * 2; task += gridDim.x) {
            const int lk = task >> 6, r = task & 63; const int l = lk >> 1, kv = lk & 1;
            transpose_tile(p.in[kv ? I_CVW1 : I_CKW1] + (size_t)l * 2048 * 128, 128, (u16*)(ws + OFF_CW1) + (size_t)lk * 128 * 2048, 2048, r >> 1, r & 1, fl);
        }
    }
    for (int l = 0; l < 2; ++l) {
        convert_straight(p.in[I_PK1] + l * 16384, (u16*)(ws + OFF_K12) + (l * 2 + 0) * 16384, 16384);
        convert_straight(p.in[I_PK2] + l * 16384, (u16*)(ws + OFF_K12) + (l * 2 + 1) * 16384, 16384);
    }
}

DEV void phase_norm(const float* __restrict__ x, const float* __restrict__ g, const float* __restrict__ sh, const float* __restrict__ sc,
                    u16* __restrict__ h) {
    const int lane = TID() & 63;
    const int gw = BID() * 4 + (TID() >> 6), nw = gridDim.x * 4;
    for (int row0 = gw * 2; row0 < NTOK; row0 += nw * 2) {
        float4 v[2][4]; float ss[2] = {0.f, 0.f};
#pragma unroll
        for (int u = 0; u < 2; ++u)
#pragma unroll
            for (int i = 0; i < 4; ++i) v[u][i] = *(const float4*)(x + (size_t)(row0 + u) * 1024 + 256 * i + lane * 4);
#pragma unroll
        for (int u = 0; u < 2; ++u) {
#pragma unroll
            for (int i = 0; i < 4; ++i) ss[u] += v[u][i].x * v[u][i].x + v[u][i].y * v[u][i].y + v[u][i].z * v[u][i].z + v[u][i].w * v[u][i].w;
            ss[u] = wave_sum(ss[u]);
        }
#pragma unroll
        for (int u = 0; u < 2; ++u) {
            const int row = row0 + u; const int b = row >> 13;
            const float rs = rsqrtf(ss[u] * (1.f / 1024.f) + 1e-6f);
#pragma unroll
            for (int i = 0; i < 4; ++i) {
                const int k = 256 * i + lane * 4;
                const float4 gg = *(const float4*)(g + k); const float4 s1 = *(const float4*)(sc + b * 6144 + k); const float4 s0 = *(const float4*)(sh + b * 6144 + k);
                u32x2 w;
                w[0] = pack2(v[u][i].x * rs * gg.x * (1.f + s1.x) + s0.x, v[u][i].y * rs * gg.y * (1.f + s1.y) + s0.y);
                w[1] = pack2(v[u][i].z * rs * gg.z * (1.f + s1.z) + s0.z, v[u][i].w * rs * gg.w * (1.f + s1.w) + s0.w);
                *(u32x2*)(h + (size_t)row * 1024 + k) = w;
            }
        }
    }
}

DEV void conv_tile(const Params& p, int l, int tile, unsigned char* lds) {
    float* ul = (float*)lds;
    const int tid = TID();
    unsigned char* ws = p.ws;
    const u16* pconv = (const u16*)(ws + OFF_PCONV);
    u16* mix = (u16*)(ws + OFF_MIX);
    const int t0g = tile * 32; const int tb = t0g & 8191;
#pragma unroll 8
    for (int rr = 0; rr < 62; ++rr) {
        const int trow = tb - 30 + rr;
        float u = 0.f;
        if (trow >= 0) {
            const size_t o = (size_t)(t0g - 30 + rr) * 512;
            const float val = bf2f(pconv[o + tid]), gt = bf2f(pconv[o + 256 + tid]);
            u = val * sigmoidf_(gt);
        }
        ul[rr * 256 + tid] = u;
    }
    __syncthreads();
    float w[31];
#pragma unroll
    for (int j = 0; j < 31; ++j) w[j] = p.in[I_CDW][(l * 31 + j) * 256 + tid];
    const float bias = p.in[I_CDB][l * 256 + tid], gg = p.in[I_CGG][l * 256 + tid], gb = p.in[I_CGB][l * 256 + tid];
    for (int tt = 0; tt < 32; ++tt) {
        float y = bias;
#pragma unroll
        for (int j = 0; j < 31; ++j) y += ul[(tt + j) * 256 + tid] * w[j];
        const float mean = wave_sum(y) * (1.f / 64.f);
        const float d = y - mean;
        const float var = wave_sum(d * d) * (1.f / 64.f);
        float o = d * rsqrtf(var + 1e-5f) * gg + gb;
        o = o * sigmoidf_(o);
        mix[(size_t)(t0g + tt) * 1024 + tid] = f2bf(o);
    }
}

DEV float softplusf_(float x) { return x > 20.f ? x : log1pf(__expf(x)); }
DEV void rwkv_prep_tile2(const Params& p, int l, int tile, unsigned char* lds) {
    u16* actb = (u16*)lds;
    const int tid = TID(), lane = tid & 63, wave = tid >> 6, q4 = lane >> 4, cidx = lane & 15;
    unsigned char* ws = p.ws;
    const u16* pr = (const u16*)(ws + OFF_PRWKV);
    const float* mu = p.in[I_MU] + l * 1024;
    const int R0 = tile * 16;
    {
        const int col = 768 + tid; const float muc = mu[col];
        u16 raw[17];
        const bool first = ((R0 & 8191) == 0);
        raw[0] = first ? (u16)0 : pr[(size_t)(R0 - 1) * 1024 + col];
#pragma unroll
        for (int tk = 0; tk < 16; ++tk) raw[tk + 1] = pr[(size_t)(R0 + tk) * 1024 + col];
#pragma unroll
        for (int tk = 0; tk < 16; ++tk) {
            const float cur = bf2f(raw[tk + 1]), prev = bf2f(raw[tk]);
            const float x = cur + (prev - cur) * muc;
            float a;
            if (tid < 64) a = tanhf(x); else if (tid < 128) a = x; else a = sigmoidf_(x);
            actb[tk * 264 + tid] = f2bf(a);
        }
    }
    __syncthreads();
    f32x4 accw[4], acca[4], accg[4];
    {
        bf16x8 af[8];
#pragma unroll
        for (int s2 = 0; s2 < 8; ++s2) af[s2] = *(const bf16x8*)(actb + cidx * 264 + 32 * s2 + 8 * q4);
        const u16* LW = (const u16*)(ws + OFF_LW) + (size_t)l * 65536;
        const f32x4 z = (f32x4){0.f, 0.f, 0.f, 0.f};
#pragma unroll
        for (int nt = 0; nt < 4; ++nt) {
            const u16* bp = LW + (size_t)(64 * wave + 16 * nt + cidx) * 256 + 8 * q4;
            accw[nt] = mfma16(af[0], ld8(bp), z); accw[nt] = mfma16(af[1], ld8(bp + 32), accw[nt]);
            acca[nt] = mfma16(af[2], ld8(bp + 64), z); acca[nt] = mfma16(af[3], ld8(bp + 96), acca[nt]);
            accg[nt] = mfma16(af[4], ld8(bp + 128), z); accg[nt] = mfma16(af[5], ld8(bp + 160), accg[nt]);
            accg[nt] = mfma16(af[6], ld8(bp + 192), accg[nt]); accg[nt] = mfma16(af[7], ld8(bp + 224), accg[nt]);
        }
    }
    float* RW = (float*)(ws + OFF_RW);
    u16 *RR = (u16*)(ws + OFF_RR), *RK = (u16*)(ws + OFF_RK), *RV = (u16*)(ws + OFF_RV), *RKK = (u16*)(ws + OFF_RKK), *RKKA = (u16*)(ws + OFF_RKKA),
        *RG = (u16*)(ws + OFF_RG);
    float* BON = (float*)(ws + OFF_BONUS);
    float w0[4], a0[4], kkc[4], kac[4], rkc[4], mur[4], muk[4], muv[4];
#pragma unroll
    for (int nt = 0; nt < 4; ++nt) {
        const int c = 64 * wave + 16 * nt + cidx;
        w0[nt] = p.in[I_W0][l * 256 + c]; a0[nt] = p.in[I_A0][l * 256 + c]; kkc[nt] = p.in[I_KK][l * 256 + c]; kac[nt] = p.in[I_KA][l * 256 + c];
        rkc[nt] = p.in[I_RK][l * 256 + c]; mur[nt] = mu[c]; muk[nt] = mu[256 + c]; muv[nt] = mu[512 + c];
    }
    u16 ld3[5][4][3];
    {
        const int rowb = R0 + 4 * q4; const bool firstrow = ((rowb & 8191) == 0);
#pragma unroll
        for (int rr_ = 0; rr_ < 5; ++rr_)
#pragma unroll
            for (int nt = 0; nt < 4; ++nt) {
                const int c = 64 * wave + 16 * nt + cidx;
                const u16* cr = pr + (size_t)(rowb - 1 + rr_) * 1024;
                const bool z = (rr_ == 0) && firstrow;
                ld3[rr_][nt][0] = z ? (u16)0 : cr[c]; ld3[rr_][nt][1] = z ? (u16)0 : cr[256 + c]; ld3[rr_][nt][2] = z ? (u16)0 : cr[512 + c];
            }
    }
#pragma unroll
    for (int r = 0; r < 4; ++r) {
        const int row = R0 + 4 * q4 + r;
        float rr[4], kf_[4], vf_[4], av[4], kkv[4], keff[4], dec[4];
        float kk2 = 0.f, bn = 0.f;
#pragma unroll
        for (int nt = 0; nt < 4; ++nt) {
            float rv = bf2f(ld3[r + 1][nt][0]), kv = bf2f(ld3[r + 1][nt][1]), vv = bf2f(ld3[r + 1][nt][2]);
            const float rp = bf2f(ld3[r][nt][0]), kp = bf2f(ld3[r][nt][1]), vp = bf2f(ld3[r][nt][2]);
            rv += (rp - rv) * mur[nt]; kv += (kp - kv) * muk[nt]; vv += (vp - vv) * muv[nt];
            const float wl = w0[nt] + accw[nt][r];
            const float wlog = -softplusf_(-wl) - 0.5f;
            dec[nt] = __expf(-__expf(wlog));
            av[nt] = sigmoidf_(a0[nt] + acca[nt][r]);
            kkv[nt] = kv * kkc[nt]; kk2 += kkv[nt] * kkv[nt];
            keff[nt] = kv * (1.f + (av[nt] - 1.f) * kac[nt]);
            bn += rv * keff[nt] * rkc[nt];
            rr[nt] = rv; kf_[nt] = kv; vf_[nt] = vv;
        }
        kk2 = reduce16(kk2); bn = reduce16(bn);
        const float inv = 1.f / fmaxf(sqrtf(kk2), 1e-12f);
#pragma unroll
        for (int nt = 0; nt < 4; ++nt) {
            const int c = 64 * wave + 16 * nt + cidx;
            const size_t o = (size_t)row * 256 + c;
            const float kk = kkv[nt] * inv;
            RW[o] = dec[nt]; RR[o] = f2bf(rr[nt]); RK[o] = f2bf(keff[nt]); RV[o] = f2bf(vf_[nt]); RKK[o] = f2bf(kk); RKKA[o] = f2bf(kk * av[nt]);
            RG[o] = f2bf(accg[nt][r]);
        }
        if (cidx == 0) BON[(size_t)row * 4 + wave] = bn;
    }
}

DEV void rwkv_scan(const Params& p, int sb, unsigned char* lds) {
    unsigned char* ws = p.ws;
    const float* RW = (const float*)(ws + OFF_RW);
    const u16 *RR = (const u16*)(ws + OFF_RR), *RK = (const u16*)(ws + OFF_RK), *RV = (const u16*)(ws + OFF_RV), *RKK = (const u16*)(ws + OFF_RKK),
              *RKKA = (const u16*)(ws + OFF_RKKA);
    float* YR = (float*)(ws + OFF_YRAW);
    const int tid = TID(), lane = tid & 63, wave = tid >> 6;
    const int bh = sb >> 2, rg = sb & 3; const int b = bh >> 2, hh = bh & 3;
    float* L = (float*)lds;
    constexpr int BUFSZ = 5 * 1024 + 256;
    float* Yb = L + 2 * BUFSZ;
    const int row_local = 4 * wave + (lane >> 4); const int kq = (lane & 15) * 4;
    const int lstep = tid >> 4, lk = (tid & 15) * 4;
    const int vstep = tid >> 4, vrow = tid & 15;
    const size_t gbase = (size_t)b * 8192 * 256 + hh * 64;
    float4 lw; u32x2 lr, lkk, lkka, lk_; u16 lv;
    auto issue = [&](int c) {
        const size_t o = gbase + (size_t)(c * 16 + lstep) * 256 + lk;
        lw = *(const float4*)(RW + o);
        lr = *(const u32x2*)(RR + o); lk_ = *(const u32x2*)(RK + o); lkk = *(const u32x2*)(RKK + o); lkka = *(const u32x2*)(RKKA + o);
        lv = RV[gbase + (size_t)(c * 16 + vstep) * 256 + rg * 16 + vrow];
    };
    auto commit = [&](int buf) {
        float* B = L + buf * BUFSZ;
        const int o = lstep * 64 + lk;
        *(float4*)(B + o) = lw;
        *(float4*)(B + 1024 + o) = (float4){bflo(lkka[0]), bfhi(lkka[0]), bflo(lkka[1]), bfhi(lkka[1])};
        *(float4*)(B + 2048 + o) = (float4){bflo(lk_[0]), bfhi(lk_[0]), bflo(lk_[1]), bfhi(lk_[1])};
        *(float4*)(B + 3072 + o) = (float4){bflo(lr[0]), bfhi(lr[0]), bflo(lr[1]), bfhi(lr[1])};
        *(float4*)(B + 4096 + o) = (float4){bflo(lkk[0]), bfhi(lkk[0]), bflo(lkk[1]), bfhi(lkk[1])};
        B[5120 + vstep * 16 + vrow] = bf2f(lv);
    };
    __syncthreads();
    issue(0); commit(0);
    __syncthreads();
    float S0 = 0.f, S1 = 0.f, S2 = 0.f, S3 = 0.f;
    constexpr int NCH = NT / 16;
    for (int c = 0; c < NCH; ++c) {
        const int buf = c & 1;
        if (c + 1 < NCH) issue(c + 1);
        const float* B = L + buf * BUFSZ;
        float* Y = Yb + buf * 256;
        float yv[16];
        float4 w4 = *(const float4*)(B + kq), a4 = *(const float4*)(B + 1024 + kq), k4 = *(const float4*)(B + 2048 + kq),
               r4 = *(const float4*)(B + 3072 + kq), n4 = *(const float4*)(B + 4096 + kq);
        float vv = B[5120 + row_local];
#pragma unroll
        for (int st = 0; st < 16; ++st) {
            float4 w4n, a4n, k4n, r4n, n4n; float vvn;
            if (st < 15) {
                w4n = *(const float4*)(B + (st + 1) * 64 + kq); a4n = *(const float4*)(B + 1024 + (st + 1) * 64 + kq);
                k4n = *(const float4*)(B + 2048 + (st + 1) * 64 + kq); r4n = *(const float4*)(B + 3072 + (st + 1) * 64 + kq);
                n4n = *(const float4*)(B + 4096 + (st + 1) * 64 + kq); vvn = B[5120 + (st + 1) * 16 + row_local];
            }
            const float part = (S0 * n4.x + S1 * n4.y) + (S2 * n4.z + S3 * n4.w);
            const float sa = -reduce16(part);
            const float t0 = S0 * w4.x + vv * k4.x, t1 = S1 * w4.y + vv * k4.y, t2 = S2 * w4.z + vv * k4.z, t3 = S3 * w4.w + vv * k4.w;
            S0 = t0 + sa * a4.x; S1 = t1 + sa * a4.y; S2 = t2 + sa * a4.z; S3 = t3 + sa * a4.w;
            const float yp = (S0 * r4.x + S1 * r4.y) + (S2 * r4.z + S3 * r4.w);
            yv[st] = reduce16(yp);
            if (st < 15) { w4 = w4n; a4 = a4n; k4 = k4n; r4 = r4n; n4 = n4n; vv = vvn; }
        }
        if ((lane & 15) == 0) {
#pragma unroll
            for (int st = 0; st < 16; ++st) Y[st * 16 + row_local] = yv[st];
        }
        if (c + 1 < NCH) commit(buf ^ 1);
        __syncthreads();
        YR[gbase + (size_t)(c * 16 + vstep) * 256 + rg * 16 + vrow] = Y[vstep * 16 + vrow];
    }
}

DEV void phase_rwkv_post(const Params& p, int l) {
    unsigned char* ws = p.ws;
    const float* YR = (const float*)(ws + OFF_YRAW); const float* BON = (const float*)(ws + OFF_BONUS);
    const u16 *RV = (const u16*)(ws + OFF_RV), *RG = (const u16*)(ws + OFF_RG);
    u16* mix = (u16*)(ws + OFF_MIX);
    const int tid = TID();
    const float lg = p.in[I_LNG][l * 256 + tid], lb = p.in[I_LNB][l * 256 + tid];
    for (int row0 = BID() * 4; row0 < NTOK; row0 += gridDim.x * 4) {
        float y[4], bon[4], vv[4], gg[4];
#pragma unroll
        for (int u = 0; u < 4; ++u) {
            const size_t o = (size_t)(row0 + u) * 256 + tid;
            y[u] = YR[o]; bon[u] = BON[(size_t)(row0 + u) * 4 + (tid >> 6)]; vv[u] = bf2f(RV[o]); gg[u] = bf2f(RG[o]);
        }
#pragma unroll
        for (int u = 0; u < 4; ++u) {
            const float mean = wave_sum(y[u]) * (1.f / 64.f);
            const float d = y[u] - mean;
            const float var = wave_sum(d * d) * (1.f / 64.f);
            const float yn = d * rsqrtf(var + 64e-5f) * lg + lb;
            mix[(size_t)(row0 + u) * 1024 + 256 + tid] = f2bf((yn + bon[u] * vv[u]) * gg[u]);
        }
    }
}

DEV void zero_mix_cols(const Params& p, int c0, int ncols) {
    u16* mix = (u16*)(p.ws + OFF_MIX);
    const int per = ncols / 8;
    const size_t total = (size_t)NTOK * per;
    for (size_t i = (size_t)BID() * 256 + TID(); i < total; i += (size_t)gridDim.x * 256) {
        const size_t row = i / per; const int cc = (int)(i % per);
        *(u32x4*)(mix + row * 1024 + c0 + cc * 8) = (u32x4){0u, 0u, 0u, 0u};
    }
}


DEV void qk_tile(const bf16x8 (&kf)[8], bf16x8 q0, bf16x8 q1, float cinit, f32x4 (&st)[4]) {
    const f32x4 c = (f32x4){cinit, cinit, cinit, cinit};
#pragma unroll
    for (int kt = 0; kt < 4; ++kt) {
        st[kt] = mfma16(kf[2 * kt], q0, c);
        st[kt] = mfma16(kf[2 * kt + 1], q1, st[kt]);
    }
}
DEV void softmax_pv_lazy(f32x4 (&st)[4], const bf16x8 (&vf)[8], float& m, float& l, f32x4& L, f32x4 (&O)[4]) {
    float lmax = fmaxf(fmaxf(fmaxf(st[0][0], st[0][1]), fmaxf(st[0][2], st[0][3])), fmaxf(fmaxf(st[1][0], st[1][1]), fmaxf(st[1][2], st[1][3])));
    lmax = fmaxf(lmax, fmaxf(fmaxf(fmaxf(st[2][0], st[2][1]), fmaxf(st[2][2], st[2][3])), fmaxf(fmaxf(st[3][0], st[3][1]), fmaxf(st[3][2], st[3][3]))));
    lmax = colmax(lmax);
    const float dlt = (lmax > 8.f) ? lmax : 0.f;
    if (__any(dlt > 0.f)) {
        const float alpha = ex2(-dlt);
#pragma unroll
        for (int mt = 0; mt < 4; ++mt) { O[mt][0] *= alpha; O[mt][1] *= alpha; O[mt][2] *= alpha; O[mt][3] *= alpha; }
        L[0] *= alpha; L[1] *= alpha; L[2] *= alpha; L[3] *= alpha; l *= alpha; m += dlt;
#pragma unroll
        for (int kt = 0; kt < 4; ++kt) { st[kt][0] -= dlt; st[kt][1] -= dlt; st[kt][2] -= dlt; st[kt][3] -= dlt; }
    }
#pragma unroll
    for (int kt = 0; kt < 4; ++kt)
#pragma unroll
        for (int r = 0; r < 4; ++r) st[kt][r] = ex2(st[kt][r]);
    union { bf16x8 v; unsigned u[4]; } ones;
    ones.u[0] = 0x3f803f80u; ones.u[1] = 0x3f803f80u; ones.u[2] = 0x3f803f80u; ones.u[3] = 0x3f803f80u;
#pragma unroll
    for (int kb = 0; kb < 2; ++kb) {
        union { bf16x8 v; unsigned u[4]; } pb;
        pb.u[0] = pack2(st[2 * kb][0], st[2 * kb][1]); pb.u[1] = pack2(st[2 * kb][2], st[2 * kb][3]);
        pb.u[2] = pack2(st[2 * kb + 1][0], st[2 * kb + 1][1]); pb.u[3] = pack2(st[2 * kb + 1][2], st[2 * kb + 1][3]);
        L = mfma16(ones.v, pb.v, L);
#pragma unroll
        for (int mt = 0; mt < 4; ++mt) O[mt] = mfma16(vf[kb * 4 + mt], pb.v, O[mt]);
    }
}
DEV void softmax_pv_tile(bool MASK, f32x4 (&st)[4], const bf16x8 (&vf)[8], int keybase, int tcol, int lowcol, bool colsel, float& m, float& l, f32x4& L, f32x4 (&O)[4], int q4) {
    float lmax = -1e30f;
    if (MASK) {
        const int hi = colsel ? tcol : -1;
#pragma unroll
        for (int kt = 0; kt < 4; ++kt)
#pragma unroll
            for (int r = 0; r < 4; ++r) {
                const int key = keybase + kt * 16 + 4 * q4 + r;
                const bool valid = (key <= hi) && (key > lowcol);
                const float sv = valid ? st[kt][r] : -1e30f;
                st[kt][r] = sv; lmax = fmaxf(lmax, sv);
            }
    } else {
        const float cs = colsel ? 0.f : -1e30f;
#pragma unroll
        for (int kt = 0; kt < 4; ++kt)
#pragma unroll
            for (int r = 0; r < 4; ++r) { const float sv = st[kt][r] + cs; st[kt][r] = sv; lmax = fmaxf(lmax, sv); }
    }
    lmax = colmax(lmax);
    const float mnew = fmaxf(m, lmax);
    const float alpha = ex2(m - mnew);
    float psum = 0.f;
#pragma unroll
    for (int kt = 0; kt < 4; ++kt)
#pragma unroll
        for (int r = 0; r < 4; ++r) {
            float pv = ex2(st[kt][r] - mnew);
            if (MASK) pv = (st[kt][r] > -1e29f) ? pv : 0.f;
            st[kt][r] = pv; psum += pv;
        }
    l = l * alpha + psum;
    if (__any(mnew > m)) {
#pragma unroll
        for (int mt = 0; mt < 4; ++mt) { O[mt][0] *= alpha; O[mt][1] *= alpha; O[mt][2] *= alpha; O[mt][3] *= alpha; }
        L[0] *= alpha; L[1] *= alpha; L[2] *= alpha; L[3] *= alpha;
    }
    m = mnew;
#pragma unroll
    for (int kb = 0; kb < 2; ++kb) {
        union { bf16x8 v; unsigned u[4]; } pb;
        pb.u[0] = pack2(st[2 * kb][0], st[2 * kb][1]); pb.u[1] = pack2(st[2 * kb][2], st[2 * kb][3]);
        pb.u[2] = pack2(st[2 * kb + 1][0], st[2 * kb + 1][1]); pb.u[3] = pack2(st[2 * kb + 1][2], st[2 * kb + 1][3]);
#pragma unroll
        for (int mt = 0; mt < 4; ++mt) O[mt] = mfma16(vf[kb * 4 + mt], pb.v, O[mt]);
    }
}
DEV unsigned pick4(unsigned a0, unsigned a1, unsigned a2, unsigned a3, int w) { return w == 0 ? a0 : (w == 1 ? a1 : (w == 2 ? a2 : a3)); }
template <int CTRL> DEV unsigned dpp_or(unsigned x) { return x | dppu<CTRL>(x); }
DEV unsigned row_or(unsigned x) { x = dpp_or<0xB1>(x); x = dpp_or<0x4E>(x); x = dpp_or<0x124>(x); x = dpp_or<0x128>(x); return x; }


DEV void nsa_branch_lds(unsigned char* lds, const u16* __restrict__ K0, const u16* __restrict__ VT0, unsigned bu0, unsigned bu1, unsigned bu2,
                        unsigned bu3, unsigned ua0, unsigned ua1, unsigned ua2, unsigned ua3, unsigned ub0, unsigned ub1, unsigned ub2, unsigned ub3,
                        const unsigned* cm, int tokl, const int (&tcol)[2], const int (&lowc)[2], const bf16x8 (&qf)[2][2], float (&m)[2],
                        float (&l)[2], f32x4 (&L)[2], f32x4 (&O)[2][4], int q4, int cidx, int cur, int lowmax) {
    const int tid = TID();
    int w = 0; unsigned bits = bu0;
    auto advance = [&]() -> int {
        while (bits == 0u && w < 3) { ++w; bits = pick4(bu0, bu1, bu2, bu3, w); }
        if (bits == 0u) return -1;
        const int jb = __builtin_ctz(bits); bits &= bits - 1u;
        return w * 32 + jb;
    };
    const int srow0 = tid >> 3, srow1 = srow0 + 32, sch = tid & 7;
    const int so0 = srow0 * 128 + ((sch ^ (srow0 & 7)) << 4), so1 = srow1 * 128 + ((sch ^ (srow1 & 7)) << 4);
    bf16x8 r0[4], r1[4];
#define NSA_GLOAD(R, BLK_) { R[0] = ld8(K0 + ((size_t)(BLK_) * 64 + srow0) * 64 + sch * 8); R[1] = ld8(K0 + ((size_t)(BLK_) * 64 + srow1) * 64 + sch * 8); \
        R[2] = ld8(VT0 + (size_t)srow0 * 8192 + (BLK_) * 64 + sch * 8); R[3] = ld8(VT0 + (size_t)srow1 * 8192 + (BLK_) * 64 + sch * 8); }
#define NSA_LWRITE(R, BUF_) { unsigned char* wb_ = lds + (BUF_) * 16384; *(bf16x8*)(wb_ + so0) = R[0]; *(bf16x8*)(wb_ + so1) = R[1]; \
        *(bf16x8*)(wb_ + 8192 + so0) = R[2]; *(bf16x8*)(wb_ + 8192 + so1) = R[3]; }
    auto compute = [&](int blk, int buf) {
        const int wq = blk >> 5, jb = blk & 31;
        const bool act0 = (pick4(ua0, ua1, ua2, ua3, wq) >> jb) & 1u, act1 = (pick4(ub0, ub1, ub2, ub3, wq) >> jb) & 1u;
        if (act0 || act1) {
            const unsigned char* kb_ = lds + buf * 16384;
            const bool need_mask = (blk == cur) || (blk * 64 <= lowmax);
            const bool cs0 = cm ? (((cm[tokl * 4 + wq] >> jb) & 1u) != 0u) : true;
            const bool cs1 = cm ? (((cm[(4 + tokl) * 4 + wq] >> jb) & 1u) != 0u) : true;
            const bool lazy = !need_mask && !__any((act0 && m[0] < -1e29f) || (act1 && m[1] < -1e29f));
            f32x4 st0[4], st1[4];
            {
                bf16x8 kf[8];
#pragma unroll
                for (int kt = 0; kt < 4; ++kt)
#pragma unroll
                    for (int s2 = 0; s2 < 2; ++s2) {
                        const int row = 16 * kt + cidx, ch = 4 * s2 + q4;
                        kf[2 * kt + s2] = *(const bf16x8*)(kb_ + row * 128 + ((ch ^ (row & 7)) << 4));
                    }
                if (act0) qk_tile(kf, qf[0][0], qf[0][1], lazy ? (cs0 ? -m[0] : -1e30f) : 0.f, st0);
                if (act1) qk_tile(kf, qf[1][0], qf[1][1], lazy ? (cs1 ? -m[1] : -1e30f) : 0.f, st1);
            }
            __builtin_amdgcn_sched_barrier(0);
            bf16x8 vf[8];
#pragma unroll
            for (int kb = 0; kb < 2; ++kb)
#pragma unroll
                for (int mt = 0; mt < 4; ++mt) {
                    const int row = 16 * mt + cidx, ch = 4 * kb + q4;
                    vf[kb * 4 + mt] = *(const bf16x8*)(kb_ + 8192 + row * 128 + ((ch ^ (row & 7)) << 4));
                }
            if (lazy) {
                if (act0) softmax_pv_lazy(st0, vf, m[0], l[0], L[0], O[0]);
                if (act1) softmax_pv_lazy(st1, vf, m[1], l[1], L[1], O[1]);
            } else {
                if (act0) softmax_pv_tile(need_mask, st0, vf, blk * 64, tcol[0], lowc[0], cs0, m[0], l[0], L[0], O[0], q4);
                if (act1) softmax_pv_tile(need_mask, st1, vf, blk * 64, tcol[1], lowc[1], cs1, m[1], l[1], L[1], O[1], q4);
            }
        }
    };
    int b0 = advance();
    if (b0 < 0) return;
    int b1 = advance();
    NSA_GLOAD(r0, b0);
    if (b1 >= 0) NSA_GLOAD(r1, b1);
    NSA_LWRITE(r0, 0);
    __syncthreads();
#pragma unroll 1
    while (b0 >= 0) {
        const int b2 = (b1 >= 0) ? advance() : -1;
        if (b2 >= 0) NSA_GLOAD(r0, b2);
        compute(b0, 0);
        if (b1 >= 0) NSA_LWRITE(r1, 1);
        __syncthreads();
        if (b1 < 0) break;
        const int b3 = (b2 >= 0) ? advance() : -1;
        if (b3 >= 0) NSA_GLOAD(r1, b3);
        compute(b1, 1);
        if (b2 >= 0) NSA_LWRITE(r0, 0);
        __syncthreads();
        b0 = b2; b1 = b3;
    }
#undef NSA_GLOAD
#undef NSA_LWRITE
}

DEV void nsa_block_task(const Params& p, int task, unsigned char* lds) {
    const int wave = TID() >> 6;
    float* wl = (float*)(lds + 32768) + wave * 2112;
    unsigned* bm = (unsigned*)(lds + 32768 + 4 * 8448);
    float* impA = wl; float* impB = wl + 1024; unsigned* selmask = (unsigned*)(wl + 1024 + 1056);
    unsigned char* ws = p.ws;
    const u16* Q = (const u16*)(ws + OFF_Q);
    const u16* KVb = (const u16*)(ws + OFF_KV);
    const u16 *KSEL = KVb + (size_t)2 * 4194304, *VSELT = KVb + (size_t)3 * 4194304, *KWIN = KVb + (size_t)4 * 4194304, *VWINT = KVb + (size_t)5 * 4194304;
    const u16* KC = (const u16*)(ws + OFF_KC); const u16* VCT = (const u16*)(ws + OFF_VCT);
    const float* GATE = (const float*)(ws + OFF_GATE);
    u16* mix = (u16*)(ws + OFF_MIX);
    const int lane = TID() & 63, q4 = lane >> 4, cidx = lane & 15;
    const int bg = task & 7, t0b = (255 - (task >> 3)) * 32, t0 = t0b + 8 * wave; const int b = bg >> 1, g = bg & 1;
    const int tokl = cidx >> 2, hr = cidx & 3; const int head = g * 4 + hr;
    const int cur = t0 >> 6;
    int tcol[2], rowc[2]; bf16x8 qf[2][2];
#pragma unroll
    for (int ti = 0; ti < 2; ++ti) {
        tcol[ti] = t0 + 4 * ti + tokl; rowc[ti] = b * 8192 + tcol[ti];
        qf[ti][0] = ld8(Q + (size_t)rowc[ti] * 512 + head * 64 + 8 * q4); qf[ti][1] = ld8(Q + (size_t)rowc[ti] * 512 + head * 64 + 32 + 8 * q4);
    }
    f32x4 Oc[2][4];
    {
        int cnt_col[2];
#pragma unroll
        for (int ti = 0; ti < 2; ++ti) cnt_col[ti] = tcol[ti] >= 31 ? ((tcol[ti] - 31) >> 4) + 1 : 0;
        const int tmax = t0 + 7; const int cmax = tmax >= 31 ? ((tmax - 31) >> 4) + 1 : 0;
        const int ntile = (cmax + 15) >> 4;
        const u16* kcb = KC + (size_t)bg * 512 * 64;
        float ml[2] = {-1e30f, -1e30f}, ll[2] = {0.f, 0.f};
#pragma unroll 1
        for (int kt = 0; kt < ntile; ++kt) {
            const u16* kp = kcb + (kt * 16 + cidx) * 64 + 8 * q4;
            const bf16x8 k0 = ld8(kp), k1 = ld8(kp + 32);
#pragma unroll
            for (int ti = 0; ti < 2; ++ti) {
                f32x4 st = mfma16(k0, qf[ti][0], (f32x4){0.f, 0.f, 0.f, 0.f});
                st = mfma16(k1, qf[ti][1], st);
                float sv[4]; float tm = -1e30f;
#pragma unroll
                for (int r = 0; r < 4; ++r) { const int n = kt * 16 + 4 * q4 + r; sv[r] = (n < cnt_col[ti]) ? st[r] : -1e30f; tm = fmaxf(tm, sv[r]); }
                const float mn = fmaxf(ml[ti], tm);
                float ps = 0.f;
#pragma unroll
                for (int r = 0; r < 4; ++r) ps += (sv[r] > -1e29f) ? ex2(sv[r] - mn) : 0.f;
                ll[ti] = ll[ti] * ex2(ml[ti] - mn) + ps; ml[ti] = mn;
            }
        }
        float mfin[2], inv[2];
#pragma unroll
        for (int ti = 0; ti < 2; ++ti) {
            mfin[ti] = colmax(ml[ti]);
            const float lsum = colsum(ll[ti] * ex2(ml[ti] - mfin[ti]));
            inv[ti] = (cnt_col[ti] > 0) ? 1.f / lsum : 0.f;
        }
#pragma unroll
        for (int ti = 0; ti < 2; ++ti)
#pragma unroll
            for (int mt = 0; mt < 4; ++mt) Oc[ti][mt] = (f32x4){0.f, 0.f, 0.f, 0.f};
        const int npair = (ntile + 1) >> 1;
#pragma unroll 1
        for (int kp2 = 0; kp2 < npair; ++kp2) {
            const int n0 = kp2 * 32;
            const u16* kp = kcb + (n0 + cidx) * 64 + 8 * q4;
            const bf16x8 ka0 = ld8(kp), ka1 = ld8(kp + 32), kb0 = ld8(kp + 1024), kb1 = ld8(kp + 1024 + 32);
            bf16x8 vf[4];
#pragma unroll
            for (int mt = 0; mt < 4; ++mt) vf[mt] = ld8(VCT + ((size_t)bg * 64 + 16 * mt + cidx) * 512 + n0 + 8 * q4);
#pragma unroll
            for (int ti = 0; ti < 2; ++ti) {
                float pa[4], pb_[4];
                f32x4 st = mfma16(ka0, qf[ti][0], (f32x4){0.f, 0.f, 0.f, 0.f});
                st = mfma16(ka1, qf[ti][1], st);
                f32x4 su = mfma16(kb0, qf[ti][0], (f32x4){0.f, 0.f, 0.f, 0.f});
                su = mfma16(kb1, qf[ti][1], su);
#pragma unroll
                for (int r = 0; r < 4; ++r) {
                    const int n = n0 + 4 * q4 + r;
                    pa[r] = (n < cnt_col[ti]) ? ex2(st[r] - mfin[ti]) * inv[ti] : 0.f;
                    pb_[r] = (n + 16 < cnt_col[ti]) ? ex2(su[r] - mfin[ti]) * inv[ti] : 0.f;
                }
                const float owna = quadsum(pa[0] + pa[1] + pa[2] + pa[3]), tha = quadsum(pa[3]);
                const float ownb = quadsum(pb_[0] + pb_[1] + pb_[2] + pb_[3]), thb = quadsum(pb_[3]);
                if (hr == 0) {
                    const int tk = 4 * ti + tokl;
                    const int sa = (n0 >> 2) + q4, sb2 = ((n0 + 16) >> 2) + q4;
                    impA[tk * 128 + sa] = owna; impB[tk * 132 + sa + 1] = tha;
                    impA[tk * 128 + sb2] = ownb; impB[tk * 132 + sb2 + 1] = thb;
                }
                union { bf16x8 v; unsigned u[4]; } pk;
                pk.u[0] = pack2(pa[0], pa[1]); pk.u[1] = pack2(pa[2], pa[3]); pk.u[2] = pack2(pb_[0], pb_[1]); pk.u[3] = pack2(pb_[2], pb_[3]);
#pragma unroll
                for (int mt = 0; mt < 4; ++mt) Oc[ti][mt] = mfma16(vf[mt], pk.v, Oc[ti][mt]);
            }
        }
#pragma unroll
        for (int ti = 0; ti < 2; ++ti) {
            const float gc = GATE[(size_t)rowc[ti] * 24 + head];
#pragma unroll
            for (int mt = 0; mt < 4; ++mt)
#pragma unroll
                for (int r = 0; r < 4; ++r) Oc[ti][mt][r] *= gc;
        }
    }
    lds_fence();
#pragma unroll 1
    for (int rd = 0; rd < 2; ++rd) {
        const int tk = 4 * rd + q4;
        unsigned m0 = 0u, m1 = 0u, m2 = 0u, m3 = 0u;
        if (cur < 16) { m0 = (2u << cur) - 1u; }
        else {
            unsigned key[8];
#pragma unroll
            for (int i = 0; i < 8; ++i) {
                const int sblk = cidx + 16 * i;
                const bool cand = (sblk >= 1) && (sblk <= cur - 2);
                const float v = impA[tk * 128 + sblk] + impB[tk * 132 + sblk];
                key[i] = cand ? ((__float_as_uint(v) & ~0x7Fu) | (unsigned)(127 - sblk)) : 0u;
            }
            int mysel = (cidx == 0) ? 0 : (cidx == 1 ? cur - 1 : (cidx == 2 ? cur : -1));
#pragma unroll 1
            for (int it = 0; it < 13; ++it) {
                unsigned mx = key[0];
#pragma unroll
                for (int i = 1; i < 8; ++i) mx = max(mx, key[i]);
                mx = max(mx, dppu<0xB1>(mx)); mx = max(mx, dppu<0x4E>(mx)); mx = max(mx, dppu<0x124>(mx)); mx = max(mx, dppu<0x128>(mx));
                const int sblk = 127 - (int)(mx & 127u);
#pragma unroll
                for (int i = 0; i < 8; ++i) key[i] = (key[i] == mx) ? 0u : key[i];
                if (cidx == it + 3) mysel = sblk;
            }
            const unsigned bit = 1u << (mysel & 31); const int wsel = mysel >> 5;
            m0 = row_or(wsel == 0 ? bit : 0u); m1 = row_or(wsel == 1 ? bit : 0u); m2 = row_or(wsel == 2 ? bit : 0u); m3 = row_or(wsel == 3 ? bit : 0u);
        }
        if (cidx < 4) selmask[tk * 4 + cidx] = (cidx == 0) ? m0 : (cidx == 1 ? m1 : (cidx == 2 ? m2 : m3));
    }
    lds_fence();
    f32x4* accl = (f32x4*)wl;
#pragma unroll
    for (int ti = 0; ti < 2; ++ti)
#pragma unroll
        for (int mt = 0; mt < 4; ++mt) accl[(ti * 4 + mt) * 64 + lane] = Oc[ti][mt];
    {
        float m[2] = {-1e30f, -1e30f}, l[2] = {0.f, 0.f}; f32x4 Os[2][4]; f32x4 Ls[2] = {(f32x4){0.f, 0.f, 0.f, 0.f}, (f32x4){0.f, 0.f, 0.f, 0.f}};
#pragma unroll
        for (int ti = 0; ti < 2; ++ti)
#pragma unroll
            for (int mt = 0; mt < 4; ++mt) Os[ti][mt] = (f32x4){0.f, 0.f, 0.f, 0.f};
        {
            unsigned ua[4], ub[4], bu[4];
#pragma unroll
            for (int w = 0; w < 4; ++w) {
                ua[w] = __builtin_amdgcn_readfirstlane(row_or(selmask[tokl * 4 + w]));
                ub[w] = __builtin_amdgcn_readfirstlane(row_or(selmask[(4 + tokl) * 4 + w]));
            }
            if (lane < 4) bm[wave * 4 + lane] = (lane == 0) ? (ua[0] | ub[0]) : (lane == 1 ? (ua[1] | ub[1]) : (lane == 2 ? (ua[2] | ub[2]) : (ua[3] | ub[3])));
            __syncthreads();
#pragma unroll
            for (int w = 0; w < 4; ++w) bu[w] = __builtin_amdgcn_readfirstlane(bm[w] | bm[4 + w] | bm[8 + w] | bm[12 + w]);
            const int lowc[2] = {-1, -1};
            nsa_branch_lds(lds, KSEL + (size_t)bg * 8192 * 64, VSELT + (size_t)bg * 64 * 8192, bu[0], bu[1], bu[2], bu[3], ua[0], ua[1], ua[2], ua[3], ub[0],
                           ub[1], ub[2], ub[3], selmask, tokl, tcol, lowc, qf, m, l, Ls, Os, q4, cidx, cur, -1);
        }
#pragma unroll
        for (int ti = 0; ti < 2; ++ti) {
            const float sc = GATE[(size_t)rowc[ti] * 24 + 8 + head] / (colsum(l[ti]) + Ls[ti][0]);
#pragma unroll
            for (int mt = 0; mt < 4; ++mt)
#pragma unroll
                for (int r = 0; r < 4; ++r) Os[ti][mt][r] *= sc;
        }
        lds_fence();
#pragma unroll
        for (int ti = 0; ti < 2; ++ti)
#pragma unroll
            for (int mt = 0; mt < 4; ++mt) { f32x4 a = accl[(ti * 4 + mt) * 64 + lane]; a += Os[ti][mt]; accl[(ti * 4 + mt) * 64 + lane] = a; }
    }
    {
        float m[2] = {-1e30f, -1e30f}, l[2] = {0.f, 0.f}; f32x4 Ow[2][4]; f32x4 Ls[2] = {(f32x4){0.f, 0.f, 0.f, 0.f}, (f32x4){0.f, 0.f, 0.f, 0.f}};
#pragma unroll
        for (int ti = 0; ti < 2; ++ti)
#pragma unroll
            for (int mt = 0; mt < 4; ++mt) Ow[ti][mt] = (f32x4){0.f, 0.f, 0.f, 0.f};
        int wb0 = (t0 - 511) >> 6; if (wb0 < 0) wb0 = 0;
        int wbb = (t0b - 511) >> 6; if (wbb < 0) wbb = 0;
        {
            unsigned uw[4], bu[4];
#pragma unroll
            for (int w = 0; w < 4; ++w) {
                const int hi = cur - 32 * w;
                unsigned mk = 0u, mkb = 0u;
                if (hi >= 0) {
                    const unsigned upper = (hi >= 31) ? 0xffffffffu : ((2u << hi) - 1u);
                    const int lo = wb0 - 32 * w, lob = wbb - 32 * w;
                    if (lo <= 31) mk = upper & ~((lo <= 0) ? 0u : ((1u << lo) - 1u));
                    if (lob <= 31) mkb = upper & ~((lob <= 0) ? 0u : ((1u << lob) - 1u));
                }
                uw[w] = mk; bu[w] = mkb;
            }
            const int lowc[2] = {tcol[0] - 512, tcol[1] - 512};
            nsa_branch_lds(lds, KWIN + (size_t)bg * 8192 * 64, VWINT + (size_t)bg * 64 * 8192, bu[0], bu[1], bu[2], bu[3], uw[0], uw[1], uw[2], uw[3], uw[0],
                           uw[1], uw[2], uw[3], nullptr, tokl, tcol, lowc, qf, m, l, Ls, Ow, q4, cidx, cur, t0 + 7 - 512);
        }
#pragma unroll
        for (int ti = 0; ti < 2; ++ti) {
            const float sc = GATE[(size_t)rowc[ti] * 24 + 16 + head] / (colsum(l[ti]) + Ls[ti][0]);
#pragma unroll
            for (int mt = 0; mt < 4; ++mt)
#pragma unroll
                for (int r = 0; r < 4; ++r) Ow[ti][mt][r] *= sc;
        }
        lds_fence();
#pragma unroll
        for (int ti = 0; ti < 2; ++ti)
#pragma unroll
            for (int mt = 0; mt < 4; ++mt) {
                const f32x4 a = accl[(ti * 4 + mt) * 64 + lane];
                const f32x4 o = Ow[ti][mt];
                u32x2 wv; wv[0] = pack2(a[0] + o[0], a[1] + o[1]); wv[1] = pack2(a[2] + o[2], a[3] + o[3]);
                *(u32x2*)(mix + (size_t)rowc[ti] * 1024 + 512 + head * 64 + 16 * mt + 4 * q4) = wv;
            }
    }


    __syncthreads();
}

template <int N> DEV void ltmask(const float (&v)[N], float x, unsigned (&mk)[N / 32]) {
#pragma unroll
    for (int w = 0; w < N / 32; ++w) {
        unsigned a0 = 0u, a1 = 0u, a2 = 0u, a3 = 0u;
#pragma unroll
        for (int i = 0; i < 8; ++i) {
            a0 = __builtin_amdgcn_alignbit(a0, __float_as_uint(v[w * 32 + i] - x), 31);
            a1 = __builtin_amdgcn_alignbit(a1, __float_as_uint(v[w * 32 + 8 + i] - x), 31);
            a2 = __builtin_amdgcn_alignbit(a2, __float_as_uint(v[w * 32 + 16 + i] - x), 31);
            a3 = __builtin_amdgcn_alignbit(a3, __float_as_uint(v[w * 32 + 24 + i] - x), 31);
        }
        mk[w] = (a0 << 24) | (a1 << 16) | (a2 << 8) | a3;
    }
}
template <int N> DEV int count_ge(const float (&v)[N], float x) {
    unsigned mk[N / 32]; ltmask<N>(v, x, mk);
    int lt = 0;
#pragma unroll
    for (int w = 0; w < N / 32; ++w) lt += __popc(mk[w]);
    return colsumi(N - lt);
}
template <int N> DEV void refine16(const float (&v)[N], float lo, int clo, float hi, int chi, float& lo_o, float& hi_o) {
    bool done = false;
    if (clo == 16) { hi = lo; done = true; }
#pragma unroll 1
    for (int it = 0; it < 200; ++it) {
        if (__all(done)) break;
        float f = 0.5f;
        if (!(it & 1)) { f = ((float)clo - 15.5f) / (float)(clo - chi); f = fminf(fmaxf(f, 0.04f), 0.96f); }
        const float mid = lo + (hi - lo) * f;
        const bool stuck = !(mid > lo && mid < hi);
        const int c = count_ge<N>(v, mid);
        if (!done) {
            if (stuck) { if (f != 0.5f) {   } else done = true; }
            else if (c == 16) { lo = mid; hi = mid; done = true; }
            else if (c > 16) { lo = mid; clo = c; }
            else { hi = mid; chi = c; }
        }
    }
    lo_o = lo; hi_o = hi;
}
template <int N> DEV void select16(const float (&v)[N], float& lo_o, float& hi_o) {
    float mx = v[0], sm = v[0];
#pragma unroll
    for (int i = 1; i < N; ++i) { mx = fmaxf(mx, v[i]); sm += v[i]; }
    mx = colmax(mx); sm = colsum(sm);
    const float hi = mx + fabsf(mx) * 1e-6f + 1e-30f;
    float lo = sm * (1.f / (4.f * N));
    int clo = count_ge<N>(v, lo);
    if (__any(clo < 16)) {
        float mn = v[0];
#pragma unroll
        for (int i = 1; i < N; ++i) mn = fminf(mn, v[i]);
        mn = -colmax(-mn);
        if (clo < 16) { lo = mn; clo = 4 * N; }
    }
    refine16<N>(v, lo, clo, hi, 0, lo_o, hi_o);
}
DEV void col_offsets(int cntA, int cntT, int q4, int cidx, int& offA, int& offT) {
    const int g0 = __shfl(cntA, cidx), g1 = __shfl(cntA, cidx + 16), g2 = __shfl(cntA, cidx + 32), g3 = __shfl(cntA, cidx + 48);
    const int e0 = __shfl(cntT, cidx), e1 = __shfl(cntT, cidx + 16), e2 = __shfl(cntT, cidx + 32);
    offA = (q4 > 0 ? g0 : 0) + (q4 > 1 ? g1 : 0) + (q4 > 2 ? g2 : 0);
    offT = g0 + g1 + g2 + g3 + (q4 > 0 ? e0 : 0) + (q4 > 1 ? e1 : 0) + (q4 > 2 ? e2 : 0);
}

DEV void peer_topk_task2(const Params& p, int l, int task, float* wl) {
    unsigned char* ws = p.ws;
    const u16* QP = (const u16*)(ws + OFF_QP);
    const u16* K12 = (const u16*)(ws + OFF_K12) + (size_t)l * 2 * 16384;
    const int lane = TID() & 63, q4 = lane >> 4, cidx = lane & 15;
    const int tq = task * 2 + (cidx >> 3), hh = cidx & 7;
    float* scl = wl;
    float* lst = wl + 2048;
    float* vv[2] = {lst, lst + 512}; int* ii[2] = {(int*)(lst + 256), (int*)(lst + 768)};
    float* fs = lst + 1024; int* fi = (int*)(lst + 1280);
#pragma unroll 1
    for (int hf = 0; hf < 2; ++hf) {
        bf16x8 qf[4];
#pragma unroll
        for (int s2 = 0; s2 < 4; ++s2) qf[s2] = ld8(QP + (size_t)tq * 2048 + hh * 256 + hf * 128 + 32 * s2 + 8 * q4);
        float sc[32];
        const u16* kb = K12 + hf * 16384;
#pragma unroll
        for (int kt = 0; kt < 8; ++kt) {
            f32x4 st = (f32x4){0.f, 0.f, 0.f, 0.f};
#pragma unroll
            for (int s2 = 0; s2 < 4; ++s2) st = mfma16(ld8(kb + (kt * 16 + cidx) * 128 + 32 * s2 + 8 * q4), qf[s2], st);
#pragma unroll
            for (int r = 0; r < 4; ++r) sc[kt * 4 + r] = st[r];
            *(f32x4*)(scl + cidx * 128 + 16 * kt + 4 * q4) = st;
        }
        float lo, hi; select16<32>(sc, lo, hi);
        unsigned mh[1], ml_[1];
        ltmask<32>(sc, hi, mh);
        if (__all(lo == hi)) ml_[0] = mh[0]; else ltmask<32>(sc, lo, ml_);
        unsigned mA = ~mh[0], mT = ~ml_[0] & mh[0];
        int offA, offT; col_offsets(__popc(mA), __popc(mT), q4, cidx, offA, offT);
        float* vo = hf ? vv[1] : vv[0]; int* io = hf ? ii[1] : ii[0];
        lds_fence();
        while (__any(mA != 0u)) {
            if (mA) {
                const int i = __clz(mA); mA &= ~(0x80000000u >> i);
                const int n = 16 * (i >> 2) + 4 * q4 + (i & 3);
                vo[cidx * 16 + offA] = scl[cidx * 128 + n]; io[cidx * 16 + offA] = n; ++offA;
            }
        }
        while (__any(mT != 0u)) {
            if (mT) {
                const int i = __clz(mT); mT &= ~(0x80000000u >> i);
                const int n = 16 * (i >> 2) + 4 * q4 + (i & 3);
                if (offT < 16) { vo[cidx * 16 + offT] = scl[cidx * 128 + n]; io[cidx * 16 + offT] = n; }
                ++offT;
            }
        }
        lds_fence();
    }
    {
        float cand[64];
        float v2r[16];
#pragma unroll
        for (int j = 0; j < 16; ++j) v2r[j] = vv[1][cidx * 16 + j];
#pragma unroll
        for (int a = 0; a < 4; ++a) {
            const float v1a = vv[0][cidx * 16 + 4 * q4 + a];
#pragma unroll
            for (int j = 0; j < 16; ++j) cand[a * 16 + j] = v1a + v2r[j];
        }
        float lo, hi;
        {
            float v2mx = v2r[0], v2mn = v2r[0];
#pragma unroll
            for (int j = 1; j < 16; ++j) { v2mx = fmaxf(v2mx, v2r[j]); v2mn = fminf(v2mn, v2r[j]); }
            float v1mx = fmaxf(fmaxf(vv[0][cidx * 16 + 4 * q4], vv[0][cidx * 16 + 4 * q4 + 1]), fmaxf(vv[0][cidx * 16 + 4 * q4 + 2], vv[0][cidx * 16 + 4 * q4 + 3]));
            float v1mn = fminf(fminf(vv[0][cidx * 16 + 4 * q4], vv[0][cidx * 16 + 4 * q4 + 1]), fminf(vv[0][cidx * 16 + 4 * q4 + 2], vv[0][cidx * 16 + 4 * q4 + 3]));
            v1mx = colmax(v1mx); v1mn = -colmax(-v1mn);
            const float smax = v1mx + v2mx;
            const float hi0 = smax + fabsf(smax) * 1e-6f + 1e-30f;
            const float lo0 = fmaxf(v1mn + v2mx, v1mx + v2mn);
            const int c0 = count_ge<64>(cand, lo0);
            refine16<64>(cand, lo0, c0, hi0, 0, lo, hi);
        }
        unsigned mh[2], ml_[2];
        ltmask<64>(cand, hi, mh);
        if (__all(lo == hi)) { ml_[0] = mh[0]; ml_[1] = mh[1]; } else ltmask<64>(cand, lo, ml_);
        unsigned mA0 = ~mh[0], mA1 = ~mh[1], mT0 = ~ml_[0] & mh[0], mT1 = ~ml_[1] & mh[1];
        int offA, offT; col_offsets(__popc(mA0) + __popc(mA1), __popc(mT0) + __popc(mT1), q4, cidx, offA, offT);
#pragma unroll
        for (int w = 0; w < 2; ++w) {
            unsigned mA = w ? mA1 : mA0;
            while (__any(mA != 0u)) {
                if (mA) {
                    const int i = __clz(mA); mA &= ~(0x80000000u >> i);
                    const int it = w * 32 + i; const int ci = (4 * q4 + (it >> 4)) * 16 + (it & 15);
                    fs[cidx * 16 + offA] = vv[0][cidx * 16 + (ci >> 4)] + vv[1][cidx * 16 + (ci & 15)]; fi[cidx * 16 + offA] = ci; ++offA;
                }
            }
        }
#pragma unroll
        for (int w = 0; w < 2; ++w) {
            unsigned mT = w ? mT1 : mT0;
            while (__any(mT != 0u)) {
                if (mT) {
                    const int i = __clz(mT); mT &= ~(0x80000000u >> i);
                    const int it = w * 32 + i; const int ci = (4 * q4 + (it >> 4)) * 16 + (it & 15);
                    if (offT < 16) { fs[cidx * 16 + offT] = vv[0][cidx * 16 + (ci >> 4)] + vv[1][cidx * 16 + (ci & 15)]; fi[cidx * 16 + offT] = ci; }
                    ++offT;
                }
            }
        }
    }
    lds_fence();
    {
        float s4[4]; int c4[4];
#pragma unroll
        for (int k = 0; k < 4; ++k) { s4[k] = fs[cidx * 16 + 4 * q4 + k]; c4[k] = fi[cidx * 16 + 4 * q4 + k]; }
        float mx = fmaxf(fmaxf(s4[0], s4[1]), fmaxf(s4[2], s4[3]));
        mx = colmax(mx);
        float e4[4]; float sm = 0.f;
#pragma unroll
        for (int k = 0; k < 4; ++k) { e4[k] = __expf(s4[k] - mx); sm += e4[k]; }
        sm = colsum(sm);
        const float inv = 1.f / sm;
        int4 eo; float4 go;
        eo.x = ii[0][cidx * 16 + (c4[0] >> 4)] * 128 + ii[1][cidx * 16 + (c4[0] & 15)];
        eo.y = ii[0][cidx * 16 + (c4[1] >> 4)] * 128 + ii[1][cidx * 16 + (c4[1] & 15)];
        eo.z = ii[0][cidx * 16 + (c4[2] >> 4)] * 128 + ii[1][cidx * 16 + (c4[2] & 15)];
        eo.w = ii[0][cidx * 16 + (c4[3] >> 4)] * 128 + ii[1][cidx * 16 + (c4[3] & 15)];
        go.x = e4[0] * inv; go.y = e4[1] * inv; go.z = e4[2] * inv; go.w = e4[3] * inv;
        int* eol = (int*)(wl + 3584); float* gol = wl + 3584 + 256;
        *(int4*)(eol + cidx * 16 + 4 * q4) = eo; *(float4*)(gol + cidx * 16 + 4 * q4) = go;
    }
    lds_fence();
}

DEV float gelu_exact(float x) { return 0.5f * x * (1.f + erff(x * 0.70710678118654752f)); }
DEV void unpack8(const bf16x8 v, float* f) {
    union { bf16x8 v; unsigned u[4]; } c; c.v = v;
#pragma unroll
    for (int i = 0; i < 4; ++i) { f[2 * i] = bflo(c.u[i]); f[2 * i + 1] = bfhi(c.u[i]); }
}
DEV void peer_experts_token(const Params& p, int l, int tok, const int* el_src, const float* w_src) {
    unsigned char* ws = p.ws;
    const u16* H = (const u16*)(ws + OFF_H);
    u16* Hw = (u16*)(ws + OFF_H);
    const unsigned char* U8 = ws + OFF_U8;
    const unsigned char* V8 = ws + OFF_U8 + 16 * MiB;
    const float* SU = (const float*)(ws + OFF_UVS);
    const float* SV = (const float*)(ws + OFF_UVS) + 16384;
    const float* mod = (const float*)(ws + OFF_MOD);
    const float* g2 = mod + l * 4 * 6144 + 5 * 1024;
    const int lane = TID() & 63;
    {
        const int b = tok >> 13;
        float acc[16];
#pragma unroll
        for (int i = 0; i < 16; ++i) acc[i] = 0.f;
#if EN_PEER
        unsigned hp[4]; float shq; int corr0;
        {
            float hx[16];
            unpack8(ld8(H + (size_t)tok * 1024 + 16 * lane), hx);
            unpack8(ld8(H + (size_t)tok * 1024 + 16 * lane + 8), hx + 8);
            float amax = 0.f;
#pragma unroll
            for (int i = 0; i < 16; ++i) amax = fmaxf(amax, fabsf(hx[i]));
            amax = wave_max(amax);
            shq = amax > 0.f ? amax * (1.f / 127.f) : 1.f;
            const float inv = 1.f / shq;
            int hsum = 0;
#pragma unroll
            for (int i = 0; i < 4; ++i) {
                const int a = __float2int_rn(hx[4 * i] * inv) + 128, b2 = __float2int_rn(hx[4 * i + 1] * inv) + 128, c = __float2int_rn(hx[4 * i + 2] * inv) + 128,
                          d = __float2int_rn(hx[4 * i + 3] * inv) + 128;
                hp[i] = (unsigned)a | ((unsigned)b2 << 8) | ((unsigned)c << 16) | ((unsigned)d << 24);
                hsum += a + b2 + c + d;
            }
            hsum = wave_sum_i(hsum);
            corr0 = 128 * 128 * 1024 - 128 * hsum;
        }
        const int* RSU = (const int*)(ws + OFF_UVS) + 2 * 16384;
        float corr = 0.f;
        u32x4 uqA[8], vqA[8], uqB[8], vqB[8];
#define PEER_LOAD(UQ, VQ, G_) { const int el_ = el_src[((G_) >> 1) * 16 + (lane & 15)]; const int k0_ = ((G_) & 1) * 8; _Pragma("unroll") for (int k = 0; k < 8; ++k) { \
            const int e = __builtin_amdgcn_readlane(el_, k0_ + k); UQ[k] = *(const u32x4*)(U8 + (size_t)e * 1024 + 16 * lane); VQ[k] = *(const u32x4*)(V8 + (size_t)e * 1024 + 16 * lane); } }
#define PEER_EVAL(UQ, VQ, G_) { const int hh_ = (G_) >> 1, k0_ = ((G_) & 1) * 8; const int el = el_src[hh_ * 16 + (lane & 15)]; const float wgt = w_src[hh_ * 16 + (lane & 15)]; \
            const float sul = SU[el] * shq, wsl = wgt * SV[el]; const int rsl = corr0 - 128 * RSU[el]; \
            int dpart[8]; _Pragma("unroll") for (int k = 0; k < 8; ++k) { unsigned di = 0u; _Pragma("unroll") for (int i = 0; i < 4; ++i) di = __builtin_amdgcn_udot4(UQ[k][i], hp[i], di, false); dpart[k] = (int)di; } \
            const int dsum = reduce8_i(dpart); const int srcl = k0_ + (lane >> 3); \
            const float sul_e = __shfl(sul, srcl), wsl_e = __shfl(wsl, srcl); const int rsl_e = __shfl(rsl, srcl); \
            const float actl = gelu_exact((float)(dsum + rsl_e) * sul_e) * wsl_e; \
            _Pragma("unroll") for (int k = 0; k < 8; ++k) { const float act = __int_as_float(__builtin_amdgcn_readlane(__float_as_int(actl), 8 * k)); corr += act * 128.f; \
                _Pragma("unroll") for (int i = 0; i < 4; ++i) { const unsigned w = VQ[k][i]; \
                    acc[4 * i] += act * (float)(w & 0xffu); acc[4 * i + 1] += act * (float)((w >> 8) & 0xffu); acc[4 * i + 2] += act * (float)((w >> 16) & 0xffu); acc[4 * i + 3] += act * (float)(w >> 24); } } }
        PEER_LOAD(uqA, vqA, 0);
#pragma unroll 1
        for (int g = 0; g < 16; g += 2) {
            PEER_LOAD(uqB, vqB, g + 1);
            PEER_EVAL(uqA, vqA, g);
            if (g + 2 < 16) PEER_LOAD(uqA, vqA, g + 2);
            PEER_EVAL(uqB, vqB, g + 1);
        }
#undef PEER_LOAD
#undef PEER_EVAL
#pragma unroll
        for (int i = 0; i < 16; ++i) acc[i] -= corr;
#endif
        const int k = 16 * lane;
        float xn[16]; float ss = 0.f;
#pragma unroll
        for (int i = 0; i < 4; ++i) {
            const float4 x0 = *(const float4*)(p.out + (size_t)tok * 1024 + k + 4 * i);
            const float4 ga = *(const float4*)(g2 + b * 6144 + k + 4 * i);
            xn[4 * i] = x0.x + ga.x * acc[4 * i]; xn[4 * i + 1] = x0.y + ga.y * acc[4 * i + 1];
            xn[4 * i + 2] = x0.z + ga.z * acc[4 * i + 2]; xn[4 * i + 3] = x0.w + ga.w * acc[4 * i + 3];
        }
#pragma unroll
        for (int i = 0; i < 16; ++i) ss += xn[i] * xn[i];
        ss = wave_sum(ss);
        const float rs = rsqrtf(ss * (1.f / 1024.f) + 1e-6f);
        if (l == 0) {
            const float* n1g = p.in[I_N1G] + 1024; const float* sh = mod + 4 * 6144 + b * 6144; const float* sc = sh + 1024;
            float hv[16];
#pragma unroll
            for (int i = 0; i < 4; ++i) {
                *(float4*)(p.out + (size_t)tok * 1024 + k + 4 * i) = (float4){xn[4 * i], xn[4 * i + 1], xn[4 * i + 2], xn[4 * i + 3]};
                const float4 gg = *(const float4*)(n1g + k + 4 * i), s1 = *(const float4*)(sc + k + 4 * i), s0 = *(const float4*)(sh + k + 4 * i);
                hv[4 * i] = xn[4 * i] * rs * gg.x * (1.f + s1.x) + s0.x; hv[4 * i + 1] = xn[4 * i + 1] * rs * gg.y * (1.f + s1.y) + s0.y;
                hv[4 * i + 2] = xn[4 * i + 2] * rs * gg.z * (1.f + s1.z) + s0.z; hv[4 * i + 3] = xn[4 * i + 3] * rs * gg.w * (1.f + s1.w) + s0.w;
            }
            u32x4 w0, w1;
#pragma unroll
            for (int i = 0; i < 4; ++i) { w0[i] = pack2(hv[2 * i], hv[2 * i + 1]); w1[i] = pack2(hv[8 + 2 * i], hv[8 + 2 * i + 1]); }
            *(u32x4*)(Hw + (size_t)tok * 1024 + k) = w0; *(u32x4*)(Hw + (size_t)tok * 1024 + k + 8) = w1;
        } else {
            const float* fg = p.in[I_FG];
#pragma unroll
            for (int i = 0; i < 4; ++i) {
                const float4 gg = *(const float4*)(fg + k + 4 * i);
                *(float4*)(p.out + (size_t)tok * 1024 + k + 4 * i) = (float4){xn[4 * i] * rs * gg.x, xn[4 * i + 1] * rs * gg.y, xn[4 * i + 2] * rs * gg.z, xn[4 * i + 3] * rs * gg.w};
            }
        }
    }
}

constexpr int NPH = 20;

__global__ void __launch_bounds__(256, 2) mega(Params p) {
    __shared__ __attribute__((aligned(16))) unsigned char lds[81920 - 128];
    __shared__ int misc[8];
    int* qslot = misc;
    cg::grid_group grid = cg::this_grid();
    if (threadIdx.x < 8) misc[threadIdx.x] = 0;
    __syncthreads();
    XcdBarrier xbar = xcd_barrier_post((unsigned*)(p.ws + OFF_BAR), (volatile unsigned*)(misc + 4));
    unsigned char* ws = p.ws;
    const float* mod = (const float*)(ws + OFF_MOD);
    unsigned* ctl = (unsigned*)(ws + OFF_CTL);
    const int G = gridDim.x, bx = BID();
    for (int ph = p.ph_lo; ph < p.ph_hi; ++ph) {
        if (ph >= 2 && (ph - 2) % 9 == 8) continue;
        if (ph == 0) {
            phase_prep(p, lds);
        } else if (ph == 1) {
            phase_norm(p.in[I_X], p.in[I_N1G], mod + 0 * 1024, mod + 1 * 1024, (u16*)(ws + OFF_H));
        } else {
            const int l = (ph - 2) / 9, sp = (ph - 2) % 9;
            const float* modl = mod + l * 4 * 6144;
            if (sp == 0) {
                EpiInProj e{(u16*)(ws + OFF_PCONV), (u16*)(ws + OFF_PRWKV), (u16*)(ws + OFF_Q), (u16*)(ws + OFF_KV), (float*)(ws + OFF_GATE)};
                gemm_phase((const u16*)(ws + OFF_H), 1024, (const u16*)(ws + OFF_WIN) + (size_t)l * NINP * 1024, 1024, 256, 8, 1024, e, lds, bx, G, 0, 4);
            } else if (sp == 1) {
#if EN_RWKV
                for (;;) { const int t = block_next(ctl + QW(l, Q_RWP), qslot); if (t >= NTOK / 16) break; rwkv_prep_tile2(p, l, t, lds); }
#endif
            } else if (sp == 2) {
#if EN_RWKV
                if (bx < 64) { __builtin_amdgcn_s_setprio(3); rwkv_scan(p, bx, lds); __builtin_amdgcn_s_setprio(0); }
#endif
                unsigned* cdone = ctl + QW(l, 5);
                unsigned* gdone = ctl + QW(l, 6);
                if (bx >= 64) {
                    EpiInProj e{(u16*)(ws + OFF_PCONV), (u16*)(ws + OFF_PRWKV), (u16*)(ws + OFF_Q), (u16*)(ws + OFF_KV), (float*)(ws + OFF_GATE)};
                    gemm_phase((const u16*)(ws + OFF_H), 1024, (const u16*)(ws + OFF_WIN) + (size_t)l * NINP * 1024, 1024, 256, 15, 1024, e, lds, bx - 64, G - 64, 4, 8, false);
                    asm volatile("s_waitcnt vmcnt(0)" ::: "memory");
                    __syncthreads();
                    if (threadIdx.x == 0) {
                        __builtin_amdgcn_fence(__ATOMIC_RELEASE, "agent");
                        asm volatile("s_waitcnt vmcnt(0)" ::: "memory");
                        __hip_atomic_fetch_add(gdone, 1u, __ATOMIC_RELAXED, __HIP_MEMORY_SCOPE_AGENT);
                    }
                }
                __syncthreads();
                if (threadIdx.x == 0) {
                    unsigned sp_ = 0;
                    while (__hip_atomic_load(gdone, __ATOMIC_RELAXED, __HIP_MEMORY_SCOPE_AGENT) < (unsigned)(G - 64)) { __builtin_amdgcn_s_sleep(8); if (++sp_ > (1u << 24)) break; }
                    __builtin_amdgcn_fence(__ATOMIC_ACQUIRE, "agent");
                    asm volatile("s_waitcnt vmcnt(0)" ::: "memory");
                }
                __syncthreads();
                if (bx >= 64 && bx < 128) {
                    const u16* KVb = (const u16*)(ws + OFF_KV);
                    if (bx < 96) {
                        EpiCompress ek{(const float*)(ws + OFF_CBP) + (l * 2 + 0) * 2048, p.in[I_CKW2] + (size_t)l * 8192, (u16*)(ws + OFF_KC), 0, lds};
                        gemm_phase(KVb, 1024, (const u16*)(ws + OFF_CW1) + (size_t)(l * 2 + 0) * 128 * 2048, 2048, 32, 1, 2048, ek, lds, bx - 64, 1 << 20);
                    } else {
                        EpiCompress ev{(const float*)(ws + OFF_CBP) + (l * 2 + 1) * 2048, p.in[I_CVW2] + (size_t)l * 8192, (u16*)(ws + OFF_VCT), 1, lds};
                        gemm_phase(KVb + 4194304, 1024, (const u16*)(ws + OFF_CW1) + (size_t)(l * 2 + 1) * 128 * 2048, 2048, 32, 1, 2048, ev, lds, bx - 96, 1 << 20);
                    }
                    asm volatile("s_waitcnt vmcnt(0)" ::: "memory");
                    __syncthreads();
                    if (threadIdx.x == 0) {
                        __builtin_amdgcn_fence(__ATOMIC_RELEASE, "agent");
                        asm volatile("s_waitcnt vmcnt(0)" ::: "memory");
                        __hip_atomic_fetch_add(cdone, 1u, __ATOMIC_RELAXED, __HIP_MEMORY_SCOPE_AGENT);
                    }
                }
#if EN_CONV
                for (;;) { const int t = block_next(ctl + QW(l, Q_CONV), qslot); if (t >= NTOK / 32) break; conv_tile(p, l, t, lds); }
#else
                zero_mix_cols(p, 0, 256);
#endif
                __syncthreads();
                if (threadIdx.x == 0) {
                    unsigned sp_ = 0;
                    while (__hip_atomic_load(cdone, __ATOMIC_RELAXED, __HIP_MEMORY_SCOPE_AGENT) < 64u) { __builtin_amdgcn_s_sleep(8); if (++sp_ > (1u << 24)) break; }
                    __builtin_amdgcn_fence(__ATOMIC_ACQUIRE, "agent");
                    asm volatile("s_waitcnt vmcnt(0)" ::: "memory");
                }
                __syncthreads();
                for (int qi = 0; qi < 8; ++qi) {
                    const int bgq = (bx + qi) & 7;
                    for (;;) { const int t = block_next(ctl + QW(l, Q_NSA) + bgq, qslot); if (t >= 256) break; nsa_block_task(p, t * 8 + bgq, lds); }
                }
                if (l == 0) {
                    float* fl = (float*)lds;
                    for (;;) {
                        const int t = block_next(ctl + QW(0, 0), qslot); if (t >= 1536) break;
                        if (t < 512) { const int l2 = t >> 8, r = t & 255; transpose_tile(p.in[I_WOUT] + (size_t)l2 * 1024 * 1024, 1024, (u16*)(ws + OFF_WOUT) + (size_t)l2 * 1024 * 1024, 1024, r >> 4, r & 15, fl); }
                        else { const int u = t - 512; const int l2 = u >> 9, r = u & 511; transpose_tile(p.in[I_PWQ] + (size_t)l2 * 1024 * 2048, 2048, (u16*)(ws + OFF_WQ) + (size_t)l2 * 2048 * 1024, 1024, r >> 5, r & 31, fl); }
                    }
                }
                for (;;) {
                    const int t = block_next(ctl + QW(l, 7), qslot); if (t >= 1024) break;
                    const int tb = t >> 9, r0 = (t & 511) * 32;
                    convert_rows_task(p.in[tb ? I_PV : I_PU] + (size_t)l * 16384 * 1024, ws + OFF_U8 + (size_t)tb * 16 * MiB, (float*)(ws + OFF_UVS) + tb * 16384,
                                      tb ? nullptr : (int*)(ws + OFF_UVS) + 2 * 16384, r0);
                }
            } else if (sp == 3) {
#if EN_RWKV
                phase_rwkv_post(p, l);
#else
                zero_mix_cols(p, 256, 256);
#endif
            } else if (sp == 4) {
                EpiOutProj e{l == 0 ? p.in[I_X] : p.out, p.out, modl + 2 * 1024};
                gemm_phase((const u16*)(ws + OFF_MIX), 1024, (const u16*)(ws + OFF_WOUT) + (size_t)l * 1024 * 1024, 1024, 256, 8, 1024, e, lds, bx, G);
            } else if (sp == 5) {
#if EN_PEER
                phase_norm(p.out, p.in[I_N2G] + l * 1024, modl + 3 * 1024, modl + 4 * 1024, (u16*)(ws + OFF_H));
#endif
            } else if (sp == 6) {
#if EN_PEER
                EpiStoreBf16 e{(u16*)(ws + OFF_QP), 2048};
                gemm_phase((const u16*)(ws + OFF_H), 1024, (const u16*)(ws + OFF_WQ) + (size_t)l * 2048 * 1024, 1024, 256, 16, 1024, e, lds, bx, G);
#endif
            } else if (sp == 7) {
#if EN_PEER
                float* wl = (float*)lds + (TID() >> 6) * 4096;
                for (int t = bx * 4 + (TID() >> 6); t < NTOK / 2; t += G * 4) {
                    peer_topk_task2(p, l, t, wl);
                    peer_experts_token(p, l, 2 * t, (const int*)(wl + 3584), wl + 3584 + 256);
                    peer_experts_token(p, l, 2 * t + 1, (const int*)(wl + 3584) + 128, wl + 3584 + 256 + 128);
                    lds_fence();
                }
#endif
            }
        }
        if (ph + 1 < p.ph_hi) { if (p.ph_lo < 0) grid.sync(); else xcd_barrier(xbar); }
    }
}

extern "C" void kernel_launch(void* const* d_in, const int* in_sizes, int n_in, void* d_out, int out_size, void* d_ws, size_t ws_size,
                              hipStream_t stream) {
    static int grid_blocks = 0;
    if (!grid_blocks) {
        int dev = 0, cus = 0, per_cu = 0;
        hipGetDevice(&dev);
        hipDeviceGetAttribute(&cus, hipDeviceAttributeMultiprocessorCount, dev);
        hipOccupancyMaxActiveBlocksPerMultiprocessor(&per_cu, (const void*)mega, 256, 0);
        if (per_cu > 2) per_cu = 2;
        if (per_cu < 1) per_cu = 1;
        grid_blocks = cus * per_cu;
        if (ws_size < WS_NEED) fprintf(stderr, "kernel_launch: workspace too small: %zu < %zu\n", ws_size, (size_t)WS_NEED);
    }
    hipMemsetAsync((char*)d_ws + OFF_CTL, 0, CTL_ZERO_BYTES, stream);
    Params p{};
    for (int i = 0; i < 35; ++i) p.in[i] = (const float*)d_in[i];
    p.out = (float*)d_out;
    p.ws = (unsigned char*)d_ws;
#if MULTI_LAUNCH
    for (int ph = 0; ph < NPH; ++ph) {
        p.ph_lo = ph; p.ph_hi = ph + 1;
        hipLaunchKernelGGL(mega, dim3(grid_blocks), dim3(256), 0, stream, p);
    }
#else
    p.ph_lo = 0; p.ph_hi = NPH;
    void* args[] = {&p};
    hipError_t e = hipLaunchCooperativeKernel((const void*)mega, dim3(grid_blocks), dim3(256), args, 0, stream);
    if (e != hipSuccess) fprintf(stderr, "cooperative launch failed: %s (grid %d)\n", hipGetErrorString(e), grid_blocks);
#endif
}
```

```cpp
#include <hip/hip_runtime.h>
#include <hip/hip_cooperative_groups.h>
#include <stdint.h>
#include <stdio.h>
namespace cg = cooperative_groups;

#ifndef EN_CONV
#define EN_CONV 1
#endif
#ifndef EN_RWKV
#define EN_RWKV 1
#endif
#ifndef EN_NSA_CMP
#define EN_NSA_CMP 1
#endif
#ifndef EN_NSA_WIN
#define EN_NSA_WIN 1
#endif
#ifndef EN_NSA_SEL
#define EN_NSA_SEL 1
#endif
#ifndef EN_PEER
#define EN_PEER 1
#endif
#ifndef MULTI_LAUNCH
#define MULTI_LAUNCH 0
#endif

#define DEV __device__ __forceinline__
typedef unsigned short u16;
typedef __attribute__((ext_vector_type(8))) short bf16x8;
typedef __attribute__((ext_vector_type(4))) float f32x4;
typedef __attribute__((ext_vector_type(4))) unsigned int u32x4;
typedef __attribute__((ext_vector_type(2))) unsigned int u32x2;

constexpr int NB = 4, NT = 8192, ND = 1024, NTOK = NB * NT, NL = 2;
constexpr int NIN = 2840, NINP = 2944;
constexpr size_t MiB = 1ull << 20;

constexpr size_t OFF_CTL = 0;
constexpr size_t CTL_ZERO_BYTES = 32768;
constexpr size_t OFF_BAR = 16384;
constexpr size_t OFF_MOD = 64 * 1024;
constexpr size_t OFF_CBP = 256 * 1024;
constexpr size_t OFF_WIN = 1 * MiB;
constexpr size_t OFF_WOUT = 13 * MiB;
constexpr size_t OFF_WQ = 17 * MiB;
constexpr size_t OFF_CW1 = 25 * MiB;
constexpr size_t OFF_K12 = 27 * MiB;
constexpr size_t OFF_LW = 27 * MiB + 512 * 1024;
constexpr size_t OFF_U8 = 28 * MiB;
constexpr size_t OFF_UVS = 512 * 1024;
constexpr size_t OFF_H = 92 * MiB;
constexpr size_t OFF_MIX = 156 * MiB;
constexpr size_t OFF_E = 220 * MiB;
constexpr size_t OFF_PCONV = OFF_E + 0;
constexpr size_t OFF_PRWKV = OFF_E + 32 * MiB;
constexpr size_t OFF_YRAW = OFF_E + 32 * MiB;
constexpr size_t OFF_Q = OFF_E + 96 * MiB;
constexpr size_t OFF_KV = OFF_E + 128 * MiB;
constexpr size_t OFF_GATE = OFF_E + 176 * MiB;
constexpr size_t OFF_KC = OFF_E + 180 * MiB;
constexpr size_t OFF_VCT = OFF_KC + 512 * 1024;
constexpr size_t OFF_RV = OFF_E + 184 * MiB;
constexpr size_t OFF_RKK = OFF_E + 200 * MiB;
constexpr size_t OFF_RKKA = OFF_E + 216 * MiB;
constexpr size_t OFF_RG = OFF_E + 232 * MiB;
constexpr size_t OFF_BONUS = OFF_E + 248 * MiB;
constexpr size_t OFF_RW = OFF_E + 249 * MiB;
constexpr size_t OFF_RR = 60 * MiB;
constexpr size_t OFF_RK = 76 * MiB;
constexpr size_t OFF_QP = OFF_E + 0;
constexpr size_t OFF_PIDX = OFF_E + 128 * MiB;
constexpr size_t OFF_PGW = OFF_E + 144 * MiB;
constexpr size_t WS_NEED = OFF_E + 281 * MiB;

#define QW(l, q) (64 * ((l) * 8 + (q)))
enum { Q_CMP = 0, Q_CONV = 1, Q_RWP = 2, Q_NSA = 3, Q_PTK = 4 };

enum { I_X = 0, I_C, I_ADAW, I_ADAB, I_N1G, I_N2G, I_WIN, I_CDW, I_CDB, I_CGG, I_CGB, I_MU, I_W0, I_WUP, I_A0, I_AUP, I_GUP,
       I_KK, I_KA, I_RK, I_LNG, I_LNB, I_CKPOS, I_CKW1, I_CKW2, I_CVPOS, I_CVW1, I_CVW2, I_WOUT, I_PWQ, I_PK1, I_PK2, I_PU, I_PV, I_FG };

struct Params {
    const float* in[35];
    float* out;
    unsigned char* ws;
    int ph_lo, ph_hi;
};

DEV int TID() { int t = threadIdx.x; asm volatile("" : "+v"(t)); return t; }
DEV int BID() { int t = blockIdx.x; asm volatile("" : "+s"(t)); return t; }
typedef __attribute__((ext_vector_type(2))) float f32x2_t;
typedef __attribute__((ext_vector_type(2))) __bf16 bf16x2_t;
DEV unsigned pack2(float a, float b) { const f32x2_t v = {a, b}; return __builtin_bit_cast(unsigned, __builtin_convertvector(v, bf16x2_t)); }
DEV u16 f2bf(float f) { const __bf16 h = (__bf16)f; return __builtin_bit_cast(u16, h); }
DEV float bf2f(u16 h) { return __uint_as_float(((unsigned)h) << 16); }
DEV float bflo(unsigned u) { return __uint_as_float(u << 16); }
DEV float bfhi(unsigned u) { return __uint_as_float(u & 0xffff0000u); }
DEV float ex2(float x) { return __builtin_amdgcn_exp2f(x); }
DEV float sigmoidf_(float x) { return 1.f / (1.f + __expf(-x)); }

DEV f32x4 mfma16(bf16x8 a, bf16x8 b, f32x4 c) { return __builtin_amdgcn_mfma_f32_16x16x32_bf16(a, b, c, 0, 0, 0); }
template <int CTRL> DEV float dppf(float x) { return __int_as_float(__builtin_amdgcn_update_dpp(0, __float_as_int(x), CTRL, 0xF, 0xF, false)); }
template <int CTRL> DEV unsigned dppu(unsigned x) { return (unsigned)__builtin_amdgcn_update_dpp(0, (int)x, CTRL, 0xF, 0xF, false); }
DEV float reduce16(float x) { x += dppf<0xB1>(x); x += dppf<0x4E>(x); x += dppf<0x124>(x); x += dppf<0x128>(x); return x; }
DEV float quadsum(float x) { x += dppf<0xB1>(x); x += dppf<0x4E>(x); return x; }
DEV float x16_sum(float x) { auto r = __builtin_amdgcn_permlane16_swap(__float_as_uint(x), __float_as_uint(x), false, false); return __uint_as_float(r[0]) + __uint_as_float(r[1]); }
DEV float x32_sum(float x) { auto r = __builtin_amdgcn_permlane32_swap(__float_as_uint(x), __float_as_uint(x), false, false); return __uint_as_float(r[0]) + __uint_as_float(r[1]); }
DEV float x16_max(float x) { auto r = __builtin_amdgcn_permlane16_swap(__float_as_uint(x), __float_as_uint(x), false, false); return fmaxf(__uint_as_float(r[0]), __uint_as_float(r[1])); }
DEV float x32_max(float x) { auto r = __builtin_amdgcn_permlane32_swap(__float_as_uint(x), __float_as_uint(x), false, false); return fmaxf(__uint_as_float(r[0]), __uint_as_float(r[1])); }
DEV int x16_sumi(int x) { auto r = __builtin_amdgcn_permlane16_swap((unsigned)x, (unsigned)x, false, false); return (int)(r[0] + r[1]); }
DEV int x32_sumi(int x) { auto r = __builtin_amdgcn_permlane32_swap((unsigned)x, (unsigned)x, false, false); return (int)(r[0] + r[1]); }
DEV float colsum(float x) { return x32_sum(x16_sum(x)); }
DEV float colmax(float x) { return x32_max(x16_max(x)); }
DEV int colsumi(int x) { return x32_sumi(x16_sumi(x)); }
DEV float wave_sum(float v) { return x32_sum(x16_sum(reduce16(v))); }
DEV int wave_sum_i(int x) {
    x += (int)dppu<0xB1>((unsigned)x); x += (int)dppu<0x4E>((unsigned)x); x += (int)dppu<0x124>((unsigned)x); x += (int)dppu<0x128>((unsigned)x);
    return x32_sumi(x16_sumi(x));
}
DEV int reduce8_i(const int (&d)[8]) {
    int t[4];
#pragma unroll
    for (int k = 0; k < 4; ++k) {
        auto r = __builtin_amdgcn_permlane32_swap((unsigned)d[k], (unsigned)d[k + 4], false, false);
        t[k] = (int)(r[0] + r[1]);
    }
    int u[2];
#pragma unroll
    for (int k = 0; k < 2; ++k) {
        auto r = __builtin_amdgcn_permlane16_swap((unsigned)t[k], (unsigned)t[k + 2], false, false);
        u[k] = (int)(r[0] + r[1]);
    }
    const bool hi8 = (threadIdx.x & 8) != 0;
    int x = hi8 ? u[1] : u[0];
    const int y = hi8 ? u[0] : u[1];
    x += (int)dppu<0x128>((unsigned)y);
    x += (int)dppu<0xB1>((unsigned)x); x += (int)dppu<0x4E>((unsigned)x); x += (int)dppu<0x141>((unsigned)x);
    return x;
}
DEV float wave_max(float x) {
    x = fmaxf(x, dppf<0xB1>(x)); x = fmaxf(x, dppf<0x4E>(x)); x = fmaxf(x, dppf<0x124>(x)); x = fmaxf(x, dppf<0x128>(x));
    return x32_max(x16_max(x));
}
DEV void lds_fence() { asm volatile("s_waitcnt lgkmcnt(0)" ::: "memory"); }
DEV bf16x8 ld8(const u16* p) { return *(const bf16x8*)p; }

DEV int block_next(unsigned* ctr, int* slot) {
    __syncthreads();
    if (TID() == 0) *slot = (int)atomicAdd(ctr, 1u);
    __syncthreads();
    return *slot;
}

#define XB_TMO      128
#define XB_XCNT(j)  (256  + 64 * (j))
#define XB_XSUB(j)  (1280 + 64 * (j))
#define XB_XGEN(j)  (2304 + 64 * (j))
#define XB_TOP      3328
#define XB_TOPGEN   3392
#define XCD_BAR_WORDS 3456
#define XB_SPIN_CAP (1u << 22)
#define LAS __attribute__((address_space(3)))
DEV unsigned xb_ld(unsigned* p) { return __hip_atomic_load(p, __ATOMIC_RELAXED, __HIP_MEMORY_SCOPE_AGENT); }
DEV unsigned xb_add(unsigned* p, unsigned v) { return __hip_atomic_fetch_add(p, v, __ATOMIC_RELAXED, __HIP_MEMORY_SCOPE_AGENT); }
DEV unsigned xb_xcc_id() { return (unsigned)__builtin_amdgcn_s_getreg((3 << 11) | 20) & 0xFu; }
#define XB_SPIN(cond, bar) do { unsigned _sp = 0; while (cond) { __builtin_amdgcn_s_sleep(1); \
    if ((++_sp & 255u) == 0u) { if (xb_ld(&(bar)[XB_TMO])) break; if (_sp > XB_SPIN_CAP) { atomicAdd(&(bar)[XB_TMO], 1u); break; } } } } while (0)
struct XcdBarrier { unsigned* bar; unsigned x; volatile unsigned* st; };
DEV XcdBarrier xcd_barrier_post(unsigned* bar, volatile unsigned* st) {
    XcdBarrier b; b.bar = bar; b.x = xb_xcc_id(); b.st = st;
    if (threadIdx.x == 0) (void)xb_add(&bar[XB_XCNT(b.x)], 1u);
    return b;
}
DEV void xcd_barrier_complete(unsigned* bar, unsigned x, unsigned& nloc, unsigned& nx) {
    const unsigned G = gridDim.x * gridDim.y * gridDim.z;
    unsigned sum, cnt, mine, sp = 0u;
    for (;;) {
        sum = 0u; cnt = 0u; mine = 0u;
#pragma unroll
        for (unsigned j = 0; j < 16; ++j) { const unsigned c = xb_ld(&bar[XB_XCNT(j)]); sum += c; cnt += (c > 0u) ? 1u : 0u; mine = (j == x) ? c : mine; }
        if (sum == G) break;
        __builtin_amdgcn_s_sleep(1);
        if ((++sp & 255u) == 0u) { if (xb_ld(&bar[XB_TMO])) break; if (sp > XB_SPIN_CAP) { atomicAdd(&bar[XB_TMO], 1u); break; } }
    }
    nloc = mine > 0u ? mine : 1u; nx = cnt > 0u ? cnt : 1u;
}
DEV void xcd_barrier(const XcdBarrier& b) {
    asm volatile("s_waitcnt vmcnt(0)" ::: "memory");
    __syncthreads();
    if (threadIdx.x == 0) {
        unsigned* bar = b.bar;
        __builtin_amdgcn_s_waitcnt(0);
        unsigned nloc = b.st[0], nx = b.st[1];
        if (nloc == 0u) { xcd_barrier_complete(bar, b.x, nloc, nx); b.st[0] = nloc; b.st[1] = nx; }
        const unsigned old = xb_add(&bar[XB_XSUB(b.x)], 1u);
        const unsigned gen = old / nloc;
        if (old + 1u == (gen + 1u) * nloc) {
            __builtin_amdgcn_fence(__ATOMIC_RELEASE, "agent");
            asm volatile("s_waitcnt vmcnt(0)" ::: "memory");
            const unsigned og = xb_add(&bar[XB_TOP], 1u);
            const unsigned tg = og / nx;
            if (og + 1u == (tg + 1u) * nx) xb_add(&bar[XB_TOPGEN], 1u);
            else XB_SPIN(xb_ld(&bar[XB_TOPGEN]) == tg, bar);
            __builtin_amdgcn_fence(__ATOMIC_ACQUIRE, "agent");
            xb_add(&bar[XB_XGEN(b.x)], 1u);
            asm volatile("s_waitcnt vmcnt(0)" ::: "memory");
        } else {
            XB_SPIN(xb_ld(&bar[XB_XGEN(b.x)]) == gen, bar);
            __builtin_amdgcn_fence(__ATOMIC_ACQUIRE, "agent");
            asm volatile("s_waitcnt vmcnt(0)" ::: "memory");
        }
    }
    __syncthreads();
}

template <class Epi>
DEV void gemm_phase(const u16* __restrict__ A, int lda, const u16* __restrict__ Bt, int ldb, int mtiles, int ntiles, int K, Epi& epi,
                    unsigned char* lds, int bid, int nb, int nt_lo = 0, int nt_skip = 0, bool xcd_order = true) {
    const int tid = TID(), lane = tid & 63, wave = tid >> 6;
    const int wm = wave >> 1, wn = wave & 1, q4 = lane >> 4, cidx = lane & 15;
    u16* As = (u16*)lds;
    u16* Bs = (u16*)(lds + 32768);
    const int KT = K >> 6;
    const int total = mtiles * ntiles;
    const int srow = tid >> 3, sch = tid & 7;
    const bool xo_ = xcd_order && ((nb & 7) == 0) && (nb <= 4096) && ((mtiles & 7) == 0);
    const int ngroups = (ntiles + 7) >> 3;
    const int nloc = xo_ ? (nb >> 3) : 1;
    const int nvirt = xo_ ? ((mtiles >> 3) * ngroups * 64) : total;
    for (int vt = xo_ ? ((bid & 7) * 64 + (bid >> 3)) : bid; vt < nvirt; vt += xo_ ? ((((vt & 63) + nloc) < 64) ? nloc : (8 * 64 - (vt & 63) + (bid >> 3))) : nb) {
        int mt, nt;
        if (xo_) {
            const int st = vt >> 6, tt = vt & 63;
            mt = (st / ngroups) * 8 + (tt >> 3); nt = (st % ngroups) * 8 + (tt & 7);
            if (nt >= ntiles) continue;
        } else { mt = vt / ntiles; nt = vt - mt * ntiles; }
        if (nt >= nt_lo) nt += nt_skip;
        const int m0 = mt * 128, n0 = nt * 128;
        const bool sw = epi.swapped(n0 + wn * 64);
        const int xo = sw ? (32768 / 2 + wn * 64 * 64) : (wm * 64 * 64);
        const int yo = sw ? (wm * 64 * 64) : (32768 / 2 + wn * 64 * 64);
        f32x4 acc[4][4];
#pragma unroll
        for (int i = 0; i < 4; ++i)
#pragma unroll
            for (int j = 0; j < 4; ++j) acc[i][j] = (f32x4){0.f, 0.f, 0.f, 0.f};
        const u16* Ag = A + (size_t)(m0 + srow) * lda + sch * 8;
        const u16* Bg = Bt + (size_t)(n0 + srow) * ldb + sch * 8;
        bf16x8 ra0[4], rb0[4], ra1[4], rb1[4];
#define GEMM_GLOAD(RA, RB, KT_) { const int k0_ = (KT_) * 64; _Pragma("unroll") for (int i = 0; i < 4; ++i) { RA[i] = ld8(Ag + (size_t)(32 * i) * lda + k0_); RB[i] = ld8(Bg + (size_t)(32 * i) * ldb + k0_); } }
#define GEMM_LWRITE(RA, RB, BUF_) { u16* Aw_ = As + (BUF_) * 8192; u16* Bw_ = Bs + (BUF_) * 8192; _Pragma("unroll") for (int i = 0; i < 4; ++i) { const int row = srow + 32 * i; const int off = row * 64 + ((sch ^ (row & 7)) << 3); *(bf16x8*)(Aw_ + off) = RA[i]; *(bf16x8*)(Bw_ + off) = RB[i]; } }
#define GEMM_COMPUTE(BUF_) { const u16* Xb = As + (BUF_) * 8192 + xo; const u16* Yb = As + (BUF_) * 8192 + yo; _Pragma("unroll") for (int s = 0; s < 2; ++s) { bf16x8 a[4], b[4]; const int ch = s * 4 + q4; _Pragma("unroll") for (int i = 0; i < 4; ++i) { const int row = i * 16 + cidx; a[i] = *(const bf16x8*)(Xb + row * 64 + ((ch ^ (row & 7)) << 3)); b[i] = *(const bf16x8*)(Yb + row * 64 + ((ch ^ (row & 7)) << 3)); } _Pragma("unroll") for (int i = 0; i < 4; ++i) _Pragma("unroll") for (int j = 0; j < 4; ++j) acc[i][j] = mfma16(a[i], b[j], acc[i][j]); } }
        GEMM_GLOAD(ra0, rb0, 0);
        if (KT > 1) GEMM_GLOAD(ra1, rb1, 1);
        GEMM_LWRITE(ra0, rb0, 0);
        __syncthreads();
        for (int kt = 0; kt < KT; kt += 2) {
            if (kt + 2 < KT) GEMM_GLOAD(ra0, rb0, kt + 2);
            GEMM_COMPUTE(0);
            GEMM_LWRITE(ra1, rb1, 1);
            __syncthreads();
            if (kt + 3 < KT) GEMM_GLOAD(ra1, rb1, kt + 3);
            GEMM_COMPUTE(1);
            if (kt + 2 < KT) GEMM_LWRITE(ra0, rb0, 0);
            __syncthreads();
        }
#undef GEMM_GLOAD
#undef GEMM_LWRITE
#undef GEMM_COMPUTE
        if (!sw) {
#pragma unroll
            for (int i = 0; i < 4; ++i)
#pragma unroll
                for (int j = 0; j < 4; ++j) epi.rows4(m0 + wm * 64 + i * 16 + q4 * 4, n0 + wn * 64 + j * 16 + cidx, acc[i][j]);
        } else {
#pragma unroll
            for (int i = 0; i < 4; ++i)
#pragma unroll
                for (int j = 0; j < 4; ++j) epi.cols4(m0 + wm * 64 + j * 16 + cidx, n0 + wn * 64 + i * 16 + q4 * 4, acc[i][j]);
        }
        epi.finish(m0, n0, lds);
    }
}

struct EpiInProj {
    u16 *pconv, *prwkv, *q, *kv; float* gate;
    DEV bool swapped(int c0) const { return !((c0 >= 2432 && c0 < 2560) || (c0 >= 2688 && c0 < 2816)); }
    DEV void rows4(int row0, int col, f32x4 v) const {
        const int c = col - 2048; const int idx = c >> 7; const int g = (c >> 6) & 1; const int d = c & 63;
        const int b = row0 >> 13; const int t0 = row0 & 8191; const int bg = b * 2 + g;
        u16* base = kv + (size_t)idx * 4194304;
        const int k = t0 & 31; const int p0 = 8 * ((k & 15) >> 2) + 4 * (k >> 4);
        u32x2 w; w[0] = pack2(v[0], v[1]); w[1] = pack2(v[2], v[3]);
        *(u32x2*)(base + (size_t)(bg * 64 + d) * 8192 + (t0 & ~31) + p0) = w;
    }
    DEV void cols4(int row, int col0, f32x4 v) const {
        if (col0 < 512) {
            u32x2 w; w[0] = pack2(v[0], v[1]); w[1] = pack2(v[2], v[3]);
            *(u32x2*)(pconv + (size_t)row * 512 + col0) = w;
        } else if (col0 < 1536) {
            u32x2 w; w[0] = pack2(v[0], v[1]); w[1] = pack2(v[2], v[3]);
            *(u32x2*)(prwkv + (size_t)row * 1024 + (col0 - 512)) = w;
        } else if (col0 < 2048) {
            const float sc = 0.18033688011112042f;
            u32x2 w; w[0] = pack2(v[0] * sc, v[1] * sc); w[1] = pack2(v[2] * sc, v[3] * sc);
            *(u32x2*)(q + (size_t)row * 512 + (col0 - 1536)) = w;
        } else if (col0 < 2816) {
            const int c = col0 - 2048; const int idx = c >> 7; const int g = (c >> 6) & 1; const int d = c & 63;
            const int b = row >> 13; const int t = row & 8191; const int bg = b * 2 + g;
            u32x2 w; w[0] = pack2(v[0], v[1]); w[1] = pack2(v[2], v[3]);
            *(u32x2*)(kv + (size_t)idx * 4194304 + ((size_t)bg * 8192 + t) * 64 + d) = w;
        } else if (col0 < 2840) {
            *(float4*)(gate + (size_t)row * 24 + (col0 - 2816)) = (float4){sigmoidf_(v[0]), sigmoidf_(v[1]), sigmoidf_(v[2]), sigmoidf_(v[3])};
        }
    }
    DEV void finish(int, int, unsigned char*) const {}
};

struct EpiOutProj {
    const float* xold; float* xnew; const float* g1;
    DEV bool swapped(int) const { return true; }
    DEV void rows4(int, int, f32x4) const {}
    DEV void cols4(int row, int col0, f32x4 v) const {
        const int b = row >> 13; const float4 gg = *(const float4*)(g1 + b * 6144 + col0);
        const size_t o = (size_t)row * 1024 + col0;
        const float4 x = *(const float4*)(xold + o);
        *(float4*)(xnew + o) = (float4){x.x + gg.x * v[0], x.y + gg.y * v[1], x.z + gg.z * v[2], x.w + gg.w * v[3]};
    }
    DEV void finish(int, int, unsigned char*) const {}
};

struct EpiStoreBf16 {
    u16* out; int ld;
    DEV bool swapped(int) const { return true; }
    DEV void rows4(int, int, f32x4) const {}
    DEV void cols4(int row, int col0, f32x4 v) const {
        u32x2 w; w[0] = pack2(v[0], v[1]); w[1] = pack2(v[2], v[3]);
        *(u32x2*)(out + (size_t)row * ld + col0) = w;
    }
    DEV void finish(int, int, unsigned char*) const {}
};

struct EpiCompress {
    const float* cbp;
    const float* w2;
    u16* outp;
    int isv;
    unsigned char* lds;
    DEV bool swapped(int) const { return false; }
    DEV void cols4(int, int, f32x4) const {}
    DEV void rows4(int row0, int col, f32x4 v) const {
        float* hid = (float*)lds;
        const int rl = row0 & 127;
#pragma unroll
        for (int r = 0; r < 4; ++r) hid[(rl + r) * 128 + col] = v[r];
    }
    DEV void finish(int m0, int, unsigned char*) const {
        __syncthreads();
        {
            float* hw = (float*)lds;
            const int t = TID(); const int c = t & 127, r0 = (t >> 7) * 64;
            float bias = 0.f;
#pragma unroll
            for (int s = 0; s < 16; ++s) bias += cbp[s * 128 + c];
#pragma unroll 4
            for (int r = 0; r < 64; ++r) { const float x = hw[(r0 + r) * 128 + c] + bias; hw[(r0 + r) * 128 + c] = x * sigmoidf_(x); }
        }
        __syncthreads();
        const float* hid = (const float*)lds;
        const int tid = TID(); const int d = tid & 63, rgp = tid >> 6;
        float acc[32];
#pragma unroll
        for (int i = 0; i < 32; ++i) acc[i] = 0.f;
#pragma unroll 1
        for (int j0 = 0; j0 < 128; j0 += 8) {
            float wv[8];
#pragma unroll
            for (int jj = 0; jj < 8; ++jj) wv[jj] = w2[(j0 + jj) * 64 + d];
#pragma unroll
            for (int rr = 0; rr < 32; ++rr) {
                const float4 h0 = *(const float4*)(hid + (rgp * 32 + rr) * 128 + j0), h1 = *(const float4*)(hid + (rgp * 32 + rr) * 128 + j0 + 4);
                acc[rr] += h0.x * wv[0] + h0.y * wv[1] + h0.z * wv[2] + h0.w * wv[3] + h1.x * wv[4] + h1.y * wv[5] + h1.z * wv[6] + h1.w * wv[7];
            }
        }
#pragma unroll
        for (int rr = 0; rr < 32; ++rr) {
            const int m = m0 + rgp * 32 + rr; const int bg = m >> 9, n = m & 511;
            const u16 val = (n == 511) ? (u16)0 : f2bf(acc[rr]);
            if (!isv) outp[((size_t)bg * 512 + n) * 64 + d] = val;
            else {
                const int k = n & 31; const int pp = 8 * ((k & 15) >> 2) + (k & 3) + 4 * (k >> 4);
                outp[((size_t)bg * 64 + d) * 512 + (n & ~31) + pp] = val;
            }
        }
        __syncthreads();
    }
};

DEV void transpose_tile(const float* __restrict__ src, int N, u16* __restrict__ dst, int ldk, int kt, int nt, float* tl) {
    const int tid = TID(); const int k0 = kt * 64, n0 = nt * 64;
#pragma unroll 4
    for (int i = 0; i < 16; ++i) {
        const int idx = tid + 256 * i; const int kr = idx >> 6, nc = idx & 63; const int n = n0 + nc;
        tl[kr * 65 + nc] = (n < N) ? src[(size_t)(k0 + kr) * N + n] : 0.f;
    }
    __syncthreads();
#pragma unroll 4
    for (int i = 0; i < 16; ++i) {
        const int idx = tid + 256 * i; const int nr = idx >> 6, kc = idx & 63;
        dst[(size_t)(n0 + nr) * ldk + k0 + kc] = f2bf(tl[kc * 65 + nr]);
    }
    __syncthreads();
}

DEV void convert_straight(const float* __restrict__ src, u16* __restrict__ dst, size_t n) {
    const size_t stride = (size_t)gridDim.x * 256 * 8;
    for (size_t i = ((size_t)BID() * 256 + TID()) * 8; i < n; i += stride) {
        const float4 a = *(const float4*)(src + i); const float4 b = *(const float4*)(src + i + 4);
        u32x4 w; w[0] = pack2(a.x, a.y); w[1] = pack2(a.z, a.w); w[2] = pack2(b.x, b.y); w[3] = pack2(b.z, b.w);
        *(u32x4*)(dst + i) = w;
    }
}

DEV void convert_rows_task(const float* __restrict__ src, unsigned char* __restrict__ dst, float* __restrict__ scale, int* __restrict__ rowsum, int row0) {
    const int lane = TID() & 63, wave = TID() >> 6;
#pragma unroll 1
    for (int it = 0; it < 4; ++it) {
        float4 v[2][4]; float amax[2] = {0.f, 0.f};
#pragma unroll
        for (int u = 0; u < 2; ++u) {
            const int row = row0 + wave * 8 + it * 2 + u;
#pragma unroll
            for (int i = 0; i < 4; ++i) v[u][i] = *(const float4*)(src + (size_t)row * 1024 + 16 * lane + 4 * i);
        }
#pragma unroll
        for (int u = 0; u < 2; ++u) {
#pragma unroll
            for (int i = 0; i < 4; ++i)
                amax[u] = fmaxf(amax[u], fmaxf(fmaxf(fabsf(v[u][i].x), fabsf(v[u][i].y)), fmaxf(fabsf(v[u][i].z), fabsf(v[u][i].w))));
            amax[u] = wave_max(amax[u]);
            const int row = row0 + wave * 8 + it * 2 + u;
            const float sc = amax[u] > 0.f ? amax[u] * (1.f / 127.f) : 1.f;
            const float inv = 1.f / sc;
            u32x4 w;
#pragma unroll
            for (int i = 0; i < 4; ++i) {
                const int a = __float2int_rn(v[u][i].x * inv) + 128, b = __float2int_rn(v[u][i].y * inv) + 128, c = __float2int_rn(v[u][i].z * inv) + 128,
                          d = __float2int_rn(v[u][i].w * inv) + 128;
                w[i] = (unsigned)a | ((unsigned)b << 8) | ((unsigned)c << 16) | ((unsigned)d << 24);
            }
            *(u32x4*)(dst + (size_t)row * 1024 + 16 * lane) = w;
            int bs = 0;
#pragma unroll
            for (int i = 0; i < 4; ++i) bs += (int)(w[i] & 0xffu) + (int)((w[i] >> 8) & 0xffu) + (int)((w[i] >> 16) & 0xffu) + (int)(w[i] >> 24);
            bs = wave_sum_i(bs);
            if (lane == 0) { scale[row] = sc; if (rowsum) rowsum[row] = bs; }
        }
    }
}

DEV void phase_prep(const Params& p, unsigned char* lds) {
    const int tid = TID();
    float* fl = (float*)lds;
    unsigned char* ws = p.ws;
    for (int task = BID(); task < 192; task += gridDim.x) {
        const int l = task / 96, cgp = task % 96;
        float* cs = fl;
        float* red = fl + 4096;
        for (int i = tid; i < 4096; i += 256) { const float c = p.in[I_C][i]; cs[i] = c / (1.f + __expf(-c)); }
        __syncthreads();
        const int col = cgp * 64 + (tid & 63), ks = tid >> 6;
        float a0 = 0, a1 = 0, a2 = 0, a3 = 0;
        const float* w = p.in[I_ADAW] + ((size_t)l * 1024 + ks * 256) * 6144 + col;
#pragma unroll 32
        for (int k = 0; k < 256; ++k) {
            const float wv = w[(size_t)k * 6144]; const int kk = ks * 256 + k;
            a0 += cs[kk] * wv; a1 += cs[1024 + kk] * wv; a2 += cs[2048 + kk] * wv; a3 += cs[3072 + kk] * wv;
        }
        red[(ks * 4 + 0) * 64 + (tid & 63)] = a0; red[(ks * 4 + 1) * 64 + (tid & 63)] = a1;
        red[(ks * 4 + 2) * 64 + (tid & 63)] = a2; red[(ks * 4 + 3) * 64 + (tid & 63)] = a3;
        __syncthreads();
        {
            const int b = tid >> 6, c = tid & 63;
            const float s = red[(0 * 4 + b) * 64 + c] + red[(1 * 4 + b) * 64 + c] + red[(2 * 4 + b) * 64 + c] + red[(3 * 4 + b) * 64 + c];
            const int colg = cgp * 64 + c;
            ((float*)(ws + OFF_MOD))[(l * 4 + b) * 6144 + colg] = s + p.in[I_ADAB][l * 6144 + colg];
        }
        __syncthreads();
    }
    for (int task = BID(); task < 64; task += gridDim.x) {
        const int l = task >> 5, kv = (task >> 4) & 1, s = task & 15;
        const float* pos = p.in[kv ? I_CVPOS : I_CKPOS] + l * 2048;
        const float* w1 = p.in[kv ? I_CVW1 : I_CKW1] + (size_t)l * 2048 * 128;
        const int col = tid & 127, half = tid >> 7;
        float a = 0;
        const int i0 = s * 128 + half * 64;
#pragma unroll 8
        for (int i = 0; i < 64; ++i) a += pos[i0 + i] * w1[(size_t)(i0 + i) * 128 + col];
        fl[tid] = a;
        __syncthreads();
        if (tid < 128) ((float*)(ws + OFF_CBP))[((l * 2 + kv) * 16 + s) * 128 + tid] = fl[tid] + fl[tid + 128];
        __syncthreads();
    }
    {
        for (int task = BID(); task < 2 * 16 * 46; task += gridDim.x) {
            const int l = task / (16 * 46), r = task % (16 * 46);
            transpose_tile(p.in[I_WIN] + (size_t)l * 1024 * NIN, NIN, (u16*)(ws + OFF_WIN) + (size_t)l * NINP * 1024, 1024, r / 46, r % 46, fl);
        }
        for (int task = BID(); task < 2 * 16; task += gridDim.x) {
            const int l = task >> 4, r = task & 15; const int nt = r & 3, part = r >> 2;
            u16* dst = (u16*)(ws + OFF_LW) + (size_t)l * 65536;
            if (part == 0) transpose_tile(p.in[I_WUP] + (size_t)l * 64 * 256, 256, dst, 256, 0, nt, fl);
            else if (part == 1) transpose_tile(p.in[I_AUP] + (size_t)l * 64 * 256, 256, dst + 64, 256, 0, nt, fl);
            else transpose_tile(p.in[I_GUP] + (size_t)l * 128 * 256, 256, dst + 128, 256, part - 2, nt, fl);
        }
        for (int task = BID(); task < 4 * 32 * 2; task += gridDim.x) {
            const int lk = task >> 6, r = task & 63; const int l = lk >> 1, kv = lk & 1;
            transpose_tile(p.in[kv ? I_CVW1 : I_CKW1] + (size_t)l * 2048 * 128, 128, (u16*)(ws + OFF_CW1) + (size_t)lk * 128 * 2048, 2048, r >> 1, r & 1, fl);
        }
    }
    for (int l = 0; l < 2; ++l) {
        convert_straight(p.in[I_PK1] + l * 16384, (u16*)(ws + OFF_K12) + (l * 2 + 0) * 16384, 16384);
        convert_straight(p.in[I_PK2] + l * 16384, (u16*)(ws + OFF_K12) + (l * 2 + 1) * 16384, 16384);
    }
}

DEV void phase_norm(const float* __restrict__ x, const float* __restrict__ g, const float* __restrict__ sh, const float* __restrict__ sc,
                    u16* __restrict__ h) {
    const int lane = TID() & 63;
    const int gw = BID() * 4 + (TID() >> 6), nw = gridDim.x * 4;
    for (int row0 = gw * 2; row0 < NTOK; row0 += nw * 2) {
        float4 v[2][4]; float ss[2] = {0.f, 0.f};
#pragma unroll
        for (int u = 0; u < 2; ++u)
#pragma unroll
            for (int i = 0; i < 4; ++i) v[u][i] = *(const float4*)(x + (size_t)(row0 + u) * 1024 + 256 * i + lane * 4);
#pragma unroll
        for (int u = 0; u < 2; ++u) {
#pragma unroll
            for (int i = 0; i < 4; ++i) ss[u] += v[u][i].x * v[u][i].x + v[u][i].y * v[u][i].y + v[u][i].z * v[u][i].z + v[u][i].w * v[u][i].w;
            ss[u] = wave_sum(ss[u]);
        }
#pragma unroll
        for (int u = 0; u < 2; ++u) {
            const int row = row0 + u; const int b = row >> 13;
            const float rs = rsqrtf(ss[u] * (1.f / 1024.f) + 1e-6f);
#pragma unroll
            for (int i = 0; i < 4; ++i) {
                const int k = 256 * i + lane * 4;
                const float4 gg = *(const float4*)(g + k); const float4 s1 = *(const float4*)(sc + b * 6144 + k); const float4 s0 = *(const float4*)(sh + b * 6144 + k);
                u32x2 w;
                w[0] = pack2(v[u][i].x * rs * gg.x * (1.f + s1.x) + s0.x, v[u][i].y * rs * gg.y * (1.f + s1.y) + s0.y);
                w[1] = pack2(v[u][i].z * rs * gg.z * (1.f + s1.z) + s0.z, v[u][i].w * rs * gg.w * (1.f + s1.w) + s0.w);
                *(u32x2*)(h + (size_t)row * 1024 + k) = w;
            }
        }
    }
}

DEV void conv_tile(const Params& p, int l, int tile, unsigned char* lds) {
    float* ul = (float*)lds;
    const int tid = TID();
    unsigned char* ws = p.ws;
    const u16* pconv = (const u16*)(ws + OFF_PCONV);
    u16* mix = (u16*)(ws + OFF_MIX);
    const int t0g = tile * 32; const int tb = t0g & 8191;
#pragma unroll 8
    for (int rr = 0; rr < 62; ++rr) {
        const int trow = tb - 30 + rr;
        float u = 0.f;
        if (trow >= 0) {
            const size_t o = (size_t)(t0g - 30 + rr) * 512;
            const float val = bf2f(pconv[o + tid]), gt = bf2f(pconv[o + 256 + tid]);
            u = val * sigmoidf_(gt);
        }
        ul[rr * 256 + tid] = u;
    }
    __syncthreads();
    float w[31];
#pragma unroll
    for (int j = 0; j < 31; ++j) w[j] = p.in[I_CDW][(l * 31 + j) * 256 + tid];
    const float bias = p.in[I_CDB][l * 256 + tid], gg = p.in[I_CGG][l * 256 + tid], gb = p.in[I_CGB][l * 256 + tid];
    for (int tt = 0; tt < 32; ++tt) {
        float y = bias;
#pragma unroll
        for (int j = 0; j < 31; ++j) y += ul[(tt + j) * 256 + tid] * w[j];
        const float mean = wave_sum(y) * (1.f / 64.f);
        const float d = y - mean;
        const float var = wave_sum(d * d) * (1.f / 64.f);
        float o = d * rsqrtf(var + 1e-5f) * gg + gb;
        o = o * sigmoidf_(o);
        mix[(size_t)(t0g + tt) * 1024 + tid] = f2bf(o);
    }
}

DEV float softplusf_(float x) { return x > 20.f ? x : log1pf(__expf(x)); }
DEV void rwkv_prep_tile2(const Params& p, int l, int tile, unsigned char* lds) {
    u16* actb = (u16*)lds;
    const int tid = TID(), lane = tid & 63, wave = tid >> 6, q4 = lane >> 4, cidx = lane & 15;
    unsigned char* ws = p.ws;
    const u16* pr = (const u16*)(ws + OFF_PRWKV);
    const float* mu = p.in[I_MU] + l * 1024;
    const int R0 = tile * 16;
    {
        const int col = 768 + tid; const float muc = mu[col];
        u16 raw[17];
        const bool first = ((R0 & 8191) == 0);
        raw[0] = first ? (u16)0 : pr[(size_t)(R0 - 1) * 1024 + col];
#pragma unroll
        for (int tk = 0; tk < 16; ++tk) raw[tk + 1] = pr[(size_t)(R0 + tk) * 1024 + col];
#pragma unroll
        for (int tk = 0; tk < 16; ++tk) {
            const float cur = bf2f(raw[tk + 1]), prev = bf2f(raw[tk]);
            const float x = cur + (prev - cur) * muc;
            float a;
            if (tid < 64) a = tanhf(x); else if (tid < 128) a = x; else a = sigmoidf_(x);
            actb[tk * 264 + tid] = f2bf(a);
        }
    }
    __syncthreads();
    f32x4 accw[4], acca[4], accg[4];
    {
        bf16x8 af[8];
#pragma unroll
        for (int s2 = 0; s2 < 8; ++s2) af[s2] = *(const bf16x8*)(actb + cidx * 264 + 32 * s2 + 8 * q4);
        const u16* LW = (const u16*)(ws + OFF_LW) + (size_t)l * 65536;
        const f32x4 z = (f32x4){0.f, 0.f, 0.f, 0.f};
#pragma unroll
        for (int nt = 0; nt < 4; ++nt) {
            const u16* bp = LW + (size_t)(64 * wave + 16 * nt + cidx) * 256 + 8 * q4;
            accw[nt] = mfma16(af[0], ld8(bp), z); accw[nt] = mfma16(af[1], ld8(bp + 32), accw[nt]);
            acca[nt] = mfma16(af[2], ld8(bp + 64), z); acca[nt] = mfma16(af[3], ld8(bp + 96), acca[nt]);
            accg[nt] = mfma16(af[4], ld8(bp + 128), z); accg[nt] = mfma16(af[5], ld8(bp + 160), accg[nt]);
            accg[nt] = mfma16(af[6], ld8(bp + 192), accg[nt]); accg[nt] = mfma16(af[7], ld8(bp + 224), accg[nt]);
        }
    }
    float* RW = (float*)(ws + OFF_RW);
    u16 *RR = (u16*)(ws + OFF_RR), *RK = (u16*)(ws + OFF_RK), *RV = (u16*)(ws + OFF_RV), *RKK = (u16*)(ws + OFF_RKK), *RKKA = (u16*)(ws + OFF_RKKA),
        *RG = (u16*)(ws + OFF_RG);
    float* BON = (float*)(ws + OFF_BONUS);
    float w0[4], a0[4], kkc[4], kac[4], rkc[4], mur[4], muk[4], muv[4];
#pragma unroll
    for (int nt = 0; nt < 4; ++nt) {
        const int c = 64 * wave + 16 * nt + cidx;
        w0[nt] = p.in[I_W0][l * 256 + c]; a0[nt] = p.in[I_A0][l * 256 + c]; kkc[nt] = p.in[I_KK][l * 256 + c]; kac[nt] = p.in[I_KA][l * 256 + c];
        rkc[nt] = p.in[I_RK][l * 256 + c]; mur[nt] = mu[c]; muk[nt] = mu[256 + c]; muv[nt] = mu[512 + c];
    }
    u16 ld3[5][4][3];
    {
        const int rowb = R0 + 4 * q4; const bool firstrow = ((rowb & 8191) == 0);
#pragma unroll
        for (int rr_ = 0; rr_ < 5; ++rr_)
#pragma unroll
            for (int nt = 0; nt < 4; ++nt) {
                const int c = 64 * wave + 16 * nt + cidx;
                const u16* cr = pr + (size_t)(rowb - 1 + rr_) * 1024;
                const bool z = (rr_ == 0) && firstrow;
                ld3[rr_][nt][0] = z ? (u16)0 : cr[c]; ld3[rr_][nt][1] = z ? (u16)0 : cr[256 + c]; ld3[rr_][nt][2] = z ? (u16)0 : cr[512 + c];
            }
    }
#pragma unroll
    for (int r = 0; r < 4; ++r) {
        const int row = R0 + 4 * q4 + r;
        float rr[4], kf_[4], vf_[4], av[4], kkv[4], keff[4], dec[4];
        float kk2 = 0.f, bn = 0.f;
#pragma unroll
        for (int nt = 0; nt < 4; ++nt) {
            float rv = bf2f(ld3[r + 1][nt][0]), kv = bf2f(ld3[r + 1][nt][1]), vv = bf2f(ld3[r + 1][nt][2]);
            const float rp = bf2f(ld3[r][nt][0]), kp = bf2f(ld3[r][nt][1]), vp = bf2f(ld3[r][nt][2]);
            rv += (rp - rv) * mur[nt]; kv += (kp - kv) * muk[nt]; vv += (vp - vv) * muv[nt];
            const float wl = w0[nt] + accw[nt][r];
            const float wlog = -softplusf_(-wl) - 0.5f;
            dec[nt] = __expf(-__expf(wlog));
            av[nt] = sigmoidf_(a0[nt] + acca[nt][r]);
            kkv[nt] = kv * kkc[nt]; kk2 += kkv[nt] * kkv[nt];
            keff[nt] = kv * (1.f + (av[nt] - 1.f) * kac[nt]);
            bn += rv * keff[nt] * rkc[nt];
            rr[nt] = rv; kf_[nt] = kv; vf_[nt] = vv;
        }
        kk2 = reduce16(kk2); bn = reduce16(bn);
        const float inv = 1.f / fmaxf(sqrtf(kk2), 1e-12f);
#pragma unroll
        for (int nt = 0; nt < 4; ++nt) {
            const int c = 64 * wave + 16 * nt + cidx;
            const size_t o = (size_t)row * 256 + c;
            const float kk = kkv[nt] * inv;
            RW[o] = dec[nt]; RR[o] = f2bf(rr[nt]); RK[o] = f2bf(keff[nt]); RV[o] = f2bf(vf_[nt]); RKK[o] = f2bf(kk); RKKA[o] = f2bf(kk * av[nt]);
            RG[o] = f2bf(accg[nt][r]);
        }
        if (cidx == 0) BON[(size_t)row * 4 + wave] = bn;
    }
}

DEV void rwkv_scan(const Params& p, int sb, unsigned char* lds) {
    unsigned char* ws = p.ws;
    const float* RW = (const float*)(ws + OFF_RW);
    const u16 *RR = (const u16*)(ws + OFF_RR), *RK = (const u16*)(ws + OFF_RK), *RV = (const u16*)(ws + OFF_RV), *RKK = (const u16*)(ws + OFF_RKK),
              *RKKA = (const u16*)(ws + OFF_RKKA);
    float* YR = (float*)(ws + OFF_YRAW);
    const int tid = TID(), lane = tid & 63, wave = tid >> 6;
    const int bh = sb >> 2, rg = sb & 3; const int b = bh >> 2, hh = bh & 3;
    float* L = (float*)lds;
    constexpr int BUFSZ = 5 * 1024 + 256;
    float* Yb = L + 2 * BUFSZ;
    const int row_local = 4 * wave + (lane >> 4); const int kq = (lane & 15) * 4;
    const int lstep = tid >> 4, lk = (tid & 15) * 4;
    const int vstep = tid >> 4, vrow = tid & 15;
    const size_t gbase = (size_t)b * 8192 * 256 + hh * 64;
    float4 lw; u32x2 lr, lkk, lkka, lk_; u16 lv;
    auto issue = [&](int c) {
        const size_t o = gbase + (size_t)(c * 16 + lstep) * 256 + lk;
        lw = *(const float4*)(RW + o);
        lr = *(const u32x2*)(RR + o); lk_ = *(const u32x2*)(RK + o); lkk = *(const u32x2*)(RKK + o); lkka = *(const u32x2*)(RKKA + o);
        lv = RV[gbase + (size_t)(c * 16 + vstep) * 256 + rg * 16 + vrow];
    };
    auto commit = [&](int buf) {
        float* B = L + buf * BUFSZ;
        const int o = lstep * 64 + lk;
        *(float4*)(B + o) = lw;
        *(float4*)(B + 1024 + o) = (float4){bflo(lkka[0]), bfhi(lkka[0]), bflo(lkka[1]), bfhi(lkka[1])};
        *(float4*)(B + 2048 + o) = (float4){bflo(lk_[0]), bfhi(lk_[0]), bflo(lk_[1]), bfhi(lk_[1])};
        *(float4*)(B + 3072 + o) = (float4){bflo(lr[0]), bfhi(lr[0]), bflo(lr[1]), bfhi(lr[1])};
        *(float4*)(B + 4096 + o) = (float4){bflo(lkk[0]), bfhi(lkk[0]), bflo(lkk[1]), bfhi(lkk[1])};
        B[5120 + vstep * 16 + vrow] = bf2f(lv);
    };
    __syncthreads();
    issue(0); commit(0);
    __syncthreads();
    float S0 = 0.f, S1 = 0.f, S2 = 0.f, S3 = 0.f;
    constexpr int NCH = NT / 16;
    for (int c = 0; c < NCH; ++c) {
        const int buf = c & 1;
        if (c + 1 < NCH) issue(c + 1);
        const float* B = L + buf * BUFSZ;
        float* Y = Yb + buf * 256;
        float yv[16];
        float4 w4 = *(const float4*)(B + kq), a4 = *(const float4*)(B + 1024 + kq), k4 = *(const float4*)(B + 2048 + kq),
               r4 = *(const float4*)(B + 3072 + kq), n4 = *(const float4*)(B + 4096 + kq);
        float vv = B[5120 + row_local];
#pragma unroll
        for (int st = 0; st < 16; ++st) {
            float4 w4n, a4n, k4n, r4n, n4n; float vvn;
            if (st < 15) {
                w4n = *(const float4*)(B + (st + 1) * 64 + kq); a4n = *(const float4*)(B + 1024 + (st + 1) * 64 + kq);
                k4n = *(const float4*)(B + 2048 + (st + 1) * 64 + kq); r4n = *(const float4*)(B + 3072 + (st + 1) * 64 + kq);
                n4n = *(const float4*)(B + 4096 + (st + 1) * 64 + kq); vvn = B[5120 + (st + 1) * 16 + row_local];
            }
            const float part = (S0 * n4.x + S1 * n4.y) + (S2 * n4.z + S3 * n4.w);
            const float sa = -reduce16(part);
            const float t0 = S0 * w4.x + vv * k4.x, t1 = S1 * w4.y + vv * k4.y, t2 = S2 * w4.z + vv * k4.z, t3 = S3 * w4.w + vv * k4.w;
            S0 = t0 + sa * a4.x; S1 = t1 + sa * a4.y; S2 = t2 + sa * a4.z; S3 = t3 + sa * a4.w;
            const float yp = (S0 * r4.x + S1 * r4.y) + (S2 * r4.z + S3 * r4.w);
            yv[st] = reduce16(yp);
            if (st < 15) { w4 = w4n; a4 = a4n; k4 = k4n; r4 = r4n; n4 = n4n; vv = vvn; }
        }
        if ((lane & 15) == 0) {
#pragma unroll
            for (int st = 0; st < 16; ++st) Y[st * 16 + row_local] = yv[st];
        }
        if (c + 1 < NCH) commit(buf ^ 1);
        __syncthreads();
        YR[gbase + (size_t)(c * 16 + vstep) * 256 + rg * 16 + vrow] = Y[vstep * 16 + vrow];
    }
}

DEV void phase_rwkv_post(const Params& p, int l) {
    unsigned char* ws = p.ws;
    const float* YR = (const float*)(ws + OFF_YRAW); const float* BON = (const float*)(ws + OFF_BONUS);
    const u16 *RV = (const u16*)(ws + OFF_RV), *RG = (const u16*)(ws + OFF_RG);
    u16* mix = (u16*)(ws + OFF_MIX);
    const int tid = TID();
    const float lg = p.in[I_LNG][l * 256 + tid], lb = p.in[I_LNB][l * 256 + tid];
    for (int row0 = BID() * 4; row0 < NTOK; row0 += gridDim.x * 4) {
        float y[4], bon[4], vv[4], gg[4];
#pragma unroll
        for (int u = 0; u < 4; ++u) {
            const size_t o = (size_t)(row0 + u) * 256 + tid;
            y[u] = YR[o]; bon[u] = BON[(size_t)(row0 + u) * 4 + (tid >> 6)]; vv[u] = bf2f(RV[o]); gg[u] = bf2f(RG[o]);
        }
#pragma unroll
        for (int u = 0; u < 4; ++u) {
            const float mean = wave_sum(y[u]) * (1.f / 64.f);
            const float d = y[u] - mean;
            const float var = wave_sum(d * d) * (1.f / 64.f);
            const float yn = d * rsqrtf(var + 64e-5f) * lg + lb;
            mix[(size_t)(row0 + u) * 1024 + 256 + tid] = f2bf((yn + bon[u] * vv[u]) * gg[u]);
        }
    }
}

DEV void zero_mix_cols(const Params& p, int c0, int ncols) {
    u16* mix = (u16*)(p.ws + OFF_MIX);
    const int per = ncols / 8;
    const size_t total = (size_t)NTOK * per;
    for (size_t i = (size_t)BID() * 256 + TID(); i < total; i += (size_t)gridDim.x * 256) {
        const size_t row = i / per; const int cc = (int)(i % per);
        *(u32x4*)(mix + row * 1024 + c0 + cc * 8) = (u32x4){0u, 0u, 0u, 0u};
    }
}


DEV void qk_tile(const bf16x8 (&kf)[8], bf16x8 q0, bf16x8 q1, float cinit, f32x4 (&st)[4]) {
    const f32x4 c = (f32x4){cinit, cinit, cinit, cinit};
#pragma unroll
    for (int kt = 0; kt < 4; ++kt) {
        st[kt] = mfma16(kf[2 * kt], q0, c);
        st[kt] = mfma16(kf[2 * kt + 1], q1, st[kt]);
    }
}
DEV void softmax_pv_lazy(f32x4 (&st)[4], const bf16x8 (&vf)[8], float& m, float& l, f32x4& L, f32x4 (&O)[4]) {
    float lmax = fmaxf(fmaxf(fmaxf(st[0][0], st[0][1]), fmaxf(st[0][2], st[0][3])), fmaxf(fmaxf(st[1][0], st[1][1]), fmaxf(st[1][2], st[1][3])));
    lmax = fmaxf(lmax, fmaxf(fmaxf(fmaxf(st[2][0], st[2][1]), fmaxf(st[2][2], st[2][3])), fmaxf(fmaxf(st[3][0], st[3][1]), fmaxf(st[3][2], st[3][3]))));
    lmax = colmax(lmax);
    const float dlt = (lmax > 8.f) ? lmax : 0.f;
    if (__any(dlt > 0.f)) {
        const float alpha = ex2(-dlt);
#pragma unroll
        for (int mt = 0; mt < 4; ++mt) { O[mt][0] *= alpha; O[mt][1] *= alpha; O[mt][2] *= alpha; O[mt][3] *= alpha; }
        L[0] *= alpha; L[1] *= alpha; L[2] *= alpha; L[3] *= alpha; l *= alpha; m += dlt;
#pragma unroll
        for (int kt = 0; kt < 4; ++kt) { st[kt][0] -= dlt; st[kt][1] -= dlt; st[kt][2] -= dlt; st[kt][3] -= dlt; }
    }
#pragma unroll
    for (int kt = 0; kt < 4; ++kt)
#pragma unroll
        for (int r = 0; r < 4; ++r) st[kt][r] = ex2(st[kt][r]);
    union { bf16x8 v; unsigned u[4]; } ones;
    ones.u[0] = 0x3f803f80u; ones.u[1] = 0x3f803f80u; ones.u[2] = 0x3f803f80u; ones.u[3] = 0x3f803f80u;
#pragma unroll
    for (int kb = 0; kb < 2; ++kb) {
        union { bf16x8 v; unsigned u[4]; } pb;
        pb.u[0] = pack2(st[2 * kb][0], st[2 * kb][1]); pb.u[1] = pack2(st[2 * kb][2], st[2 * kb][3]);
        pb.u[2] = pack2(st[2 * kb + 1][0], st[2 * kb + 1][1]); pb.u[3] = pack2(st[2 * kb + 1][2], st[2 * kb + 1][3]);
        L = mfma16(ones.v, pb.v, L);
#pragma unroll
        for (int mt = 0; mt < 4; ++mt) O[mt] = mfma16(vf[kb * 4 + mt], pb.v, O[mt]);
    }
}
DEV void softmax_pv_tile(bool MASK, f32x4 (&st)[4], const bf16x8 (&vf)[8], int keybase, int tcol, int lowcol, bool colsel, float& m, float& l, f32x4& L, f32x4 (&O)[4], int q4) {
    float lmax = -1e30f;
    if (MASK) {
        const int hi = colsel ? tcol : -1;
#pragma unroll
        for (int kt = 0; kt < 4; ++kt)
#pragma unroll
            for (int r = 0; r < 4; ++r) {
                const int key = keybase + kt * 16 + 4 * q4 + r;
                const bool valid = (key <= hi) && (key > lowcol);
                const float sv = valid ? st[kt][r] : -1e30f;
                st[kt][r] = sv; lmax = fmaxf(lmax, sv);
            }
    } else {
        const float cs = colsel ? 0.f : -1e30f;
#pragma unroll
        for (int kt = 0; kt < 4; ++kt)
#pragma unroll
            for (int r = 0; r < 4; ++r) { const float sv = st[kt][r] + cs; st[kt][r] = sv; lmax = fmaxf(lmax, sv); }
    }
    lmax = colmax(lmax);
    const float mnew = fmaxf(m, lmax);
    const float alpha = ex2(m - mnew);
    float psum = 0.f;
#pragma unroll
    for (int kt = 0; kt < 4; ++kt)
#pragma unroll
        for (int r = 0; r < 4; ++r) {
            float pv = ex2(st[kt][r] - mnew);
            if (MASK) pv = (st[kt][r] > -1e29f) ? pv : 0.f;
            st[kt][r] = pv; psum += pv;
        }
    l = l * alpha + psum;
    if (__any(mnew > m)) {
#pragma unroll
        for (int mt = 0; mt < 4; ++mt) { O[mt][0] *= alpha; O[mt][1] *= alpha; O[mt][2] *= alpha; O[mt][3] *= alpha; }
        L[0] *= alpha; L[1] *= alpha; L[2] *= alpha; L[3] *= alpha;
    }
    m = mnew;
#pragma unroll
    for (int kb = 0; kb < 2; ++kb) {
        union { bf16x8 v; unsigned u[4]; } pb;
        pb.u[0] = pack2(st[2 * kb][0], st[2 * kb][1]); pb.u[1] = pack2(st[2 * kb][2], st[2 * kb][3]);
        pb.u[2] = pack2(st[2 * kb + 1][0], st[2 * kb + 1][1]); pb.u[3] = pack2(st[2 * kb + 1][2], st[2 * kb + 1][3]);
#pragma unroll
        for (int mt = 0; mt < 4; ++mt) O[mt] = mfma16(vf[kb * 4 + mt], pb.v, O[mt]);
    }
}
DEV unsigned pick4(unsigned a0, unsigned a1, unsigned a2, unsigned a3, int w) { return w == 0 ? a0 : (w == 1 ? a1 : (w == 2 ? a2 : a3)); }
template <int CTRL> DEV unsigned dpp_or(unsigned x) { return x | dppu<CTRL>(x); }
DEV unsigned row_or(unsigned x) { x = dpp_or<0xB1>(x); x = dpp_or<0x4E>(x); x = dpp_or<0x124>(x); x = dpp_or<0x128>(x); return x; }


DEV void nsa_branch_lds(unsigned char* lds, const u16* __restrict__ K0, const u16* __restrict__ VT0, unsigned bu0, unsigned bu1, unsigned bu2,
                        unsigned bu3, unsigned ua0, unsigned ua1, unsigned ua2, unsigned ua3, unsigned ub0, unsigned ub1, unsigned ub2, unsigned ub3,
                        const unsigned* cm, int tokl, const int (&tcol)[2], const int (&lowc)[2], const bf16x8 (&qf)[2][2], float (&m)[2],
                        float (&l)[2], f32x4 (&L)[2], f32x4 (&O)[2][4], int q4, int cidx, int cur, int lowmax) {
    const int tid = TID();
    int w = 0; unsigned bits = bu0;
    auto advance = [&]() -> int {
        while (bits == 0u && w < 3) { ++w; bits = pick4(bu0, bu1, bu2, bu3, w); }
        if (bits == 0u) return -1;
        const int jb = __builtin_ctz(bits); bits &= bits - 1u;
        return w * 32 + jb;
    };
    const int srow0 = tid >> 3, srow1 = srow0 + 32, sch = tid & 7;
    const int so0 = srow0 * 128 + ((sch ^ (srow0 & 7)) << 4), so1 = srow1 * 128 + ((sch ^ (srow1 & 7)) << 4);
    bf16x8 r0[4], r1[4];
#define NSA_GLOAD(R, BLK_) { R[0] = ld8(K0 + ((size_t)(BLK_) * 64 + srow0) * 64 + sch * 8); R[1] = ld8(K0 + ((size_t)(BLK_) * 64 + srow1) * 64 + sch * 8); \
        R[2] = ld8(VT0 + (size_t)srow0 * 8192 + (BLK_) * 64 + sch * 8); R[3] = ld8(VT0 + (size_t)srow1 * 8192 + (BLK_) * 64 + sch * 8); }
#define NSA_LWRITE(R, BUF_) { unsigned char* wb_ = lds + (BUF_) * 16384; *(bf16x8*)(wb_ + so0) = R[0]; *(bf16x8*)(wb_ + so1) = R[1]; \
        *(bf16x8*)(wb_ + 8192 + so0) = R[2]; *(bf16x8*)(wb_ + 8192 + so1) = R[3]; }
    auto compute = [&](int blk, int buf) {
        const int wq = blk >> 5, jb = blk & 31;
        const bool act0 = (pick4(ua0, ua1, ua2, ua3, wq) >> jb) & 1u, act1 = (pick4(ub0, ub1, ub2, ub3, wq) >> jb) & 1u;
        if (act0 || act1) {
            const unsigned char* kb_ = lds + buf * 16384;
            const bool need_mask = (blk == cur) || (blk * 64 <= lowmax);
            const bool cs0 = cm ? (((cm[tokl * 4 + wq] >> jb) & 1u) != 0u) : true;
            const bool cs1 = cm ? (((cm[(4 + tokl) * 4 + wq] >> jb) & 1u) != 0u) : true;
            const bool lazy = !need_mask && !__any((act0 && m[0] < -1e29f) || (act1 && m[1] < -1e29f));
            f32x4 st0[4], st1[4];
            {
                bf16x8 kf[8];
#pragma unroll
                for (int kt = 0; kt < 4; ++kt)
#pragma unroll
                    for (int s2 = 0; s2 < 2; ++s2) {
                        const int row = 16 * kt + cidx, ch = 4 * s2 + q4;
                        kf[2 * kt + s2] = *(const bf16x8*)(kb_ + row * 128 + ((ch ^ (row & 7)) << 4));
                    }
                if (act0) qk_tile(kf, qf[0][0], qf[0][1], lazy ? (cs0 ? -m[0] : -1e30f) : 0.f, st0);
                if (act1) qk_tile(kf, qf[1][0], qf[1][1], lazy ? (cs1 ? -m[1] : -1e30f) : 0.f, st1);
            }
            __builtin_amdgcn_sched_barrier(0);
            bf16x8 vf[8];
#pragma unroll
            for (int kb = 0; kb < 2; ++kb)
#pragma unroll
                for (int mt = 0; mt < 4; ++mt) {
                    const int row = 16 * mt + cidx, ch = 4 * kb + q4;
                    vf[kb * 4 + mt] = *(const bf16x8*)(kb_ + 8192 + row * 128 + ((ch ^ (row & 7)) << 4));
                }
            if (lazy) {
                if (act0) softmax_pv_lazy(st0, vf, m[0], l[0], L[0], O[0]);
                if (act1) softmax_pv_lazy(st1, vf, m[1], l[1], L[1], O[1]);
            } else {
                if (act0) softmax_pv_tile(need_mask, st0, vf, blk * 64, tcol[0], lowc[0], cs0, m[0], l[0], L[0], O[0], q4);
                if (act1) softmax_pv_tile(need_mask, st1, vf, blk * 64, tcol[1], lowc[1], cs1, m[1], l[1], L[1], O[1], q4);
            }
        }
    };
    int b0 = advance();
    if (b0 < 0) return;
    int b1 = advance();
    NSA_GLOAD(r0, b0);
    if (b1 >= 0) NSA_GLOAD(r1, b1);
    NSA_LWRITE(r0, 0);
    __syncthreads();
#pragma unroll 1
    while (b0 >= 0) {
        const int b2 = (b1 >= 0) ? advance() : -1;
        if (b2 >= 0) NSA_GLOAD(r0, b2);
        compute(b0, 0);
        if (b1 >= 0) NSA_LWRITE(r1, 1);
        __syncthreads();
        if (b1 < 0) break;
        const int b3 = (b2 >= 0) ? advance() : -1;
        if (b3 >= 0) NSA_GLOAD(r1, b3);
        compute(b1, 1);
        if (b2 >= 0) NSA_LWRITE(r0, 0);
        __syncthreads();
        b0 = b2; b1 = b3;
    }
#undef NSA_GLOAD
#undef NSA_LWRITE
}

DEV void nsa_block_task(const Params& p, int task, unsigned char* lds) {
    const int wave = TID() >> 6;
    float* wl = (float*)(lds + 32768) + wave * 2112;
    unsigned* bm = (unsigned*)(lds + 32768 + 4 * 8448);
    float* impA = wl; float* impB = wl + 1024; unsigned* selmask = (unsigned*)(wl + 1024 + 1056);
    unsigned char* ws = p.ws;
    const u16* Q = (const u16*)(ws + OFF_Q);
    const u16* KVb = (const u16*)(ws + OFF_KV);
    const u16 *KSEL = KVb + (size_t)2 * 4194304, *VSELT = KVb + (size_t)3 * 4194304, *KWIN = KVb + (size_t)4 * 4194304, *VWINT = KVb + (size_t)5 * 4194304;
    const u16* KC = (const u16*)(ws + OFF_KC); const u16* VCT = (const u16*)(ws + OFF_VCT);
    const float* GATE = (const float*)(ws + OFF_GATE);
    u16* mix = (u16*)(ws + OFF_MIX);
    const int lane = TID() & 63, q4 = lane >> 4, cidx = lane & 15;
    const int bg = task & 7, t0b = (255 - (task >> 3)) * 32, t0 = t0b + 8 * wave; const int b = bg >> 1, g = bg & 1;
    const int tokl = cidx >> 2, hr = cidx & 3; const int head = g * 4 + hr;
    const int cur = t0 >> 6;
    int tcol[2], rowc[2]; bf16x8 qf[2][2];
#pragma unroll
    for (int ti = 0; ti < 2; ++ti) {
        tcol[ti] = t0 + 4 * ti + tokl; rowc[ti] = b * 8192 + tcol[ti];
        qf[ti][0] = ld8(Q + (size_t)rowc[ti] * 512 + head * 64 + 8 * q4); qf[ti][1] = ld8(Q + (size_t)rowc[ti] * 512 + head * 64 + 32 + 8 * q4);
    }
    f32x4 Oc[2][4];
    {
        int cnt_col[2];
#pragma unroll
        for (int ti = 0; ti < 2; ++ti) cnt_col[ti] = tcol[ti] >= 31 ? ((tcol[ti] - 31) >> 4) + 1 : 0;
        const int tmax = t0 + 7; const int cmax = tmax >= 31 ? ((tmax - 31) >> 4) + 1 : 0;
        const int ntile = (cmax + 15) >> 4;
        const u16* kcb = KC + (size_t)bg * 512 * 64;
        float ml[2] = {-1e30f, -1e30f}, ll[2] = {0.f, 0.f};
#pragma unroll 1
        for (int kt = 0; kt < ntile; ++kt) {
            const u16* kp = kcb + (kt * 16 + cidx) * 64 + 8 * q4;
            const bf16x8 k0 = ld8(kp), k1 = ld8(kp + 32);
#pragma unroll
            for (int ti = 0; ti < 2; ++ti) {
                f32x4 st = mfma16(k0, qf[ti][0], (f32x4){0.f, 0.f, 0.f, 0.f});
                st = mfma16(k1, qf[ti][1], st);
                float sv[4]; float tm = -1e30f;
#pragma unroll
                for (int r = 0; r < 4; ++r) { const int n = kt * 16 + 4 * q4 + r; sv[r] = (n < cnt_col[ti]) ? st[r] : -1e30f; tm = fmaxf(tm, sv[r]); }
                const float mn = fmaxf(ml[ti], tm);
                float ps = 0.f;
#pragma unroll
                for (int r = 0; r < 4; ++r) ps += (sv[r] > -1e29f) ? ex2(sv[r] - mn) : 0.f;
                ll[ti] = ll[ti] * ex2(ml[ti] - mn) + ps; ml[ti] = mn;
            }
        }
        float mfin[2], inv[2];
#pragma unroll
        for (int ti = 0; ti < 2; ++ti) {
            mfin[ti] = colmax(ml[ti]);
            const float lsum = colsum(ll[ti] * ex2(ml[ti] - mfin[ti]));
            inv[ti] = (cnt_col[ti] > 0) ? 1.f / lsum : 0.f;
        }
#pragma unroll
        for (int ti = 0; ti < 2; ++ti)
#pragma unroll
            for (int mt = 0; mt < 4; ++mt) Oc[ti][mt] = (f32x4){0.f, 0.f, 0.f, 0.f};
        const int npair = (ntile + 1) >> 1;
#pragma unroll 1
        for (int kp2 = 0; kp2 < npair; ++kp2) {
            const int n0 = kp2 * 32;
            const u16* kp = kcb + (n0 + cidx) * 64 + 8 * q4;
            const bf16x8 ka0 = ld8(kp), ka1 = ld8(kp + 32), kb0 = ld8(kp + 1024), kb1 = ld8(kp + 1024 + 32);
            bf16x8 vf[4];
#pragma unroll
            for (int mt = 0; mt < 4; ++mt) vf[mt] = ld8(VCT + ((size_t)bg * 64 + 16 * mt + cidx) * 512 + n0 + 8 * q4);
#pragma unroll
            for (int ti = 0; ti < 2; ++ti) {
                float pa[4], pb_[4];
                f32x4 st = mfma16(ka0, qf[ti][0], (f32x4){0.f, 0.f, 0.f, 0.f});
                st = mfma16(ka1, qf[ti][1], st);
                f32x4 su = mfma16(kb0, qf[ti][0], (f32x4){0.f, 0.f, 0.f, 0.f});
                su = mfma16(kb1, qf[ti][1], su);
#pragma unroll
                for (int r = 0; r < 4; ++r) {
                    const int n = n0 + 4 * q4 + r;
                    pa[r] = (n < cnt_col[ti]) ? ex2(st[r] - mfin[ti]) * inv[ti] : 0.f;
                    pb_[r] = (n + 16 < cnt_col[ti]) ? ex2(su[r] - mfin[ti]) * inv[ti] : 0.f;
                }
                const float owna = quadsum(pa[0] + pa[1] + pa[2] + pa[3]), tha = quadsum(pa[3]);
                const float ownb = quadsum(pb_[0] + pb_[1] + pb_[2] + pb_[3]), thb = quadsum(pb_[3]);
                if (hr == 0) {
                    const int tk = 4 * ti + tokl;
                    const int sa = (n0 >> 2) + q4, sb2 = ((n0 + 16) >> 2) + q4;
                    impA[tk * 128 + sa] = owna; impB[tk * 132 + sa + 1] = tha;
                    impA[tk * 128 + sb2] = ownb; impB[tk * 132 + sb2 + 1] = thb;
                }
                union { bf16x8 v; unsigned u[4]; } pk;
                pk.u[0] = pack2(pa[0], pa[1]); pk.u[1] = pack2(pa[2], pa[3]); pk.u[2] = pack2(pb_[0], pb_[1]); pk.u[3] = pack2(pb_[2], pb_[3]);
#pragma unroll
                for (int mt = 0; mt < 4; ++mt) Oc[ti][mt] = mfma16(vf[mt], pk.v, Oc[ti][mt]);
            }
        }
#pragma unroll
        for (int ti = 0; ti < 2; ++ti) {
            const float gc = GATE[(size_t)rowc[ti] * 24 + head];
#pragma unroll
            for (int mt = 0; mt < 4; ++mt)
#pragma unroll
                for (int r = 0; r < 4; ++r) Oc[ti][mt][r] *= gc;
        }
    }
    lds_fence();
#pragma unroll 1
    for (int rd = 0; rd < 2; ++rd) {
        const int tk = 4 * rd + q4;
        unsigned m0 = 0u, m1 = 0u, m2 = 0u, m3 = 0u;
        if (cur < 16) { m0 = (2u << cur) - 1u; }
        else {
            unsigned key[8];
#pragma unroll
            for (int i = 0; i < 8; ++i) {
                const int sblk = cidx + 16 * i;
                const bool cand = (sblk >= 1) && (sblk <= cur - 2);
                const float v = impA[tk * 128 + sblk] + impB[tk * 132 + sblk];
                key[i] = cand ? ((__float_as_uint(v) & ~0x7Fu) | (unsigned)(127 - sblk)) : 0u;
            }
            int mysel = (cidx == 0) ? 0 : (cidx == 1 ? cur - 1 : (cidx == 2 ? cur : -1));
#pragma unroll 1
            for (int it = 0; it < 13; ++it) {
                unsigned mx = key[0];
#pragma unroll
                for (int i = 1; i < 8; ++i) mx = max(mx, key[i]);
                mx = max(mx, dppu<0xB1>(mx)); mx = max(mx, dppu<0x4E>(mx)); mx = max(mx, dppu<0x124>(mx)); mx = max(mx, dppu<0x128>(mx));
                const int sblk = 127 - (int)(mx & 127u);
#pragma unroll
                for (int i = 0; i < 8; ++i) key[i] = (key[i] == mx) ? 0u : key[i];
                if (cidx == it + 3) mysel = sblk;
            }
            const unsigned bit = 1u << (mysel & 31); const int wsel = mysel >> 5;
            m0 = row_or(wsel == 0 ? bit : 0u); m1 = row_or(wsel == 1 ? bit : 0u); m2 = row_or(wsel == 2 ? bit : 0u); m3 = row_or(wsel == 3 ? bit : 0u);
        }
        if (cidx < 4) selmask[tk * 4 + cidx] = (cidx == 0) ? m0 : (cidx == 1 ? m1 : (cidx == 2 ? m2 : m3));
    }
    lds_fence();
    f32x4* accl = (f32x4*)wl;
#pragma unroll
    for (int ti = 0; ti < 2; ++ti)
#pragma unroll
        for (int mt = 0; mt < 4; ++mt) accl[(ti * 4 + mt) * 64 + lane] = Oc[ti][mt];
    {
        float m[2] = {-1e30f, -1e30f}, l[2] = {0.f, 0.f}; f32x4 Os[2][4]; f32x4 Ls[2] = {(f32x4){0.f, 0.f, 0.f, 0.f}, (f32x4){0.f, 0.f, 0.f, 0.f}};
#pragma unroll
        for (int ti = 0; ti < 2; ++ti)
#pragma unroll
            for (int mt = 0; mt < 4; ++mt) Os[ti][mt] = (f32x4){0.f, 0.f, 0.f, 0.f};
        {
            unsigned ua[4], ub[4], bu[4];
#pragma unroll
            for (int w = 0; w < 4; ++w) {
                ua[w] = __builtin_amdgcn_readfirstlane(row_or(selmask[tokl * 4 + w]));
                ub[w] = __builtin_amdgcn_readfirstlane(row_or(selmask[(4 + tokl) * 4 + w]));
            }
            if (lane < 4) bm[wave * 4 + lane] = (lane == 0) ? (ua[0] | ub[0]) : (lane == 1 ? (ua[1] | ub[1]) : (lane == 2 ? (ua[2] | ub[2]) : (ua[3] | ub[3])));
            __syncthreads();
#pragma unroll
            for (int w = 0; w < 4; ++w) bu[w] = __builtin_amdgcn_readfirstlane(bm[w] | bm[4 + w] | bm[8 + w] | bm[12 + w]);
            const int lowc[2] = {-1, -1};
            nsa_branch_lds(lds, KSEL + (size_t)bg * 8192 * 64, VSELT + (size_t)bg * 64 * 8192, bu[0], bu[1], bu[2], bu[3], ua[0], ua[1], ua[2], ua[3], ub[0],
                           ub[1], ub[2], ub[3], selmask, tokl, tcol, lowc, qf, m, l, Ls, Os, q4, cidx, cur, -1);
        }
#pragma unroll
        for (int ti = 0; ti < 2; ++ti) {
            const float sc = GATE[(size_t)rowc[ti] * 24 + 8 + head] / (colsum(l[ti]) + Ls[ti][0]);
#pragma unroll
            for (int mt = 0; mt < 4; ++mt)
#pragma unroll
                for (int r = 0; r < 4; ++r) Os[ti][mt][r] *= sc;
        }
        lds_fence();
#pragma unroll
        for (int ti = 0; ti < 2; ++ti)
#pragma unroll
            for (int mt = 0; mt < 4; ++mt) { f32x4 a = accl[(ti * 4 + mt) * 64 + lane]; a += Os[ti][mt]; accl[(ti * 4 + mt) * 64 + lane] = a; }
    }
    {
        float m[2] = {-1e30f, -1e30f}, l[2] = {0.f, 0.f}; f32x4 Ow[2][4]; f32x4 Ls[2] = {(f32x4){0.f, 0.f, 0.f, 0.f}, (f32x4){0.f, 0.f, 0.f, 0.f}};
#pragma unroll
        for (int ti = 0; ti < 2; ++ti)
#pragma unroll
            for (int mt = 0; mt < 4; ++mt) Ow[ti][mt] = (f32x4){0.f, 0.f, 0.f, 0.f};
        int wb0 = (t0 - 511) >> 6; if (wb0 < 0) wb0 = 0;
        int wbb = (t0b - 511) >> 6; if (wbb < 0) wbb = 0;
        {
            unsigned uw[4], bu[4];
#pragma unroll
            for (int w = 0; w < 4; ++w) {
                const int hi = cur - 32 * w;
                unsigned mk = 0u, mkb = 0u;
                if (hi >= 0) {
                    const unsigned upper = (hi >= 31) ? 0xffffffffu : ((2u << hi) - 1u);
                    const int lo = wb0 - 32 * w, lob = wbb - 32 * w;
                    if (lo <= 31) mk = upper & ~((lo <= 0) ? 0u : ((1u << lo) - 1u));
                    if (lob <= 31) mkb = upper & ~((lob <= 0) ? 0u : ((1u << lob) - 1u));
                }
                uw[w] = mk; bu[w] = mkb;
            }
            const int lowc[2] = {tcol[0] - 512, tcol[1] - 512};
            nsa_branch_lds(lds, KWIN + (size_t)bg * 8192 * 64, VWINT + (size_t)bg * 64 * 8192, bu[0], bu[1], bu[2], bu[3], uw[0], uw[1], uw[2], uw[3], uw[0],
                           uw[1], uw[2], uw[3], nullptr, tokl, tcol, lowc, qf, m, l, Ls, Ow, q4, cidx, cur, t0 + 7 - 512);
        }
#pragma unroll
        for (int ti = 0; ti < 2; ++ti) {
            const float sc = GATE[(size_t)rowc[ti] * 24 + 16 + head] / (colsum(l[ti]) + Ls[ti][0]);
#pragma unroll
            for (int mt = 0; mt < 4; ++mt)
#pragma unroll
                for (int r = 0; r < 4; ++r) Ow[ti][mt][r] *= sc;
        }
        lds_fence();
#pragma unroll
        for (int ti = 0; ti < 2; ++ti)
#pragma unroll
            for (int mt = 0; mt < 4; ++mt) {
                const f32x4 a = accl[(ti * 4 + mt) * 64 + lane];
                const f32x4 o = Ow[ti][mt];
                u32x2 wv; wv[0] = pack2(a[0] + o[0], a[1] + o[1]); wv[1] = pack2(a[2] + o[2], a[3] + o[3]);
                *(u32x2*)(mix + (size_t)rowc[ti] * 1024 + 512 + head * 64 + 16 * mt + 4 * q4) = wv;
            }
    }


    __syncthreads();
}

template <int N> DEV void ltmask(const float (&v)[N], float x, unsigned (&mk)[N / 32]) {
#pragma unroll
    for (int w = 0; w < N / 32; ++w) {
        unsigned a0 = 0u, a1 = 0u, a2 = 0u, a3 = 0u;
#pragma unroll
        for (int i = 0; i < 8; ++i) {
            a0 = __builtin_amdgcn_alignbit(a0, __float_as_uint(v[w * 32 + i] - x), 31);
            a1 = __builtin_amdgcn_alignbit(a1, __float_as_uint(v[w * 32 + 8 + i] - x), 31);
            a2 = __builtin_amdgcn_alignbit(a2, __float_as_uint(v[w * 32 + 16 + i] - x), 31);
            a3 = __builtin_amdgcn_alignbit(a3, __float_as_uint(v[w * 32 + 24 + i] - x), 31);
        }
        mk[w] = (a0 << 24) | (a1 << 16) | (a2 << 8) | a3;
    }
}
template <int N> DEV int count_ge(const float (&v)[N], float x) {
    unsigned mk[N / 32]; ltmask<N>(v, x, mk);
    int lt = 0;
#pragma unroll
    for (int w = 0; w < N / 32; ++w) lt += __popc(mk[w]);
    return colsumi(N - lt);
}
template <int N> DEV void refine16(const float (&v)[N], float lo, int clo, float hi, int chi, float& lo_o, float& hi_o) {
    bool done = false;
    if (clo == 16) { hi = lo; done = true; }
#pragma unroll 1
    for (int it = 0; it < 200; ++it) {
        if (__all(done)) break;
        float f = 0.5f;
        if (!(it & 1)) { f = ((float)clo - 15.5f) / (float)(clo - chi); f = fminf(fmaxf(f, 0.04f), 0.96f); }
        const float mid = lo + (hi - lo) * f;
        const bool stuck = !(mid > lo && mid < hi);
        const int c = count_ge<N>(v, mid);
        if (!done) {
            if (stuck) { if (f != 0.5f) {   } else done = true; }
            else if (c == 16) { lo = mid; hi = mid; done = true; }
            else if (c > 16) { lo = mid; clo = c; }
            else { hi = mid; chi = c; }
        }
    }
    lo_o = lo; hi_o = hi;
}
template <int N> DEV void select16(const float (&v)[N], float& lo_o, float& hi_o) {
    float mx = v[0], sm = v[0];
#pragma unroll
    for (int i = 1; i < N; ++i) { mx = fmaxf(mx, v[i]); sm += v[i]; }
    mx = colmax(mx); sm = colsum(sm);
    const float hi = mx + fabsf(mx) * 1e-6f + 1e-30f;
    float lo = sm * (1.f / (4.f * N));
    int clo = count_ge<N>(v, lo);
    if (__any(clo < 16)) {
        float mn = v[0];
#pragma unroll
        for (int i = 1; i < N; ++i) mn = fminf(mn, v[i]);
        mn = -colmax(-mn);
        if (clo < 16) { lo = mn; clo = 4 * N; }
    }
    refine16<N>(v, lo, clo, hi, 0, lo_o, hi_o);
}
DEV void col_offsets(int cntA, int cntT, int q4, int cidx, int& offA, int& offT) {
    const int g0 = __shfl(cntA, cidx), g1 = __shfl(cntA, cidx + 16), g2 = __shfl(cntA, cidx + 32), g3 = __shfl(cntA, cidx + 48);
    const int e0 = __shfl(cntT, cidx), e1 = __shfl(cntT, cidx + 16), e2 = __shfl(cntT, cidx + 32);
    offA = (q4 > 0 ? g0 : 0) + (q4 > 1 ? g1 : 0) + (q4 > 2 ? g2 : 0);
    offT = g0 + g1 + g2 + g3 + (q4 > 0 ? e0 : 0) + (q4 > 1 ? e1 : 0) + (q4 > 2 ? e2 : 0);
}

DEV void peer_topk_task2(const Params& p, int l, int task, float* wl) {
    unsigned char* ws = p.ws;
    const u16* QP = (const u16*)(ws + OFF_QP);
    const u16* K12 = (const u16*)(ws + OFF_K12) + (size_t)l * 2 * 16384;
    const int lane = TID() & 63, q4 = lane >> 4, cidx = lane & 15;
    const int tq = task * 2 + (cidx >> 3), hh = cidx & 7;
    float* scl = wl;
    float* lst = wl + 2048;
    float* vv[2] = {lst, lst + 512}; int* ii[2] = {(int*)(lst + 256), (int*)(lst + 768)};
    float* fs = lst + 1024; int* fi = (int*)(lst + 1280);
#pragma unroll 1
    for (int hf = 0; hf < 2; ++hf) {
        bf16x8 qf[4];
#pragma unroll
        for (int s2 = 0; s2 < 4; ++s2) qf[s2] = ld8(QP + (size_t)tq * 2048 + hh * 256 + hf * 128 + 32 * s2 + 8 * q4);
        float sc[32];
        const u16* kb = K12 + hf * 16384;
#pragma unroll
        for (int kt = 0; kt < 8; ++kt) {
            f32x4 st = (f32x4){0.f, 0.f, 0.f, 0.f};
#pragma unroll
            for (int s2 = 0; s2 < 4; ++s2) st = mfma16(ld8(kb + (kt * 16 + cidx) * 128 + 32 * s2 + 8 * q4), qf[s2], st);
#pragma unroll
            for (int r = 0; r < 4; ++r) sc[kt * 4 + r] = st[r];
            *(f32x4*)(scl + cidx * 128 + 16 * kt + 4 * q4) = st;
        }
        float lo, hi; select16<32>(sc, lo, hi);
        unsigned mh[1], ml_[1];
        ltmask<32>(sc, hi, mh);
        if (__all(lo == hi)) ml_[0] = mh[0]; else ltmask<32>(sc, lo, ml_);
        unsigned mA = ~mh[0], mT = ~ml_[0] & mh[0];
        int offA, offT; col_offsets(__popc(mA), __popc(mT), q4, cidx, offA, offT);
        float* vo = hf ? vv[1] : vv[0]; int* io = hf ? ii[1] : ii[0];
        while (__any(mA != 0u)) {
            if (mA) {
                const int i = __clz(mA); mA &= ~(0x80000000u >> i);
                io[cidx * 16 + offA] = 16 * (i >> 2) + 4 * q4 + (i & 3); ++offA;
            }
        }
        while (__any(mT != 0u)) {
            if (mT) {
                const int i = __clz(mT); mT &= ~(0x80000000u >> i);
                if (offT < 16) io[cidx * 16 + offT] = 16 * (i >> 2) + 4 * q4 + (i & 3);
                ++offT;
            }
        }
        lds_fence();
        {
            const int4 n4 = *(const int4*)(io + cidx * 16 + 4 * q4);
            float4 v4; v4.x = scl[cidx * 128 + n4.x]; v4.y = scl[cidx * 128 + n4.y]; v4.z = scl[cidx * 128 + n4.z]; v4.w = scl[cidx * 128 + n4.w];
            *(float4*)(vo + cidx * 16 + 4 * q4) = v4;
        }
        lds_fence();
    }
    {
        float cand[64];
        float v2r[16];
#pragma unroll
        for (int j = 0; j < 16; ++j) v2r[j] = vv[1][cidx * 16 + j];
#pragma unroll
        for (int a = 0; a < 4; ++a) {
            const float v1a = vv[0][cidx * 16 + 4 * q4 + a];
#pragma unroll
            for (int j = 0; j < 16; ++j) cand[a * 16 + j] = v1a + v2r[j];
        }
        float lo, hi;
        {
            float v2mx = v2r[0], v2mn = v2r[0];
#pragma unroll
            for (int j = 1; j < 16; ++j) { v2mx = fmaxf(v2mx, v2r[j]); v2mn = fminf(v2mn, v2r[j]); }
            float v1mx = fmaxf(fmaxf(vv[0][cidx * 16 + 4 * q4], vv[0][cidx * 16 + 4 * q4 + 1]), fmaxf(vv[0][cidx * 16 + 4 * q4 + 2], vv[0][cidx * 16 + 4 * q4 + 3]));
            float v1mn = fminf(fminf(vv[0][cidx * 16 + 4 * q4], vv[0][cidx * 16 + 4 * q4 + 1]), fminf(vv[0][cidx * 16 + 4 * q4 + 2], vv[0][cidx * 16 + 4 * q4 + 3]));
            v1mx = colmax(v1mx); v1mn = -colmax(-v1mn);
            const float smax = v1mx + v2mx;
            const float hi0 = smax + fabsf(smax) * 1e-6f + 1e-30f;
            const float lo0 = fmaxf(v1mn + v2mx, v1mx + v2mn);
            const int c0 = count_ge<64>(cand, lo0);
            refine16<64>(cand, lo0, c0, hi0, 0, lo, hi);
        }
        unsigned mh[2], ml_[2];
        ltmask<64>(cand, hi, mh);
        if (__all(lo == hi)) { ml_[0] = mh[0]; ml_[1] = mh[1]; } else ltmask<64>(cand, lo, ml_);
        unsigned mA0 = ~mh[0], mA1 = ~mh[1], mT0 = ~ml_[0] & mh[0], mT1 = ~ml_[1] & mh[1];
        int offA, offT; col_offsets(__popc(mA0) + __popc(mA1), __popc(mT0) + __popc(mT1), q4, cidx, offA, offT);
#pragma unroll
        for (int w = 0; w < 2; ++w) {
            unsigned mA = w ? mA1 : mA0;
            while (__any(mA != 0u)) {
                if (mA) {
                    const int i = __clz(mA); mA &= ~(0x80000000u >> i);
                    const int it = w * 32 + i; const int ci = (4 * q4 + (it >> 4)) * 16 + (it & 15);
                    fi[cidx * 16 + offA] = ci; ++offA;
                }
            }
        }
#pragma unroll
        for (int w = 0; w < 2; ++w) {
            unsigned mT = w ? mT1 : mT0;
            while (__any(mT != 0u)) {
                if (mT) {
                    const int i = __clz(mT); mT &= ~(0x80000000u >> i);
                    const int it = w * 32 + i; const int ci = (4 * q4 + (it >> 4)) * 16 + (it & 15);
                    if (offT < 16) fi[cidx * 16 + offT] = ci;
                    ++offT;
                }
            }
        }
    }
    lds_fence();
    {
        float s4[4]; int c4[4];
#pragma unroll
        for (int k = 0; k < 4; ++k) { c4[k] = fi[cidx * 16 + 4 * q4 + k]; s4[k] = vv[0][cidx * 16 + (c4[k] >> 4)] + vv[1][cidx * 16 + (c4[k] & 15)]; }
        float mx = fmaxf(fmaxf(s4[0], s4[1]), fmaxf(s4[2], s4[3]));
        mx = colmax(mx);
        float e4[4]; float sm = 0.f;
#pragma unroll
        for (int k = 0; k < 4; ++k) { e4[k] = __expf(s4[k] - mx); sm += e4[k]; }
        sm = colsum(sm);
        const float inv = 1.f / sm;
        int4 eo; float4 go;
        eo.x = ii[0][cidx * 16 + (c4[0] >> 4)] * 128 + ii[1][cidx * 16 + (c4[0] & 15)];
        eo.y = ii[0][cidx * 16 + (c4[1] >> 4)] * 128 + ii[1][cidx * 16 + (c4[1] & 15)];
        eo.z = ii[0][cidx * 16 + (c4[2] >> 4)] * 128 + ii[1][cidx * 16 + (c4[2] & 15)];
        eo.w = ii[0][cidx * 16 + (c4[3] >> 4)] * 128 + ii[1][cidx * 16 + (c4[3] & 15)];
        go.x = e4[0] * inv; go.y = e4[1] * inv; go.z = e4[2] * inv; go.w = e4[3] * inv;
        int* eol = (int*)(wl + 3584); float* gol = wl + 3584 + 256;
        *(int4*)(eol + cidx * 16 + 4 * q4) = eo; *(float4*)(gol + cidx * 16 + 4 * q4) = go;
    }
    lds_fence();
}

DEV float gelu_exact(float x) { return 0.5f * x * (1.f + erff(x * 0.70710678118654752f)); }
DEV void unpack8(const bf16x8 v, float* f) {
    union { bf16x8 v; unsigned u[4]; } c; c.v = v;
#pragma unroll
    for (int i = 0; i < 4; ++i) { f[2 * i] = bflo(c.u[i]); f[2 * i + 1] = bfhi(c.u[i]); }
}
DEV void peer_experts_token(const Params& p, int l, int tok, const int* el_src, const float* w_src) {
    unsigned char* ws = p.ws;
    const u16* H = (const u16*)(ws + OFF_H);
    u16* Hw = (u16*)(ws + OFF_H);
    const unsigned char* U8 = ws + OFF_U8;
    const unsigned char* V8 = ws + OFF_U8 + 16 * MiB;
    const float* SU = (const float*)(ws + OFF_UVS);
    const float* SV = (const float*)(ws + OFF_UVS) + 16384;
    const float* mod = (const float*)(ws + OFF_MOD);
    const float* g2 = mod + l * 4 * 6144 + 5 * 1024;
    const int lane = TID() & 63;
    {
        const int b = tok >> 13;
        float acc[16];
#pragma unroll
        for (int i = 0; i < 16; ++i) acc[i] = 0.f;
#if EN_PEER
        unsigned hp[4]; float shq; int corr0;
        {
            float hx[16];
            unpack8(ld8(H + (size_t)tok * 1024 + 16 * lane), hx);
            unpack8(ld8(H + (size_t)tok * 1024 + 16 * lane + 8), hx + 8);
            float amax = 0.f;
#pragma unroll
            for (int i = 0; i < 16; ++i) amax = fmaxf(amax, fabsf(hx[i]));
            amax = wave_max(amax);
            shq = amax > 0.f ? amax * (1.f / 127.f) : 1.f;
            const float inv = 1.f / shq;
            int hsum = 0;
#pragma unroll
            for (int i = 0; i < 4; ++i) {
                const int a = __float2int_rn(hx[4 * i] * inv) + 128, b2 = __float2int_rn(hx[4 * i + 1] * inv) + 128, c = __float2int_rn(hx[4 * i + 2] * inv) + 128,
                          d = __float2int_rn(hx[4 * i + 3] * inv) + 128;
                hp[i] = (unsigned)a | ((unsigned)b2 << 8) | ((unsigned)c << 16) | ((unsigned)d << 24);
                hsum += a + b2 + c + d;
            }
            hsum = wave_sum_i(hsum);
            corr0 = 128 * 128 * 1024 - 128 * hsum;
        }
        const int* RSU = (const int*)(ws + OFF_UVS) + 2 * 16384;
        float corr = 0.f;
        u32x4 uqA[8], vqA[8], uqB[8], vqB[8];
#define PEER_LOAD(UQ, VQ, G_) { const int el_ = el_src[((G_) >> 1) * 16 + (lane & 15)]; const int k0_ = ((G_) & 1) * 8; _Pragma("unroll") for (int k = 0; k < 8; ++k) { \
            const int e = __builtin_amdgcn_readlane(el_, k0_ + k); UQ[k] = *(const u32x4*)(U8 + (size_t)e * 1024 + 16 * lane); VQ[k] = *(const u32x4*)(V8 + (size_t)e * 1024 + 16 * lane); } }
#define PEER_EVAL(UQ, VQ, G_) { const int hh_ = (G_) >> 1, k0_ = ((G_) & 1) * 8; const int el = el_src[hh_ * 16 + (lane & 15)]; const float wgt = w_src[hh_ * 16 + (lane & 15)]; \
            const float sul = SU[el] * shq, wsl = wgt * SV[el]; const int rsl = corr0 - 128 * RSU[el]; \
            int dpart[8]; _Pragma("unroll") for (int k = 0; k < 8; ++k) { unsigned di = 0u; _Pragma("unroll") for (int i = 0; i < 4; ++i) di = __builtin_amdgcn_udot4(UQ[k][i], hp[i], di, false); dpart[k] = (int)di; } \
            const int dsum = reduce8_i(dpart); const int srcl = k0_ + (lane >> 3); \
            const float sul_e = __shfl(sul, srcl), wsl_e = __shfl(wsl, srcl); const int rsl_e = __shfl(rsl, srcl); \
            const float actl = gelu_exact((float)(dsum + rsl_e) * sul_e) * wsl_e; \
            _Pragma("unroll") for (int k = 0; k < 8; ++k) { const float act = __int_as_float(__builtin_amdgcn_readlane(__float_as_int(actl), 8 * k)); corr += act * 128.f; \
                _Pragma("unroll") for (int i = 0; i < 4; ++i) { const unsigned w = VQ[k][i]; \
                    acc[4 * i] += act * (float)(w & 0xffu); acc[4 * i + 1] += act * (float)((w >> 8) & 0xffu); acc[4 * i + 2] += act * (float)((w >> 16) & 0xffu); acc[4 * i + 3] += act * (float)(w >> 24); } } }
        PEER_LOAD(uqA, vqA, 0);
#pragma unroll 1
        for (int g = 0; g < 16; g += 2) {
            PEER_LOAD(uqB, vqB, g + 1);
            PEER_EVAL(uqA, vqA, g);
            if (g + 2 < 16) PEER_LOAD(uqA, vqA, g + 2);
            PEER_EVAL(uqB, vqB, g + 1);
        }
#undef PEER_LOAD
#undef PEER_EVAL
#pragma unroll
        for (int i = 0; i < 16; ++i) acc[i] -= corr;
#endif
        const int k = 16 * lane;
        float xn[16]; float ss = 0.f;
#pragma unroll
        for (int i = 0; i < 4; ++i) {
            const float4 x0 = *(const float4*)(p.out + (size_t)tok * 1024 + k + 4 * i);
            const float4 ga = *(const float4*)(g2 + b * 6144 + k + 4 * i);
            xn[4 * i] = x0.x + ga.x * acc[4 * i]; xn[4 * i + 1] = x0.y + ga.y * acc[4 * i + 1];
            xn[4 * i + 2] = x0.z + ga.z * acc[4 * i + 2]; xn[4 * i + 3] = x0.w + ga.w * acc[4 * i + 3];
        }
#pragma unroll
        for (int i = 0; i < 16; ++i) ss += xn[i] * xn[i];
        ss = wave_sum(ss);
        const float rs = rsqrtf(ss * (1.f / 1024.f) + 1e-6f);
        if (l == 0) {
            const float* n1g = p.in[I_N1G] + 1024; const float* sh = mod + 4 * 6144 + b * 6144; const float* sc = sh + 1024;
            float hv[16];
#pragma unroll
            for (int i = 0; i < 4; ++i) {
                *(float4*)(p.out + (size_t)tok * 1024 + k + 4 * i) = (float4){xn[4 * i], xn[4 * i + 1], xn[4 * i + 2], xn[4 * i + 3]};
                const float4 gg = *(const float4*)(n1g + k + 4 * i), s1 = *(const float4*)(sc + k + 4 * i), s0 = *(const float4*)(sh + k + 4 * i);
                hv[4 * i] = xn[4 * i] * rs * gg.x * (1.f + s1.x) + s0.x; hv[4 * i + 1] = xn[4 * i + 1] * rs * gg.y * (1.f + s1.y) + s0.y;
                hv[4 * i + 2] = xn[4 * i + 2] * rs * gg.z * (1.f + s1.z) + s0.z; hv[4 * i + 3] = xn[4 * i + 3] * rs * gg.w * (1.f + s1.w) + s0.w;
            }
            u32x4 w0, w1;
#pragma unroll
            for (int i = 0; i < 4; ++i) { w0[i] = pack2(hv[2 * i], hv[2 * i + 1]); w1[i] = pack2(hv[8 + 2 * i], hv[8 + 2 * i + 1]); }
            *(u32x4*)(Hw + (size_t)tok * 1024 + k) = w0; *(u32x4*)(Hw + (size_t)tok * 1024 + k + 8) = w1;
        } else {
            const float* fg = p.in[I_FG];
#pragma unroll
            for (int i = 0; i < 4; ++i) {
                const float4 gg = *(const float4*)(fg + k + 4 * i);
                *(float4*)(p.out + (size_t)tok * 1024 + k + 4 * i) = (float4){xn[4 * i] * rs * gg.x, xn[4 * i + 1] * rs * gg.y, xn[4 * i + 2] * rs * gg.z, xn[4 * i + 3] * rs * gg.w};
            }
        }
    }
}

constexpr int NPH = 20;

__global__ void __launch_bounds__(256, 2) mega(Params p) {
    __shared__ __attribute__((aligned(16))) unsigned char lds[81920 - 128];
    __shared__ int misc[8];
    int* qslot = misc;
    cg::grid_group grid = cg::this_grid();
    if (threadIdx.x < 8) misc[threadIdx.x] = 0;
    __syncthreads();
    XcdBarrier xbar = xcd_barrier_post((unsigned*)(p.ws + OFF_BAR), (volatile unsigned*)(misc + 4));
    unsigned char* ws = p.ws;
    const float* mod = (const float*)(ws + OFF_MOD);
    unsigned* ctl = (unsigned*)(ws + OFF_CTL);
    const int G = gridDim.x, bx = BID();
    for (int ph = p.ph_lo; ph < p.ph_hi; ++ph) {
        if (ph >= 2 && (ph - 2) % 9 == 8) continue;
        if (ph == 0) {
            phase_prep(p, lds);
        } else if (ph == 1) {
            phase_norm(p.in[I_X], p.in[I_N1G], mod + 0 * 1024, mod + 1 * 1024, (u16*)(ws + OFF_H));
        } else {
            const int l = (ph - 2) / 9, sp = (ph - 2) % 9;
            const float* modl = mod + l * 4 * 6144;
            if (sp == 0) {
                EpiInProj e{(u16*)(ws + OFF_PCONV), (u16*)(ws + OFF_PRWKV), (u16*)(ws + OFF_Q), (u16*)(ws + OFF_KV), (float*)(ws + OFF_GATE)};
                gemm_phase((const u16*)(ws + OFF_H), 1024, (const u16*)(ws + OFF_WIN) + (size_t)l * NINP * 1024, 1024, 256, 8, 1024, e, lds, bx, G, 0, 4);
            } else if (sp == 1) {
#if EN_RWKV
                for (;;) { const int t = block_next(ctl + QW(l, Q_RWP), qslot); if (t >= NTOK / 16) break; rwkv_prep_tile2(p, l, t, lds); }
#endif
            } else if (sp == 2) {
#if EN_RWKV
                if (bx < 64) { __builtin_amdgcn_s_setprio(3); rwkv_scan(p, bx, lds); __builtin_amdgcn_s_setprio(0); }
#endif
                unsigned* cdone = ctl + QW(l, 5);
                unsigned* gdone = ctl + QW(l, 6);
                if (bx >= 64) {
                    EpiInProj e{(u16*)(ws + OFF_PCONV), (u16*)(ws + OFF_PRWKV), (u16*)(ws + OFF_Q), (u16*)(ws + OFF_KV), (float*)(ws + OFF_GATE)};
                    gemm_phase((const u16*)(ws + OFF_H), 1024, (const u16*)(ws + OFF_WIN) + (size_t)l * NINP * 1024, 1024, 256, 15, 1024, e, lds, bx - 64, G - 64, 4, 8, false);
                    asm volatile("s_waitcnt vmcnt(0)" ::: "memory");
                    __syncthreads();
                    if (threadIdx.x == 0) {
                        __builtin_amdgcn_fence(__ATOMIC_RELEASE, "agent");
                        asm volatile("s_waitcnt vmcnt(0)" ::: "memory");
                        __hip_atomic_fetch_add(gdone, 1u, __ATOMIC_RELAXED, __HIP_MEMORY_SCOPE_AGENT);
                    }
                }
                __syncthreads();
                if (threadIdx.x == 0) {
                    unsigned sp_ = 0;
                    while (__hip_atomic_load(gdone, __ATOMIC_RELAXED, __HIP_MEMORY_SCOPE_AGENT) < (unsigned)(G - 64)) { __builtin_amdgcn_s_sleep(8); if (++sp_ > (1u << 24)) break; }
                    __builtin_amdgcn_fence(__ATOMIC_ACQUIRE, "agent");
                    asm volatile("s_waitcnt vmcnt(0)" ::: "memory");
                }
                __syncthreads();
                if (bx >= 64 && bx < 128) {
                    const u16* KVb = (const u16*)(ws + OFF_KV);
                    if (bx < 96) {
                        EpiCompress ek{(const float*)(ws + OFF_CBP) + (l * 2 + 0) * 2048, p.in[I_CKW2] + (size_t)l * 8192, (u16*)(ws + OFF_KC), 0, lds};
                        gemm_phase(KVb, 1024, (const u16*)(ws + OFF_CW1) + (size_t)(l * 2 + 0) * 128 * 2048, 2048, 32, 1, 2048, ek, lds, bx - 64, 1 << 20);
                    } else {
                        EpiCompress ev{(const float*)(ws + OFF_CBP) + (l * 2 + 1) * 2048, p.in[I_CVW2] + (size_t)l * 8192, (u16*)(ws + OFF_VCT), 1, lds};
                        gemm_phase(KVb + 4194304, 1024, (const u16*)(ws + OFF_CW1) + (size_t)(l * 2 + 1) * 128 * 2048, 2048, 32, 1, 2048, ev, lds, bx - 96, 1 << 20);
                    }
                    asm volatile("s_waitcnt vmcnt(0)" ::: "memory");
                    __syncthreads();
                    if (threadIdx.x == 0) {
                        __builtin_amdgcn_fence(__ATOMIC_RELEASE, "agent");
                        asm volatile("s_waitcnt vmcnt(0)" ::: "memory");
                        __hip_atomic_fetch_add(cdone, 1u, __ATOMIC_RELAXED, __HIP_MEMORY_SCOPE_AGENT);
                    }
                }
#if EN_CONV
                for (;;) { const int t = block_next(ctl + QW(l, Q_CONV), qslot); if (t >= NTOK / 32) break; conv_tile(p, l, t, lds); }
#else
                zero_mix_cols(p, 0, 256);
#endif
                __syncthreads();
                if (threadIdx.x == 0) {
                    unsigned sp_ = 0;
                    while (__hip_atomic_load(cdone, __ATOMIC_RELAXED, __HIP_MEMORY_SCOPE_AGENT) < 64u) { __builtin_amdgcn_s_sleep(8); if (++sp_ > (1u << 24)) break; }
                    __builtin_amdgcn_fence(__ATOMIC_ACQUIRE, "agent");
                    asm volatile("s_waitcnt vmcnt(0)" ::: "memory");
                }
                __syncthreads();
                for (int qi = 0; qi < 8; ++qi) {
                    const int bgq = (bx + qi) & 7;
                    for (;;) { const int t = block_next(ctl + QW(l, Q_NSA) + bgq, qslot); if (t >= 256) break; nsa_block_task(p, t * 8 + bgq, lds); }
                }
                if (l == 0) {
                    float* fl = (float*)lds;
                    for (;;) {
                        const int t = block_next(ctl + QW(0, 0), qslot); if (t >= 1536) break;
                        if (t < 512) { const int l2 = t >> 8, r = t & 255; transpose_tile(p.in[I_WOUT] + (size_t)l2 * 1024 * 1024, 1024, (u16*)(ws + OFF_WOUT) + (size_t)l2 * 1024 * 1024, 1024, r >> 4, r & 15, fl); }
                        else { const int u = t - 512; const int l2 = u >> 9, r = u & 511; transpose_tile(p.in[I_PWQ] + (size_t)l2 * 1024 * 2048, 2048, (u16*)(ws + OFF_WQ) + (size_t)l2 * 2048 * 1024, 1024, r >> 5, r & 31, fl); }
                    }
                }
                for (;;) {
                    const int t = block_next(ctl + QW(l, 7), qslot); if (t >= 1024) break;
                    const int tb = t >> 9, r0 = (t & 511) * 32;
                    convert_rows_task(p.in[tb ? I_PV : I_PU] + (size_t)l * 16384 * 1024, ws + OFF_U8 + (size_t)tb * 16 * MiB, (float*)(ws + OFF_UVS) + tb * 16384,
                                      tb ? nullptr : (int*)(ws + OFF_UVS) + 2 * 16384, r0);
                }
            } else if (sp == 3) {
#if EN_RWKV
                phase_rwkv_post(p, l);
#else
                zero_mix_cols(p, 256, 256);
#endif
            } else if (sp == 4) {
                EpiOutProj e{l == 0 ? p.in[I_X] : p.out, p.out, modl + 2 * 1024};
                gemm_phase((const u16*)(ws + OFF_MIX), 1024, (const u16*)(ws + OFF_WOUT) + (size_t)l * 1024 * 1024, 1024, 256, 8, 1024, e, lds, bx, G);
            } else if (sp == 5) {
#if EN_PEER
                phase_norm(p.out, p.in[I_N2G] + l * 1024, modl + 3 * 1024, modl + 4 * 1024, (u16*)(ws + OFF_H));
#endif
            } else if (sp == 6) {
#if EN_PEER
                EpiStoreBf16 e{(u16*)(ws + OFF_QP), 2048};
                gemm_phase((const u16*)(ws + OFF_H), 1024, (const u16*)(ws + OFF_WQ) + (size_t)l * 2048 * 1024, 1024, 256, 16, 1024, e, lds, bx, G);
#endif
            } else if (sp == 7) {
#if EN_PEER
                float* wl = (float*)lds + (TID() >> 6) * 4096;
                for (int t = bx * 4 + (TID() >> 6); t < NTOK / 2; t += G * 4) {
                    peer_topk_task2(p, l, t, wl);
                    peer_experts_token(p, l, 2 * t, (const int*)(wl + 3584), wl + 3584 + 256);
                    peer_experts_token(p, l, 2 * t + 1, (const int*)(wl + 3584) + 128, wl + 3584 + 256 + 128);
                    lds_fence();
                }
#endif
            }
        }
        if (ph + 1 < p.ph_hi) { if (p.ph_lo < 0) grid.sync(); else xcd_barrier(xbar); }
    }
}

extern "C" void kernel_launch(void* const* d_in, const int* in_sizes, int n_in, void* d_out, int out_size, void* d_ws, size_t ws_size,
                              hipStream_t stream) {
    static int grid_blocks = 0;
    if (!grid_blocks) {
        int dev = 0, cus = 0, per_cu = 0;
        hipGetDevice(&dev);
        hipDeviceGetAttribute(&cus, hipDeviceAttributeMultiprocessorCount, dev);
        hipOccupancyMaxActiveBlocksPerMultiprocessor(&per_cu, (const void*)mega, 256, 0);
        if (per_cu > 2) per_cu = 2;
        if (per_cu < 1) per_cu = 1;
        grid_blocks = cus * per_cu;
        if (ws_size < WS_NEED) fprintf(stderr, "kernel_launch: workspace too small: %zu < %zu\n", ws_size, (size_t)WS_NEED);
    }
    hipMemsetAsync((char*)d_ws + OFF_CTL, 0, CTL_ZERO_BYTES, stream);
    Params p{};
    for (int i = 0; i < 35; ++i) p.in[i] = (const float*)d_in[i];
    p.out = (float*)d_out;
    p.ws = (unsigned char*)d_ws;
#if MULTI_LAUNCH
    for (int ph = 0; ph < NPH; ++ph) {
        p.ph_lo = ph; p.ph_hi = ph + 1;
        hipLaunchKernelGGL(mega, dim3(grid_blocks), dim3(256), 0, stream, p);
    }
#else
    p.ph_lo = 0; p.ph_hi = NPH;
    void* args[] = {&p};
    hipError_t e = hipLaunchCooperativeKernel((const void*)mega, dim3(grid_blocks), dim3(256), args, 0, stream);
    if (e != hipSuccess) fprintf(stderr, "cooperative launch failed: %s (grid %d)\n", hipGetErrorString(e), grid_blocks);
#endif
}
```

```cpp
#include <hip/hip_runtime.h>
#include <hip/hip_cooperative_groups.h>
#include <stdint.h>
#include <stdio.h>
namespace cg = cooperative_groups;

#ifndef EN_CONV
#define EN_CONV 1
#endif
#ifndef EN_RWKV
#define EN_RWKV 1
#endif
#ifndef EN_NSA_CMP
#define EN_NSA_CMP 1
#endif
#ifndef EN_NSA_WIN
#define EN_NSA_WIN 1
#endif
#ifndef EN_NSA_SEL
#define EN_NSA_SEL 1
#endif
#ifndef EN_PEER
#define EN_PEER 1
#endif
#ifndef MULTI_LAUNCH
#define MULTI_LAUNCH 0
#endif

#define DEV __device__ __forceinline__
typedef unsigned short u16;
typedef __attribute__((ext_vector_type(8))) short bf16x8;
typedef __attribute__((ext_vector_type(4))) float f32x4;
typedef __attribute__((ext_vector_type(4))) unsigned int u32x4;
typedef __attribute__((ext_vector_type(2))) unsigned int u32x2;

constexpr int NB = 4, NT = 8192, ND = 1024, NTOK = NB * NT, NL = 2;
constexpr int NIN = 2840, NINP = 2944;
constexpr size_t MiB = 1ull << 20;

constexpr size_t OFF_CTL = 0;
constexpr size_t CTL_ZERO_BYTES = 32768;
constexpr size_t OFF_BAR = 16384;
constexpr size_t OFF_MOD = 64 * 1024;
constexpr size_t OFF_CBP = 256 * 1024;
constexpr size_t OFF_WIN = 1 * MiB;
constexpr size_t OFF_WOUT = 13 * MiB;
constexpr size_t OFF_WQ = 17 * MiB;
constexpr size_t OFF_CW1 = 25 * MiB;
constexpr size_t OFF_K12 = 27 * MiB;
constexpr size_t OFF_LW = 27 * MiB + 512 * 1024;
constexpr size_t OFF_U8 = 28 * MiB;
constexpr size_t OFF_UVS = 512 * 1024;
constexpr size_t OFF_H = 92 * MiB;
constexpr size_t OFF_MIX = 156 * MiB;
constexpr size_t OFF_E = 220 * MiB;
constexpr size_t OFF_PCONV = OFF_E + 0;
constexpr size_t OFF_PRWKV = OFF_E + 32 * MiB;
constexpr size_t OFF_YRAW = OFF_E + 32 * MiB;
constexpr size_t OFF_Q = OFF_E + 96 * MiB;
constexpr size_t OFF_KV = OFF_E + 128 * MiB;
constexpr size_t OFF_GATE = OFF_E + 176 * MiB;
constexpr size_t OFF_KC = OFF_E + 180 * MiB;
constexpr size_t OFF_VCT = OFF_KC + 512 * 1024;
constexpr size_t OFF_RV = OFF_E + 184 * MiB;
constexpr size_t OFF_RKK = OFF_E + 200 * MiB;
constexpr size_t OFF_RKKA = OFF_E + 216 * MiB;
constexpr size_t OFF_RG = OFF_E + 232 * MiB;
constexpr size_t OFF_BONUS = OFF_E + 248 * MiB;
constexpr size_t OFF_RW = OFF_E + 249 * MiB;
constexpr size_t OFF_RR = 60 * MiB;
constexpr size_t OFF_RK = 76 * MiB;
constexpr size_t OFF_QP = OFF_E + 0;
constexpr size_t OFF_PIDX = OFF_E + 128 * MiB;
constexpr size_t OFF_PGW = OFF_E + 144 * MiB;
constexpr size_t WS_NEED = OFF_E + 281 * MiB;

#define QW(l, q) (64 * ((l) * 8 + (q)))
enum { Q_CMP = 0, Q_CONV = 1, Q_RWP = 2, Q_NSA = 3, Q_PTK = 4 };

enum { I_X = 0, I_C, I_ADAW, I_ADAB, I_N1G, I_N2G, I_WIN, I_CDW, I_CDB, I_CGG, I_CGB, I_MU, I_W0, I_WUP, I_A0, I_AUP, I_GUP,
       I_KK, I_KA, I_RK, I_LNG, I_LNB, I_CKPOS, I_CKW1, I_CKW2, I_CVPOS, I_CVW1, I_CVW2, I_WOUT, I_PWQ, I_PK1, I_PK2, I_PU, I_PV, I_FG };

struct Params {
    const float* in[35];
    float* out;
    unsigned char* ws;
    int ph_lo, ph_hi;
};

DEV int TID() { int t = threadIdx.x; asm volatile("" : "+v"(t)); return t; }
DEV int BID() { int t = blockIdx.x; asm volatile("" : "+s"(t)); return t; }
typedef __attribute__((ext_vector_type(2))) float f32x2_t;
typedef __attribute__((ext_vector_type(2))) __bf16 bf16x2_t;
DEV unsigned pack2(float a, float b) { const f32x2_t v = {a, b}; return __builtin_bit_cast(unsigned, __builtin_convertvector(v, bf16x2_t)); }
DEV u16 f2bf(float f) { const __bf16 h = (__bf16)f; return __builtin_bit_cast(u16, h); }
DEV float bf2f(u16 h) { return __uint_as_float(((unsigned)h) << 16); }
DEV float bflo(unsigned u) { return __uint_as_float(u << 16); }
DEV float bfhi(unsigned u) { return __uint_as_float(u & 0xffff0000u); }
DEV float ex2(float x) { return __builtin_amdgcn_exp2f(x); }
DEV float sigmoidf_(float x) { return 1.f / (1.f + __expf(-x)); }

DEV f32x4 mfma16(bf16x8 a, bf16x8 b, f32x4 c) { return __builtin_amdgcn_mfma_f32_16x16x32_bf16(a, b, c, 0, 0, 0); }
template <int CTRL> DEV float dppf(float x) { return __int_as_float(__builtin_amdgcn_update_dpp(0, __float_as_int(x), CTRL, 0xF, 0xF, false)); }
template <int CTRL> DEV unsigned dppu(unsigned x) { return (unsigned)__builtin_amdgcn_update_dpp(0, (int)x, CTRL, 0xF, 0xF, false); }
DEV float reduce16(float x) { x += dppf<0xB1>(x); x += dppf<0x4E>(x); x += dppf<0x124>(x); x += dppf<0x128>(x); return x; }
DEV float quadsum(float x) { x += dppf<0xB1>(x); x += dppf<0x4E>(x); return x; }
DEV float x16_sum(float x) { auto r = __builtin_amdgcn_permlane16_swap(__float_as_uint(x), __float_as_uint(x), false, false); return __uint_as_float(r[0]) + __uint_as_float(r[1]); }
DEV float x32_sum(float x) { auto r = __builtin_amdgcn_permlane32_swap(__float_as_uint(x), __float_as_uint(x), false, false); return __uint_as_float(r[0]) + __uint_as_float(r[1]); }
DEV float x16_max(float x) { auto r = __builtin_amdgcn_permlane16_swap(__float_as_uint(x), __float_as_uint(x), false, false); return fmaxf(__uint_as_float(r[0]), __uint_as_float(r[1])); }
DEV float x32_max(float x) { auto r = __builtin_amdgcn_permlane32_swap(__float_as_uint(x), __float_as_uint(x), false, false); return fmaxf(__uint_as_float(r[0]), __uint_as_float(r[1])); }
DEV int x16_sumi(int x) { auto r = __builtin_amdgcn_permlane16_swap((unsigned)x, (unsigned)x, false, false); return (int)(r[0] + r[1]); }
DEV int x32_sumi(int x) { auto r = __builtin_amdgcn_permlane32_swap((unsigned)x, (unsigned)x, false, false); return (int)(r[0] + r[1]); }
DEV float colsum(float x) { return x32_sum(x16_sum(x)); }
DEV float colmax(float x) { return x32_max(x16_max(x)); }
DEV int colsumi(int x) { return x32_sumi(x16_sumi(x)); }
DEV float wave_sum(float v) { return x32_sum(x16_sum(reduce16(v))); }
DEV int wave_sum_i(int x) {
    x += (int)dppu<0xB1>((unsigned)x); x += (int)dppu<0x4E>((unsigned)x); x += (int)dppu<0x124>((unsigned)x); x += (int)dppu<0x128>((unsigned)x);
    return x32_sumi(x16_sumi(x));
}
DEV int reduce8_i(const int (&d)[8]) {
    int t[4];
#pragma unroll
    for (int k = 0; k < 4; ++k) {
        auto r = __builtin_amdgcn_permlane32_swap((unsigned)d[k], (unsigned)d[k + 4], false, false);
        t[k] = (int)(r[0] + r[1]);
    }
    int u[2];
#pragma unroll
    for (int k = 0; k < 2; ++k) {
        auto r = __builtin_amdgcn_permlane16_swap((unsigned)t[k], (unsigned)t[k + 2], false, false);
        u[k] = (int)(r[0] + r[1]);
    }
    const bool hi8 = (threadIdx.x & 8) != 0;
    int x = hi8 ? u[1] : u[0];
    const int y = hi8 ? u[0] : u[1];
    x += (int)dppu<0x128>((unsigned)y);
    x += (int)dppu<0xB1>((unsigned)x); x += (int)dppu<0x4E>((unsigned)x); x += (int)dppu<0x141>((unsigned)x);
    return x;
}
DEV float wave_max(float x) {
    x = fmaxf(x, dppf<0xB1>(x)); x = fmaxf(x, dppf<0x4E>(x)); x = fmaxf(x, dppf<0x124>(x)); x = fmaxf(x, dppf<0x128>(x));
    return x32_max(x16_max(x));
}
DEV void lds_fence() { asm volatile("s_waitcnt lgkmcnt(0)" ::: "memory"); }
DEV bf16x8 ld8(const u16* p) { return *(const bf16x8*)p; }

DEV int block_next(unsigned* ctr, int* slot) {
    __syncthreads();
    if (TID() == 0) *slot = (int)atomicAdd(ctr, 1u);
    __syncthreads();
    return *slot;
}

#define XB_TMO      128
#define XB_XCNT(j)  (256  + 64 * (j))
#define XB_XSUB(j)  (1280 + 64 * (j))
#define XB_XGEN(j)  (2304 + 64 * (j))
#define XB_TOP      3328
#define XB_TOPGEN   3392
#define XCD_BAR_WORDS 3456
#define XB_SPIN_CAP (1u << 22)
#define LAS __attribute__((address_space(3)))
DEV unsigned xb_ld(unsigned* p) { return __hip_atomic_load(p, __ATOMIC_RELAXED, __HIP_MEMORY_SCOPE_AGENT); }
DEV unsigned xb_add(unsigned* p, unsigned v) { return __hip_atomic_fetch_add(p, v, __ATOMIC_RELAXED, __HIP_MEMORY_SCOPE_AGENT); }
DEV unsigned xb_xcc_id() { return (unsigned)__builtin_amdgcn_s_getreg((3 << 11) | 20) & 0xFu; }
#define XB_SPIN(cond, bar) do { unsigned _sp = 0; while (cond) { __builtin_amdgcn_s_sleep(1); \
    if ((++_sp & 255u) == 0u) { if (xb_ld(&(bar)[XB_TMO])) break; if (_sp > XB_SPIN_CAP) { atomicAdd(&(bar)[XB_TMO], 1u); break; } } } } while (0)
struct XcdBarrier { unsigned* bar; unsigned x; volatile unsigned* st; };
DEV XcdBarrier xcd_barrier_post(unsigned* bar, volatile unsigned* st) {
    XcdBarrier b; b.bar = bar; b.x = xb_xcc_id(); b.st = st;
    if (threadIdx.x == 0) (void)xb_add(&bar[XB_XCNT(b.x)], 1u);
    return b;
}
DEV void xcd_barrier_complete(unsigned* bar, unsigned x, unsigned& nloc, unsigned& nx) {
    const unsigned G = gridDim.x * gridDim.y * gridDim.z;
    unsigned sum, cnt, mine, sp = 0u;
    for (;;) {
        sum = 0u; cnt = 0u; mine = 0u;
#pragma unroll
        for (unsigned j = 0; j < 16; ++j) { const unsigned c = xb_ld(&bar[XB_XCNT(j)]); sum += c; cnt += (c > 0u) ? 1u : 0u; mine = (j == x) ? c : mine; }
        if (sum == G) break;
        __builtin_amdgcn_s_sleep(1);
        if ((++sp & 255u) == 0u) { if (xb_ld(&bar[XB_TMO])) break; if (sp > XB_SPIN_CAP) { atomicAdd(&bar[XB_TMO], 1u); break; } }
    }
    nloc = mine > 0u ? mine : 1u; nx = cnt > 0u ? cnt : 1u;
}
DEV void xcd_barrier(const XcdBarrier& b) {
    asm volatile("s_waitcnt vmcnt(0)" ::: "memory");
    __syncthreads();
    if (threadIdx.x == 0) {
        unsigned* bar = b.bar;
        __builtin_amdgcn_s_waitcnt(0);
        unsigned nloc = b.st[0], nx = b.st[1];
        if (nloc == 0u) { xcd_barrier_complete(bar, b.x, nloc, nx); b.st[0] = nloc; b.st[1] = nx; }
        const unsigned old = xb_add(&bar[XB_XSUB(b.x)], 1u);
        const unsigned gen = old / nloc;
        if (old + 1u == (gen + 1u) * nloc) {
            __builtin_amdgcn_fence(__ATOMIC_RELEASE, "agent");
            asm volatile("s_waitcnt vmcnt(0)" ::: "memory");
            const unsigned og = xb_add(&bar[XB_TOP], 1u);
            const unsigned tg = og / nx;
            if (og + 1u == (tg + 1u) * nx) xb_add(&bar[XB_TOPGEN], 1u);
            else XB_SPIN(xb_ld(&bar[XB_TOPGEN]) == tg, bar);
            __builtin_amdgcn_fence(__ATOMIC_ACQUIRE, "agent");
            xb_add(&bar[XB_XGEN(b.x)], 1u);
            asm volatile("s_waitcnt vmcnt(0)" ::: "memory");
        } else {
            XB_SPIN(xb_ld(&bar[XB_XGEN(b.x)]) == gen, bar);
            __builtin_amdgcn_fence(__ATOMIC_ACQUIRE, "agent");
            asm volatile("s_waitcnt vmcnt(0)" ::: "memory");
        }
    }
    __syncthreads();
}

template <class Epi>
DEV void gemm_phase(const u16* __restrict__ A, int lda, const u16* __restrict__ Bt, int ldb, int mtiles, int ntiles, int K, Epi& epi,
                    unsigned char* lds, int bid, int nb, int nt_lo = 0, int nt_skip = 0, bool xcd_order = true) {
    const int tid = TID(), lane = tid & 63, wave = tid >> 6;
    const int wm = wave >> 1, wn = wave & 1, q4 = lane >> 4, cidx = lane & 15;
    u16* As = (u16*)lds;
    u16* Bs = (u16*)(lds + 32768);
    const int KT = K >> 6;
    const int total = mtiles * ntiles;
    const int srow = tid >> 3, sch = tid & 7;
    const bool xo_ = xcd_order && ((nb & 7) == 0) && (nb <= 4096) && ((mtiles & 7) == 0);
    const int ngroups = (ntiles + 7) >> 3;
    const int nloc = xo_ ? (nb >> 3) : 1;
    const int nvirt = xo_ ? ((mtiles >> 3) * ngroups * 64) : total;
    for (int vt = xo_ ? ((bid & 7) * 64 + (bid >> 3)) : bid; vt < nvirt; vt += xo_ ? ((((vt & 63) + nloc) < 64) ? nloc : (8 * 64 - (vt & 63) + (bid >> 3))) : nb) {
        int mt, nt;
        if (xo_) {
            const int st = vt >> 6, tt = vt & 63;
            mt = (st / ngroups) * 8 + (tt >> 3); nt = (st % ngroups) * 8 + (tt & 7);
            if (nt >= ntiles) continue;
        } else { mt = vt / ntiles; nt = vt - mt * ntiles; }
        if (nt >= nt_lo) nt += nt_skip;
        const int m0 = mt * 128, n0 = nt * 128;
        const bool sw = epi.swapped(n0 + wn * 64);
        const int xo = sw ? (32768 / 2 + wn * 64 * 64) : (wm * 64 * 64);
        const int yo = sw ? (wm * 64 * 64) : (32768 / 2 + wn * 64 * 64);
        f32x4 acc[4][4];
#pragma unroll
        for (int i = 0; i < 4; ++i)
#pragma unroll
            for (int j = 0; j < 4; ++j) acc[i][j] = (f32x4){0.f, 0.f, 0.f, 0.f};
        const u16* Ag = A + (size_t)(m0 + srow) * lda + sch * 8;
        const u16* Bg = Bt + (size_t)(n0 + srow) * ldb + sch * 8;
        bf16x8 ra0[4], rb0[4], ra1[4], rb1[4];
#define GEMM_GLOAD(RA, RB, KT_) { const int k0_ = (KT_) * 64; _Pragma("unroll") for (int i = 0; i < 4; ++i) { RA[i] = ld8(Ag + (size_t)(32 * i) * lda + k0_); RB[i] = ld8(Bg + (size_t)(32 * i) * ldb + k0_); } }
#define GEMM_LWRITE(RA, RB, BUF_) { u16* Aw_ = As + (BUF_) * 8192; u16* Bw_ = Bs + (BUF_) * 8192; _Pragma("unroll") for (int i = 0; i < 4; ++i) { const int row = srow + 32 * i; const int off = row * 64 + ((sch ^ (row & 7)) << 3); *(bf16x8*)(Aw_ + off) = RA[i]; *(bf16x8*)(Bw_ + off) = RB[i]; } }
#define GEMM_COMPUTE(BUF_) { const u16* Xb = As + (BUF_) * 8192 + xo; const u16* Yb = As + (BUF_) * 8192 + yo; _Pragma("unroll") for (int s = 0; s < 2; ++s) { bf16x8 a[4], b[4]; const int ch = s * 4 + q4; _Pragma("unroll") for (int i = 0; i < 4; ++i) { const int row = i * 16 + cidx; a[i] = *(const bf16x8*)(Xb + row * 64 + ((ch ^ (row & 7)) << 3)); b[i] = *(const bf16x8*)(Yb + row * 64 + ((ch ^ (row & 7)) << 3)); } _Pragma("unroll") for (int i = 0; i < 4; ++i) _Pragma("unroll") for (int j = 0; j < 4; ++j) acc[i][j] = mfma16(a[i], b[j], acc[i][j]); } }
        GEMM_GLOAD(ra0, rb0, 0);
        if (KT > 1) GEMM_GLOAD(ra1, rb1, 1);
        GEMM_LWRITE(ra0, rb0, 0);
        __syncthreads();
        for (int kt = 0; kt < KT; kt += 2) {
            if (kt + 2 < KT) GEMM_GLOAD(ra0, rb0, kt + 2);
            GEMM_COMPUTE(0);
            GEMM_LWRITE(ra1, rb1, 1);
            __syncthreads();
            if (kt + 3 < KT) GEMM_GLOAD(ra1, rb1, kt + 3);
            GEMM_COMPUTE(1);
            if (kt + 2 < KT) GEMM_LWRITE(ra0, rb0, 0);
            __syncthreads();
        }
#undef GEMM_GLOAD
#undef GEMM_LWRITE
#undef GEMM_COMPUTE
        if (!sw) {
#pragma unroll
            for (int i = 0; i < 4; ++i)
#pragma unroll
                for (int j = 0; j < 4; ++j) epi.rows4(m0 + wm * 64 + i * 16 + q4 * 4, n0 + wn * 64 + j * 16 + cidx, acc[i][j]);
        } else {
#pragma unroll
            for (int i = 0; i < 4; ++i)
#pragma unroll
                for (int j = 0; j < 4; ++j) epi.cols4(m0 + wm * 64 + j * 16 + cidx, n0 + wn * 64 + i * 16 + q4 * 4, acc[i][j]);
        }
        epi.finish(m0, n0, lds);
    }
}

struct EpiInProj {
    u16 *pconv, *prwkv, *q, *kv; float* gate;
    DEV bool swapped(int c0) const { return !((c0 >= 2432 && c0 < 2560) || (c0 >= 2688 && c0 < 2816)); }
    DEV void rows4(int row0, int col, f32x4 v) const {
        const int c = col - 2048; const int idx = c >> 7; const int g = (c >> 6) & 1; const int d = c & 63;
        const int b = row0 >> 13; const int t0 = row0 & 8191; const int bg = b * 2 + g;
        u16* base = kv + (size_t)idx * 4194304;
        const int k = t0 & 31; const int p0 = 8 * ((k & 15) >> 2) + 4 * (k >> 4);
        u32x2 w; w[0] = pack2(v[0], v[1]); w[1] = pack2(v[2], v[3]);
        *(u32x2*)(base + (size_t)(bg * 64 + d) * 8192 + (t0 & ~31) + p0) = w;
    }
    DEV void cols4(int row, int col0, f32x4 v) const {
        if (col0 < 512) {
            u32x2 w; w[0] = pack2(v[0], v[1]); w[1] = pack2(v[2], v[3]);
            *(u32x2*)(pconv + (size_t)row * 512 + col0) = w;
        } else if (col0 < 1536) {
            u32x2 w; w[0] = pack2(v[0], v[1]); w[1] = pack2(v[2], v[3]);
            *(u32x2*)(prwkv + (size_t)row * 1024 + (col0 - 512)) = w;
        } else if (col0 < 2048) {
            const float sc = 0.18033688011112042f;
            u32x2 w; w[0] = pack2(v[0] * sc, v[1] * sc); w[1] = pack2(v[2] * sc, v[3] * sc);
            *(u32x2*)(q + (size_t)row * 512 + (col0 - 1536)) = w;
        } else if (col0 < 2816) {
            const int c = col0 - 2048; const int idx = c >> 7; const int g = (c >> 6) & 1; const int d = c & 63;
            const int b = row >> 13; const int t = row & 8191; const int bg = b * 2 + g;
            u32x2 w; w[0] = pack2(v[0], v[1]); w[1] = pack2(v[2], v[3]);
            *(u32x2*)(kv + (size_t)idx * 4194304 + ((size_t)bg * 8192 + t) * 64 + d) = w;
        } else if (col0 < 2840) {
            *(float4*)(gate + (size_t)row * 24 + (col0 - 2816)) = (float4){sigmoidf_(v[0]), sigmoidf_(v[1]), sigmoidf_(v[2]), sigmoidf_(v[3])};
        }
    }
    DEV void finish(int, int, unsigned char*) const {}
};

struct EpiOutProj {
    const float* xold; float* xnew; const float* g1;
    DEV bool swapped(int) const { return true; }
    DEV void rows4(int, int, f32x4) const {}
    DEV void cols4(int row, int col0, f32x4 v) const {
        const int b = row >> 13; const float4 gg = *(const float4*)(g1 + b * 6144 + col0);
        const size_t o = (size_t)row * 1024 + col0;
        const float4 x = *(const float4*)(xold + o);
        *(float4*)(xnew + o) = (float4){x.x + gg.x * v[0], x.y + gg.y * v[1], x.z + gg.z * v[2], x.w + gg.w * v[3]};
    }
    DEV void finish(int, int, unsigned char*) const {}
};

struct EpiStoreBf16 {
    u16* out; int ld;
    DEV bool swapped(int) const { return true; }
    DEV void rows4(int, int, f32x4) const {}
    DEV void cols4(int row, int col0, f32x4 v) const {
        u32x2 w; w[0] = pack2(v[0], v[1]); w[1] = pack2(v[2], v[3]);
        *(u32x2*)(out + (size_t)row * ld + col0) = w;
    }
    DEV void finish(int, int, unsigned char*) const {}
};

struct EpiCompress {
    const float* cbp;
    const float* w2;
    u16* outp;
    int isv;
    unsigned char* lds;
    DEV bool swapped(int) const { return false; }
    DEV void cols4(int, int, f32x4) const {}
    DEV void rows4(int row0, int col, f32x4 v) const {
        float* hid = (float*)lds;
        const int rl = row0 & 127;
#pragma unroll
        for (int r = 0; r < 4; ++r) hid[(rl + r) * 128 + col] = v[r];
    }
    DEV void finish(int m0, int, unsigned char*) const {
        __syncthreads();
        {
            float* hw = (float*)lds;
            const int t = TID(); const int c = t & 127, r0 = (t >> 7) * 64;
            float bias = 0.f;
#pragma unroll
            for (int s = 0; s < 16; ++s) bias += cbp[s * 128 + c];
#pragma unroll 4
            for (int r = 0; r < 64; ++r) { const float x = hw[(r0 + r) * 128 + c] + bias; hw[(r0 + r) * 128 + c] = x * sigmoidf_(x); }
        }
        __syncthreads();
        const float* hid = (const float*)lds;
        const int tid = TID(); const int d = tid & 63, rgp = tid >> 6;
        float acc[32];
#pragma unroll
        for (int i = 0; i < 32; ++i) acc[i] = 0.f;
#pragma unroll 1
        for (int j0 = 0; j0 < 128; j0 += 8) {
            float wv[8];
#pragma unroll
            for (int jj = 0; jj < 8; ++jj) wv[jj] = w2[(j0 + jj) * 64 + d];
#pragma unroll
            for (int rr = 0; rr < 32; ++rr) {
                const float4 h0 = *(const float4*)(hid + (rgp * 32 + rr) * 128 + j0), h1 = *(const float4*)(hid + (rgp * 32 + rr) * 128 + j0 + 4);
                acc[rr] += h0.x * wv[0] + h0.y * wv[1] + h0.z * wv[2] + h0.w * wv[3] + h1.x * wv[4] + h1.y * wv[5] + h1.z * wv[6] + h1.w * wv[7];
            }
        }
#pragma unroll
        for (int rr = 0; rr < 32; ++rr) {
            const int m = m0 + rgp * 32 + rr; const int bg = m >> 9, n = m & 511;
            const u16 val = (n == 511) ? (u16)0 : f2bf(acc[rr]);
            if (!isv) outp[((size_t)bg * 512 + n) * 64 + d] = val;
            else {
                const int k = n & 31; const int pp = 8 * ((k & 15) >> 2) + (k & 3) + 4 * (k >> 4);
                outp[((size_t)bg * 64 + d) * 512 + (n & ~31) + pp] = val;
            }
        }
        __syncthreads();
    }
};

DEV void transpose_tile(const float* __restrict__ src, int N, u16* __restrict__ dst, int ldk, int kt, int nt, float* tl) {
    const int tid = TID(); const int k0 = kt * 64, n0 = nt * 64;
#pragma unroll 4
    for (int i = 0; i < 16; ++i) {
        const int idx = tid + 256 * i; const int kr = idx >> 6, nc = idx & 63; const int n = n0 + nc;
        tl[kr * 65 + nc] = (n < N) ? src[(size_t)(k0 + kr) * N + n] : 0.f;
    }
    __syncthreads();
#pragma unroll 4
    for (int i = 0; i < 16; ++i) {
        const int idx = tid + 256 * i; const int nr = idx >> 6, kc = idx & 63;
        dst[(size_t)(n0 + nr) * ldk + k0 + kc] = f2bf(tl[kc * 65 + nr]);
    }
    __syncthreads();
}

DEV void convert_straight(const float* __restrict__ src, u16* __restrict__ dst, size_t n) {
    const size_t stride = (size_t)gridDim.x * 256 * 8;
    for (size_t i = ((size_t)BID() * 256 + TID()) * 8; i < n; i += stride) {
        const float4 a = *(const float4*)(src + i); const float4 b = *(const float4*)(src + i + 4);
        u32x4 w; w[0] = pack2(a.x, a.y); w[1] = pack2(a.z, a.w); w[2] = pack2(b.x, b.y); w[3] = pack2(b.z, b.w);
        *(u32x4*)(dst + i) = w;
    }
}

DEV void convert_rows_task(const float* __restrict__ src, unsigned char* __restrict__ dst, float* __restrict__ scale, int* __restrict__ rowsum, int row0) {
    const int lane = TID() & 63, wave = TID() >> 6;
#pragma unroll 1
    for (int it = 0; it < 4; ++it) {
        float4 v[2][4]; float amax[2] = {0.f, 0.f};
#pragma unroll
        for (int u = 0; u < 2; ++u) {
            const int row = row0 + wave * 8 + it * 2 + u;
#pragma unroll
            for (int i = 0; i < 4; ++i) v[u][i] = *(const float4*)(src + (size_t)row * 1024 + 16 * lane + 4 * i);
        }
#pragma unroll
        for (int u = 0; u < 2; ++u) {
#pragma unroll
            for (int i = 0; i < 4; ++i)
                amax[u] = fmaxf(amax[u], fmaxf(fmaxf(fabsf(v[u][i].x), fabsf(v[u][i].y)), fmaxf(fabsf(v[u][i].z), fabsf(v[u][i].w))));
            amax[u] = wave_max(amax[u]);
            const int row = row0 + wave * 8 + it * 2 + u;
            const float sc = amax[u] > 0.f ? amax[u] * (1.f / 127.f) : 1.f;
            const float inv = 1.f / sc;
            u32x4 w;
#pragma unroll
            for (int i = 0; i < 4; ++i) {
                const int a = __float2int_rn(v[u][i].x * inv) + 128, b = __float2int_rn(v[u][i].y * inv) + 128, c = __float2int_rn(v[u][i].z * inv) + 128,
                          d = __float2int_rn(v[u][i].w * inv) + 128;
                w[i] = (unsigned)a | ((unsigned)b << 8) | ((unsigned)c << 16) | ((unsigned)d << 24);
            }
            *(u32x4*)(dst + (size_t)row * 1024 + 16 * lane) = w;
            int bs = 0;
#pragma unroll
            for (int i = 0; i < 4; ++i) bs += (int)(w[i] & 0xffu) + (int)((w[i] >> 8) & 0xffu) + (int)((w[i] >> 16) & 0xffu) + (int)(w[i] >> 24);
            bs = wave_sum_i(bs);
            if (lane == 0) { scale[row] = sc; if (rowsum) rowsum[row] = bs; }
        }
    }
}

DEV void phase_prep(const Params& p, unsigned char* lds) {
    const int tid = TID();
    float* fl = (float*)lds;
    unsigned char* ws = p.ws;
    for (int task = BID(); task < 192; task += gridDim.x) {
        const int l = task / 96, cgp = task % 96;
        float* cs = fl;
        float* red = fl + 4096;
        for (int i = tid; i < 4096; i += 256) { const float c = p.in[I_C][i]; cs[i] = c / (1.f + __expf(-c)); }
        __syncthreads();
        const int col = cgp * 64 + (tid & 63), ks = tid >> 6;
        float a0 = 0, a1 = 0, a2 = 0, a3 = 0;
        const float* w = p.in[I_ADAW] + ((size_t)l * 1024 + ks * 256) * 6144 + col;
#pragma unroll 32
        for (int k = 0; k < 256; ++k) {
            const float wv = w[(size_t)k * 6144]; const int kk = ks * 256 + k;
            a0 += cs[kk] * wv; a1 += cs[1024 + kk] * wv; a2 += cs[2048 + kk] * wv; a3 += cs[3072 + kk] * wv;
        }
        red[(ks * 4 + 0) * 64 + (tid & 63)] = a0; red[(ks * 4 + 1) * 64 + (tid & 63)] = a1;
        red[(ks * 4 + 2) * 64 + (tid & 63)] = a2; red[(ks * 4 + 3) * 64 + (tid & 63)] = a3;
        __syncthreads();
        {
            const int b = tid >> 6, c = tid & 63;
            const float s = red[(0 * 4 + b) * 64 + c] + red[(1 * 4 + b) * 64 + c] + red[(2 * 4 + b) * 64 + c] + red[(3 * 4 + b) * 64 + c];
            const int colg = cgp * 64 + c;
            ((float*)(ws + OFF_MOD))[(l * 4 + b) * 6144 + colg] = s + p.in[I_ADAB][l * 6144 + colg];
        }
        __syncthreads();
    }
    for (int task = BID(); task < 64; task += gridDim.x) {
        const int l = task >> 5, kv = (task >> 4) & 1, s = task & 15;
        const float* pos = p.in[kv ? I_CVPOS : I_CKPOS] + l * 2048;
        const float* w1 = p.in[kv ? I_CVW1 : I_CKW1] + (size_t)l * 2048 * 128;
        const int col = tid & 127, half = tid >> 7;
        float a = 0;
        const int i0 = s * 128 + half * 64;
#pragma unroll 8
        for (int i = 0; i < 64; ++i) a += pos[i0 + i] * w1[(size_t)(i0 + i) * 128 + col];
        fl[tid] = a;
        __syncthreads();
        if (tid < 128) ((float*)(ws + OFF_CBP))[((l * 2 + kv) * 16 + s) * 128 + tid] = fl[tid] + fl[tid + 128];
        __syncthreads();
    }
    {
        for (int task = BID(); task < 2 * 16 * 46; task += gridDim.x) {
            const int l = task / (16 * 46), r = task % (16 * 46);
            transpose_tile(p.in[I_WIN] + (size_t)l * 1024 * NIN, NIN, (u16*)(ws + OFF_WIN) + (size_t)l * NINP * 1024, 1024, r / 46, r % 46, fl);
        }
        for (int task = BID(); task < 2 * 16; task += gridDim.x) {
            const int l = task >> 4, r = task & 15; const int nt = r & 3, part = r >> 2;
            u16* dst = (u16*)(ws + OFF_LW) + (size_t)l * 65536;
            if (part == 0) transpose_tile(p.in[I_WUP] + (size_t)l * 64 * 256, 256, dst, 256, 0, nt, fl);
            else if (part == 1) transpose_tile(p.in[I_AUP] + (size_t)l * 64 * 256, 256, dst + 64, 256, 0, nt, fl);
            else transpose_tile(p.in[I_GUP] + (size_t)l * 128 * 256, 256, dst + 128, 256, part - 2, nt, fl);
        }
        for (int task = BID(); task < 4 * 32 * 2; task += gridDim.x) {
            const int lk = task >> 6, r = task & 63; const int l = lk >> 1, kv = lk & 1;
            transpose_tile(p.in[kv ? I_CVW1 : I_CKW1] + (size_t)l * 2048 * 128, 128, (u16*)(ws + OFF_CW1) + (size_t)lk * 128 * 2048, 2048, r >> 1, r & 1, fl);
        }
    }
    for (int l = 0; l < 2; ++l) {
        convert_straight(p.in[I_PK1] + l * 16384, (u16*)(ws + OFF_K12) + (l * 2 + 0) * 16384, 16384);
        convert_straight(p.in[I_PK2] + l * 16384, (u16*)(ws + OFF_K12) + (l * 2 + 1) * 16384, 16384);
    }
}

DEV void phase_norm(const float* __restrict__ x, const float* __restrict__ g, const float* __restrict__ sh, const float* __restrict__ sc,
                    u16* __restrict__ h) {
    const int lane = TID() & 63;
    const int gw = BID() * 4 + (TID() >> 6), nw = gridDim.x * 4;
    for (int row0 = gw * 2; row0 < NTOK; row0 += nw * 2) {
        float4 v[2][4]; float ss[2] = {0.f, 0.f};
#pragma unroll
        for (int u = 0; u < 2; ++u)
#pragma unroll
            for (int i = 0; i < 4; ++i) v[u][i] = *(const float4*)(x + (size_t)(row0 + u) * 1024 + 256 * i + lane * 4);
#pragma unroll
        for (int u = 0; u < 2; ++u) {
#pragma unroll
            for (int i = 0; i < 4; ++i) ss[u] += v[u][i].x * v[u][i].x + v[u][i].y * v[u][i].y + v[u][i].z * v[u][i].z + v[u][i].w * v[u][i].w;
            ss[u] = wave_sum(ss[u]);
        }
#pragma unroll
        for (int u = 0; u < 2; ++u) {
            const int row = row0 + u; const int b = row >> 13;
            const float rs = rsqrtf(ss[u] * (1.f / 1024.f) + 1e-6f);
#pragma unroll
            for (int i = 0; i < 4; ++i) {
                const int k = 256 * i + lane * 4;
                const float4 gg = *(const float4*)(g + k); const float4 s1 = *(const float4*)(sc + b * 6144 + k); const float4 s0 = *(const float4*)(sh + b * 6144 + k);
                u32x2 w;
                w[0] = pack2(v[u][i].x * rs * gg.x * (1.f + s1.x) + s0.x, v[u][i].y * rs * gg.y * (1.f + s1.y) + s0.y);
                w[1] = pack2(v[u][i].z * rs * gg.z * (1.f + s1.z) + s0.z, v[u][i].w * rs * gg.w * (1.f + s1.w) + s0.w);
                *(u32x2*)(h + (size_t)row * 1024 + k) = w;
            }
        }
    }
}

DEV void conv_tile(const Params& p, int l, int tile, unsigned char* lds) {
    float* ul = (float*)lds;
    const int tid = TID();
    unsigned char* ws = p.ws;
    const u16* pconv = (const u16*)(ws + OFF_PCONV);
    u16* mix = (u16*)(ws + OFF_MIX);
    const int t0g = tile * 32; const int tb = t0g & 8191;
#pragma unroll 8
    for (int rr = 0; rr < 62; ++rr) {
        const int trow = tb - 30 + rr;
        float u = 0.f;
        if (trow >= 0) {
            const size_t o = (size_t)(t0g - 30 + rr) * 512;
            const float val = bf2f(pconv[o + tid]), gt = bf2f(pconv[o + 256 + tid]);
            u = val * sigmoidf_(gt);
        }
        ul[rr * 256 + tid] = u;
    }
    __syncthreads();
    float w[31];
#pragma unroll
    for (int j = 0; j < 31; ++j) w[j] = p.in[I_CDW][(l * 31 + j) * 256 + tid];
    const float bias = p.in[I_CDB][l * 256 + tid], gg = p.in[I_CGG][l * 256 + tid], gb = p.in[I_CGB][l * 256 + tid];
    for (int tt = 0; tt < 32; ++tt) {
        float y = bias;
#pragma unroll
        for (int j = 0; j < 31; ++j) y += ul[(tt + j) * 256 + tid] * w[j];
        const float mean = wave_sum(y) * (1.f / 64.f);
        const float d = y - mean;
        const float var = wave_sum(d * d) * (1.f / 64.f);
        float o = d * rsqrtf(var + 1e-5f) * gg + gb;
        o = o * sigmoidf_(o);
        mix[(size_t)(t0g + tt) * 1024 + tid] = f2bf(o);
    }
}

DEV float softplusf_(float x) { return x > 20.f ? x : log1pf(__expf(x)); }
DEV void rwkv_prep_tile2(const Params& p, int l, int tile, unsigned char* lds) {
    u16* actb = (u16*)lds;
    const int tid = TID(), lane = tid & 63, wave = tid >> 6, q4 = lane >> 4, cidx = lane & 15;
    unsigned char* ws = p.ws;
    const u16* pr = (const u16*)(ws + OFF_PRWKV);
    const float* mu = p.in[I_MU] + l * 1024;
    const int R0 = tile * 16;
    {
        const int col = 768 + tid; const float muc = mu[col];
        u16 raw[17];
        const bool first = ((R0 & 8191) == 0);
        raw[0] = first ? (u16)0 : pr[(size_t)(R0 - 1) * 1024 + col];
#pragma unroll
        for (int tk = 0; tk < 16; ++tk) raw[tk + 1] = pr[(size_t)(R0 + tk) * 1024 + col];
#pragma unroll
        for (int tk = 0; tk < 16; ++tk) {
            const float cur = bf2f(raw[tk + 1]), prev = bf2f(raw[tk]);
            const float x = cur + (prev - cur) * muc;
            float a;
            if (tid < 64) a = tanhf(x); else if (tid < 128) a = x; else a = sigmoidf_(x);
            actb[tk * 264 + tid] = f2bf(a);
        }
    }
    __syncthreads();
    f32x4 accw[4], acca[4], accg[4];
    {
        bf16x8 af[8];
#pragma unroll
        for (int s2 = 0; s2 < 8; ++s2) af[s2] = *(const bf16x8*)(actb + cidx * 264 + 32 * s2 + 8 * q4);
        const u16* LW = (const u16*)(ws + OFF_LW) + (size_t)l * 65536;
        const f32x4 z = (f32x4){0.f, 0.f, 0.f, 0.f};
#pragma unroll
        for (int nt = 0; nt < 4; ++nt) {
            const u16* bp = LW + (size_t)(64 * wave + 16 * nt + cidx) * 256 + 8 * q4;
            accw[nt] = mfma16(af[0], ld8(bp), z); accw[nt] = mfma16(af[1], ld8(bp + 32), accw[nt]);
            acca[nt] = mfma16(af[2], ld8(bp + 64), z); acca[nt] = mfma16(af[3], ld8(bp + 96), acca[nt]);
            accg[nt] = mfma16(af[4], ld8(bp + 128), z); accg[nt] = mfma16(af[5], ld8(bp + 160), accg[nt]);
            accg[nt] = mfma16(af[6], ld8(bp + 192), accg[nt]); accg[nt] = mfma16(af[7], ld8(bp + 224), accg[nt]);
        }
    }
    float* RW = (float*)(ws + OFF_RW);
    u16 *RR = (u16*)(ws + OFF_RR), *RK = (u16*)(ws + OFF_RK), *RV = (u16*)(ws + OFF_RV), *RKK = (u16*)(ws + OFF_RKK), *RKKA = (u16*)(ws + OFF_RKKA),
        *RG = (u16*)(ws + OFF_RG);
    float* BON = (float*)(ws + OFF_BONUS);
    float w0[4], a0[4], kkc[4], kac[4], rkc[4], mur[4], muk[4], muv[4];
#pragma unroll
    for (int nt = 0; nt < 4; ++nt) {
        const int c = 64 * wave + 16 * nt + cidx;
        w0[nt] = p.in[I_W0][l * 256 + c]; a0[nt] = p.in[I_A0][l * 256 + c]; kkc[nt] = p.in[I_KK][l * 256 + c]; kac[nt] = p.in[I_KA][l * 256 + c];
        rkc[nt] = p.in[I_RK][l * 256 + c]; mur[nt] = mu[c]; muk[nt] = mu[256 + c]; muv[nt] = mu[512 + c];
    }
    u16 ld3[5][4][3];
    {
        const int rowb = R0 + 4 * q4; const bool firstrow = ((rowb & 8191) == 0);
#pragma unroll
        for (int rr_ = 0; rr_ < 5; ++rr_)
#pragma unroll
            for (int nt = 0; nt < 4; ++nt) {
                const int c = 64 * wave + 16 * nt + cidx;
                const u16* cr = pr + (size_t)(rowb - 1 + rr_) * 1024;
                const bool z = (rr_ == 0) && firstrow;
                ld3[rr_][nt][0] = z ? (u16)0 : cr[c]; ld3[rr_][nt][1] = z ? (u16)0 : cr[256 + c]; ld3[rr_][nt][2] = z ? (u16)0 : cr[512 + c];
            }
    }
#pragma unroll
    for (int r = 0; r < 4; ++r) {
        const int row = R0 + 4 * q4 + r;
        float rr[4], kf_[4], vf_[4], av[4], kkv[4], keff[4], dec[4];
        float kk2 = 0.f, bn = 0.f;
#pragma unroll
        for (int nt = 0; nt < 4; ++nt) {
            float rv = bf2f(ld3[r + 1][nt][0]), kv = bf2f(ld3[r + 1][nt][1]), vv = bf2f(ld3[r + 1][nt][2]);
            const float rp = bf2f(ld3[r][nt][0]), kp = bf2f(ld3[r][nt][1]), vp = bf2f(ld3[r][nt][2]);
            rv += (rp - rv) * mur[nt]; kv += (kp - kv) * muk[nt]; vv += (vp - vv) * muv[nt];
            const float wl = w0[nt] + accw[nt][r];
            const float wlog = -softplusf_(-wl) - 0.5f;
            dec[nt] = __expf(-__expf(wlog));
            av[nt] = sigmoidf_(a0[nt] + acca[nt][r]);
            kkv[nt] = kv * kkc[nt]; kk2 += kkv[nt] * kkv[nt];
            keff[nt] = kv * (1.f + (av[nt] - 1.f) * kac[nt]);
            bn += rv * keff[nt] * rkc[nt];
            rr[nt] = rv; kf_[nt] = kv; vf_[nt] = vv;
        }
        kk2 = reduce16(kk2); bn = reduce16(bn);
        const float inv = 1.f / fmaxf(sqrtf(kk2), 1e-12f);
#pragma unroll
        for (int nt = 0; nt < 4; ++nt) {
            const int c = 64 * wave + 16 * nt + cidx;
            const size_t o = (size_t)row * 256 + c;
            const float kk = kkv[nt] * inv;
            RW[o] = dec[nt]; RR[o] = f2bf(rr[nt]); RK[o] = f2bf(keff[nt]); RV[o] = f2bf(vf_[nt]); RKK[o] = f2bf(kk); RKKA[o] = f2bf(kk * av[nt]);
            RG[o] = f2bf(accg[nt][r]);
        }
        if (cidx == 0) BON[(size_t)row * 4 + wave] = bn;
    }
}

DEV void rwkv_scan(const Params& p, int sb, unsigned char* lds) {
    unsigned char* ws = p.ws;
    const float* RW = (const float*)(ws + OFF_RW);
    const u16 *RR = (const u16*)(ws + OFF_RR), *RK = (const u16*)(ws + OFF_RK), *RV = (const u16*)(ws + OFF_RV), *RKK = (const u16*)(ws + OFF_RKK),
              *RKKA = (const u16*)(ws + OFF_RKKA);
    float* YR = (float*)(ws + OFF_YRAW);
    const int tid = TID(), lane = tid & 63, wave = tid >> 6;
    const int bh = sb >> 2, rg = sb & 3; const int b = bh >> 2, hh = bh & 3;
    float* L = (float*)lds;
    constexpr int BUFSZ = 5 * 1024 + 256;
    float* Yb = L + 2 * BUFSZ;
    const int row_local = 4 * wave + (lane >> 4); const int kq = (lane & 15) * 4;
    const int lstep = tid >> 4, lk = (tid & 15) * 4;
    const int vstep = tid >> 4, vrow = tid & 15;
    const size_t gbase = (size_t)b * 8192 * 256 + hh * 64;
    float4 lw; u32x2 lr, lkk, lkka, lk_; u16 lv;
    auto issue = [&](int c) {
        const size_t o = gbase + (size_t)(c * 16 + lstep) * 256 + lk;
        lw = *(const float4*)(RW + o);
        lr = *(const u32x2*)(RR + o); lk_ = *(const u32x2*)(RK + o); lkk = *(const u32x2*)(RKK + o); lkka = *(const u32x2*)(RKKA + o);
        lv = RV[gbase + (size_t)(c * 16 + vstep) * 256 + rg * 16 + vrow];
    };
    auto commit = [&](int buf) {
        float* B = L + buf * BUFSZ;
        const int o = lstep * 64 + lk;
        *(float4*)(B + o) = lw;
        *(float4*)(B + 1024 + o) = (float4){bflo(lkka[0]), bfhi(lkka[0]), bflo(lkka[1]), bfhi(lkka[1])};
        *(float4*)(B + 2048 + o) = (float4){bflo(lk_[0]), bfhi(lk_[0]), bflo(lk_[1]), bfhi(lk_[1])};
        *(float4*)(B + 3072 + o) = (float4){bflo(lr[0]), bfhi(lr[0]), bflo(lr[1]), bfhi(lr[1])};
        *(float4*)(B + 4096 + o) = (float4){bflo(lkk[0]), bfhi(lkk[0]), bflo(lkk[1]), bfhi(lkk[1])};
        B[5120 + vstep * 16 + vrow] = bf2f(lv);
    };
    __syncthreads();
    issue(0); commit(0);
    __syncthreads();
    float S0 = 0.f, S1 = 0.f, S2 = 0.f, S3 = 0.f;
    constexpr int NCH = NT / 16;
    for (int c = 0; c < NCH; ++c) {
        const int buf = c & 1;
        if (c + 1 < NCH) issue(c + 1);
        const float* B = L + buf * BUFSZ;
        float* Y = Yb + buf * 256;
        float yv[16];
        float4 w4 = *(const float4*)(B + kq), a4 = *(const float4*)(B + 1024 + kq), k4 = *(const float4*)(B + 2048 + kq),
               r4 = *(const float4*)(B + 3072 + kq), n4 = *(const float4*)(B + 4096 + kq);
        float vv = B[5120 + row_local];
#pragma unroll
        for (int st = 0; st < 16; ++st) {
            float4 w4n, a4n, k4n, r4n, n4n; float vvn;
            if (st < 15) {
                w4n = *(const float4*)(B + (st + 1) * 64 + kq); a4n = *(const float4*)(B + 1024 + (st + 1) * 64 + kq);
                k4n = *(const float4*)(B + 2048 + (st + 1) * 64 + kq); r4n = *(const float4*)(B + 3072 + (st + 1) * 64 + kq);
                n4n = *(const float4*)(B + 4096 + (st + 1) * 64 + kq); vvn = B[5120 + (st + 1) * 16 + row_local];
            }
            const float part = (S0 * n4.x + S1 * n4.y) + (S2 * n4.z + S3 * n4.w);
            const float sa = -reduce16(part);
            const float t0 = S0 * w4.x + vv * k4.x, t1 = S1 * w4.y + vv * k4.y, t2 = S2 * w4.z + vv * k4.z, t3 = S3 * w4.w + vv * k4.w;
            S0 = t0 + sa * a4.x; S1 = t1 + sa * a4.y; S2 = t2 + sa * a4.z; S3 = t3 + sa * a4.w;
            const float yp = (S0 * r4.x + S1 * r4.y) + (S2 * r4.z + S3 * r4.w);
            yv[st] = reduce16(yp);
            if (st < 15) { w4 = w4n; a4 = a4n; k4 = k4n; r4 = r4n; n4 = n4n; vv = vvn; }
        }
        if ((lane & 15) == 0) {
#pragma unroll
            for (int st = 0; st < 16; ++st) Y[st * 16 + row_local] = yv[st];
        }
        if (c + 1 < NCH) commit(buf ^ 1);
        __syncthreads();
        YR[gbase + (size_t)(c * 16 + vstep) * 256 + rg * 16 + vrow] = Y[vstep * 16 + vrow];
    }
}

DEV void phase_rwkv_post(const Params& p, int l) {
    unsigned char* ws = p.ws;
    const float* YR = (const float*)(ws + OFF_YRAW); const float* BON = (const float*)(ws + OFF_BONUS);
    const u16 *RV = (const u16*)(ws + OFF_RV), *RG = (const u16*)(ws + OFF_RG);
    u16* mix = (u16*)(ws + OFF_MIX);
    const int tid = TID();
    const float lg = p.in[I_LNG][l * 256 + tid], lb = p.in[I_LNB][l * 256 + tid];
    for (int row0 = BID() * 4; row0 < NTOK; row0 += gridDim.x * 4) {
        float y[4], bon[4], vv[4], gg[4];
#pragma unroll
        for (int u = 0; u < 4; ++u) {
            const size_t o = (size_t)(row0 + u) * 256 + tid;
            y[u] = YR[o]; bon[u] = BON[(size_t)(row0 + u) * 4 + (tid >> 6)]; vv[u] = bf2f(RV[o]); gg[u] = bf2f(RG[o]);
        }
#pragma unroll
        for (int u = 0; u < 4; ++u) {
            const float mean = wave_sum(y[u]) * (1.f / 64.f);
            const float d = y[u] - mean;
            const float var = wave_sum(d * d) * (1.f / 64.f);
            const float yn = d * rsqrtf(var + 64e-5f) * lg + lb;
            mix[(size_t)(row0 + u) * 1024 + 256 + tid] = f2bf((yn + bon[u] * vv[u]) * gg[u]);
        }
    }
}

DEV void zero_mix_cols(const Params& p, int c0, int ncols) {
    u16* mix = (u16*)(p.ws + OFF_MIX);
    const int per = ncols / 8;
    const size_t total = (size_t)NTOK * per;
    for (size_t i = (size_t)BID() * 256 + TID(); i < total; i += (size_t)gridDim.x * 256) {
        const size_t row = i / per; const int cc = (int)(i % per);
        *(u32x4*)(mix + row * 1024 + c0 + cc * 8) = (u32x4){0u, 0u, 0u, 0u};
    }
}


DEV void qk_tile(const bf16x8 (&kf)[8], bf16x8 q0, bf16x8 q1, float cinit, f32x4 (&st)[4]) {
    const f32x4 c = (f32x4){cinit, cinit, cinit, cinit};
#pragma unroll
    for (int kt = 0; kt < 4; ++kt) {
        st[kt] = mfma16(kf[2 * kt], q0, c);
        st[kt] = mfma16(kf[2 * kt + 1], q1, st[kt]);
    }
}
DEV void softmax_pv_lazy(f32x4 (&st)[4], const bf16x8 (&vf)[8], float& m, float& l, f32x4& L, f32x4 (&O)[4]) {
    float lmax = fmaxf(fmaxf(fmaxf(st[0][0], st[0][1]), fmaxf(st[0][2], st[0][3])), fmaxf(fmaxf(st[1][0], st[1][1]), fmaxf(st[1][2], st[1][3])));
    lmax = fmaxf(lmax, fmaxf(fmaxf(fmaxf(st[2][0], st[2][1]), fmaxf(st[2][2], st[2][3])), fmaxf(fmaxf(st[3][0], st[3][1]), fmaxf(st[3][2], st[3][3]))));
    lmax = colmax(lmax);
    const float dlt = (lmax > 8.f) ? lmax : 0.f;
    if (__any(dlt > 0.f)) {
        const float alpha = ex2(-dlt);
#pragma unroll
        for (int mt = 0; mt < 4; ++mt) { O[mt][0] *= alpha; O[mt][1] *= alpha; O[mt][2] *= alpha; O[mt][3] *= alpha; }
        L[0] *= alpha; L[1] *= alpha; L[2] *= alpha; L[3] *= alpha; l *= alpha; m += dlt;
#pragma unroll
        for (int kt = 0; kt < 4; ++kt) { st[kt][0] -= dlt; st[kt][1] -= dlt; st[kt][2] -= dlt; st[kt][3] -= dlt; }
    }
#pragma unroll
    for (int kt = 0; kt < 4; ++kt)
#pragma unroll
        for (int r = 0; r < 4; ++r) st[kt][r] = ex2(st[kt][r]);
    union { bf16x8 v; unsigned u[4]; } ones;
    ones.u[0] = 0x3f803f80u; ones.u[1] = 0x3f803f80u; ones.u[2] = 0x3f803f80u; ones.u[3] = 0x3f803f80u;
#pragma unroll
    for (int kb = 0; kb < 2; ++kb) {
        union { bf16x8 v; unsigned u[4]; } pb;
        pb.u[0] = pack2(st[2 * kb][0], st[2 * kb][1]); pb.u[1] = pack2(st[2 * kb][2], st[2 * kb][3]);
        pb.u[2] = pack2(st[2 * kb + 1][0], st[2 * kb + 1][1]); pb.u[3] = pack2(st[2 * kb + 1][2], st[2 * kb + 1][3]);
        L = mfma16(ones.v, pb.v, L);
#pragma unroll
        for (int mt = 0; mt < 4; ++mt) O[mt] = mfma16(vf[kb * 4 + mt], pb.v, O[mt]);
    }
}
DEV void softmax_pv_tile(bool MASK, f32x4 (&st)[4], const bf16x8 (&vf)[8], int keybase, int tcol, int lowcol, bool colsel, float& m, float& l, f32x4& L, f32x4 (&O)[4], int q4) {
    float lmax = -1e30f;
    if (MASK) {
        const int hi = colsel ? tcol : -1;
#pragma unroll
        for (int kt = 0; kt < 4; ++kt)
#pragma unroll
            for (int r = 0; r < 4; ++r) {
                const int key = keybase + kt * 16 + 4 * q4 + r;
                const bool valid = (key <= hi) && (key > lowcol);
                const float sv = valid ? st[kt][r] : -1e30f;
                st[kt][r] = sv; lmax = fmaxf(lmax, sv);
            }
    } else {
        const float cs = colsel ? 0.f : -1e30f;
#pragma unroll
        for (int kt = 0; kt < 4; ++kt)
#pragma unroll
            for (int r = 0; r < 4; ++r) { const float sv = st[kt][r] + cs; st[kt][r] = sv; lmax = fmaxf(lmax, sv); }
    }
    lmax = colmax(lmax);
    const float mnew = fmaxf(m, lmax);
    const float alpha = ex2(m - mnew);
    float psum = 0.f;
#pragma unroll
    for (int kt = 0; kt < 4; ++kt)
#pragma unroll
        for (int r = 0; r < 4; ++r) {
            float pv = ex2(st[kt][r] - mnew);
            if (MASK) pv = (st[kt][r] > -1e29f) ? pv : 0.f;
            st[kt][r] = pv; psum += pv;
        }
    l = l * alpha + psum;
    if (__any(mnew > m)) {
#pragma unroll
        for (int mt = 0; mt < 4; ++mt) { O[mt][0] *= alpha; O[mt][1] *= alpha; O[mt][2] *= alpha; O[mt][3] *= alpha; }
        L[0] *= alpha; L[1] *= alpha; L[2] *= alpha; L[3] *= alpha;
    }
    m = mnew;
#pragma unroll
    for (int kb = 0; kb < 2; ++kb) {
        union { bf16x8 v; unsigned u[4]; } pb;
        pb.u[0] = pack2(st[2 * kb][0], st[2 * kb][1]); pb.u[1] = pack2(st[2 * kb][2], st[2 * kb][3]);
        pb.u[2] = pack2(st[2 * kb + 1][0], st[2 * kb + 1][1]); pb.u[3] = pack2(st[2 * kb + 1][2], st[2 * kb + 1][3]);
#pragma unroll
        for (int mt = 0; mt < 4; ++mt) O[mt] = mfma16(vf[kb * 4 + mt], pb.v, O[mt]);
    }
}
DEV unsigned pick4(unsigned a0, unsigned a1, unsigned a2, unsigned a3, int w) { return w == 0 ? a0 : (w == 1 ? a1 : (w == 2 ? a2 : a3)); }
template <int CTRL> DEV unsigned dpp_or(unsigned x) { return x | dppu<CTRL>(x); }
DEV unsigned row_or(unsigned x) { x = dpp_or<0xB1>(x); x = dpp_or<0x4E>(x); x = dpp_or<0x124>(x); x = dpp_or<0x128>(x); return x; }


DEV void nsa_branch_lds(unsigned char* lds, const u16* __restrict__ K0, const u16* __restrict__ VT0, unsigned bu0, unsigned bu1, unsigned bu2,
                        unsigned bu3, unsigned ua0, unsigned ua1, unsigned ua2, unsigned ua3, unsigned ub0, unsigned ub1, unsigned ub2, unsigned ub3,
                        const unsigned* cm, int tokl, const int (&tcol)[2], const int (&lowc)[2], const bf16x8 (&qf)[2][2], float (&m)[2],
                        float (&l)[2], f32x4 (&L)[2], f32x4 (&O)[2][4], int q4, int cidx, int cur, int lowmax) {
    const int tid = TID();
    int w = 0; unsigned bits = bu0;
    auto advance = [&]() -> int {
        while (bits == 0u && w < 3) { ++w; bits = pick4(bu0, bu1, bu2, bu3, w); }
        if (bits == 0u) return -1;
        const int jb = __builtin_ctz(bits); bits &= bits - 1u;
        return w * 32 + jb;
    };
    const int srow0 = tid >> 3, srow1 = srow0 + 32, sch = tid & 7;
    const int so0 = srow0 * 128 + ((sch ^ (srow0 & 7)) << 4), so1 = srow1 * 128 + ((sch ^ (srow1 & 7)) << 4);
    bf16x8 r0[4], r1[4];
#define NSA_GLOAD(R, BLK_) { R[0] = ld8(K0 + ((size_t)(BLK_) * 64 + srow0) * 64 + sch * 8); R[1] = ld8(K0 + ((size_t)(BLK_) * 64 + srow1) * 64 + sch * 8); \
        R[2] = ld8(VT0 + (size_t)srow0 * 8192 + (BLK_) * 64 + sch * 8); R[3] = ld8(VT0 + (size_t)srow1 * 8192 + (BLK_) * 64 + sch * 8); }
#define NSA_LWRITE(R, BUF_) { unsigned char* wb_ = lds + (BUF_) * 16384; *(bf16x8*)(wb_ + so0) = R[0]; *(bf16x8*)(wb_ + so1) = R[1]; \
        *(bf16x8*)(wb_ + 8192 + so0) = R[2]; *(bf16x8*)(wb_ + 8192 + so1) = R[3]; }
    auto compute = [&](int blk, int buf) {
        const int wq = blk >> 5, jb = blk & 31;
        const bool act0 = (pick4(ua0, ua1, ua2, ua3, wq) >> jb) & 1u, act1 = (pick4(ub0, ub1, ub2, ub3, wq) >> jb) & 1u;
        if (act0 || act1) {
            const unsigned char* kb_ = lds + buf * 16384;
            const bool need_mask = (blk == cur) || (blk * 64 <= lowmax);
            const bool cs0 = cm ? (((cm[tokl * 4 + wq] >> jb) & 1u) != 0u) : true;
            const bool cs1 = cm ? (((cm[(4 + tokl) * 4 + wq] >> jb) & 1u) != 0u) : true;
            const bool lazy = !need_mask && !__any((act0 && m[0] < -1e29f) || (act1 && m[1] < -1e29f));
            f32x4 st0[4], st1[4];
            {
                bf16x8 kf[8];
#pragma unroll
                for (int kt = 0; kt < 4; ++kt)
#pragma unroll
                    for (int s2 = 0; s2 < 2; ++s2) {
                        const int row = 16 * kt + cidx, ch = 4 * s2 + q4;
                        kf[2 * kt + s2] = *(const bf16x8*)(kb_ + row * 128 + ((ch ^ (row & 7)) << 4));
                    }
                if (act0) qk_tile(kf, qf[0][0], qf[0][1], lazy ? (cs0 ? -m[0] : -1e30f) : 0.f, st0);
                if (act1) qk_tile(kf, qf[1][0], qf[1][1], lazy ? (cs1 ? -m[1] : -1e30f) : 0.f, st1);
            }
            __builtin_amdgcn_sched_barrier(0);
            bf16x8 vf[8];
#pragma unroll
            for (int kb = 0; kb < 2; ++kb)
#pragma unroll
                for (int mt = 0; mt < 4; ++mt) {
                    const int row = 16 * mt + cidx, ch = 4 * kb + q4;
                    vf[kb * 4 + mt] = *(const bf16x8*)(kb_ + 8192 + row * 128 + ((ch ^ (row & 7)) << 4));
                }
            if (lazy) {
                if (act0) softmax_pv_lazy(st0, vf, m[0], l[0], L[0], O[0]);
                if (act1) softmax_pv_lazy(st1, vf, m[1], l[1], L[1], O[1]);
            } else {
                if (act0) softmax_pv_tile(need_mask, st0, vf, blk * 64, tcol[0], lowc[0], cs0, m[0], l[0], L[0], O[0], q4);
                if (act1) softmax_pv_tile(need_mask, st1, vf, blk * 64, tcol[1], lowc[1], cs1, m[1], l[1], L[1], O[1], q4);
            }
        }
    };
    int b0 = advance();
    if (b0 < 0) return;
    int b1 = advance();
    NSA_GLOAD(r0, b0);
    if (b1 >= 0) NSA_GLOAD(r1, b1);
    NSA_LWRITE(r0, 0);
    __syncthreads();
#pragma unroll 1
    while (b0 >= 0) {
        const int b2 = (b1 >= 0) ? advance() : -1;
        if (b2 >= 0) NSA_GLOAD(r0, b2);
        compute(b0, 0);
        if (b1 >= 0) NSA_LWRITE(r1, 1);
        __syncthreads();
        if (b1 < 0) break;
        const int b3 = (b2 >= 0) ? advance() : -1;
        if (b3 >= 0) NSA_GLOAD(r1, b3);
        compute(b1, 1);
        if (b2 >= 0) NSA_LWRITE(r0, 0);
        __syncthreads();
        b0 = b2; b1 = b3;
    }
#undef NSA_GLOAD
#undef NSA_LWRITE
}

DEV void nsa_block_task(const Params& p, int task, unsigned char* lds) {
    const int wave = TID() >> 6;
    float* wl = (float*)(lds + 32768) + wave * 2112;
    unsigned* bm = (unsigned*)(lds + 32768 + 4 * 8448);
    float* impA = wl; float* impB = wl + 1024; unsigned* selmask = (unsigned*)(wl + 1024 + 1056);
    unsigned char* ws = p.ws;
    const u16* Q = (const u16*)(ws + OFF_Q);
    const u16* KVb = (const u16*)(ws + OFF_KV);
    const u16 *KSEL = KVb + (size_t)2 * 4194304, *VSELT = KVb + (size_t)3 * 4194304, *KWIN = KVb + (size_t)4 * 4194304, *VWINT = KVb + (size_t)5 * 4194304;
    const u16* KC = (const u16*)(ws + OFF_KC); const u16* VCT = (const u16*)(ws + OFF_VCT);
    const float* GATE = (const float*)(ws + OFF_GATE);
    u16* mix = (u16*)(ws + OFF_MIX);
    const int lane = TID() & 63, q4 = lane >> 4, cidx = lane & 15;
    const int bg = task & 7, t0b = (255 - (task >> 3)) * 32, t0 = t0b + 8 * wave; const int b = bg >> 1, g = bg & 1;
    const int tokl = cidx >> 2, hr = cidx & 3; const int head = g * 4 + hr;
    const int cur = t0 >> 6;
    int tcol[2], rowc[2]; bf16x8 qf[2][2];
#pragma unroll
    for (int ti = 0; ti < 2; ++ti) {
        tcol[ti] = t0 + 4 * ti + tokl; rowc[ti] = b * 8192 + tcol[ti];
        qf[ti][0] = ld8(Q + (size_t)rowc[ti] * 512 + head * 64 + 8 * q4); qf[ti][1] = ld8(Q + (size_t)rowc[ti] * 512 + head * 64 + 32 + 8 * q4);
    }
    f32x4 Oc[2][4];
    {
        int cnt_col[2];
#pragma unroll
        for (int ti = 0; ti < 2; ++ti) cnt_col[ti] = tcol[ti] >= 31 ? ((tcol[ti] - 31) >> 4) + 1 : 0;
        const int tmax = t0 + 7; const int cmax = tmax >= 31 ? ((tmax - 31) >> 4) + 1 : 0;
        const int ntile = (cmax + 15) >> 4;
        const u16* kcb = KC + (size_t)bg * 512 * 64;
        float ml[2] = {-1e30f, -1e30f}, ll[2] = {0.f, 0.f};
#pragma unroll 1
        for (int kt = 0; kt < ntile; ++kt) {
            const u16* kp = kcb + (kt * 16 + cidx) * 64 + 8 * q4;
            const bf16x8 k0 = ld8(kp), k1 = ld8(kp + 32);
#pragma unroll
            for (int ti = 0; ti < 2; ++ti) {
                f32x4 st = mfma16(k0, qf[ti][0], (f32x4){0.f, 0.f, 0.f, 0.f});
                st = mfma16(k1, qf[ti][1], st);
                float sv[4]; float tm = -1e30f;
#pragma unroll
                for (int r = 0; r < 4; ++r) { const int n = kt * 16 + 4 * q4 + r; sv[r] = (n < cnt_col[ti]) ? st[r] : -1e30f; tm = fmaxf(tm, sv[r]); }
                const float mn = fmaxf(ml[ti], tm);
                float ps = 0.f;
#pragma unroll
                for (int r = 0; r < 4; ++r) ps += (sv[r] > -1e29f) ? ex2(sv[r] - mn) : 0.f;
                ll[ti] = ll[ti] * ex2(ml[ti] - mn) + ps; ml[ti] = mn;
            }
        }
        float mfin[2], inv[2];
#pragma unroll
        for (int ti = 0; ti < 2; ++ti) {
            mfin[ti] = colmax(ml[ti]);
            const float lsum = colsum(ll[ti] * ex2(ml[ti] - mfin[ti]));
            inv[ti] = (cnt_col[ti] > 0) ? 1.f / lsum : 0.f;
        }
#pragma unroll
        for (int ti = 0; ti < 2; ++ti)
#pragma unroll
            for (int mt = 0; mt < 4; ++mt) Oc[ti][mt] = (f32x4){0.f, 0.f, 0.f, 0.f};
        const int npair = (ntile + 1) >> 1;
#pragma unroll 1
        for (int kp2 = 0; kp2 < npair; ++kp2) {
            const int n0 = kp2 * 32;
            const u16* kp = kcb + (n0 + cidx) * 64 + 8 * q4;
            const bf16x8 ka0 = ld8(kp), ka1 = ld8(kp + 32), kb0 = ld8(kp + 1024), kb1 = ld8(kp + 1024 + 32);
            bf16x8 vf[4];
#pragma unroll
            for (int mt = 0; mt < 4; ++mt) vf[mt] = ld8(VCT + ((size_t)bg * 64 + 16 * mt + cidx) * 512 + n0 + 8 * q4);
#pragma unroll
            for (int ti = 0; ti < 2; ++ti) {
                float pa[4], pb_[4];
                f32x4 st = mfma16(ka0, qf[ti][0], (f32x4){0.f, 0.f, 0.f, 0.f});
                st = mfma16(ka1, qf[ti][1], st);
                f32x4 su = mfma16(kb0, qf[ti][0], (f32x4){0.f, 0.f, 0.f, 0.f});
                su = mfma16(kb1, qf[ti][1], su);
#pragma unroll
                for (int r = 0; r < 4; ++r) {
                    const int n = n0 + 4 * q4 + r;
                    pa[r] = (n < cnt_col[ti]) ? ex2(st[r] - mfin[ti]) * inv[ti] : 0.f;
                    pb_[r] = (n + 16 < cnt_col[ti]) ? ex2(su[r] - mfin[ti]) * inv[ti] : 0.f;
                }
                const float owna = quadsum(pa[0] + pa[1] + pa[2] + pa[3]), tha = quadsum(pa[3]);
                const float ownb = quadsum(pb_[0] + pb_[1] + pb_[2] + pb_[3]), thb = quadsum(pb_[3]);
                if (hr == 0) {
                    const int tk = 4 * ti + tokl;
                    const int sa = (n0 >> 2) + q4, sb2 = ((n0 + 16) >> 2) + q4;
                    impA[tk * 128 + sa] = owna; impB[tk * 132 + sa + 1] = tha;
                    impA[tk * 128 + sb2] = ownb; impB[tk * 132 + sb2 + 1] = thb;
                }
                union { bf16x8 v; unsigned u[4]; } pk;
                pk.u[0] = pack2(pa[0], pa[1]); pk.u[1] = pack2(pa[2], pa[3]); pk.u[2] = pack2(pb_[0], pb_[1]); pk.u[3] = pack2(pb_[2], pb_[3]);
#pragma unroll
                for (int mt = 0; mt < 4; ++mt) Oc[ti][mt] = mfma16(vf[mt], pk.v, Oc[ti][mt]);
            }
        }
#pragma unroll
        for (int ti = 0; ti < 2; ++ti) {
            const float gc = GATE[(size_t)rowc[ti] * 24 + head];
#pragma unroll
            for (int mt = 0; mt < 4; ++mt)
#pragma unroll
                for (int r = 0; r < 4; ++r) Oc[ti][mt][r] *= gc;
        }
    }
    lds_fence();
#pragma unroll 1
    for (int rd = 0; rd < 2; ++rd) {
        const int tk = 4 * rd + q4;
        unsigned m0 = 0u, m1 = 0u, m2 = 0u, m3 = 0u;
        if (cur < 16) { m0 = (2u << cur) - 1u; }
        else {
            unsigned key[8];
#pragma unroll
            for (int i = 0; i < 8; ++i) {
                const int sblk = cidx + 16 * i;
                const bool cand = (sblk >= 1) && (sblk <= cur - 2);
                const float v = impA[tk * 128 + sblk] + impB[tk * 132 + sblk];
                key[i] = cand ? ((__float_as_uint(v) & ~0x7Fu) | (unsigned)(127 - sblk)) : 0u;
            }
            int mysel = (cidx == 0) ? 0 : (cidx == 1 ? cur - 1 : (cidx == 2 ? cur : -1));
#pragma unroll 1
            for (int it = 0; it < 13; ++it) {
                unsigned mx = key[0];
#pragma unroll
                for (int i = 1; i < 8; ++i) mx = max(mx, key[i]);
                mx = max(mx, dppu<0xB1>(mx)); mx = max(mx, dppu<0x4E>(mx)); mx = max(mx, dppu<0x124>(mx)); mx = max(mx, dppu<0x128>(mx));
                const int sblk = 127 - (int)(mx & 127u);
#pragma unroll
                for (int i = 0; i < 8; ++i) key[i] = (key[i] == mx) ? 0u : key[i];
                if (cidx == it + 3) mysel = sblk;
            }
            const unsigned bit = 1u << (mysel & 31); const int wsel = mysel >> 5;
            m0 = row_or(wsel == 0 ? bit : 0u); m1 = row_or(wsel == 1 ? bit : 0u); m2 = row_or(wsel == 2 ? bit : 0u); m3 = row_or(wsel == 3 ? bit : 0u);
        }
        if (cidx < 4) selmask[tk * 4 + cidx] = (cidx == 0) ? m0 : (cidx == 1 ? m1 : (cidx == 2 ? m2 : m3));
    }
    lds_fence();
    f32x4* accl = (f32x4*)wl;
#pragma unroll
    for (int ti = 0; ti < 2; ++ti)
#pragma unroll
        for (int mt = 0; mt < 4; ++mt) accl[(ti * 4 + mt) * 64 + lane] = Oc[ti][mt];
    {
        float m[2] = {-1e30f, -1e30f}, l[2] = {0.f, 0.f}; f32x4 Os[2][4]; f32x4 Ls[2] = {(f32x4){0.f, 0.f, 0.f, 0.f}, (f32x4){0.f, 0.f, 0.f, 0.f}};
#pragma unroll
        for (int ti = 0; ti < 2; ++ti)
#pragma unroll
            for (int mt = 0; mt < 4; ++mt) Os[ti][mt] = (f32x4){0.f, 0.f, 0.f, 0.f};
        {
            unsigned ua[4], ub[4], bu[4];
#pragma unroll
            for (int w = 0; w < 4; ++w) {
                ua[w] = __builtin_amdgcn_readfirstlane(row_or(selmask[tokl * 4 + w]));
                ub[w] = __builtin_amdgcn_readfirstlane(row_or(selmask[(4 + tokl) * 4 + w]));
            }
            if (lane < 4) bm[wave * 4 + lane] = (lane == 0) ? (ua[0] | ub[0]) : (lane == 1 ? (ua[1] | ub[1]) : (lane == 2 ? (ua[2] | ub[2]) : (ua[3] | ub[3])));
            __syncthreads();
#pragma unroll
            for (int w = 0; w < 4; ++w) bu[w] = __builtin_amdgcn_readfirstlane(bm[w] | bm[4 + w] | bm[8 + w] | bm[12 + w]);
            const int lowc[2] = {-1, -1};
            nsa_branch_lds(lds, KSEL + (size_t)bg * 8192 * 64, VSELT + (size_t)bg * 64 * 8192, bu[0], bu[1], bu[2], bu[3], ua[0], ua[1], ua[2], ua[3], ub[0],
                           ub[1], ub[2], ub[3], selmask, tokl, tcol, lowc, qf, m, l, Ls, Os, q4, cidx, cur, -1);
        }
#pragma unroll
        for (int ti = 0; ti < 2; ++ti) {
            const float sc = GATE[(size_t)rowc[ti] * 24 + 8 + head] / (colsum(l[ti]) + Ls[ti][0]);
#pragma unroll
            for (int mt = 0; mt < 4; ++mt)
#pragma unroll
                for (int r = 0; r < 4; ++r) Os[ti][mt][r] *= sc;
        }
        lds_fence();
#pragma unroll
        for (int ti = 0; ti < 2; ++ti)
#pragma unroll
            for (int mt = 0; mt < 4; ++mt) { f32x4 a = accl[(ti * 4 + mt) * 64 + lane]; a += Os[ti][mt]; accl[(ti * 4 + mt) * 64 + lane] = a; }
    }
    {
        float m[2] = {-1e30f, -1e30f}, l[2] = {0.f, 0.f}; f32x4 Ow[2][4]; f32x4 Ls[2] = {(f32x4){0.f, 0.f, 0.f, 0.f}, (f32x4){0.f, 0.f, 0.f, 0.f}};
#pragma unroll
        for (int ti = 0; ti < 2; ++ti)
#pragma unroll
            for (int mt = 0; mt < 4; ++mt) Ow[ti][mt] = (f32x4){0.f, 0.f, 0.f, 0.f};
        int wb0 = (t0 - 511) >> 6; if (wb0 < 0) wb0 = 0;
        int wbb = (t0b - 511) >> 6; if (wbb < 0) wbb = 0;
        {
            unsigned uw[4], bu[4];
#pragma unroll
            for (int w = 0; w < 4; ++w) {
                const int hi = cur - 32 * w;
                unsigned mk = 0u, mkb = 0u;
                if (hi >= 0) {
                    const unsigned upper = (hi >= 31) ? 0xffffffffu : ((2u << hi) - 1u);
                    const int lo = wb0 - 32 * w, lob = wbb - 32 * w;
                    if (lo <= 31) mk = upper & ~((lo <= 0) ? 0u : ((1u << lo) - 1u));
                    if (lob <= 31) mkb = upper & ~((lob <= 0) ? 0u : ((1u << lob) - 1u));
                }
                uw[w] = mk; bu[w] = mkb;
            }
            const int lowc[2] = {tcol[0] - 512, tcol[1] - 512};
            nsa_branch_lds(lds, KWIN + (size_t)bg * 8192 * 64, VWINT + (size_t)bg * 64 * 8192, bu[0], bu[1], bu[2], bu[3], uw[0], uw[1], uw[2], uw[3], uw[0],
                           uw[1], uw[2], uw[3], nullptr, tokl, tcol, lowc, qf, m, l, Ls, Ow, q4, cidx, cur, t0 + 7 - 512);
        }
#pragma unroll
        for (int ti = 0; ti < 2; ++ti) {
            const float sc = GATE[(size_t)rowc[ti] * 24 + 16 + head] / (colsum(l[ti]) + Ls[ti][0]);
#pragma unroll
            for (int mt = 0; mt < 4; ++mt)
#pragma unroll
                for (int r = 0; r < 4; ++r) Ow[ti][mt][r] *= sc;
        }
        lds_fence();
#pragma unroll
        for (int ti = 0; ti < 2; ++ti)
#pragma unroll
            for (int mt = 0; mt < 4; ++mt) {
                const f32x4 a = accl[(ti * 4 + mt) * 64 + lane];
                const f32x4 o = Ow[ti][mt];
                u32x2 wv; wv[0] = pack2(a[0] + o[0], a[1] + o[1]); wv[1] = pack2(a[2] + o[2], a[3] + o[3]);
                *(u32x2*)(mix + (size_t)rowc[ti] * 1024 + 512 + head * 64 + 16 * mt + 4 * q4) = wv;
            }
    }


    __syncthreads();
}

template <int N> DEV void ltmask(const float (&v)[N], float x, unsigned (&mk)[N / 32]) {
#pragma unroll
    for (int w = 0; w < N / 32; ++w) {
        unsigned a0 = 0u, a1 = 0u, a2 = 0u, a3 = 0u;
#pragma unroll
        for (int i = 0; i < 8; ++i) {
            a0 = __builtin_amdgcn_alignbit(a0, __float_as_uint(v[w * 32 + i] - x), 31);
            a1 = __builtin_amdgcn_alignbit(a1, __float_as_uint(v[w * 32 + 8 + i] - x), 31);
            a2 = __builtin_amdgcn_alignbit(a2, __float_as_uint(v[w * 32 + 16 + i] - x), 31);
            a3 = __builtin_amdgcn_alignbit(a3, __float_as_uint(v[w * 32 + 24 + i] - x), 31);
        }
        mk[w] = (a0 << 24) | (a1 << 16) | (a2 << 8) | a3;
    }
}
template <int N> DEV int count_ge(const float (&v)[N], float x) {
    unsigned mk[N / 32]; ltmask<N>(v, x, mk);
    int lt = 0;
#pragma unroll
    for (int w = 0; w < N / 32; ++w) lt += __popc(mk[w]);
    return colsumi(N - lt);
}
template <int N> DEV void refine16(const float (&v)[N], float lo, int clo, float hi, int chi, float& lo_o, float& hi_o) {
    bool done = false;
    if (clo == 16) { hi = lo; done = true; }
#pragma unroll 1
    for (int it = 0; it < 200; ++it) {
        if (__all(done)) break;
        float f = 0.5f;
        if (!(it & 1)) { f = ((float)clo - 15.5f) / (float)(clo - chi); f = fminf(fmaxf(f, 0.04f), 0.96f); }
        const float mid = lo + (hi - lo) * f;
        const bool stuck = !(mid > lo && mid < hi);
        const int c = count_ge<N>(v, mid);
        if (!done) {
            if (stuck) { if (f != 0.5f) {   } else done = true; }
            else if (c == 16) { lo = mid; hi = mid; done = true; }
            else if (c > 16) { lo = mid; clo = c; }
            else { hi = mid; chi = c; }
        }
    }
    lo_o = lo; hi_o = hi;
}
template <int N> DEV void select16(const float (&v)[N], float& lo_o, float& hi_o) {
    float mx = v[0], sm = v[0];
#pragma unroll
    for (int i = 1; i < N; ++i) { mx = fmaxf(mx, v[i]); sm += v[i]; }
    mx = colmax(mx); sm = colsum(sm);
    const float hi = mx + fabsf(mx) * 1e-6f + 1e-30f;
    float lo = sm * (1.f / (4.f * N));
    int clo = count_ge<N>(v, lo);
    if (__any(clo < 16)) {
        float mn = v[0];
#pragma unroll
        for (int i = 1; i < N; ++i) mn = fminf(mn, v[i]);
        mn = -colmax(-mn);
        if (clo < 16) { lo = mn; clo = 4 * N; }
    }
    refine16<N>(v, lo, clo, hi, 0, lo_o, hi_o);
}
DEV void col_offsets(int cntA, int cntT, int q4, int cidx, int& offA, int& offT) {
    const int g0 = __shfl(cntA, cidx), g1 = __shfl(cntA, cidx + 16), g2 = __shfl(cntA, cidx + 32), g3 = __shfl(cntA, cidx + 48);
    const int e0 = __shfl(cntT, cidx), e1 = __shfl(cntT, cidx + 16), e2 = __shfl(cntT, cidx + 32);
    offA = (q4 > 0 ? g0 : 0) + (q4 > 1 ? g1 : 0) + (q4 > 2 ? g2 : 0);
    offT = g0 + g1 + g2 + g3 + (q4 > 0 ? e0 : 0) + (q4 > 1 ? e1 : 0) + (q4 > 2 ? e2 : 0);
}

DEV void peer_topk_task2(const Params& p, int l, int task, float* wl) {
    unsigned char* ws = p.ws;
    const u16* QP = (const u16*)(ws + OFF_QP);
    const u16* K12 = (const u16*)(ws + OFF_K12) + (size_t)l * 2 * 16384;
    const int lane = TID() & 63, q4 = lane >> 4, cidx = lane & 15;
    const int tq = task * 2 + (cidx >> 3), hh = cidx & 7;
    float* scl = wl;
    float* lst = wl + 2048;
    float* vv[2] = {lst, lst + 512}; int* ii[2] = {(int*)(lst + 256), (int*)(lst + 768)};
    float* fs = lst + 1024; int* fi = (int*)(lst + 1280);
#pragma unroll 1
    for (int hf = 0; hf < 2; ++hf) {
        bf16x8 qf[4];
#pragma unroll
        for (int s2 = 0; s2 < 4; ++s2) qf[s2] = ld8(QP + (size_t)tq * 2048 + hh * 256 + hf * 128 + 32 * s2 + 8 * q4);
        float sc[32];
        const u16* kb = K12 + hf * 16384;
#pragma unroll
        for (int kt = 0; kt < 8; ++kt) {
            f32x4 st = (f32x4){0.f, 0.f, 0.f, 0.f};
#pragma unroll
            for (int s2 = 0; s2 < 4; ++s2) st = mfma16(ld8(kb + (kt * 16 + cidx) * 128 + 32 * s2 + 8 * q4), qf[s2], st);
#pragma unroll
            for (int r = 0; r < 4; ++r) sc[kt * 4 + r] = st[r];
            *(f32x4*)(scl + cidx * 128 + 16 * kt + 4 * q4) = st;
        }
        float lo, hi; select16<32>(sc, lo, hi);
        unsigned mh[1], ml_[1];
        ltmask<32>(sc, hi, mh);
        if (__all(lo == hi)) ml_[0] = mh[0]; else ltmask<32>(sc, lo, ml_);
        unsigned mA = ~mh[0], mT = ~ml_[0] & mh[0];
        int offA, offT; col_offsets(__popc(mA), __popc(mT), q4, cidx, offA, offT);
        float* vo = hf ? vv[1] : vv[0]; int* io = hf ? ii[1] : ii[0];
        while (__any(mA != 0u)) {
            if (mA) {
                const int i = __clz(mA); mA &= ~(0x80000000u >> i);
                io[cidx * 16 + offA] = 16 * (i >> 2) + 4 * q4 + (i & 3); ++offA;
            }
        }
        while (__any(mT != 0u)) {
            if (mT) {
                const int i = __clz(mT); mT &= ~(0x80000000u >> i);
                if (offT < 16) io[cidx * 16 + offT] = 16 * (i >> 2) + 4 * q4 + (i & 3);
                ++offT;
            }
        }
        lds_fence();
        {
            const int4 n4 = *(const int4*)(io + cidx * 16 + 4 * q4);
            float4 v4; v4.x = scl[cidx * 128 + n4.x]; v4.y = scl[cidx * 128 + n4.y]; v4.z = scl[cidx * 128 + n4.z]; v4.w = scl[cidx * 128 + n4.w];
            *(float4*)(vo + cidx * 16 + 4 * q4) = v4;
        }
        lds_fence();
    }
    {
        float cand[64];
        float v2r[16];
#pragma unroll
        for (int j = 0; j < 16; ++j) v2r[j] = vv[1][cidx * 16 + j];
#pragma unroll
        for (int a = 0; a < 4; ++a) {
            const float v1a = vv[0][cidx * 16 + 4 * q4 + a];
#pragma unroll
            for (int j = 0; j < 16; ++j) cand[a * 16 + j] = v1a + v2r[j];
        }
        float lo, hi;
        {
            float v2mx = v2r[0], v2mn = v2r[0];
#pragma unroll
            for (int j = 1; j < 16; ++j) { v2mx = fmaxf(v2mx, v2r[j]); v2mn = fminf(v2mn, v2r[j]); }
            float v1mx = fmaxf(fmaxf(vv[0][cidx * 16 + 4 * q4], vv[0][cidx * 16 + 4 * q4 + 1]), fmaxf(vv[0][cidx * 16 + 4 * q4 + 2], vv[0][cidx * 16 + 4 * q4 + 3]));
            float v1mn = fminf(fminf(vv[0][cidx * 16 + 4 * q4], vv[0][cidx * 16 + 4 * q4 + 1]), fminf(vv[0][cidx * 16 + 4 * q4 + 2], vv[0][cidx * 16 + 4 * q4 + 3]));
            v1mx = colmax(v1mx); v1mn = -colmax(-v1mn);
            const float smax = v1mx + v2mx;
            const float hi0 = smax + fabsf(smax) * 1e-6f + 1e-30f;
            const float lo0 = fmaxf(v1mn + v2mx, v1mx + v2mn);
            const int c0 = count_ge<64>(cand, lo0);
            refine16<64>(cand, lo0, c0, hi0, 0, lo, hi);
        }
        unsigned mh[2], ml_[2];
        ltmask<64>(cand, hi, mh);
        if (__all(lo == hi)) { ml_[0] = mh[0]; ml_[1] = mh[1]; } else ltmask<64>(cand, lo, ml_);
        unsigned mA0 = ~mh[0], mA1 = ~mh[1], mT0 = ~ml_[0] & mh[0], mT1 = ~ml_[1] & mh[1];
        int offA, offT; col_offsets(__popc(mA0) + __popc(mA1), __popc(mT0) + __popc(mT1), q4, cidx, offA, offT);
#pragma unroll
        for (int w = 0; w < 2; ++w) {
            unsigned mA = w ? mA1 : mA0;
            while (__any(mA != 0u)) {
                if (mA) {
                    const int i = __clz(mA); mA &= ~(0x80000000u >> i);
                    const int it = w * 32 + i; const int ci = (4 * q4 + (it >> 4)) * 16 + (it & 15);
                    fi[cidx * 16 + offA] = ci; ++offA;
                }
            }
        }
#pragma unroll
        for (int w = 0; w < 2; ++w) {
            unsigned mT = w ? mT1 : mT0;
            while (__any(mT != 0u)) {
                if (mT) {
                    const int i = __clz(mT); mT &= ~(0x80000000u >> i);
                    const int it = w * 32 + i; const int ci = (4 * q4 + (it >> 4)) * 16 + (it & 15);
                    if (offT < 16) fi[cidx * 16 + offT] = ci;
                    ++offT;
                }
            }
        }
    }
    lds_fence();
    {
        float s4[4]; int c4[4];
#pragma unroll
        for (int k = 0; k < 4; ++k) { c4[k] = fi[cidx * 16 + 4 * q4 + k]; s4[k] = vv[0][cidx * 16 + (c4[k] >> 4)] + vv[1][cidx * 16 + (c4[k] & 15)]; }
        float mx = fmaxf(fmaxf(s4[0], s4[1]), fmaxf(s4[2], s4[3]));
        mx = colmax(mx);
        float e4[4]; float sm = 0.f;
#pragma unroll
        for (int k = 0; k < 4; ++k) { e4[k] = __expf(s4[k] - mx); sm += e4[k]; }
        sm = colsum(sm);
        const float inv = 1.f / sm;
        int4 eo; float4 go;
        eo.x = ii[0][cidx * 16 + (c4[0] >> 4)] * 128 + ii[1][cidx * 16 + (c4[0] & 15)];
        eo.y = ii[0][cidx * 16 + (c4[1] >> 4)] * 128 + ii[1][cidx * 16 + (c4[1] & 15)];
        eo.z = ii[0][cidx * 16 + (c4[2] >> 4)] * 128 + ii[1][cidx * 16 + (c4[2] & 15)];
        eo.w = ii[0][cidx * 16 + (c4[3] >> 4)] * 128 + ii[1][cidx * 16 + (c4[3] & 15)];
        go.x = e4[0] * inv; go.y = e4[1] * inv; go.z = e4[2] * inv; go.w = e4[3] * inv;
        int* eol = (int*)(wl + 3584); float* gol = wl + 3584 + 256;
        *(int4*)(eol + cidx * 16 + 4 * q4) = eo; *(float4*)(gol + cidx * 16 + 4 * q4) = go;
    }
    lds_fence();
}

DEV float gelu_exact(float x) { return 0.5f * x * (1.f + erff(x * 0.70710678118654752f)); }
DEV void unpack8(const bf16x8 v, float* f) {
    union { bf16x8 v; unsigned u[4]; } c; c.v = v;
#pragma unroll
    for (int i = 0; i < 4; ++i) { f[2 * i] = bflo(c.u[i]); f[2 * i + 1] = bfhi(c.u[i]); }
}
DEV void peer_experts_token(const Params& p, int l, int tok, const int* el_src, const float* w_src) {
    unsigned char* ws = p.ws;
    const u16* H = (const u16*)(ws + OFF_H);
    u16* Hw = (u16*)(ws + OFF_H);
    const unsigned char* U8 = ws + OFF_U8;
    const unsigned char* V8 = ws + OFF_U8 + 16 * MiB;
    const float* SU = (const float*)(ws + OFF_UVS);
    const float* SV = (const float*)(ws + OFF_UVS) + 16384;
    const float* mod = (const float*)(ws + OFF_MOD);
    const float* g2 = mod + l * 4 * 6144 + 5 * 1024;
    const int lane = TID() & 63;
    {
        const int b = tok >> 13;
        float acc[16];
#pragma unroll
        for (int i = 0; i < 16; ++i) acc[i] = 0.f;
#if EN_PEER
        unsigned hp[4]; float shq; int corr0;
        {
            float hx[16];
            unpack8(ld8(H + (size_t)tok * 1024 + 16 * lane), hx);
            unpack8(ld8(H + (size_t)tok * 1024 + 16 * lane + 8), hx + 8);
            float amax = 0.f;
#pragma unroll
            for (int i = 0; i < 16; ++i) amax = fmaxf(amax, fabsf(hx[i]));
            amax = wave_max(amax);
            shq = amax > 0.f ? amax * (1.f / 127.f) : 1.f;
            const float inv = 1.f / shq;
            int hsum = 0;
#pragma unroll
            for (int i = 0; i < 4; ++i) {
                const int a = __float2int_rn(hx[4 * i] * inv) + 128, b2 = __float2int_rn(hx[4 * i + 1] * inv) + 128, c = __float2int_rn(hx[4 * i + 2] * inv) + 128,
                          d = __float2int_rn(hx[4 * i + 3] * inv) + 128;
                hp[i] = (unsigned)a | ((unsigned)b2 << 8) | ((unsigned)c << 16) | ((unsigned)d << 24);
                hsum += a + b2 + c + d;
            }
            hsum = wave_sum_i(hsum);
            corr0 = 128 * 128 * 1024 - 128 * hsum;
        }
        const int* RSU = (const int*)(ws + OFF_UVS) + 2 * 16384;
        float corr = 0.f;
        u32x4 uqA[8], vqA[8], uqB[8], vqB[8];
#define PEER_LOAD(UQ, VQ, G_) { const int el_ = el_src[((G_) >> 1) * 16 + (lane & 15)]; const int k0_ = ((G_) & 1) * 8; _Pragma("unroll") for (int k = 0; k < 8; ++k) { \
            const int e = __builtin_amdgcn_readlane(el_, k0_ + k); UQ[k] = *(const u32x4*)(U8 + (size_t)e * 1024 + 16 * lane); VQ[k] = *(const u32x4*)(V8 + (size_t)e * 1024 + 16 * lane); } }
#define PEER_EVAL(UQ, VQ, G_) { const int hh_ = (G_) >> 1, k0_ = ((G_) & 1) * 8; const int el = el_src[hh_ * 16 + (lane & 15)]; const float wgt = w_src[hh_ * 16 + (lane & 15)]; \
            const float sul = SU[el] * shq, wsl = wgt * SV[el]; const int rsl = corr0 - 128 * RSU[el]; \
            int dpart[8]; _Pragma("unroll") for (int k = 0; k < 8; ++k) { unsigned di = 0u; _Pragma("unroll") for (int i = 0; i < 4; ++i) di = __builtin_amdgcn_udot4(UQ[k][i], hp[i], di, false); dpart[k] = (int)di; } \
            const int dsum = reduce8_i(dpart); const int srcl = k0_ + (lane >> 3); \
            const float sul_e = __shfl(sul, srcl), wsl_e = __shfl(wsl, srcl); const int rsl_e = __shfl(rsl, srcl); \
            const float actl = gelu_exact((float)(dsum + rsl_e) * sul_e) * wsl_e; \
            _Pragma("unroll") for (int k = 0; k < 8; ++k) { const float act = __int_as_float(__builtin_amdgcn_readlane(__float_as_int(actl), 8 * k)); corr += act * 128.f; \
                _Pragma("unroll") for (int i = 0; i < 4; ++i) { const unsigned w = VQ[k][i]; \
                    acc[4 * i] += act * (float)(w & 0xffu); acc[4 * i + 1] += act * (float)((w >> 8) & 0xffu); acc[4 * i + 2] += act * (float)((w >> 16) & 0xffu); acc[4 * i + 3] += act * (float)(w >> 24); } } }
        PEER_LOAD(uqA, vqA, 0);
#pragma unroll 1
        for (int g = 0; g < 16; g += 2) {
            PEER_LOAD(uqB, vqB, g + 1);
            PEER_EVAL(uqA, vqA, g);
            if (g + 2 < 16) PEER_LOAD(uqA, vqA, g + 2);
            PEER_EVAL(uqB, vqB, g + 1);
        }
#undef PEER_LOAD
#undef PEER_EVAL
#pragma unroll
        for (int i = 0; i < 16; ++i) acc[i] -= corr;
#endif
        const int k = 16 * lane;
        float xn[16]; float ss = 0.f;
#pragma unroll
        for (int i = 0; i < 4; ++i) {
            const float4 x0 = *(const float4*)(p.out + (size_t)tok * 1024 + k + 4 * i);
            const float4 ga = *(const float4*)(g2 + b * 6144 + k + 4 * i);
            xn[4 * i] = x0.x + ga.x * acc[4 * i]; xn[4 * i + 1] = x0.y + ga.y * acc[4 * i + 1];
            xn[4 * i + 2] = x0.z + ga.z * acc[4 * i + 2]; xn[4 * i + 3] = x0.w + ga.w * acc[4 * i + 3];
        }
#pragma unroll
        for (int i = 0; i < 16; ++i) ss += xn[i] * xn[i];
        ss = wave_sum(ss);
        const float rs = rsqrtf(ss * (1.f / 1024.f) + 1e-6f);
        if (l == 0) {
            const float* n1g = p.in[I_N1G] + 1024; const float* sh = mod + 4 * 6144 + b * 6144; const float* sc = sh + 1024;
            float hv[16];
#pragma unroll
            for (int i = 0; i < 4; ++i) {
                *(float4*)(p.out + (size_t)tok * 1024 + k + 4 * i) = (float4){xn[4 * i], xn[4 * i + 1], xn[4 * i + 2], xn[4 * i + 3]};
                const float4 gg = *(const float4*)(n1g + k + 4 * i), s1 = *(const float4*)(sc + k + 4 * i), s0 = *(const float4*)(sh + k + 4 * i);
                hv[4 * i] = xn[4 * i] * rs * gg.x * (1.f + s1.x) + s0.x; hv[4 * i + 1] = xn[4 * i + 1] * rs * gg.y * (1.f + s1.y) + s0.y;
                hv[4 * i + 2] = xn[4 * i + 2] * rs * gg.z * (1.f + s1.z) + s0.z; hv[4 * i + 3] = xn[4 * i + 3] * rs * gg.w * (1.f + s1.w) + s0.w;
            }
            u32x4 w0, w1;
#pragma unroll
            for (int i = 0; i < 4; ++i) { w0[i] = pack2(hv[2 * i], hv[2 * i + 1]); w1[i] = pack2(hv[8 + 2 * i], hv[8 + 2 * i + 1]); }
            *(u32x4*)(Hw + (size_t)tok * 1024 + k) = w0; *(u32x4*)(Hw + (size_t)tok * 1024 + k + 8) = w1;
        } else {
            const float* fg = p.in[I_FG];
#pragma unroll
            for (int i = 0; i < 4; ++i) {
                const float4 gg = *(const float4*)(fg + k + 4 * i);
                *(float4*)(p.out + (size_t)tok * 1024 + k + 4 * i) = (float4){xn[4 * i] * rs * gg.x, xn[4 * i + 1] * rs * gg.y, xn[4 * i + 2] * rs * gg.z, xn[4 * i + 3] * rs * gg.w};
            }
        }
    }
}

constexpr int NPH = 20;

__global__ void __launch_bounds__(256, 2) mega(Params p) {
    __shared__ __attribute__((aligned(16))) unsigned char lds[81920 - 128];
    __shared__ int misc[8];
    int* qslot = misc;
    cg::grid_group grid = cg::this_grid();
    if (threadIdx.x < 8) misc[threadIdx.x] = 0;
    __syncthreads();
    XcdBarrier xbar = xcd_barrier_post((unsigned*)(p.ws + OFF_BAR), (volatile unsigned*)(misc + 4));
    unsigned char* ws = p.ws;
    const float* mod = (const float*)(ws + OFF_MOD);
    unsigned* ctl = (unsigned*)(ws + OFF_CTL);
    const int G = gridDim.x, bx = BID();
    for (int ph = p.ph_lo; ph < p.ph_hi; ++ph) {
        if (ph >= 2 && (ph - 2) % 9 == 8) continue;
        if (ph == 0) {
            phase_prep(p, lds);
        } else if (ph == 1) {
            phase_norm(p.in[I_X], p.in[I_N1G], mod + 0 * 1024, mod + 1 * 1024, (u16*)(ws + OFF_H));
        } else {
            const int l = (ph - 2) / 9, sp = (ph - 2) % 9;
            const float* modl = mod + l * 4 * 6144;
            if (sp == 0) {
                EpiInProj e{(u16*)(ws + OFF_PCONV), (u16*)(ws + OFF_PRWKV), (u16*)(ws + OFF_Q), (u16*)(ws + OFF_KV), (float*)(ws + OFF_GATE)};
                gemm_phase((const u16*)(ws + OFF_H), 1024, (const u16*)(ws + OFF_WIN) + (size_t)l * NINP * 1024, 1024, 256, 8, 1024, e, lds, bx, G, 0, 4);
            } else if (sp == 1) {
#if EN_RWKV
                for (;;) { const int t = block_next(ctl + QW(l, Q_RWP), qslot); if (t >= NTOK / 16) break; rwkv_prep_tile2(p, l, t, lds); }
#endif
            } else if (sp == 2) {
#if EN_RWKV
                if (bx < 64) { __builtin_amdgcn_s_setprio(3); rwkv_scan(p, bx, lds); __builtin_amdgcn_s_setprio(0); }
#endif
                unsigned* cdone = ctl + QW(l, 5);
                unsigned* gdone = ctl + QW(l, 6);
                if (bx >= 64) {
                    EpiInProj e{(u16*)(ws + OFF_PCONV), (u16*)(ws + OFF_PRWKV), (u16*)(ws + OFF_Q), (u16*)(ws + OFF_KV), (float*)(ws + OFF_GATE)};
                    gemm_phase((const u16*)(ws + OFF_H), 1024, (const u16*)(ws + OFF_WIN) + (size_t)l * NINP * 1024, 1024, 256, 15, 1024, e, lds, bx - 64, G - 64, 4, 8, false);
                    asm volatile("s_waitcnt vmcnt(0)" ::: "memory");
                    __syncthreads();
                    if (threadIdx.x == 0) {
                        __builtin_amdgcn_fence(__ATOMIC_RELEASE, "agent");
                        asm volatile("s_waitcnt vmcnt(0)" ::: "memory");
                        __hip_atomic_fetch_add(gdone, 1u, __ATOMIC_RELAXED, __HIP_MEMORY_SCOPE_AGENT);
                    }
                }
                __syncthreads();
                if (threadIdx.x == 0) {
                    unsigned sp_ = 0;
                    while (__hip_atomic_load(gdone, __ATOMIC_RELAXED, __HIP_MEMORY_SCOPE_AGENT) < (unsigned)(G - 64)) { __builtin_amdgcn_s_sleep(8); if (++sp_ > (1u << 24)) break; }
                    __builtin_amdgcn_fence(__ATOMIC_ACQUIRE, "agent");
                    asm volatile("s_waitcnt vmcnt(0)" ::: "memory");
                }
                __syncthreads();
                if (bx >= 64 && bx < 128) {
                    const u16* KVb = (const u16*)(ws + OFF_KV);
                    if (bx < 96) {
                        EpiCompress ek{(const float*)(ws + OFF_CBP) + (l * 2 + 0) * 2048, p.in[I_CKW2] + (size_t)l * 8192, (u16*)(ws + OFF_KC), 0, lds};
                        gemm_phase(KVb, 1024, (const u16*)(ws + OFF_CW1) + (size_t)(l * 2 + 0) * 128 * 2048, 2048, 32, 1, 2048, ek, lds, bx - 64, 1 << 20);
                    } else {
                        EpiCompress ev{(const float*)(ws + OFF_CBP) + (l * 2 + 1) * 2048, p.in[I_CVW2] + (size_t)l * 8192, (u16*)(ws + OFF_VCT), 1, lds};
                        gemm_phase(KVb + 4194304, 1024, (const u16*)(ws + OFF_CW1) + (size_t)(l * 2 + 1) * 128 * 2048, 2048, 32, 1, 2048, ev, lds, bx - 96, 1 << 20);
                    }
                    asm volatile("s_waitcnt vmcnt(0)" ::: "memory");
                    __syncthreads();
                    if (threadIdx.x == 0) {
                        __builtin_amdgcn_fence(__ATOMIC_RELEASE, "agent");
                        asm volatile("s_waitcnt vmcnt(0)" ::: "memory");
                        __hip_atomic_fetch_add(cdone, 1u, __ATOMIC_RELAXED, __HIP_MEMORY_SCOPE_AGENT);
                    }
                }
#if EN_CONV
                for (;;) { const int t = block_next(ctl + QW(l, Q_CONV), qslot); if (t >= NTOK / 32) break; conv_tile(p, l, t, lds); }
#else
                zero_mix_cols(p, 0, 256);
#endif
                __syncthreads();
                if (threadIdx.x == 0) {
                    unsigned sp_ = 0;
                    while (__hip_atomic_load(cdone, __ATOMIC_RELAXED, __HIP_MEMORY_SCOPE_AGENT) < 64u) { __builtin_amdgcn_s_sleep(8); if (++sp_ > (1u << 24)) break; }
                    __builtin_amdgcn_fence(__ATOMIC_ACQUIRE, "agent");
                    asm volatile("s_waitcnt vmcnt(0)" ::: "memory");
                }
                __syncthreads();
                for (int qi = 0; qi < 8; ++qi) {
                    const int bgq = (bx + qi) & 7;
                    for (;;) { const int t = block_next(ctl + QW(l, Q_NSA) + bgq, qslot); if (t >= 256) break; nsa_block_task(p, t * 8 + bgq, lds); }
                }
                if (l == 0) {
                    float* fl = (float*)lds;
                    for (;;) {
                        const int t = block_next(ctl + QW(0, 0), qslot); if (t >= 1536) break;
                        if (t < 512) { const int l2 = t >> 8, r = t & 255; transpose_tile(p.in[I_WOUT] + (size_t)l2 * 1024 * 1024, 1024, (u16*)(ws + OFF_WOUT) + (size_t)l2 * 1024 * 1024, 1024, r >> 4, r & 15, fl); }
                        else { const int u = t - 512; const int l2 = u >> 9, r = u & 511; transpose_tile(p.in[I_PWQ] + (size_t)l2 * 1024 * 2048, 2048, (u16*)(ws + OFF_WQ) + (size_t)l2 * 2048 * 1024, 1024, r >> 5, r & 31, fl); }
                    }
                }
                for (;;) {
                    const int t = block_next(ctl + QW(l, 7), qslot); if (t >= 1024) break;
                    const int tb = t >> 9, r0 = (t & 511) * 32;
                    convert_rows_task(p.in[tb ? I_PV : I_PU] + (size_t)l * 16384 * 1024, ws + OFF_U8 + (size_t)tb * 16 * MiB, (float*)(ws + OFF_UVS) + tb * 16384,
                                      tb ? nullptr : (int*)(ws + OFF_UVS) + 2 * 16384, r0);
                }
            } else if (sp == 3) {
#if EN_RWKV
                phase_rwkv_post(p, l);
#else
                zero_mix_cols(p, 256, 256);
#endif
            } else if (sp == 4) {
                EpiOutProj e{l == 0 ? p.in[I_X] : p.out, p.out, modl + 2 * 1024};
                gemm_phase((const u16*)(ws + OFF_MIX), 1024, (const u16*)(ws + OFF_WOUT) + (size_t)l * 1024 * 1024, 1024, 256, 8, 1024, e, lds, bx, G);
            } else if (sp == 5) {
#if EN_PEER
                phase_norm(p.out, p.in[I_N2G] + l * 1024, modl + 3 * 1024, modl + 4 * 1024, (u16*)(ws + OFF_H));
#endif
            } else if (sp == 6) {
#if EN_PEER
                EpiStoreBf16 e{(u16*)(ws + OFF_QP), 2048};
                gemm_phase((const u16*)(ws + OFF_H), 1024, (const u16*)(ws + OFF_WQ) + (size_t)l * 2048 * 1024, 1024, 256, 16, 1024, e, lds, bx, G);
#endif
            } else if (sp == 7) {
#if EN_PEER
                float* wl = (float*)lds + (TID() >> 6) * 4096;
                for (int t = bx * 4 + (TID() >> 6); t < NTOK / 2; t += G * 4) {
                    peer_topk_task2(p, l, t, wl);
                    __builtin_amdgcn_s_setprio(3);
                    peer_experts_token(p, l, 2 * t, (const int*)(wl + 3584), wl + 3584 + 256);
                    peer_experts_token(p, l, 2 * t + 1, (const int*)(wl + 3584) + 128, wl + 3584 + 256 + 128);
                    __builtin_amdgcn_s_setprio(0);
                    lds_fence();
                }
#endif
            }
        }
        if (ph + 1 < p.ph_hi) { if (p.ph_lo < 0) grid.sync(); else xcd_barrier(xbar); }
    }
}

extern "C" void kernel_launch(void* const* d_in, const int* in_sizes, int n_in, void* d_out, int out_size, void* d_ws, size_t ws_size,
                              hipStream_t stream) {
    static int grid_blocks = 0;
    if (!grid_blocks) {
        int dev = 0, cus = 0, per_cu = 0;
        hipGetDevice(&dev);
        hipDeviceGetAttribute(&cus, hipDeviceAttributeMultiprocessorCount, dev);
        hipOccupancyMaxActiveBlocksPerMultiprocessor(&per_cu, (const void*)mega, 256, 0);
        if (per_cu > 2) per_cu = 2;
        if (per_cu < 1) per_cu = 1;
        grid_blocks = cus * per_cu;
        if (ws_size < WS_NEED) fprintf(stderr, "kernel_launch: workspace too small: %zu < %zu\n", ws_size, (size_t)WS_NEED);
    }
    hipMemsetAsync((char*)d_ws + OFF_CTL, 0, CTL_ZERO_BYTES, stream);
    Params p{};
    for (int i = 0; i < 35; ++i) p.in[i] = (const float*)d_in[i];
    p.out = (float*)d_out;
    p.ws = (unsigned char*)d_ws;
#if MULTI_LAUNCH
    for (int ph = 0; ph < NPH; ++ph) {
        p.ph_lo = ph; p.ph_hi = ph + 1;
        hipLaunchKernelGGL(mega, dim3(grid_blocks), dim3(256), 0, stream, p);
    }
#else
    p.ph_lo = 0; p.ph_hi = NPH;
    void* args[] = {&p};
    hipError_t e = hipLaunchCooperativeKernel((const void*)mega, dim3(grid_blocks), dim3(256), args, 0, stream);
    if (e != hipSuccess) fprintf(stderr, "cooperative launch failed: %s (grid %d)\n", hipGetErrorString(e), grid_blocks);
#endif
}
```

```cpp
#include <hip/hip_runtime.h>
#include <hip/hip_cooperative_groups.h>
#include <stdint.h>
#include <stdio.h>
namespace cg = cooperative_groups;

#ifndef EN_CONV
#define EN_CONV 1
#endif
#ifndef EN_RWKV
#define EN_RWKV 1
#endif
#ifndef EN_NSA_CMP
#define EN_NSA_CMP 1
#endif
#ifndef EN_NSA_WIN
#define EN_NSA_WIN 1
#endif
#ifndef EN_NSA_SEL
#define EN_NSA_SEL 1
#endif
#ifndef EN_PEER
#define EN_PEER 1
#endif
#ifndef MULTI_LAUNCH
#define MULTI_LAUNCH 0
#endif

#define DEV __device__ __forceinline__
typedef unsigned short u16;
typedef __attribute__((ext_vector_type(8))) short bf16x8;
typedef __attribute__((ext_vector_type(4))) float f32x4;
typedef __attribute__((ext_vector_type(4))) unsigned int u32x4;
typedef __attribute__((ext_vector_type(2))) unsigned int u32x2;

constexpr int NB = 4, NT = 8192, ND = 1024, NTOK = NB * NT, NL = 2;
constexpr int NIN = 2840, NINP = 2944;
constexpr size_t MiB = 1ull << 20;

constexpr size_t OFF_CTL = 0;
constexpr size_t CTL_ZERO_BYTES = 32768;
constexpr size_t OFF_BAR = 16384;
constexpr size_t OFF_MOD = 64 * 1024;
constexpr size_t OFF_CBP = 256 * 1024;
constexpr size_t OFF_WIN = 1 * MiB;
constexpr size_t OFF_WOUT = 13 * MiB;
constexpr size_t OFF_WQ = 17 * MiB;
constexpr size_t OFF_CW1 = 25 * MiB;
constexpr size_t OFF_K12 = 27 * MiB;
constexpr size_t OFF_LW = 27 * MiB + 512 * 1024;
constexpr size_t OFF_U8 = 28 * MiB;
constexpr size_t OFF_UVS = 512 * 1024;
constexpr size_t OFF_H = 92 * MiB;
constexpr size_t OFF_MIX = 156 * MiB;
constexpr size_t OFF_E = 220 * MiB;
constexpr size_t OFF_PCONV = OFF_E + 0;
constexpr size_t OFF_PRWKV = OFF_E + 32 * MiB;
constexpr size_t OFF_YRAW = OFF_E + 32 * MiB;
constexpr size_t OFF_Q = OFF_E + 96 * MiB;
constexpr size_t OFF_KV = OFF_E + 128 * MiB;
constexpr size_t OFF_GATE = OFF_E + 176 * MiB;
constexpr size_t OFF_KC = OFF_E + 180 * MiB;
constexpr size_t OFF_VCT = OFF_KC + 512 * 1024;
constexpr size_t OFF_RV = OFF_E + 184 * MiB;
constexpr size_t OFF_RKK = OFF_E + 200 * MiB;
constexpr size_t OFF_RKKA = OFF_E + 216 * MiB;
constexpr size_t OFF_RG = OFF_E + 232 * MiB;
constexpr size_t OFF_BONUS = OFF_E + 248 * MiB;
constexpr size_t OFF_RW = OFF_E + 249 * MiB;
constexpr size_t OFF_RR = 60 * MiB;
constexpr size_t OFF_RK = 76 * MiB;
constexpr size_t OFF_QP = OFF_E + 0;
constexpr size_t OFF_PIDX = OFF_E + 128 * MiB;
constexpr size_t OFF_PGW = OFF_E + 144 * MiB;
constexpr size_t WS_NEED = OFF_E + 281 * MiB;

#define QW(l, q) (64 * ((l) * 8 + (q)))
enum { Q_CMP = 0, Q_CONV = 1, Q_RWP = 2, Q_NSA = 3, Q_PTK = 4 };

enum { I_X = 0, I_C, I_ADAW, I_ADAB, I_N1G, I_N2G, I_WIN, I_CDW, I_CDB, I_CGG, I_CGB, I_MU, I_W0, I_WUP, I_A0, I_AUP, I_GUP,
       I_KK, I_KA, I_RK, I_LNG, I_LNB, I_CKPOS, I_CKW1, I_CKW2, I_CVPOS, I_CVW1, I_CVW2, I_WOUT, I_PWQ, I_PK1, I_PK2, I_PU, I_PV, I_FG };

struct Params {
    const float* in[35];
    float* out;
    unsigned char* ws;
    int ph_lo, ph_hi;
};

DEV int TID() { int t = threadIdx.x; asm volatile("" : "+v"(t)); return t; }
DEV int BID() { int t = blockIdx.x; asm volatile("" : "+s"(t)); return t; }
typedef __attribute__((ext_vector_type(2))) float f32x2_t;
typedef __attribute__((ext_vector_type(2))) __bf16 bf16x2_t;
DEV unsigned pack2(float a, float b) { const f32x2_t v = {a, b}; return __builtin_bit_cast(unsigned, __builtin_convertvector(v, bf16x2_t)); }
DEV u16 f2bf(float f) { const __bf16 h = (__bf16)f; return __builtin_bit_cast(u16, h); }
DEV float bf2f(u16 h) { return __uint_as_float(((unsigned)h) << 16); }
DEV float bflo(unsigned u) { return __uint_as_float(u << 16); }
DEV float bfhi(unsigned u) { return __uint_as_float(u & 0xffff0000u); }
DEV float ex2(float x) { return __builtin_amdgcn_exp2f(x); }
DEV float sigmoidf_(float x) { return 1.f / (1.f + __expf(-x)); }

DEV f32x4 mfma16(bf16x8 a, bf16x8 b, f32x4 c) { return __builtin_amdgcn_mfma_f32_16x16x32_bf16(a, b, c, 0, 0, 0); }
template <int CTRL> DEV float dppf(float x) { return __int_as_float(__builtin_amdgcn_update_dpp(0, __float_as_int(x), CTRL, 0xF, 0xF, false)); }
template <int CTRL> DEV unsigned dppu(unsigned x) { return (unsigned)__builtin_amdgcn_update_dpp(0, (int)x, CTRL, 0xF, 0xF, false); }
DEV float reduce16(float x) { x += dppf<0xB1>(x); x += dppf<0x4E>(x); x += dppf<0x124>(x); x += dppf<0x128>(x); return x; }
DEV float quadsum(float x) { x += dppf<0xB1>(x); x += dppf<0x4E>(x); return x; }
DEV float x16_sum(float x) { auto r = __builtin_amdgcn_permlane16_swap(__float_as_uint(x), __float_as_uint(x), false, false); return __uint_as_float(r[0]) + __uint_as_float(r[1]); }
DEV float x32_sum(float x) { auto r = __builtin_amdgcn_permlane32_swap(__float_as_uint(x), __float_as_uint(x), false, false); return __uint_as_float(r[0]) + __uint_as_float(r[1]); }
DEV float x16_max(float x) { auto r = __builtin_amdgcn_permlane16_swap(__float_as_uint(x), __float_as_uint(x), false, false); return fmaxf(__uint_as_float(r[0]), __uint_as_float(r[1])); }
DEV float x32_max(float x) { auto r = __builtin_amdgcn_permlane32_swap(__float_as_uint(x), __float_as_uint(x), false, false); return fmaxf(__uint_as_float(r[0]), __uint_as_float(r[1])); }
DEV int x16_sumi(int x) { auto r = __builtin_amdgcn_permlane16_swap((unsigned)x, (unsigned)x, false, false); return (int)(r[0] + r[1]); }
DEV int x32_sumi(int x) { auto r = __builtin_amdgcn_permlane32_swap((unsigned)x, (unsigned)x, false, false); return (int)(r[0] + r[1]); }
DEV float colsum(float x) { return x32_sum(x16_sum(x)); }
DEV float colmax(float x) { return x32_max(x16_max(x)); }
DEV int colsumi(int x) { return x32_sumi(x16_sumi(x)); }
DEV float wave_sum(float v) { return x32_sum(x16_sum(reduce16(v))); }
DEV int wave_sum_i(int x) {
    x += (int)dppu<0xB1>((unsigned)x); x += (int)dppu<0x4E>((unsigned)x); x += (int)dppu<0x124>((unsigned)x); x += (int)dppu<0x128>((unsigned)x);
    return x32_sumi(x16_sumi(x));
}
DEV int reduce8_i(const int (&d)[8]) {
    int t[4];
#pragma unroll
    for (int k = 0; k < 4; ++k) {
        auto r = __builtin_amdgcn_permlane32_swap((unsigned)d[k], (unsigned)d[k + 4], false, false);
        t[k] = (int)(r[0] + r[1]);
    }
    int u[2];
#pragma unroll
    for (int k = 0; k < 2; ++k) {
        auto r = __builtin_amdgcn_permlane16_swap((unsigned)t[k], (unsigned)t[k + 2], false, false);
        u[k] = (int)(r[0] + r[1]);
    }
    const bool hi8 = (threadIdx.x & 8) != 0;
    int x = hi8 ? u[1] : u[0];
    const int y = hi8 ? u[0] : u[1];
    x += (int)dppu<0x128>((unsigned)y);
    x += (int)dppu<0xB1>((unsigned)x); x += (int)dppu<0x4E>((unsigned)x); x += (int)dppu<0x141>((unsigned)x);
    return x;
}
DEV float wave_max(float x) {
    x = fmaxf(x, dppf<0xB1>(x)); x = fmaxf(x, dppf<0x4E>(x)); x = fmaxf(x, dppf<0x124>(x)); x = fmaxf(x, dppf<0x128>(x));
    return x32_max(x16_max(x));
}
DEV void lds_fence() { asm volatile("s_waitcnt lgkmcnt(0)" ::: "memory"); }
DEV bf16x8 ld8(const u16* p) { return *(const bf16x8*)p; }

DEV int block_next(unsigned* ctr, int* slot) {
    __syncthreads();
    if (TID() == 0) *slot = (int)atomicAdd(ctr, 1u);
    __syncthreads();
    return *slot;
}

#define XB_TMO      128
#define XB_XCNT(j)  (256  + 64 * (j))
#define XB_XSUB(j)  (1280 + 64 * (j))
#define XB_XGEN(j)  (2304 + 64 * (j))
#define XB_TOP      3328
#define XB_TOPGEN   3392
#define XCD_BAR_WORDS 3456
#define XB_SPIN_CAP (1u << 22)
#define LAS __attribute__((address_space(3)))
DEV unsigned xb_ld(unsigned* p) { return __hip_atomic_load(p, __ATOMIC_RELAXED, __HIP_MEMORY_SCOPE_AGENT); }
DEV unsigned xb_add(unsigned* p, unsigned v) { return __hip_atomic_fetch_add(p, v, __ATOMIC_RELAXED, __HIP_MEMORY_SCOPE_AGENT); }
DEV unsigned xb_xcc_id() { return (unsigned)__builtin_amdgcn_s_getreg((3 << 11) | 20) & 0xFu; }
#define XB_SPIN(cond, bar) do { unsigned _sp = 0; while (cond) { __builtin_amdgcn_s_sleep(1); \
    if ((++_sp & 255u) == 0u) { if (xb_ld(&(bar)[XB_TMO])) break; if (_sp > XB_SPIN_CAP) { atomicAdd(&(bar)[XB_TMO], 1u); break; } } } } while (0)
struct XcdBarrier { unsigned* bar; unsigned x; volatile unsigned* st; };
DEV XcdBarrier xcd_barrier_post(unsigned* bar, volatile unsigned* st) {
    XcdBarrier b; b.bar = bar; b.x = xb_xcc_id(); b.st = st;
    if (threadIdx.x == 0) (void)xb_add(&bar[XB_XCNT(b.x)], 1u);
    return b;
}
DEV void xcd_barrier_complete(unsigned* bar, unsigned x, unsigned& nloc, unsigned& nx) {
    const unsigned G = gridDim.x * gridDim.y * gridDim.z;
    unsigned sum, cnt, mine, sp = 0u;
    for (;;) {
        sum = 0u; cnt = 0u; mine = 0u;
#pragma unroll
        for (unsigned j = 0; j < 16; ++j) { const unsigned c = xb_ld(&bar[XB_XCNT(j)]); sum += c; cnt += (c > 0u) ? 1u : 0u; mine = (j == x) ? c : mine; }
        if (sum == G) break;
        __builtin_amdgcn_s_sleep(1);
        if ((++sp & 255u) == 0u) { if (xb_ld(&bar[XB_TMO])) break; if (sp > XB_SPIN_CAP) { atomicAdd(&bar[XB_TMO], 1u); break; } }
    }
    nloc = mine > 0u ? mine : 1u; nx = cnt > 0u ? cnt : 1u;
}
DEV void xcd_barrier(const XcdBarrier& b) {
    asm volatile("s_waitcnt vmcnt(0)" ::: "memory");
    __syncthreads();
    if (threadIdx.x == 0) {
        unsigned* bar = b.bar;
        __builtin_amdgcn_s_waitcnt(0);
        unsigned nloc = b.st[0], nx = b.st[1];
        if (nloc == 0u) { xcd_barrier_complete(bar, b.x, nloc, nx); b.st[0] = nloc; b.st[1] = nx; }
        const unsigned old = xb_add(&bar[XB_XSUB(b.x)], 1u);
        const unsigned gen = old / nloc;
        if (old + 1u == (gen + 1u) * nloc) {
            __builtin_amdgcn_fence(__ATOMIC_RELEASE, "agent");
            asm volatile("s_waitcnt vmcnt(0)" ::: "memory");
            const unsigned og = xb_add(&bar[XB_TOP], 1u);
            const unsigned tg = og / nx;
            if (og + 1u == (tg + 1u) * nx) xb_add(&bar[XB_TOPGEN], 1u);
            else XB_SPIN(xb_ld(&bar[XB_TOPGEN]) == tg, bar);
            __builtin_amdgcn_fence(__ATOMIC_ACQUIRE, "agent");
            xb_add(&bar[XB_XGEN(b.x)], 1u);
            asm volatile("s_waitcnt vmcnt(0)" ::: "memory");
        } else {
            XB_SPIN(xb_ld(&bar[XB_XGEN(b.x)]) == gen, bar);
            __builtin_amdgcn_fence(__ATOMIC_ACQUIRE, "agent");
            asm volatile("s_waitcnt vmcnt(0)" ::: "memory");
        }
    }
    __syncthreads();
}

template <class Epi>
DEV void gemm_phase(const u16* __restrict__ A, int lda, const u16* __restrict__ Bt, int ldb, int mtiles, int ntiles, int K, Epi& epi,
                    unsigned char* lds, int bid, int nb, int nt_lo = 0, int nt_skip = 0, bool xcd_order = true) {
    const int tid = TID(), lane = tid & 63, wave = tid >> 6;
    const int wm = wave >> 1, wn = wave & 1, q4 = lane >> 4, cidx = lane & 15;
    u16* As = (u16*)lds;
    u16* Bs = (u16*)(lds + 32768);
    const int KT = K >> 6;
    const int total = mtiles * ntiles;
    const int srow = tid >> 3, sch = tid & 7;
    const bool xo_ = xcd_order && ((nb & 7) == 0) && (nb <= 4096) && ((mtiles & 7) == 0);
    const int ngroups = (ntiles + 7) >> 3;
    const int nloc = xo_ ? (nb >> 3) : 1;
    const int nvirt = xo_ ? ((mtiles >> 3) * ngroups * 64) : total;
    for (int vt = xo_ ? ((bid & 7) * 64 + (bid >> 3)) : bid; vt < nvirt; vt += xo_ ? ((((vt & 63) + nloc) < 64) ? nloc : (8 * 64 - (vt & 63) + (bid >> 3))) : nb) {
        int mt, nt;
        if (xo_) {
            const int st = vt >> 6, tt = vt & 63;
            mt = (st / ngroups) * 8 + (tt >> 3); nt = (st % ngroups) * 8 + (tt & 7);
            if (nt >= ntiles) continue;
        } else { mt = vt / ntiles; nt = vt - mt * ntiles; }
        if (nt >= nt_lo) nt += nt_skip;
        const int m0 = mt * 128, n0 = nt * 128;
        const bool sw = epi.swapped(n0 + wn * 64);
        const int xo = sw ? (32768 / 2 + wn * 64 * 64) : (wm * 64 * 64);
        const int yo = sw ? (wm * 64 * 64) : (32768 / 2 + wn * 64 * 64);
        f32x4 acc[4][4];
#pragma unroll
        for (int i = 0; i < 4; ++i)
#pragma unroll
            for (int j = 0; j < 4; ++j) acc[i][j] = (f32x4){0.f, 0.f, 0.f, 0.f};
        const u16* Ag = A + (size_t)(m0 + srow) * lda + sch * 8;
        const u16* Bg = Bt + (size_t)(n0 + srow) * ldb + sch * 8;
        bf16x8 ra0[4], rb0[4], ra1[4], rb1[4];
#define GEMM_GLOAD(RA, RB, KT_) { const int k0_ = (KT_) * 64; _Pragma("unroll") for (int i = 0; i < 4; ++i) { RA[i] = ld8(Ag + (size_t)(32 * i) * lda + k0_); RB[i] = ld8(Bg + (size_t)(32 * i) * ldb + k0_); } }
#define GEMM_LWRITE(RA, RB, BUF_) { u16* Aw_ = As + (BUF_) * 8192; u16* Bw_ = Bs + (BUF_) * 8192; _Pragma("unroll") for (int i = 0; i < 4; ++i) { const int row = srow + 32 * i; const int off = row * 64 + ((sch ^ (row & 7)) << 3); *(bf16x8*)(Aw_ + off) = RA[i]; *(bf16x8*)(Bw_ + off) = RB[i]; } }
#define GEMM_COMPUTE(BUF_) { const u16* Xb = As + (BUF_) * 8192 + xo; const u16* Yb = As + (BUF_) * 8192 + yo; _Pragma("unroll") for (int s = 0; s < 2; ++s) { bf16x8 a[4], b[4]; const int ch = s * 4 + q4; _Pragma("unroll") for (int i = 0; i < 4; ++i) { const int row = i * 16 + cidx; a[i] = *(const bf16x8*)(Xb + row * 64 + ((ch ^ (row & 7)) << 3)); b[i] = *(const bf16x8*)(Yb + row * 64 + ((ch ^ (row & 7)) << 3)); } _Pragma("unroll") for (int i = 0; i < 4; ++i) _Pragma("unroll") for (int j = 0; j < 4; ++j) acc[i][j] = mfma16(a[i], b[j], acc[i][j]); } }
        GEMM_GLOAD(ra0, rb0, 0);
        if (KT > 1) GEMM_GLOAD(ra1, rb1, 1);
        GEMM_LWRITE(ra0, rb0, 0);
        __syncthreads();
        for (int kt = 0; kt < KT; kt += 2) {
            if (kt + 2 < KT) GEMM_GLOAD(ra0, rb0, kt + 2);
            GEMM_COMPUTE(0);
            GEMM_LWRITE(ra1, rb1, 1);
            __syncthreads();
            if (kt + 3 < KT) GEMM_GLOAD(ra1, rb1, kt + 3);
            GEMM_COMPUTE(1);
            if (kt + 2 < KT) GEMM_LWRITE(ra0, rb0, 0);
            __syncthreads();
        }
#undef GEMM_GLOAD
#undef GEMM_LWRITE
#undef GEMM_COMPUTE
        if (!sw) {
#pragma unroll
            for (int i = 0; i < 4; ++i)
#pragma unroll
                for (int j = 0; j < 4; ++j) epi.rows4(m0 + wm * 64 + i * 16 + q4 * 4, n0 + wn * 64 + j * 16 + cidx, acc[i][j]);
        } else {
#pragma unroll
            for (int i = 0; i < 4; ++i)
#pragma unroll
                for (int j = 0; j < 4; ++j) epi.cols4(m0 + wm * 64 + j * 16 + cidx, n0 + wn * 64 + i * 16 + q4 * 4, acc[i][j]);
        }
        epi.finish(m0, n0, lds);
    }
}

struct EpiInProj {
    u16 *pconv, *prwkv, *q, *kv; float* gate;
    DEV bool swapped(int c0) const { return !((c0 >= 2432 && c0 < 2560) || (c0 >= 2688 && c0 < 2816)); }
    DEV void rows4(int row0, int col, f32x4 v) const {
        const int c = col - 2048; const int idx = c >> 7; const int g = (c >> 6) & 1; const int d = c & 63;
        const int b = row0 >> 13; const int t0 = row0 & 8191; const int bg = b * 2 + g;
        u16* base = kv + (size_t)idx * 4194304;
        const int k = t0 & 31; const int p0 = 8 * ((k & 15) >> 2) + 4 * (k >> 4);
        u32x2 w; w[0] = pack2(v[0], v[1]); w[1] = pack2(v[2], v[3]);
        *(u32x2*)(base + (size_t)(bg * 64 + d) * 8192 + (t0 & ~31) + p0) = w;
    }
    DEV void cols4(int row, int col0, f32x4 v) const {
        if (col0 < 512) {
            u32x2 w; w[0] = pack2(v[0], v[1]); w[1] = pack2(v[2], v[3]);
            *(u32x2*)(pconv + (size_t)row * 512 + col0) = w;
        } else if (col0 < 1536) {
            u32x2 w; w[0] = pack2(v[0], v[1]); w[1] = pack2(v[2], v[3]);
            *(u32x2*)(prwkv + (size_t)row * 1024 + (col0 - 512)) = w;
        } else if (col0 < 2048) {
            const float sc = 0.18033688011112042f;
            u32x2 w; w[0] = pack2(v[0] * sc, v[1] * sc); w[1] = pack2(v[2] * sc, v[3] * sc);
            *(u32x2*)(q + (size_t)row * 512 + (col0 - 1536)) = w;
        } else if (col0 < 2816) {
            const int c = col0 - 2048; const int idx = c >> 7; const int g = (c >> 6) & 1; const int d = c & 63;
            const int b = row >> 13; const int t = row & 8191; const int bg = b * 2 + g;
            u32x2 w; w[0] = pack2(v[0], v[1]); w[1] = pack2(v[2], v[3]);
            *(u32x2*)(kv + (size_t)idx * 4194304 + ((size_t)bg * 8192 + t) * 64 + d) = w;
        } else if (col0 < 2840) {
            *(float4*)(gate + (size_t)row * 24 + (col0 - 2816)) = (float4){sigmoidf_(v[0]), sigmoidf_(v[1]), sigmoidf_(v[2]), sigmoidf_(v[3])};
        }
    }
    DEV void finish(int, int, unsigned char*) const {}
};

struct EpiOutProj {
    const float* xold; float* xnew; const float* g1;
    DEV bool swapped(int) const { return true; }
    DEV void rows4(int, int, f32x4) const {}
    DEV void cols4(int row, int col0, f32x4 v) const {
        const int b = row >> 13; const float4 gg = *(const float4*)(g1 + b * 6144 + col0);
        const size_t o = (size_t)row * 1024 + col0;
        const float4 x = *(const float4*)(xold + o);
        *(float4*)(xnew + o) = (float4){x.x + gg.x * v[0], x.y + gg.y * v[1], x.z + gg.z * v[2], x.w + gg.w * v[3]};
    }
    DEV void finish(int, int, unsigned char*) const {}
};

struct EpiStoreBf16 {
    u16* out; int ld;
    DEV bool swapped(int) const { return true; }
    DEV void rows4(int, int, f32x4) const {}
    DEV void cols4(int row, int col0, f32x4 v) const {
        u32x2 w; w[0] = pack2(v[0], v[1]); w[1] = pack2(v[2], v[3]);
        *(u32x2*)(out + (size_t)row * ld + col0) = w;
    }
    DEV void finish(int, int, unsigned char*) const {}
};

struct EpiCompress {
    const float* cbp;
    const float* w2;
    u16* outp;
    int isv;
    unsigned char* lds;
    DEV bool swapped(int) const { return false; }
    DEV void cols4(int, int, f32x4) const {}
    DEV void rows4(int row0, int col, f32x4 v) const {
        float* hid = (float*)lds;
        const int rl = row0 & 127;
#pragma unroll
        for (int r = 0; r < 4; ++r) hid[(rl + r) * 128 + col] = v[r];
    }
    DEV void finish(int m0, int, unsigned char*) const {
        __syncthreads();
        {
            float* hw = (float*)lds;
            const int t = TID(); const int c = t & 127, r0 = (t >> 7) * 64;
            float bias = 0.f;
#pragma unroll
            for (int s = 0; s < 16; ++s) bias += cbp[s * 128 + c];
#pragma unroll 4
            for (int r = 0; r < 64; ++r) { const float x = hw[(r0 + r) * 128 + c] + bias; hw[(r0 + r) * 128 + c] = x * sigmoidf_(x); }
        }
        __syncthreads();
        const float* hid = (const float*)lds;
        const int tid = TID(); const int d = tid & 63, rgp = tid >> 6;
        float acc[32];
#pragma unroll
        for (int i = 0; i < 32; ++i) acc[i] = 0.f;
#pragma unroll 1
        for (int j0 = 0; j0 < 128; j0 += 8) {
            float wv[8];
#pragma unroll
            for (int jj = 0; jj < 8; ++jj) wv[jj] = w2[(j0 + jj) * 64 + d];
#pragma unroll
            for (int rr = 0; rr < 32; ++rr) {
                const float4 h0 = *(const float4*)(hid + (rgp * 32 + rr) * 128 + j0), h1 = *(const float4*)(hid + (rgp * 32 + rr) * 128 + j0 + 4);
                acc[rr] += h0.x * wv[0] + h0.y * wv[1] + h0.z * wv[2] + h0.w * wv[3] + h1.x * wv[4] + h1.y * wv[5] + h1.z * wv[6] + h1.w * wv[7];
            }
        }
#pragma unroll
        for (int rr = 0; rr < 32; ++rr) {
            const int m = m0 + rgp * 32 + rr; const int bg = m >> 9, n = m & 511;
            const u16 val = (n == 511) ? (u16)0 : f2bf(acc[rr]);
            if (!isv) outp[((size_t)bg * 512 + n) * 64 + d] = val;
            else {
                const int k = n & 31; const int pp = 8 * ((k & 15) >> 2) + (k & 3) + 4 * (k >> 4);
                outp[((size_t)bg * 64 + d) * 512 + (n & ~31) + pp] = val;
            }
        }
        __syncthreads();
    }
};

DEV void transpose_tile(const float* __restrict__ src, int N, u16* __restrict__ dst, int ldk, int kt, int nt, float* tl) {
    const int tid = TID(); const int k0 = kt * 64, n0 = nt * 64;
#pragma unroll 4
    for (int i = 0; i < 16; ++i) {
        const int idx = tid + 256 * i; const int kr = idx >> 6, nc = idx & 63; const int n = n0 + nc;
        tl[kr * 65 + nc] = (n < N) ? src[(size_t)(k0 + kr) * N + n] : 0.f;
    }
    __syncthreads();
#pragma unroll 4
    for (int i = 0; i < 16; ++i) {
        const int idx = tid + 256 * i; const int nr = idx >> 6, kc = idx & 63;
        dst[(size_t)(n0 + nr) * ldk + k0 + kc] = f2bf(tl[kc * 65 + nr]);
    }
    __syncthreads();
}

DEV void convert_straight(const float* __restrict__ src, u16* __restrict__ dst, size_t n) {
    const size_t stride = (size_t)gridDim.x * 256 * 8;
    for (size_t i = ((size_t)BID() * 256 + TID()) * 8; i < n; i += stride) {
        const float4 a = *(const float4*)(src + i); const float4 b = *(const float4*)(src + i + 4);
        u32x4 w; w[0] = pack2(a.x, a.y); w[1] = pack2(a.z, a.w); w[2] = pack2(b.x, b.y); w[3] = pack2(b.z, b.w);
        *(u32x4*)(dst + i) = w;
    }
}

DEV void convert_rows_task(const float* __restrict__ src, unsigned char* __restrict__ dst, float* __restrict__ scale, int* __restrict__ rowsum, int row0) {
    const int lane = TID() & 63, wave = TID() >> 6;
#pragma unroll 1
    for (int it = 0; it < 4; ++it) {
        float4 v[2][4]; float amax[2] = {0.f, 0.f};
#pragma unroll
        for (int u = 0; u < 2; ++u) {
            const int row = row0 + wave * 8 + it * 2 + u;
#pragma unroll
            for (int i = 0; i < 4; ++i) v[u][i] = *(const float4*)(src + (size_t)row * 1024 + 16 * lane + 4 * i);
        }
#pragma unroll
        for (int u = 0; u < 2; ++u) {
#pragma unroll
            for (int i = 0; i < 4; ++i)
                amax[u] = fmaxf(amax[u], fmaxf(fmaxf(fabsf(v[u][i].x), fabsf(v[u][i].y)), fmaxf(fabsf(v[u][i].z), fabsf(v[u][i].w))));
            amax[u] = wave_max(amax[u]);
            const int row = row0 + wave * 8 + it * 2 + u;
            const float sc = amax[u] > 0.f ? amax[u] * (1.f / 127.f) : 1.f;
            const float inv = 1.f / sc;
            u32x4 w;
#pragma unroll
            for (int i = 0; i < 4; ++i) {
                const int a = __float2int_rn(v[u][i].x * inv) + 128, b = __float2int_rn(v[u][i].y * inv) + 128, c = __float2int_rn(v[u][i].z * inv) + 128,
                          d = __float2int_rn(v[u][i].w * inv) + 128;
                w[i] = (unsigned)a | ((unsigned)b << 8) | ((unsigned)c << 16) | ((unsigned)d << 24);
            }
            *(u32x4*)(dst + (size_t)row * 1024 + 16 * lane) = w;
            int bs = 0;
#pragma unroll
            for (int i = 0; i < 4; ++i) bs += (int)(w[i] & 0xffu) + (int)((w[i] >> 8) & 0xffu) + (int)((w[i] >> 16) & 0xffu) + (int)(w[i] >> 24);
            bs = wave_sum_i(bs);
            if (lane == 0) { scale[row] = sc; if (rowsum) rowsum[row] = bs; }
        }
    }
}

DEV void phase_prep(const Params& p, unsigned char* lds) {
    const int tid = TID();
    float* fl = (float*)lds;
    unsigned char* ws = p.ws;
    for (int task = BID(); task < 192; task += gridDim.x) {
        const int l = task / 96, cgp = task % 96;
        float* cs = fl;
        float* red = fl + 4096;
        for (int i = tid; i < 4096; i += 256) { const float c = p.in[I_C][i]; cs[i] = c / (1.f + __expf(-c)); }
        __syncthreads();
        const int col = cgp * 64 + (tid & 63), ks = tid >> 6;
        float a0 = 0, a1 = 0, a2 = 0, a3 = 0;
        const float* w = p.in[I_ADAW] + ((size_t)l * 1024 + ks * 256) * 6144 + col;
#pragma unroll 32
        for (int k = 0; k < 256; ++k) {
            const float wv = w[(size_t)k * 6144]; const int kk = ks * 256 + k;
            a0 += cs[kk] * wv; a1 += cs[1024 + kk] * wv; a2 += cs[2048 + kk] * wv; a3 += cs[3072 + kk] * wv;
        }
        red[(ks * 4 + 0) * 64 + (tid & 63)] = a0; red[(ks * 4 + 1) * 64 + (tid & 63)] = a1;
        red[(ks * 4 + 2) * 64 + (tid & 63)] = a2; red[(ks * 4 + 3) * 64 + (tid & 63)] = a3;
        __syncthreads();
        {
            const int b = tid >> 6, c = tid & 63;
            const float s = red[(0 * 4 + b) * 64 + c] + red[(1 * 4 + b) * 64 + c] + red[(2 * 4 + b) * 64 + c] + red[(3 * 4 + b) * 64 + c];
            const int colg = cgp * 64 + c;
            ((float*)(ws + OFF_MOD))[(l * 4 + b) * 6144 + colg] = s + p.in[I_ADAB][l * 6144 + colg];
        }
        __syncthreads();
    }
    for (int task = BID(); task < 64; task += gridDim.x) {
        const int l = task >> 5, kv = (task >> 4) & 1, s = task & 15;
        const float* pos = p.in[kv ? I_CVPOS : I_CKPOS] + l * 2048;
        const float* w1 = p.in[kv ? I_CVW1 : I_CKW1] + (size_t)l * 2048 * 128;
        const int col = tid & 127, half = tid >> 7;
        float a = 0;
        const int i0 = s * 128 + half * 64;
#pragma unroll 8
        for (int i = 0; i < 64; ++i) a += pos[i0 + i] * w1[(size_t)(i0 + i) * 128 + col];
        fl[tid] = a;
        __syncthreads();
        if (tid < 128) ((float*)(ws + OFF_CBP))[((l * 2 + kv) * 16 + s) * 128 + tid] = fl[tid] + fl[tid + 128];
        __syncthreads();
    }
    {
        for (int task = BID(); task < 2 * 16 * 46; task += gridDim.x) {
            const int l = task / (16 * 46), r = task % (16 * 46);
            transpose_tile(p.in[I_WIN] + (size_t)l * 1024 * NIN, NIN, (u16*)(ws + OFF_WIN) + (size_t)l * NINP * 1024, 1024, r / 46, r % 46, fl);
        }
        for (int task = BID(); task < 2 * 16; task += gridDim.x) {
            const int l = task >> 4, r = task & 15; const int nt = r & 3, part = r >> 2;
            u16* dst = (u16*)(ws + OFF_LW) + (size_t)l * 65536;
            if (part == 0) transpose_tile(p.in[I_WUP] + (size_t)l * 64 * 256, 256, dst, 256, 0, nt, fl);
            else if (part == 1) transpose_tile(p.in[I_AUP] + (size_t)l * 64 * 256, 256, dst + 64, 256, 0, nt, fl);
            else transpose_tile(p.in[I_GUP] + (size_t)l * 128 * 256, 256, dst + 128, 256, part - 2, nt, fl);
        }
        for (int task = BID(); task < 4 * 32 * 2; task += gridDim.x) {
            const int lk = task >> 6, r = task & 63; const int l = lk >> 1, kv = lk & 1;
            transpose_tile(p.in[kv ? I_CVW1 : I_CKW1] + (size_t)l * 2048 * 128, 128, (u16*)(ws + OFF_CW1) + (size_t)lk * 128 * 2048, 2048, r >> 1, r & 1, fl);
        }
    }
    for (int l = 0; l < 2; ++l) {
        convert_straight(p.in[I_PK1] + l * 16384, (u16*)(ws + OFF_K12) + (l * 2 + 0) * 16384, 16384);
        convert_straight(p.in[I_PK2] + l * 16384, (u16*)(ws + OFF_K12) + (l * 2 + 1) * 16384, 16384);
    }
}

DEV void phase_norm(const float* __restrict__ x, const float* __restrict__ g, const float* __restrict__ sh, const float* __restrict__ sc,
                    u16* __restrict__ h) {
    const int lane = TID() & 63;
    const int gw = BID() * 4 + (TID() >> 6), nw = gridDim.x * 4;
    for (int row0 = gw * 2; row0 < NTOK; row0 += nw * 2) {
        float4 v[2][4]; float ss[2] = {0.f, 0.f};
#pragma unroll
        for (int u = 0; u < 2; ++u)
#pragma unroll
            for (int i = 0; i < 4; ++i) v[u][i] = *(const float4*)(x + (size_t)(row0 + u) * 1024 + 256 * i + lane * 4);
#pragma unroll
        for (int u = 0; u < 2; ++u) {
#pragma unroll
            for (int i = 0; i < 4; ++i) ss[u] += v[u][i].x * v[u][i].x + v[u][i].y * v[u][i].y + v[u][i].z * v[u][i].z + v[u][i].w * v[u][i].w;
            ss[u] = wave_sum(ss[u]);
        }
#pragma unroll
        for (int u = 0; u < 2; ++u) {
            const int row = row0 + u; const int b = row >> 13;
            const float rs = rsqrtf(ss[u] * (1.f / 1024.f) + 1e-6f);
#pragma unroll
            for (int i = 0; i < 4; ++i) {
                const int k = 256 * i + lane * 4;
                const float4 gg = *(const float4*)(g + k); const float4 s1 = *(const float4*)(sc + b * 6144 + k); const float4 s0 = *(const float4*)(sh + b * 6144 + k);
                u32x2 w;
                w[0] = pack2(v[u][i].x * rs * gg.x * (1.f + s1.x) + s0.x, v[u][i].y * rs * gg.y * (1.f + s1.y) + s0.y);
                w[1] = pack2(v[u][i].z * rs * gg.z * (1.f + s1.z) + s0.z, v[u][i].w * rs * gg.w * (1.f + s1.w) + s0.w);
                *(u32x2*)(h + (size_t)row * 1024 + k) = w;
            }
        }
    }
}

DEV void conv_tile(const Params& p, int l, int tile, unsigned char* lds) {
    float* ul = (float*)lds;
    const int tid = TID();
    unsigned char* ws = p.ws;
    const u16* pconv = (const u16*)(ws + OFF_PCONV);
    u16* mix = (u16*)(ws + OFF_MIX);
    const int t0g = tile * 32; const int tb = t0g & 8191;
#pragma unroll 8
    for (int rr = 0; rr < 62; ++rr) {
        const int trow = tb - 30 + rr;
        float u = 0.f;
        if (trow >= 0) {
            const size_t o = (size_t)(t0g - 30 + rr) * 512;
            const float val = bf2f(pconv[o + tid]), gt = bf2f(pconv[o + 256 + tid]);
            u = val * sigmoidf_(gt);
        }
        ul[rr * 256 + tid] = u;
    }
    __syncthreads();
    float w[31];
#pragma unroll
    for (int j = 0; j < 31; ++j) w[j] = p.in[I_CDW][(l * 31 + j) * 256 + tid];
    const float bias = p.in[I_CDB][l * 256 + tid], gg = p.in[I_CGG][l * 256 + tid], gb = p.in[I_CGB][l * 256 + tid];
    for (int tt = 0; tt < 32; ++tt) {
        float y = bias;
#pragma unroll
        for (int j = 0; j < 31; ++j) y += ul[(tt + j) * 256 + tid] * w[j];
        const float mean = wave_sum(y) * (1.f / 64.f);
        const float d = y - mean;
        const float var = wave_sum(d * d) * (1.f / 64.f);
        float o = d * rsqrtf(var + 1e-5f) * gg + gb;
        o = o * sigmoidf_(o);
        mix[(size_t)(t0g + tt) * 1024 + tid] = f2bf(o);
    }
}

DEV float softplusf_(float x) { return x > 20.f ? x : log1pf(__expf(x)); }
DEV void rwkv_prep_tile2(const Params& p, int l, int tile, unsigned char* lds) {
    u16* actb = (u16*)lds;
    const int tid = TID(), lane = tid & 63, wave = tid >> 6, q4 = lane >> 4, cidx = lane & 15;
    unsigned char* ws = p.ws;
    const u16* pr = (const u16*)(ws + OFF_PRWKV);
    const float* mu = p.in[I_MU] + l * 1024;
    const int R0 = tile * 16;
    {
        const int col = 768 + tid; const float muc = mu[col];
        u16 raw[17];
        const bool first = ((R0 & 8191) == 0);
        raw[0] = first ? (u16)0 : pr[(size_t)(R0 - 1) * 1024 + col];
#pragma unroll
        for (int tk = 0; tk < 16; ++tk) raw[tk + 1] = pr[(size_t)(R0 + tk) * 1024 + col];
#pragma unroll
        for (int tk = 0; tk < 16; ++tk) {
            const float cur = bf2f(raw[tk + 1]), prev = bf2f(raw[tk]);
            const float x = cur + (prev - cur) * muc;
            float a;
            if (tid < 64) a = tanhf(x); else if (tid < 128) a = x; else a = sigmoidf_(x);
            actb[tk * 264 + tid] = f2bf(a);
        }
    }
    __syncthreads();
    f32x4 accw[4], acca[4], accg[4];
    {
        bf16x8 af[8];
#pragma unroll
        for (int s2 = 0; s2 < 8; ++s2) af[s2] = *(const bf16x8*)(actb + cidx * 264 + 32 * s2 + 8 * q4);
        const u16* LW = (const u16*)(ws + OFF_LW) + (size_t)l * 65536;
        const f32x4 z = (f32x4){0.f, 0.f, 0.f, 0.f};
#pragma unroll
        for (int nt = 0; nt < 4; ++nt) {
            const u16* bp = LW + (size_t)(64 * wave + 16 * nt + cidx) * 256 + 8 * q4;
            accw[nt] = mfma16(af[0], ld8(bp), z); accw[nt] = mfma16(af[1], ld8(bp + 32), accw[nt]);
            acca[nt] = mfma16(af[2], ld8(bp + 64), z); acca[nt] = mfma16(af[3], ld8(bp + 96), acca[nt]);
            accg[nt] = mfma16(af[4], ld8(bp + 128), z); accg[nt] = mfma16(af[5], ld8(bp + 160), accg[nt]);
            accg[nt] = mfma16(af[6], ld8(bp + 192), accg[nt]); accg[nt] = mfma16(af[7], ld8(bp + 224), accg[nt]);
        }
    }
    float* RW = (float*)(ws + OFF_RW);
    u16 *RR = (u16*)(ws + OFF_RR), *RK = (u16*)(ws + OFF_RK), *RV = (u16*)(ws + OFF_RV), *RKK = (u16*)(ws + OFF_RKK), *RKKA = (u16*)(ws + OFF_RKKA),
        *RG = (u16*)(ws + OFF_RG);
    float* BON = (float*)(ws + OFF_BONUS);
    float w0[4], a0[4], kkc[4], kac[4], rkc[4], mur[4], muk[4], muv[4];
#pragma unroll
    for (int nt = 0; nt < 4; ++nt) {
        const int c = 64 * wave + 16 * nt + cidx;
        w0[nt] = p.in[I_W0][l * 256 + c]; a0[nt] = p.in[I_A0][l * 256 + c]; kkc[nt] = p.in[I_KK][l * 256 + c]; kac[nt] = p.in[I_KA][l * 256 + c];
        rkc[nt] = p.in[I_RK][l * 256 + c]; mur[nt] = mu[c]; muk[nt] = mu[256 + c]; muv[nt] = mu[512 + c];
    }
    u16 ld3[5][4][3];
    {
        const int rowb = R0 + 4 * q4; const bool firstrow = ((rowb & 8191) == 0);
#pragma unroll
        for (int rr_ = 0; rr_ < 5; ++rr_)
#pragma unroll
            for (int nt = 0; nt < 4; ++nt) {
                const int c = 64 * wave + 16 * nt + cidx;
                const u16* cr = pr + (size_t)(rowb - 1 + rr_) * 1024;
                const bool z = (rr_ == 0) && firstrow;
                ld3[rr_][nt][0] = z ? (u16)0 : cr[c]; ld3[rr_][nt][1] = z ? (u16)0 : cr[256 + c]; ld3[rr_][nt][2] = z ? (u16)0 : cr[512 + c];
            }
    }
#pragma unroll
    for (int r = 0; r < 4; ++r) {
        const int row = R0 + 4 * q4 + r;
        float rr[4], kf_[4], vf_[4], av[4], kkv[4], keff[4], dec[4];
        float kk2 = 0.f, bn = 0.f;
#pragma unroll
        for (int nt = 0; nt < 4; ++nt) {
            float rv = bf2f(ld3[r + 1][nt][0]), kv = bf2f(ld3[r + 1][nt][1]), vv = bf2f(ld3[r + 1][nt][2]);
            const float rp = bf2f(ld3[r][nt][0]), kp = bf2f(ld3[r][nt][1]), vp = bf2f(ld3[r][nt][2]);
            rv += (rp - rv) * mur[nt]; kv += (kp - kv) * muk[nt]; vv += (vp - vv) * muv[nt];
            const float wl = w0[nt] + accw[nt][r];
            const float wlog = -softplusf_(-wl) - 0.5f;
            dec[nt] = __expf(-__expf(wlog));
            av[nt] = sigmoidf_(a0[nt] + acca[nt][r]);
            kkv[nt] = kv * kkc[nt]; kk2 += kkv[nt] * kkv[nt];
            keff[nt] = kv * (1.f + (av[nt] - 1.f) * kac[nt]);
            bn += rv * keff[nt] * rkc[nt];
            rr[nt] = rv; kf_[nt] = kv; vf_[nt] = vv;
        }
        kk2 = reduce16(kk2); bn = reduce16(bn);
        const float inv = 1.f / fmaxf(sqrtf(kk2), 1e-12f);
#pragma unroll
        for (int nt = 0; nt < 4; ++nt) {
            const int c = 64 * wave + 16 * nt + cidx;
            const size_t o = (size_t)row * 256 + c;
            const float kk = kkv[nt] * inv;
            RW[o] = dec[nt]; RR[o] = f2bf(rr[nt]); RK[o] = f2bf(keff[nt]); RV[o] = f2bf(vf_[nt]); RKK[o] = f2bf(kk); RKKA[o] = f2bf(kk * av[nt]);
            RG[o] = f2bf(accg[nt][r]);
        }
        if (cidx == 0) BON[(size_t)row * 4 + wave] = bn;
    }
}

DEV void rwkv_scan(const Params& p, int sb, unsigned char* lds) {
    unsigned char* ws = p.ws;
    const float* RW = (const float*)(ws + OFF_RW);
    const u16 *RR = (const u16*)(ws + OFF_RR), *RK = (const u16*)(ws + OFF_RK), *RV = (const u16*)(ws + OFF_RV), *RKK = (const u16*)(ws + OFF_RKK),
              *RKKA = (const u16*)(ws + OFF_RKKA);
    float* YR = (float*)(ws + OFF_YRAW);
    const int tid = TID(), lane = tid & 63, wave = tid >> 6;
    const int bh = sb >> 2, rg = sb & 3; const int b = bh >> 2, hh = bh & 3;
    float* L = (float*)lds;
    constexpr int BUFSZ = 5 * 1024 + 256;
    float* Yb = L + 2 * BUFSZ;
    const int row_local = 4 * wave + (lane >> 4); const int kq = (lane & 15) * 4;
    const int lstep = tid >> 4, lk = (tid & 15) * 4;
    const int vstep = tid >> 4, vrow = tid & 15;
    const size_t gbase = (size_t)b * 8192 * 256 + hh * 64;
    float4 lw; u32x2 lr, lkk, lkka, lk_; u16 lv;
    auto issue = [&](int c) {
        const size_t o = gbase + (size_t)(c * 16 + lstep) * 256 + lk;
        lw = *(const float4*)(RW + o);
        lr = *(const u32x2*)(RR + o); lk_ = *(const u32x2*)(RK + o); lkk = *(const u32x2*)(RKK + o); lkka = *(const u32x2*)(RKKA + o);
        lv = RV[gbase + (size_t)(c * 16 + vstep) * 256 + rg * 16 + vrow];
    };
    auto commit = [&](int buf) {
        float* B = L + buf * BUFSZ;
        const int o = lstep * 64 + lk;
        *(float4*)(B + o) = lw;
        *(float4*)(B + 1024 + o) = (float4){bflo(lkka[0]), bfhi(lkka[0]), bflo(lkka[1]), bfhi(lkka[1])};
        *(float4*)(B + 2048 + o) = (float4){bflo(lk_[0]), bfhi(lk_[0]), bflo(lk_[1]), bfhi(lk_[1])};
        *(float4*)(B + 3072 + o) = (float4){bflo(lr[0]), bfhi(lr[0]), bflo(lr[1]), bfhi(lr[1])};
        *(float4*)(B + 4096 + o) = (float4){bflo(lkk[0]), bfhi(lkk[0]), bflo(lkk[1]), bfhi(lkk[1])};
        B[5120 + vstep * 16 + vrow] = bf2f(lv);
    };
    __syncthreads();
    issue(0); commit(0);
    __syncthreads();
    float S0 = 0.f, S1 = 0.f, S2 = 0.f, S3 = 0.f;
    constexpr int NCH = NT / 16;
    for (int c = 0; c < NCH; ++c) {
        const int buf = c & 1;
        if (c + 1 < NCH) issue(c + 1);
        const float* B = L + buf * BUFSZ;
        float* Y = Yb + buf * 256;
        float yv[16];
        float4 w4 = *(const float4*)(B + kq), a4 = *(const float4*)(B + 1024 + kq), k4 = *(const float4*)(B + 2048 + kq),
               r4 = *(const float4*)(B + 3072 + kq), n4 = *(const float4*)(B + 4096 + kq);
        float vv = B[5120 + row_local];
#pragma unroll
        for (int st = 0; st < 16; ++st) {
            float4 w4n, a4n, k4n, r4n, n4n; float vvn;
            if (st < 15) {
                w4n = *(const float4*)(B + (st + 1) * 64 + kq); a4n = *(const float4*)(B + 1024 + (st + 1) * 64 + kq);
                k4n = *(const float4*)(B + 2048 + (st + 1) * 64 + kq); r4n = *(const float4*)(B + 3072 + (st + 1) * 64 + kq);
                n4n = *(const float4*)(B + 4096 + (st + 1) * 64 + kq); vvn = B[5120 + (st + 1) * 16 + row_local];
            }
            const float part = (S0 * n4.x + S1 * n4.y) + (S2 * n4.z + S3 * n4.w);
            const float sa = -reduce16(part);
            const float t0 = S0 * w4.x + vv * k4.x, t1 = S1 * w4.y + vv * k4.y, t2 = S2 * w4.z + vv * k4.z, t3 = S3 * w4.w + vv * k4.w;
            S0 = t0 + sa * a4.x; S1 = t1 + sa * a4.y; S2 = t2 + sa * a4.z; S3 = t3 + sa * a4.w;
            const float yp = (S0 * r4.x + S1 * r4.y) + (S2 * r4.z + S3 * r4.w);
            yv[st] = reduce16(yp);
            if (st < 15) { w4 = w4n; a4 = a4n; k4 = k4n; r4 = r4n; n4 = n4n; vv = vvn; }
        }
        if ((lane & 15) == 0) {
#pragma unroll
            for (int st = 0; st < 16; ++st) Y[st * 16 + row_local] = yv[st];
        }
        if (c + 1 < NCH) commit(buf ^ 1);
        __syncthreads();
        YR[gbase + (size_t)(c * 16 + vstep) * 256 + rg * 16 + vrow] = Y[vstep * 16 + vrow];
    }
}

DEV void phase_rwkv_post(const Params& p, int l) {
    unsigned char* ws = p.ws;
    const float* YR = (const float*)(ws + OFF_YRAW); const float* BON = (const float*)(ws + OFF_BONUS);
    const u16 *RV = (const u16*)(ws + OFF_RV), *RG = (const u16*)(ws + OFF_RG);
    u16* mix = (u16*)(ws + OFF_MIX);
    const int tid = TID();
    const float lg = p.in[I_LNG][l * 256 + tid], lb = p.in[I_LNB][l * 256 + tid];
    for (int row0 = BID() * 4; row0 < NTOK; row0 += gridDim.x * 4) {
        float y[4], bon[4], vv[4], gg[4];
#pragma unroll
        for (int u = 0; u < 4; ++u) {
            const size_t o = (size_t)(row0 + u) * 256 + tid;
            y[u] = YR[o]; bon[u] = BON[(size_t)(row0 + u) * 4 + (tid >> 6)]; vv[u] = bf2f(RV[o]); gg[u] = bf2f(RG[o]);
        }
#pragma unroll
        for (int u = 0; u < 4; ++u) {
            const float mean = wave_sum(y[u]) * (1.f / 64.f);
            const float d = y[u] - mean;
            const float var = wave_sum(d * d) * (1.f / 64.f);
            const float yn = d * rsqrtf(var + 64e-5f) * lg + lb;
            mix[(size_t)(row0 + u) * 1024 + 256 + tid] = f2bf((yn + bon[u] * vv[u]) * gg[u]);
        }
    }
}

DEV void zero_mix_cols(const Params& p, int c0, int ncols) {
    u16* mix = (u16*)(p.ws + OFF_MIX);
    const int per = ncols / 8;
    const size_t total = (size_t)NTOK * per;
    for (size_t i = (size_t)BID() * 256 + TID(); i < total; i += (size_t)gridDim.x * 256) {
        const size_t row = i / per; const int cc = (int)(i % per);
        *(u32x4*)(mix + row * 1024 + c0 + cc * 8) = (u32x4){0u, 0u, 0u, 0u};
    }
}


DEV void qk_tile(const bf16x8 (&kf)[8], bf16x8 q0, bf16x8 q1, float cinit, f32x4 (&st)[4]) {
    const f32x4 c = (f32x4){cinit, cinit, cinit, cinit};
#pragma unroll
    for (int kt = 0; kt < 4; ++kt) {
        st[kt] = mfma16(kf[2 * kt], q0, c);
        st[kt] = mfma16(kf[2 * kt + 1], q1, st[kt]);
    }
}
DEV void softmax_pv_lazy(f32x4 (&st)[4], const bf16x8 (&vf)[8], float& m, float& l, f32x4& L, f32x4 (&O)[4]) {
    float lmax = fmaxf(fmaxf(fmaxf(st[0][0], st[0][1]), fmaxf(st[0][2], st[0][3])), fmaxf(fmaxf(st[1][0], st[1][1]), fmaxf(st[1][2], st[1][3])));
    lmax = fmaxf(lmax, fmaxf(fmaxf(fmaxf(st[2][0], st[2][1]), fmaxf(st[2][2], st[2][3])), fmaxf(fmaxf(st[3][0], st[3][1]), fmaxf(st[3][2], st[3][3]))));
    lmax = colmax(lmax);
    const float dlt = (lmax > 8.f) ? lmax : 0.f;
    if (__any(dlt > 0.f)) {
        const float alpha = ex2(-dlt);
#pragma unroll
        for (int mt = 0; mt < 4; ++mt) { O[mt][0] *= alpha; O[mt][1] *= alpha; O[mt][2] *= alpha; O[mt][3] *= alpha; }
        L[0] *= alpha; L[1] *= alpha; L[2] *= alpha; L[3] *= alpha; l *= alpha; m += dlt;
#pragma unroll
        for (int kt = 0; kt < 4; ++kt) { st[kt][0] -= dlt; st[kt][1] -= dlt; st[kt][2] -= dlt; st[kt][3] -= dlt; }
    }
#pragma unroll
    for (int kt = 0; kt < 4; ++kt)
#pragma unroll
        for (int r = 0; r < 4; ++r) st[kt][r] = ex2(st[kt][r]);
    union { bf16x8 v; unsigned u[4]; } ones;
    ones.u[0] = 0x3f803f80u; ones.u[1] = 0x3f803f80u; ones.u[2] = 0x3f803f80u; ones.u[3] = 0x3f803f80u;
#pragma unroll
    for (int kb = 0; kb < 2; ++kb) {
        union { bf16x8 v; unsigned u[4]; } pb;
        pb.u[0] = pack2(st[2 * kb][0], st[2 * kb][1]); pb.u[1] = pack2(st[2 * kb][2], st[2 * kb][3]);
        pb.u[2] = pack2(st[2 * kb + 1][0], st[2 * kb + 1][1]); pb.u[3] = pack2(st[2 * kb + 1][2], st[2 * kb + 1][3]);
        L = mfma16(ones.v, pb.v, L);
#pragma unroll
        for (int mt = 0; mt < 4; ++mt) O[mt] = mfma16(vf[kb * 4 + mt], pb.v, O[mt]);
    }
}
DEV void softmax_pv_tile(bool MASK, f32x4 (&st)[4], const bf16x8 (&vf)[8], int keybase, int tcol, int lowcol, bool colsel, float& m, float& l, f32x4& L, f32x4 (&O)[4], int q4) {
    float lmax = -1e30f;
    if (MASK) {
        const int hi = colsel ? tcol : -1;
#pragma unroll
        for (int kt = 0; kt < 4; ++kt)
#pragma unroll
            for (int r = 0; r < 4; ++r) {
                const int key = keybase + kt * 16 + 4 * q4 + r;
                const bool valid = (key <= hi) && (key > lowcol);
                const float sv = valid ? st[kt][r] : -1e30f;
                st[kt][r] = sv; lmax = fmaxf(lmax, sv);
            }
    } else {
        const float cs = colsel ? 0.f : -1e30f;
#pragma unroll
        for (int kt = 0; kt < 4; ++kt)
#pragma unroll
            for (int r = 0; r < 4; ++r) { const float sv = st[kt][r] + cs; st[kt][r] = sv; lmax = fmaxf(lmax, sv); }
    }
    lmax = colmax(lmax);
    const float mnew = fmaxf(m, lmax);
    const float alpha = ex2(m - mnew);
    float psum = 0.f;
#pragma unroll
    for (int kt = 0; kt < 4; ++kt)
#pragma unroll
        for (int r = 0; r < 4; ++r) {
            float pv = ex2(st[kt][r] - mnew);
            if (MASK) pv = (st[kt][r] > -1e29f) ? pv : 0.f;
            st[kt][r] = pv; psum += pv;
        }
    l = l * alpha + psum;
    if (__any(mnew > m)) {
#pragma unroll
        for (int mt = 0; mt < 4; ++mt) { O[mt][0] *= alpha; O[mt][1] *= alpha; O[mt][2] *= alpha; O[mt][3] *= alpha; }
        L[0] *= alpha; L[1] *= alpha; L[2] *= alpha; L[3] *= alpha;
    }
    m = mnew;
#pragma unroll
    for (int kb = 0; kb < 2; ++kb) {
        union { bf16x8 v; unsigned u[4]; } pb;
        pb.u[0] = pack2(st[2 * kb][0], st[2 * kb][1]); pb.u[1] = pack2(st[2 * kb][2], st[2 * kb][3]);
        pb.u[2] = pack2(st[2 * kb + 1][0], st[2 * kb + 1][1]); pb.u[3] = pack2(st[2 * kb + 1][2], st[2 * kb + 1][3]);
#pragma unroll
        for (int mt = 0; mt < 4; ++mt) O[mt] = mfma16(vf[kb * 4 + mt], pb.v, O[mt]);
    }
}
DEV unsigned pick4(unsigned a0, unsigned a1, unsigned a2, unsigned a3, int w) { return w == 0 ? a0 : (w == 1 ? a1 : (w == 2 ? a2 : a3)); }
template <int CTRL> DEV unsigned dpp_or(unsigned x) { return x | dppu<CTRL>(x); }
DEV unsigned row_or(unsigned x) { x = dpp_or<0xB1>(x); x = dpp_or<0x4E>(x); x = dpp_or<0x124>(x); x = dpp_or<0x128>(x); return x; }


DEV void nsa_branch_lds(unsigned char* lds, const u16* __restrict__ K0, const u16* __restrict__ VT0, unsigned bu0, unsigned bu1, unsigned bu2,
                        unsigned bu3, unsigned ua0, unsigned ua1, unsigned ua2, unsigned ua3, unsigned ub0, unsigned ub1, unsigned ub2, unsigned ub3,
                        const unsigned* cm, int tokl, const int (&tcol)[2], const int (&lowc)[2], const bf16x8 (&qf)[2][2], float (&m)[2],
                        float (&l)[2], f32x4 (&L)[2], f32x4 (&O)[2][4], int q4, int cidx, int cur, int lowmax) {
    const int tid = TID();
    int w = 0; unsigned bits = bu0;
    auto advance = [&]() -> int {
        while (bits == 0u && w < 3) { ++w; bits = pick4(bu0, bu1, bu2, bu3, w); }
        if (bits == 0u) return -1;
        const int jb = __builtin_ctz(bits); bits &= bits - 1u;
        return w * 32 + jb;
    };
    const int srow0 = tid >> 3, srow1 = srow0 + 32, sch = tid & 7;
    const int so0 = srow0 * 128 + ((sch ^ (srow0 & 7)) << 4), so1 = srow1 * 128 + ((sch ^ (srow1 & 7)) << 4);
    bf16x8 r0[4], r1[4];
#define NSA_GLOAD(R, BLK_) { R[0] = ld8(K0 + ((size_t)(BLK_) * 64 + srow0) * 64 + sch * 8); R[1] = ld8(K0 + ((size_t)(BLK_) * 64 + srow1) * 64 + sch * 8); \
        R[2] = ld8(VT0 + (size_t)srow0 * 8192 + (BLK_) * 64 + sch * 8); R[3] = ld8(VT0 + (size_t)srow1 * 8192 + (BLK_) * 64 + sch * 8); }
#define NSA_LWRITE(R, BUF_) { unsigned char* wb_ = lds + (BUF_) * 16384; *(bf16x8*)(wb_ + so0) = R[0]; *(bf16x8*)(wb_ + so1) = R[1]; \
        *(bf16x8*)(wb_ + 8192 + so0) = R[2]; *(bf16x8*)(wb_ + 8192 + so1) = R[3]; }
    auto compute = [&](int blk, int buf) {
        const int wq = blk >> 5, jb = blk & 31;
        const bool act0 = (pick4(ua0, ua1, ua2, ua3, wq) >> jb) & 1u, act1 = (pick4(ub0, ub1, ub2, ub3, wq) >> jb) & 1u;
        if (act0 || act1) {
            const unsigned char* kb_ = lds + buf * 16384;
            const bool need_mask = (blk == cur) || (blk * 64 <= lowmax);
            const bool cs0 = cm ? (((cm[tokl * 4 + wq] >> jb) & 1u) != 0u) : true;
            const bool cs1 = cm ? (((cm[(4 + tokl) * 4 + wq] >> jb) & 1u) != 0u) : true;
            const bool lazy = !need_mask && !__any((act0 && m[0] < -1e29f) || (act1 && m[1] < -1e29f));
            f32x4 st0[4], st1[4];
            {
                bf16x8 kf[8];
#pragma unroll
                for (int kt = 0; kt < 4; ++kt)
#pragma unroll
                    for (int s2 = 0; s2 < 2; ++s2) {
                        const int row = 16 * kt + cidx, ch = 4 * s2 + q4;
                        kf[2 * kt + s2] = *(const bf16x8*)(kb_ + row * 128 + ((ch ^ (row & 7)) << 4));
                    }
                if (act0) qk_tile(kf, qf[0][0], qf[0][1], lazy ? (cs0 ? -m[0] : -1e30f) : 0.f, st0);
                if (act1) qk_tile(kf, qf[1][0], qf[1][1], lazy ? (cs1 ? -m[1] : -1e30f) : 0.f, st1);
            }
            __builtin_amdgcn_sched_barrier(0);
            bf16x8 vf[8];
#pragma unroll
            for (int kb = 0; kb < 2; ++kb)
#pragma unroll
                for (int mt = 0; mt < 4; ++mt) {
                    const int row = 16 * mt + cidx, ch = 4 * kb + q4;
                    vf[kb * 4 + mt] = *(const bf16x8*)(kb_ + 8192 + row * 128 + ((ch ^ (row & 7)) << 4));
                }
            if (lazy) {
                if (act0) softmax_pv_lazy(st0, vf, m[0], l[0], L[0], O[0]);
                if (act1) softmax_pv_lazy(st1, vf, m[1], l[1], L[1], O[1]);
            } else {
                if (act0) softmax_pv_tile(need_mask, st0, vf, blk * 64, tcol[0], lowc[0], cs0, m[0], l[0], L[0], O[0], q4);
                if (act1) softmax_pv_tile(need_mask, st1, vf, blk * 64, tcol[1], lowc[1], cs1, m[1], l[1], L[1], O[1], q4);
            }
        }
    };
    int b0 = advance();
    if (b0 < 0) return;
    int b1 = advance();
    NSA_GLOAD(r0, b0);
    if (b1 >= 0) NSA_GLOAD(r1, b1);
    NSA_LWRITE(r0, 0);
    __syncthreads();
#pragma unroll 1
    while (b0 >= 0) {
        const int b2 = (b1 >= 0) ? advance() : -1;
        if (b2 >= 0) NSA_GLOAD(r0, b2);
        compute(b0, 0);
        if (b1 >= 0) NSA_LWRITE(r1, 1);
        __syncthreads();
        if (b1 < 0) break;
        const int b3 = (b2 >= 0) ? advance() : -1;
        if (b3 >= 0) NSA_GLOAD(r1, b3);
        compute(b1, 1);
        if (b2 >= 0) NSA_LWRITE(r0, 0);
        __syncthreads();
        b0 = b2; b1 = b3;
    }
#undef NSA_GLOAD
#undef NSA_LWRITE
}

DEV void nsa_block_task(const Params& p, int task, unsigned char* lds) {
    const int wave = TID() >> 6;
    float* wl = (float*)(lds + 32768) + wave * 2112;
    unsigned* bm = (unsigned*)(lds + 32768 + 4 * 8448);
    float* impA = wl; float* impB = wl + 1024; unsigned* selmask = (unsigned*)(wl + 1024 + 1056);
    unsigned char* ws = p.ws;
    const u16* Q = (const u16*)(ws + OFF_Q);
    const u16* KVb = (const u16*)(ws + OFF_KV);
    const u16 *KSEL = KVb + (size_t)2 * 4194304, *VSELT = KVb + (size_t)3 * 4194304, *KWIN = KVb + (size_t)4 * 4194304, *VWINT = KVb + (size_t)5 * 4194304;
    const u16* KC = (const u16*)(ws + OFF_KC); const u16* VCT = (const u16*)(ws + OFF_VCT);
    const float* GATE = (const float*)(ws + OFF_GATE);
    u16* mix = (u16*)(ws + OFF_MIX);
    const int lane = TID() & 63, q4 = lane >> 4, cidx = lane & 15;
    const int bg = task & 7, t0b = (255 - (task >> 3)) * 32, t0 = t0b + 8 * wave; const int b = bg >> 1, g = bg & 1;
    const int tokl = cidx >> 2, hr = cidx & 3; const int head = g * 4 + hr;
    const int cur = t0 >> 6;
    int tcol[2], rowc[2]; bf16x8 qf[2][2];
#pragma unroll
    for (int ti = 0; ti < 2; ++ti) {
        tcol[ti] = t0 + 4 * ti + tokl; rowc[ti] = b * 8192 + tcol[ti];
        qf[ti][0] = ld8(Q + (size_t)rowc[ti] * 512 + head * 64 + 8 * q4); qf[ti][1] = ld8(Q + (size_t)rowc[ti] * 512 + head * 64 + 32 + 8 * q4);
    }
    f32x4 Oc[2][4];
    {
        int cnt_col[2];
#pragma unroll
        for (int ti = 0; ti < 2; ++ti) cnt_col[ti] = tcol[ti] >= 31 ? ((tcol[ti] - 31) >> 4) + 1 : 0;
        const int tmax = t0 + 7; const int cmax = tmax >= 31 ? ((tmax - 31) >> 4) + 1 : 0;
        const int ntile = (cmax + 15) >> 4;
        const u16* kcb = KC + (size_t)bg * 512 * 64;
        float ml[2] = {-1e30f, -1e30f}, ll[2] = {0.f, 0.f};
#pragma unroll 1
        for (int kt = 0; kt < ntile; ++kt) {
            const u16* kp = kcb + (kt * 16 + cidx) * 64 + 8 * q4;
            const bf16x8 k0 = ld8(kp), k1 = ld8(kp + 32);
#pragma unroll
            for (int ti = 0; ti < 2; ++ti) {
                f32x4 st = mfma16(k0, qf[ti][0], (f32x4){0.f, 0.f, 0.f, 0.f});
                st = mfma16(k1, qf[ti][1], st);
                float sv[4]; float tm = -1e30f;
#pragma unroll
                for (int r = 0; r < 4; ++r) { const int n = kt * 16 + 4 * q4 + r; sv[r] = (n < cnt_col[ti]) ? st[r] : -1e30f; tm = fmaxf(tm, sv[r]); }
                const float mn = fmaxf(ml[ti], tm);
                float ps = 0.f;
#pragma unroll
                for (int r = 0; r < 4; ++r) ps += (sv[r] > -1e29f) ? ex2(sv[r] - mn) : 0.f;
                ll[ti] = ll[ti] * ex2(ml[ti] - mn) + ps; ml[ti] = mn;
            }
        }
        float mfin[2], inv[2];
#pragma unroll
        for (int ti = 0; ti < 2; ++ti) {
            mfin[ti] = colmax(ml[ti]);
            const float lsum = colsum(ll[ti] * ex2(ml[ti] - mfin[ti]));
            inv[ti] = (cnt_col[ti] > 0) ? 1.f / lsum : 0.f;
        }
#pragma unroll
        for (int ti = 0; ti < 2; ++ti)
#pragma unroll
            for (int mt = 0; mt < 4; ++mt) Oc[ti][mt] = (f32x4){0.f, 0.f, 0.f, 0.f};
        const int npair = (ntile + 1) >> 1;
#pragma unroll 1
        for (int kp2 = 0; kp2 < npair; ++kp2) {
            const int n0 = kp2 * 32;
            const u16* kp = kcb + (n0 + cidx) * 64 + 8 * q4;
            const bf16x8 ka0 = ld8(kp), ka1 = ld8(kp + 32), kb0 = ld8(kp + 1024), kb1 = ld8(kp + 1024 + 32);
            bf16x8 vf[4];
#pragma unroll
            for (int mt = 0; mt < 4; ++mt) vf[mt] = ld8(VCT + ((size_t)bg * 64 + 16 * mt + cidx) * 512 + n0 + 8 * q4);
#pragma unroll
            for (int ti = 0; ti < 2; ++ti) {
                float pa[4], pb_[4];
                f32x4 st = mfma16(ka0, qf[ti][0], (f32x4){0.f, 0.f, 0.f, 0.f});
                st = mfma16(ka1, qf[ti][1], st);
                f32x4 su = mfma16(kb0, qf[ti][0], (f32x4){0.f, 0.f, 0.f, 0.f});
                su = mfma16(kb1, qf[ti][1], su);
#pragma unroll
                for (int r = 0; r < 4; ++r) {
                    const int n = n0 + 4 * q4 + r;
                    pa[r] = (n < cnt_col[ti]) ? ex2(st[r] - mfin[ti]) * inv[ti] : 0.f;
                    pb_[r] = (n + 16 < cnt_col[ti]) ? ex2(su[r] - mfin[ti]) * inv[ti] : 0.f;
                }
                const float owna = quadsum(pa[0] + pa[1] + pa[2] + pa[3]), tha = quadsum(pa[3]);
                const float ownb = quadsum(pb_[0] + pb_[1] + pb_[2] + pb_[3]), thb = quadsum(pb_[3]);
                if (hr == 0) {
                    const int tk = 4 * ti + tokl;
                    const int sa = (n0 >> 2) + q4, sb2 = ((n0 + 16) >> 2) + q4;
                    impA[tk * 128 + sa] = owna; impB[tk * 132 + sa + 1] = tha;
                    impA[tk * 128 + sb2] = ownb; impB[tk * 132 + sb2 + 1] = thb;
                }
                union { bf16x8 v; unsigned u[4]; } pk;
                pk.u[0] = pack2(pa[0], pa[1]); pk.u[1] = pack2(pa[2], pa[3]); pk.u[2] = pack2(pb_[0], pb_[1]); pk.u[3] = pack2(pb_[2], pb_[3]);
#pragma unroll
                for (int mt = 0; mt < 4; ++mt) Oc[ti][mt] = mfma16(vf[mt], pk.v, Oc[ti][mt]);
            }
        }
#pragma unroll
        for (int ti = 0; ti < 2; ++ti) {
            const float gc = GATE[(size_t)rowc[ti] * 24 + head];
#pragma unroll
            for (int mt = 0; mt < 4; ++mt)
#pragma unroll
                for (int r = 0; r < 4; ++r) Oc[ti][mt][r] *= gc;
        }
    }
    lds_fence();
#pragma unroll 1
    for (int rd = 0; rd < 2; ++rd) {
        const int tk = 4 * rd + q4;
        unsigned m0 = 0u, m1 = 0u, m2 = 0u, m3 = 0u;
        if (cur < 16) { m0 = (2u << cur) - 1u; }
        else {
            unsigned key[8];
#pragma unroll
            for (int i = 0; i < 8; ++i) {
                const int sblk = cidx + 16 * i;
                const bool cand = (sblk >= 1) && (sblk <= cur - 2);
                const float v = impA[tk * 128 + sblk] + impB[tk * 132 + sblk];
                key[i] = cand ? ((__float_as_uint(v) & ~0x7Fu) | (unsigned)(127 - sblk)) : 0u;
            }
            int mysel = (cidx == 0) ? 0 : (cidx == 1 ? cur - 1 : (cidx == 2 ? cur : -1));
#pragma unroll 1
            for (int it = 0; it < 13; ++it) {
                unsigned mx = key[0];
#pragma unroll
                for (int i = 1; i < 8; ++i) mx = max(mx, key[i]);
                mx = max(mx, dppu<0xB1>(mx)); mx = max(mx, dppu<0x4E>(mx)); mx = max(mx, dppu<0x124>(mx)); mx = max(mx, dppu<0x128>(mx));
                const int sblk = 127 - (int)(mx & 127u);
#pragma unroll
                for (int i = 0; i < 8; ++i) key[i] = (key[i] == mx) ? 0u : key[i];
                if (cidx == it + 3) mysel = sblk;
            }
            const unsigned bit = 1u << (mysel & 31); const int wsel = mysel >> 5;
            m0 = row_or(wsel == 0 ? bit : 0u); m1 = row_or(wsel == 1 ? bit : 0u); m2 = row_or(wsel == 2 ? bit : 0u); m3 = row_or(wsel == 3 ? bit : 0u);
        }
        if (cidx < 4) selmask[tk * 4 + cidx] = (cidx == 0) ? m0 : (cidx == 1 ? m1 : (cidx == 2 ? m2 : m3));
    }
    lds_fence();
    f32x4* accl = (f32x4*)wl;
#pragma unroll
    for (int ti = 0; ti < 2; ++ti)
#pragma unroll
        for (int mt = 0; mt < 4; ++mt) accl[(ti * 4 + mt) * 64 + lane] = Oc[ti][mt];
    {
        float m[2] = {-1e30f, -1e30f}, l[2] = {0.f, 0.f}; f32x4 Os[2][4]; f32x4 Ls[2] = {(f32x4){0.f, 0.f, 0.f, 0.f}, (f32x4){0.f, 0.f, 0.f, 0.f}};
#pragma unroll
        for (int ti = 0; ti < 2; ++ti)
#pragma unroll
            for (int mt = 0; mt < 4; ++mt) Os[ti][mt] = (f32x4){0.f, 0.f, 0.f, 0.f};
        {
            unsigned ua[4], ub[4], bu[4];
#pragma unroll
            for (int w = 0; w < 4; ++w) {
                ua[w] = __builtin_amdgcn_readfirstlane(row_or(selmask[tokl * 4 + w]));
                ub[w] = __builtin_amdgcn_readfirstlane(row_or(selmask[(4 + tokl) * 4 + w]));
            }
            if (lane < 4) bm[wave * 4 + lane] = (lane == 0) ? (ua[0] | ub[0]) : (lane == 1 ? (ua[1] | ub[1]) : (lane == 2 ? (ua[2] | ub[2]) : (ua[3] | ub[3])));
            __syncthreads();
#pragma unroll
            for (int w = 0; w < 4; ++w) bu[w] = __builtin_amdgcn_readfirstlane(bm[w] | bm[4 + w] | bm[8 + w] | bm[12 + w]);
            const int lowc[2] = {-1, -1};
            nsa_branch_lds(lds, KSEL + (size_t)bg * 8192 * 64, VSELT + (size_t)bg * 64 * 8192, bu[0], bu[1], bu[2], bu[3], ua[0], ua[1], ua[2], ua[3], ub[0],
                           ub[1], ub[2], ub[3], selmask, tokl, tcol, lowc, qf, m, l, Ls, Os, q4, cidx, cur, -1);
        }
#pragma unroll
        for (int ti = 0; ti < 2; ++ti) {
            const float sc = GATE[(size_t)rowc[ti] * 24 + 8 + head] / (colsum(l[ti]) + Ls[ti][0]);
#pragma unroll
            for (int mt = 0; mt < 4; ++mt)
#pragma unroll
                for (int r = 0; r < 4; ++r) Os[ti][mt][r] *= sc;
        }
        lds_fence();
#pragma unroll
        for (int ti = 0; ti < 2; ++ti)
#pragma unroll
            for (int mt = 0; mt < 4; ++mt) { f32x4 a = accl[(ti * 4 + mt) * 64 + lane]; a += Os[ti][mt]; accl[(ti * 4 + mt) * 64 + lane] = a; }
    }
    {
        float m[2] = {-1e30f, -1e30f}, l[2] = {0.f, 0.f}; f32x4 Ow[2][4]; f32x4 Ls[2] = {(f32x4){0.f, 0.f, 0.f, 0.f}, (f32x4){0.f, 0.f, 0.f, 0.f}};
#pragma unroll
        for (int ti = 0; ti < 2; ++ti)
#pragma unroll
            for (int mt = 0; mt < 4; ++mt) Ow[ti][mt] = (f32x4){0.f, 0.f, 0.f, 0.f};
        int wb0 = (t0 - 511) >> 6; if (wb0 < 0) wb0 = 0;
        int wbb = (t0b - 511) >> 6; if (wbb < 0) wbb = 0;
        {
            unsigned uw[4], bu[4];
#pragma unroll
            for (int w = 0; w < 4; ++w) {
                const int hi = cur - 32 * w;
                unsigned mk = 0u, mkb = 0u;
                if (hi >= 0) {
                    const unsigned upper = (hi >= 31) ? 0xffffffffu : ((2u << hi) - 1u);
                    const int lo = wb0 - 32 * w, lob = wbb - 32 * w;
                    if (lo <= 31) mk = upper & ~((lo <= 0) ? 0u : ((1u << lo) - 1u));
                    if (lob <= 31) mkb = upper & ~((lob <= 0) ? 0u : ((1u << lob) - 1u));
                }
                uw[w] = mk; bu[w] = mkb;
            }
            const int lowc[2] = {tcol[0] - 512, tcol[1] - 512};
            nsa_branch_lds(lds, KWIN + (size_t)bg * 8192 * 64, VWINT + (size_t)bg * 64 * 8192, bu[0], bu[1], bu[2], bu[3], uw[0], uw[1], uw[2], uw[3], uw[0],
                           uw[1], uw[2], uw[3], nullptr, tokl, tcol, lowc, qf, m, l, Ls, Ow, q4, cidx, cur, t0 + 7 - 512);
        }
#pragma unroll
        for (int ti = 0; ti < 2; ++ti) {
            const float sc = GATE[(size_t)rowc[ti] * 24 + 16 + head] / (colsum(l[ti]) + Ls[ti][0]);
#pragma unroll
            for (int mt = 0; mt < 4; ++mt)
#pragma unroll
                for (int r = 0; r < 4; ++r) Ow[ti][mt][r] *= sc;
        }
        lds_fence();
#pragma unroll
        for (int ti = 0; ti < 2; ++ti)
#pragma unroll
            for (int mt = 0; mt < 4; ++mt) {
                const f32x4 a = accl[(ti * 4 + mt) * 64 + lane];
                const f32x4 o = Ow[ti][mt];
                u32x2 wv; wv[0] = pack2(a[0] + o[0], a[1] + o[1]); wv[1] = pack2(a[2] + o[2], a[3] + o[3]);
                *(u32x2*)(mix + (size_t)rowc[ti] * 1024 + 512 + head * 64 + 16 * mt + 4 * q4) = wv;
            }
    }


    __syncthreads();
}

template <int N> DEV void ltmask(const float (&v)[N], float x, unsigned (&mk)[N / 32]) {
#pragma unroll
    for (int w = 0; w < N / 32; ++w) {
        unsigned a0 = 0u, a1 = 0u, a2 = 0u, a3 = 0u;
#pragma unroll
        for (int i = 0; i < 8; ++i) {
            a0 = __builtin_amdgcn_alignbit(a0, __float_as_uint(v[w * 32 + i] - x), 31);
            a1 = __builtin_amdgcn_alignbit(a1, __float_as_uint(v[w * 32 + 8 + i] - x), 31);
            a2 = __builtin_amdgcn_alignbit(a2, __float_as_uint(v[w * 32 + 16 + i] - x), 31);
            a3 = __builtin_amdgcn_alignbit(a3, __float_as_uint(v[w * 32 + 24 + i] - x), 31);
        }
        mk[w] = (a0 << 24) | (a1 << 16) | (a2 << 8) | a3;
    }
}
template <int N> DEV int count_ge(const float (&v)[N], float x) {
    unsigned mk[N / 32]; ltmask<N>(v, x, mk);
    int lt = 0;
#pragma unroll
    for (int w = 0; w < N / 32; ++w) lt += __popc(mk[w]);
    return colsumi(N - lt);
}
template <int N> DEV void refine16(const float (&v)[N], float lo, int clo, float hi, int chi, float& lo_o, float& hi_o) {
    bool done = false;
    if (clo == 16) { hi = lo; done = true; }
#pragma unroll 1
    for (int it = 0; it < 200; ++it) {
        if (__all(done)) break;
        float f = 0.5f;
        if (!(it & 1)) { f = ((float)clo - 15.5f) / (float)(clo - chi); f = fminf(fmaxf(f, 0.04f), 0.96f); }
        const float mid = lo + (hi - lo) * f;
        const bool stuck = !(mid > lo && mid < hi);
        const int c = count_ge<N>(v, mid);
        if (!done) {
            if (stuck) { if (f != 0.5f) {   } else done = true; }
            else if (c == 16) { lo = mid; hi = mid; done = true; }
            else if (c > 16) { lo = mid; clo = c; }
            else { hi = mid; chi = c; }
        }
    }
    lo_o = lo; hi_o = hi;
}
template <int N> DEV void select16(const float (&v)[N], float& lo_o, float& hi_o) {
    float mx = v[0], sm = v[0];
#pragma unroll
    for (int i = 1; i < N; ++i) { mx = fmaxf(mx, v[i]); sm += v[i]; }
    mx = colmax(mx); sm = colsum(sm);
    const float hi = mx + fabsf(mx) * 1e-6f + 1e-30f;
    float lo = sm * (1.f / (4.f * N));
    int clo = count_ge<N>(v, lo);
    if (__any(clo < 16)) {
        float mn = v[0];
#pragma unroll
        for (int i = 1; i < N; ++i) mn = fminf(mn, v[i]);
        mn = -colmax(-mn);
        if (clo < 16) { lo = mn; clo = 4 * N; }
    }
    refine16<N>(v, lo, clo, hi, 0, lo_o, hi_o);
}
DEV void col_offsets(int cntA, int cntT, int q4, int cidx, int& offA, int& offT) {
    const int g0 = __shfl(cntA, cidx), g1 = __shfl(cntA, cidx + 16), g2 = __shfl(cntA, cidx + 32), g3 = __shfl(cntA, cidx + 48);
    const int e0 = __shfl(cntT, cidx), e1 = __shfl(cntT, cidx + 16), e2 = __shfl(cntT, cidx + 32);
    offA = (q4 > 0 ? g0 : 0) + (q4 > 1 ? g1 : 0) + (q4 > 2 ? g2 : 0);
    offT = g0 + g1 + g2 + g3 + (q4 > 0 ? e0 : 0) + (q4 > 1 ? e1 : 0) + (q4 > 2 ? e2 : 0);
}

DEV void peer_topk_task2(const Params& p, int l, int task, float* wl) {
    unsigned char* ws = p.ws;
    const u16* QP = (const u16*)(ws + OFF_QP);
    const u16* K12 = (const u16*)(ws + OFF_K12) + (size_t)l * 2 * 16384;
    const int lane = TID() & 63, q4 = lane >> 4, cidx = lane & 15;
    const int tq = task * 2 + (cidx >> 3), hh = cidx & 7;
    float* scl = wl;
    float* lst = wl + 2048;
    float* vv[2] = {lst, lst + 512}; int* ii[2] = {(int*)(lst + 256), (int*)(lst + 768)};
    float* fs = lst + 1024; int* fi = (int*)(lst + 1280);
#pragma unroll 1
    for (int hf = 0; hf < 2; ++hf) {
        bf16x8 qf[4];
#pragma unroll
        for (int s2 = 0; s2 < 4; ++s2) qf[s2] = ld8(QP + (size_t)tq * 2048 + hh * 256 + hf * 128 + 32 * s2 + 8 * q4);
        float sc[32];
        const u16* kb = K12 + hf * 16384;
#pragma unroll
        for (int kt = 0; kt < 8; ++kt) {
            f32x4 st = (f32x4){0.f, 0.f, 0.f, 0.f};
#pragma unroll
            for (int s2 = 0; s2 < 4; ++s2) st = mfma16(ld8(kb + (kt * 16 + cidx) * 128 + 32 * s2 + 8 * q4), qf[s2], st);
#pragma unroll
            for (int r = 0; r < 4; ++r) sc[kt * 4 + r] = st[r];
            *(f32x4*)(scl + cidx * 128 + 16 * kt + 4 * q4) = st;
        }
        float lo, hi; select16<32>(sc, lo, hi);
        unsigned mh[1], ml_[1];
        ltmask<32>(sc, hi, mh);
        if (__all(lo == hi)) ml_[0] = mh[0]; else ltmask<32>(sc, lo, ml_);
        unsigned mA = ~mh[0], mT = ~ml_[0] & mh[0];
        int offA, offT; col_offsets(__popc(mA), __popc(mT), q4, cidx, offA, offT);
        float* vo = hf ? vv[1] : vv[0]; int* io = hf ? ii[1] : ii[0];
        while (__any(mA != 0u)) {
            if (mA) {
                const int i = __clz(mA); mA &= ~(0x80000000u >> i);
                io[cidx * 16 + offA] = 16 * (i >> 2) + 4 * q4 + (i & 3); ++offA;
            }
        }
        while (__any(mT != 0u)) {
            if (mT) {
                const int i = __clz(mT); mT &= ~(0x80000000u >> i);
                if (offT < 16) io[cidx * 16 + offT] = 16 * (i >> 2) + 4 * q4 + (i & 3);
                ++offT;
            }
        }
        lds_fence();
        {
            const int4 n4 = *(const int4*)(io + cidx * 16 + 4 * q4);
            float4 v4; v4.x = scl[cidx * 128 + n4.x]; v4.y = scl[cidx * 128 + n4.y]; v4.z = scl[cidx * 128 + n4.z]; v4.w = scl[cidx * 128 + n4.w];
            *(float4*)(vo + cidx * 16 + 4 * q4) = v4;
        }
        lds_fence();
    }
    {
        float cand[64];
        float v2r[16];
#pragma unroll
        for (int j = 0; j < 16; ++j) v2r[j] = vv[1][cidx * 16 + j];
#pragma unroll
        for (int a = 0; a < 4; ++a) {
            const float v1a = vv[0][cidx * 16 + 4 * q4 + a];
#pragma unroll
            for (int j = 0; j < 16; ++j) cand[a * 16 + j] = v1a + v2r[j];
        }
        float lo, hi;
        {
            float v2mx = v2r[0], v2mn = v2r[0];
#pragma unroll
            for (int j = 1; j < 16; ++j) { v2mx = fmaxf(v2mx, v2r[j]); v2mn = fminf(v2mn, v2r[j]); }
            float v1mx = fmaxf(fmaxf(vv[0][cidx * 16 + 4 * q4], vv[0][cidx * 16 + 4 * q4 + 1]), fmaxf(vv[0][cidx * 16 + 4 * q4 + 2], vv[0][cidx * 16 + 4 * q4 + 3]));
            float v1mn = fminf(fminf(vv[0][cidx * 16 + 4 * q4], vv[0][cidx * 16 + 4 * q4 + 1]), fminf(vv[0][cidx * 16 + 4 * q4 + 2], vv[0][cidx * 16 + 4 * q4 + 3]));
            v1mx = colmax(v1mx); v1mn = -colmax(-v1mn);
            const float smax = v1mx + v2mx;
            const float hi0 = smax + fabsf(smax) * 1e-6f + 1e-30f;
            const float lo0 = fmaxf(v1mn + v2mx, v1mx + v2mn);
            const int c0 = count_ge<64>(cand, lo0);
            refine16<64>(cand, lo0, c0, hi0, 0, lo, hi);
        }
        unsigned mh[2], ml_[2];
        ltmask<64>(cand, hi, mh);
        if (__all(lo == hi)) { ml_[0] = mh[0]; ml_[1] = mh[1]; } else ltmask<64>(cand, lo, ml_);
        unsigned mA0 = ~mh[0], mA1 = ~mh[1], mT0 = ~ml_[0] & mh[0], mT1 = ~ml_[1] & mh[1];
        int offA, offT; col_offsets(__popc(mA0) + __popc(mA1), __popc(mT0) + __popc(mT1), q4, cidx, offA, offT);
#pragma unroll
        for (int w = 0; w < 2; ++w) {
            unsigned mA = w ? mA1 : mA0;
            while (__any(mA != 0u)) {
                if (mA) {
                    const int i = __clz(mA); mA &= ~(0x80000000u >> i);
                    const int it = w * 32 + i; const int ci = (4 * q4 + (it >> 4)) * 16 + (it & 15);
                    fi[cidx * 16 + offA] = ci; ++offA;
                }
            }
        }
#pragma unroll
        for (int w = 0; w < 2; ++w) {
            unsigned mT = w ? mT1 : mT0;
            while (__any(mT != 0u)) {
                if (mT) {
                    const int i = __clz(mT); mT &= ~(0x80000000u >> i);
                    const int it = w * 32 + i; const int ci = (4 * q4 + (it >> 4)) * 16 + (it & 15);
                    if (offT < 16) fi[cidx * 16 + offT] = ci;
                    ++offT;
                }
            }
        }
    }
    lds_fence();
    {
        float s4[4]; int c4[4];
#pragma unroll
        for (int k = 0; k < 4; ++k) { c4[k] = fi[cidx * 16 + 4 * q4 + k]; s4[k] = vv[0][cidx * 16 + (c4[k] >> 4)] + vv[1][cidx * 16 + (c4[k] & 15)]; }
        float mx = fmaxf(fmaxf(s4[0], s4[1]), fmaxf(s4[2], s4[3]));
        mx = colmax(mx);
        float e4[4]; float sm = 0.f;
#pragma unroll
        for (int k = 0; k < 4; ++k) { e4[k] = __expf(s4[k] - mx); sm += e4[k]; }
        sm = colsum(sm);
        const float inv = 1.f / sm;
        int4 eo; float4 go;
        eo.x = ii[0][cidx * 16 + (c4[0] >> 4)] * 128 + ii[1][cidx * 16 + (c4[0] & 15)];
        eo.y = ii[0][cidx * 16 + (c4[1] >> 4)] * 128 + ii[1][cidx * 16 + (c4[1] & 15)];
        eo.z = ii[0][cidx * 16 + (c4[2] >> 4)] * 128 + ii[1][cidx * 16 + (c4[2] & 15)];
        eo.w = ii[0][cidx * 16 + (c4[3] >> 4)] * 128 + ii[1][cidx * 16 + (c4[3] & 15)];
        go.x = e4[0] * inv; go.y = e4[1] * inv; go.z = e4[2] * inv; go.w = e4[3] * inv;
        int* eol = (int*)(wl + 3584); float* gol = wl + 3584 + 256;
        *(int4*)(eol + cidx * 16 + 4 * q4) = eo; *(float4*)(gol + cidx * 16 + 4 * q4) = go;
    }
    lds_fence();
}

DEV float gelu_exact(float x) { return 0.5f * x * (1.f + erff(x * 0.70710678118654752f)); }
DEV void unpack8(const bf16x8 v, float* f) {
    union { bf16x8 v; unsigned u[4]; } c; c.v = v;
#pragma unroll
    for (int i = 0; i < 4; ++i) { f[2 * i] = bflo(c.u[i]); f[2 * i + 1] = bfhi(c.u[i]); }
}
DEV void peer_experts_token(const Params& p, int l, int tok, const int* el_src, const float* w_src) {
    unsigned char* ws = p.ws;
    const u16* H = (const u16*)(ws + OFF_H);
    u16* Hw = (u16*)(ws + OFF_H);
    const unsigned char* U8 = ws + OFF_U8;
    const unsigned char* V8 = ws + OFF_U8 + 16 * MiB;
    const float* SU = (const float*)(ws + OFF_UVS);
    const float* SV = (const float*)(ws + OFF_UVS) + 16384;
    const float* mod = (const float*)(ws + OFF_MOD);
    const float* g2 = mod + l * 4 * 6144 + 5 * 1024;
    const int lane = TID() & 63;
    {
        const int b = tok >> 13;
        float acc[16];
#pragma unroll
        for (int i = 0; i < 16; ++i) acc[i] = 0.f;
#if EN_PEER
        unsigned hp[4]; float shq; int corr0;
        {
            float hx[16];
            unpack8(ld8(H + (size_t)tok * 1024 + 16 * lane), hx);
            unpack8(ld8(H + (size_t)tok * 1024 + 16 * lane + 8), hx + 8);
            float amax = 0.f;
#pragma unroll
            for (int i = 0; i < 16; ++i) amax = fmaxf(amax, fabsf(hx[i]));
            amax = wave_max(amax);
            shq = amax > 0.f ? amax * (1.f / 127.f) : 1.f;
            const float inv = 1.f / shq;
            int hsum = 0;
#pragma unroll
            for (int i = 0; i < 4; ++i) {
                const int a = __float2int_rn(hx[4 * i] * inv) + 128, b2 = __float2int_rn(hx[4 * i + 1] * inv) + 128, c = __float2int_rn(hx[4 * i + 2] * inv) + 128,
                          d = __float2int_rn(hx[4 * i + 3] * inv) + 128;
                hp[i] = (unsigned)a | ((unsigned)b2 << 8) | ((unsigned)c << 16) | ((unsigned)d << 24);
                hsum += a + b2 + c + d;
            }
            hsum = wave_sum_i(hsum);
            corr0 = 128 * 128 * 1024 - 128 * hsum;
        }
        const int* RSU = (const int*)(ws + OFF_UVS) + 2 * 16384;
        float corr = 0.f;
        u32x4 uqA[8], vqA[8], uqB[8], vqB[8];
#define PEER_LOAD(UQ, VQ, G_) { const int el_ = el_src[((G_) >> 1) * 16 + (lane & 15)]; const int k0_ = ((G_) & 1) * 8; _Pragma("unroll") for (int k = 0; k < 8; ++k) { \
            const int e = __builtin_amdgcn_readlane(el_, k0_ + k); UQ[k] = *(const u32x4*)(U8 + (size_t)e * 1024 + 16 * lane); VQ[k] = *(const u32x4*)(V8 + (size_t)e * 1024 + 16 * lane); } }
#define PEER_EVAL(UQ, VQ, G_) { const int hh_ = (G_) >> 1, k0_ = ((G_) & 1) * 8; const int el = el_src[hh_ * 16 + (lane & 15)]; const float wgt = w_src[hh_ * 16 + (lane & 15)]; \
            const float sul = SU[el] * shq, wsl = wgt * SV[el]; const int rsl = corr0 - 128 * RSU[el]; \
            int dpart[8]; _Pragma("unroll") for (int k = 0; k < 8; ++k) { unsigned di = 0u; _Pragma("unroll") for (int i = 0; i < 4; ++i) di = __builtin_amdgcn_udot4(UQ[k][i], hp[i], di, false); dpart[k] = (int)di; } \
            const int dsum = reduce8_i(dpart); const int srcl = k0_ + (lane >> 3); \
            const float sul_e = __shfl(sul, srcl), wsl_e = __shfl(wsl, srcl); const int rsl_e = __shfl(rsl, srcl); \
            const float actl = gelu_exact((float)(dsum + rsl_e) * sul_e) * wsl_e; \
            _Pragma("unroll") for (int k = 0; k < 8; ++k) { const float act = __int_as_float(__builtin_amdgcn_readlane(__float_as_int(actl), 8 * k)); corr += act * 128.f; \
                _Pragma("unroll") for (int i = 0; i < 4; ++i) { const unsigned w = VQ[k][i]; \
                    acc[4 * i] += act * (float)(w & 0xffu); acc[4 * i + 1] += act * (float)((w >> 8) & 0xffu); acc[4 * i + 2] += act * (float)((w >> 16) & 0xffu); acc[4 * i + 3] += act * (float)(w >> 24); } } }
        PEER_LOAD(uqA, vqA, 0);
#pragma unroll 1
        for (int g = 0; g < 16; g += 2) {
            PEER_LOAD(uqB, vqB, g + 1);
            PEER_EVAL(uqA, vqA, g);
            if (g + 2 < 16) PEER_LOAD(uqA, vqA, g + 2);
            PEER_EVAL(uqB, vqB, g + 1);
        }
#undef PEER_LOAD
#undef PEER_EVAL
#pragma unroll
        for (int i = 0; i < 16; ++i) acc[i] -= corr;
#endif
        const int k = 16 * lane;
        float xn[16]; float ss = 0.f;
#pragma unroll
        for (int i = 0; i < 4; ++i) {
            const float4 x0 = *(const float4*)(p.out + (size_t)tok * 1024 + k + 4 * i);
            const float4 ga = *(const float4*)(g2 + b * 6144 + k + 4 * i);
            xn[4 * i] = x0.x + ga.x * acc[4 * i]; xn[4 * i + 1] = x0.y + ga.y * acc[4 * i + 1];
            xn[4 * i + 2] = x0.z + ga.z * acc[4 * i + 2]; xn[4 * i + 3] = x0.w + ga.w * acc[4 * i + 3];
        }
#pragma unroll
        for (int i = 0; i < 16; ++i) ss += xn[i] * xn[i];
        ss = wave_sum(ss);
        const float rs = rsqrtf(ss * (1.f / 1024.f) + 1e-6f);
        if (l == 0) {
            const float* n1g = p.in[I_N1G] + 1024; const float* sh = mod + 4 * 6144 + b * 6144; const float* sc = sh + 1024;
            float hv[16];
#pragma unroll
            for (int i = 0; i < 4; ++i) {
                *(float4*)(p.out + (size_t)tok * 1024 + k + 4 * i) = (float4){xn[4 * i], xn[4 * i + 1], xn[4 * i + 2], xn[4 * i + 3]};
                const float4 gg = *(const float4*)(n1g + k + 4 * i), s1 = *(const float4*)(sc + k + 4 * i), s0 = *(const float4*)(sh + k + 4 * i);
                hv[4 * i] = xn[4 * i] * rs * gg.x * (1.f + s1.x) + s0.x; hv[4 * i + 1] = xn[4 * i + 1] * rs * gg.y * (1.f + s1.y) + s0.y;
                hv[4 * i + 2] = xn[4 * i + 2] * rs * gg.z * (1.f + s1.z) + s0.z; hv[4 * i + 3] = xn[4 * i + 3] * rs * gg.w * (1.f + s1.w) + s0.w;
            }
            u32x4 w0, w1;
#pragma unroll
            for (int i = 0; i < 4; ++i) { w0[i] = pack2(hv[2 * i], hv[2 * i + 1]); w1[i] = pack2(hv[8 + 2 * i], hv[8 + 2 * i + 1]); }
            *(u32x4*)(Hw + (size_t)tok * 1024 + k) = w0; *(u32x4*)(Hw + (size_t)tok * 1024 + k + 8) = w1;
        } else {
            const float* fg = p.in[I_FG];
#pragma unroll
            for (int i = 0; i < 4; ++i) {
                const float4 gg = *(const float4*)(fg + k + 4 * i);
                *(float4*)(p.out + (size_t)tok * 1024 + k + 4 * i) = (float4){xn[4 * i] * rs * gg.x, xn[4 * i + 1] * rs * gg.y, xn[4 * i + 2] * rs * gg.z, xn[4 * i + 3] * rs * gg.w};
            }
        }
    }
}

constexpr int NPH = 20;

__global__ void __launch_bounds__(256, 2) mega(Params p) {
    __shared__ __attribute__((aligned(16))) unsigned char lds[81920 - 128];
    __shared__ int misc[8];
    int* qslot = misc;
    cg::grid_group grid = cg::this_grid();
    if (threadIdx.x < 8) misc[threadIdx.x] = 0;
    __syncthreads();
    XcdBarrier xbar = xcd_barrier_post((unsigned*)(p.ws + OFF_BAR), (volatile unsigned*)(misc + 4));
    unsigned char* ws = p.ws;
    const float* mod = (const float*)(ws + OFF_MOD);
    unsigned* ctl = (unsigned*)(ws + OFF_CTL);
    const int G = gridDim.x, bx = BID();
    for (int ph = p.ph_lo; ph < p.ph_hi; ++ph) {
        if (ph >= 2 && (ph - 2) % 9 == 8) continue;
        if (ph == 0) {
            phase_prep(p, lds);
        } else if (ph == 1) {
            phase_norm(p.in[I_X], p.in[I_N1G], mod + 0 * 1024, mod + 1 * 1024, (u16*)(ws + OFF_H));
        } else {
            const int l = (ph - 2) / 9, sp = (ph - 2) % 9;
            const float* modl = mod + l * 4 * 6144;
            if (sp == 0) {
                EpiInProj e{(u16*)(ws + OFF_PCONV), (u16*)(ws + OFF_PRWKV), (u16*)(ws + OFF_Q), (u16*)(ws + OFF_KV), (float*)(ws + OFF_GATE)};
                gemm_phase((const u16*)(ws + OFF_H), 1024, (const u16*)(ws + OFF_WIN) + (size_t)l * NINP * 1024, 1024, 256, 8, 1024, e, lds, bx, G, 0, 4);
            } else if (sp == 1) {
#if EN_RWKV
                for (int t = bx; t < NTOK / 16; t += G) { rwkv_prep_tile2(p, l, t, lds); __syncthreads(); }
#endif
            } else if (sp == 2) {
#if EN_RWKV
                if (bx < 64) { __builtin_amdgcn_s_setprio(3); rwkv_scan(p, bx, lds); __builtin_amdgcn_s_setprio(0); }
#endif
                unsigned* cdone = ctl + QW(l, 5);
                unsigned* gdone = ctl + QW(l, 6);
                if (bx >= 64) {
                    EpiInProj e{(u16*)(ws + OFF_PCONV), (u16*)(ws + OFF_PRWKV), (u16*)(ws + OFF_Q), (u16*)(ws + OFF_KV), (float*)(ws + OFF_GATE)};
                    gemm_phase((const u16*)(ws + OFF_H), 1024, (const u16*)(ws + OFF_WIN) + (size_t)l * NINP * 1024, 1024, 256, 15, 1024, e, lds, bx - 64, G - 64, 4, 8, false);
                    asm volatile("s_waitcnt vmcnt(0)" ::: "memory");
                    __syncthreads();
                    if (threadIdx.x == 0) {
                        __builtin_amdgcn_fence(__ATOMIC_RELEASE, "agent");
                        asm volatile("s_waitcnt vmcnt(0)" ::: "memory");
                        __hip_atomic_fetch_add(gdone, 1u, __ATOMIC_RELAXED, __HIP_MEMORY_SCOPE_AGENT);
                    }
                }
                __syncthreads();
                if (threadIdx.x == 0) {
                    unsigned sp_ = 0;
                    while (__hip_atomic_load(gdone, __ATOMIC_RELAXED, __HIP_MEMORY_SCOPE_AGENT) < (unsigned)(G - 64)) { __builtin_amdgcn_s_sleep(8); if (++sp_ > (1u << 24)) break; }
                    __builtin_amdgcn_fence(__ATOMIC_ACQUIRE, "agent");
                    asm volatile("s_waitcnt vmcnt(0)" ::: "memory");
                }
                __syncthreads();
                if (bx >= 64 && bx < 128) {
                    const u16* KVb = (const u16*)(ws + OFF_KV);
                    if (bx < 96) {
                        EpiCompress ek{(const float*)(ws + OFF_CBP) + (l * 2 + 0) * 2048, p.in[I_CKW2] + (size_t)l * 8192, (u16*)(ws + OFF_KC), 0, lds};
                        gemm_phase(KVb, 1024, (const u16*)(ws + OFF_CW1) + (size_t)(l * 2 + 0) * 128 * 2048, 2048, 32, 1, 2048, ek, lds, bx - 64, 1 << 20);
                    } else {
                        EpiCompress ev{(const float*)(ws + OFF_CBP) + (l * 2 + 1) * 2048, p.in[I_CVW2] + (size_t)l * 8192, (u16*)(ws + OFF_VCT), 1, lds};
                        gemm_phase(KVb + 4194304, 1024, (const u16*)(ws + OFF_CW1) + (size_t)(l * 2 + 1) * 128 * 2048, 2048, 32, 1, 2048, ev, lds, bx - 96, 1 << 20);
                    }
                    asm volatile("s_waitcnt vmcnt(0)" ::: "memory");
                    __syncthreads();
                    if (threadIdx.x == 0) {
                        __builtin_amdgcn_fence(__ATOMIC_RELEASE, "agent");
                        asm volatile("s_waitcnt vmcnt(0)" ::: "memory");
                        __hip_atomic_fetch_add(cdone, 1u, __ATOMIC_RELAXED, __HIP_MEMORY_SCOPE_AGENT);
                    }
                }
#if EN_CONV
                for (;;) { const int t = block_next(ctl + QW(l, Q_CONV), qslot); if (t >= NTOK / 32) break; conv_tile(p, l, t, lds); }
#else
                zero_mix_cols(p, 0, 256);
#endif
                __syncthreads();
                if (threadIdx.x == 0) {
                    unsigned sp_ = 0;
                    while (__hip_atomic_load(cdone, __ATOMIC_RELAXED, __HIP_MEMORY_SCOPE_AGENT) < 64u) { __builtin_amdgcn_s_sleep(8); if (++sp_ > (1u << 24)) break; }
                    __builtin_amdgcn_fence(__ATOMIC_ACQUIRE, "agent");
                    asm volatile("s_waitcnt vmcnt(0)" ::: "memory");
                }
                __syncthreads();
                for (int qi = 0; qi < 8; ++qi) {
                    const int bgq = (bx + qi) & 7;
                    for (;;) { const int t = block_next(ctl + QW(l, Q_NSA) + bgq, qslot); if (t >= 256) break; nsa_block_task(p, t * 8 + bgq, lds); }
                }
                if (l == 0) {
                    float* fl = (float*)lds;
                    for (;;) {
                        const int t = block_next(ctl + QW(0, 0), qslot); if (t >= 1536) break;
                        if (t < 512) { const int l2 = t >> 8, r = t & 255; transpose_tile(p.in[I_WOUT] + (size_t)l2 * 1024 * 1024, 1024, (u16*)(ws + OFF_WOUT) + (size_t)l2 * 1024 * 1024, 1024, r >> 4, r & 15, fl); }
                        else { const int u = t - 512; const int l2 = u >> 9, r = u & 511; transpose_tile(p.in[I_PWQ] + (size_t)l2 * 1024 * 2048, 2048, (u16*)(ws + OFF_WQ) + (size_t)l2 * 2048 * 1024, 1024, r >> 5, r & 31, fl); }
                    }
                }
                for (;;) {
                    const int t = block_next(ctl + QW(l, 7), qslot); if (t >= 1024) break;
                    const int tb = t >> 9, r0 = (t & 511) * 32;
                    convert_rows_task(p.in[tb ? I_PV : I_PU] + (size_t)l * 16384 * 1024, ws + OFF_U8 + (size_t)tb * 16 * MiB, (float*)(ws + OFF_UVS) + tb * 16384,
                                      tb ? nullptr : (int*)(ws + OFF_UVS) + 2 * 16384, r0);
                }
            } else if (sp == 3) {
#if EN_RWKV
                phase_rwkv_post(p, l);
#else
                zero_mix_cols(p, 256, 256);
#endif
            } else if (sp == 4) {
                EpiOutProj e{l == 0 ? p.in[I_X] : p.out, p.out, modl + 2 * 1024};
                gemm_phase((const u16*)(ws + OFF_MIX), 1024, (const u16*)(ws + OFF_WOUT) + (size_t)l * 1024 * 1024, 1024, 256, 8, 1024, e, lds, bx, G);
            } else if (sp == 5) {
#if EN_PEER
                phase_norm(p.out, p.in[I_N2G] + l * 1024, modl + 3 * 1024, modl + 4 * 1024, (u16*)(ws + OFF_H));
#endif
            } else if (sp == 6) {
#if EN_PEER
                EpiStoreBf16 e{(u16*)(ws + OFF_QP), 2048};
                gemm_phase((const u16*)(ws + OFF_H), 1024, (const u16*)(ws + OFF_WQ) + (size_t)l * 2048 * 1024, 1024, 256, 16, 1024, e, lds, bx, G);
#endif
            } else if (sp == 7) {
#if EN_PEER
                float* wl = (float*)lds + (TID() >> 6) * 4096;
                for (int t = bx * 4 + (TID() >> 6); t < NTOK / 2; t += G * 4) {
                    peer_topk_task2(p, l, t, wl);
                    __builtin_amdgcn_s_setprio(3);
                    peer_experts_token(p, l, 2 * t, (const int*)(wl + 3584), wl + 3584 + 256);
                    peer_experts_token(p, l, 2 * t + 1, (const int*)(wl + 3584) + 128, wl + 3584 + 256 + 128);
                    __builtin_amdgcn_s_setprio(0);
                    lds_fence();
                }
#endif
            }
        }
        if (ph + 1 < p.ph_hi) { if (p.ph_lo < 0) grid.sync(); else xcd_barrier(xbar); }
    }
}

extern "C" void kernel_launch(void* const* d_in, const int* in_sizes, int n_in, void* d_out, int out_size, void* d_ws, size_t ws_size,
                              hipStream_t stream) {
    static int grid_blocks = 0;
    if (!grid_blocks) {
        int dev = 0, cus = 0, per_cu = 0;
        hipGetDevice(&dev);
        hipDeviceGetAttribute(&cus, hipDeviceAttributeMultiprocessorCount, dev);
        hipOccupancyMaxActiveBlocksPerMultiprocessor(&per_cu, (const void*)mega, 256, 0);
        if (per_cu > 2) per_cu = 2;
        if (per_cu < 1) per_cu = 1;
        grid_blocks = cus * per_cu;
        if (ws_size < WS_NEED) fprintf(stderr, "kernel_launch: workspace too small: %zu < %zu\n", ws_size, (size_t)WS_NEED);
    }
    hipMemsetAsync((char*)d_ws + OFF_CTL, 0, CTL_ZERO_BYTES, stream);
    Params p{};
    for (int i = 0; i < 35; ++i) p.in[i] = (const float*)d_in[i];
    p.out = (float*)d_out;
    p.ws = (unsigned char*)d_ws;
#if MULTI_LAUNCH
    for (int ph = 0; ph < NPH; ++ph) {
        p.ph_lo = ph; p.ph_hi = ph + 1;
        hipLaunchKernelGGL(mega, dim3(grid_blocks), dim3(256), 0, stream, p);
    }
#else
    p.ph_lo = 0; p.ph_hi = NPH;
    void* args[] = {&p};
    hipError_t e = hipLaunchCooperativeKernel((const void*)mega, dim3(grid_blocks), dim3(256), args, 0, stream);
    if (e != hipSuccess) fprintf(stderr, "cooperative launch failed: %s (grid %d)\n", hipGetErrorString(e), grid_blocks);
#endif
}
```

```cpp
#include <hip/hip_runtime.h>
#include <hip/hip_cooperative_groups.h>
#include <stdint.h>
#include <stdio.h>
namespace cg = cooperative_groups;

#ifndef EN_CONV
#define EN_CONV 1
#endif
#ifndef EN_RWKV
#define EN_RWKV 1
#endif
#ifndef EN_NSA_CMP
#define EN_NSA_CMP 1
#endif
#ifndef EN_NSA_WIN
#define EN_NSA_WIN 1
#endif
#ifndef EN_NSA_SEL
#define EN_NSA_SEL 1
#endif
#ifndef EN_PEER
#define EN_PEER 1
#endif
#ifndef MULTI_LAUNCH
#define MULTI_LAUNCH 0
#endif

#define DEV __device__ __forceinline__
typedef unsigned short u16;
typedef __attribute__((ext_vector_type(8))) short bf16x8;
typedef __attribute__((ext_vector_type(4))) float f32x4;
typedef __attribute__((ext_vector_type(4))) unsigned int u32x4;
typedef __attribute__((ext_vector_type(2))) unsigned int u32x2;

constexpr int NB = 4, NT = 8192, ND = 1024, NTOK = NB * NT, NL = 2;
constexpr int NIN = 2840, NINP = 2944;
constexpr size_t MiB = 1ull << 20;

constexpr size_t OFF_CTL = 0;
constexpr size_t CTL_ZERO_BYTES = 32768;
constexpr size_t OFF_BAR = 16384;
constexpr size_t OFF_MOD = 64 * 1024;
constexpr size_t OFF_CBP = 256 * 1024;
constexpr size_t OFF_WIN = 1 * MiB;
constexpr size_t OFF_WOUT = 13 * MiB;
constexpr size_t OFF_WQ = 17 * MiB;
constexpr size_t OFF_CW1 = 25 * MiB;
constexpr size_t OFF_K12 = 27 * MiB;
constexpr size_t OFF_LW = 27 * MiB + 512 * 1024;
constexpr size_t OFF_U8 = 28 * MiB;
constexpr size_t OFF_UVS = 512 * 1024;
constexpr size_t OFF_H = 92 * MiB;
constexpr size_t OFF_MIX = 156 * MiB;
constexpr size_t OFF_E = 220 * MiB;
constexpr size_t OFF_PCONV = OFF_E + 0;
constexpr size_t OFF_PRWKV = OFF_E + 32 * MiB;
constexpr size_t OFF_YRAW = OFF_E + 32 * MiB;
constexpr size_t OFF_Q = OFF_E + 96 * MiB;
constexpr size_t OFF_KV = OFF_E + 128 * MiB;
constexpr size_t OFF_GATE = OFF_E + 176 * MiB;
constexpr size_t OFF_KC = OFF_E + 180 * MiB;
constexpr size_t OFF_VCT = OFF_KC + 512 * 1024;
constexpr size_t OFF_RV = OFF_E + 184 * MiB;
constexpr size_t OFF_RKK = OFF_E + 200 * MiB;
constexpr size_t OFF_RKKA = OFF_E + 216 * MiB;
constexpr size_t OFF_RG = OFF_E + 232 * MiB;
constexpr size_t OFF_BONUS = OFF_E + 248 * MiB;
constexpr size_t OFF_RW = OFF_E + 249 * MiB;
constexpr size_t OFF_RR = 60 * MiB;
constexpr size_t OFF_RK = 76 * MiB;
constexpr size_t OFF_QP = OFF_E + 0;
constexpr size_t OFF_PIDX = OFF_E + 128 * MiB;
constexpr size_t OFF_PGW = OFF_E + 144 * MiB;
constexpr size_t WS_NEED = OFF_E + 281 * MiB;

#define QW(l, q) (64 * ((l) * 8 + (q)))
enum { Q_CMP = 0, Q_CONV = 1, Q_RWP = 2, Q_NSA = 3, Q_PTK = 4 };

enum { I_X = 0, I_C, I_ADAW, I_ADAB, I_N1G, I_N2G, I_WIN, I_CDW, I_CDB, I_CGG, I_CGB, I_MU, I_W0, I_WUP, I_A0, I_AUP, I_GUP,
       I_KK, I_KA, I_RK, I_LNG, I_LNB, I_CKPOS, I_CKW1, I_CKW2, I_CVPOS, I_CVW1, I_CVW2, I_WOUT, I_PWQ, I_PK1, I_PK2, I_PU, I_PV, I_FG };

struct Params {
    const float* in[35];
    float* out;
    unsigned char* ws;
    int ph_lo, ph_hi;
};

DEV int TID() { int t = threadIdx.x; asm volatile("" : "+v"(t)); return t; }
DEV int BID() { int t = blockIdx.x; asm volatile("" : "+s"(t)); return t; }
typedef __attribute__((ext_vector_type(2))) float f32x2_t;
typedef __attribute__((ext_vector_type(2))) __bf16 bf16x2_t;
DEV unsigned pack2(float a, float b) { const f32x2_t v = {a, b}; return __builtin_bit_cast(unsigned, __builtin_convertvector(v, bf16x2_t)); }
DEV u16 f2bf(float f) { const __bf16 h = (__bf16)f; return __builtin_bit_cast(u16, h); }
DEV float bf2f(u16 h) { return __uint_as_float(((unsigned)h) << 16); }
DEV float bflo(unsigned u) { return __uint_as_float(u << 16); }
DEV float bfhi(unsigned u) { return __uint_as_float(u & 0xffff0000u); }
DEV float ex2(float x) { return __builtin_amdgcn_exp2f(x); }
DEV float sigmoidf_(float x) { return 1.f / (1.f + __expf(-x)); }

DEV f32x4 mfma16(bf16x8 a, bf16x8 b, f32x4 c) { return __builtin_amdgcn_mfma_f32_16x16x32_bf16(a, b, c, 0, 0, 0); }
template <int CTRL> DEV float dppf(float x) { return __int_as_float(__builtin_amdgcn_update_dpp(0, __float_as_int(x), CTRL, 0xF, 0xF, false)); }
template <int CTRL> DEV unsigned dppu(unsigned x) { return (unsigned)__builtin_amdgcn_update_dpp(0, (int)x, CTRL, 0xF, 0xF, false); }
DEV float reduce16(float x) { x += dppf<0xB1>(x); x += dppf<0x4E>(x); x += dppf<0x124>(x); x += dppf<0x128>(x); return x; }
DEV float quadsum(float x) { x += dppf<0xB1>(x); x += dppf<0x4E>(x); return x; }
DEV float x16_sum(float x) { auto r = __builtin_amdgcn_permlane16_swap(__float_as_uint(x), __float_as_uint(x), false, false); return __uint_as_float(r[0]) + __uint_as_float(r[1]); }
DEV float x32_sum(float x) { auto r = __builtin_amdgcn_permlane32_swap(__float_as_uint(x), __float_as_uint(x), false, false); return __uint_as_float(r[0]) + __uint_as_float(r[1]); }
DEV float x16_max(float x) { auto r = __builtin_amdgcn_permlane16_swap(__float_as_uint(x), __float_as_uint(x), false, false); return fmaxf(__uint_as_float(r[0]), __uint_as_float(r[1])); }
DEV float x32_max(float x) { auto r = __builtin_amdgcn_permlane32_swap(__float_as_uint(x), __float_as_uint(x), false, false); return fmaxf(__uint_as_float(r[0]), __uint_as_float(r[1])); }
DEV int x16_sumi(int x) { auto r = __builtin_amdgcn_permlane16_swap((unsigned)x, (unsigned)x, false, false); return (int)(r[0] + r[1]); }
DEV int x32_sumi(int x) { auto r = __builtin_amdgcn_permlane32_swap((unsigned)x, (unsigned)x, false, false); return (int)(r[0] + r[1]); }
DEV float colsum(float x) { return x32_sum(x16_sum(x)); }
DEV float colmax(float x) { return x32_max(x16_max(x)); }
DEV int colsumi(int x) { return x32_sumi(x16_sumi(x)); }
DEV float wave_sum(float v) { return x32_sum(x16_sum(reduce16(v))); }
DEV int wave_sum_i(int x) {
    x += (int)dppu<0xB1>((unsigned)x); x += (int)dppu<0x4E>((unsigned)x); x += (int)dppu<0x124>((unsigned)x); x += (int)dppu<0x128>((unsigned)x);
    return x32_sumi(x16_sumi(x));
}
DEV int reduce8_i(const int (&d)[8]) {
    int t[4];
#pragma unroll
    for (int k = 0; k < 4; ++k) {
        auto r = __builtin_amdgcn_permlane32_swap((unsigned)d[k], (unsigned)d[k + 4], false, false);
        t[k] = (int)(r[0] + r[1]);
    }
    int u[2];
#pragma unroll
    for (int k = 0; k < 2; ++k) {
        auto r = __builtin_amdgcn_permlane16_swap((unsigned)t[k], (unsigned)t[k + 2], false, false);
        u[k] = (int)(r[0] + r[1]);
    }
    const bool hi8 = (threadIdx.x & 8) != 0;
    int x = hi8 ? u[1] : u[0];
    const int y = hi8 ? u[0] : u[1];
    x += (int)dppu<0x128>((unsigned)y);
    x += (int)dppu<0xB1>((unsigned)x); x += (int)dppu<0x4E>((unsigned)x); x += (int)dppu<0x141>((unsigned)x);
    return x;
}
DEV float wave_max(float x) {
    x = fmaxf(x, dppf<0xB1>(x)); x = fmaxf(x, dppf<0x4E>(x)); x = fmaxf(x, dppf<0x124>(x)); x = fmaxf(x, dppf<0x128>(x));
    return x32_max(x16_max(x));
}
DEV void lds_fence() { asm volatile("s_waitcnt lgkmcnt(0)" ::: "memory"); }
DEV bf16x8 ld8(const u16* p) { return *(const bf16x8*)p; }

DEV int block_next(unsigned* ctr, int* slot) {
    __syncthreads();
    if (TID() == 0) *slot = (int)atomicAdd(ctr, 1u);
    __syncthreads();
    return *slot;
}

#define XB_TMO      128
#define XB_XCNT(j)  (256  + 64 * (j))
#define XB_XSUB(j)  (1280 + 64 * (j))
#define XB_XGEN(j)  (2304 + 64 * (j))
#define XB_TOP      3328
#define XB_TOPGEN   3392
#define XCD_BAR_WORDS 3456
#define XB_SPIN_CAP (1u << 22)
#define LAS __attribute__((address_space(3)))
DEV unsigned xb_ld(unsigned* p) { return __hip_atomic_load(p, __ATOMIC_RELAXED, __HIP_MEMORY_SCOPE_AGENT); }
DEV unsigned xb_add(unsigned* p, unsigned v) { return __hip_atomic_fetch_add(p, v, __ATOMIC_RELAXED, __HIP_MEMORY_SCOPE_AGENT); }
DEV unsigned xb_xcc_id() { return (unsigned)__builtin_amdgcn_s_getreg((3 << 11) | 20) & 0xFu; }
#define XB_SPIN(cond, bar) do { unsigned _sp = 0; while (cond) { __builtin_amdgcn_s_sleep(1); \
    if ((++_sp & 255u) == 0u) { if (xb_ld(&(bar)[XB_TMO])) break; if (_sp > XB_SPIN_CAP) { atomicAdd(&(bar)[XB_TMO], 1u); break; } } } } while (0)
struct XcdBarrier { unsigned* bar; unsigned x; volatile unsigned* st; };
DEV XcdBarrier xcd_barrier_post(unsigned* bar, volatile unsigned* st) {
    XcdBarrier b; b.bar = bar; b.x = xb_xcc_id(); b.st = st;
    if (threadIdx.x == 0) (void)xb_add(&bar[XB_XCNT(b.x)], 1u);
    return b;
}
DEV void xcd_barrier_complete(unsigned* bar, unsigned x, unsigned& nloc, unsigned& nx) {
    const unsigned G = gridDim.x * gridDim.y * gridDim.z;
    unsigned sum, cnt, mine, sp = 0u;
    for (;;) {
        sum = 0u; cnt = 0u; mine = 0u;
#pragma unroll
        for (unsigned j = 0; j < 16; ++j) { const unsigned c = xb_ld(&bar[XB_XCNT(j)]); sum += c; cnt += (c > 0u) ? 1u : 0u; mine = (j == x) ? c : mine; }
        if (sum == G) break;
        __builtin_amdgcn_s_sleep(1);
        if ((++sp & 255u) == 0u) { if (xb_ld(&bar[XB_TMO])) break; if (sp > XB_SPIN_CAP) { atomicAdd(&bar[XB_TMO], 1u); break; } }
    }
    nloc = mine > 0u ? mine : 1u; nx = cnt > 0u ? cnt : 1u;
}
DEV void xcd_barrier(const XcdBarrier& b) {
    asm volatile("s_waitcnt vmcnt(0)" ::: "memory");
    __syncthreads();
    if (threadIdx.x == 0) {
        unsigned* bar = b.bar;
        __builtin_amdgcn_s_waitcnt(0);
        unsigned nloc = b.st[0], nx = b.st[1];
        if (nloc == 0u) { xcd_barrier_complete(bar, b.x, nloc, nx); b.st[0] = nloc; b.st[1] = nx; }
        const unsigned old = xb_add(&bar[XB_XSUB(b.x)], 1u);
        const unsigned gen = old / nloc;
        if (old + 1u == (gen + 1u) * nloc) {
            __builtin_amdgcn_fence(__ATOMIC_RELEASE, "agent");
            asm volatile("s_waitcnt vmcnt(0)" ::: "memory");
            const unsigned og = xb_add(&bar[XB_TOP], 1u);
            const unsigned tg = og / nx;
            if (og + 1u == (tg + 1u) * nx) xb_add(&bar[XB_TOPGEN], 1u);
            else XB_SPIN(xb_ld(&bar[XB_TOPGEN]) == tg, bar);
            __builtin_amdgcn_fence(__ATOMIC_ACQUIRE, "agent");
            xb_add(&bar[XB_XGEN(b.x)], 1u);
            asm volatile("s_waitcnt vmcnt(0)" ::: "memory");
        } else {
            XB_SPIN(xb_ld(&bar[XB_XGEN(b.x)]) == gen, bar);
            __builtin_amdgcn_fence(__ATOMIC_ACQUIRE, "agent");
            asm volatile("s_waitcnt vmcnt(0)" ::: "memory");
        }
    }
    __syncthreads();
}

template <class Epi>
DEV void gemm_phase(const u16* __restrict__ A, int lda, const u16* __restrict__ Bt, int ldb, int mtiles, int ntiles, int K, Epi& epi,
                    unsigned char* lds, int bid, int nb, int nt_lo = 0, int nt_skip = 0, bool xcd_order = true) {
    const int tid = TID(), lane = tid & 63, wave = tid >> 6;
    const int wm = wave >> 1, wn = wave & 1, q4 = lane >> 4, cidx = lane & 15;
    u16* As = (u16*)lds;
    u16* Bs = (u16*)(lds + 32768);
    const int KT = K >> 6;
    const int total = mtiles * ntiles;
    const int srow = tid >> 3, sch = tid & 7;
    const bool xo_ = xcd_order && ((nb & 7) == 0) && (nb <= 4096) && ((mtiles & 7) == 0);
    const int ngroups = (ntiles + 7) >> 3;
    const int nloc = xo_ ? (nb >> 3) : 1;
    const int nvirt = xo_ ? ((mtiles >> 3) * ngroups * 64) : total;
    for (int vt = xo_ ? ((bid & 7) * 64 + (bid >> 3)) : bid; vt < nvirt; vt += xo_ ? ((((vt & 63) + nloc) < 64) ? nloc : (8 * 64 - (vt & 63) + (bid >> 3))) : nb) {
        int mt, nt;
        if (xo_) {
            const int st = vt >> 6, tt = vt & 63;
            mt = (st / ngroups) * 8 + (tt >> 3); nt = (st % ngroups) * 8 + (tt & 7);
            if (nt >= ntiles) continue;
        } else { mt = vt / ntiles; nt = vt - mt * ntiles; }
        if (nt >= nt_lo) nt += nt_skip;
        const int m0 = mt * 128, n0 = nt * 128;
        const bool sw = epi.swapped(n0 + wn * 64);
        const int xo = sw ? (32768 / 2 + wn * 64 * 64) : (wm * 64 * 64);
        const int yo = sw ? (wm * 64 * 64) : (32768 / 2 + wn * 64 * 64);
        f32x4 acc[4][4];
#pragma unroll
        for (int i = 0; i < 4; ++i)
#pragma unroll
            for (int j = 0; j < 4; ++j) acc[i][j] = (f32x4){0.f, 0.f, 0.f, 0.f};
        const u16* Ag = A + (size_t)(m0 + srow) * lda + sch * 8;
        const u16* Bg = Bt + (size_t)(n0 + srow) * ldb + sch * 8;
        bf16x8 ra0[4], rb0[4], ra1[4], rb1[4];
#define GEMM_GLOAD(RA, RB, KT_) { const int k0_ = (KT_) * 64; _Pragma("unroll") for (int i = 0; i < 4; ++i) { RA[i] = ld8(Ag + (size_t)(32 * i) * lda + k0_); RB[i] = ld8(Bg + (size_t)(32 * i) * ldb + k0_); } }
#define GEMM_LWRITE(RA, RB, BUF_) { u16* Aw_ = As + (BUF_) * 8192; u16* Bw_ = Bs + (BUF_) * 8192; _Pragma("unroll") for (int i = 0; i < 4; ++i) { const int row = srow + 32 * i; const int off = row * 64 + ((sch ^ (row & 7)) << 3); *(bf16x8*)(Aw_ + off) = RA[i]; *(bf16x8*)(Bw_ + off) = RB[i]; } }
#define GEMM_COMPUTE(BUF_) { const u16* Xb = As + (BUF_) * 8192 + xo; const u16* Yb = As + (BUF_) * 8192 + yo; _Pragma("unroll") for (int s = 0; s < 2; ++s) { bf16x8 a[4], b[4]; const int ch = s * 4 + q4; _Pragma("unroll") for (int i = 0; i < 4; ++i) { const int row = i * 16 + cidx; a[i] = *(const bf16x8*)(Xb + row * 64 + ((ch ^ (row & 7)) << 3)); b[i] = *(const bf16x8*)(Yb + row * 64 + ((ch ^ (row & 7)) << 3)); } _Pragma("unroll") for (int i = 0; i < 4; ++i) _Pragma("unroll") for (int j = 0; j < 4; ++j) acc[i][j] = mfma16(a[i], b[j], acc[i][j]); } }
        GEMM_GLOAD(ra0, rb0, 0);
        if (KT > 1) GEMM_GLOAD(ra1, rb1, 1);
        GEMM_LWRITE(ra0, rb0, 0);
        __syncthreads();
        for (int kt = 0; kt < KT; kt += 2) {
            if (kt + 2 < KT) GEMM_GLOAD(ra0, rb0, kt + 2);
            GEMM_COMPUTE(0);
            GEMM_LWRITE(ra1, rb1, 1);
            __syncthreads();
            if (kt + 3 < KT) GEMM_GLOAD(ra1, rb1, kt + 3);
            GEMM_COMPUTE(1);
            if (kt + 2 < KT) GEMM_LWRITE(ra0, rb0, 0);
            __syncthreads();
        }
#undef GEMM_GLOAD
#undef GEMM_LWRITE
#undef GEMM_COMPUTE
        if (!sw) {
#pragma unroll
            for (int i = 0; i < 4; ++i)
#pragma unroll
                for (int j = 0; j < 4; ++j) epi.rows4(m0 + wm * 64 + i * 16 + q4 * 4, n0 + wn * 64 + j * 16 + cidx, acc[i][j]);
        } else {
#pragma unroll
            for (int i = 0; i < 4; ++i)
#pragma unroll
                for (int j = 0; j < 4; ++j) epi.cols4(m0 + wm * 64 + j * 16 + cidx, n0 + wn * 64 + i * 16 + q4 * 4, acc[i][j]);
        }
        epi.finish(m0, n0, lds);
    }
}

struct EpiInProj {
    u16 *pconv, *prwkv, *q, *kv; float* gate;
    DEV bool swapped(int c0) const { return !((c0 >= 2432 && c0 < 2560) || (c0 >= 2688 && c0 < 2816)); }
    DEV void rows4(int row0, int col, f32x4 v) const {
        const int c = col - 2048; const int idx = c >> 7; const int g = (c >> 6) & 1; const int d = c & 63;
        const int b = row0 >> 13; const int t0 = row0 & 8191; const int bg = b * 2 + g;
        u16* base = kv + (size_t)idx * 4194304;
        const int k = t0 & 31; const int p0 = 8 * ((k & 15) >> 2) + 4 * (k >> 4);
        u32x2 w; w[0] = pack2(v[0], v[1]); w[1] = pack2(v[2], v[3]);
        *(u32x2*)(base + (size_t)(bg * 64 + d) * 8192 + (t0 & ~31) + p0) = w;
    }
    DEV void cols4(int row, int col0, f32x4 v) const {
        if (col0 < 512) {
            u32x2 w; w[0] = pack2(v[0], v[1]); w[1] = pack2(v[2], v[3]);
            *(u32x2*)(pconv + (size_t)row * 512 + col0) = w;
        } else if (col0 < 1536) {
            u32x2 w; w[0] = pack2(v[0], v[1]); w[1] = pack2(v[2], v[3]);
            *(u32x2*)(prwkv + (size_t)row * 1024 + (col0 - 512)) = w;
        } else if (col0 < 2048) {
            const float sc = 0.18033688011112042f;
            u32x2 w; w[0] = pack2(v[0] * sc, v[1] * sc); w[1] = pack2(v[2] * sc, v[3] * sc);
            *(u32x2*)(q + (size_t)row * 512 + (col0 - 1536)) = w;
        } else if (col0 < 2816) {
            const int c = col0 - 2048; const int idx = c >> 7; const int g = (c >> 6) & 1; const int d = c & 63;
            const int b = row >> 13; const int t = row & 8191; const int bg = b * 2 + g;
            u32x2 w; w[0] = pack2(v[0], v[1]); w[1] = pack2(v[2], v[3]);
            *(u32x2*)(kv + (size_t)idx * 4194304 + ((size_t)bg * 8192 + t) * 64 + d) = w;
        } else if (col0 < 2840) {
            *(float4*)(gate + (size_t)row * 24 + (col0 - 2816)) = (float4){sigmoidf_(v[0]), sigmoidf_(v[1]), sigmoidf_(v[2]), sigmoidf_(v[3])};
        }
    }
    DEV void finish(int, int, unsigned char*) const {}
};

struct EpiOutProj {
    const float* xold; float* xnew; const float* g1;
    DEV bool swapped(int) const { return true; }
    DEV void rows4(int, int, f32x4) const {}
    DEV void cols4(int row, int col0, f32x4 v) const {
        const int b = row >> 13; const float4 gg = *(const float4*)(g1 + b * 6144 + col0);
        const size_t o = (size_t)row * 1024 + col0;
        const float4 x = *(const float4*)(xold + o);
        *(float4*)(xnew + o) = (float4){x.x + gg.x * v[0], x.y + gg.y * v[1], x.z + gg.z * v[2], x.w + gg.w * v[3]};
    }
    DEV void finish(int, int, unsigned char*) const {}
};

struct EpiStoreBf16 {
    u16* out; int ld;
    DEV bool swapped(int) const { return true; }
    DEV void rows4(int, int, f32x4) const {}
    DEV void cols4(int row, int col0, f32x4 v) const {
        u32x2 w; w[0] = pack2(v[0], v[1]); w[1] = pack2(v[2], v[3]);
        *(u32x2*)(out + (size_t)row * ld + col0) = w;
    }
    DEV void finish(int, int, unsigned char*) const {}
};

struct EpiCompress {
    const float* cbp;
    const float* w2;
    u16* outp;
    int isv;
    unsigned char* lds;
    DEV bool swapped(int) const { return false; }
    DEV void cols4(int, int, f32x4) const {}
    DEV void rows4(int row0, int col, f32x4 v) const {
        float* hid = (float*)lds;
        const int rl = row0 & 127;
#pragma unroll
        for (int r = 0; r < 4; ++r) hid[(rl + r) * 128 + col] = v[r];
    }
    DEV void finish(int m0, int, unsigned char*) const {
        __syncthreads();
        {
            float* hw = (float*)lds;
            const int t = TID(); const int c = t & 127, r0 = (t >> 7) * 64;
            float bias = 0.f;
#pragma unroll
            for (int s = 0; s < 16; ++s) bias += cbp[s * 128 + c];
#pragma unroll 4
            for (int r = 0; r < 64; ++r) { const float x = hw[(r0 + r) * 128 + c] + bias; hw[(r0 + r) * 128 + c] = x * sigmoidf_(x); }
        }
        __syncthreads();
        const float* hid = (const float*)lds;
        const int tid = TID(); const int d = tid & 63, rgp = tid >> 6;
        float acc[32];
#pragma unroll
        for (int i = 0; i < 32; ++i) acc[i] = 0.f;
#pragma unroll 1
        for (int j0 = 0; j0 < 128; j0 += 8) {
            float wv[8];
#pragma unroll
            for (int jj = 0; jj < 8; ++jj) wv[jj] = w2[(j0 + jj) * 64 + d];
#pragma unroll
            for (int rr = 0; rr < 32; ++rr) {
                const float4 h0 = *(const float4*)(hid + (rgp * 32 + rr) * 128 + j0), h1 = *(const float4*)(hid + (rgp * 32 + rr) * 128 + j0 + 4);
                acc[rr] += h0.x * wv[0] + h0.y * wv[1] + h0.z * wv[2] + h0.w * wv[3] + h1.x * wv[4] + h1.y * wv[5] + h1.z * wv[6] + h1.w * wv[7];
            }
        }
#pragma unroll
        for (int rr = 0; rr < 32; ++rr) {
            const int m = m0 + rgp * 32 + rr; const int bg = m >> 9, n = m & 511;
            const u16 val = (n == 511) ? (u16)0 : f2bf(acc[rr]);
            if (!isv) outp[((size_t)bg * 512 + n) * 64 + d] = val;
            else {
                const int k = n & 31; const int pp = 8 * ((k & 15) >> 2) + (k & 3) + 4 * (k >> 4);
                outp[((size_t)bg * 64 + d) * 512 + (n & ~31) + pp] = val;
            }
        }
        __syncthreads();
    }
};

DEV void transpose_tile(const float* __restrict__ src, int N, u16* __restrict__ dst, int ldk, int kt, int nt, float* tl) {
    const int tid = TID(); const int k0 = kt * 64, n0 = nt * 64;
#pragma unroll 4
    for (int i = 0; i < 16; ++i) {
        const int idx = tid + 256 * i; const int kr = idx >> 6, nc = idx & 63; const int n = n0 + nc;
        tl[kr * 65 + nc] = (n < N) ? src[(size_t)(k0 + kr) * N + n] : 0.f;
    }
    __syncthreads();
#pragma unroll 4
    for (int i = 0; i < 16; ++i) {
        const int idx = tid + 256 * i; const int nr = idx >> 6, kc = idx & 63;
        dst[(size_t)(n0 + nr) * ldk + k0 + kc] = f2bf(tl[kc * 65 + nr]);
    }
    __syncthreads();
}

DEV void convert_straight(const float* __restrict__ src, u16* __restrict__ dst, size_t n) {
    const size_t stride = (size_t)gridDim.x * 256 * 8;
    for (size_t i = ((size_t)BID() * 256 + TID()) * 8; i < n; i += stride) {
        const float4 a = *(const float4*)(src + i); const float4 b = *(const float4*)(src + i + 4);
        u32x4 w; w[0] = pack2(a.x, a.y); w[1] = pack2(a.z, a.w); w[2] = pack2(b.x, b.y); w[3] = pack2(b.z, b.w);
        *(u32x4*)(dst + i) = w;
    }
}

DEV void convert_rows_task(const float* __restrict__ src, unsigned char* __restrict__ dst, float* __restrict__ scale, int* __restrict__ rowsum, int row0) {
    const int lane = TID() & 63, wave = TID() >> 6;
#pragma unroll 1
    for (int it = 0; it < 4; ++it) {
        float4 v[2][4]; float amax[2] = {0.f, 0.f};
#pragma unroll
        for (int u = 0; u < 2; ++u) {
            const int row = row0 + wave * 8 + it * 2 + u;
#pragma unroll
            for (int i = 0; i < 4; ++i) v[u][i] = *(const float4*)(src + (size_t)row * 1024 + 16 * lane + 4 * i);
        }
#pragma unroll
        for (int u = 0; u < 2; ++u) {
#pragma unroll
            for (int i = 0; i < 4; ++i)
                amax[u] = fmaxf(amax[u], fmaxf(fmaxf(fabsf(v[u][i].x), fabsf(v[u][i].y)), fmaxf(fabsf(v[u][i].z), fabsf(v[u][i].w))));
            amax[u] = wave_max(amax[u]);
            const int row = row0 + wave * 8 + it * 2 + u;
            const float sc = amax[u] > 0.f ? amax[u] * (1.f / 127.f) : 1.f;
            const float inv = 1.f / sc;
            u32x4 w;
#pragma unroll
            for (int i = 0; i < 4; ++i) {
                const int a = __float2int_rn(v[u][i].x * inv), b = __float2int_rn(v[u][i].y * inv), c = __float2int_rn(v[u][i].z * inv), d = __float2int_rn(v[u][i].w * inv);
                w[i] = ((unsigned)a & 0xffu) | (((unsigned)b & 0xffu) << 8) | (((unsigned)c & 0xffu) << 16) | (((unsigned)d & 0xffu) << 24);
            }
            *(u32x4*)(dst + (size_t)row * 1024 + 16 * lane) = w;
            if (lane == 0) scale[row] = sc;
        }
    }
}

DEV void phase_prep(const Params& p, unsigned char* lds) {
    const int tid = TID();
    float* fl = (float*)lds;
    unsigned char* ws = p.ws;
    for (int task = BID(); task < 192; task += gridDim.x) {
        const int l = task / 96, cgp = task % 96;
        float* cs = fl;
        float* red = fl + 4096;
        for (int i = tid; i < 4096; i += 256) { const float c = p.in[I_C][i]; cs[i] = c / (1.f + __expf(-c)); }
        __syncthreads();
        const int col = cgp * 64 + (tid & 63), ks = tid >> 6;
        float a0 = 0, a1 = 0, a2 = 0, a3 = 0;
        const float* w = p.in[I_ADAW] + ((size_t)l * 1024 + ks * 256) * 6144 + col;
#pragma unroll 32
        for (int k = 0; k < 256; ++k) {
            const float wv = w[(size_t)k * 6144]; const int kk = ks * 256 + k;
            a0 += cs[kk] * wv; a1 += cs[1024 + kk] * wv; a2 += cs[2048 + kk] * wv; a3 += cs[3072 + kk] * wv;
        }
        red[(ks * 4 + 0) * 64 + (tid & 63)] = a0; red[(ks * 4 + 1) * 64 + (tid & 63)] = a1;
        red[(ks * 4 + 2) * 64 + (tid & 63)] = a2; red[(ks * 4 + 3) * 64 + (tid & 63)] = a3;
        __syncthreads();
        {
            const int b = tid >> 6, c = tid & 63;
            const float s = red[(0 * 4 + b) * 64 + c] + red[(1 * 4 + b) * 64 + c] + red[(2 * 4 + b) * 64 + c] + red[(3 * 4 + b) * 64 + c];
            const int colg = cgp * 64 + c;
            ((float*)(ws + OFF_MOD))[(l * 4 + b) * 6144 + colg] = s + p.in[I_ADAB][l * 6144 + colg];
        }
        __syncthreads();
    }
    for (int task = BID(); task < 64; task += gridDim.x) {
        const int l = task >> 5, kv = (task >> 4) & 1, s = task & 15;
        const float* pos = p.in[kv ? I_CVPOS : I_CKPOS] + l * 2048;
        const float* w1 = p.in[kv ? I_CVW1 : I_CKW1] + (size_t)l * 2048 * 128;
        const int col = tid & 127, half = tid >> 7;
        float a = 0;
        const int i0 = s * 128 + half * 64;
#pragma unroll 8
        for (int i = 0; i < 64; ++i) a += pos[i0 + i] * w1[(size_t)(i0 + i) * 128 + col];
        fl[tid] = a;
        __syncthreads();
        if (tid < 128) ((float*)(ws + OFF_CBP))[((l * 2 + kv) * 16 + s) * 128 + tid] = fl[tid] + fl[tid + 128];
        __syncthreads();
    }
    {
        for (int task = BID(); task < 2 * 16 * 46; task += gridDim.x) {
            const int l = task / (16 * 46), r = task % (16 * 46);
            transpose_tile(p.in[I_WIN] + (size_t)l * 1024 * NIN, NIN, (u16*)(ws + OFF_WIN) + (size_t)l * NINP * 1024, 1024, r / 46, r % 46, fl);
        }
        for (int task = BID(); task < 2 * 16; task += gridDim.x) {
            const int l = task >> 4, r = task & 15; const int nt = r & 3, part = r >> 2;
            u16* dst = (u16*)(ws + OFF_LW) + (size_t)l * 65536;
            if (part == 0) transpose_tile(p.in[I_WUP] + (size_t)l * 64 * 256, 256, dst, 256, 0, nt, fl);
            else if (part == 1) transpose_tile(p.in[I_AUP] + (size_t)l * 64 * 256, 256, dst + 64, 256, 0, nt, fl);
            else transpose_tile(p.in[I_GUP] + (size_t)l * 128 * 256, 256, dst + 128, 256, part - 2, nt, fl);
        }
        for (int task = BID(); task < 4 * 32 * 2; task += gridDim.x) {
            const int lk = task >> 6, r = task & 63; const int l = lk >> 1, kv = lk & 1;
            transpose_tile(p.in[kv ? I_CVW1 : I_CKW1] + (size_t)l * 2048 * 128, 128, (u16*)(ws + OFF_CW1) + (size_t)lk * 128 * 2048, 2048, r >> 1, r & 1, fl);
        }
    }
    for (int l = 0; l < 2; ++l) {
        convert_straight(p.in[I_PK1] + l * 16384, (u16*)(ws + OFF_K12) + (l * 2 + 0) * 16384, 16384);
        convert_straight(p.in[I_PK2] + l * 16384, (u16*)(ws + OFF_K12) + (l * 2 + 1) * 16384, 16384);
    }
}

DEV void phase_norm(const float* __restrict__ x, const float* __restrict__ g, const float* __restrict__ sh, const float* __restrict__ sc,
                    u16* __restrict__ h) {
    const int lane = TID() & 63;
    const int gw = BID() * 4 + (TID() >> 6), nw = gridDim.x * 4;
    for (int row0 = gw * 2; row0 < NTOK; row0 += nw * 2) {
        float4 v[2][4]; float ss[2] = {0.f, 0.f};
#pragma unroll
        for (int u = 0; u < 2; ++u)
#pragma unroll
            for (int i = 0; i < 4; ++i) v[u][i] = *(const float4*)(x + (size_t)(row0 + u) * 1024 + 256 * i + lane * 4);
#pragma unroll
        for (int u = 0; u < 2; ++u) {
#pragma unroll
            for (int i = 0; i < 4; ++i) ss[u] += v[u][i].x * v[u][i].x + v[u][i].y * v[u][i].y + v[u][i].z * v[u][i].z + v[u][i].w * v[u][i].w;
            ss[u] = wave_sum(ss[u]);
        }
#pragma unroll
        for (int u = 0; u < 2; ++u) {
            const int row = row0 + u; const int b = row >> 13;
            const float rs = rsqrtf(ss[u] * (1.f / 1024.f) + 1e-6f);
#pragma unroll
            for (int i = 0; i < 4; ++i) {
                const int k = 256 * i + lane * 4;
                const float4 gg = *(const float4*)(g + k); const float4 s1 = *(const float4*)(sc + b * 6144 + k); const float4 s0 = *(const float4*)(sh + b * 6144 + k);
                u32x2 w;
                w[0] = pack2(v[u][i].x * rs * gg.x * (1.f + s1.x) + s0.x, v[u][i].y * rs * gg.y * (1.f + s1.y) + s0.y);
                w[1] = pack2(v[u][i].z * rs * gg.z * (1.f + s1.z) + s0.z, v[u][i].w * rs * gg.w * (1.f + s1.w) + s0.w);
                *(u32x2*)(h + (size_t)row * 1024 + k) = w;
            }
        }
    }
}

DEV void conv_tile(const Params& p, int l, int tile, unsigned char* lds) {
    float* ul = (float*)lds;
    const int tid = TID();
    unsigned char* ws = p.ws;
    const u16* pconv = (const u16*)(ws + OFF_PCONV);
    u16* mix = (u16*)(ws + OFF_MIX);
    const int t0g = tile * 32; const int tb = t0g & 8191;
#pragma unroll 8
    for (int rr = 0; rr < 62; ++rr) {
        const int trow = tb - 30 + rr;
        float u = 0.f;
        if (trow >= 0) {
            const size_t o = (size_t)(t0g - 30 + rr) * 512;
            const float val = bf2f(pconv[o + tid]), gt = bf2f(pconv[o + 256 + tid]);
            u = val * sigmoidf_(gt);
        }
        ul[rr * 256 + tid] = u;
    }
    __syncthreads();
    float w[31];
#pragma unroll
    for (int j = 0; j < 31; ++j) w[j] = p.in[I_CDW][(l * 31 + j) * 256 + tid];
    const float bias = p.in[I_CDB][l * 256 + tid], gg = p.in[I_CGG][l * 256 + tid], gb = p.in[I_CGB][l * 256 + tid];
    for (int tt = 0; tt < 32; ++tt) {
        float y = bias;
#pragma unroll
        for (int j = 0; j < 31; ++j) y += ul[(tt + j) * 256 + tid] * w[j];
        const float mean = wave_sum(y) * (1.f / 64.f);
        const float d = y - mean;
        const float var = wave_sum(d * d) * (1.f / 64.f);
        float o = d * rsqrtf(var + 1e-5f) * gg + gb;
        o = o * sigmoidf_(o);
        mix[(size_t)(t0g + tt) * 1024 + tid] = f2bf(o);
    }
}

DEV float softplusf_(float x) { return x > 20.f ? x : log1pf(__expf(x)); }
DEV void rwkv_prep_tile2(const Params& p, int l, int tile, unsigned char* lds) {
    u16* actb = (u16*)lds;
    const int tid = TID(), lane = tid & 63, wave = tid >> 6, q4 = lane >> 4, cidx = lane & 15;
    unsigned char* ws = p.ws;
    const u16* pr = (const u16*)(ws + OFF_PRWKV);
    const float* mu = p.in[I_MU] + l * 1024;
    const int R0 = tile * 16;
    {
        const int col = 768 + tid; const float muc = mu[col];
        u16 raw[17];
        const bool first = ((R0 & 8191) == 0);
        raw[0] = first ? (u16)0 : pr[(size_t)(R0 - 1) * 1024 + col];
#pragma unroll
        for (int tk = 0; tk < 16; ++tk) raw[tk + 1] = pr[(size_t)(R0 + tk) * 1024 + col];
#pragma unroll
        for (int tk = 0; tk < 16; ++tk) {
            const float cur = bf2f(raw[tk + 1]), prev = bf2f(raw[tk]);
            const float x = cur + (prev - cur) * muc;
            float a;
            if (tid < 64) a = tanhf(x); else if (tid < 128) a = x; else a = sigmoidf_(x);
            actb[tk * 264 + tid] = f2bf(a);
        }
    }
    __syncthreads();
    f32x4 accw[4], acca[4], accg[4];
    {
        bf16x8 af[8];
#pragma unroll
        for (int s2 = 0; s2 < 8; ++s2) af[s2] = *(const bf16x8*)(actb + cidx * 264 + 32 * s2 + 8 * q4);
        const u16* LW = (const u16*)(ws + OFF_LW) + (size_t)l * 65536;
        const f32x4 z = (f32x4){0.f, 0.f, 0.f, 0.f};
#pragma unroll
        for (int nt = 0; nt < 4; ++nt) {
            const u16* bp = LW + (size_t)(64 * wave + 16 * nt + cidx) * 256 + 8 * q4;
            accw[nt] = mfma16(af[0], ld8(bp), z); accw[nt] = mfma16(af[1], ld8(bp + 32), accw[nt]);
            acca[nt] = mfma16(af[2], ld8(bp + 64), z); acca[nt] = mfma16(af[3], ld8(bp + 96), acca[nt]);
            accg[nt] = mfma16(af[4], ld8(bp + 128), z); accg[nt] = mfma16(af[5], ld8(bp + 160), accg[nt]);
            accg[nt] = mfma16(af[6], ld8(bp + 192), accg[nt]); accg[nt] = mfma16(af[7], ld8(bp + 224), accg[nt]);
        }
    }
    float* RW = (float*)(ws + OFF_RW);
    u16 *RR = (u16*)(ws + OFF_RR), *RK = (u16*)(ws + OFF_RK), *RV = (u16*)(ws + OFF_RV), *RKK = (u16*)(ws + OFF_RKK), *RKKA = (u16*)(ws + OFF_RKKA),
        *RG = (u16*)(ws + OFF_RG);
    float* BON = (float*)(ws + OFF_BONUS);
    float w0[4], a0[4], kkc[4], kac[4], rkc[4], mur[4], muk[4], muv[4];
#pragma unroll
    for (int nt = 0; nt < 4; ++nt) {
        const int c = 64 * wave + 16 * nt + cidx;
        w0[nt] = p.in[I_W0][l * 256 + c]; a0[nt] = p.in[I_A0][l * 256 + c]; kkc[nt] = p.in[I_KK][l * 256 + c]; kac[nt] = p.in[I_KA][l * 256 + c];
        rkc[nt] = p.in[I_RK][l * 256 + c]; mur[nt] = mu[c]; muk[nt] = mu[256 + c]; muv[nt] = mu[512 + c];
    }
    u16 ld3[5][4][3];
    {
        const int rowb = R0 + 4 * q4; const bool firstrow = ((rowb & 8191) == 0);
#pragma unroll
        for (int rr_ = 0; rr_ < 5; ++rr_)
#pragma unroll
            for (int nt = 0; nt < 4; ++nt) {
                const int c = 64 * wave + 16 * nt + cidx;
                const u16* cr = pr + (size_t)(rowb - 1 + rr_) * 1024;
                const bool z = (rr_ == 0) && firstrow;
                ld3[rr_][nt][0] = z ? (u16)0 : cr[c]; ld3[rr_][nt][1] = z ? (u16)0 : cr[256 + c]; ld3[rr_][nt][2] = z ? (u16)0 : cr[512 + c];
            }
    }
#pragma unroll
    for (int r = 0; r < 4; ++r) {
        const int row = R0 + 4 * q4 + r;
        float rr[4], kf_[4], vf_[4], av[4], kkv[4], keff[4], dec[4];
        float kk2 = 0.f, bn = 0.f;
#pragma unroll
        for (int nt = 0; nt < 4; ++nt) {
            float rv = bf2f(ld3[r + 1][nt][0]), kv = bf2f(ld3[r + 1][nt][1]), vv = bf2f(ld3[r + 1][nt][2]);
            const float rp = bf2f(ld3[r][nt][0]), kp = bf2f(ld3[r][nt][1]), vp = bf2f(ld3[r][nt][2]);
            rv += (rp - rv) * mur[nt]; kv += (kp - kv) * muk[nt]; vv += (vp - vv) * muv[nt];
            const float wl = w0[nt] + accw[nt][r];
            const float wlog = -softplusf_(-wl) - 0.5f;
            dec[nt] = __expf(-__expf(wlog));
            av[nt] = sigmoidf_(a0[nt] + acca[nt][r]);
            kkv[nt] = kv * kkc[nt]; kk2 += kkv[nt] * kkv[nt];
            keff[nt] = kv * (1.f + (av[nt] - 1.f) * kac[nt]);
            bn += rv * keff[nt] * rkc[nt];
            rr[nt] = rv; kf_[nt] = kv; vf_[nt] = vv;
        }
        kk2 = reduce16(kk2); bn = reduce16(bn);
        const float inv = 1.f / fmaxf(sqrtf(kk2), 1e-12f);
#pragma unroll
        for (int nt = 0; nt < 4; ++nt) {
            const int c = 64 * wave + 16 * nt + cidx;
            const size_t o = (size_t)row * 256 + c;
            const float kk = kkv[nt] * inv;
            RW[o] = dec[nt]; RR[o] = f2bf(rr[nt]); RK[o] = f2bf(keff[nt]); RV[o] = f2bf(vf_[nt]); RKK[o] = f2bf(kk); RKKA[o] = f2bf(kk * av[nt]);
            RG[o] = f2bf(accg[nt][r]);
        }
        if (cidx == 0) BON[(size_t)row * 4 + wave] = bn;
    }
}

DEV void rwkv_scan(const Params& p, int sb, unsigned char* lds) {
    unsigned char* ws = p.ws;
    const float* RW = (const float*)(ws + OFF_RW);
    const u16 *RR = (const u16*)(ws + OFF_RR), *RK = (const u16*)(ws + OFF_RK), *RV = (const u16*)(ws + OFF_RV), *RKK = (const u16*)(ws + OFF_RKK),
              *RKKA = (const u16*)(ws + OFF_RKKA);
    float* YR = (float*)(ws + OFF_YRAW);
    const int tid = TID(), lane = tid & 63, wave = tid >> 6;
    const int bh = sb >> 2, rg = sb & 3; const int b = bh >> 2, hh = bh & 3;
    float* L = (float*)lds;
    constexpr int BUFSZ = 5 * 1024 + 256;
    float* Yb = L + 2 * BUFSZ;
    const int row_local = 4 * wave + (lane >> 4); const int kq = (lane & 15) * 4;
    const int lstep = tid >> 4, lk = (tid & 15) * 4;
    const int vstep = tid >> 4, vrow = tid & 15;
    const size_t gbase = (size_t)b * 8192 * 256 + hh * 64;
    float4 lw; u32x2 lr, lkk, lkka, lk_; u16 lv;
    auto issue = [&](int c) {
        const size_t o = gbase + (size_t)(c * 16 + lstep) * 256 + lk;
        lw = *(const float4*)(RW + o);
        lr = *(const u32x2*)(RR + o); lk_ = *(const u32x2*)(RK + o); lkk = *(const u32x2*)(RKK + o); lkka = *(const u32x2*)(RKKA + o);
        lv = RV[gbase + (size_t)(c * 16 + vstep) * 256 + rg * 16 + vrow];
    };
    auto commit = [&](int buf) {
        float* B = L + buf * BUFSZ;
        const int o = lstep * 64 + lk;
        *(float4*)(B + o) = lw;
        *(float4*)(B + 1024 + o) = (float4){bflo(lkka[0]), bfhi(lkka[0]), bflo(lkka[1]), bfhi(lkka[1])};
        *(float4*)(B + 2048 + o) = (float4){bflo(lk_[0]), bfhi(lk_[0]), bflo(lk_[1]), bfhi(lk_[1])};
        *(float4*)(B + 3072 + o) = (float4){bflo(lr[0]), bfhi(lr[0]), bflo(lr[1]), bfhi(lr[1])};
        *(float4*)(B + 4096 + o) = (float4){bflo(lkk[0]), bfhi(lkk[0]), bflo(lkk[1]), bfhi(lkk[1])};
        B[5120 + vstep * 16 + vrow] = bf2f(lv);
    };
    __syncthreads();
    issue(0); commit(0);
    __syncthreads();
    float S0 = 0.f, S1 = 0.f, S2 = 0.f, S3 = 0.f;
    constexpr int NCH = NT / 16;
    for (int c = 0; c < NCH; ++c) {
        const int buf = c & 1;
        if (c + 1 < NCH) issue(c + 1);
        const float* B = L + buf * BUFSZ;
        float* Y = Yb + buf * 256;
        float yv[16];
        float4 w4 = *(const float4*)(B + kq), a4 = *(const float4*)(B + 1024 + kq), k4 = *(const float4*)(B + 2048 + kq),
               r4 = *(const float4*)(B + 3072 + kq), n4 = *(const float4*)(B + 4096 + kq);
        float vv = B[5120 + row_local];
#pragma unroll
        for (int st = 0; st < 16; ++st) {
            float4 w4n, a4n, k4n, r4n, n4n; float vvn;
            if (st < 15) {
                w4n = *(const float4*)(B + (st + 1) * 64 + kq); a4n = *(const float4*)(B + 1024 + (st + 1) * 64 + kq);
                k4n = *(const float4*)(B + 2048 + (st + 1) * 64 + kq); r4n = *(const float4*)(B + 3072 + (st + 1) * 64 + kq);
                n4n = *(const float4*)(B + 4096 + (st + 1) * 64 + kq); vvn = B[5120 + (st + 1) * 16 + row_local];
            }
            const float part = (S0 * n4.x + S1 * n4.y) + (S2 * n4.z + S3 * n4.w);
            const float sa = -reduce16(part);
            const float t0 = S0 * w4.x + vv * k4.x, t1 = S1 * w4.y + vv * k4.y, t2 = S2 * w4.z + vv * k4.z, t3 = S3 * w4.w + vv * k4.w;
            S0 = t0 + sa * a4.x; S1 = t1 + sa * a4.y; S2 = t2 + sa * a4.z; S3 = t3 + sa * a4.w;
            const float yp = (S0 * r4.x + S1 * r4.y) + (S2 * r4.z + S3 * r4.w);
            yv[st] = reduce16(yp);
            if (st < 15) { w4 = w4n; a4 = a4n; k4 = k4n; r4 = r4n; n4 = n4n; vv = vvn; }
        }
        if ((lane & 15) == 0) {
#pragma unroll
            for (int st = 0; st < 16; ++st) Y[st * 16 + row_local] = yv[st];
        }
        if (c + 1 < NCH) commit(buf ^ 1);
        __syncthreads();
        YR[gbase + (size_t)(c * 16 + vstep) * 256 + rg * 16 + vrow] = Y[vstep * 16 + vrow];
    }
}

DEV void phase_rwkv_post(const Params& p, int l) {
    unsigned char* ws = p.ws;
    const float* YR = (const float*)(ws + OFF_YRAW); const float* BON = (const float*)(ws + OFF_BONUS);
    const u16 *RV = (const u16*)(ws + OFF_RV), *RG = (const u16*)(ws + OFF_RG);
    u16* mix = (u16*)(ws + OFF_MIX);
    const int tid = TID();
    const float lg = p.in[I_LNG][l * 256 + tid], lb = p.in[I_LNB][l * 256 + tid];
    for (int row0 = BID() * 4; row0 < NTOK; row0 += gridDim.x * 4) {
        float y[4], bon[4], vv[4], gg[4];
#pragma unroll
        for (int u = 0; u < 4; ++u) {
            const size_t o = (size_t)(row0 + u) * 256 + tid;
            y[u] = YR[o]; bon[u] = BON[(size_t)(row0 + u) * 4 + (tid >> 6)]; vv[u] = bf2f(RV[o]); gg[u] = bf2f(RG[o]);
        }
#pragma unroll
        for (int u = 0; u < 4; ++u) {
            const float mean = wave_sum(y[u]) * (1.f / 64.f);
            const float d = y[u] - mean;
            const float var = wave_sum(d * d) * (1.f / 64.f);
            const float yn = d * rsqrtf(var + 64e-5f) * lg + lb;
            mix[(size_t)(row0 + u) * 1024 + 256 + tid] = f2bf((yn + bon[u] * vv[u]) * gg[u]);
        }
    }
}

DEV void zero_mix_cols(const Params& p, int c0, int ncols) {
    u16* mix = (u16*)(p.ws + OFF_MIX);
    const int per = ncols / 8;
    const size_t total = (size_t)NTOK * per;
    for (size_t i = (size_t)BID() * 256 + TID(); i < total; i += (size_t)gridDim.x * 256) {
        const size_t row = i / per; const int cc = (int)(i % per);
        *(u32x4*)(mix + row * 1024 + c0 + cc * 8) = (u32x4){0u, 0u, 0u, 0u};
    }
}


DEV void qk_tile(const bf16x8 (&kf)[8], bf16x8 q0, bf16x8 q1, float cinit, f32x4 (&st)[4]) {
    const f32x4 c = (f32x4){cinit, cinit, cinit, cinit};
#pragma unroll
    for (int kt = 0; kt < 4; ++kt) {
        st[kt] = mfma16(kf[2 * kt], q0, c);
        st[kt] = mfma16(kf[2 * kt + 1], q1, st[kt]);
    }
}
DEV void softmax_pv_lazy(f32x4 (&st)[4], const bf16x8 (&vf)[8], float& m, float& l, f32x4& L, f32x4 (&O)[4]) {
    float lmax = fmaxf(fmaxf(fmaxf(st[0][0], st[0][1]), fmaxf(st[0][2], st[0][3])), fmaxf(fmaxf(st[1][0], st[1][1]), fmaxf(st[1][2], st[1][3])));
    lmax = fmaxf(lmax, fmaxf(fmaxf(fmaxf(st[2][0], st[2][1]), fmaxf(st[2][2], st[2][3])), fmaxf(fmaxf(st[3][0], st[3][1]), fmaxf(st[3][2], st[3][3]))));
    lmax = colmax(lmax);
    const float dlt = (lmax > 8.f) ? lmax : 0.f;
    if (__any(dlt > 0.f)) {
        const float alpha = ex2(-dlt);
#pragma unroll
        for (int mt = 0; mt < 4; ++mt) { O[mt][0] *= alpha; O[mt][1] *= alpha; O[mt][2] *= alpha; O[mt][3] *= alpha; }
        L[0] *= alpha; L[1] *= alpha; L[2] *= alpha; L[3] *= alpha; l *= alpha; m += dlt;
#pragma unroll
        for (int kt = 0; kt < 4; ++kt) { st[kt][0] -= dlt; st[kt][1] -= dlt; st[kt][2] -= dlt; st[kt][3] -= dlt; }
    }
#pragma unroll
    for (int kt = 0; kt < 4; ++kt)
#pragma unroll
        for (int r = 0; r < 4; ++r) st[kt][r] = ex2(st[kt][r]);
    union { bf16x8 v; unsigned u[4]; } ones;
    ones.u[0] = 0x3f803f80u; ones.u[1] = 0x3f803f80u; ones.u[2] = 0x3f803f80u; ones.u[3] = 0x3f803f80u;
#pragma unroll
    for (int kb = 0; kb < 2; ++kb) {
        union { bf16x8 v; unsigned u[4]; } pb;
        pb.u[0] = pack2(st[2 * kb][0], st[2 * kb][1]); pb.u[1] = pack2(st[2 * kb][2], st[2 * kb][3]);
        pb.u[2] = pack2(st[2 * kb + 1][0], st[2 * kb + 1][1]); pb.u[3] = pack2(st[2 * kb + 1][2], st[2 * kb + 1][3]);
        L = mfma16(ones.v, pb.v, L);
#pragma unroll
        for (int mt = 0; mt < 4; ++mt) O[mt] = mfma16(vf[kb * 4 + mt], pb.v, O[mt]);
    }
}
DEV void softmax_pv_tile(bool MASK, f32x4 (&st)[4], const bf16x8 (&vf)[8], int keybase, int tcol, int lowcol, bool colsel, float& m, float& l, f32x4& L, f32x4 (&O)[4], int q4) {
    float lmax = -1e30f;
    if (MASK) {
        const int hi = colsel ? tcol : -1;
#pragma unroll
        for (int kt = 0; kt < 4; ++kt)
#pragma unroll
            for (int r = 0; r < 4; ++r) {
                const int key = keybase + kt * 16 + 4 * q4 + r;
                const bool valid = (key <= hi) && (key > lowcol);
                const float sv = valid ? st[kt][r] : -1e30f;
                st[kt][r] = sv; lmax = fmaxf(lmax, sv);
            }
    } else {
        const float cs = colsel ? 0.f : -1e30f;
#pragma unroll
        for (int kt = 0; kt < 4; ++kt)
#pragma unroll
            for (int r = 0; r < 4; ++r) { const float sv = st[kt][r] + cs; st[kt][r] = sv; lmax = fmaxf(lmax, sv); }
    }
    lmax = colmax(lmax);
    const float mnew = fmaxf(m, lmax);
    const float alpha = ex2(m - mnew);
    float psum = 0.f;
#pragma unroll
    for (int kt = 0; kt < 4; ++kt)
#pragma unroll
        for (int r = 0; r < 4; ++r) {
            float pv = ex2(st[kt][r] - mnew);
            if (MASK) pv = (st[kt][r] > -1e29f) ? pv : 0.f;
            st[kt][r] = pv; psum += pv;
        }
    l = l * alpha + psum;
    if (__any(mnew > m)) {
#pragma unroll
        for (int mt = 0; mt < 4; ++mt) { O[mt][0] *= alpha; O[mt][1] *= alpha; O[mt][2] *= alpha; O[mt][3] *= alpha; }
        L[0] *= alpha; L[1] *= alpha; L[2] *= alpha; L[3] *= alpha;
    }
    m = mnew;
#pragma unroll
    for (int kb = 0; kb < 2; ++kb) {
        union { bf16x8 v; unsigned u[4]; } pb;
        pb.u[0] = pack2(st[2 * kb][0], st[2 * kb][1]); pb.u[1] = pack2(st[2 * kb][2], st[2 * kb][3]);
        pb.u[2] = pack2(st[2 * kb + 1][0], st[2 * kb + 1][1]); pb.u[3] = pack2(st[2 * kb + 1][2], st[2 * kb + 1][3]);
#pragma unroll
        for (int mt = 0; mt < 4; ++mt) O[mt] = mfma16(vf[kb * 4 + mt], pb.v, O[mt]);
    }
}
DEV unsigned pick4(unsigned a0, unsigned a1, unsigned a2, unsigned a3, int w) { return w == 0 ? a0 : (w == 1 ? a1 : (w == 2 ? a2 : a3)); }
template <int CTRL> DEV unsigned dpp_or(unsigned x) { return x | dppu<CTRL>(x); }
DEV unsigned row_or(unsigned x) { x = dpp_or<0xB1>(x); x = dpp_or<0x4E>(x); x = dpp_or<0x124>(x); x = dpp_or<0x128>(x); return x; }


DEV void nsa_branch_lds(unsigned char* lds, const u16* __restrict__ K0, const u16* __restrict__ VT0, unsigned bu0, unsigned bu1, unsigned bu2,
                        unsigned bu3, unsigned ua0, unsigned ua1, unsigned ua2, unsigned ua3, unsigned ub0, unsigned ub1, unsigned ub2, unsigned ub3,
                        const unsigned* cm, int tokl, const int (&tcol)[2], const int (&lowc)[2], const bf16x8 (&qf)[2][2], float (&m)[2],
                        float (&l)[2], f32x4 (&L)[2], f32x4 (&O)[2][4], int q4, int cidx, int cur, int lowmax) {
    const int tid = TID();
    int w = 0; unsigned bits = bu0;
    auto advance = [&]() -> int {
        while (bits == 0u && w < 3) { ++w; bits = pick4(bu0, bu1, bu2, bu3, w); }
        if (bits == 0u) return -1;
        const int jb = __builtin_ctz(bits); bits &= bits - 1u;
        return w * 32 + jb;
    };
    const int srow0 = tid >> 3, srow1 = srow0 + 32, sch = tid & 7;
    const int so0 = srow0 * 128 + ((sch ^ (srow0 & 7)) << 4), so1 = srow1 * 128 + ((sch ^ (srow1 & 7)) << 4);
    bf16x8 r0[4], r1[4];
#define NSA_GLOAD(R, BLK_) { R[0] = ld8(K0 + ((size_t)(BLK_) * 64 + srow0) * 64 + sch * 8); R[1] = ld8(K0 + ((size_t)(BLK_) * 64 + srow1) * 64 + sch * 8); \
        R[2] = ld8(VT0 + (size_t)srow0 * 8192 + (BLK_) * 64 + sch * 8); R[3] = ld8(VT0 + (size_t)srow1 * 8192 + (BLK_) * 64 + sch * 8); }
#define NSA_LWRITE(R, BUF_) { unsigned char* wb_ = lds + (BUF_) * 16384; *(bf16x8*)(wb_ + so0) = R[0]; *(bf16x8*)(wb_ + so1) = R[1]; \
        *(bf16x8*)(wb_ + 8192 + so0) = R[2]; *(bf16x8*)(wb_ + 8192 + so1) = R[3]; }
    auto compute = [&](int blk, int buf) {
        const int wq = blk >> 5, jb = blk & 31;
        const bool act0 = (pick4(ua0, ua1, ua2, ua3, wq) >> jb) & 1u, act1 = (pick4(ub0, ub1, ub2, ub3, wq) >> jb) & 1u;
        if (act0 || act1) {
            const unsigned char* kb_ = lds + buf * 16384;
            const bool need_mask = (blk == cur) || (blk * 64 <= lowmax);
            const bool cs0 = cm ? (((cm[tokl * 4 + wq] >> jb) & 1u) != 0u) : true;
            const bool cs1 = cm ? (((cm[(4 + tokl) * 4 + wq] >> jb) & 1u) != 0u) : true;
            const bool lazy = !need_mask && !__any((act0 && m[0] < -1e29f) || (act1 && m[1] < -1e29f));
            f32x4 st0[4], st1[4];
            {
                bf16x8 kf[8];
#pragma unroll
                for (int kt = 0; kt < 4; ++kt)
#pragma unroll
                    for (int s2 = 0; s2 < 2; ++s2) {
                        const int row = 16 * kt + cidx, ch = 4 * s2 + q4;
                        kf[2 * kt + s2] = *(const bf16x8*)(kb_ + row * 128 + ((ch ^ (row & 7)) << 4));
                    }
                if (act0) qk_tile(kf, qf[0][0], qf[0][1], lazy ? (cs0 ? -m[0] : -1e30f) : 0.f, st0);
                if (act1) qk_tile(kf, qf[1][0], qf[1][1], lazy ? (cs1 ? -m[1] : -1e30f) : 0.f, st1);
            }
            __builtin_amdgcn_sched_barrier(0);
            bf16x8 vf[8];
#pragma unroll
            for (int kb = 0; kb < 2; ++kb)
#pragma unroll
                for (int mt = 0; mt < 4; ++mt) {
                    const int row = 16 * mt + cidx, ch = 4 * kb + q4;
                    vf[kb * 4 + mt] = *(const bf16x8*)(kb_ + 8192 + row * 128 + ((ch ^ (row & 7)) << 4));
                }
            if (lazy) {
                if (act0) softmax_pv_lazy(st0, vf, m[0], l[0], L[0], O[0]);
                if (act1) softmax_pv_lazy(st1, vf, m[1], l[1], L[1], O[1]);
            } else {
                if (act0) softmax_pv_tile(need_mask, st0, vf, blk * 64, tcol[0], lowc[0], cs0, m[0], l[0], L[0], O[0], q4);
                if (act1) softmax_pv_tile(need_mask, st1, vf, blk * 64, tcol[1], lowc[1], cs1, m[1], l[1], L[1], O[1], q4);
            }
        }
    };
    int b0 = advance();
    if (b0 < 0) return;
    int b1 = advance();
    NSA_GLOAD(r0, b0);
    if (b1 >= 0) NSA_GLOAD(r1, b1);
    NSA_LWRITE(r0, 0);
    __syncthreads();
#pragma unroll 1
    while (b0 >= 0) {
        const int b2 = (b1 >= 0) ? advance() : -1;
        if (b2 >= 0) NSA_GLOAD(r0, b2);
        compute(b0, 0);
        if (b1 >= 0) NSA_LWRITE(r1, 1);
        __syncthreads();
        if (b1 < 0) break;
        const int b3 = (b2 >= 0) ? advance() : -1;
        if (b3 >= 0) NSA_GLOAD(r1, b3);
        compute(b1, 1);
        if (b2 >= 0) NSA_LWRITE(r0, 0);
        __syncthreads();
        b0 = b2; b1 = b3;
    }
#undef NSA_GLOAD
#undef NSA_LWRITE
}

DEV void nsa_block_task(const Params& p, int task, unsigned char* lds) {
    const int wave = TID() >> 6;
    float* wl = (float*)(lds + 32768) + wave * 2112;
    unsigned* bm = (unsigned*)(lds + 32768 + 4 * 8448);
    float* impA = wl; float* impB = wl + 1024; unsigned* selmask = (unsigned*)(wl + 1024 + 1056);
    unsigned char* ws = p.ws;
    const u16* Q = (const u16*)(ws + OFF_Q);
    const u16* KVb = (const u16*)(ws + OFF_KV);
    const u16 *KSEL = KVb + (size_t)2 * 4194304, *VSELT = KVb + (size_t)3 * 4194304, *KWIN = KVb + (size_t)4 * 4194304, *VWINT = KVb + (size_t)5 * 4194304;
    const u16* KC = (const u16*)(ws + OFF_KC); const u16* VCT = (const u16*)(ws + OFF_VCT);
    const float* GATE = (const float*)(ws + OFF_GATE);
    u16* mix = (u16*)(ws + OFF_MIX);
    const int lane = TID() & 63, q4 = lane >> 4, cidx = lane & 15;
    const int bg = task & 7, t0b = (255 - (task >> 3)) * 32, t0 = t0b + 8 * wave; const int b = bg >> 1, g = bg & 1;
    const int tokl = cidx >> 2, hr = cidx & 3; const int head = g * 4 + hr;
    const int cur = t0 >> 6;
    int tcol[2], rowc[2]; bf16x8 qf[2][2];
#pragma unroll
    for (int ti = 0; ti < 2; ++ti) {
        tcol[ti] = t0 + 4 * ti + tokl; rowc[ti] = b * 8192 + tcol[ti];
        qf[ti][0] = ld8(Q + (size_t)rowc[ti] * 512 + head * 64 + 8 * q4); qf[ti][1] = ld8(Q + (size_t)rowc[ti] * 512 + head * 64 + 32 + 8 * q4);
    }
    f32x4 Oc[2][4];
    {
        int cnt_col[2];
#pragma unroll
        for (int ti = 0; ti < 2; ++ti) cnt_col[ti] = tcol[ti] >= 31 ? ((tcol[ti] - 31) >> 4) + 1 : 0;
        const int tmax = t0 + 7; const int cmax = tmax >= 31 ? ((tmax - 31) >> 4) + 1 : 0;
        const int ntile = (cmax + 15) >> 4;
        const u16* kcb = KC + (size_t)bg * 512 * 64;
        float ml[2] = {-1e30f, -1e30f}, ll[2] = {0.f, 0.f};
#pragma unroll 1
        for (int kt = 0; kt < ntile; ++kt) {
            const u16* kp = kcb + (kt * 16 + cidx) * 64 + 8 * q4;
            const bf16x8 k0 = ld8(kp), k1 = ld8(kp + 32);
#pragma unroll
            for (int ti = 0; ti < 2; ++ti) {
                f32x4 st = mfma16(k0, qf[ti][0], (f32x4){0.f, 0.f, 0.f, 0.f});
                st = mfma16(k1, qf[ti][1], st);
                float sv[4]; float tm = -1e30f;
#pragma unroll
                for (int r = 0; r < 4; ++r) { const int n = kt * 16 + 4 * q4 + r; sv[r] = (n < cnt_col[ti]) ? st[r] : -1e30f; tm = fmaxf(tm, sv[r]); }
                const float mn = fmaxf(ml[ti], tm);
                float ps = 0.f;
#pragma unroll
                for (int r = 0; r < 4; ++r) ps += (sv[r] > -1e29f) ? ex2(sv[r] - mn) : 0.f;
                ll[ti] = ll[ti] * ex2(ml[ti] - mn) + ps; ml[ti] = mn;
            }
        }
        float mfin[2], inv[2];
#pragma unroll
        for (int ti = 0; ti < 2; ++ti) {
            mfin[ti] = colmax(ml[ti]);
            const float lsum = colsum(ll[ti] * ex2(ml[ti] - mfin[ti]));
            inv[ti] = (cnt_col[ti] > 0) ? 1.f / lsum : 0.f;
        }
#pragma unroll
        for (int ti = 0; ti < 2; ++ti)
#pragma unroll
            for (int mt = 0; mt < 4; ++mt) Oc[ti][mt] = (f32x4){0.f, 0.f, 0.f, 0.f};
        const int npair = (ntile + 1) >> 1;
#pragma unroll 1
        for (int kp2 = 0; kp2 < npair; ++kp2) {
            const int n0 = kp2 * 32;
            const u16* kp = kcb + (n0 + cidx) * 64 + 8 * q4;
            const bf16x8 ka0 = ld8(kp), ka1 = ld8(kp + 32), kb0 = ld8(kp + 1024), kb1 = ld8(kp + 1024 + 32);
            bf16x8 vf[4];
#pragma unroll
            for (int mt = 0; mt < 4; ++mt) vf[mt] = ld8(VCT + ((size_t)bg * 64 + 16 * mt + cidx) * 512 + n0 + 8 * q4);
#pragma unroll
            for (int ti = 0; ti < 2; ++ti) {
                float pa[4], pb_[4];
                f32x4 st = mfma16(ka0, qf[ti][0], (f32x4){0.f, 0.f, 0.f, 0.f});
                st = mfma16(ka1, qf[ti][1], st);
                f32x4 su = mfma16(kb0, qf[ti][0], (f32x4){0.f, 0.f, 0.f, 0.f});
                su = mfma16(kb1, qf[ti][1], su);
#pragma unroll
                for (int r = 0; r < 4; ++r) {
                    const int n = n0 + 4 * q4 + r;
                    pa[r] = (n < cnt_col[ti]) ? ex2(st[r] - mfin[ti]) * inv[ti] : 0.f;
                    pb_[r] = (n + 16 < cnt_col[ti]) ? ex2(su[r] - mfin[ti]) * inv[ti] : 0.f;
                }
                const float owna = quadsum(pa[0] + pa[1] + pa[2] + pa[3]), tha = quadsum(pa[3]);
                const float ownb = quadsum(pb_[0] + pb_[1] + pb_[2] + pb_[3]), thb = quadsum(pb_[3]);
                if (hr == 0) {
                    const int tk = 4 * ti + tokl;
                    const int sa = (n0 >> 2) + q4, sb2 = ((n0 + 16) >> 2) + q4;
                    impA[tk * 128 + sa] = owna; impB[tk * 132 + sa + 1] = tha;
                    impA[tk * 128 + sb2] = ownb; impB[tk * 132 + sb2 + 1] = thb;
                }
                union { bf16x8 v; unsigned u[4]; } pk;
                pk.u[0] = pack2(pa[0], pa[1]); pk.u[1] = pack2(pa[2], pa[3]); pk.u[2] = pack2(pb_[0], pb_[1]); pk.u[3] = pack2(pb_[2], pb_[3]);
#pragma unroll
                for (int mt = 0; mt < 4; ++mt) Oc[ti][mt] = mfma16(vf[mt], pk.v, Oc[ti][mt]);
            }
        }
#pragma unroll
        for (int ti = 0; ti < 2; ++ti) {
            const float gc = GATE[(size_t)rowc[ti] * 24 + head];
#pragma unroll
            for (int mt = 0; mt < 4; ++mt)
#pragma unroll
                for (int r = 0; r < 4; ++r) Oc[ti][mt][r] *= gc;
        }
    }
    lds_fence();
#pragma unroll 1
    for (int rd = 0; rd < 2; ++rd) {
        const int tk = 4 * rd + q4;
        unsigned m0 = 0u, m1 = 0u, m2 = 0u, m3 = 0u;
        if (cur < 16) { m0 = (2u << cur) - 1u; }
        else {
            unsigned key[8];
#pragma unroll
            for (int i = 0; i < 8; ++i) {
                const int sblk = cidx + 16 * i;
                const bool cand = (sblk >= 1) && (sblk <= cur - 2);
                const float v = impA[tk * 128 + sblk] + impB[tk * 132 + sblk];
                key[i] = cand ? ((__float_as_uint(v) & ~0x7Fu) | (unsigned)(127 - sblk)) : 0u;
            }
            int mysel = (cidx == 0) ? 0 : (cidx == 1 ? cur - 1 : (cidx == 2 ? cur : -1));
#pragma unroll 1
            for (int it = 0; it < 13; ++it) {
                unsigned mx = key[0];
#pragma unroll
                for (int i = 1; i < 8; ++i) mx = max(mx, key[i]);
                mx = max(mx, dppu<0xB1>(mx)); mx = max(mx, dppu<0x4E>(mx)); mx = max(mx, dppu<0x124>(mx)); mx = max(mx, dppu<0x128>(mx));
                const int sblk = 127 - (int)(mx & 127u);
#pragma unroll
                for (int i = 0; i < 8; ++i) key[i] = (key[i] == mx) ? 0u : key[i];
                if (cidx == it + 3) mysel = sblk;
            }
            const unsigned bit = 1u << (mysel & 31); const int wsel = mysel >> 5;
            m0 = row_or(wsel == 0 ? bit : 0u); m1 = row_or(wsel == 1 ? bit : 0u); m2 = row_or(wsel == 2 ? bit : 0u); m3 = row_or(wsel == 3 ? bit : 0u);
        }
        if (cidx < 4) selmask[tk * 4 + cidx] = (cidx == 0) ? m0 : (cidx == 1 ? m1 : (cidx == 2 ? m2 : m3));
    }
    lds_fence();
    f32x4* accl = (f32x4*)wl;
#pragma unroll
    for (int ti = 0; ti < 2; ++ti)
#pragma unroll
        for (int mt = 0; mt < 4; ++mt) accl[(ti * 4 + mt) * 64 + lane] = Oc[ti][mt];
    {
        float m[2] = {-1e30f, -1e30f}, l[2] = {0.f, 0.f}; f32x4 Os[2][4]; f32x4 Ls[2] = {(f32x4){0.f, 0.f, 0.f, 0.f}, (f32x4){0.f, 0.f, 0.f, 0.f}};
#pragma unroll
        for (int ti = 0; ti < 2; ++ti)
#pragma unroll
            for (int mt = 0; mt < 4; ++mt) Os[ti][mt] = (f32x4){0.f, 0.f, 0.f, 0.f};
        {
            unsigned ua[4], ub[4], bu[4];
#pragma unroll
            for (int w = 0; w < 4; ++w) {
                ua[w] = __builtin_amdgcn_readfirstlane(row_or(selmask[tokl * 4 + w]));
                ub[w] = __builtin_amdgcn_readfirstlane(row_or(selmask[(4 + tokl) * 4 + w]));
            }
            if (lane < 4) bm[wave * 4 + lane] = (lane == 0) ? (ua[0] | ub[0]) : (lane == 1 ? (ua[1] | ub[1]) : (lane == 2 ? (ua[2] | ub[2]) : (ua[3] | ub[3])));
            __syncthreads();
#pragma unroll
            for (int w = 0; w < 4; ++w) bu[w] = __builtin_amdgcn_readfirstlane(bm[w] | bm[4 + w] | bm[8 + w] | bm[12 + w]);
            const int lowc[2] = {-1, -1};
            nsa_branch_lds(lds, KSEL + (size_t)bg * 8192 * 64, VSELT + (size_t)bg * 64 * 8192, bu[0], bu[1], bu[2], bu[3], ua[0], ua[1], ua[2], ua[3], ub[0],
                           ub[1], ub[2], ub[3], selmask, tokl, tcol, lowc, qf, m, l, Ls, Os, q4, cidx, cur, -1);
        }
#pragma unroll
        for (int ti = 0; ti < 2; ++ti) {
            const float sc = GATE[(size_t)rowc[ti] * 24 + 8 + head] / (colsum(l[ti]) + Ls[ti][0]);
#pragma unroll
            for (int mt = 0; mt < 4; ++mt)
#pragma unroll
                for (int r = 0; r < 4; ++r) Os[ti][mt][r] *= sc;
        }
        lds_fence();
#pragma unroll
        for (int ti = 0; ti < 2; ++ti)
#pragma unroll
            for (int mt = 0; mt < 4; ++mt) { f32x4 a = accl[(ti * 4 + mt) * 64 + lane]; a += Os[ti][mt]; accl[(ti * 4 + mt) * 64 + lane] = a; }
    }
    {
        float m[2] = {-1e30f, -1e30f}, l[2] = {0.f, 0.f}; f32x4 Ow[2][4]; f32x4 Ls[2] = {(f32x4){0.f, 0.f, 0.f, 0.f}, (f32x4){0.f, 0.f, 0.f, 0.f}};
#pragma unroll
        for (int ti = 0; ti < 2; ++ti)
#pragma unroll
            for (int mt = 0; mt < 4; ++mt) Ow[ti][mt] = (f32x4){0.f, 0.f, 0.f, 0.f};
        int wb0 = (t0 - 511) >> 6; if (wb0 < 0) wb0 = 0;
        int wbb = (t0b - 511) >> 6; if (wbb < 0) wbb = 0;
        {
            unsigned uw[4], bu[4];
#pragma unroll
            for (int w = 0; w < 4; ++w) {
                const int hi = cur - 32 * w;
                unsigned mk = 0u, mkb = 0u;
                if (hi >= 0) {
                    const unsigned upper = (hi >= 31) ? 0xffffffffu : ((2u << hi) - 1u);
                    const int lo = wb0 - 32 * w, lob = wbb - 32 * w;
                    if (lo <= 31) mk = upper & ~((lo <= 0) ? 0u : ((1u << lo) - 1u));
                    if (lob <= 31) mkb = upper & ~((lob <= 0) ? 0u : ((1u << lob) - 1u));
                }
                uw[w] = mk; bu[w] = mkb;
            }
            const int lowc[2] = {tcol[0] - 512, tcol[1] - 512};
            nsa_branch_lds(lds, KWIN + (size_t)bg * 8192 * 64, VWINT + (size_t)bg * 64 * 8192, bu[0], bu[1], bu[2], bu[3], uw[0], uw[1], uw[2], uw[3], uw[0],
                           uw[1], uw[2], uw[3], nullptr, tokl, tcol, lowc, qf, m, l, Ls, Ow, q4, cidx, cur, t0 + 7 - 512);
        }
#pragma unroll
        for (int ti = 0; ti < 2; ++ti) {
            const float sc = GATE[(size_t)rowc[ti] * 24 + 16 + head] / (colsum(l[ti]) + Ls[ti][0]);
#pragma unroll
            for (int mt = 0; mt < 4; ++mt)
#pragma unroll
                for (int r = 0; r < 4; ++r) Ow[ti][mt][r] *= sc;
        }
        lds_fence();
#pragma unroll
        for (int ti = 0; ti < 2; ++ti)
#pragma unroll
            for (int mt = 0; mt < 4; ++mt) {
                const f32x4 a = accl[(ti * 4 + mt) * 64 + lane];
                const f32x4 o = Ow[ti][mt];
                u32x2 wv; wv[0] = pack2(a[0] + o[0], a[1] + o[1]); wv[1] = pack2(a[2] + o[2], a[3] + o[3]);
                *(u32x2*)(mix + (size_t)rowc[ti] * 1024 + 512 + head * 64 + 16 * mt + 4 * q4) = wv;
            }
    }


    __syncthreads();
}

template <int N> DEV void ltmask(const float (&v)[N], float x, unsigned (&mk)[N / 32]) {
#pragma unroll
    for (int w = 0; w < N / 32; ++w) {
        unsigned a0 = 0u, a1 = 0u, a2 = 0u, a3 = 0u;
#pragma unroll
        for (int i = 0; i < 8; ++i) {
            a0 = __builtin_amdgcn_alignbit(a0, __float_as_uint(v[w * 32 + i] - x), 31);
            a1 = __builtin_amdgcn_alignbit(a1, __float_as_uint(v[w * 32 + 8 + i] - x), 31);
            a2 = __builtin_amdgcn_alignbit(a2, __float_as_uint(v[w * 32 + 16 + i] - x), 31);
            a3 = __builtin_amdgcn_alignbit(a3, __float_as_uint(v[w * 32 + 24 + i] - x), 31);
        }
        mk[w] = (a0 << 24) | (a1 << 16) | (a2 << 8) | a3;
    }
}
template <int N> DEV int count_ge(const float (&v)[N], float x) {
    unsigned mk[N / 32]; ltmask<N>(v, x, mk);
    int lt = 0;
#pragma unroll
    for (int w = 0; w < N / 32; ++w) lt += __popc(mk[w]);
    return colsumi(N - lt);
}
template <int N> DEV void refine16(const float (&v)[N], float lo, int clo, float hi, int chi, float& lo_o, float& hi_o) {
    bool done = false;
    if (clo == 16) { hi = lo; done = true; }
#pragma unroll 1
    for (int it = 0; it < 200; ++it) {
        if (__all(done)) break;
        float f = 0.5f;
        if (!(it & 1)) { f = ((float)clo - 15.5f) / (float)(clo - chi); f = fminf(fmaxf(f, 0.04f), 0.96f); }
        const float mid = lo + (hi - lo) * f;
        const bool stuck = !(mid > lo && mid < hi);
        const int c = count_ge<N>(v, mid);
        if (!done) {
            if (stuck) { if (f != 0.5f) {   } else done = true; }
            else if (c == 16) { lo = mid; hi = mid; done = true; }
            else if (c > 16) { lo = mid; clo = c; }
            else { hi = mid; chi = c; }
        }
    }
    lo_o = lo; hi_o = hi;
}
template <int N> DEV void select16(const float (&v)[N], float& lo_o, float& hi_o) {
    float mx = v[0], sm = v[0];
#pragma unroll
    for (int i = 1; i < N; ++i) { mx = fmaxf(mx, v[i]); sm += v[i]; }
    mx = colmax(mx); sm = colsum(sm);
    const float hi = mx + fabsf(mx) * 1e-6f + 1e-30f;
    float lo = sm * (1.f / (4.f * N));
    int clo = count_ge<N>(v, lo);
    if (__any(clo < 16)) {
        float mn = v[0];
#pragma unroll
        for (int i = 1; i < N; ++i) mn = fminf(mn, v[i]);
        mn = -colmax(-mn);
        if (clo < 16) { lo = mn; clo = 4 * N; }
    }
    refine16<N>(v, lo, clo, hi, 0, lo_o, hi_o);
}
DEV void col_offsets(int cntA, int cntT, int q4, int cidx, int& offA, int& offT) {
    const int g0 = __shfl(cntA, cidx), g1 = __shfl(cntA, cidx + 16), g2 = __shfl(cntA, cidx + 32), g3 = __shfl(cntA, cidx + 48);
    const int e0 = __shfl(cntT, cidx), e1 = __shfl(cntT, cidx + 16), e2 = __shfl(cntT, cidx + 32);
    offA = (q4 > 0 ? g0 : 0) + (q4 > 1 ? g1 : 0) + (q4 > 2 ? g2 : 0);
    offT = g0 + g1 + g2 + g3 + (q4 > 0 ? e0 : 0) + (q4 > 1 ? e1 : 0) + (q4 > 2 ? e2 : 0);
}

DEV void peer_topk_task2(const Params& p, int l, int task, float* wl) {
    unsigned char* ws = p.ws;
    const u16* QP = (const u16*)(ws + OFF_QP);
    const u16* K12 = (const u16*)(ws + OFF_K12) + (size_t)l * 2 * 16384;
    const int lane = TID() & 63, q4 = lane >> 4, cidx = lane & 15;
    const int tq = task * 2 + (cidx >> 3), hh = cidx & 7;
    float* scl = wl;
    float* lst = wl + 2048;
    float* vv[2] = {lst, lst + 512}; int* ii[2] = {(int*)(lst + 256), (int*)(lst + 768)};
    float* fs = lst + 1024; int* fi = (int*)(lst + 1280);
#pragma unroll 1
    for (int hf = 0; hf < 2; ++hf) {
        bf16x8 qf[4];
#pragma unroll
        for (int s2 = 0; s2 < 4; ++s2) qf[s2] = ld8(QP + (size_t)tq * 2048 + hh * 256 + hf * 128 + 32 * s2 + 8 * q4);
        float sc[32];
        const u16* kb = K12 + hf * 16384;
#pragma unroll
        for (int kt = 0; kt < 8; ++kt) {
            f32x4 st = (f32x4){0.f, 0.f, 0.f, 0.f};
#pragma unroll
            for (int s2 = 0; s2 < 4; ++s2) st = mfma16(ld8(kb + (kt * 16 + cidx) * 128 + 32 * s2 + 8 * q4), qf[s2], st);
#pragma unroll
            for (int r = 0; r < 4; ++r) sc[kt * 4 + r] = st[r];
            *(f32x4*)(scl + cidx * 128 + 16 * kt + 4 * q4) = st;
        }
        float lo, hi; select16<32>(sc, lo, hi);
        unsigned mh[1], ml_[1];
        ltmask<32>(sc, hi, mh);
        if (__all(lo == hi)) ml_[0] = mh[0]; else ltmask<32>(sc, lo, ml_);
        unsigned mA = ~mh[0], mT = ~ml_[0] & mh[0];
        int offA, offT; col_offsets(__popc(mA), __popc(mT), q4, cidx, offA, offT);
        float* vo = hf ? vv[1] : vv[0]; int* io = hf ? ii[1] : ii[0];
        while (__any(mA != 0u)) {
            if (mA) {
                const int i = __clz(mA); mA &= ~(0x80000000u >> i);
                io[cidx * 16 + offA] = 16 * (i >> 2) + 4 * q4 + (i & 3); ++offA;
            }
        }
        while (__any(mT != 0u)) {
            if (mT) {
                const int i = __clz(mT); mT &= ~(0x80000000u >> i);
                if (offT < 16) io[cidx * 16 + offT] = 16 * (i >> 2) + 4 * q4 + (i & 3);
                ++offT;
            }
        }
        lds_fence();
        {
            const int4 n4 = *(const int4*)(io + cidx * 16 + 4 * q4);
            float4 v4; v4.x = scl[cidx * 128 + n4.x]; v4.y = scl[cidx * 128 + n4.y]; v4.z = scl[cidx * 128 + n4.z]; v4.w = scl[cidx * 128 + n4.w];
            *(float4*)(vo + cidx * 16 + 4 * q4) = v4;
        }
        lds_fence();
    }
    {
        float cand[64];
        float v2r[16];
#pragma unroll
        for (int j = 0; j < 16; ++j) v2r[j] = vv[1][cidx * 16 + j];
#pragma unroll
        for (int a = 0; a < 4; ++a) {
            const float v1a = vv[0][cidx * 16 + 4 * q4 + a];
#pragma unroll
            for (int j = 0; j < 16; ++j) cand[a * 16 + j] = v1a + v2r[j];
        }
        float lo, hi;
        {
            float v2mx = v2r[0], v2mn = v2r[0];
#pragma unroll
            for (int j = 1; j < 16; ++j) { v2mx = fmaxf(v2mx, v2r[j]); v2mn = fminf(v2mn, v2r[j]); }
            float v1mx = fmaxf(fmaxf(vv[0][cidx * 16 + 4 * q4], vv[0][cidx * 16 + 4 * q4 + 1]), fmaxf(vv[0][cidx * 16 + 4 * q4 + 2], vv[0][cidx * 16 + 4 * q4 + 3]));
            float v1mn = fminf(fminf(vv[0][cidx * 16 + 4 * q4], vv[0][cidx * 16 + 4 * q4 + 1]), fminf(vv[0][cidx * 16 + 4 * q4 + 2], vv[0][cidx * 16 + 4 * q4 + 3]));
            v1mx = colmax(v1mx); v1mn = -colmax(-v1mn);
            const float smax = v1mx + v2mx;
            const float hi0 = smax + fabsf(smax) * 1e-6f + 1e-30f;
            const float lo0 = fmaxf(v1mn + v2mx, v1mx + v2mn);
            const int c0 = count_ge<64>(cand, lo0);
            refine16<64>(cand, lo0, c0, hi0, 0, lo, hi);
        }
        unsigned mh[2], ml_[2];
        ltmask<64>(cand, hi, mh);
        if (__all(lo == hi)) { ml_[0] = mh[0]; ml_[1] = mh[1]; } else ltmask<64>(cand, lo, ml_);
        unsigned mA0 = ~mh[0], mA1 = ~mh[1], mT0 = ~ml_[0] & mh[0], mT1 = ~ml_[1] & mh[1];
        int offA, offT; col_offsets(__popc(mA0) + __popc(mA1), __popc(mT0) + __popc(mT1), q4, cidx, offA, offT);
#pragma unroll
        for (int w = 0; w < 2; ++w) {
            unsigned mA = w ? mA1 : mA0;
            while (__any(mA != 0u)) {
                if (mA) {
                    const int i = __clz(mA); mA &= ~(0x80000000u >> i);
                    const int it = w * 32 + i; const int ci = (4 * q4 + (it >> 4)) * 16 + (it & 15);
                    fi[cidx * 16 + offA] = ci; ++offA;
                }
            }
        }
#pragma unroll
        for (int w = 0; w < 2; ++w) {
            unsigned mT = w ? mT1 : mT0;
            while (__any(mT != 0u)) {
                if (mT) {
                    const int i = __clz(mT); mT &= ~(0x80000000u >> i);
                    const int it = w * 32 + i; const int ci = (4 * q4 + (it >> 4)) * 16 + (it & 15);
                    if (offT < 16) fi[cidx * 16 + offT] = ci;
                    ++offT;
                }
            }
        }
    }
    lds_fence();
    {
        float s4[4]; int c4[4];
#pragma unroll
        for (int k = 0; k < 4; ++k) { c4[k] = fi[cidx * 16 + 4 * q4 + k]; s4[k] = vv[0][cidx * 16 + (c4[k] >> 4)] + vv[1][cidx * 16 + (c4[k] & 15)]; }
        float mx = fmaxf(fmaxf(s4[0], s4[1]), fmaxf(s4[2], s4[3]));
        mx = colmax(mx);
        float e4[4]; float sm = 0.f;
#pragma unroll
        for (int k = 0; k < 4; ++k) { e4[k] = __expf(s4[k] - mx); sm += e4[k]; }
        sm = colsum(sm);
        const float inv = 1.f / sm;
        int4 eo; float4 go;
        eo.x = ii[0][cidx * 16 + (c4[0] >> 4)] * 128 + ii[1][cidx * 16 + (c4[0] & 15)];
        eo.y = ii[0][cidx * 16 + (c4[1] >> 4)] * 128 + ii[1][cidx * 16 + (c4[1] & 15)];
        eo.z = ii[0][cidx * 16 + (c4[2] >> 4)] * 128 + ii[1][cidx * 16 + (c4[2] & 15)];
        eo.w = ii[0][cidx * 16 + (c4[3] >> 4)] * 128 + ii[1][cidx * 16 + (c4[3] & 15)];
        go.x = e4[0] * inv; go.y = e4[1] * inv; go.z = e4[2] * inv; go.w = e4[3] * inv;
        int* eol = (int*)(wl + 3584); float* gol = wl + 3584 + 256;
        *(int4*)(eol + cidx * 16 + 4 * q4) = eo; *(float4*)(gol + cidx * 16 + 4 * q4) = go;
    }
    lds_fence();
}

DEV float gelu_exact(float x) { return 0.5f * x * (1.f + erff(x * 0.70710678118654752f)); }
DEV void unpack8(const bf16x8 v, float* f) {
    union { bf16x8 v; unsigned u[4]; } c; c.v = v;
#pragma unroll
    for (int i = 0; i < 4; ++i) { f[2 * i] = bflo(c.u[i]); f[2 * i + 1] = bfhi(c.u[i]); }
}
DEV void peer_experts_token(const Params& p, int l, int tok, const int* el_src, const float* w_src, float* act_lds) {
    unsigned char* ws = p.ws;
    const u16* H = (const u16*)(ws + OFF_H);
    u16* Hw = (u16*)(ws + OFF_H);
    const unsigned char* U8 = ws + OFF_U8;
    const unsigned char* V8 = ws + OFF_U8 + 16 * MiB;
    const float* SU = (const float*)(ws + OFF_UVS);
    const float* SV = (const float*)(ws + OFF_UVS) + 16384;
    const float* mod = (const float*)(ws + OFF_MOD);
    const float* g2 = mod + l * 4 * 6144 + 5 * 1024;
    const int lane = TID() & 63;
    {
        const int b = tok >> 13;
        float acc[16];
#pragma unroll
        for (int i = 0; i < 16; ++i) acc[i] = 0.f;
#if EN_PEER
        unsigned hp[4]; float shq;
        {
            float hx[16];
            unpack8(ld8(H + (size_t)tok * 1024 + 16 * lane), hx);
            unpack8(ld8(H + (size_t)tok * 1024 + 16 * lane + 8), hx + 8);
            float amax = 0.f;
#pragma unroll
            for (int i = 0; i < 16; ++i) amax = fmaxf(amax, fabsf(hx[i]));
            amax = wave_max(amax);
            shq = amax > 0.f ? amax * (1.f / 127.f) : 1.f;
            const float inv = 1.f / shq;
#pragma unroll
            for (int i = 0; i < 4; ++i) {
                const int a = __float2int_rn(hx[4 * i] * inv), b2 = __float2int_rn(hx[4 * i + 1] * inv), c = __float2int_rn(hx[4 * i + 2] * inv), d = __float2int_rn(hx[4 * i + 3] * inv);
                hp[i] = ((unsigned)a & 0xffu) | (((unsigned)b2 & 0xffu) << 8) | (((unsigned)c & 0xffu) << 16) | (((unsigned)d & 0xffu) << 24);
            }
        }
        float* actf = act_lds;
        unsigned* actq = (unsigned*)(act_lds + 128);
#define PEER_LOADT(Q, T, G_) { const int el_ = el_src[((G_) >> 1) * 16 + (lane & 15)]; const int k0_ = ((G_) & 1) * 8; _Pragma("unroll") for (int k = 0; k < 8; ++k) { \
            const int e = __builtin_amdgcn_readlane(el_, k0_ + k); Q[k] = *(const u32x4*)(T + (size_t)e * 1024 + 16 * lane); } }
        {
            u32x4 qA[8], qB[8], qC[8], qD[8];
#define PEER_EVALU(Q, G_) { const int hh_ = (G_) >> 1, k0_ = ((G_) & 1) * 8; const int el = el_src[hh_ * 16 + (lane & 15)]; const float wgt = w_src[hh_ * 16 + (lane & 15)]; \
            const float sul = SU[el] * shq, wsl = wgt * SV[el]; \
            int dpart[8]; _Pragma("unroll") for (int k = 0; k < 8; ++k) { int di = 0; _Pragma("unroll") for (int i = 0; i < 4; ++i) di = __builtin_amdgcn_sdot4((int)Q[k][i], (int)hp[i], di, false); dpart[k] = di; } \
            const int dsum = reduce8_i(dpart); const int srcl = k0_ + (lane >> 3); \
            const float sul_e = __shfl(sul, srcl), wsl_e = __shfl(wsl, srcl); \
            const float actl = gelu_exact((float)dsum * sul_e) * wsl_e; \
            if ((lane & 7) == 0) actf[(G_) * 8 + (lane >> 3)] = actl; }
            PEER_LOADT(qA, U8, 0); PEER_LOADT(qB, U8, 1); PEER_LOADT(qC, U8, 2);
#pragma unroll 1
            for (int g = 0; g < 16; g += 4) {
                PEER_LOADT(qD, U8, g + 3);
                PEER_EVALU(qA, g);
                if (g + 4 < 16) PEER_LOADT(qA, U8, g + 4);
                PEER_EVALU(qB, g + 1);
                if (g + 5 < 16) PEER_LOADT(qB, U8, g + 5);
                PEER_EVALU(qC, g + 2);
                if (g + 6 < 16) PEER_LOADT(qC, U8, g + 6);
                PEER_EVALU(qD, g + 3);
            }
#undef PEER_EVALU
        }
        u32x4 vA[8], vB[8];
        PEER_LOADT(vA, V8, 0);
        lds_fence();
        float sa;
        {
            const float a0 = actf[lane], a1 = actf[lane + 64];
            const float amax = wave_max(fmaxf(fabsf(a0), fabsf(a1)));
            sa = amax > 0.f ? amax * (1.f / 127.f) : 1.f;
            const float inv = 1.f / sa;
            ((signed char*)actq)[lane] = (signed char)__float2int_rn(a0 * inv);
            ((signed char*)actq)[lane + 64] = (signed char)__float2int_rn(a1 * inv);
        }
        lds_fence();
        int iacc[16];
#pragma unroll
        for (int i = 0; i < 16; ++i) iacc[i] = 0;
        {
#define PEER_EVALV(Q, G_) { _Pragma("unroll") for (int qd = 0; qd < 2; ++qd) { const int a4 = (int)actq[(G_) * 2 + qd]; \
            _Pragma("unroll") for (int c = 0; c < 4; ++c) { \
                const unsigned w0 = Q[4 * qd][c], w1 = Q[4 * qd + 1][c], w2 = Q[4 * qd + 2][c], w3 = Q[4 * qd + 3][c]; \
                const unsigned x01l = __builtin_amdgcn_perm(w1, w0, 0x05010400u), x01h = __builtin_amdgcn_perm(w1, w0, 0x07030602u); \
                const unsigned x23l = __builtin_amdgcn_perm(w3, w2, 0x05010400u), x23h = __builtin_amdgcn_perm(w3, w2, 0x07030602u); \
                iacc[4 * c + 0] = __builtin_amdgcn_sdot4((int)__builtin_amdgcn_perm(x23l, x01l, 0x05040100u), a4, iacc[4 * c + 0], false); \
                iacc[4 * c + 1] = __builtin_amdgcn_sdot4((int)__builtin_amdgcn_perm(x23l, x01l, 0x07060302u), a4, iacc[4 * c + 1], false); \
                iacc[4 * c + 2] = __builtin_amdgcn_sdot4((int)__builtin_amdgcn_perm(x23h, x01h, 0x05040100u), a4, iacc[4 * c + 2], false); \
                iacc[4 * c + 3] = __builtin_amdgcn_sdot4((int)__builtin_amdgcn_perm(x23h, x01h, 0x07060302u), a4, iacc[4 * c + 3], false); } } }
#pragma unroll 1
            for (int g = 0; g < 16; g += 2) {
                PEER_LOADT(vB, V8, g + 1);
                PEER_EVALV(vA, g);
                if (g + 2 < 16) PEER_LOADT(vA, V8, g + 2);
                PEER_EVALV(vB, g + 1);
            }
#undef PEER_EVALV
        }
#undef PEER_LOADT
#pragma unroll
        for (int i = 0; i < 16; ++i) acc[i] = sa * (float)iacc[i];
        lds_fence();
#endif

        const int k = 16 * lane;
        float xn[16]; float ss = 0.f;
#pragma unroll
        for (int i = 0; i < 4; ++i) {
            const float4 x0 = *(const float4*)(p.out + (size_t)tok * 1024 + k + 4 * i);
            const float4 ga = *(const float4*)(g2 + b * 6144 + k + 4 * i);
            xn[4 * i] = x0.x + ga.x * acc[4 * i]; xn[4 * i + 1] = x0.y + ga.y * acc[4 * i + 1];
            xn[4 * i + 2] = x0.z + ga.z * acc[4 * i + 2]; xn[4 * i + 3] = x0.w + ga.w * acc[4 * i + 3];
        }
#pragma unroll
        for (int i = 0; i < 16; ++i) ss += xn[i] * xn[i];
        ss = wave_sum(ss);
        const float rs = rsqrtf(ss * (1.f / 1024.f) + 1e-6f);
        if (l == 0) {
            const float* n1g = p.in[I_N1G] + 1024; const float* sh = mod + 4 * 6144 + b * 6144; const float* sc = sh + 1024;
            float hv[16];
#pragma unroll
            for (int i = 0; i < 4; ++i) {
                *(float4*)(p.out + (size_t)tok * 1024 + k + 4 * i) = (float4){xn[4 * i], xn[4 * i + 1], xn[4 * i + 2], xn[4 * i + 3]};
                const float4 gg = *(const float4*)(n1g + k + 4 * i), s1 = *(const float4*)(sc + k + 4 * i), s0 = *(const float4*)(sh + k + 4 * i);
                hv[4 * i] = xn[4 * i] * rs * gg.x * (1.f + s1.x) + s0.x; hv[4 * i + 1] = xn[4 * i + 1] * rs * gg.y * (1.f + s1.y) + s0.y;
                hv[4 * i + 2] = xn[4 * i + 2] * rs * gg.z * (1.f + s1.z) + s0.z; hv[4 * i + 3] = xn[4 * i + 3] * rs * gg.w * (1.f + s1.w) + s0.w;
            }
            u32x4 w0, w1;
#pragma unroll
            for (int i = 0; i < 4; ++i) { w0[i] = pack2(hv[2 * i], hv[2 * i + 1]); w1[i] = pack2(hv[8 + 2 * i], hv[8 + 2 * i + 1]); }
            *(u32x4*)(Hw + (size_t)tok * 1024 + k) = w0; *(u32x4*)(Hw + (size_t)tok * 1024 + k + 8) = w1;
        } else {
            const float* fg = p.in[I_FG];
#pragma unroll
            for (int i = 0; i < 4; ++i) {
                const float4 gg = *(const float4*)(fg + k + 4 * i);
                *(float4*)(p.out + (size_t)tok * 1024 + k + 4 * i) = (float4){xn[4 * i] * rs * gg.x, xn[4 * i + 1] * rs * gg.y, xn[4 * i + 2] * rs * gg.z, xn[4 * i + 3] * rs * gg.w};
            }
        }
    }
}

constexpr int NPH = 20;

__global__ void __launch_bounds__(256, 2) mega(Params p) {
    __shared__ __attribute__((aligned(16))) unsigned char lds[81920 - 128];
    __shared__ int misc[8];
    int* qslot = misc;
    cg::grid_group grid = cg::this_grid();
    if (threadIdx.x < 8) misc[threadIdx.x] = 0;
    __syncthreads();
    XcdBarrier xbar = xcd_barrier_post((unsigned*)(p.ws + OFF_BAR), (volatile unsigned*)(misc + 4));
    unsigned char* ws = p.ws;
    const float* mod = (const float*)(ws + OFF_MOD);
    unsigned* ctl = (unsigned*)(ws + OFF_CTL);
    const int G = gridDim.x, bx = BID();
    for (int ph = p.ph_lo; ph < p.ph_hi; ++ph) {
        if (ph >= 2 && (ph - 2) % 9 == 8) continue;
        if (ph == 0) {
            phase_prep(p, lds);
        } else if (ph == 1) {
            phase_norm(p.in[I_X], p.in[I_N1G], mod + 0 * 1024, mod + 1 * 1024, (u16*)(ws + OFF_H));
        } else {
            const int l = (ph - 2) / 9, sp = (ph - 2) % 9;
            const float* modl = mod + l * 4 * 6144;
            if (sp == 0) {
                EpiInProj e{(u16*)(ws + OFF_PCONV), (u16*)(ws + OFF_PRWKV), (u16*)(ws + OFF_Q), (u16*)(ws + OFF_KV), (float*)(ws + OFF_GATE)};
                gemm_phase((const u16*)(ws + OFF_H), 1024, (const u16*)(ws + OFF_WIN) + (size_t)l * NINP * 1024, 1024, 256, 8, 1024, e, lds, bx, G, 0, 4);
            } else if (sp == 1) {
#if EN_RWKV
                for (int t = bx; t < NTOK / 16; t += G) { rwkv_prep_tile2(p, l, t, lds); __syncthreads(); }
#endif
            } else if (sp == 2) {
#if EN_RWKV
                if (bx < 64) { __builtin_amdgcn_s_setprio(3); rwkv_scan(p, bx, lds); __builtin_amdgcn_s_setprio(0); }
#endif
                unsigned* cdone = ctl + QW(l, 5);
                unsigned* gdone = ctl + QW(l, 6);
                if (bx >= 64) {
                    EpiInProj e{(u16*)(ws + OFF_PCONV), (u16*)(ws + OFF_PRWKV), (u16*)(ws + OFF_Q), (u16*)(ws + OFF_KV), (float*)(ws + OFF_GATE)};
                    gemm_phase((const u16*)(ws + OFF_H), 1024, (const u16*)(ws + OFF_WIN) + (size_t)l * NINP * 1024, 1024, 256, 15, 1024, e, lds, bx - 64, G - 64, 4, 8, false);
                    asm volatile("s_waitcnt vmcnt(0)" ::: "memory");
                    __syncthreads();
                    if (threadIdx.x == 0) {
                        __builtin_amdgcn_fence(__ATOMIC_RELEASE, "agent");
                        asm volatile("s_waitcnt vmcnt(0)" ::: "memory");
                        __hip_atomic_fetch_add(gdone, 1u, __ATOMIC_RELAXED, __HIP_MEMORY_SCOPE_AGENT);
                    }
                }
                __syncthreads();
                if (threadIdx.x == 0) {
                    unsigned sp_ = 0;
                    while (__hip_atomic_load(gdone, __ATOMIC_RELAXED, __HIP_MEMORY_SCOPE_AGENT) < (unsigned)(G - 64)) { __builtin_amdgcn_s_sleep(8); if (++sp_ > (1u << 24)) break; }
                    __builtin_amdgcn_fence(__ATOMIC_ACQUIRE, "agent");
                    asm volatile("s_waitcnt vmcnt(0)" ::: "memory");
                }
                __syncthreads();
                if (bx >= 64 && bx < 128) {
                    const u16* KVb = (const u16*)(ws + OFF_KV);
                    if (bx < 96) {
                        EpiCompress ek{(const float*)(ws + OFF_CBP) + (l * 2 + 0) * 2048, p.in[I_CKW2] + (size_t)l * 8192, (u16*)(ws + OFF_KC), 0, lds};
                        gemm_phase(KVb, 1024, (const u16*)(ws + OFF_CW1) + (size_t)(l * 2 + 0) * 128 * 2048, 2048, 32, 1, 2048, ek, lds, bx - 64, 1 << 20);
                    } else {
                        EpiCompress ev{(const float*)(ws + OFF_CBP) + (l * 2 + 1) * 2048, p.in[I_CVW2] + (size_t)l * 8192, (u16*)(ws + OFF_VCT), 1, lds};
                        gemm_phase(KVb + 4194304, 1024, (const u16*)(ws + OFF_CW1) + (size_t)(l * 2 + 1) * 128 * 2048, 2048, 32, 1, 2048, ev, lds, bx - 96, 1 << 20);
                    }
                    asm volatile("s_waitcnt vmcnt(0)" ::: "memory");
                    __syncthreads();
                    if (threadIdx.x == 0) {
                        __builtin_amdgcn_fence(__ATOMIC_RELEASE, "agent");
                        asm volatile("s_waitcnt vmcnt(0)" ::: "memory");
                        __hip_atomic_fetch_add(cdone, 1u, __ATOMIC_RELAXED, __HIP_MEMORY_SCOPE_AGENT);
                    }
                }
#if EN_CONV
                for (;;) { const int t = block_next(ctl + QW(l, Q_CONV), qslot); if (t >= NTOK / 32) break; conv_tile(p, l, t, lds); }
#else
                zero_mix_cols(p, 0, 256);
#endif
                __syncthreads();
                if (threadIdx.x == 0) {
                    unsigned sp_ = 0;
                    while (__hip_atomic_load(cdone, __ATOMIC_RELAXED, __HIP_MEMORY_SCOPE_AGENT) < 64u) { __builtin_amdgcn_s_sleep(8); if (++sp_ > (1u << 24)) break; }
                    __builtin_amdgcn_fence(__ATOMIC_ACQUIRE, "agent");
                    asm volatile("s_waitcnt vmcnt(0)" ::: "memory");
                }
                __syncthreads();
                for (int qi = 0; qi < 8; ++qi) {
                    const int bgq = (bx + qi) & 7;
                    for (;;) { const int t = block_next(ctl + QW(l, Q_NSA) + bgq, qslot); if (t >= 256) break; nsa_block_task(p, t * 8 + bgq, lds); }
                }
                if (l == 0) {
                    float* fl = (float*)lds;
                    for (;;) {
                        const int t = block_next(ctl + QW(0, 0), qslot); if (t >= 1536) break;
                        if (t < 512) { const int l2 = t >> 8, r = t & 255; transpose_tile(p.in[I_WOUT] + (size_t)l2 * 1024 * 1024, 1024, (u16*)(ws + OFF_WOUT) + (size_t)l2 * 1024 * 1024, 1024, r >> 4, r & 15, fl); }
                        else { const int u = t - 512; const int l2 = u >> 9, r = u & 511; transpose_tile(p.in[I_PWQ] + (size_t)l2 * 1024 * 2048, 2048, (u16*)(ws + OFF_WQ) + (size_t)l2 * 2048 * 1024, 1024, r >> 5, r & 31, fl); }
                    }
                }
                for (;;) {
                    const int t = block_next(ctl + QW(l, 7), qslot); if (t >= 1024) break;
                    const int tb = t >> 9, r0 = (t & 511) * 32;
                    convert_rows_task(p.in[tb ? I_PV : I_PU] + (size_t)l * 16384 * 1024, ws + OFF_U8 + (size_t)tb * 16 * MiB, (float*)(ws + OFF_UVS) + tb * 16384,
                                      tb ? nullptr : (int*)(ws + OFF_UVS) + 2 * 16384, r0);
                }
            } else if (sp == 3) {
#if EN_RWKV
                phase_rwkv_post(p, l);
#else
                zero_mix_cols(p, 256, 256);
#endif
            } else if (sp == 4) {
                EpiOutProj e{l == 0 ? p.in[I_X] : p.out, p.out, modl + 2 * 1024};
                gemm_phase((const u16*)(ws + OFF_MIX), 1024, (const u16*)(ws + OFF_WOUT) + (size_t)l * 1024 * 1024, 1024, 256, 8, 1024, e, lds, bx, G);
            } else if (sp == 5) {
#if EN_PEER
                phase_norm(p.out, p.in[I_N2G] + l * 1024, modl + 3 * 1024, modl + 4 * 1024, (u16*)(ws + OFF_H));
#endif
            } else if (sp == 6) {
#if EN_PEER
                EpiStoreBf16 e{(u16*)(ws + OFF_QP), 2048};
                gemm_phase((const u16*)(ws + OFF_H), 1024, (const u16*)(ws + OFF_WQ) + (size_t)l * 2048 * 1024, 1024, 256, 16, 1024, e, lds, bx, G);
#endif
            } else if (sp == 7) {
#if EN_PEER
                float* wl = (float*)lds + (TID() >> 6) * 4096;
                for (int t = bx * 4 + (TID() >> 6); t < NTOK / 2; t += G * 4) {
                    peer_topk_task2(p, l, t, wl);
                    __builtin_amdgcn_s_setprio(3);
                    peer_experts_token(p, l, 2 * t, (const int*)(wl + 3584), wl + 3584 + 256, wl);
                    peer_experts_token(p, l, 2 * t + 1, (const int*)(wl + 3584) + 128, wl + 3584 + 256 + 128, wl);
                    __builtin_amdgcn_s_setprio(0);
                    lds_fence();
                }
#endif
            }
        }
        if (ph + 1 < p.ph_hi) { if (p.ph_lo < 0) grid.sync(); else xcd_barrier(xbar); }
    }
}

extern "C" void kernel_launch(void* const* d_in, const int* in_sizes, int n_in, void* d_out, int out_size, void* d_ws, size_t ws_size,
                              hipStream_t stream) {
    static int grid_blocks = 0;
    if (!grid_blocks) {
        int dev = 0, cus = 0, per_cu = 0;
        hipGetDevice(&dev);
        hipDeviceGetAttribute(&cus, hipDeviceAttributeMultiprocessorCount, dev);
        hipOccupancyMaxActiveBlocksPerMultiprocessor(&per_cu, (const void*)mega, 256, 0);
        if (per_cu > 2) per_cu = 2;
        if (per_cu < 1) per_cu = 1;
        grid_blocks = cus * per_cu;
        if (ws_size < WS_NEED) fprintf(stderr, "kernel_launch: workspace too small: %zu < %zu\n", ws_size, (size_t)WS_NEED);
    }
    hipMemsetAsync((char*)d_ws + OFF_CTL, 0, CTL_ZERO_BYTES, stream);
    Params p{};
    for (int i = 0; i < 35; ++i) p.in[i] = (const float*)d_in[i];
    p.out = (float*)d_out;
    p.ws = (unsigned char*)d_ws;
#if MULTI_LAUNCH
    for (int ph = 0; ph < NPH; ++ph) {
        p.ph_lo = ph; p.ph_hi = ph + 1;
        hipLaunchKernelGGL(mega, dim3(grid_blocks), dim3(256), 0, stream, p);
    }
#else
    p.ph_lo = 0; p.ph_hi = NPH;
    void* args[] = {&p};
    hipError_t e = hipLaunchCooperativeKernel((const void*)mega, dim3(grid_blocks), dim3(256), args, 0, stream);
    if (e != hipSuccess) fprintf(stderr, "cooperative launch failed: %s (grid %d)\n", hipGetErrorString(e), grid_blocks);
#endif
}
```

```cpp
#include <hip/hip_runtime.h>
#include <hip/hip_cooperative_groups.h>
#include <stdint.h>
#include <stdio.h>
namespace cg = cooperative_groups;

#ifndef EN_CONV
#define EN_CONV 1
#endif
#ifndef EN_RWKV
#define EN_RWKV 1
#endif
#ifndef EN_NSA_CMP
#define EN_NSA_CMP 1
#endif
#ifndef EN_NSA_WIN
#define EN_NSA_WIN 1
#endif
#ifndef EN_NSA_SEL
#define EN_NSA_SEL 1
#endif
#ifndef EN_PEER
#define EN_PEER 1
#endif
#ifndef MULTI_LAUNCH
#define MULTI_LAUNCH 0
#endif

#define DEV __device__ __forceinline__
typedef unsigned short u16;
typedef __attribute__((ext_vector_type(8))) short bf16x8;
typedef __attribute__((ext_vector_type(4))) float f32x4;
typedef __attribute__((ext_vector_type(4))) unsigned int u32x4;
typedef __attribute__((ext_vector_type(2))) unsigned int u32x2;

constexpr int NB = 4, NT = 8192, ND = 1024, NTOK = NB * NT, NL = 2;
constexpr int NIN = 2840, NINP = 2944;
constexpr size_t MiB = 1ull << 20;

constexpr size_t OFF_CTL = 0;
constexpr size_t CTL_ZERO_BYTES = 32768;
constexpr size_t OFF_BAR = 16384;
constexpr size_t OFF_MOD = 64 * 1024;
constexpr size_t OFF_CBP = 256 * 1024;
constexpr size_t OFF_WIN = 1 * MiB;
constexpr size_t OFF_WOUT = 13 * MiB;
constexpr size_t OFF_WQ = 17 * MiB;
constexpr size_t OFF_CW1 = 25 * MiB;
constexpr size_t OFF_K12 = 27 * MiB;
constexpr size_t OFF_LW = 27 * MiB + 512 * 1024;
constexpr size_t OFF_U8 = 28 * MiB;
constexpr size_t OFF_UVS = 512 * 1024;
constexpr size_t OFF_H = 92 * MiB;
constexpr size_t OFF_MIX = 156 * MiB;
constexpr size_t OFF_E = 220 * MiB;
constexpr size_t OFF_PCONV = OFF_E + 0;
constexpr size_t OFF_PRWKV = OFF_E + 32 * MiB;
constexpr size_t OFF_YRAW = OFF_E + 32 * MiB;
constexpr size_t OFF_Q = OFF_E + 96 * MiB;
constexpr size_t OFF_KV = OFF_E + 128 * MiB;
constexpr size_t OFF_GATE = OFF_E + 176 * MiB;
constexpr size_t OFF_KC = OFF_E + 180 * MiB;
constexpr size_t OFF_VCT = OFF_KC + 512 * 1024;
constexpr size_t OFF_RV = OFF_E + 184 * MiB;
constexpr size_t OFF_RKK = OFF_E + 200 * MiB;
constexpr size_t OFF_RKKA = OFF_E + 216 * MiB;
constexpr size_t OFF_RG = OFF_E + 232 * MiB;
constexpr size_t OFF_BONUS = OFF_E + 248 * MiB;
constexpr size_t OFF_RW = OFF_E + 249 * MiB;
constexpr size_t OFF_RR = 60 * MiB;
constexpr size_t OFF_RK = 76 * MiB;
constexpr size_t OFF_QP = OFF_E + 0;
constexpr size_t OFF_HP8 = OFF_MIX;
constexpr size_t OFF_EL = OFF_MIX + 32 * MiB;
constexpr size_t OFF_GW = OFF_MIX + 40 * MiB;
constexpr size_t OFF_AQ = OFF_MIX + 56 * MiB;
constexpr size_t OFF_SHQ = OFF_MIX + 60 * MiB;
constexpr size_t OFF_SA = OFF_MIX + 61 * MiB;
constexpr size_t OFF_PART = OFF_E + 128 * MiB;
constexpr size_t OFF_PIDX = OFF_E + 128 * MiB;
constexpr size_t OFF_PGW = OFF_E + 144 * MiB;
constexpr size_t WS_NEED = OFF_E + 281 * MiB;

#define QW(l, q) (64 * ((l) * 8 + (q)))
#define PQ(l, pass, x) (1024 + 16 * (((l) * 2 + (pass)) * 8 + (x)))
enum { Q_CMP = 0, Q_CONV = 1, Q_RWP = 2, Q_NSA = 3, Q_PTK = 4 };

enum { I_X = 0, I_C, I_ADAW, I_ADAB, I_N1G, I_N2G, I_WIN, I_CDW, I_CDB, I_CGG, I_CGB, I_MU, I_W0, I_WUP, I_A0, I_AUP, I_GUP,
       I_KK, I_KA, I_RK, I_LNG, I_LNB, I_CKPOS, I_CKW1, I_CKW2, I_CVPOS, I_CVW1, I_CVW2, I_WOUT, I_PWQ, I_PK1, I_PK2, I_PU, I_PV, I_FG };

struct Params {
    const float* in[35];
    float* out;
    unsigned char* ws;
    int ph_lo, ph_hi;
};

DEV int TID() { int t = threadIdx.x; asm volatile("" : "+v"(t)); return t; }
DEV int BID() { int t = blockIdx.x; asm volatile("" : "+s"(t)); return t; }
typedef __attribute__((ext_vector_type(2))) float f32x2_t;
typedef __attribute__((ext_vector_type(2))) __bf16 bf16x2_t;
DEV unsigned pack2(float a, float b) { const f32x2_t v = {a, b}; return __builtin_bit_cast(unsigned, __builtin_convertvector(v, bf16x2_t)); }
DEV u16 f2bf(float f) { const __bf16 h = (__bf16)f; return __builtin_bit_cast(u16, h); }
DEV float bf2f(u16 h) { return __uint_as_float(((unsigned)h) << 16); }
DEV float bflo(unsigned u) { return __uint_as_float(u << 16); }
DEV float bfhi(unsigned u) { return __uint_as_float(u & 0xffff0000u); }
DEV float ex2(float x) { return __builtin_amdgcn_exp2f(x); }
DEV float sigmoidf_(float x) { return 1.f / (1.f + __expf(-x)); }

DEV f32x4 mfma16(bf16x8 a, bf16x8 b, f32x4 c) { return __builtin_amdgcn_mfma_f32_16x16x32_bf16(a, b, c, 0, 0, 0); }
template <int CTRL> DEV float dppf(float x) { return __int_as_float(__builtin_amdgcn_update_dpp(0, __float_as_int(x), CTRL, 0xF, 0xF, false)); }
template <int CTRL> DEV unsigned dppu(unsigned x) { return (unsigned)__builtin_amdgcn_update_dpp(0, (int)x, CTRL, 0xF, 0xF, false); }
DEV float reduce16(float x) { x += dppf<0xB1>(x); x += dppf<0x4E>(x); x += dppf<0x124>(x); x += dppf<0x128>(x); return x; }
DEV float quadsum(float x) { x += dppf<0xB1>(x); x += dppf<0x4E>(x); return x; }
DEV float x16_sum(float x) { auto r = __builtin_amdgcn_permlane16_swap(__float_as_uint(x), __float_as_uint(x), false, false); return __uint_as_float(r[0]) + __uint_as_float(r[1]); }
DEV float x32_sum(float x) { auto r = __builtin_amdgcn_permlane32_swap(__float_as_uint(x), __float_as_uint(x), false, false); return __uint_as_float(r[0]) + __uint_as_float(r[1]); }
DEV float x16_max(float x) { auto r = __builtin_amdgcn_permlane16_swap(__float_as_uint(x), __float_as_uint(x), false, false); return fmaxf(__uint_as_float(r[0]), __uint_as_float(r[1])); }
DEV float x32_max(float x) { auto r = __builtin_amdgcn_permlane32_swap(__float_as_uint(x), __float_as_uint(x), false, false); return fmaxf(__uint_as_float(r[0]), __uint_as_float(r[1])); }
DEV int x16_sumi(int x) { auto r = __builtin_amdgcn_permlane16_swap((unsigned)x, (unsigned)x, false, false); return (int)(r[0] + r[1]); }
DEV int x32_sumi(int x) { auto r = __builtin_amdgcn_permlane32_swap((unsigned)x, (unsigned)x, false, false); return (int)(r[0] + r[1]); }
DEV float colsum(float x) { return x32_sum(x16_sum(x)); }
DEV float colmax(float x) { return x32_max(x16_max(x)); }
DEV int colsumi(int x) { return x32_sumi(x16_sumi(x)); }
DEV float wave_sum(float v) { return x32_sum(x16_sum(reduce16(v))); }
DEV int wave_sum_i(int x) {
    x += (int)dppu<0xB1>((unsigned)x); x += (int)dppu<0x4E>((unsigned)x); x += (int)dppu<0x124>((unsigned)x); x += (int)dppu<0x128>((unsigned)x);
    return x32_sumi(x16_sumi(x));
}
DEV int reduce8_i(const int (&d)[8]) {
    int t[4];
#pragma unroll
    for (int k = 0; k < 4; ++k) {
        auto r = __builtin_amdgcn_permlane32_swap((unsigned)d[k], (unsigned)d[k + 4], false, false);
        t[k] = (int)(r[0] + r[1]);
    }
    int u[2];
#pragma unroll
    for (int k = 0; k < 2; ++k) {
        auto r = __builtin_amdgcn_permlane16_swap((unsigned)t[k], (unsigned)t[k + 2], false, false);
        u[k] = (int)(r[0] + r[1]);
    }
    const bool hi8 = (threadIdx.x & 8) != 0;
    int x = hi8 ? u[1] : u[0];
    const int y = hi8 ? u[0] : u[1];
    x += (int)dppu<0x128>((unsigned)y);
    x += (int)dppu<0xB1>((unsigned)x); x += (int)dppu<0x4E>((unsigned)x); x += (int)dppu<0x141>((unsigned)x);
    return x;
}
DEV float wave_max(float x) {
    x = fmaxf(x, dppf<0xB1>(x)); x = fmaxf(x, dppf<0x4E>(x)); x = fmaxf(x, dppf<0x124>(x)); x = fmaxf(x, dppf<0x128>(x));
    return x32_max(x16_max(x));
}
DEV void lds_fence() { asm volatile("s_waitcnt lgkmcnt(0)" ::: "memory"); }
DEV bf16x8 ld8(const u16* p) { return *(const bf16x8*)p; }

DEV int block_next(unsigned* ctr, int* slot) {
    __syncthreads();
    if (TID() == 0) *slot = (int)atomicAdd(ctr, 1u);
    __syncthreads();
    return *slot;
}

#define XB_TMO      128
#define XB_XCNT(j)  (256  + 64 * (j))
#define XB_XSUB(j)  (1280 + 64 * (j))
#define XB_XGEN(j)  (2304 + 64 * (j))
#define XB_TOP      3328
#define XB_TOPGEN   3392
#define XCD_BAR_WORDS 3456
#define XB_SPIN_CAP (1u << 22)
#define LAS __attribute__((address_space(3)))
DEV unsigned xb_ld(unsigned* p) { return __hip_atomic_load(p, __ATOMIC_RELAXED, __HIP_MEMORY_SCOPE_AGENT); }
DEV unsigned xb_add(unsigned* p, unsigned v) { return __hip_atomic_fetch_add(p, v, __ATOMIC_RELAXED, __HIP_MEMORY_SCOPE_AGENT); }
DEV unsigned xb_xcc_id() { return (unsigned)__builtin_amdgcn_s_getreg((3 << 11) | 20) & 0xFu; }
#define XB_SPIN(cond, bar) do { unsigned _sp = 0; while (cond) { __builtin_amdgcn_s_sleep(1); \
    if ((++_sp & 255u) == 0u) { if (xb_ld(&(bar)[XB_TMO])) break; if (_sp > XB_SPIN_CAP) { atomicAdd(&(bar)[XB_TMO], 1u); break; } } } } while (0)
struct XcdBarrier { unsigned* bar; unsigned x; volatile unsigned* st; };
DEV XcdBarrier xcd_barrier_post(unsigned* bar, volatile unsigned* st) {
    XcdBarrier b; b.bar = bar; b.x = xb_xcc_id(); b.st = st;
    if (threadIdx.x == 0) (void)xb_add(&bar[XB_XCNT(b.x)], 1u);
    return b;
}
DEV void xcd_barrier_complete(unsigned* bar, unsigned x, unsigned& nloc, unsigned& nx) {
    const unsigned G = gridDim.x * gridDim.y * gridDim.z;
    unsigned sum, cnt, mine, sp = 0u;
    for (;;) {
        sum = 0u; cnt = 0u; mine = 0u;
#pragma unroll
        for (unsigned j = 0; j < 16; ++j) { const unsigned c = xb_ld(&bar[XB_XCNT(j)]); sum += c; cnt += (c > 0u) ? 1u : 0u; mine = (j == x) ? c : mine; }
        if (sum == G) break;
        __builtin_amdgcn_s_sleep(1);
        if ((++sp & 255u) == 0u) { if (xb_ld(&bar[XB_TMO])) break; if (sp > XB_SPIN_CAP) { atomicAdd(&bar[XB_TMO], 1u); break; } }
    }
    nloc = mine > 0u ? mine : 1u; nx = cnt > 0u ? cnt : 1u;
}
DEV void xcd_barrier(const XcdBarrier& b) {
    asm volatile("s_waitcnt vmcnt(0)" ::: "memory");
    __syncthreads();
    if (threadIdx.x == 0) {
        unsigned* bar = b.bar;
        __builtin_amdgcn_s_waitcnt(0);
        unsigned nloc = b.st[0], nx = b.st[1];
        if (nloc == 0u) { xcd_barrier_complete(bar, b.x, nloc, nx); b.st[0] = nloc; b.st[1] = nx; }
        const unsigned old = xb_add(&bar[XB_XSUB(b.x)], 1u);
        const unsigned gen = old / nloc;
        if (old + 1u == (gen + 1u) * nloc) {
            __builtin_amdgcn_fence(__ATOMIC_RELEASE, "agent");
            asm volatile("s_waitcnt vmcnt(0)" ::: "memory");
            const unsigned og = xb_add(&bar[XB_TOP], 1u);
            const unsigned tg = og / nx;
            if (og + 1u == (tg + 1u) * nx) xb_add(&bar[XB_TOPGEN], 1u);
            else XB_SPIN(xb_ld(&bar[XB_TOPGEN]) == tg, bar);
            __builtin_amdgcn_fence(__ATOMIC_ACQUIRE, "agent");
            xb_add(&bar[XB_XGEN(b.x)], 1u);
            asm volatile("s_waitcnt vmcnt(0)" ::: "memory");
        } else {
            XB_SPIN(xb_ld(&bar[XB_XGEN(b.x)]) == gen, bar);
            __builtin_amdgcn_fence(__ATOMIC_ACQUIRE, "agent");
            asm volatile("s_waitcnt vmcnt(0)" ::: "memory");
        }
    }
    __syncthreads();
}

template <class Epi>
DEV void gemm_phase(const u16* __restrict__ A, int lda, const u16* __restrict__ Bt, int ldb, int mtiles, int ntiles, int K, Epi& epi,
                    unsigned char* lds, int bid, int nb, int nt_lo = 0, int nt_skip = 0, bool xcd_order = true) {
    const int tid = TID(), lane = tid & 63, wave = tid >> 6;
    const int wm = wave >> 1, wn = wave & 1, q4 = lane >> 4, cidx = lane & 15;
    u16* As = (u16*)lds;
    u16* Bs = (u16*)(lds + 32768);
    const int KT = K >> 6;
    const int total = mtiles * ntiles;
    const int srow = tid >> 3, sch = tid & 7;
    const bool xo_ = xcd_order && ((nb & 7) == 0) && (nb <= 4096) && ((mtiles & 7) == 0);
    const int ngroups = (ntiles + 7) >> 3;
    const int nloc = xo_ ? (nb >> 3) : 1;
    const int nvirt = xo_ ? ((mtiles >> 3) * ngroups * 64) : total;
    for (int vt = xo_ ? ((bid & 7) * 64 + (bid >> 3)) : bid; vt < nvirt; vt += xo_ ? ((((vt & 63) + nloc) < 64) ? nloc : (8 * 64 - (vt & 63) + (bid >> 3))) : nb) {
        int mt, nt;
        if (xo_) {
            const int st = vt >> 6, tt = vt & 63;
            mt = (st / ngroups) * 8 + (tt >> 3); nt = (st % ngroups) * 8 + (tt & 7);
            if (nt >= ntiles) continue;
        } else { mt = vt / ntiles; nt = vt - mt * ntiles; }
        if (nt >= nt_lo) nt += nt_skip;
        const int m0 = mt * 128, n0 = nt * 128;
        const bool sw = epi.swapped(n0 + wn * 64);
        const int xo = sw ? (32768 / 2 + wn * 64 * 64) : (wm * 64 * 64);
        const int yo = sw ? (wm * 64 * 64) : (32768 / 2 + wn * 64 * 64);
        f32x4 acc[4][4];
#pragma unroll
        for (int i = 0; i < 4; ++i)
#pragma unroll
            for (int j = 0; j < 4; ++j) acc[i][j] = (f32x4){0.f, 0.f, 0.f, 0.f};
        const u16* Ag = A + (size_t)(m0 + srow) * lda + sch * 8;
        const u16* Bg = Bt + (size_t)(n0 + srow) * ldb + sch * 8;
        bf16x8 ra0[4], rb0[4], ra1[4], rb1[4];
#define GEMM_GLOAD(RA, RB, KT_) { const int k0_ = (KT_) * 64; _Pragma("unroll") for (int i = 0; i < 4; ++i) { RA[i] = ld8(Ag + (size_t)(32 * i) * lda + k0_); RB[i] = ld8(Bg + (size_t)(32 * i) * ldb + k0_); } }
#define GEMM_LWRITE(RA, RB, BUF_) { u16* Aw_ = As + (BUF_) * 8192; u16* Bw_ = Bs + (BUF_) * 8192; _Pragma("unroll") for (int i = 0; i < 4; ++i) { const int row = srow + 32 * i; const int off = row * 64 + ((sch ^ (row & 7)) << 3); *(bf16x8*)(Aw_ + off) = RA[i]; *(bf16x8*)(Bw_ + off) = RB[i]; } }
#define GEMM_COMPUTE(BUF_) { const u16* Xb = As + (BUF_) * 8192 + xo; const u16* Yb = As + (BUF_) * 8192 + yo; _Pragma("unroll") for (int s = 0; s < 2; ++s) { bf16x8 a[4], b[4]; const int ch = s * 4 + q4; _Pragma("unroll") for (int i = 0; i < 4; ++i) { const int row = i * 16 + cidx; a[i] = *(const bf16x8*)(Xb + row * 64 + ((ch ^ (row & 7)) << 3)); b[i] = *(const bf16x8*)(Yb + row * 64 + ((ch ^ (row & 7)) << 3)); } _Pragma("unroll") for (int i = 0; i < 4; ++i) _Pragma("unroll") for (int j = 0; j < 4; ++j) acc[i][j] = mfma16(a[i], b[j], acc[i][j]); } }
        GEMM_GLOAD(ra0, rb0, 0);
        if (KT > 1) GEMM_GLOAD(ra1, rb1, 1);
        GEMM_LWRITE(ra0, rb0, 0);
        __syncthreads();
        for (int kt = 0; kt < KT; kt += 2) {
            if (kt + 2 < KT) GEMM_GLOAD(ra0, rb0, kt + 2);
            GEMM_COMPUTE(0);
            GEMM_LWRITE(ra1, rb1, 1);
            __syncthreads();
            if (kt + 3 < KT) GEMM_GLOAD(ra1, rb1, kt + 3);
            GEMM_COMPUTE(1);
            if (kt + 2 < KT) GEMM_LWRITE(ra0, rb0, 0);
            __syncthreads();
        }
#undef GEMM_GLOAD
#undef GEMM_LWRITE
#undef GEMM_COMPUTE
        if (!sw) {
#pragma unroll
            for (int i = 0; i < 4; ++i)
#pragma unroll
                for (int j = 0; j < 4; ++j) epi.rows4(m0 + wm * 64 + i * 16 + q4 * 4, n0 + wn * 64 + j * 16 + cidx, acc[i][j]);
        } else {
#pragma unroll
            for (int i = 0; i < 4; ++i)
#pragma unroll
                for (int j = 0; j < 4; ++j) epi.cols4(m0 + wm * 64 + j * 16 + cidx, n0 + wn * 64 + i * 16 + q4 * 4, acc[i][j]);
        }
        epi.finish(m0, n0, lds);
    }
}

struct EpiInProj {
    u16 *pconv, *prwkv, *q, *kv; float* gate;
    DEV bool swapped(int c0) const { return !((c0 >= 2432 && c0 < 2560) || (c0 >= 2688 && c0 < 2816)); }
    DEV void rows4(int row0, int col, f32x4 v) const {
        const int c = col - 2048; const int idx = c >> 7; const int g = (c >> 6) & 1; const int d = c & 63;
        const int b = row0 >> 13; const int t0 = row0 & 8191; const int bg = b * 2 + g;
        u16* base = kv + (size_t)idx * 4194304;
        const int k = t0 & 31; const int p0 = 8 * ((k & 15) >> 2) + 4 * (k >> 4);
        u32x2 w; w[0] = pack2(v[0], v[1]); w[1] = pack2(v[2], v[3]);
        *(u32x2*)(base + (size_t)(bg * 64 + d) * 8192 + (t0 & ~31) + p0) = w;
    }
    DEV void cols4(int row, int col0, f32x4 v) const {
        if (col0 < 512) {
            u32x2 w; w[0] = pack2(v[0], v[1]); w[1] = pack2(v[2], v[3]);
            *(u32x2*)(pconv + (size_t)row * 512 + col0) = w;
        } else if (col0 < 1536) {
            u32x2 w; w[0] = pack2(v[0], v[1]); w[1] = pack2(v[2], v[3]);
            *(u32x2*)(prwkv + (size_t)row * 1024 + (col0 - 512)) = w;
        } else if (col0 < 2048) {
            const float sc = 0.18033688011112042f;
            u32x2 w; w[0] = pack2(v[0] * sc, v[1] * sc); w[1] = pack2(v[2] * sc, v[3] * sc);
            *(u32x2*)(q + (size_t)row * 512 + (col0 - 1536)) = w;
        } else if (col0 < 2816) {
            const int c = col0 - 2048; const int idx = c >> 7; const int g = (c >> 6) & 1; const int d = c & 63;
            const int b = row >> 13; const int t = row & 8191; const int bg = b * 2 + g;
            u32x2 w; w[0] = pack2(v[0], v[1]); w[1] = pack2(v[2], v[3]);
            *(u32x2*)(kv + (size_t)idx * 4194304 + ((size_t)bg * 8192 + t) * 64 + d) = w;
        } else if (col0 < 2840) {
            *(float4*)(gate + (size_t)row * 24 + (col0 - 2816)) = (float4){sigmoidf_(v[0]), sigmoidf_(v[1]), sigmoidf_(v[2]), sigmoidf_(v[3])};
        }
    }
    DEV void finish(int, int, unsigned char*) const {}
};

struct EpiOutProj {
    const float* xold; float* xnew; const float* g1;
    DEV bool swapped(int) const { return true; }
    DEV void rows4(int, int, f32x4) const {}
    DEV void cols4(int row, int col0, f32x4 v) const {
        const int b = row >> 13; const float4 gg = *(const float4*)(g1 + b * 6144 + col0);
        const size_t o = (size_t)row * 1024 + col0;
        const float4 x = *(const float4*)(xold + o);
        *(float4*)(xnew + o) = (float4){x.x + gg.x * v[0], x.y + gg.y * v[1], x.z + gg.z * v[2], x.w + gg.w * v[3]};
    }
    DEV void finish(int, int, unsigned char*) const {}
};

struct EpiStoreBf16 {
    u16* out; int ld;
    DEV bool swapped(int) const { return true; }
    DEV void rows4(int, int, f32x4) const {}
    DEV void cols4(int row, int col0, f32x4 v) const {
        u32x2 w; w[0] = pack2(v[0], v[1]); w[1] = pack2(v[2], v[3]);
        *(u32x2*)(out + (size_t)row * ld + col0) = w;
    }
    DEV void finish(int, int, unsigned char*) const {}
};

struct EpiCompress {
    const float* cbp;
    const float* w2;
    u16* outp;
    int isv;
    unsigned char* lds;
    DEV bool swapped(int) const { return false; }
    DEV void cols4(int, int, f32x4) const {}
    DEV void rows4(int row0, int col, f32x4 v) const {
        float* hid = (float*)lds;
        const int rl = row0 & 127;
#pragma unroll
        for (int r = 0; r < 4; ++r) hid[(rl + r) * 128 + col] = v[r];
    }
    DEV void finish(int m0, int, unsigned char*) const {
        __syncthreads();
        {
            float* hw = (float*)lds;
            const int t = TID(); const int c = t & 127, r0 = (t >> 7) * 64;
            float bias = 0.f;
#pragma unroll
            for (int s = 0; s < 16; ++s) bias += cbp[s * 128 + c];
#pragma unroll 4
            for (int r = 0; r < 64; ++r) { const float x = hw[(r0 + r) * 128 + c] + bias; hw[(r0 + r) * 128 + c] = x * sigmoidf_(x); }
        }
        __syncthreads();
        const float* hid = (const float*)lds;
        const int tid = TID(); const int d = tid & 63, rgp = tid >> 6;
        float acc[32];
#pragma unroll
        for (int i = 0; i < 32; ++i) acc[i] = 0.f;
#pragma unroll 1
        for (int j0 = 0; j0 < 128; j0 += 8) {
            float wv[8];
#pragma unroll
            for (int jj = 0; jj < 8; ++jj) wv[jj] = w2[(j0 + jj) * 64 + d];
#pragma unroll
            for (int rr = 0; rr < 32; ++rr) {
                const float4 h0 = *(const float4*)(hid + (rgp * 32 + rr) * 128 + j0), h1 = *(const float4*)(hid + (rgp * 32 + rr) * 128 + j0 + 4);
                acc[rr] += h0.x * wv[0] + h0.y * wv[1] + h0.z * wv[2] + h0.w * wv[3] + h1.x * wv[4] + h1.y * wv[5] + h1.z * wv[6] + h1.w * wv[7];
            }
        }
#pragma unroll
        for (int rr = 0; rr < 32; ++rr) {
            const int m = m0 + rgp * 32 + rr; const int bg = m >> 9, n = m & 511;
            const u16 val = (n == 511) ? (u16)0 : f2bf(acc[rr]);
            if (!isv) outp[((size_t)bg * 512 + n) * 64 + d] = val;
            else {
                const int k = n & 31; const int pp = 8 * ((k & 15) >> 2) + (k & 3) + 4 * (k >> 4);
                outp[((size_t)bg * 64 + d) * 512 + (n & ~31) + pp] = val;
            }
        }
        __syncthreads();
    }
};

DEV void transpose_tile(const float* __restrict__ src, int N, u16* __restrict__ dst, int ldk, int kt, int nt, float* tl) {
    const int tid = TID(); const int k0 = kt * 64, n0 = nt * 64;
#pragma unroll 4
    for (int i = 0; i < 16; ++i) {
        const int idx = tid + 256 * i; const int kr = idx >> 6, nc = idx & 63; const int n = n0 + nc;
        tl[kr * 65 + nc] = (n < N) ? src[(size_t)(k0 + kr) * N + n] : 0.f;
    }
    __syncthreads();
#pragma unroll 4
    for (int i = 0; i < 16; ++i) {
        const int idx = tid + 256 * i; const int nr = idx >> 6, kc = idx & 63;
        dst[(size_t)(n0 + nr) * ldk + k0 + kc] = f2bf(tl[kc * 65 + nr]);
    }
    __syncthreads();
}

DEV void convert_straight(const float* __restrict__ src, u16* __restrict__ dst, size_t n) {
    const size_t stride = (size_t)gridDim.x * 256 * 8;
    for (size_t i = ((size_t)BID() * 256 + TID()) * 8; i < n; i += stride) {
        const float4 a = *(const float4*)(src + i); const float4 b = *(const float4*)(src + i + 4);
        u32x4 w; w[0] = pack2(a.x, a.y); w[1] = pack2(a.z, a.w); w[2] = pack2(b.x, b.y); w[3] = pack2(b.z, b.w);
        *(u32x4*)(dst + i) = w;
    }
}

DEV void convert_rows_task(const float* __restrict__ src, unsigned char* __restrict__ dst, float* __restrict__ scale, int* __restrict__ rowsum, int row0) {
    const int lane = TID() & 63, wave = TID() >> 6;
#pragma unroll 1
    for (int it = 0; it < 4; ++it) {
        float4 v[2][4]; float amax[2] = {0.f, 0.f};
#pragma unroll
        for (int u = 0; u < 2; ++u) {
            const int row = row0 + wave * 8 + it * 2 + u;
#pragma unroll
            for (int i = 0; i < 4; ++i) v[u][i] = *(const float4*)(src + (size_t)row * 1024 + 16 * lane + 4 * i);
        }
#pragma unroll
        for (int u = 0; u < 2; ++u) {
#pragma unroll
            for (int i = 0; i < 4; ++i)
                amax[u] = fmaxf(amax[u], fmaxf(fmaxf(fabsf(v[u][i].x), fabsf(v[u][i].y)), fmaxf(fabsf(v[u][i].z), fabsf(v[u][i].w))));
            amax[u] = wave_max(amax[u]);
            const int row = row0 + wave * 8 + it * 2 + u;
            const float sc = amax[u] > 0.f ? amax[u] * (1.f / 127.f) : 1.f;
            const float inv = 1.f / sc;
            u32x4 w;
#pragma unroll
            for (int i = 0; i < 4; ++i) {
                const int a = __float2int_rn(v[u][i].x * inv), b = __float2int_rn(v[u][i].y * inv), c = __float2int_rn(v[u][i].z * inv), d = __float2int_rn(v[u][i].w * inv);
                w[i] = ((unsigned)a & 0xffu) | (((unsigned)b & 0xffu) << 8) | (((unsigned)c & 0xffu) << 16) | (((unsigned)d & 0xffu) << 24);
            }
            *(u32x4*)(dst + (size_t)(lane >> 3) * (2 * MiB) + (size_t)row * 128 + 16 * (lane & 7)) = w;
            if (lane == 0) scale[row] = sc;
        }
    }
}

DEV void phase_prep(const Params& p, unsigned char* lds) {
    const int tid = TID();
    float* fl = (float*)lds;
    unsigned char* ws = p.ws;
    for (int task = BID(); task < 192; task += gridDim.x) {
        const int l = task / 96, cgp = task % 96;
        float* cs = fl;
        float* red = fl + 4096;
        for (int i = tid; i < 4096; i += 256) { const float c = p.in[I_C][i]; cs[i] = c / (1.f + __expf(-c)); }
        __syncthreads();
        const int col = cgp * 64 + (tid & 63), ks = tid >> 6;
        float a0 = 0, a1 = 0, a2 = 0, a3 = 0;
        const float* w = p.in[I_ADAW] + ((size_t)l * 1024 + ks * 256) * 6144 + col;
#pragma unroll 32
        for (int k = 0; k < 256; ++k) {
            const float wv = w[(size_t)k * 6144]; const int kk = ks * 256 + k;
            a0 += cs[kk] * wv; a1 += cs[1024 + kk] * wv; a2 += cs[2048 + kk] * wv; a3 += cs[3072 + kk] * wv;
        }
        red[(ks * 4 + 0) * 64 + (tid & 63)] = a0; red[(ks * 4 + 1) * 64 + (tid & 63)] = a1;
        red[(ks * 4 + 2) * 64 + (tid & 63)] = a2; red[(ks * 4 + 3) * 64 + (tid & 63)] = a3;
        __syncthreads();
        {
            const int b = tid >> 6, c = tid & 63;
            const float s = red[(0 * 4 + b) * 64 + c] + red[(1 * 4 + b) * 64 + c] + red[(2 * 4 + b) * 64 + c] + red[(3 * 4 + b) * 64 + c];
            const int colg = cgp * 64 + c;
            ((float*)(ws + OFF_MOD))[(l * 4 + b) * 6144 + colg] = s + p.in[I_ADAB][l * 6144 + colg];
        }
        __syncthreads();
    }
    for (int task = BID(); task < 64; task += gridDim.x) {
        const int l = task >> 5, kv = (task >> 4) & 1, s = task & 15;
        const float* pos = p.in[kv ? I_CVPOS : I_CKPOS] + l * 2048;
        const float* w1 = p.in[kv ? I_CVW1 : I_CKW1] + (size_t)l * 2048 * 128;
        const int col = tid & 127, half = tid >> 7;
        float a = 0;
        const int i0 = s * 128 + half * 64;
#pragma unroll 8
        for (int i = 0; i < 64; ++i) a += pos[i0 + i] * w1[(size_t)(i0 + i) * 128 + col];
        fl[tid] = a;
        __syncthreads();
        if (tid < 128) ((float*)(ws + OFF_CBP))[((l * 2 + kv) * 16 + s) * 128 + tid] = fl[tid] + fl[tid + 128];
        __syncthreads();
    }
    {
        for (int task = BID(); task < 2 * 16 * 46; task += gridDim.x) {
            const int l = task / (16 * 46), r = task % (16 * 46);
            transpose_tile(p.in[I_WIN] + (size_t)l * 1024 * NIN, NIN, (u16*)(ws + OFF_WIN) + (size_t)l * NINP * 1024, 1024, r / 46, r % 46, fl);
        }
        for (int task = BID(); task < 2 * 16; task += gridDim.x) {
            const int l = task >> 4, r = task & 15; const int nt = r & 3, part = r >> 2;
            u16* dst = (u16*)(ws + OFF_LW) + (size_t)l * 65536;
            if (part == 0) transpose_tile(p.in[I_WUP] + (size_t)l * 64 * 256, 256, dst, 256, 0, nt, fl);
            else if (part == 1) transpose_tile(p.in[I_AUP] + (size_t)l * 64 * 256, 256, dst + 64, 256, 0, nt, fl);
            else transpose_tile(p.in[I_GUP] + (size_t)l * 128 * 256, 256, dst + 128, 256, part - 2, nt, fl);
        }
        for (int task = BID(); task < 4 * 32 * 2; task += gridDim.x) {
            const int lk = task >> 6, r = task & 63; const int l = lk >> 1, kv = lk & 1;
            transpose_tile(p.in[kv ? I_CVW1 : I_CKW1] + (size_t)l * 2048 * 128, 128, (u16*)(ws + OFF_CW1) + (size_t)lk * 128 * 2048, 2048, r >> 1, r & 1, fl);
        }
    }
    for (int l = 0; l < 2; ++l) {
        convert_straight(p.in[I_PK1] + l * 16384, (u16*)(ws + OFF_K12) + (l * 2 + 0) * 16384, 16384);
        convert_straight(p.in[I_PK2] + l * 16384, (u16*)(ws + OFF_K12) + (l * 2 + 1) * 16384, 16384);
    }
}

DEV void phase_norm(const float* __restrict__ x, const float* __restrict__ g, const float* __restrict__ sh, const float* __restrict__ sc,
                    u16* __restrict__ h) {
    const int lane = TID() & 63;
    const int gw = BID() * 4 + (TID() >> 6), nw = gridDim.x * 4;
    for (int row0 = gw * 2; row0 < NTOK; row0 += nw * 2) {
        float4 v[2][4]; float ss[2] = {0.f, 0.f};
#pragma unroll
        for (int u = 0; u < 2; ++u)
#pragma unroll
            for (int i = 0; i < 4; ++i) v[u][i] = *(const float4*)(x + (size_t)(row0 + u) * 1024 + 256 * i + lane * 4);
#pragma unroll
        for (int u = 0; u < 2; ++u) {
#pragma unroll
            for (int i = 0; i < 4; ++i) ss[u] += v[u][i].x * v[u][i].x + v[u][i].y * v[u][i].y + v[u][i].z * v[u][i].z + v[u][i].w * v[u][i].w;
            ss[u] = wave_sum(ss[u]);
        }
#pragma unroll
        for (int u = 0; u < 2; ++u) {
            const int row = row0 + u; const int b = row >> 13;
            const float rs = rsqrtf(ss[u] * (1.f / 1024.f) + 1e-6f);
#pragma unroll
            for (int i = 0; i < 4; ++i) {
                const int k = 256 * i + lane * 4;
                const float4 gg = *(const float4*)(g + k); const float4 s1 = *(const float4*)(sc + b * 6144 + k); const float4 s0 = *(const float4*)(sh + b * 6144 + k);
                u32x2 w;
                w[0] = pack2(v[u][i].x * rs * gg.x * (1.f + s1.x) + s0.x, v[u][i].y * rs * gg.y * (1.f + s1.y) + s0.y);
                w[1] = pack2(v[u][i].z * rs * gg.z * (1.f + s1.z) + s0.z, v[u][i].w * rs * gg.w * (1.f + s1.w) + s0.w);
                *(u32x2*)(h + (size_t)row * 1024 + k) = w;
            }
        }
    }
}

DEV void conv_tile(const Params& p, int l, int tile, unsigned char* lds) {
    float* ul = (float*)lds;
    const int tid = TID();
    unsigned char* ws = p.ws;
    const u16* pconv = (const u16*)(ws + OFF_PCONV);
    u16* mix = (u16*)(ws + OFF_MIX);
    const int t0g = tile * 32; const int tb = t0g & 8191;
#pragma unroll 8
    for (int rr = 0; rr < 62; ++rr) {
        const int trow = tb - 30 + rr;
        float u = 0.f;
        if (trow >= 0) {
            const size_t o = (size_t)(t0g - 30 + rr) * 512;
            const float val = bf2f(pconv[o + tid]), gt = bf2f(pconv[o + 256 + tid]);
            u = val * sigmoidf_(gt);
        }
        ul[rr * 256 + tid] = u;
    }
    __syncthreads();
    float w[31];
#pragma unroll
    for (int j = 0; j < 31; ++j) w[j] = p.in[I_CDW][(l * 31 + j) * 256 + tid];
    const float bias = p.in[I_CDB][l * 256 + tid], gg = p.in[I_CGG][l * 256 + tid], gb = p.in[I_CGB][l * 256 + tid];
    for (int tt = 0; tt < 32; ++tt) {
        float y = bias;
#pragma unroll
        for (int j = 0; j < 31; ++j) y += ul[(tt + j) * 256 + tid] * w[j];
        const float mean = wave_sum(y) * (1.f / 64.f);
        const float d = y - mean;
        const float var = wave_sum(d * d) * (1.f / 64.f);
        float o = d * rsqrtf(var + 1e-5f) * gg + gb;
        o = o * sigmoidf_(o);
        mix[(size_t)(t0g + tt) * 1024 + tid] = f2bf(o);
    }
}

DEV float softplusf_(float x) { return x > 20.f ? x : log1pf(__expf(x)); }
DEV void rwkv_prep_tile2(const Params& p, int l, int tile, unsigned char* lds) {
    u16* actb = (u16*)lds;
    const int tid = TID(), lane = tid & 63, wave = tid >> 6, q4 = lane >> 4, cidx = lane & 15;
    unsigned char* ws = p.ws;
    const u16* pr = (const u16*)(ws + OFF_PRWKV);
    const float* mu = p.in[I_MU] + l * 1024;
    const int R0 = tile * 16;
    {
        const int col = 768 + tid; const float muc = mu[col];
        u16 raw[17];
        const bool first = ((R0 & 8191) == 0);
        raw[0] = first ? (u16)0 : pr[(size_t)(R0 - 1) * 1024 + col];
#pragma unroll
        for (int tk = 0; tk < 16; ++tk) raw[tk + 1] = pr[(size_t)(R0 + tk) * 1024 + col];
#pragma unroll
        for (int tk = 0; tk < 16; ++tk) {
            const float cur = bf2f(raw[tk + 1]), prev = bf2f(raw[tk]);
            const float x = cur + (prev - cur) * muc;
            float a;
            if (tid < 64) a = tanhf(x); else if (tid < 128) a = x; else a = sigmoidf_(x);
            actb[tk * 264 + tid] = f2bf(a);
        }
    }
    __syncthreads();
    f32x4 accw[4], acca[4], accg[4];
    {
        bf16x8 af[8];
#pragma unroll
        for (int s2 = 0; s2 < 8; ++s2) af[s2] = *(const bf16x8*)(actb + cidx * 264 + 32 * s2 + 8 * q4);
        const u16* LW = (const u16*)(ws + OFF_LW) + (size_t)l * 65536;
        const f32x4 z = (f32x4){0.f, 0.f, 0.f, 0.f};
#pragma unroll
        for (int nt = 0; nt < 4; ++nt) {
            const u16* bp = LW + (size_t)(64 * wave + 16 * nt + cidx) * 256 + 8 * q4;
            accw[nt] = mfma16(af[0], ld8(bp), z); accw[nt] = mfma16(af[1], ld8(bp + 32), accw[nt]);
            acca[nt] = mfma16(af[2], ld8(bp + 64), z); acca[nt] = mfma16(af[3], ld8(bp + 96), acca[nt]);
            accg[nt] = mfma16(af[4], ld8(bp + 128), z); accg[nt] = mfma16(af[5], ld8(bp + 160), accg[nt]);
            accg[nt] = mfma16(af[6], ld8(bp + 192), accg[nt]); accg[nt] = mfma16(af[7], ld8(bp + 224), accg[nt]);
        }
    }
    float* RW = (float*)(ws + OFF_RW);
    u16 *RR = (u16*)(ws + OFF_RR), *RK = (u16*)(ws + OFF_RK), *RV = (u16*)(ws + OFF_RV), *RKK = (u16*)(ws + OFF_RKK), *RKKA = (u16*)(ws + OFF_RKKA),
        *RG = (u16*)(ws + OFF_RG);
    float* BON = (float*)(ws + OFF_BONUS);
    float w0[4], a0[4], kkc[4], kac[4], rkc[4], mur[4], muk[4], muv[4];
#pragma unroll
    for (int nt = 0; nt < 4; ++nt) {
        const int c = 64 * wave + 16 * nt + cidx;
        w0[nt] = p.in[I_W0][l * 256 + c]; a0[nt] = p.in[I_A0][l * 256 + c]; kkc[nt] = p.in[I_KK][l * 256 + c]; kac[nt] = p.in[I_KA][l * 256 + c];
        rkc[nt] = p.in[I_RK][l * 256 + c]; mur[nt] = mu[c]; muk[nt] = mu[256 + c]; muv[nt] = mu[512 + c];
    }
    u16 ld3[5][4][3];
    {
        const int rowb = R0 + 4 * q4; const bool firstrow = ((rowb & 8191) == 0);
#pragma unroll
        for (int rr_ = 0; rr_ < 5; ++rr_)
#pragma unroll
            for (int nt = 0; nt < 4; ++nt) {
                const int c = 64 * wave + 16 * nt + cidx;
                const u16* cr = pr + (size_t)(rowb - 1 + rr_) * 1024;
                const bool z = (rr_ == 0) && firstrow;
                ld3[rr_][nt][0] = z ? (u16)0 : cr[c]; ld3[rr_][nt][1] = z ? (u16)0 : cr[256 + c]; ld3[rr_][nt][2] = z ? (u16)0 : cr[512 + c];
            }
    }
#pragma unroll
    for (int r = 0; r < 4; ++r) {
        const int row = R0 + 4 * q4 + r;
        float rr[4], kf_[4], vf_[4], av[4], kkv[4], keff[4], dec[4];
        float kk2 = 0.f, bn = 0.f;
#pragma unroll
        for (int nt = 0; nt < 4; ++nt) {
            float rv = bf2f(ld3[r + 1][nt][0]), kv = bf2f(ld3[r + 1][nt][1]), vv = bf2f(ld3[r + 1][nt][2]);
            const float rp = bf2f(ld3[r][nt][0]), kp = bf2f(ld3[r][nt][1]), vp = bf2f(ld3[r][nt][2]);
            rv += (rp - rv) * mur[nt]; kv += (kp - kv) * muk[nt]; vv += (vp - vv) * muv[nt];
            const float wl = w0[nt] + accw[nt][r];
            const float wlog = -softplusf_(-wl) - 0.5f;
            dec[nt] = __expf(-__expf(wlog));
            av[nt] = sigmoidf_(a0[nt] + acca[nt][r]);
            kkv[nt] = kv * kkc[nt]; kk2 += kkv[nt] * kkv[nt];
            keff[nt] = kv * (1.f + (av[nt] - 1.f) * kac[nt]);
            bn += rv * keff[nt] * rkc[nt];
            rr[nt] = rv; kf_[nt] = kv; vf_[nt] = vv;
        }
        kk2 = reduce16(kk2); bn = reduce16(bn);
        const float inv = 1.f / fmaxf(sqrtf(kk2), 1e-12f);
#pragma unroll
        for (int nt = 0; nt < 4; ++nt) {
            const int c = 64 * wave + 16 * nt + cidx;
            const size_t o = (size_t)row * 256 + c;
            const float kk = kkv[nt] * inv;
            RW[o] = dec[nt]; RR[o] = f2bf(rr[nt]); RK[o] = f2bf(keff[nt]); RV[o] = f2bf(vf_[nt]); RKK[o] = f2bf(kk); RKKA[o] = f2bf(kk * av[nt]);
            RG[o] = f2bf(accg[nt][r]);
        }
        if (cidx == 0) BON[(size_t)row * 4 + wave] = bn;
    }
}

DEV void rwkv_scan(const Params& p, int sb, unsigned char* lds) {
    unsigned char* ws = p.ws;
    const float* RW = (const float*)(ws + OFF_RW);
    const u16 *RR = (const u16*)(ws + OFF_RR), *RK = (const u16*)(ws + OFF_RK), *RV = (const u16*)(ws + OFF_RV), *RKK = (const u16*)(ws + OFF_RKK),
              *RKKA = (const u16*)(ws + OFF_RKKA);
    float* YR = (float*)(ws + OFF_YRAW);
    const int tid = TID(), lane = tid & 63, wave = tid >> 6;
    const int bh = sb >> 2, rg = sb & 3; const int b = bh >> 2, hh = bh & 3;
    float* L = (float*)lds;
    constexpr int BUFSZ = 5 * 1024 + 256;
    float* Yb = L + 2 * BUFSZ;
    const int row_local = 4 * wave + (lane >> 4); const int kq = (lane & 15) * 4;
    const int lstep = tid >> 4, lk = (tid & 15) * 4;
    const int vstep = tid >> 4, vrow = tid & 15;
    const size_t gbase = (size_t)b * 8192 * 256 + hh * 64;
    float4 lw; u32x2 lr, lkk, lkka, lk_; u16 lv;
    auto issue = [&](int c) {
        const size_t o = gbase + (size_t)(c * 16 + lstep) * 256 + lk;
        lw = *(const float4*)(RW + o);
        lr = *(const u32x2*)(RR + o); lk_ = *(const u32x2*)(RK + o); lkk = *(const u32x2*)(RKK + o); lkka = *(const u32x2*)(RKKA + o);
        lv = RV[gbase + (size_t)(c * 16 + vstep) * 256 + rg * 16 + vrow];
    };
    auto commit = [&](int buf) {
        float* B = L + buf * BUFSZ;
        const int o = lstep * 64 + lk;
        *(float4*)(B + o) = lw;
        *(float4*)(B + 1024 + o) = (float4){bflo(lkka[0]), bfhi(lkka[0]), bflo(lkka[1]), bfhi(lkka[1])};
        *(float4*)(B + 2048 + o) = (float4){bflo(lk_[0]), bfhi(lk_[0]), bflo(lk_[1]), bfhi(lk_[1])};
        *(float4*)(B + 3072 + o) = (float4){bflo(lr[0]), bfhi(lr[0]), bflo(lr[1]), bfhi(lr[1])};
        *(float4*)(B + 4096 + o) = (float4){bflo(lkk[0]), bfhi(lkk[0]), bflo(lkk[1]), bfhi(lkk[1])};
        B[5120 + vstep * 16 + vrow] = bf2f(lv);
    };
    __syncthreads();
    issue(0); commit(0);
    __syncthreads();
    float S0 = 0.f, S1 = 0.f, S2 = 0.f, S3 = 0.f;
    constexpr int NCH = NT / 16;
    for (int c = 0; c < NCH; ++c) {
        const int buf = c & 1;
        if (c + 1 < NCH) issue(c + 1);
        const float* B = L + buf * BUFSZ;
        float* Y = Yb + buf * 256;
        float yv[16];
        float4 w4 = *(const float4*)(B + kq), a4 = *(const float4*)(B + 1024 + kq), k4 = *(const float4*)(B + 2048 + kq),
               r4 = *(const float4*)(B + 3072 + kq), n4 = *(const float4*)(B + 4096 + kq);
        float vv = B[5120 + row_local];
#pragma unroll
        for (int st = 0; st < 16; ++st) {
            float4 w4n, a4n, k4n, r4n, n4n; float vvn;
            if (st < 15) {
                w4n = *(const float4*)(B + (st + 1) * 64 + kq); a4n = *(const float4*)(B + 1024 + (st + 1) * 64 + kq);
                k4n = *(const float4*)(B + 2048 + (st + 1) * 64 + kq); r4n = *(const float4*)(B + 3072 + (st + 1) * 64 + kq);
                n4n = *(const float4*)(B + 4096 + (st + 1) * 64 + kq); vvn = B[5120 + (st + 1) * 16 + row_local];
            }
            const float part = (S0 * n4.x + S1 * n4.y) + (S2 * n4.z + S3 * n4.w);
            const float sa = -reduce16(part);
            const float t0 = S0 * w4.x + vv * k4.x, t1 = S1 * w4.y + vv * k4.y, t2 = S2 * w4.z + vv * k4.z, t3 = S3 * w4.w + vv * k4.w;
            S0 = t0 + sa * a4.x; S1 = t1 + sa * a4.y; S2 = t2 + sa * a4.z; S3 = t3 + sa * a4.w;
            const float yp = (S0 * r4.x + S1 * r4.y) + (S2 * r4.z + S3 * r4.w);
            yv[st] = reduce16(yp);
            if (st < 15) { w4 = w4n; a4 = a4n; k4 = k4n; r4 = r4n; n4 = n4n; vv = vvn; }
        }
        if ((lane & 15) == 0) {
#pragma unroll
            for (int st = 0; st < 16; ++st) Y[st * 16 + row_local] = yv[st];
        }
        if (c + 1 < NCH) commit(buf ^ 1);
        __syncthreads();
        YR[gbase + (size_t)(c * 16 + vstep) * 256 + rg * 16 + vrow] = Y[vstep * 16 + vrow];
    }
}

DEV void phase_rwkv_post(const Params& p, int l) {
    unsigned char* ws = p.ws;
    const float* YR = (const float*)(ws + OFF_YRAW); const float* BON = (const float*)(ws + OFF_BONUS);
    const u16 *RV = (const u16*)(ws + OFF_RV), *RG = (const u16*)(ws + OFF_RG);
    u16* mix = (u16*)(ws + OFF_MIX);
    const int tid = TID();
    const float lg = p.in[I_LNG][l * 256 + tid], lb = p.in[I_LNB][l * 256 + tid];
    for (int row0 = BID() * 4; row0 < NTOK; row0 += gridDim.x * 4) {
        float y[4], bon[4], vv[4], gg[4];
#pragma unroll
        for (int u = 0; u < 4; ++u) {
            const size_t o = (size_t)(row0 + u) * 256 + tid;
            y[u] = YR[o]; bon[u] = BON[(size_t)(row0 + u) * 4 + (tid >> 6)]; vv[u] = bf2f(RV[o]); gg[u] = bf2f(RG[o]);
        }
#pragma unroll
        for (int u = 0; u < 4; ++u) {
            const float mean = wave_sum(y[u]) * (1.f / 64.f);
            const float d = y[u] - mean;
            const float var = wave_sum(d * d) * (1.f / 64.f);
            const float yn = d * rsqrtf(var + 64e-5f) * lg + lb;
            mix[(size_t)(row0 + u) * 1024 + 256 + tid] = f2bf((yn + bon[u] * vv[u]) * gg[u]);
        }
    }
}

DEV void zero_mix_cols(const Params& p, int c0, int ncols) {
    u16* mix = (u16*)(p.ws + OFF_MIX);
    const int per = ncols / 8;
    const size_t total = (size_t)NTOK * per;
    for (size_t i = (size_t)BID() * 256 + TID(); i < total; i += (size_t)gridDim.x * 256) {
        const size_t row = i / per; const int cc = (int)(i % per);
        *(u32x4*)(mix + row * 1024 + c0 + cc * 8) = (u32x4){0u, 0u, 0u, 0u};
    }
}


DEV void qk_tile(const bf16x8 (&kf)[8], bf16x8 q0, bf16x8 q1, float cinit, f32x4 (&st)[4]) {
    const f32x4 c = (f32x4){cinit, cinit, cinit, cinit};
#pragma unroll
    for (int kt = 0; kt < 4; ++kt) {
        st[kt] = mfma16(kf[2 * kt], q0, c);
        st[kt] = mfma16(kf[2 * kt + 1], q1, st[kt]);
    }
}
DEV void softmax_pv_lazy(f32x4 (&st)[4], const bf16x8 (&vf)[8], float& m, float& l, f32x4& L, f32x4 (&O)[4]) {
    float lmax = fmaxf(fmaxf(fmaxf(st[0][0], st[0][1]), fmaxf(st[0][2], st[0][3])), fmaxf(fmaxf(st[1][0], st[1][1]), fmaxf(st[1][2], st[1][3])));
    lmax = fmaxf(lmax, fmaxf(fmaxf(fmaxf(st[2][0], st[2][1]), fmaxf(st[2][2], st[2][3])), fmaxf(fmaxf(st[3][0], st[3][1]), fmaxf(st[3][2], st[3][3]))));
    lmax = colmax(lmax);
    const float dlt = (lmax > 8.f) ? lmax : 0.f;
    if (__any(dlt > 0.f)) {
        const float alpha = ex2(-dlt);
#pragma unroll
        for (int mt = 0; mt < 4; ++mt) { O[mt][0] *= alpha; O[mt][1] *= alpha; O[mt][2] *= alpha; O[mt][3] *= alpha; }
        L[0] *= alpha; L[1] *= alpha; L[2] *= alpha; L[3] *= alpha; l *= alpha; m += dlt;
#pragma unroll
        for (int kt = 0; kt < 4; ++kt) { st[kt][0] -= dlt; st[kt][1] -= dlt; st[kt][2] -= dlt; st[kt][3] -= dlt; }
    }
#pragma unroll
    for (int kt = 0; kt < 4; ++kt)
#pragma unroll
        for (int r = 0; r < 4; ++r) st[kt][r] = ex2(st[kt][r]);
    union { bf16x8 v; unsigned u[4]; } ones;
    ones.u[0] = 0x3f803f80u; ones.u[1] = 0x3f803f80u; ones.u[2] = 0x3f803f80u; ones.u[3] = 0x3f803f80u;
#pragma unroll
    for (int kb = 0; kb < 2; ++kb) {
        union { bf16x8 v; unsigned u[4]; } pb;
        pb.u[0] = pack2(st[2 * kb][0], st[2 * kb][1]); pb.u[1] = pack2(st[2 * kb][2], st[2 * kb][3]);
        pb.u[2] = pack2(st[2 * kb + 1][0], st[2 * kb + 1][1]); pb.u[3] = pack2(st[2 * kb + 1][2], st[2 * kb + 1][3]);
        L = mfma16(ones.v, pb.v, L);
#pragma unroll
        for (int mt = 0; mt < 4; ++mt) O[mt] = mfma16(vf[kb * 4 + mt], pb.v, O[mt]);
    }
}
DEV void softmax_pv_tile(bool MASK, f32x4 (&st)[4], const bf16x8 (&vf)[8], int keybase, int tcol, int lowcol, bool colsel, float& m, float& l, f32x4& L, f32x4 (&O)[4], int q4) {
    float lmax = -1e30f;
    if (MASK) {
        const int hi = colsel ? tcol : -1;
#pragma unroll
        for (int kt = 0; kt < 4; ++kt)
#pragma unroll
            for (int r = 0; r < 4; ++r) {
                const int key = keybase + kt * 16 + 4 * q4 + r;
                const bool valid = (key <= hi) && (key > lowcol);
                const float sv = valid ? st[kt][r] : -1e30f;
                st[kt][r] = sv; lmax = fmaxf(lmax, sv);
            }
    } else {
        const float cs = colsel ? 0.f : -1e30f;
#pragma unroll
        for (int kt = 0; kt < 4; ++kt)
#pragma unroll
            for (int r = 0; r < 4; ++r) { const float sv = st[kt][r] + cs; st[kt][r] = sv; lmax = fmaxf(lmax, sv); }
    }
    lmax = colmax(lmax);
    const float mnew = fmaxf(m, lmax);
    const float alpha = ex2(m - mnew);
    float psum = 0.f;
#pragma unroll
    for (int kt = 0; kt < 4; ++kt)
#pragma unroll
        for (int r = 0; r < 4; ++r) {
            float pv = ex2(st[kt][r] - mnew);
            if (MASK) pv = (st[kt][r] > -1e29f) ? pv : 0.f;
            st[kt][r] = pv; psum += pv;
        }
    l = l * alpha + psum;
    if (__any(mnew > m)) {
#pragma unroll
        for (int mt = 0; mt < 4; ++mt) { O[mt][0] *= alpha; O[mt][1] *= alpha; O[mt][2] *= alpha; O[mt][3] *= alpha; }
        L[0] *= alpha; L[1] *= alpha; L[2] *= alpha; L[3] *= alpha;
    }
    m = mnew;
#pragma unroll
    for (int kb = 0; kb < 2; ++kb) {
        union { bf16x8 v; unsigned u[4]; } pb;
        pb.u[0] = pack2(st[2 * kb][0], st[2 * kb][1]); pb.u[1] = pack2(st[2 * kb][2], st[2 * kb][3]);
        pb.u[2] = pack2(st[2 * kb + 1][0], st[2 * kb + 1][1]); pb.u[3] = pack2(st[2 * kb + 1][2], st[2 * kb + 1][3]);
#pragma unroll
        for (int mt = 0; mt < 4; ++mt) O[mt] = mfma16(vf[kb * 4 + mt], pb.v, O[mt]);
    }
}
DEV unsigned pick4(unsigned a0, unsigned a1, unsigned a2, unsigned a3, int w) { return w == 0 ? a0 : (w == 1 ? a1 : (w == 2 ? a2 : a3)); }
template <int CTRL> DEV unsigned dpp_or(unsigned x) { return x | dppu<CTRL>(x); }
DEV unsigned row_or(unsigned x) { x = dpp_or<0xB1>(x); x = dpp_or<0x4E>(x); x = dpp_or<0x124>(x); x = dpp_or<0x128>(x); return x; }


DEV void nsa_branch_lds(unsigned char* lds, const u16* __restrict__ K0, const u16* __restrict__ VT0, unsigned bu0, unsigned bu1, unsigned bu2,
                        unsigned bu3, unsigned ua0, unsigned ua1, unsigned ua2, unsigned ua3, unsigned ub0, unsigned ub1, unsigned ub2, unsigned ub3,
                        const unsigned* cm, int tokl, const int (&tcol)[2], const int (&lowc)[2], const bf16x8 (&qf)[2][2], float (&m)[2],
                        float (&l)[2], f32x4 (&L)[2], f32x4 (&O)[2][4], int q4, int cidx, int cur, int lowmax) {
    const int tid = TID();
    int w = 0; unsigned bits = bu0;
    auto advance = [&]() -> int {
        while (bits == 0u && w < 3) { ++w; bits = pick4(bu0, bu1, bu2, bu3, w); }
        if (bits == 0u) return -1;
        const int jb = __builtin_ctz(bits); bits &= bits - 1u;
        return w * 32 + jb;
    };
    const int srow0 = tid >> 3, srow1 = srow0 + 32, sch = tid & 7;
    const int so0 = srow0 * 128 + ((sch ^ (srow0 & 7)) << 4), so1 = srow1 * 128 + ((sch ^ (srow1 & 7)) << 4);
    bf16x8 r0[4], r1[4];
#define NSA_GLOAD(R, BLK_) { R[0] = ld8(K0 + ((size_t)(BLK_) * 64 + srow0) * 64 + sch * 8); R[1] = ld8(K0 + ((size_t)(BLK_) * 64 + srow1) * 64 + sch * 8); \
        R[2] = ld8(VT0 + (size_t)srow0 * 8192 + (BLK_) * 64 + sch * 8); R[3] = ld8(VT0 + (size_t)srow1 * 8192 + (BLK_) * 64 + sch * 8); }
#define NSA_LWRITE(R, BUF_) { unsigned char* wb_ = lds + (BUF_) * 16384; *(bf16x8*)(wb_ + so0) = R[0]; *(bf16x8*)(wb_ + so1) = R[1]; \
        *(bf16x8*)(wb_ + 8192 + so0) = R[2]; *(bf16x8*)(wb_ + 8192 + so1) = R[3]; }
    auto compute = [&](int blk, int buf) {
        const int wq = blk >> 5, jb = blk & 31;
        const bool act0 = (pick4(ua0, ua1, ua2, ua3, wq) >> jb) & 1u, act1 = (pick4(ub0, ub1, ub2, ub3, wq) >> jb) & 1u;
        if (act0 || act1) {
            const unsigned char* kb_ = lds + buf * 16384;
            const bool need_mask = (blk == cur) || (blk * 64 <= lowmax);
            const bool cs0 = cm ? (((cm[tokl * 4 + wq] >> jb) & 1u) != 0u) : true;
            const bool cs1 = cm ? (((cm[(4 + tokl) * 4 + wq] >> jb) & 1u) != 0u) : true;
            const bool lazy = !need_mask && !__any((act0 && m[0] < -1e29f) || (act1 && m[1] < -1e29f));
            f32x4 st0[4], st1[4];
            {
                bf16x8 kf[8];
#pragma unroll
                for (int kt = 0; kt < 4; ++kt)
#pragma unroll
                    for (int s2 = 0; s2 < 2; ++s2) {
                        const int row = 16 * kt + cidx, ch = 4 * s2 + q4;
                        kf[2 * kt + s2] = *(const bf16x8*)(kb_ + row * 128 + ((ch ^ (row & 7)) << 4));
                    }
                if (act0) qk_tile(kf, qf[0][0], qf[0][1], lazy ? (cs0 ? -m[0] : -1e30f) : 0.f, st0);
                if (act1) qk_tile(kf, qf[1][0], qf[1][1], lazy ? (cs1 ? -m[1] : -1e30f) : 0.f, st1);
            }
            __builtin_amdgcn_sched_barrier(0);
            bf16x8 vf[8];
#pragma unroll
            for (int kb = 0; kb < 2; ++kb)
#pragma unroll
                for (int mt = 0; mt < 4; ++mt) {
                    const int row = 16 * mt + cidx, ch = 4 * kb + q4;
                    vf[kb * 4 + mt] = *(const bf16x8*)(kb_ + 8192 + row * 128 + ((ch ^ (row & 7)) << 4));
                }
            if (lazy) {
                if (act0) softmax_pv_lazy(st0, vf, m[0], l[0], L[0], O[0]);
                if (act1) softmax_pv_lazy(st1, vf, m[1], l[1], L[1], O[1]);
            } else {
                if (act0) softmax_pv_tile(need_mask, st0, vf, blk * 64, tcol[0], lowc[0], cs0, m[0], l[0], L[0], O[0], q4);
                if (act1) softmax_pv_tile(need_mask, st1, vf, blk * 64, tcol[1], lowc[1], cs1, m[1], l[1], L[1], O[1], q4);
            }
        }
    };
    int b0 = advance();
    if (b0 < 0) return;
    int b1 = advance();
    NSA_GLOAD(r0, b0);
    if (b1 >= 0) NSA_GLOAD(r1, b1);
    NSA_LWRITE(r0, 0);
    __syncthreads();
#pragma unroll 1
    while (b0 >= 0) {
        const int b2 = (b1 >= 0) ? advance() : -1;
        if (b2 >= 0) NSA_GLOAD(r0, b2);
        compute(b0, 0);
        if (b1 >= 0) NSA_LWRITE(r1, 1);
        __syncthreads();
        if (b1 < 0) break;
        const int b3 = (b2 >= 0) ? advance() : -1;
        if (b3 >= 0) NSA_GLOAD(r1, b3);
        compute(b1, 1);
        if (b2 >= 0) NSA_LWRITE(r0, 0);
        __syncthreads();
        b0 = b2; b1 = b3;
    }
#undef NSA_GLOAD
#undef NSA_LWRITE
}

DEV void nsa_block_task(const Params& p, int task, unsigned char* lds) {
    const int wave = TID() >> 6;
    float* wl = (float*)(lds + 32768) + wave * 2112;
    unsigned* bm = (unsigned*)(lds + 32768 + 4 * 8448);
    float* impA = wl; float* impB = wl + 1024; unsigned* selmask = (unsigned*)(wl + 1024 + 1056);
    unsigned char* ws = p.ws;
    const u16* Q = (const u16*)(ws + OFF_Q);
    const u16* KVb = (const u16*)(ws + OFF_KV);
    const u16 *KSEL = KVb + (size_t)2 * 4194304, *VSELT = KVb + (size_t)3 * 4194304, *KWIN = KVb + (size_t)4 * 4194304, *VWINT = KVb + (size_t)5 * 4194304;
    const u16* KC = (const u16*)(ws + OFF_KC); const u16* VCT = (const u16*)(ws + OFF_VCT);
    const float* GATE = (const float*)(ws + OFF_GATE);
    u16* mix = (u16*)(ws + OFF_MIX);
    const int lane = TID() & 63, q4 = lane >> 4, cidx = lane & 15;
    const int bg = task & 7, t0b = (255 - (task >> 3)) * 32, t0 = t0b + 8 * wave; const int b = bg >> 1, g = bg & 1;
    const int tokl = cidx >> 2, hr = cidx & 3; const int head = g * 4 + hr;
    const int cur = t0 >> 6;
    int tcol[2], rowc[2]; bf16x8 qf[2][2];
#pragma unroll
    for (int ti = 0; ti < 2; ++ti) {
        tcol[ti] = t0 + 4 * ti + tokl; rowc[ti] = b * 8192 + tcol[ti];
        qf[ti][0] = ld8(Q + (size_t)rowc[ti] * 512 + head * 64 + 8 * q4); qf[ti][1] = ld8(Q + (size_t)rowc[ti] * 512 + head * 64 + 32 + 8 * q4);
    }
    f32x4 Oc[2][4];
    {
        int cnt_col[2];
#pragma unroll
        for (int ti = 0; ti < 2; ++ti) cnt_col[ti] = tcol[ti] >= 31 ? ((tcol[ti] - 31) >> 4) + 1 : 0;
        const int tmax = t0 + 7; const int cmax = tmax >= 31 ? ((tmax - 31) >> 4) + 1 : 0;
        const int ntile = (cmax + 15) >> 4;
        const u16* kcb = KC + (size_t)bg * 512 * 64;
        float ml[2] = {-1e30f, -1e30f}, ll[2] = {0.f, 0.f};
#pragma unroll 1
        for (int kt = 0; kt < ntile; ++kt) {
            const u16* kp = kcb + (kt * 16 + cidx) * 64 + 8 * q4;
            const bf16x8 k0 = ld8(kp), k1 = ld8(kp + 32);
#pragma unroll
            for (int ti = 0; ti < 2; ++ti) {
                f32x4 st = mfma16(k0, qf[ti][0], (f32x4){0.f, 0.f, 0.f, 0.f});
                st = mfma16(k1, qf[ti][1], st);
                float sv[4]; float tm = -1e30f;
#pragma unroll
                for (int r = 0; r < 4; ++r) { const int n = kt * 16 + 4 * q4 + r; sv[r] = (n < cnt_col[ti]) ? st[r] : -1e30f; tm = fmaxf(tm, sv[r]); }
                const float mn = fmaxf(ml[ti], tm);
                float ps = 0.f;
#pragma unroll
                for (int r = 0; r < 4; ++r) ps += (sv[r] > -1e29f) ? ex2(sv[r] - mn) : 0.f;
                ll[ti] = ll[ti] * ex2(ml[ti] - mn) + ps; ml[ti] = mn;
            }
        }
        float mfin[2], inv[2];
#pragma unroll
        for (int ti = 0; ti < 2; ++ti) {
            mfin[ti] = colmax(ml[ti]);
            const float lsum = colsum(ll[ti] * ex2(ml[ti] - mfin[ti]));
            inv[ti] = (cnt_col[ti] > 0) ? 1.f / lsum : 0.f;
        }
#pragma unroll
        for (int ti = 0; ti < 2; ++ti)
#pragma unroll
            for (int mt = 0; mt < 4; ++mt) Oc[ti][mt] = (f32x4){0.f, 0.f, 0.f, 0.f};
        const int npair = (ntile + 1) >> 1;
#pragma unroll 1
        for (int kp2 = 0; kp2 < npair; ++kp2) {
            const int n0 = kp2 * 32;
            const u16* kp = kcb + (n0 + cidx) * 64 + 8 * q4;
            const bf16x8 ka0 = ld8(kp), ka1 = ld8(kp + 32), kb0 = ld8(kp + 1024), kb1 = ld8(kp + 1024 + 32);
            bf16x8 vf[4];
#pragma unroll
            for (int mt = 0; mt < 4; ++mt) vf[mt] = ld8(VCT + ((size_t)bg * 64 + 16 * mt + cidx) * 512 + n0 + 8 * q4);
#pragma unroll
            for (int ti = 0; ti < 2; ++ti) {
                float pa[4], pb_[4];
                f32x4 st = mfma16(ka0, qf[ti][0], (f32x4){0.f, 0.f, 0.f, 0.f});
                st = mfma16(ka1, qf[ti][1], st);
                f32x4 su = mfma16(kb0, qf[ti][0], (f32x4){0.f, 0.f, 0.f, 0.f});
                su = mfma16(kb1, qf[ti][1], su);
#pragma unroll
                for (int r = 0; r < 4; ++r) {
                    const int n = n0 + 4 * q4 + r;
                    pa[r] = (n < cnt_col[ti]) ? ex2(st[r] - mfin[ti]) * inv[ti] : 0.f;
                    pb_[r] = (n + 16 < cnt_col[ti]) ? ex2(su[r] - mfin[ti]) * inv[ti] : 0.f;
                }
                const float owna = quadsum(pa[0] + pa[1] + pa[2] + pa[3]), tha = quadsum(pa[3]);
                const float ownb = quadsum(pb_[0] + pb_[1] + pb_[2] + pb_[3]), thb = quadsum(pb_[3]);
                if (hr == 0) {
                    const int tk = 4 * ti + tokl;
                    const int sa = (n0 >> 2) + q4, sb2 = ((n0 + 16) >> 2) + q4;
                    impA[tk * 128 + sa] = owna; impB[tk * 132 + sa + 1] = tha;
                    impA[tk * 128 + sb2] = ownb; impB[tk * 132 + sb2 + 1] = thb;
                }
                union { bf16x8 v; unsigned u[4]; } pk;
                pk.u[0] = pack2(pa[0], pa[1]); pk.u[1] = pack2(pa[2], pa[3]); pk.u[2] = pack2(pb_[0], pb_[1]); pk.u[3] = pack2(pb_[2], pb_[3]);
#pragma unroll
                for (int mt = 0; mt < 4; ++mt) Oc[ti][mt] = mfma16(vf[mt], pk.v, Oc[ti][mt]);
            }
        }
#pragma unroll
        for (int ti = 0; ti < 2; ++ti) {
            const float gc = GATE[(size_t)rowc[ti] * 24 + head];
#pragma unroll
            for (int mt = 0; mt < 4; ++mt)
#pragma unroll
                for (int r = 0; r < 4; ++r) Oc[ti][mt][r] *= gc;
        }
    }
    lds_fence();
#pragma unroll 1
    for (int rd = 0; rd < 2; ++rd) {
        const int tk = 4 * rd + q4;
        unsigned m0 = 0u, m1 = 0u, m2 = 0u, m3 = 0u;
        if (cur < 16) { m0 = (2u << cur) - 1u; }
        else {
            unsigned key[8];
#pragma unroll
            for (int i = 0; i < 8; ++i) {
                const int sblk = cidx + 16 * i;
                const bool cand = (sblk >= 1) && (sblk <= cur - 2);
                const float v = impA[tk * 128 + sblk] + impB[tk * 132 + sblk];
                key[i] = cand ? ((__float_as_uint(v) & ~0x7Fu) | (unsigned)(127 - sblk)) : 0u;
            }
            int mysel = (cidx == 0) ? 0 : (cidx == 1 ? cur - 1 : (cidx == 2 ? cur : -1));
#pragma unroll 1
            for (int it = 0; it < 13; ++it) {
                unsigned mx = key[0];
#pragma unroll
                for (int i = 1; i < 8; ++i) mx = max(mx, key[i]);
                mx = max(mx, dppu<0xB1>(mx)); mx = max(mx, dppu<0x4E>(mx)); mx = max(mx, dppu<0x124>(mx)); mx = max(mx, dppu<0x128>(mx));
                const int sblk = 127 - (int)(mx & 127u);
#pragma unroll
                for (int i = 0; i < 8; ++i) key[i] = (key[i] == mx) ? 0u : key[i];
                if (cidx == it + 3) mysel = sblk;
            }
            const unsigned bit = 1u << (mysel & 31); const int wsel = mysel >> 5;
            m0 = row_or(wsel == 0 ? bit : 0u); m1 = row_or(wsel == 1 ? bit : 0u); m2 = row_or(wsel == 2 ? bit : 0u); m3 = row_or(wsel == 3 ? bit : 0u);
        }
        if (cidx < 4) selmask[tk * 4 + cidx] = (cidx == 0) ? m0 : (cidx == 1 ? m1 : (cidx == 2 ? m2 : m3));
    }
    lds_fence();
    f32x4* accl = (f32x4*)wl;
#pragma unroll
    for (int ti = 0; ti < 2; ++ti)
#pragma unroll
        for (int mt = 0; mt < 4; ++mt) accl[(ti * 4 + mt) * 64 + lane] = Oc[ti][mt];
    {
        float m[2] = {-1e30f, -1e30f}, l[2] = {0.f, 0.f}; f32x4 Os[2][4]; f32x4 Ls[2] = {(f32x4){0.f, 0.f, 0.f, 0.f}, (f32x4){0.f, 0.f, 0.f, 0.f}};
#pragma unroll
        for (int ti = 0; ti < 2; ++ti)
#pragma unroll
            for (int mt = 0; mt < 4; ++mt) Os[ti][mt] = (f32x4){0.f, 0.f, 0.f, 0.f};
        {
            unsigned ua[4], ub[4], bu[4];
#pragma unroll
            for (int w = 0; w < 4; ++w) {
                ua[w] = __builtin_amdgcn_readfirstlane(row_or(selmask[tokl * 4 + w]));
                ub[w] = __builtin_amdgcn_readfirstlane(row_or(selmask[(4 + tokl) * 4 + w]));
            }
            if (lane < 4) bm[wave * 4 + lane] = (lane == 0) ? (ua[0] | ub[0]) : (lane == 1 ? (ua[1] | ub[1]) : (lane == 2 ? (ua[2] | ub[2]) : (ua[3] | ub[3])));
            __syncthreads();
#pragma unroll
            for (int w = 0; w < 4; ++w) bu[w] = __builtin_amdgcn_readfirstlane(bm[w] | bm[4 + w] | bm[8 + w] | bm[12 + w]);
            const int lowc[2] = {-1, -1};
            nsa_branch_lds(lds, KSEL + (size_t)bg * 8192 * 64, VSELT + (size_t)bg * 64 * 8192, bu[0], bu[1], bu[2], bu[3], ua[0], ua[1], ua[2], ua[3], ub[0],
                           ub[1], ub[2], ub[3], selmask, tokl, tcol, lowc, qf, m, l, Ls, Os, q4, cidx, cur, -1);
        }
#pragma unroll
        for (int ti = 0; ti < 2; ++ti) {
            const float sc = GATE[(size_t)rowc[ti] * 24 + 8 + head] / (colsum(l[ti]) + Ls[ti][0]);
#pragma unroll
            for (int mt = 0; mt < 4; ++mt)
#pragma unroll
                for (int r = 0; r < 4; ++r) Os[ti][mt][r] *= sc;
        }
        lds_fence();
#pragma unroll
        for (int ti = 0; ti < 2; ++ti)
#pragma unroll
            for (int mt = 0; mt < 4; ++mt) { f32x4 a = accl[(ti * 4 + mt) * 64 + lane]; a += Os[ti][mt]; accl[(ti * 4 + mt) * 64 + lane] = a; }
    }
    {
        float m[2] = {-1e30f, -1e30f}, l[2] = {0.f, 0.f}; f32x4 Ow[2][4]; f32x4 Ls[2] = {(f32x4){0.f, 0.f, 0.f, 0.f}, (f32x4){0.f, 0.f, 0.f, 0.f}};
#pragma unroll
        for (int ti = 0; ti < 2; ++ti)
#pragma unroll
            for (int mt = 0; mt < 4; ++mt) Ow[ti][mt] = (f32x4){0.f, 0.f, 0.f, 0.f};
        int wb0 = (t0 - 511) >> 6; if (wb0 < 0) wb0 = 0;
        int wbb = (t0b - 511) >> 6; if (wbb < 0) wbb = 0;
        {
            unsigned uw[4], bu[4];
#pragma unroll
            for (int w = 0; w < 4; ++w) {
                const int hi = cur - 32 * w;
                unsigned mk = 0u, mkb = 0u;
                if (hi >= 0) {
                    const unsigned upper = (hi >= 31) ? 0xffffffffu : ((2u << hi) - 1u);
                    const int lo = wb0 - 32 * w, lob = wbb - 32 * w;
                    if (lo <= 31) mk = upper & ~((lo <= 0) ? 0u : ((1u << lo) - 1u));
                    if (lob <= 31) mkb = upper & ~((lob <= 0) ? 0u : ((1u << lob) - 1u));
                }
                uw[w] = mk; bu[w] = mkb;
            }
            const int lowc[2] = {tcol[0] - 512, tcol[1] - 512};
            nsa_branch_lds(lds, KWIN + (size_t)bg * 8192 * 64, VWINT + (size_t)bg * 64 * 8192, bu[0], bu[1], bu[2], bu[3], uw[0], uw[1], uw[2], uw[3], uw[0],
                           uw[1], uw[2], uw[3], nullptr, tokl, tcol, lowc, qf, m, l, Ls, Ow, q4, cidx, cur, t0 + 7 - 512);
        }
#pragma unroll
        for (int ti = 0; ti < 2; ++ti) {
            const float sc = GATE[(size_t)rowc[ti] * 24 + 16 + head] / (colsum(l[ti]) + Ls[ti][0]);
#pragma unroll
            for (int mt = 0; mt < 4; ++mt)
#pragma unroll
                for (int r = 0; r < 4; ++r) Ow[ti][mt][r] *= sc;
        }
        lds_fence();
#pragma unroll
        for (int ti = 0; ti < 2; ++ti)
#pragma unroll
            for (int mt = 0; mt < 4; ++mt) {
                const f32x4 a = accl[(ti * 4 + mt) * 64 + lane];
                const f32x4 o = Ow[ti][mt];
                u32x2 wv; wv[0] = pack2(a[0] + o[0], a[1] + o[1]); wv[1] = pack2(a[2] + o[2], a[3] + o[3]);
                *(u32x2*)(mix + (size_t)rowc[ti] * 1024 + 512 + head * 64 + 16 * mt + 4 * q4) = wv;
            }
    }


    __syncthreads();
}

template <int N> DEV void ltmask(const float (&v)[N], float x, unsigned (&mk)[N / 32]) {
#pragma unroll
    for (int w = 0; w < N / 32; ++w) {
        unsigned a0 = 0u, a1 = 0u, a2 = 0u, a3 = 0u;
#pragma unroll
        for (int i = 0; i < 8; ++i) {
            a0 = __builtin_amdgcn_alignbit(a0, __float_as_uint(v[w * 32 + i] - x), 31);
            a1 = __builtin_amdgcn_alignbit(a1, __float_as_uint(v[w * 32 + 8 + i] - x), 31);
            a2 = __builtin_amdgcn_alignbit(a2, __float_as_uint(v[w * 32 + 16 + i] - x), 31);
            a3 = __builtin_amdgcn_alignbit(a3, __float_as_uint(v[w * 32 + 24 + i] - x), 31);
        }
        mk[w] = (a0 << 24) | (a1 << 16) | (a2 << 8) | a3;
    }
}
template <int N> DEV int count_ge(const float (&v)[N], float x) {
    unsigned mk[N / 32]; ltmask<N>(v, x, mk);
    int lt = 0;
#pragma unroll
    for (int w = 0; w < N / 32; ++w) lt += __popc(mk[w]);
    return colsumi(N - lt);
}
template <int N> DEV void refine16(const float (&v)[N], float lo, int clo, float hi, int chi, float& lo_o, float& hi_o) {
    bool done = false;
    if (clo == 16) { hi = lo; done = true; }
#pragma unroll 1
    for (int it = 0; it < 200; ++it) {
        if (__all(done)) break;
        float f = 0.5f;
        if (!(it & 1)) { f = ((float)clo - 15.5f) / (float)(clo - chi); f = fminf(fmaxf(f, 0.04f), 0.96f); }
        const float mid = lo + (hi - lo) * f;
        const bool stuck = !(mid > lo && mid < hi);
        const int c = count_ge<N>(v, mid);
        if (!done) {
            if (stuck) { if (f != 0.5f) {   } else done = true; }
            else if (c == 16) { lo = mid; hi = mid; done = true; }
            else if (c > 16) { lo = mid; clo = c; }
            else { hi = mid; chi = c; }
        }
    }
    lo_o = lo; hi_o = hi;
}
template <int N> DEV void select16(const float (&v)[N], float& lo_o, float& hi_o) {
    float mx = v[0], sm = v[0];
#pragma unroll
    for (int i = 1; i < N; ++i) { mx = fmaxf(mx, v[i]); sm += v[i]; }
    mx = colmax(mx); sm = colsum(sm);
    const float hi = mx + fabsf(mx) * 1e-6f + 1e-30f;
    float lo = sm * (1.f / (4.f * N));
    int clo = count_ge<N>(v, lo);
    if (__any(clo < 16)) {
        float mn = v[0];
#pragma unroll
        for (int i = 1; i < N; ++i) mn = fminf(mn, v[i]);
        mn = -colmax(-mn);
        if (clo < 16) { lo = mn; clo = 4 * N; }
    }
    refine16<N>(v, lo, clo, hi, 0, lo_o, hi_o);
}
DEV void col_offsets(int cntA, int cntT, int q4, int cidx, int& offA, int& offT) {
    const int g0 = __shfl(cntA, cidx), g1 = __shfl(cntA, cidx + 16), g2 = __shfl(cntA, cidx + 32), g3 = __shfl(cntA, cidx + 48);
    const int e0 = __shfl(cntT, cidx), e1 = __shfl(cntT, cidx + 16), e2 = __shfl(cntT, cidx + 32);
    offA = (q4 > 0 ? g0 : 0) + (q4 > 1 ? g1 : 0) + (q4 > 2 ? g2 : 0);
    offT = g0 + g1 + g2 + g3 + (q4 > 0 ? e0 : 0) + (q4 > 1 ? e1 : 0) + (q4 > 2 ? e2 : 0);
}

DEV void peer_topk_task2(const Params& p, int l, int task, float* wl) {
    unsigned char* ws = p.ws;
    const u16* QP = (const u16*)(ws + OFF_QP);
    const u16* K12 = (const u16*)(ws + OFF_K12) + (size_t)l * 2 * 16384;
    const int lane = TID() & 63, q4 = lane >> 4, cidx = lane & 15;
    const int tq = task * 2 + (cidx >> 3), hh = cidx & 7;
    float* scl = wl;
    float* lst = wl + 2048;
    float* vv[2] = {lst, lst + 512}; int* ii[2] = {(int*)(lst + 256), (int*)(lst + 768)};
    float* fs = lst + 1024; int* fi = (int*)(lst + 1280);
#pragma unroll 1
    for (int hf = 0; hf < 2; ++hf) {
        bf16x8 qf[4];
#pragma unroll
        for (int s2 = 0; s2 < 4; ++s2) qf[s2] = ld8(QP + (size_t)tq * 2048 + hh * 256 + hf * 128 + 32 * s2 + 8 * q4);
        float sc[32];
        const u16* kb = K12 + hf * 16384;
#pragma unroll
        for (int kt = 0; kt < 8; ++kt) {
            f32x4 st = (f32x4){0.f, 0.f, 0.f, 0.f};
#pragma unroll
            for (int s2 = 0; s2 < 4; ++s2) st = mfma16(ld8(kb + (kt * 16 + cidx) * 128 + 32 * s2 + 8 * q4), qf[s2], st);
#pragma unroll
            for (int r = 0; r < 4; ++r) sc[kt * 4 + r] = st[r];
            *(f32x4*)(scl + cidx * 128 + 16 * kt + 4 * q4) = st;
        }
        float lo, hi; select16<32>(sc, lo, hi);
        unsigned mh[1], ml_[1];
        ltmask<32>(sc, hi, mh);
        if (__all(lo == hi)) ml_[0] = mh[0]; else ltmask<32>(sc, lo, ml_);
        unsigned mA = ~mh[0], mT = ~ml_[0] & mh[0];
        int offA, offT; col_offsets(__popc(mA), __popc(mT), q4, cidx, offA, offT);
        float* vo = hf ? vv[1] : vv[0]; int* io = hf ? ii[1] : ii[0];
        while (__any(mA != 0u)) {
            if (mA) {
                const int i = __clz(mA); mA &= ~(0x80000000u >> i);
                io[cidx * 16 + offA] = 16 * (i >> 2) + 4 * q4 + (i & 3); ++offA;
            }
        }
        while (__any(mT != 0u)) {
            if (mT) {
                const int i = __clz(mT); mT &= ~(0x80000000u >> i);
                if (offT < 16) io[cidx * 16 + offT] = 16 * (i >> 2) + 4 * q4 + (i & 3);
                ++offT;
            }
        }
        lds_fence();
        {
            const int4 n4 = *(const int4*)(io + cidx * 16 + 4 * q4);
            float4 v4; v4.x = scl[cidx * 128 + n4.x]; v4.y = scl[cidx * 128 + n4.y]; v4.z = scl[cidx * 128 + n4.z]; v4.w = scl[cidx * 128 + n4.w];
            *(float4*)(vo + cidx * 16 + 4 * q4) = v4;
        }
        lds_fence();
    }
    {
        float cand[64];
        float v2r[16];
#pragma unroll
        for (int j = 0; j < 16; ++j) v2r[j] = vv[1][cidx * 16 + j];
#pragma unroll
        for (int a = 0; a < 4; ++a) {
            const float v1a = vv[0][cidx * 16 + 4 * q4 + a];
#pragma unroll
            for (int j = 0; j < 16; ++j) cand[a * 16 + j] = v1a + v2r[j];
        }
        float lo, hi;
        {
            float v2mx = v2r[0], v2mn = v2r[0];
#pragma unroll
            for (int j = 1; j < 16; ++j) { v2mx = fmaxf(v2mx, v2r[j]); v2mn = fminf(v2mn, v2r[j]); }
            float v1mx = fmaxf(fmaxf(vv[0][cidx * 16 + 4 * q4], vv[0][cidx * 16 + 4 * q4 + 1]), fmaxf(vv[0][cidx * 16 + 4 * q4 + 2], vv[0][cidx * 16 + 4 * q4 + 3]));
            float v1mn = fminf(fminf(vv[0][cidx * 16 + 4 * q4], vv[0][cidx * 16 + 4 * q4 + 1]), fminf(vv[0][cidx * 16 + 4 * q4 + 2], vv[0][cidx * 16 + 4 * q4 + 3]));
            v1mx = colmax(v1mx); v1mn = -colmax(-v1mn);
            const float smax = v1mx + v2mx;
            const float hi0 = smax + fabsf(smax) * 1e-6f + 1e-30f;
            const float lo0 = fmaxf(v1mn + v2mx, v1mx + v2mn);
            const int c0 = count_ge<64>(cand, lo0);
            refine16<64>(cand, lo0, c0, hi0, 0, lo, hi);
        }
        unsigned mh[2], ml_[2];
        ltmask<64>(cand, hi, mh);
        if (__all(lo == hi)) { ml_[0] = mh[0]; ml_[1] = mh[1]; } else ltmask<64>(cand, lo, ml_);
        unsigned mA0 = ~mh[0], mA1 = ~mh[1], mT0 = ~ml_[0] & mh[0], mT1 = ~ml_[1] & mh[1];
        int offA, offT; col_offsets(__popc(mA0) + __popc(mA1), __popc(mT0) + __popc(mT1), q4, cidx, offA, offT);
#pragma unroll
        for (int w = 0; w < 2; ++w) {
            unsigned mA = w ? mA1 : mA0;
            while (__any(mA != 0u)) {
                if (mA) {
                    const int i = __clz(mA); mA &= ~(0x80000000u >> i);
                    const int it = w * 32 + i; const int ci = (4 * q4 + (it >> 4)) * 16 + (it & 15);
                    fi[cidx * 16 + offA] = ci; ++offA;
                }
            }
        }
#pragma unroll
        for (int w = 0; w < 2; ++w) {
            unsigned mT = w ? mT1 : mT0;
            while (__any(mT != 0u)) {
                if (mT) {
                    const int i = __clz(mT); mT &= ~(0x80000000u >> i);
                    const int it = w * 32 + i; const int ci = (4 * q4 + (it >> 4)) * 16 + (it & 15);
                    if (offT < 16) fi[cidx * 16 + offT] = ci;
                    ++offT;
                }
            }
        }
    }
    lds_fence();
    {
        float s4[4]; int c4[4];
#pragma unroll
        for (int k = 0; k < 4; ++k) { c4[k] = fi[cidx * 16 + 4 * q4 + k]; s4[k] = vv[0][cidx * 16 + (c4[k] >> 4)] + vv[1][cidx * 16 + (c4[k] & 15)]; }
        float mx = fmaxf(fmaxf(s4[0], s4[1]), fmaxf(s4[2], s4[3]));
        mx = colmax(mx);
        float e4[4]; float sm = 0.f;
#pragma unroll
        for (int k = 0; k < 4; ++k) { e4[k] = __expf(s4[k] - mx); sm += e4[k]; }
        sm = colsum(sm);
        const float inv = 1.f / sm;
        int4 eo; float4 go;
        eo.x = ii[0][cidx * 16 + (c4[0] >> 4)] * 128 + ii[1][cidx * 16 + (c4[0] & 15)];
        eo.y = ii[0][cidx * 16 + (c4[1] >> 4)] * 128 + ii[1][cidx * 16 + (c4[1] & 15)];
        eo.z = ii[0][cidx * 16 + (c4[2] >> 4)] * 128 + ii[1][cidx * 16 + (c4[2] & 15)];
        eo.w = ii[0][cidx * 16 + (c4[3] >> 4)] * 128 + ii[1][cidx * 16 + (c4[3] & 15)];
        go.x = e4[0] * inv; go.y = e4[1] * inv; go.z = e4[2] * inv; go.w = e4[3] * inv;
        u16* elg = (u16*)(ws + OFF_EL) + (size_t)tq * 128 + hh * 16 + 4 * q4;
        float* gwg = (float*)(ws + OFF_GW) + (size_t)tq * 128 + hh * 16 + 4 * q4;
        u32x2 ep; ep[0] = (unsigned)eo.x | ((unsigned)eo.y << 16); ep[1] = (unsigned)eo.z | ((unsigned)eo.w << 16);
        *(u32x2*)elg = ep; *(float4*)gwg = go;
    }
    lds_fence();
}

DEV float gelu_exact(float x) { return 0.5f * x * (1.f + erff(x * 0.70710678118654752f)); }
DEV void unpack8(const bf16x8 v, float* f) {
    union { bf16x8 v; unsigned u[4]; } c; c.v = v;
#pragma unroll
    for (int i = 0; i < 4; ++i) { f[2 * i] = bflo(c.u[i]); f[2 * i + 1] = bfhi(c.u[i]); }
}
DEV void peer_experts_token(const Params& p, int l, int tok, const int* el_src, const float* w_src, float* act_lds) {
    unsigned char* ws = p.ws;
    const u16* H = (const u16*)(ws + OFF_H);
    u16* Hw = (u16*)(ws + OFF_H);
    const unsigned char* U8 = ws + OFF_U8;
    const unsigned char* V8 = ws + OFF_U8 + 16 * MiB;
    const float* SU = (const float*)(ws + OFF_UVS);
    const float* SV = (const float*)(ws + OFF_UVS) + 16384;
    const float* mod = (const float*)(ws + OFF_MOD);
    const float* g2 = mod + l * 4 * 6144 + 5 * 1024;
    const int lane = TID() & 63;
    {
        const int b = tok >> 13;
        float acc[16];
#pragma unroll
        for (int i = 0; i < 16; ++i) acc[i] = 0.f;
#if EN_PEER
        unsigned hp[4]; float shq;
        {
            float hx[16];
            unpack8(ld8(H + (size_t)tok * 1024 + 16 * lane), hx);
            unpack8(ld8(H + (size_t)tok * 1024 + 16 * lane + 8), hx + 8);
            float amax = 0.f;
#pragma unroll
            for (int i = 0; i < 16; ++i) amax = fmaxf(amax, fabsf(hx[i]));
            amax = wave_max(amax);
            shq = amax > 0.f ? amax * (1.f / 127.f) : 1.f;
            const float inv = 1.f / shq;
#pragma unroll
            for (int i = 0; i < 4; ++i) {
                const int a = __float2int_rn(hx[4 * i] * inv), b2 = __float2int_rn(hx[4 * i + 1] * inv), c = __float2int_rn(hx[4 * i + 2] * inv), d = __float2int_rn(hx[4 * i + 3] * inv);
                hp[i] = ((unsigned)a & 0xffu) | (((unsigned)b2 & 0xffu) << 8) | (((unsigned)c & 0xffu) << 16) | (((unsigned)d & 0xffu) << 24);
            }
        }
        float* actf = act_lds;
        unsigned* actq = (unsigned*)(act_lds + 128);
#define PEER_LOADT(Q, T, G_) { const int el_ = el_src[((G_) >> 1) * 16 + (lane & 15)]; const int k0_ = ((G_) & 1) * 8; _Pragma("unroll") for (int k = 0; k < 8; ++k) { \
            const int e = __builtin_amdgcn_readlane(el_, k0_ + k); Q[k] = *(const u32x4*)(T + (size_t)e * 1024 + 16 * lane); } }
        {
            u32x4 qA[8], qB[8], qC[8], qD[8];
#define PEER_EVALU(Q, G_) { const int hh_ = (G_) >> 1, k0_ = ((G_) & 1) * 8; const int el = el_src[hh_ * 16 + (lane & 15)]; const float wgt = w_src[hh_ * 16 + (lane & 15)]; \
            const float sul = SU[el] * shq, wsl = wgt * SV[el]; \
            int dpart[8]; _Pragma("unroll") for (int k = 0; k < 8; ++k) { int di = 0; _Pragma("unroll") for (int i = 0; i < 4; ++i) di = __builtin_amdgcn_sdot4((int)Q[k][i], (int)hp[i], di, false); dpart[k] = di; } \
            const int dsum = reduce8_i(dpart); const int srcl = k0_ + (lane >> 3); \
            const float sul_e = __shfl(sul, srcl), wsl_e = __shfl(wsl, srcl); \
            const float actl = gelu_exact((float)dsum * sul_e) * wsl_e; \
            if ((lane & 7) == 0) actf[(G_) * 8 + (lane >> 3)] = actl; }
            PEER_LOADT(qA, U8, 0); PEER_LOADT(qB, U8, 1); PEER_LOADT(qC, U8, 2);
#pragma unroll 1
            for (int g = 0; g < 16; g += 4) {
                PEER_LOADT(qD, U8, g + 3);
                PEER_EVALU(qA, g);
                if (g + 4 < 16) PEER_LOADT(qA, U8, g + 4);
                PEER_EVALU(qB, g + 1);
                if (g + 5 < 16) PEER_LOADT(qB, U8, g + 5);
                PEER_EVALU(qC, g + 2);
                if (g + 6 < 16) PEER_LOADT(qC, U8, g + 6);
                PEER_EVALU(qD, g + 3);
            }
#undef PEER_EVALU
        }
        u32x4 vA[8], vB[8];
        PEER_LOADT(vA, V8, 0);
        lds_fence();
        float sa;
        {
            const float a0 = actf[lane], a1 = actf[lane + 64];
            const float amax = wave_max(fmaxf(fabsf(a0), fabsf(a1)));
            sa = amax > 0.f ? amax * (1.f / 127.f) : 1.f;
            const float inv = 1.f / sa;
            ((signed char*)actq)[lane] = (signed char)__float2int_rn(a0 * inv);
            ((signed char*)actq)[lane + 64] = (signed char)__float2int_rn(a1 * inv);
        }
        lds_fence();
        int iacc[16];
#pragma unroll
        for (int i = 0; i < 16; ++i) iacc[i] = 0;
        {
#define PEER_EVALV(Q, G_) { _Pragma("unroll") for (int qd = 0; qd < 2; ++qd) { const int a4 = (int)actq[(G_) * 2 + qd]; \
            _Pragma("unroll") for (int c = 0; c < 4; ++c) { \
                const unsigned w0 = Q[4 * qd][c], w1 = Q[4 * qd + 1][c], w2 = Q[4 * qd + 2][c], w3 = Q[4 * qd + 3][c]; \
                const unsigned x01l = __builtin_amdgcn_perm(w1, w0, 0x05010400u), x01h = __builtin_amdgcn_perm(w1, w0, 0x07030602u); \
                const unsigned x23l = __builtin_amdgcn_perm(w3, w2, 0x05010400u), x23h = __builtin_amdgcn_perm(w3, w2, 0x07030602u); \
                iacc[4 * c + 0] = __builtin_amdgcn_sdot4((int)__builtin_amdgcn_perm(x23l, x01l, 0x05040100u), a4, iacc[4 * c + 0], false); \
                iacc[4 * c + 1] = __builtin_amdgcn_sdot4((int)__builtin_amdgcn_perm(x23l, x01l, 0x07060302u), a4, iacc[4 * c + 1], false); \
                iacc[4 * c + 2] = __builtin_amdgcn_sdot4((int)__builtin_amdgcn_perm(x23h, x01h, 0x05040100u), a4, iacc[4 * c + 2], false); \
                iacc[4 * c + 3] = __builtin_amdgcn_sdot4((int)__builtin_amdgcn_perm(x23h, x01h, 0x07060302u), a4, iacc[4 * c + 3], false); } } }
#pragma unroll 1
            for (int g = 0; g < 16; g += 2) {
                PEER_LOADT(vB, V8, g + 1);
                PEER_EVALV(vA, g);
                if (g + 2 < 16) PEER_LOADT(vA, V8, g + 2);
                PEER_EVALV(vB, g + 1);
            }
#undef PEER_EVALV
        }
#undef PEER_LOADT
#pragma unroll
        for (int i = 0; i < 16; ++i) acc[i] = sa * (float)iacc[i];
        lds_fence();
#endif

        const int k = 16 * lane;
        float xn[16]; float ss = 0.f;
#pragma unroll
        for (int i = 0; i < 4; ++i) {
            const float4 x0 = *(const float4*)(p.out + (size_t)tok * 1024 + k + 4 * i);
            const float4 ga = *(const float4*)(g2 + b * 6144 + k + 4 * i);
            xn[4 * i] = x0.x + ga.x * acc[4 * i]; xn[4 * i + 1] = x0.y + ga.y * acc[4 * i + 1];
            xn[4 * i + 2] = x0.z + ga.z * acc[4 * i + 2]; xn[4 * i + 3] = x0.w + ga.w * acc[4 * i + 3];
        }
#pragma unroll
        for (int i = 0; i < 16; ++i) ss += xn[i] * xn[i];
        ss = wave_sum(ss);
        const float rs = rsqrtf(ss * (1.f / 1024.f) + 1e-6f);
        if (l == 0) {
            const float* n1g = p.in[I_N1G] + 1024; const float* sh = mod + 4 * 6144 + b * 6144; const float* sc = sh + 1024;
            float hv[16];
#pragma unroll
            for (int i = 0; i < 4; ++i) {
                *(float4*)(p.out + (size_t)tok * 1024 + k + 4 * i) = (float4){xn[4 * i], xn[4 * i + 1], xn[4 * i + 2], xn[4 * i + 3]};
                const float4 gg = *(const float4*)(n1g + k + 4 * i), s1 = *(const float4*)(sc + k + 4 * i), s0 = *(const float4*)(sh + k + 4 * i);
                hv[4 * i] = xn[4 * i] * rs * gg.x * (1.f + s1.x) + s0.x; hv[4 * i + 1] = xn[4 * i + 1] * rs * gg.y * (1.f + s1.y) + s0.y;
                hv[4 * i + 2] = xn[4 * i + 2] * rs * gg.z * (1.f + s1.z) + s0.z; hv[4 * i + 3] = xn[4 * i + 3] * rs * gg.w * (1.f + s1.w) + s0.w;
            }
            u32x4 w0, w1;
#pragma unroll
            for (int i = 0; i < 4; ++i) { w0[i] = pack2(hv[2 * i], hv[2 * i + 1]); w1[i] = pack2(hv[8 + 2 * i], hv[8 + 2 * i + 1]); }
            *(u32x4*)(Hw + (size_t)tok * 1024 + k) = w0; *(u32x4*)(Hw + (size_t)tok * 1024 + k + 8) = w1;
        } else {
            const float* fg = p.in[I_FG];
#pragma unroll
            for (int i = 0; i < 4; ++i) {
                const float4 gg = *(const float4*)(fg + k + 4 * i);
                *(float4*)(p.out + (size_t)tok * 1024 + k + 4 * i) = (float4){xn[4 * i] * rs * gg.x, xn[4 * i + 1] * rs * gg.y, xn[4 * i + 2] * rs * gg.z, xn[4 * i + 3] * rs * gg.w};
            }
        }
    }
}

DEV void peer_quant_h(const Params& p, int tok) {
    unsigned char* ws = p.ws;
    const u16* H = (const u16*)(ws + OFF_H);
    const int lane = TID() & 63;
    float hx[16];
    unpack8(ld8(H + (size_t)tok * 1024 + 16 * lane), hx);
    unpack8(ld8(H + (size_t)tok * 1024 + 16 * lane + 8), hx + 8);
    float amax = 0.f;
#pragma unroll
    for (int i = 0; i < 16; ++i) amax = fmaxf(amax, fabsf(hx[i]));
    amax = wave_max(amax);
    const float shq = amax > 0.f ? amax * (1.f / 127.f) : 1.f;
    const float inv = 1.f / shq;
    u32x4 hp;
#pragma unroll
    for (int i = 0; i < 4; ++i) {
        const int a = __float2int_rn(hx[4 * i] * inv), b2 = __float2int_rn(hx[4 * i + 1] * inv), c = __float2int_rn(hx[4 * i + 2] * inv), d = __float2int_rn(hx[4 * i + 3] * inv);
        hp[i] = ((unsigned)a & 0xffu) | (((unsigned)b2 & 0xffu) << 8) | (((unsigned)c & 0xffu) << 16) | (((unsigned)d & 0xffu) << 24);
    }
    *(u32x4*)(ws + OFF_HP8 + (size_t)tok * 1024 + 16 * lane) = hp;
    if (lane == 0) ((float*)(ws + OFF_SHQ))[tok] = shq;
}

#define PEER_EIDX(EA, EB, K_) ((((K_) < 8 ? EA[((K_) & 7) >> 1] : EB[((K_) & 7) >> 1]) >> (16 * ((K_) & 1))) & 0xffffu)

DEV void peer_u_chunk(const Params& p, int x, int tok0, int ntok) {
    unsigned char* ws = p.ws;
    const int lane = TID() & 63, g = lane >> 3, c = lane & 7;
    const unsigned char* Us = ws + OFF_U8 + (size_t)x * (2 * MiB) + 16 * c;
    const u16* EL = (const u16*)(ws + OFF_EL);
    const unsigned char* HP = ws + OFF_HP8 + 128 * x + 16 * c;
    int* PART = (int*)(ws + OFF_PART);
    u32x4 ea = *(const u32x4*)(EL + (size_t)tok0 * 128 + g * 16), eb = *(const u32x4*)(EL + (size_t)tok0 * 128 + g * 16 + 8);
#pragma unroll 1
    for (int i = 0; i < ntok; ++i) {
        const int tok = tok0 + i;
        u32x4 na = ea, nb = eb;
        if (i + 1 < ntok) { na = *(const u32x4*)(EL + (size_t)(tok + 1) * 128 + g * 16); nb = *(const u32x4*)(EL + (size_t)(tok + 1) * 128 + g * 16 + 8); }
        u32x4 Q[16];
#pragma unroll
        for (int k = 0; k < 16; ++k) { const unsigned e = PEER_EIDX(ea, eb, k); Q[k] = *(const u32x4*)(Us + e * 128u); }
        const u32x4 hp = *(const u32x4*)(HP + (size_t)tok * 1024);
        int d[16];
#pragma unroll
        for (int k = 0; k < 16; ++k) {
            int di = 0;
#pragma unroll
            for (int j = 0; j < 4; ++j) di = __builtin_amdgcn_sdot4((int)Q[k][j], (int)hp[j], di, false);
            di += (int)dppu<0xB1>((unsigned)di); di += (int)dppu<0x4E>((unsigned)di); di += (int)dppu<0x141>((unsigned)di);
            d[k] = di;
        }
        if (c == 0) {
            int* o = PART + ((size_t)tok * 8 + x) * 128 + g * 16;
#pragma unroll
            for (int j = 0; j < 4; ++j) *(int4*)(o + 4 * j) = (int4){d[4 * j], d[4 * j + 1], d[4 * j + 2], d[4 * j + 3]};
        }
        ea = na; eb = nb;
    }
}

DEV void peer_combine_token(const Params& p, int tok) {
    unsigned char* ws = p.ws;
    const int lane = TID() & 63;
    const int* PART = (const int*)(ws + OFF_PART) + (size_t)tok * 1024;
    const u16* EL = (const u16*)(ws + OFF_EL) + (size_t)tok * 128;
    const float* GW = (const float*)(ws + OFF_GW) + (size_t)tok * 128;
    const float* SU = (const float*)(ws + OFF_UVS);
    const float* SV = SU + 16384;
    const float shq = ((const float*)(ws + OFF_SHQ))[tok];
    int s0 = 0, s1 = 0;
#pragma unroll
    for (int x = 0; x < 8; ++x) { s0 += PART[x * 128 + lane]; s1 += PART[x * 128 + 64 + lane]; }
    const int e0 = EL[lane], e1 = EL[64 + lane];
    const float a0 = gelu_exact((float)s0 * (SU[e0] * shq)) * (GW[lane] * SV[e0]);
    const float a1 = gelu_exact((float)s1 * (SU[e1] * shq)) * (GW[64 + lane] * SV[e1]);
    const float amax = wave_max(fmaxf(fabsf(a0), fabsf(a1)));
    const float sa = amax > 0.f ? amax * (1.f / 127.f) : 1.f;
    const float inv = 1.f / sa;
    signed char* AQ = (signed char*)(ws + OFF_AQ) + (size_t)tok * 128;
    AQ[lane] = (signed char)__float2int_rn(a0 * inv);
    AQ[64 + lane] = (signed char)__float2int_rn(a1 * inv);
    if (lane == 0) ((float*)(ws + OFF_SA))[tok] = sa;
}

DEV void peer_v_chunk(const Params& p, int l, int x, int tok0, int ntok) {
    unsigned char* ws = p.ws;
    const int lane = TID() & 63, g = lane >> 3, c = lane & 7;
    const unsigned char* Vs = ws + OFF_U8 + 16 * MiB + (size_t)x * (2 * MiB) + 16 * c;
    const u16* EL = (const u16*)(ws + OFF_EL);
    const unsigned char* AQ = ws + OFF_AQ + 16 * g;
    const float* SA = (const float*)(ws + OFF_SA);
    const float* g2 = (const float*)(ws + OFF_MOD) + l * 4 * 6144 + 5 * 1024;
    const int col = 128 * x + 16 * c + 8 * ((g >> 1) & 1) + 4 * (g >> 2);
    u32x4 ea = *(const u32x4*)(EL + (size_t)tok0 * 128 + g * 16), eb = *(const u32x4*)(EL + (size_t)tok0 * 128 + g * 16 + 8);
#pragma unroll 1
    for (int i = 0; i < ntok; ++i) {
        const int tok = tok0 + i;
        u32x4 na = ea, nb = eb;
        if (i + 1 < ntok) { na = *(const u32x4*)(EL + (size_t)(tok + 1) * 128 + g * 16); nb = *(const u32x4*)(EL + (size_t)(tok + 1) * 128 + g * 16 + 8); }
        u32x4 Q[16];
#pragma unroll
        for (int k = 0; k < 16; ++k) { const unsigned e = PEER_EIDX(ea, eb, k); Q[k] = *(const u32x4*)(Vs + e * 128u); }
        const u32x4 a4 = *(const u32x4*)(AQ + (size_t)tok * 128);
        const float sa = SA[tok];
        const float4 xo = *(const float4*)(p.out + (size_t)tok * 1024 + col);
        int iacc[16];
#pragma unroll
        for (int j = 0; j < 16; ++j) iacc[j] = 0;
#pragma unroll
        for (int m = 0; m < 4; ++m) {
            const int am = (int)a4[m];
#pragma unroll
            for (int cq = 0; cq < 4; ++cq) {
                const unsigned w0 = Q[4 * m][cq], w1 = Q[4 * m + 1][cq], w2 = Q[4 * m + 2][cq], w3 = Q[4 * m + 3][cq];
                const unsigned x01l = __builtin_amdgcn_perm(w1, w0, 0x05010400u), x01h = __builtin_amdgcn_perm(w1, w0, 0x07030602u);
                const unsigned x23l = __builtin_amdgcn_perm(w3, w2, 0x05010400u), x23h = __builtin_amdgcn_perm(w3, w2, 0x07030602u);
                iacc[4 * cq + 0] = __builtin_amdgcn_sdot4((int)__builtin_amdgcn_perm(x23l, x01l, 0x05040100u), am, iacc[4 * cq + 0], false);
                iacc[4 * cq + 1] = __builtin_amdgcn_sdot4((int)__builtin_amdgcn_perm(x23l, x01l, 0x07060302u), am, iacc[4 * cq + 1], false);
                iacc[4 * cq + 2] = __builtin_amdgcn_sdot4((int)__builtin_amdgcn_perm(x23h, x01h, 0x05040100u), am, iacc[4 * cq + 2], false);
                iacc[4 * cq + 3] = __builtin_amdgcn_sdot4((int)__builtin_amdgcn_perm(x23h, x01h, 0x07060302u), am, iacc[4 * cq + 3], false);
            }
        }
        int u8_[8], v4_[4];
#pragma unroll
        for (int j = 0; j < 16; ++j) iacc[j] += (int)dppu<0x128>((unsigned)iacc[j]);
#pragma unroll
        for (int j = 0; j < 8; ++j) { auto r = __builtin_amdgcn_permlane16_swap((unsigned)iacc[j], (unsigned)iacc[j + 8], false, false); u8_[j] = (int)(r[0] + r[1]); }
#pragma unroll
        for (int j = 0; j < 4; ++j) { auto r = __builtin_amdgcn_permlane32_swap((unsigned)u8_[j], (unsigned)u8_[j + 4], false, false); v4_[j] = (int)(r[0] + r[1]); }
        if ((g & 1) == 0) {
            const float4 ga = *(const float4*)(g2 + (tok >> 13) * 6144 + col);
            float4 xn;
            xn.x = xo.x + ga.x * (sa * (float)v4_[0]); xn.y = xo.y + ga.y * (sa * (float)v4_[1]);
            xn.z = xo.z + ga.z * (sa * (float)v4_[2]); xn.w = xo.w + ga.w * (sa * (float)v4_[3]);
            *(float4*)(p.out + (size_t)tok * 1024 + col) = xn;
        }
        ea = na; eb = nb;
    }
}

DEV void phase_final_norm(float* __restrict__ x, const float* __restrict__ g) {
    const int lane = TID() & 63;
    const int gw = BID() * 4 + (TID() >> 6), nw = gridDim.x * 4;
    for (int row0 = gw * 2; row0 < NTOK; row0 += nw * 2) {
        float4 v[2][4]; float ss[2] = {0.f, 0.f};
#pragma unroll
        for (int u = 0; u < 2; ++u)
#pragma unroll
            for (int i = 0; i < 4; ++i) v[u][i] = *(const float4*)(x + (size_t)(row0 + u) * 1024 + 256 * i + lane * 4);
#pragma unroll
        for (int u = 0; u < 2; ++u) {
#pragma unroll
            for (int i = 0; i < 4; ++i) ss[u] += v[u][i].x * v[u][i].x + v[u][i].y * v[u][i].y + v[u][i].z * v[u][i].z + v[u][i].w * v[u][i].w;
            ss[u] = wave_sum(ss[u]);
        }
#pragma unroll
        for (int u = 0; u < 2; ++u) {
            const float rs = rsqrtf(ss[u] * (1.f / 1024.f) + 1e-6f);
#pragma unroll
            for (int i = 0; i < 4; ++i) {
                const int k = 256 * i + lane * 4;
                const float4 gg = *(const float4*)(g + k);
                *(float4*)(x + (size_t)(row0 + u) * 1024 + k) = (float4){v[u][i].x * rs * gg.x, v[u][i].y * rs * gg.y, v[u][i].z * rs * gg.z, v[u][i].w * rs * gg.w};
            }
        }
    }
}

constexpr int NSUB = 12;
constexpr int NPH = 2 + 2 * NSUB;

__global__ void __launch_bounds__(256, 2) mega(Params p) {
    __shared__ __attribute__((aligned(16))) unsigned char lds[81920 - 128];
    __shared__ int misc[8];
    int* qslot = misc;
    cg::grid_group grid = cg::this_grid();
    if (threadIdx.x < 8) misc[threadIdx.x] = 0;
    __syncthreads();
    XcdBarrier xbar = xcd_barrier_post((unsigned*)(p.ws + OFF_BAR), (volatile unsigned*)(misc + 4));
    unsigned char* ws = p.ws;
    const float* mod = (const float*)(ws + OFF_MOD);
    unsigned* ctl = (unsigned*)(ws + OFF_CTL);
    const int G = gridDim.x, bx = BID();
    for (int ph = p.ph_lo; ph < p.ph_hi; ++ph) {
        if (ph == 0) {
            phase_prep(p, lds);
        } else if (ph == 1) {
            phase_norm(p.in[I_X], p.in[I_N1G], mod + 0 * 1024, mod + 1 * 1024, (u16*)(ws + OFF_H));
        } else {
            const int l = (ph - 2) / NSUB, sp = (ph - 2) % NSUB;
            const float* modl = mod + l * 4 * 6144;
            if (sp == 0) {
                EpiInProj e{(u16*)(ws + OFF_PCONV), (u16*)(ws + OFF_PRWKV), (u16*)(ws + OFF_Q), (u16*)(ws + OFF_KV), (float*)(ws + OFF_GATE)};
                gemm_phase((const u16*)(ws + OFF_H), 1024, (const u16*)(ws + OFF_WIN) + (size_t)l * NINP * 1024, 1024, 256, 8, 1024, e, lds, bx, G, 0, 4);
            } else if (sp == 1) {
#if EN_RWKV
                for (int t = bx; t < NTOK / 16; t += G) { rwkv_prep_tile2(p, l, t, lds); __syncthreads(); }
#endif
            } else if (sp == 2) {
#if EN_RWKV
                if (bx < 64) { __builtin_amdgcn_s_setprio(3); rwkv_scan(p, bx, lds); __builtin_amdgcn_s_setprio(0); }
#endif
                unsigned* cdone = ctl + QW(l, 5);
                unsigned* gdone = ctl + QW(l, 6);
                if (bx >= 64) {
                    EpiInProj e{(u16*)(ws + OFF_PCONV), (u16*)(ws + OFF_PRWKV), (u16*)(ws + OFF_Q), (u16*)(ws + OFF_KV), (float*)(ws + OFF_GATE)};
                    gemm_phase((const u16*)(ws + OFF_H), 1024, (const u16*)(ws + OFF_WIN) + (size_t)l * NINP * 1024, 1024, 256, 15, 1024, e, lds, bx - 64, G - 64, 4, 8, false);
                    asm volatile("s_waitcnt vmcnt(0)" ::: "memory");
                    __syncthreads();
                    if (threadIdx.x == 0) {
                        __builtin_amdgcn_fence(__ATOMIC_RELEASE, "agent");
                        asm volatile("s_waitcnt vmcnt(0)" ::: "memory");
                        __hip_atomic_fetch_add(gdone, 1u, __ATOMIC_RELAXED, __HIP_MEMORY_SCOPE_AGENT);
                    }
                }
                __syncthreads();
                if (threadIdx.x == 0) {
                    unsigned sp_ = 0;
                    while (__hip_atomic_load(gdone, __ATOMIC_RELAXED, __HIP_MEMORY_SCOPE_AGENT) < (unsigned)(G - 64)) { __builtin_amdgcn_s_sleep(8); if (++sp_ > (1u << 24)) break; }
                    __builtin_amdgcn_fence(__ATOMIC_ACQUIRE, "agent");
                    asm volatile("s_waitcnt vmcnt(0)" ::: "memory");
                }
                __syncthreads();
                if (bx >= 64 && bx < 128) {
                    const u16* KVb = (const u16*)(ws + OFF_KV);
                    if (bx < 96) {
                        EpiCompress ek{(const float*)(ws + OFF_CBP) + (l * 2 + 0) * 2048, p.in[I_CKW2] + (size_t)l * 8192, (u16*)(ws + OFF_KC), 0, lds};
                        gemm_phase(KVb, 1024, (const u16*)(ws + OFF_CW1) + (size_t)(l * 2 + 0) * 128 * 2048, 2048, 32, 1, 2048, ek, lds, bx - 64, 1 << 20);
                    } else {
                        EpiCompress ev{(const float*)(ws + OFF_CBP) + (l * 2 + 1) * 2048, p.in[I_CVW2] + (size_t)l * 8192, (u16*)(ws + OFF_VCT), 1, lds};
                        gemm_phase(KVb + 4194304, 1024, (const u16*)(ws + OFF_CW1) + (size_t)(l * 2 + 1) * 128 * 2048, 2048, 32, 1, 2048, ev, lds, bx - 96, 1 << 20);
                    }
                    asm volatile("s_waitcnt vmcnt(0)" ::: "memory");
                    __syncthreads();
                    if (threadIdx.x == 0) {
                        __builtin_amdgcn_fence(__ATOMIC_RELEASE, "agent");
                        asm volatile("s_waitcnt vmcnt(0)" ::: "memory");
                        __hip_atomic_fetch_add(cdone, 1u, __ATOMIC_RELAXED, __HIP_MEMORY_SCOPE_AGENT);
                    }
                }
#if EN_CONV
                for (;;) { const int t = block_next(ctl + QW(l, Q_CONV), qslot); if (t >= NTOK / 32) break; conv_tile(p, l, t, lds); }
#else
                zero_mix_cols(p, 0, 256);
#endif
                __syncthreads();
                if (threadIdx.x == 0) {
                    unsigned sp_ = 0;
                    while (__hip_atomic_load(cdone, __ATOMIC_RELAXED, __HIP_MEMORY_SCOPE_AGENT) < 64u) { __builtin_amdgcn_s_sleep(8); if (++sp_ > (1u << 24)) break; }
                    __builtin_amdgcn_fence(__ATOMIC_ACQUIRE, "agent");
                    asm volatile("s_waitcnt vmcnt(0)" ::: "memory");
                }
                __syncthreads();
                for (int qi = 0; qi < 8; ++qi) {
                    const int bgq = (bx + qi) & 7;
                    for (;;) { const int t = block_next(ctl + QW(l, Q_NSA) + bgq, qslot); if (t >= 256) break; nsa_block_task(p, t * 8 + bgq, lds); }
                }
                if (l == 0) {
                    float* fl = (float*)lds;
                    for (;;) {
                        const int t = block_next(ctl + QW(0, 0), qslot); if (t >= 1536) break;
                        if (t < 512) { const int l2 = t >> 8, r = t & 255; transpose_tile(p.in[I_WOUT] + (size_t)l2 * 1024 * 1024, 1024, (u16*)(ws + OFF_WOUT) + (size_t)l2 * 1024 * 1024, 1024, r >> 4, r & 15, fl); }
                        else { const int u = t - 512; const int l2 = u >> 9, r = u & 511; transpose_tile(p.in[I_PWQ] + (size_t)l2 * 1024 * 2048, 2048, (u16*)(ws + OFF_WQ) + (size_t)l2 * 2048 * 1024, 1024, r >> 5, r & 31, fl); }
                    }
                }
                for (;;) {
                    const int t = block_next(ctl + QW(l, 7), qslot); if (t >= 1024) break;
                    const int tb = t >> 9, r0 = (t & 511) * 32;
                    convert_rows_task(p.in[tb ? I_PV : I_PU] + (size_t)l * 16384 * 1024, ws + OFF_U8 + (size_t)tb * 16 * MiB, (float*)(ws + OFF_UVS) + tb * 16384,
                                      tb ? nullptr : (int*)(ws + OFF_UVS) + 2 * 16384, r0);
                }
            } else if (sp == 3) {
#if EN_RWKV
                phase_rwkv_post(p, l);
#else
                zero_mix_cols(p, 256, 256);
#endif
            } else if (sp == 4) {
                EpiOutProj e{l == 0 ? p.in[I_X] : p.out, p.out, modl + 2 * 1024};
                gemm_phase((const u16*)(ws + OFF_MIX), 1024, (const u16*)(ws + OFF_WOUT) + (size_t)l * 1024 * 1024, 1024, 256, 8, 1024, e, lds, bx, G);
            } else if (sp == 5) {
#if EN_PEER
                phase_norm(p.out, p.in[I_N2G] + l * 1024, modl + 3 * 1024, modl + 4 * 1024, (u16*)(ws + OFF_H));
#endif
            } else if (sp == 6) {
#if EN_PEER
                EpiStoreBf16 e{(u16*)(ws + OFF_QP), 2048};
                gemm_phase((const u16*)(ws + OFF_H), 1024, (const u16*)(ws + OFF_WQ) + (size_t)l * 2048 * 1024, 1024, 256, 16, 1024, e, lds, bx, G);
#endif
            } else if (sp == 7) {
#if EN_PEER
                float* wl = (float*)lds + (TID() >> 6) * 4096;
                for (int t = bx * 4 + (TID() >> 6); t < NTOK / 2; t += G * 4) {
                    peer_topk_task2(p, l, t, wl);
                    peer_quant_h(p, 2 * t); peer_quant_h(p, 2 * t + 1);
                    lds_fence();
                }
#endif
            } else if (sp == 8 || sp == 10) {
#if EN_PEER
                const int pass = sp == 10;
                for (int qi = 0; qi < 8; ++qi) {
                    const int x = (bx + qi) & 7;
                    for (;;) {
                        const int t = block_next(ctl + PQ(l, pass, x), qslot); if (t >= NTOK / 64) break;
                        const int tok0 = t * 64 + (TID() >> 6) * 16;
                        if (pass == 0) peer_u_chunk(p, x, tok0, 16); else peer_v_chunk(p, l, x, tok0, 16);
                    }
                }
#endif
            } else if (sp == 9) {
#if EN_PEER
                for (int tok = bx * 4 + (TID() >> 6); tok < NTOK; tok += G * 4) peer_combine_token(p, tok);
#endif
            } else if (sp == 11) {
                if (l == 0) phase_norm(p.out, p.in[I_N1G] + 1024, mod + 4 * 6144, mod + 4 * 6144 + 1024, (u16*)(ws + OFF_H));
                else phase_final_norm(p.out, p.in[I_FG]);
            }
        }
        if (ph + 1 < p.ph_hi) { if (p.ph_lo < 0) grid.sync(); else xcd_barrier(xbar); }
    }
}

extern "C" void kernel_launch(void* const* d_in, const int* in_sizes, int n_in, void* d_out, int out_size, void* d_ws, size_t ws_size,
                              hipStream_t stream) {
    static int grid_blocks = 0;
    if (!grid_blocks) {
        int dev = 0, cus = 0, per_cu = 0;
        hipGetDevice(&dev);
        hipDeviceGetAttribute(&cus, hipDeviceAttributeMultiprocessorCount, dev);
        hipOccupancyMaxActiveBlocksPerMultiprocessor(&per_cu, (const void*)mega, 256, 0);
        if (per_cu > 2) per_cu = 2;
        if (per_cu < 1) per_cu = 1;
        grid_blocks = cus * per_cu;
        if (ws_size < WS_NEED) fprintf(stderr, "kernel_launch: workspace too small: %zu < %zu\n", ws_size, (size_t)WS_NEED);
    }
    hipMemsetAsync((char*)d_ws + OFF_CTL, 0, CTL_ZERO_BYTES, stream);
    Params p{};
    for (int i = 0; i < 35; ++i) p.in[i] = (const float*)d_in[i];
    p.out = (float*)d_out;
    p.ws = (unsigned char*)d_ws;
#if MULTI_LAUNCH
    for (int ph = 0; ph < NPH; ++ph) {
        p.ph_lo = ph; p.ph_hi = ph + 1;
        hipLaunchKernelGGL(mega, dim3(grid_blocks), dim3(256), 0, stream, p);
    }
#else
    p.ph_lo = 0; p.ph_hi = NPH;
    void* args[] = {&p};
    hipError_t e = hipLaunchCooperativeKernel((const void*)mega, dim3(grid_blocks), dim3(256), args, 0, stream);
    if (e != hipSuccess) fprintf(stderr, "cooperative launch failed: %s (grid %d)\n", hipGetErrorString(e), grid_blocks);
#endif
}
```
